# Optimizing an MI355X kernel written in HIP

```python
import math
import jax
import jax.numpy as jnp
from jax import lax
import numpy as np

D_MODEL = 1024
BATCH = 4
SEQ = 4096
DEPTH = 1

GRID_W = 64
CTX_LEN = 256
NORM_EPS = 1e-6

N_HEADS = 8
N_KV_HEADS = 2
HEAD_DIM = 64
WINDOW = 128
BLOCK = 128
ROPE_BASE = 10000.0

HY_WIDTH = 512
HY_SHORT = 3
HY_EMB_BANDS = 16
HY_EMB_DIM = 1 + 2 * HY_EMB_BANDS
HY_FILTER_HIDDEN = 64
HY_FAST_DECAY = 0.3
HY_SLOW_DECAY = 1.5
HY_DECAY_TARGET = 1e-2

PEER_HEADS = 8
PEER_KEYS = 128
PEER_EXPERTS = PEER_KEYS * PEER_KEYS
PEER_TOPK = 16
PEER_DKEY = 128
PEER_CHUNK = 128

Q_W = N_HEADS * HEAD_DIM
KV_W = N_KV_HEADS * HEAD_DIM
HY_IN = 3 * HY_WIDTH
GATE_W = 2 * D_MODEL
OFF_K = Q_W
OFF_V = OFF_K + KV_W
OFF_HY = OFF_V + KV_W
OFF_G = OFF_HY + HY_IN
IN_W = OFF_G + GATE_W

kernel_name = 'hybrid_swa_hyena_peer_dit_block'


def _rmsnorm(x, g):
    xf = x.astype(jnp.float32)
    y = xf * lax.rsqrt(jnp.mean(xf * xf, axis=-1, keepdims=True) + NORM_EPS)
    return (y * g.astype(jnp.float32)).astype(x.dtype)


def _modulate(h, shift, scale):
    return h * (1 + scale) + shift


def _rope_1d(x, pos):
    f = x.shape[-1] // 2
    inv = ROPE_BASE ** (-jnp.arange(f, dtype=jnp.float32) / f)
    ang = pos.astype(jnp.float32)[:, None] * inv[None, :]
    cos = jnp.cos(ang)[:, None, :]
    sin = jnp.sin(ang)[:, None, :]
    xf = x.astype(jnp.float32)
    x1, x2 = xf[..., :f], xf[..., f:]
    return jnp.concatenate([x1 * cos - x2 * sin, x2 * cos + x1 * sin], axis=-1).astype(x.dtype)


def _rope_2d(x, row, col):
    half = x.shape[-1] // 2
    return jnp.concatenate([_rope_1d(x[..., :half], row), _rope_1d(x[..., half:], col)], axis=-1)


def _window_attention(q, k, v, k_ctx, v_ctx, sink):
    B, L, H, dh = q.shape
    C = k_ctx.shape[1]
    G = H // N_KV_HEADS
    nb = L // BLOCK
    scale = dh ** -0.5
    qb = q.reshape(B, nb, BLOCK, N_KV_HEADS, G, dh)
    pad = ((0, 0), (BLOCK, BLOCK), (0, 0), (0, 0))
    kp = jnp.pad(k, pad).reshape(B, nb + 2, BLOCK, N_KV_HEADS, dh)
    vp = jnp.pad(v, pad).reshape(B, nb + 2, BLOCK, N_KV_HEADS, dh)
    kw = jnp.concatenate([kp[:, :-2], kp[:, 1:-1], kp[:, 2:]], axis=2)
    vw = jnp.concatenate([vp[:, :-2], vp[:, 1:-1], vp[:, 2:]], axis=2)
    s_loc = jnp.einsum('bnqhgd,bnkhd->bnhgqk', qb, kw).astype(jnp.float32) * scale
    s_ctx = jnp.einsum('bnqhgd,bchd->bnhgqc', qb, k_ctx).astype(jnp.float32) * scale
    blk = jnp.arange(nb, dtype=jnp.int32)
    qpos = blk[:, None] * BLOCK + jnp.arange(BLOCK, dtype=jnp.int32)[None, :]
    kpos = (blk[:, None] - 1) * BLOCK + jnp.arange(3 * BLOCK, dtype=jnp.int32)[None, :]
    rel = kpos[:, None, :] - qpos[:, :, None]
    valid = (jnp.abs(rel) <= WINDOW) & (kpos[:, None, :] >= 0) & (kpos[:, None, :] < L)
    s_loc = jnp.where(valid[None, :, None, None], s_loc, -jnp.inf)
    s_sink = jnp.broadcast_to(sink.astype(jnp.float32).reshape(1, 1, N_KV_HEADS, G, 1, 1),
                              s_loc.shape[:-1] + (1,))
    prob = jax.nn.softmax(jnp.concatenate([s_loc, s_ctx, s_sink], axis=-1), axis=-1)
    p_loc = prob[..., :3 * BLOCK].astype(v.dtype)
    p_ctx = prob[..., 3 * BLOCK:3 * BLOCK + C].astype(v.dtype)
    o = (jnp.einsum('bnhgqk,bnkhd->bnqhgd', p_loc, vw)
         + jnp.einsum('bnhgqc,bchd->bnqhgd', p_ctx, v_ctx))
    return o.reshape(B, L, H * dh)


def _context_attention(q, k, v, sink):
    B, C, H, dh = q.shape
    G = H // N_KV_HEADS
    qg = q.reshape(B, C, N_KV_HEADS, G, dh)
    s = jnp.einsum('bqhgd,bkhd->bhgqk', qg, k).astype(jnp.float32) * (dh ** -0.5)
    s_sink = jnp.broadcast_to(sink.astype(jnp.float32).reshape(1, N_KV_HEADS, G, 1, 1), s.shape[:-1] + (1,))
    prob = jax.nn.softmax(jnp.concatenate([s, s_sink], axis=-1), axis=-1)[..., :C]
    o = jnp.einsum('bhgqk,bkhd->bqhgd', prob.astype(v.dtype), v)
    return o.reshape(B, C, H * dh)


def _hyena_filter(L, fw1, fb1, fw2, fb2, fw3, fb3, freq):
    fw1, fb1, fw2, fb2, fw3, fb3, freq = [a.astype(jnp.float32) for a in (fw1, fb1, fw2, fb2, fw3, fb3, freq)]
    t = jnp.arange(L, dtype=jnp.float32) / L
    bands = jnp.arange(1, HY_EMB_BANDS + 1, dtype=jnp.float32)
    ang = 2.0 * math.pi * t[:, None] * bands[None, :]
    z = jnp.concatenate([t[:, None], jnp.cos(ang), jnp.sin(ang)], axis=-1)
    h = jnp.sin(freq * (z @ fw1 + fb1))
    h = jnp.sin(freq * (h @ fw2 + fb2))
    h = h @ fw3 + fb3
    deltas = jnp.linspace(math.log(HY_DECAY_TARGET) / HY_SLOW_DECAY,
                          math.log(HY_DECAY_TARGET) / HY_FAST_DECAY, HY_WIDTH, dtype=jnp.float32)
    decay = jnp.exp(-t[:, None] * jnp.abs(deltas)[None, :])
    h_fwd = h[:, :HY_WIDTH] * decay
    h_bwd = h[:, HY_WIDTH:] * decay
    kern = jnp.concatenate([h_fwd, jnp.zeros((1, HY_WIDTH), jnp.float32), jnp.flip(h_bwd[:L - 1], axis=0)], axis=0)
    return kern / jnp.sum(jnp.abs(kern), axis=0, keepdims=True)


def _short_conv(u, w, b):
    up = jnp.pad(u, ((0, 0), (1, 1), (0, 0)))
    return up[:, :-2] * w[0] + up[:, 1:-1] * w[1] + up[:, 2:] * w[2] + b


def _fft_long_conv(u, kern, skip):
    L = u.shape[1]
    uf = jnp.fft.rfft(u.astype(jnp.float32), n=2 * L, axis=1)
    kf = jnp.fft.rfft(kern, n=2 * L, axis=0)
    y = jnp.fft.irfft(uf * kf[None], n=2 * L, axis=1)[:, :L]
    return (y + u.astype(jnp.float32) * skip.astype(jnp.float32)).astype(u.dtype)


def _hyena_branch(z, conv_w, conv_b, kern, skip):
    z = _short_conv(z, conv_w, conv_b)
    x0, x1, v = z[..., :HY_WIDTH], z[..., HY_WIDTH:2 * HY_WIDTH], z[..., 2 * HY_WIDTH:]
    v = _fft_long_conv(v * x1, kern, skip)
    return v * x0


def _branch_merge(p, y_attn, y_hy, w_o_attn, w_o_hy, w_out):
    gate = jax.nn.sigmoid(p[..., OFF_G:])
    merged = gate[..., :D_MODEL] * (y_attn @ w_o_attn) + gate[..., D_MODEL:] * (y_hy @ w_o_hy)
    return merged @ w_out


def _peer_route(h, w_q, sub_keys):
    T = h.shape[0]
    q = (h @ w_q).reshape(T, PEER_HEADS, 2, PEER_DKEY // 2)
    s = jnp.einsum('thpd,hpkd->thpk', q, sub_keys).astype(jnp.float32)
    s_top, i_top = lax.top_k(s, PEER_TOPK)
    cand = s_top[:, :, 0, :, None] + s_top[:, :, 1, None, :]
    cand_idx = i_top[:, :, 0, :, None] * PEER_KEYS + i_top[:, :, 1, None, :]
    best, pos = lax.top_k(cand.reshape(T, PEER_HEADS, PEER_TOPK * PEER_TOPK), PEER_TOPK)
    idx = jnp.take_along_axis(cand_idx.reshape(T, PEER_HEADS, PEER_TOPK * PEER_TOPK), pos, axis=-1)
    g = jax.nn.softmax(best, axis=-1)
    return idx.reshape(T, PEER_HEADS * PEER_TOPK), g.reshape(T, PEER_HEADS * PEER_TOPK)


def _peer_ffn(h, w_q, sub_keys, u_tab, v_tab):
    B, L, D = h.shape
    T = B * L
    ht = h.reshape(T, D)
    idx, g = _peer_route(ht, w_q, sub_keys)
    nc = T // PEER_CHUNK

    def chunk(args):
        hc, ic, gc = args
        u = u_tab[ic]
        a = jax.nn.gelu(jnp.einsum('tkd,td->tk', u, hc))
        return jnp.einsum('tk,tkd->td', (gc * a).astype(hc.dtype), v_tab[ic])

    out = lax.map(chunk, (ht.reshape(nc, PEER_CHUNK, D),
                          idx.reshape(nc, PEER_CHUNK, -1),
                          g.reshape(nc, PEER_CHUNK, -1)))
    return out.reshape(B, L, D)


def setup_inputs(seed: int = 0) -> dict:
    key = jax.random.key(seed)
    ks = jax.random.split(key, 28)

    def nrm(k, shape, scale):
        return jax.random.normal(k, shape, jnp.float32) * scale

    Dp = DEPTH
    return {
        'x': nrm(ks[0], (BATCH, SEQ, D_MODEL), 1.0),
        'c': nrm(ks[1], (BATCH, D_MODEL), 1.0),
        'ctx': nrm(ks[2], (BATCH, CTX_LEN, D_MODEL), 1.0),
        'c_ctx': nrm(ks[3], (D_MODEL,), 1.0),
        'w_mod': nrm(ks[4], (Dp, D_MODEL, 6 * D_MODEL), 0.5 * D_MODEL ** -0.5),
        'b_mod': nrm(ks[5], (Dp, 6 * D_MODEL), 0.02),
        'norm1_g': 1.0 + nrm(ks[6], (Dp, D_MODEL), 0.02),
        'w_in': nrm(ks[7], (Dp, D_MODEL, IN_W), D_MODEL ** -0.5),
        'attn_sink': nrm(ks[8], (Dp, N_HEADS), 0.5),
        'hy_conv_w': nrm(ks[9], (Dp, HY_SHORT, HY_IN), HY_SHORT ** -0.5),
        'hy_conv_b': nrm(ks[10], (Dp, HY_IN), 0.02),
        'hy_fw1': nrm(ks[11], (Dp, HY_EMB_DIM, HY_FILTER_HIDDEN), HY_EMB_DIM ** -0.5),
        'hy_fb1': nrm(ks[12], (Dp, HY_FILTER_HIDDEN), 0.1),
        'hy_fw2': nrm(ks[13], (Dp, HY_FILTER_HIDDEN, HY_FILTER_HIDDEN), HY_FILTER_HIDDEN ** -0.5),
        'hy_fb2': nrm(ks[14], (Dp, HY_FILTER_HIDDEN), 0.1),
        'hy_fw3': nrm(ks[15], (Dp, HY_FILTER_HIDDEN, 2 * HY_WIDTH), HY_FILTER_HIDDEN ** -0.5),
        'hy_fb3': nrm(ks[16], (Dp, 2 * HY_WIDTH), 0.02),
        'hy_freq': 1.0 + nrm(ks[17], (Dp, HY_FILTER_HIDDEN), 0.02),
        'hy_skip': nrm(ks[18], (Dp, HY_WIDTH), 0.5),
        'w_o_attn': nrm(ks[19], (Dp, Q_W, D_MODEL), Q_W ** -0.5),
        'w_o_hy': nrm(ks[20], (Dp, HY_WIDTH, D_MODEL), HY_WIDTH ** -0.5),
        'w_out': nrm(ks[21], (Dp, D_MODEL, D_MODEL), D_MODEL ** -0.5),
        'norm2_g': 1.0 + nrm(ks[22], (Dp, D_MODEL), 0.02),
        'peer_wq': nrm(ks[23], (Dp, D_MODEL, PEER_HEADS * PEER_DKEY), D_MODEL ** -0.5),
        'peer_keys': nrm(ks[24], (Dp, PEER_HEADS, 2, PEER_KEYS, PEER_DKEY // 2), (PEER_DKEY // 2) ** -0.5),
        'peer_u': nrm(ks[25], (Dp, PEER_EXPERTS, D_MODEL), D_MODEL ** -0.5),
        'peer_v': nrm(ks[26], (Dp, PEER_EXPERTS, D_MODEL), 0.2),
        'final_g': 1.0 + nrm(ks[27], (D_MODEL,), 0.02),
    }


def reference(x, c, ctx, c_ctx, w_mod, b_mod, norm1_g, w_in, attn_sink, hy_conv_w, hy_conv_b,
              hy_fw1, hy_fb1, hy_fw2, hy_fb2, hy_fw3, hy_fb3, hy_freq, hy_skip,
              w_o_attn, w_o_hy, w_out, norm2_g, peer_wq, peer_keys, peer_u, peer_v, final_g):
    B, L, _ = x.shape
    C = ctx.shape[1]
    rows = L // GRID_W
    row = jnp.repeat(jnp.arange(rows, dtype=jnp.int32), GRID_W)
    col = jnp.tile(jnp.arange(GRID_W, dtype=jnp.int32), rows)
    for li in range(DEPTH):
        last = li == DEPTH - 1
        hy = (hy_fw1[li], hy_fb1[li], hy_fw2[li], hy_fb2[li], hy_fw3[li], hy_fb3[li], hy_freq[li])
        mod = jax.nn.silu(c) @ w_mod[li] + b_mod[li]
        mod_c = jax.nn.silu(c_ctx) @ w_mod[li] + b_mod[li]
        sh1, sc1, g1, sh2, sc2, g2 = jnp.split(mod[:, None, :], 6, axis=-1)
        csh1, csc1, cg1, csh2, csc2, cg2 = jnp.split(mod_c[None, None, :], 6, axis=-1)

        hc = _modulate(_rmsnorm(ctx, norm1_g[li]), csh1, csc1)
        if last:
            pkv = hc @ w_in[li][:, OFF_K:OFF_HY]
            kc = pkv[..., :KV_W].reshape(B, C, N_KV_HEADS, HEAD_DIM)
            vc = pkv[..., KV_W:].reshape(B, C, N_KV_HEADS, HEAD_DIM)
        else:
            pc = hc @ w_in[li]
            qc = pc[..., :OFF_K].reshape(B, C, N_HEADS, HEAD_DIM)
            kc = pc[..., OFF_K:OFF_V].reshape(B, C, N_KV_HEADS, HEAD_DIM)
            vc = pc[..., OFF_V:OFF_HY].reshape(B, C, N_KV_HEADS, HEAD_DIM)
            yc_attn = _context_attention(qc, kc, vc, attn_sink[li])
            yc_hy = _hyena_branch(pc[..., OFF_HY:OFF_G], hy_conv_w[li], hy_conv_b[li],
                                  _hyena_filter(C, *hy), hy_skip[li])
            ctx_mid = ctx + cg1 * _branch_merge(pc, yc_attn, yc_hy, w_o_attn[li], w_o_hy[li], w_out[li])
            hc2 = _modulate(_rmsnorm(ctx_mid, norm2_g[li]), csh2, csc2)
            ctx_next = ctx_mid + cg2 * _peer_ffn(hc2, peer_wq[li], peer_keys[li], peer_u[li], peer_v[li])

        h = _modulate(_rmsnorm(x, norm1_g[li]), sh1, sc1)
        p = h @ w_in[li]
        q = _rope_2d(p[..., :OFF_K].reshape(B, L, N_HEADS, HEAD_DIM), row, col)
        k = _rope_2d(p[..., OFF_K:OFF_V].reshape(B, L, N_KV_HEADS, HEAD_DIM), row, col)
        v = p[..., OFF_V:OFF_HY].reshape(B, L, N_KV_HEADS, HEAD_DIM)
        y_attn = _window_attention(q, k, v, kc, vc, attn_sink[li])
        y_hy = _hyena_branch(p[..., OFF_HY:OFF_G], hy_conv_w[li], hy_conv_b[li],
                             _hyena_filter(L, *hy), hy_skip[li])
        x = x + g1 * _branch_merge(p, y_attn, y_hy, w_o_attn[li], w_o_hy[li], w_out[li])
        h2 = _modulate(_rmsnorm(x, norm2_g[li]), sh2, sc2)
        x = x + g2 * _peer_ffn(h2, peer_wq[li], peer_keys[li], peer_u[li], peer_v[li])
        if not last:
            ctx = ctx_next
    return _rmsnorm(x, final_g)
```

```cpp
#include <hip/hip_runtime.h>
#include <hip/hip_bf16.h>
#include <hip/hip_cooperative_groups.h>
#include <cstdio>
namespace cg = cooperative_groups;

typedef unsigned short u16;
typedef __attribute__((ext_vector_type(8))) short bf16x8;
typedef __attribute__((ext_vector_type(4))) float f32x4;
typedef __attribute__((ext_vector_type(4))) unsigned u32x4;

#define DEV __device__ __forceinline__
#ifndef PH
#define PH -1
#endif
#define PHON(n) (PH < 0 || PH == (n))

constexpr int T_TOK = 16384;
constexpr int DM = 1024;
constexpr int SEQL = 4096;
constexpr int INW = 4352;

struct Params {
  const float *x, *c, *ctx, *c_ctx, *w_mod, *b_mod, *norm1_g, *w_in, *attn_sink, *hy_conv_w, *hy_conv_b,
      *hy_fw1, *hy_fb1, *hy_fw2, *hy_fb2, *hy_fw3, *hy_fb3, *hy_freq, *hy_skip, *w_o_attn, *w_o_hy, *w_out,
      *norm2_g, *peer_wq, *peer_keys, *peer_u, *peer_v, *final_g;
  float* out;
  char* ws;
};

constexpr size_t MB = 1u << 20;
constexpr size_t OFF_MOD = 0;
constexpr size_t OFF_ROPE = 128 * 1024;
constexpr size_t OFF_NINV = OFF_ROPE + 8192;
constexpr size_t OFF_H2F = 256 * 1024;
constexpr size_t OFF_WIN = OFF_H2F + MB;
constexpr size_t OFF_WOA = OFF_WIN + 9 * MB;
constexpr size_t OFF_WOH = OFF_WOA + MB;
constexpr size_t OFF_WOUT = OFF_WOH + MB;
constexpr size_t OFF_WQ = OFF_WOUT + 2 * MB;
constexpr size_t OFF_KEYS = OFF_WQ + 2 * MB;
constexpr size_t OFF_UBF = OFF_KEYS + MB;
constexpr size_t OFF_VBF = OFF_UBF + 32 * MB;
constexpr size_t OFF_Q = OFF_VBF + 32 * MB;
constexpr size_t OFF_K = OFF_Q + 16 * MB;
constexpr size_t OFF_VT = OFF_K + 4 * MB;
constexpr size_t OFF_KC = OFF_VT + 4 * MB;
constexpr size_t OFF_VCT = OFF_KC + MB / 2;
constexpr size_t OFF_Z = OFF_VCT + MB / 2;
constexpr size_t OFF_GATE = OFF_Z + 48 * MB;
constexpr size_t OFF_YATT = OFF_GATE + 64 * MB;
constexpr size_t OFF_YHY = OFF_YATT + 16 * MB;
constexpr size_t OFF_RIDX = OFF_Q;
constexpr size_t OFF_RW = OFF_Q + 8 * MB;
constexpr size_t OFF_MERGED = OFF_Z;
constexpr size_t OFF_H2 = OFF_GATE;
constexpr size_t OFF_QP = OFF_GATE + 32 * MB;
constexpr size_t OO_H1 = 0;
constexpr size_t OO_UT = 0;
constexpr size_t OO_X0T = 16 * MB;
constexpr size_t OO_HC = 32 * MB;
constexpr size_t OO_G = 34 * MB;

constexpr int SMEM_BYTES = 70144;

DEV u16 f2bf(float f) {
  unsigned u = __float_as_uint(f);
  u += 0x7fffu + ((u >> 16) & 1u);
  return (u16)(u >> 16);
}
DEV float bf2f(u16 h) { return __uint_as_float(((unsigned)h) << 16); }
DEV unsigned pack2(float a, float b) { return (unsigned)f2bf(a) | ((unsigned)f2bf(b) << 16); }
DEV float bflo(unsigned w) { return __uint_as_float(w << 16); }
DEV float bfhi(unsigned w) { return __uint_as_float(w & 0xffff0000u); }
DEV float wave_sum(float v) {
#pragma unroll
  for (int o = 32; o > 0; o >>= 1) v += __shfl_xor(v, o);
  return v;
}
DEV float wave_max(float v) {
#pragma unroll
  for (int o = 32; o > 0; o >>= 1) v = fmaxf(v, __shfl_xor(v, o));
  return v;
}

DEV void p0_mod(const Params& p, int item, float* sm) {
  const int tid = threadIdx.x;
  for (int i = tid; i < 5 * 1024; i += 256) {
    int r = i >> 10, k = i & 1023;
    float c = (r < 4) ? p.c[r * 1024 + k] : p.c_ctx[k];
    sm[i] = c / (1.f + expf(-c));
  }
  __syncthreads();
  const int col = item * 64 + (tid & 63), kg = tid >> 6;
  float a0 = 0, a1 = 0, a2 = 0, a3 = 0, a4 = 0;
  for (int k = kg * 256; k < kg * 256 + 256; ++k) {
    float w = p.w_mod[(size_t)k * 6144 + col];
    a0 += sm[k] * w; a1 += sm[1024 + k] * w; a2 += sm[2048 + k] * w; a3 += sm[3072 + k] * w; a4 += sm[4096 + k] * w;
  }
  float* red = sm + 5 * 1024;
  red[(kg * 5 + 0) * 64 + (tid & 63)] = a0;
  red[(kg * 5 + 1) * 64 + (tid & 63)] = a1;
  red[(kg * 5 + 2) * 64 + (tid & 63)] = a2;
  red[(kg * 5 + 3) * 64 + (tid & 63)] = a3;
  red[(kg * 5 + 4) * 64 + (tid & 63)] = a4;
  __syncthreads();
  float* mod = (float*)(p.ws + OFF_MOD);
  for (int i = tid; i < 320; i += 256) {
    int r = i >> 6, cc = i & 63;
    float s = red[(0 * 5 + r) * 64 + cc] + red[(1 * 5 + r) * 64 + cc] + red[(2 * 5 + r) * 64 + cc] + red[(3 * 5 + r) * 64 + cc];
    mod[r * 6144 + item * 64 + cc] = s + p.b_mod[item * 64 + cc];
  }
  __syncthreads();
}

DEV void transpose_tile(const float* __restrict__ src, int N, int K, u16* __restrict__ dst, int tile, float* sm) {
  const int tid = threadIdx.x;
  const int nkt = K >> 6;
  const int kt = tile % nkt, nt = tile / nkt;
  const int k0 = kt * 64, n0 = nt * 64;
  const int c = tid & 63, r = tid >> 6;
#pragma unroll
  for (int rr = 0; rr < 16; ++rr) sm[(rr * 4 + r) * 65 + c] = src[(size_t)(k0 + rr * 4 + r) * N + n0 + c];
  __syncthreads();
  const int nn = tid >> 2, part = tid & 3;
  unsigned w[8];
#pragma unroll
  for (int j = 0; j < 8; ++j) w[j] = pack2(sm[(part * 16 + 2 * j) * 65 + nn], sm[(part * 16 + 2 * j + 1) * 65 + nn]);
  uint4* d = (uint4*)(dst + (size_t)(n0 + nn) * K + k0 + part * 16);
  d[0] = make_uint4(w[0], w[1], w[2], w[3]);
  d[1] = make_uint4(w[4], w[5], w[6], w[7]);
  __syncthreads();
}

DEV void p0_hidden(const Params& p, int item, float* sm) {
  const int tid = threadIdx.x;
  float* z = sm;
  float* h1 = sm + 4 * 36;
  if (tid < 4 * 33) {
    int tt = tid / 33, i = tid % 33;
    int t = item * 4 + tt;
    float v;
    if (i == 0) v = (float)t * (1.f / 4096.f);
    else {
      int band = (i <= 16) ? i : (i - 16);
      float fr = (float)((t * band) & 4095) * (1.f / 4096.f);
      v = (i <= 16) ? cospif(2.f * fr) : sinpif(2.f * fr);
    }
    z[tt * 36 + i] = v;
  }
  __syncthreads();
  const int tt = tid >> 6, j = tid & 63;
  float a = p.hy_fb1[j];
  for (int i = 0; i < 33; ++i) a += z[tt * 36 + i] * p.hy_fw1[i * 64 + j];
  const float fq = p.hy_freq[j];
  h1[tt * 64 + j] = sinf(fq * a);
  __syncthreads();
  float b = p.hy_fb2[j];
  for (int i = 0; i < 64; ++i) b += h1[tt * 64 + i] * p.hy_fw2[i * 64 + j];
  ((float*)(p.ws + OFF_H2F))[(item * 4 + tt) * 64 + j] = sinf(fq * b);
  __syncthreads();
}

DEV void convert_flat(const float* __restrict__ src, u16* __restrict__ dst, size_t n) {
  size_t stride = (size_t)gridDim.x * 256 * 8;
  for (size_t i = ((size_t)blockIdx.x * 256 + threadIdx.x) * 8; i < n; i += stride) {
    float4 a = *(const float4*)(src + i);
    float4 b = *(const float4*)(src + i + 4);
    *(uint4*)(dst + i) = make_uint4(pack2(a.x, a.y), pack2(a.z, a.w), pack2(b.x, b.y), pack2(b.z, b.w));
  }
}

DEV void norm_row(const float* __restrict__ xr, const float* __restrict__ g, const float* __restrict__ sh,
                  const float* __restrict__ sc, u16* __restrict__ dst, int lane) {
  float4 v[4];
  float ss = 0.f;
#pragma unroll
  for (int i = 0; i < 4; ++i) {
    v[i] = ((const float4*)xr)[lane + 64 * i];
    ss += v[i].x * v[i].x + v[i].y * v[i].y + v[i].z * v[i].z + v[i].w * v[i].w;
  }
  ss = wave_sum(ss);
  const float r = rsqrtf(ss * (1.f / 1024.f) + 1e-6f);
#pragma unroll
  for (int i = 0; i < 4; ++i) {
    const int idx = lane + 64 * i;
    float4 gg = ((const float4*)g)[idx], s1 = ((const float4*)sh)[idx], s2 = ((const float4*)sc)[idx];
    float y0 = v[i].x * r * gg.x * (1.f + s2.x) + s1.x;
    float y1 = v[i].y * r * gg.y * (1.f + s2.y) + s1.y;
    float y2 = v[i].z * r * gg.z * (1.f + s2.z) + s1.z;
    float y3 = v[i].w * r * gg.w * (1.f + s2.w) + s1.w;
    *(uint2*)(dst + idx * 4) = make_uint2(pack2(y0, y1), pack2(y2, y3));
  }
}

DEV void p1_filter(const Params& p, int item, float* sm) {
  const int tid = threadIdx.x;
  float* wc = sm;
  float* fb = sm + 512;
  float* dl = sm + 520;
  float* red = sm + 528;
  const int c0 = item * 4;
  for (int i = tid; i < 512; i += 256) {
    int j = i >> 6, k = i & 63;
    int col = (j < 4) ? (c0 + j) : (512 + c0 + j - 4);
    wc[j * 64 + k] = p.hy_fw3[k * 1024 + col];
  }
  if (tid < 8) fb[tid] = p.hy_fb3[(tid < 4) ? (c0 + tid) : (512 + c0 + tid - 4)];
  if (tid < 4) {
    const float a = logf(1e-2f) / 1.5f, b = logf(1e-2f) / 0.3f;
    float d = a + (b - a) * (float)(c0 + tid) / 511.f;
    dl[tid] = fabsf(d);
  }
  __syncthreads();
  u16* G = (u16*)((char*)p.out + OO_G);
  const float* H = (const float*)(p.ws + OFF_H2F);
  float as0 = 0, as1 = 0, as2 = 0, as3 = 0;
  for (int t = tid; t < 4096; t += 256) {
    const float4* hp = (const float4*)(H + t * 64);
    float d[8];
#pragma unroll
    for (int j = 0; j < 8; ++j) d[j] = fb[j];
#pragma unroll 1
    for (int q = 0; q < 16; ++q) {
      float4 hv = hp[q];
#pragma unroll
      for (int j = 0; j < 8; ++j)
        d[j] += hv.x * wc[j * 64 + 4 * q] + hv.y * wc[j * 64 + 4 * q + 1] + hv.z * wc[j * 64 + 4 * q + 2] + hv.w * wc[j * 64 + 4 * q + 3];
    }
    const float tn = (float)t * (1.f / 4096.f);
    float asum[4];
#pragma unroll
    for (int j = 0; j < 4; ++j) {
      float dec = expf(-tn * dl[j]);
      float f = d[j] * dec, bw = d[4 + j] * dec;
      u16* Gc = G + (size_t)(c0 + j) * 8192;
      Gc[4095 - t] = f2bf(f);
      float s = fabsf(f);
      if (t < 4095) { Gc[4096 + t] = f2bf(bw); s += fabsf(bw); }
      else Gc[8191] = 0;
      asum[j] = s;
    }
    as0 += asum[0]; as1 += asum[1]; as2 += asum[2]; as3 += asum[3];
  }
  as0 = wave_sum(as0); as1 = wave_sum(as1); as2 = wave_sum(as2); as3 = wave_sum(as3);
  if ((tid & 63) == 0) {
    int w = tid >> 6;
    red[w * 4 + 0] = as0; red[w * 4 + 1] = as1; red[w * 4 + 2] = as2; red[w * 4 + 3] = as3;
  }
  __syncthreads();
  if (tid < 4) {
    float s = red[tid] + red[4 + tid] + red[8 + tid] + red[12 + tid];
    ((float*)(p.ws + OFF_NINV))[c0 + tid] = 1.f / s;
  }
  __syncthreads();
}

struct Acc { f32x4 v[4][4]; };

DEV void acc_zero(Acc& a) {
#pragma unroll
  for (int i = 0; i < 4; ++i)
#pragma unroll
    for (int j = 0; j < 4; ++j) a.v[i][j] = (f32x4){0.f, 0.f, 0.f, 0.f};
}

DEV void gemm_kloop(const u16* __restrict__ A, int lda, const u16* __restrict__ Bt, int ldb, int K, int m0, int n0,
                    u16* sA, u16* sB, Acc& acc) {
  const int tid = threadIdx.x, lane = tid & 63, wave = tid >> 6, wm = wave >> 1, wn = wave & 1;
  const int l15 = lane & 15, quad = lane >> 4;
  const int srow = tid >> 3, sch = tid & 7;
  const u16* ga = A + (size_t)(m0 + srow) * lda + sch * 8;
  const u16* gb = Bt + (size_t)(n0 + srow) * ldb + sch * 8;
  u32x4 ra[4], rb[4];
#pragma unroll
  for (int i = 0; i < 4; ++i) {
    ra[i] = *(const u32x4*)(ga + (size_t)i * 32 * lda);
    rb[i] = *(const u32x4*)(gb + (size_t)i * 32 * ldb);
  }
  const int nk = K >> 6;
  for (int kt = 0; kt < nk; ++kt) {
#pragma unroll
    for (int i = 0; i < 4; ++i) {
      *(u32x4*)(sA + (srow + i * 32) * 72 + sch * 8) = ra[i];
      *(u32x4*)(sB + (srow + i * 32) * 72 + sch * 8) = rb[i];
    }
    __syncthreads();
    if (kt + 1 < nk) {
#pragma unroll
      for (int i = 0; i < 4; ++i) {
        ra[i] = *(const u32x4*)(ga + (size_t)i * 32 * lda + (kt + 1) * 64);
        rb[i] = *(const u32x4*)(gb + (size_t)i * 32 * ldb + (kt + 1) * 64);
      }
    }
#pragma unroll
    for (int ks = 0; ks < 2; ++ks) {
      bf16x8 af[4], bfr[4];
#pragma unroll
      for (int i = 0; i < 4; ++i) af[i] = *(const bf16x8*)(sB + (wn * 64 + i * 16 + l15) * 72 + ks * 32 + quad * 8);
#pragma unroll
      for (int j = 0; j < 4; ++j) bfr[j] = *(const bf16x8*)(sA + (wm * 64 + j * 16 + l15) * 72 + ks * 32 + quad * 8);
#pragma unroll
      for (int i = 0; i < 4; ++i)
#pragma unroll
        for (int j = 0; j < 4; ++j) acc.v[i][j] = __builtin_amdgcn_mfma_f32_16x16x32_bf16(af[i], bfr[j], acc.v[i][j], 0, 0, 0);
    }
    __syncthreads();
  }
}

DEV void p2_inproj(const Params& p, int tile, u16* sA, u16* sB) {
  const int mt = tile / 34, nt = tile % 34;
  const int m0 = mt * 128, n0 = nt * 128;
  Acc acc; acc_zero(acc);
  gemm_kloop((const u16*)((const char*)p.out + OO_H1), 1024, (const u16*)(p.ws + OFF_WIN), 1024, 1024, m0, n0, sA, sB, acc);
  const int tid = threadIdx.x, lane = tid & 63, wave = tid >> 6, wm = wave >> 1, wn = wave & 1;
  const int l15 = lane & 15, quad = lane >> 4;
  const int mb = m0 + wm * 64, nb = n0 + wn * 64;
  if (nb < 640) {
    const float2* rope = (const float2*)(p.ws + OFF_ROPE);
    const bool isq = nb < 512;
    const float qs = isq ? 0.125f : 1.f;
#pragma unroll
    for (int j = 0; j < 4; ++j) {
      const int m = mb + j * 16 + l15;
      const int b = m >> 12, l = m & 4095;
      const int prow = l >> 6, pcol = l & 63;
      u16* dst;
      if (isq) dst = (u16*)(p.ws + OFF_Q) + ((size_t)(b * 8 + (nb >> 6)) * 4096 + l) * 64;
      else dst = (u16*)(p.ws + OFF_K) + ((size_t)(b * 2 + ((nb - 512) >> 6)) * 4096 + l) * 64;
#pragma unroll
      for (int hh = 0; hh < 2; ++hh) {
        const int pos = hh ? pcol : prow;
        f32x4 x1 = acc.v[hh * 2][j], x2 = acc.v[hh * 2 + 1][j];
        float o1[4], o2[4];
#pragma unroll
        for (int r = 0; r < 4; ++r) {
          float2 cs = rope[pos * 16 + quad * 4 + r];
          o1[r] = (x1[r] * cs.x - x2[r] * cs.y) * qs;
          o2[r] = (x2[r] * cs.x + x1[r] * cs.y) * qs;
        }
        *(uint2*)(dst + hh * 32 + quad * 4) = make_uint2(pack2(o1[0], o1[1]), pack2(o1[2], o1[3]));
        *(uint2*)(dst + hh * 32 + 16 + quad * 4) = make_uint2(pack2(o2[0], o2[1]), pack2(o2[2], o2[3]));
      }
    }
  } else if (nb < 768) {
    const int g = (nb - 640) >> 6;
    u16* vt = (u16*)(p.ws + OFF_VT);
#pragma unroll
    for (int j = 0; j < 4; ++j) {
      const int m = mb + j * 16 + l15;
      const int b = m >> 12, l = m & 4095;
#pragma unroll
      for (int i = 0; i < 4; ++i)
#pragma unroll
        for (int r = 0; r < 4; ++r) {
          const int d = i * 16 + quad * 4 + r;
          vt[((size_t)(b * 2 + g) * 64 + d) * 4096 + l] = f2bf(acc.v[i][j][r]);
        }
    }
  } else if (nb < 2304) {
    u16* z = (u16*)(p.ws + OFF_Z);
#pragma unroll
    for (int j = 0; j < 4; ++j) {
      const int m = mb + j * 16 + l15;
#pragma unroll
      for (int i = 0; i < 4; ++i) {
        const int n = nb - 768 + i * 16 + quad * 4;
        f32x4 a = acc.v[i][j];
        *(uint2*)(z + (size_t)m * 1536 + n) = make_uint2(pack2(a[0], a[1]), pack2(a[2], a[3]));
      }
    }
  } else {
    u16* gt = (u16*)(p.ws + OFF_GATE);
#pragma unroll
    for (int j = 0; j < 4; ++j) {
      const int m = mb + j * 16 + l15;
#pragma unroll
      for (int i = 0; i < 4; ++i) {
        const int n = nb - 2304 + i * 16 + quad * 4;
        f32x4 a = acc.v[i][j];
        float s0 = 1.f / (1.f + __expf(-a[0])), s1 = 1.f / (1.f + __expf(-a[1]));
        float s2 = 1.f / (1.f + __expf(-a[2])), s3 = 1.f / (1.f + __expf(-a[3]));
        *(uint2*)(gt + (size_t)m * 2048 + n) = make_uint2(pack2(s0, s1), pack2(s2, s3));
      }
    }
  }
}

DEV void p2_ctxkv(const Params& p, int tile, u16* sA, u16* sB) {
  const int mt = tile >> 1, nt = tile & 1;
  const int m0 = mt * 128, n0 = nt * 128;
  Acc acc; acc_zero(acc);
  gemm_kloop((const u16*)((const char*)p.out + OO_HC), 1024, (const u16*)(p.ws + OFF_WIN) + (size_t)512 * 1024, 1024, 1024, m0, n0, sA, sB, acc);
  const int tid = threadIdx.x, lane = tid & 63, wave = tid >> 6, wm = wave >> 1, wn = wave & 1;
  const int l15 = lane & 15, quad = lane >> 4;
  const int mb = m0 + wm * 64, nb = n0 + wn * 64;
  const int g = (nb >> 6) & 1;
  if (nb < 128) {
    u16* kc = (u16*)(p.ws + OFF_KC);
#pragma unroll
    for (int j = 0; j < 4; ++j) {
      const int m = mb + j * 16 + l15;
      const int b = m >> 8, c = m & 255;
#pragma unroll
      for (int i = 0; i < 4; ++i) {
        f32x4 a = acc.v[i][j];
        *(uint2*)(kc + ((size_t)(b * 2 + g) * 256 + c) * 64 + i * 16 + quad * 4) = make_uint2(pack2(a[0], a[1]), pack2(a[2], a[3]));
      }
    }
  } else {
    u16* vct = (u16*)(p.ws + OFF_VCT);
#pragma unroll
    for (int j = 0; j < 4; ++j) {
      const int m = mb + j * 16 + l15;
      const int b = m >> 8, c = m & 255;
#pragma unroll
      for (int i = 0; i < 4; ++i)
#pragma unroll
        for (int r = 0; r < 4; ++r) {
          const int d = i * 16 + quad * 4 + r;
          vct[((size_t)(b * 2 + g) * 64 + d) * 256 + c] = f2bf(acc.v[i][j][r]);
        }
    }
  }
}

DEV void p3_attn(const Params& p, int item, u16* sK, u16* sVt) {
  const int tid = threadIdx.x, lane = tid & 63, wave = tid >> 6, l15 = lane & 15, quad = lane >> 4;
  const int n = item & 31, h = (item >> 5) & 7, b = item >> 8;
  const int g = h >> 2;
  const u16* Q = (const u16*)(p.ws + OFF_Q) + ((size_t)(b * 8 + h) * 4096 + n * 128 + wave * 32) * 64;
  bf16x8 bq[2][2];
#pragma unroll
  for (int qt = 0; qt < 2; ++qt)
#pragma unroll
    for (int ks = 0; ks < 2; ++ks) bq[qt][ks] = *(const bf16x8*)(Q + (qt * 16 + l15) * 64 + ks * 32 + quad * 8);
  const float sink = p.attn_sink[h];
  float mrun[2] = {sink, sink};
  float lrun[2];
  lrun[0] = lrun[1] = (quad == 0) ? 1.f : 0.f;
  f32x4 O[4][2];
#pragma unroll
  for (int dt = 0; dt < 4; ++dt)
#pragma unroll
    for (int qt = 0; qt < 2; ++qt) O[dt][qt] = (f32x4){0.f, 0.f, 0.f, 0.f};

  for (int kb = 0; kb < 5; ++kb) {
    const u16* Ksrc;
    const u16* Vsrc;
    int vstride;
    if (kb < 3) {
      const int nbk = n + kb - 1;
      if (nbk < 0 || nbk >= 32) continue;
      Ksrc = (const u16*)(p.ws + OFF_K) + ((size_t)(b * 2 + g) * 4096 + nbk * 128) * 64;
      Vsrc = (const u16*)(p.ws + OFF_VT) + (size_t)(b * 2 + g) * 64 * 4096 + nbk * 128;
      vstride = 4096;
    } else {
      const int cb = kb - 3;
      Ksrc = (const u16*)(p.ws + OFF_KC) + ((size_t)(b * 2 + g) * 256 + cb * 128) * 64;
      Vsrc = (const u16*)(p.ws + OFF_VCT) + (size_t)(b * 2 + g) * 64 * 256 + cb * 128;
      vstride = 256;
    }
#pragma unroll
    for (int i = 0; i < 4; ++i) {
      const int id = tid + i * 256;
      const int kr = id >> 3, kc8 = id & 7;
      *(uint4*)(sK + kr * 72 + kc8 * 8) = *(const uint4*)(Ksrc + kr * 64 + kc8 * 8);
      const int vr = id >> 4, vc = id & 15;
      *(uint4*)(sVt + vr * 136 + vc * 8) = *(const uint4*)(Vsrc + (size_t)vr * vstride + vc * 8);
    }
    __syncthreads();
#pragma unroll 1
    for (int c4 = 0; c4 < 4; ++c4) {
      f32x4 s[2][2];
#pragma unroll
      for (int kt = 0; kt < 2; ++kt) {
        bf16x8 ak0 = *(const bf16x8*)(sK + (c4 * 32 + kt * 16 + l15) * 72 + quad * 8);
        bf16x8 ak1 = *(const bf16x8*)(sK + (c4 * 32 + kt * 16 + l15) * 72 + 32 + quad * 8);
#pragma unroll
        for (int qt = 0; qt < 2; ++qt) {
          f32x4 z = (f32x4){0.f, 0.f, 0.f, 0.f};
          z = __builtin_amdgcn_mfma_f32_16x16x32_bf16(ak0, bq[qt][0], z, 0, 0, 0);
          z = __builtin_amdgcn_mfma_f32_16x16x32_bf16(ak1, bq[qt][1], z, 0, 0, 0);
          s[kt][qt] = z;
        }
      }
      if (kb == 0 || kb == 2) {
#pragma unroll
        for (int kt = 0; kt < 2; ++kt)
#pragma unroll
          for (int qt = 0; qt < 2; ++qt)
#pragma unroll
            for (int r = 0; r < 4; ++r) {
              const int kk = c4 * 32 + kt * 16 + quad * 4 + r;
              const int qq = wave * 32 + qt * 16 + l15;
              const bool valid = (kb == 0) ? (kk >= qq) : (kk <= qq);
              if (!valid) s[kt][qt][r] = -INFINITY;
            }
      }
      bf16x8 bp[2];
#pragma unroll
      for (int qt = 0; qt < 2; ++qt) {
        float cm = fmaxf(fmaxf(fmaxf(s[0][qt][0], s[0][qt][1]), fmaxf(s[0][qt][2], s[0][qt][3])),
                         fmaxf(fmaxf(s[1][qt][0], s[1][qt][1]), fmaxf(s[1][qt][2], s[1][qt][3])));
        cm = fmaxf(cm, __shfl_xor(cm, 16));
        cm = fmaxf(cm, __shfl_xor(cm, 32));
        const float mnew = fmaxf(mrun[qt], cm);
        const float alpha = __expf(mrun[qt] - mnew);
        mrun[qt] = mnew;
        float ps = 0.f;
        float pv[8];
#pragma unroll
        for (int r = 0; r < 4; ++r) {
          pv[r] = __expf(s[0][qt][r] - mnew);
          pv[4 + r] = __expf(s[1][qt][r] - mnew);
          ps += pv[r] + pv[4 + r];
        }
        lrun[qt] = lrun[qt] * alpha + ps;
#pragma unroll
        for (int dt = 0; dt < 4; ++dt) {
          O[dt][qt][0] *= alpha; O[dt][qt][1] *= alpha; O[dt][qt][2] *= alpha; O[dt][qt][3] *= alpha;
        }
        union { bf16x8 v; unsigned u[4]; } pk;
        pk.u[0] = pack2(pv[0], pv[1]); pk.u[1] = pack2(pv[2], pv[3]);
        pk.u[2] = pack2(pv[4], pv[5]); pk.u[3] = pack2(pv[6], pv[7]);
        bp[qt] = pk.v;
      }
#pragma unroll
      for (int dt = 0; dt < 4; ++dt) {
        union { bf16x8 v; uint2 h[2]; } av;
        const u16* vrow = sVt + (dt * 16 + l15) * 136 + c4 * 32 + quad * 4;
        av.h[0] = *(const uint2*)(vrow);
        av.h[1] = *(const uint2*)(vrow + 16);
#pragma unroll
        for (int qt = 0; qt < 2; ++qt) O[dt][qt] = __builtin_amdgcn_mfma_f32_16x16x32_bf16(av.v, bp[qt], O[dt][qt], 0, 0, 0);
      }
    }
    __syncthreads();
  }
  u16* Y = (u16*)(p.ws + OFF_YATT);
#pragma unroll
  for (int qt = 0; qt < 2; ++qt) {
    float l = lrun[qt];
    l += __shfl_xor(l, 16);
    l += __shfl_xor(l, 32);
    const float inv = 1.f / l;
    const int t = b * 4096 + n * 128 + wave * 32 + qt * 16 + l15;
#pragma unroll
    for (int dt = 0; dt < 4; ++dt) {
      f32x4 o = O[dt][qt];
      *(uint2*)(Y + (size_t)t * 512 + h * 64 + dt * 16 + quad * 4) = make_uint2(pack2(o[0] * inv, o[1] * inv), pack2(o[2] * inv, o[3] * inv));
    }
  }
}

DEV void p3_hypre(const Params& p, int item, u16* sm) {
  const int tid = threadIdx.x;
  const int cb = item & 7, tb = (item >> 3) & 63, b = item >> 9;
  const int tq = tid >> 6, ch = tid & 63;
  const int c = cb * 64 + ch;
  u16* su = sm;
  u16* sx = sm + 64 * 66;
  float w[3][3], bias[3];
#pragma unroll
  for (int s = 0; s < 3; ++s) {
#pragma unroll
    for (int k = 0; k < 3; ++k) w[s][k] = p.hy_conv_w[k * 1536 + s * 512 + c];
    bias[s] = p.hy_conv_b[s * 512 + c];
  }
  const u16* Z = (const u16*)(p.ws + OFF_Z) + (size_t)b * 4096 * 1536;
  const int l0 = tb * 64 + tq * 16;
  float prev[3], cur[3], nxt[3];
#pragma unroll
  for (int s = 0; s < 3; ++s) {
    prev[s] = (l0 > 0) ? bf2f(Z[(size_t)(l0 - 1) * 1536 + s * 512 + c]) : 0.f;
    cur[s] = bf2f(Z[(size_t)l0 * 1536 + s * 512 + c]);
  }
  for (int i = 0; i < 16; ++i) {
    const int l = l0 + i;
#pragma unroll
    for (int s = 0; s < 3; ++s) nxt[s] = (l + 1 < 4096) ? bf2f(Z[(size_t)(l + 1) * 1536 + s * 512 + c]) : 0.f;
    float cv[3];
#pragma unroll
    for (int s = 0; s < 3; ++s) cv[s] = prev[s] * w[s][0] + cur[s] * w[s][1] + nxt[s] * w[s][2] + bias[s];
    su[ch * 66 + tq * 16 + i] = f2bf(cv[2] * cv[1]);
    sx[ch * 66 + tq * 16 + i] = f2bf(cv[0]);
#pragma unroll
    for (int s = 0; s < 3; ++s) { prev[s] = cur[s]; cur[s] = nxt[s]; }
  }
  __syncthreads();
  const int chr = tid >> 2, part = tid & 3;
  const int cc = cb * 64 + chr;
  const unsigned* ru = (const unsigned*)(su + chr * 66 + part * 16);
  const unsigned* rx = (const unsigned*)(sx + chr * 66 + part * 16);
  u16* UT = (u16*)((char*)p.out + OO_UT) + ((size_t)(cc * 4 + b) * 4096 + tb * 64 + part * 16);
  u16* XT = (u16*)((char*)p.out + OO_X0T) + ((size_t)(cc * 4 + b) * 4096 + tb * 64 + part * 16);
  ((uint4*)UT)[0] = make_uint4(ru[0], ru[1], ru[2], ru[3]);
  ((uint4*)UT)[1] = make_uint4(ru[4], ru[5], ru[6], ru[7]);
  ((uint4*)XT)[0] = make_uint4(rx[0], rx[1], rx[2], rx[3]);
  ((uint4*)XT)[1] = make_uint4(rx[4], rx[5], rx[6], rx[7]);
  __syncthreads();
}

DEV void p3_toeplitz(const Params& p, int c, char* smem) {
  const int tid = threadIdx.x, lane = tid & 63, wave = tid >> 6, l15 = lane & 15, quad = lane >> 4;
  u16* sG0 = (u16*)smem;
  u16* sG1 = (u16*)(smem + 16384 + 64);
  u16* sU = (u16*)(smem + 32768 + 128);
  u16* sZ = sU + 4 * 64 * 72;
  const u16* G = (const u16*)((const char*)p.out + OO_G) + (size_t)c * 8192;
  const u16* UT = (const u16*)((const char*)p.out + OO_UT) + (size_t)c * 16384;
#pragma unroll
  for (int i = 0; i < 4; ++i) {
    const int id = tid + i * 256;
    *(uint4*)(sG0 + id * 8) = *(const uint4*)(G + id * 8);
  }
#pragma unroll
  for (int i = 0; i < 8; ++i) {
    const int id = tid + i * 256;
    const int bb = id >> 9, blk = (id >> 3) & 63, c8 = id & 7;
    *(uint4*)(sU + (bb * 64 + blk) * 72 + c8 * 8) = *(const uint4*)(UT + id * 8);
  }
  if (tid < 72) sZ[tid] = 0;
  __syncthreads();
  for (int i = tid; i < 8192; i += 256) sG1[i] = (i < 8191) ? sG0[i + 1] : (u16)0;
  __syncthreads();

  Acc acc; acc_zero(acc);
  const u16* gbase = (l15 & 1) ? sG0 : (sG1 - 1);
  const u16* ubase = sU + wave * 64 * 72 + quad * 8;
  const u16* zbase = sZ + quad * 8;
  for (int d = -63; d <= 63; ++d) {
    const int base = 4095 - 64 * d - l15 + quad * 8;
    bf16x8 af[4][2];
#pragma unroll
    for (int mt = 0; mt < 4; ++mt)
#pragma unroll
      for (int ks = 0; ks < 2; ++ks) {
        const unsigned* gp = (const unsigned*)(gbase + base - mt * 16 + ks * 32);
        union { bf16x8 v; unsigned u[4]; } t;
        t.u[0] = gp[0]; t.u[1] = gp[1]; t.u[2] = gp[2]; t.u[3] = gp[3];
        af[mt][ks] = t.v;
      }
#pragma unroll
    for (int nt = 0; nt < 4; ++nt) {
      if (nt * 16 + 15 - d < 0 || nt * 16 - d > 63) continue;
      const int ip = nt * 16 + l15 - d;
      const u16* up = (ip >= 0 && ip < 64) ? (ubase + ip * 72) : zbase;
      bf16x8 b0 = *(const bf16x8*)(up);
      bf16x8 b1 = *(const bf16x8*)(up + 32);
#pragma unroll
      for (int mt = 0; mt < 4; ++mt) {
        acc.v[mt][nt] = __builtin_amdgcn_mfma_f32_16x16x32_bf16(af[mt][0], b0, acc.v[mt][nt], 0, 0, 0);
        acc.v[mt][nt] = __builtin_amdgcn_mfma_f32_16x16x32_bf16(af[mt][1], b1, acc.v[mt][nt], 0, 0, 0);
      }
    }
  }
  const float ninv = ((const float*)(p.ws + OFF_NINV))[c];
  const float skip = p.hy_skip[c];
  const u16* XT = (const u16*)((const char*)p.out + OO_X0T) + ((size_t)(c * 4 + wave) * 4096);
  u16* Y = (u16*)(p.ws + OFF_YHY);
#pragma unroll
  for (int nt = 0; nt < 4; ++nt) {
    const int ib = nt * 16 + l15;
#pragma unroll
    for (int mt = 0; mt < 4; ++mt) {
      const int r0 = mt * 16 + quad * 4;
      const int t = ib * 64 + r0;
      uint2 uu = *(const uint2*)(sU + (wave * 64 + ib) * 72 + r0);
      uint2 xx = *(const uint2*)(XT + t);
      float uv[4] = {bflo(uu.x), bfhi(uu.x), bflo(uu.y), bfhi(uu.y)};
      float xv[4] = {bflo(xx.x), bfhi(xx.x), bflo(xx.y), bfhi(xx.y)};
#pragma unroll
      for (int r = 0; r < 4; ++r) {
        float y = acc.v[mt][nt][r] * ninv + uv[r] * skip;
        Y[(size_t)(wave * 4096 + t + r) * 512 + c] = f2bf(y * xv[r]);
      }
    }
  }
  __syncthreads();
}

DEV void p4_merge(const Params& p, int tile, u16* sA, u16* sB) {
  const int mt = tile >> 3, nt = tile & 7;
  const int m0 = mt * 128, n0 = nt * 128;
  const int tid = threadIdx.x, lane = tid & 63, wave = tid >> 6, wm = wave >> 1, wn = wave & 1;
  const int l15 = lane & 15, quad = lane >> 4;
  const int mb = m0 + wm * 64, nb = n0 + wn * 64;
  const u16* gt = (const u16*)(p.ws + OFF_GATE);
  u16* mg = (u16*)(p.ws + OFF_MERGED);
  Acc a1; acc_zero(a1);
  gemm_kloop((const u16*)(p.ws + OFF_YATT), 512, (const u16*)(p.ws + OFF_WOA), 512, 512, m0, n0, sA, sB, a1);
  asm volatile("" ::: "memory");
#pragma unroll
  for (int j = 0; j < 4; ++j) {
    const int m = mb + j * 16 + l15;
#pragma unroll
    for (int i = 0; i < 4; ++i) {
      const int n = nb + i * 16 + quad * 4;
      uint2 ga = *(const uint2*)(gt + (size_t)m * 2048 + n);
      f32x4 x = a1.v[i][j];
      *(uint2*)(mg + (size_t)m * 1024 + n) = make_uint2(pack2(bflo(ga.x) * x[0], bfhi(ga.x) * x[1]), pack2(bflo(ga.y) * x[2], bfhi(ga.y) * x[3]));
    }
  }
  asm volatile("" ::: "memory");
  acc_zero(a1);
  gemm_kloop((const u16*)(p.ws + OFF_YHY), 512, (const u16*)(p.ws + OFF_WOH), 512, 512, m0, n0, sA, sB, a1);
  asm volatile("" ::: "memory");
#pragma unroll
  for (int j = 0; j < 4; ++j) {
    const int m = mb + j * 16 + l15;
#pragma unroll
    for (int i = 0; i < 4; ++i) {
      const int n = nb + i * 16 + quad * 4;
      uint2 gh = *(const uint2*)(gt + (size_t)m * 2048 + 1024 + n);
      uint2 pv = *(const uint2*)(mg + (size_t)m * 1024 + n);
      f32x4 y = a1.v[i][j];
      float o0 = bflo(pv.x) + bflo(gh.x) * y[0];
      float o1 = bfhi(pv.x) + bfhi(gh.x) * y[1];
      float o2 = bflo(pv.y) + bflo(gh.y) * y[2];
      float o3 = bfhi(pv.y) + bfhi(gh.y) * y[3];
      *(uint2*)(mg + (size_t)m * 1024 + n) = make_uint2(pack2(o0, o1), pack2(o2, o3));
    }
  }
}

DEV void p5_out(const Params& p, int tile, u16* sA, u16* sB) {
  const int mt = tile >> 3, nt = tile & 7;
  const int m0 = mt * 128, n0 = nt * 128;
  Acc acc; acc_zero(acc);
  gemm_kloop((const u16*)(p.ws + OFF_MERGED), 1024, (const u16*)(p.ws + OFF_WOUT), 1024, 1024, m0, n0, sA, sB, acc);
  const int tid = threadIdx.x, lane = tid & 63, wave = tid >> 6, wm = wave >> 1, wn = wave & 1;
  const int l15 = lane & 15, quad = lane >> 4;
  const int mb = m0 + wm * 64, nb = n0 + wn * 64;
  const float* mod = (const float*)(p.ws + OFF_MOD);
#pragma unroll
  for (int j = 0; j < 4; ++j) {
    const int m = mb + j * 16 + l15;
    const int b = m >> 12;
#pragma unroll
    for (int i = 0; i < 4; ++i) {
      const int n = nb + i * 16 + quad * 4;
      float4 g1 = *(const float4*)(mod + b * 6144 + 2048 + n);
      float4 xv = *(const float4*)(p.x + (size_t)m * 1024 + n);
      f32x4 a = acc.v[i][j];
      float4 o = make_float4(xv.x + g1.x * a[0], xv.y + g1.y * a[1], xv.z + g1.z * a[2], xv.w + g1.w * a[3]);
      *(float4*)(p.out + (size_t)m * 1024 + n) = o;
    }
  }
}

DEV void p7_qp(const Params& p, int tile, u16* sA, u16* sB) {
  const int mt = tile >> 3, nt = tile & 7;
  const int m0 = mt * 128, n0 = nt * 128;
  Acc acc; acc_zero(acc);
  gemm_kloop((const u16*)(p.ws + OFF_H2), 1024, (const u16*)(p.ws + OFF_WQ), 1024, 1024, m0, n0, sA, sB, acc);
  const int tid = threadIdx.x, lane = tid & 63, wave = tid >> 6, wm = wave >> 1, wn = wave & 1;
  const int l15 = lane & 15, quad = lane >> 4;
  const int mb = m0 + wm * 64, nb = n0 + wn * 64;
  u16* qp = (u16*)(p.ws + OFF_QP);
#pragma unroll
  for (int j = 0; j < 4; ++j) {
    const int m = mb + j * 16 + l15;
#pragma unroll
    for (int i = 0; i < 4; ++i) {
      const int n = nb + i * 16 + quad * 4;
      f32x4 a = acc.v[i][j];
      *(uint2*)(qp + (size_t)m * 1024 + n) = make_uint2(pack2(a[0], a[1]), pack2(a[2], a[3]));
    }
  }
}

DEV void p8_route(const Params& p, int item, float* sm) {
  const int tid = threadIdx.x, lane = tid & 63, wave = tid >> 6, l15 = lane & 15, quad = lane >> 4;
  const int h = item & 7, tt = item >> 3;
  const int t0 = tt * 16;
  float* sS = sm;
  float* sTv = sm + 2 * 16 * 132;
  int* sTi = (int*)(sTv + 512);
  {
    const int pp = wave >> 1;
    const u16* keys = (const u16*)(p.ws + OFF_KEYS) + (size_t)(h * 2 + pp) * 128 * 64;
    const u16* qp = (const u16*)(p.ws + OFF_QP) + (size_t)(t0 + l15) * 1024 + h * 128 + pp * 64 + quad * 8;
    bf16x8 b0 = *(const bf16x8*)(qp);
    bf16x8 b1 = *(const bf16x8*)(qp + 32);
#pragma unroll
    for (int k4 = 0; k4 < 4; ++k4) {
      const int kt = (wave & 1) * 4 + k4;
      bf16x8 a0 = *(const bf16x8*)(keys + (kt * 16 + l15) * 64 + quad * 8);
      bf16x8 a1 = *(const bf16x8*)(keys + (kt * 16 + l15) * 64 + 32 + quad * 8);
      f32x4 z = (f32x4){0.f, 0.f, 0.f, 0.f};
      z = __builtin_amdgcn_mfma_f32_16x16x32_bf16(a0, b0, z, 0, 0, 0);
      z = __builtin_amdgcn_mfma_f32_16x16x32_bf16(a1, b1, z, 0, 0, 0);
#pragma unroll
      for (int r = 0; r < 4; ++r) sS[(pp * 16 + l15) * 132 + kt * 16 + quad * 4 + r] = z[r];
    }
  }
  __syncthreads();
  for (int i = 0; i < 8; ++i) {
    const int pr = wave * 8 + i;
    const int tok = pr >> 1, pp = pr & 1;
    float v0 = sS[(pp * 16 + tok) * 132 + lane];
    float v1 = sS[(pp * 16 + tok) * 132 + 64 + lane];
    float kv = 0.f; int ki = 0;
    for (int rd = 0; rd < 16; ++rd) {
      const float m = fmaxf(v0, v1);
      const float wmx = wave_max(m);
      const unsigned long long bal = __ballot(m == wmx);
      const int owner = __ffsll((long long)bal) - 1;
      int myidx = (v0 == wmx) ? lane : (lane + 64);
      const int oidx = __shfl(myidx, owner);
      if (lane == owner) { if (v0 == wmx) v0 = -INFINITY; else v1 = -INFINITY; }
      if (lane == rd) { kv = wmx; ki = oidx; }
    }
    if (lane < 16) { sTv[(pp * 16 + tok) * 16 + lane] = kv; sTi[(pp * 16 + tok) * 16 + lane] = ki; }
  }
  __syncthreads();
  int* ridx = (int*)(p.ws + OFF_RIDX);
  float* rw = (float*)(p.ws + OFF_RW);
  for (int i = 0; i < 4; ++i) {
    const int tok = wave * 4 + i;
    float cv[4];
#pragma unroll
    for (int j = 0; j < 4; ++j) {
      const int ci = lane + 64 * j;
      cv[j] = sTv[(0 * 16 + tok) * 16 + (ci >> 4)] + sTv[(1 * 16 + tok) * 16 + (ci & 15)];
    }
    float kv = 0.f; int ki = 0;
    for (int rd = 0; rd < 16; ++rd) {
      const float m = fmaxf(fmaxf(cv[0], cv[1]), fmaxf(cv[2], cv[3]));
      const float wmx = wave_max(m);
      const unsigned long long bal = __ballot(m == wmx);
      const int owner = __ffsll((long long)bal) - 1;
      int myj = (cv[0] == wmx) ? 0 : ((cv[1] == wmx) ? 1 : ((cv[2] == wmx) ? 2 : 3));
      const int oci = __shfl(lane + 64 * myj, owner);
      if (lane == owner) {
        if (myj == 0) cv[0] = -INFINITY; else if (myj == 1) cv[1] = -INFINITY; else if (myj == 2) cv[2] = -INFINITY; else cv[3] = -INFINITY;
      }
      if (lane == rd) { kv = wmx; ki = oci; }
    }
    const float vmax = __shfl(kv, 0);
    float e = (lane < 16) ? __expf(kv - vmax) : 0.f;
    float s = e;
    s += __shfl_xor(s, 1); s += __shfl_xor(s, 2); s += __shfl_xor(s, 4); s += __shfl_xor(s, 8);
    if (lane < 16) {
      const int i1 = sTi[(0 * 16 + tok) * 16 + (ki >> 4)];
      const int i2 = sTi[(1 * 16 + tok) * 16 + (ki & 15)];
      ridx[(size_t)(t0 + tok) * 128 + h * 16 + lane] = i1 * 128 + i2;
      rw[(size_t)(t0 + tok) * 128 + h * 16 + lane] = e / s;
    }
  }
  __syncthreads();
}

DEV float gelu_tanh(float x) {
  const float u = 0.7978845608028654f * (x + 0.044715f * x * x * x);
  return 0.5f * x * (1.f + tanhf(u));
}

DEV void unpack8(const uint4& q, float* f) {
  f[0] = bflo(q.x); f[1] = bfhi(q.x); f[2] = bflo(q.y); f[3] = bfhi(q.y);
  f[4] = bflo(q.z); f[5] = bfhi(q.z); f[6] = bflo(q.w); f[7] = bfhi(q.w);
}

DEV void p9_experts(const Params& p, int t, int lane) {
  const int b = t >> 12;
  const u16* h2 = (const u16*)(p.ws + OFF_H2) + (size_t)t * 1024;
  float hf[16];
  {
    uint4 ha = *(const uint4*)(h2 + 8 * lane);
    uint4 hb = *(const uint4*)(h2 + 512 + 8 * lane);
    unpack8(ha, hf); unpack8(hb, hf + 8);
  }
  float o[16];
#pragma unroll
  for (int k = 0; k < 16; ++k) o[k] = 0.f;
  const int* ridx = (const int*)(p.ws + OFF_RIDX) + (size_t)t * 128;
  const float* rw = (const float*)(p.ws + OFF_RW) + (size_t)t * 128;
  const u16* U = (const u16*)(p.ws + OFF_UBF);
  const u16* V = (const u16*)(p.ws + OFF_VBF);
  for (int g = 0; g < 128; g += 4) {
    int e[4]; float gw[4];
    uint4 ua[4], ub[4], va[4], vb[4];
#pragma unroll
    for (int i = 0; i < 4; ++i) {
      e[i] = __builtin_amdgcn_readfirstlane(ridx[g + i]);
      gw[i] = rw[g + i];
      const u16* ur = U + (size_t)e[i] * 1024;
      const u16* vr = V + (size_t)e[i] * 1024;
      ua[i] = *(const uint4*)(ur + 8 * lane);
      ub[i] = *(const uint4*)(ur + 512 + 8 * lane);
      va[i] = *(const uint4*)(vr + 8 * lane);
      vb[i] = *(const uint4*)(vr + 512 + 8 * lane);
    }
#pragma unroll
    for (int i = 0; i < 4; ++i) {
      float uf[16];
      unpack8(ua[i], uf); unpack8(ub[i], uf + 8);
      float d = 0.f;
#pragma unroll
      for (int k = 0; k < 16; ++k) d += hf[k] * uf[k];
      d = wave_sum(d);
      const float coef = gw[i] * gelu_tanh(d);
      float vf[16];
      unpack8(va[i], vf); unpack8(vb[i], vf + 8);
#pragma unroll
      for (int k = 0; k < 16; ++k) o[k] += coef * vf[k];
    }
  }
  const float* mod = (const float*)(p.ws + OFF_MOD) + b * 6144 + 5120;
  const float* xm = p.out + (size_t)t * 1024;
  float xo[16];
  float ss = 0.f;
#pragma unroll
  for (int hlf = 0; hlf < 2; ++hlf) {
    const int base = hlf * 512 + 8 * lane;
    float4 x0 = *(const float4*)(xm + base), x1 = *(const float4*)(xm + base + 4);
    float4 g0 = *(const float4*)(mod + base), g1 = *(const float4*)(mod + base + 4);
    xo[hlf * 8 + 0] = x0.x + g0.x * o[hlf * 8 + 0];
    xo[hlf * 8 + 1] = x0.y + g0.y * o[hlf * 8 + 1];
    xo[hlf * 8 + 2] = x0.z + g0.z * o[hlf * 8 + 2];
    xo[hlf * 8 + 3] = x0.w + g0.w * o[hlf * 8 + 3];
    xo[hlf * 8 + 4] = x1.x + g1.x * o[hlf * 8 + 4];
    xo[hlf * 8 + 5] = x1.y + g1.y * o[hlf * 8 + 5];
    xo[hlf * 8 + 6] = x1.z + g1.z * o[hlf * 8 + 6];
    xo[hlf * 8 + 7] = x1.w + g1.w * o[hlf * 8 + 7];
  }
#pragma unroll
  for (int k = 0; k < 16; ++k) ss += xo[k] * xo[k];
  ss = wave_sum(ss);
  const float r = rsqrtf(ss * (1.f / 1024.f) + 1e-6f);
  float* op = p.out + (size_t)t * 1024;
#pragma unroll
  for (int hlf = 0; hlf < 2; ++hlf) {
    const int base = hlf * 512 + 8 * lane;
    float4 f0 = *(const float4*)(p.final_g + base), f1 = *(const float4*)(p.final_g + base + 4);
    *(float4*)(op + base) = make_float4(xo[hlf * 8 + 0] * r * f0.x, xo[hlf * 8 + 1] * r * f0.y, xo[hlf * 8 + 2] * r * f0.z, xo[hlf * 8 + 3] * r * f0.w);
    *(float4*)(op + base + 4) = make_float4(xo[hlf * 8 + 4] * r * f1.x, xo[hlf * 8 + 5] * r * f1.y, xo[hlf * 8 + 6] * r * f1.z, xo[hlf * 8 + 7] * r * f1.w);
  }
}

__global__ void __launch_bounds__(256, 2) mega(Params p) {
  extern __shared__ __attribute__((aligned(16))) char smem[];
  cg::grid_group grid = cg::this_grid();
  const int tid = threadIdx.x, lane = tid & 63, wave = tid >> 6;
  const int nb = gridDim.x, bid = blockIdx.x;
  float* smf = (float*)smem;
  u16* sA = (u16*)smem;
  u16* sB = (u16*)(smem + 128 * 72 * 2);

  if (PHON(0)) {
    const int N_MOD = 96, N_TIN = 16 * 68, N_TOA = 8 * 16, N_TOH = 8 * 16, N_TOUT = 16 * 16, N_TQ = 16 * 16, N_HID = 1024;
    const int total = N_MOD + N_TIN + N_TOA + N_TOH + N_TOUT + N_TQ + N_HID + 1;
    for (int it = bid; it < total; it += nb) {
      int i = it;
      if (i < N_MOD) { p0_mod(p, i, smf); continue; }
      i -= N_MOD;
      if (i < N_TIN) { transpose_tile(p.w_in, INW, 1024, (u16*)(p.ws + OFF_WIN), i, smf); continue; }
      i -= N_TIN;
      if (i < N_TOA) { transpose_tile(p.w_o_attn, 1024, 512, (u16*)(p.ws + OFF_WOA), i, smf); continue; }
      i -= N_TOA;
      if (i < N_TOH) { transpose_tile(p.w_o_hy, 1024, 512, (u16*)(p.ws + OFF_WOH), i, smf); continue; }
      i -= N_TOH;
      if (i < N_TOUT) { transpose_tile(p.w_out, 1024, 1024, (u16*)(p.ws + OFF_WOUT), i, smf); continue; }
      i -= N_TOUT;
      if (i < N_TQ) { transpose_tile(p.peer_wq, 1024, 1024, (u16*)(p.ws + OFF_WQ), i, smf); continue; }
      i -= N_TQ;
      if (i < N_HID) { p0_hidden(p, i, smf); continue; }
      float2* rope = (float2*)(p.ws + OFF_ROPE);
      for (int idx = tid; idx < 1024; idx += 256) {
        const int pos = idx >> 4, f = idx & 15;
        const float inv = powf(10000.f, -(float)f / 16.f);
        const float ang = (float)pos * inv;
        rope[idx] = make_float2(cosf(ang), sinf(ang));
      }
    }
    convert_flat(p.peer_keys, (u16*)(p.ws + OFF_KEYS), (size_t)131072);
    convert_flat(p.peer_u, (u16*)(p.ws + OFF_UBF), (size_t)16384 * 1024);
    convert_flat(p.peer_v, (u16*)(p.ws + OFF_VBF), (size_t)16384 * 1024);
  }
  grid.sync();

  if (PHON(1)) {
    const float* mod = (const float*)(p.ws + OFF_MOD);
    const int nrows = T_TOK + 1024;
    for (int r = bid * 4 + wave; r < nrows; r += nb * 4) {
      if (r < T_TOK) {
        const int b = r >> 12;
        norm_row(p.x + (size_t)r * 1024, p.norm1_g, mod + b * 6144, mod + b * 6144 + 1024,
                 (u16*)((char*)p.out + OO_H1) + (size_t)r * 1024, lane);
      } else {
        const int rc = r - T_TOK;
        norm_row(p.ctx + (size_t)rc * 1024, p.norm1_g, mod + 4 * 6144, mod + 4 * 6144 + 1024,
                 (u16*)((char*)p.out + OO_HC) + (size_t)rc * 1024, lane);
      }
    }
    for (int it = bid; it < 128; it += nb) p1_filter(p, it, smf);
  }
  grid.sync();

  if (PHON(2)) {
    const int total = 128 * 34 + 16;
    for (int it = bid; it < total; it += nb) {
      if (it < 128 * 34) p2_inproj(p, it, sA, sB);
      else p2_ctxkv(p, it - 128 * 34, sA, sB);
    }
  }
  grid.sync();

  if (PHON(3)) {
    const int total = 1024 + 2048;
    for (int it = bid; it < total; it += nb) {
      if (it < 1024) p3_attn(p, it, (u16*)smem, (u16*)(smem + 128 * 72 * 2));
      else p3_hypre(p, it - 1024, (u16*)smem);
    }
  }
  grid.sync();

  if (PHON(4)) for (int it = bid; it < 512; it += nb) p3_toeplitz(p, it, smem);
  grid.sync();

  if (PHON(5)) for (int it = bid; it < 1024; it += nb) p4_merge(p, it, sA, sB);
  grid.sync();

  if (PHON(6)) for (int it = bid; it < 1024; it += nb) p5_out(p, it, sA, sB);
  grid.sync();

  if (PHON(7)) {
    const float* mod = (const float*)(p.ws + OFF_MOD);
    for (int r = bid * 4 + wave; r < T_TOK; r += nb * 4) {
      const int b = r >> 12;
      norm_row(p.out + (size_t)r * 1024, p.norm2_g, mod + b * 6144 + 3072, mod + b * 6144 + 4096,
               (u16*)(p.ws + OFF_H2) + (size_t)r * 1024, lane);
    }
  }
  grid.sync();

  if (PHON(8)) for (int it = bid; it < 1024; it += nb) p7_qp(p, it, sA, sB);
  grid.sync();

  if (PHON(9)) for (int it = bid; it < 8192; it += nb) p8_route(p, it, smf);
  grid.sync();

  if (PHON(10)) for (int t = bid * 4 + wave; t < T_TOK; t += nb * 4) p9_experts(p, t, lane);
}

extern "C" void kernel_launch(void* const* d_in, const int* in_sizes, int n_in, void* d_out, int out_size,
                              void* d_ws, size_t ws_size, hipStream_t stream) {
  static int grid_blocks = 0;
  if (!grid_blocks) {
    int dev = 0, cus = 0, per_cu = 0;
    (void)hipGetDevice(&dev);
    (void)hipDeviceGetAttribute(&cus, hipDeviceAttributeMultiprocessorCount, dev);
    (void)hipFuncSetAttribute((const void*)mega, hipFuncAttributeMaxDynamicSharedMemorySize, SMEM_BYTES);
    (void)hipOccupancyMaxActiveBlocksPerMultiprocessor(&per_cu, mega, 256, SMEM_BYTES);
    if (per_cu > 2) per_cu = 2;
    if (per_cu < 1) per_cu = 1;
    grid_blocks = cus * per_cu;
  }
  Params p{};
  const float** pp = (const float**)&p;
  for (int i = 0; i < 28; ++i) pp[i] = (const float*)d_in[i];
  p.out = (float*)d_out;
  p.ws = (char*)d_ws;
  void* args[] = {&p};
  hipError_t e = hipLaunchCooperativeKernel((void*)mega, dim3(grid_blocks), dim3(256), args, SMEM_BYTES, stream);
  if (e != hipSuccess) fprintf(stderr, "cooperative launch failed: %s (grid %d)\n", hipGetErrorString(e), grid_blocks);
}
```

```cpp
#include <hip/hip_runtime.h>
#include <hip/hip_bf16.h>
#include <hip/hip_cooperative_groups.h>
#include <cstdio>
namespace cg = cooperative_groups;

typedef unsigned short u16;
typedef __attribute__((ext_vector_type(8))) short bf16x8;
typedef __attribute__((ext_vector_type(4))) float f32x4;
typedef __attribute__((ext_vector_type(4))) unsigned u32x4;

#define DEV __device__ __forceinline__
#ifndef PH
#define PH -1
#endif
#define PHON(n) (PH < 0 || PH == (n))
#ifndef REP
#define REP -1
#endif
#define NREP(n) ((REP == (n)) ? 2 : 1)

constexpr int T_TOK = 16384;
constexpr int DM = 1024;
constexpr int SEQL = 4096;
constexpr int INW = 4352;

struct Params {
  const float *x, *c, *ctx, *c_ctx, *w_mod, *b_mod, *norm1_g, *w_in, *attn_sink, *hy_conv_w, *hy_conv_b,
      *hy_fw1, *hy_fb1, *hy_fw2, *hy_fb2, *hy_fw3, *hy_fb3, *hy_freq, *hy_skip, *w_o_attn, *w_o_hy, *w_out,
      *norm2_g, *peer_wq, *peer_keys, *peer_u, *peer_v, *final_g;
  float* out;
  char* ws;
};

constexpr size_t MB = 1u << 20;
constexpr size_t OFF_MOD = 0;
constexpr size_t OFF_ROPE = 128 * 1024;
constexpr size_t OFF_NINV = OFF_ROPE + 8192;
constexpr size_t OFF_H2F = 256 * 1024;
constexpr size_t OFF_WIN = OFF_H2F + MB;
constexpr size_t OFF_WOA = OFF_WIN + 9 * MB;
constexpr size_t OFF_WOH = OFF_WOA + MB;
constexpr size_t OFF_WOUT = OFF_WOH + MB;
constexpr size_t OFF_WQ = OFF_WOUT + 2 * MB;
constexpr size_t OFF_KEYS = OFF_WQ + 2 * MB;
constexpr size_t OFF_UBF = OFF_KEYS + MB;
constexpr size_t OFF_VBF = OFF_UBF + 32 * MB;
constexpr size_t OFF_Q = OFF_VBF + 32 * MB;
constexpr size_t OFF_K = OFF_Q + 16 * MB;
constexpr size_t OFF_VT = OFF_K + 4 * MB;
constexpr size_t OFF_KC = OFF_VT + 4 * MB;
constexpr size_t OFF_VCT = OFF_KC + MB / 2;
constexpr size_t OFF_Z = OFF_VCT + MB / 2;
constexpr size_t OFF_GATE = OFF_Z + 48 * MB;
constexpr size_t OFF_YATT = OFF_GATE + 64 * MB;
constexpr size_t OFF_YHY = OFF_YATT + 16 * MB;
constexpr size_t OFF_RIDX = OFF_Q;
constexpr size_t OFF_RW = OFF_Q + 8 * MB;
constexpr size_t OFF_MERGED = OFF_Z;
constexpr size_t OFF_H2 = OFF_GATE;
constexpr size_t OFF_QP = OFF_GATE + 32 * MB;
constexpr size_t OO_H1 = 0;
constexpr size_t OO_UT = 0;
constexpr size_t OO_X0T = 16 * MB;
constexpr size_t OO_HC = 32 * MB;
constexpr size_t OO_G = 34 * MB;

constexpr int SMEM_BYTES = 70144;
constexpr size_t OFF_BAR = 160 * 1024;
constexpr int SMEM_XB = 70016;

DEV u16 f2bf(float f) {
  unsigned u = __float_as_uint(f);
  u += 0x7fffu + ((u >> 16) & 1u);
  return (u16)(u >> 16);
}
DEV float bf2f(u16 h) { return __uint_as_float(((unsigned)h) << 16); }
DEV unsigned pack2(float a, float b) { return (unsigned)f2bf(a) | ((unsigned)f2bf(b) << 16); }
DEV float bflo(unsigned w) { return __uint_as_float(w << 16); }
DEV float bfhi(unsigned w) { return __uint_as_float(w & 0xffff0000u); }
DEV float wave_sum(float v) {
#pragma unroll
  for (int o = 32; o > 0; o >>= 1) v += __shfl_xor(v, o);
  return v;
}
DEV float wave_max(float v) {
#pragma unroll
  for (int o = 32; o > 0; o >>= 1) v = fmaxf(v, __shfl_xor(v, o));
  return v;
}

DEV void p0_mod(const Params& p, int item, float* sm) {
  const int tid = threadIdx.x;
  for (int i = tid; i < 5 * 1024; i += 256) {
    int r = i >> 10, k = i & 1023;
    float c = (r < 4) ? p.c[r * 1024 + k] : p.c_ctx[k];
    sm[i] = c / (1.f + expf(-c));
  }
  __syncthreads();
  const int col = item * 64 + (tid & 63), kg = tid >> 6;
  float a0 = 0, a1 = 0, a2 = 0, a3 = 0, a4 = 0;
  for (int k = kg * 256; k < kg * 256 + 256; ++k) {
    float w = p.w_mod[(size_t)k * 6144 + col];
    a0 += sm[k] * w; a1 += sm[1024 + k] * w; a2 += sm[2048 + k] * w; a3 += sm[3072 + k] * w; a4 += sm[4096 + k] * w;
  }
  float* red = sm + 5 * 1024;
  red[(kg * 5 + 0) * 64 + (tid & 63)] = a0;
  red[(kg * 5 + 1) * 64 + (tid & 63)] = a1;
  red[(kg * 5 + 2) * 64 + (tid & 63)] = a2;
  red[(kg * 5 + 3) * 64 + (tid & 63)] = a3;
  red[(kg * 5 + 4) * 64 + (tid & 63)] = a4;
  __syncthreads();
  float* mod = (float*)(p.ws + OFF_MOD);
  for (int i = tid; i < 320; i += 256) {
    int r = i >> 6, cc = i & 63;
    float s = red[(0 * 5 + r) * 64 + cc] + red[(1 * 5 + r) * 64 + cc] + red[(2 * 5 + r) * 64 + cc] + red[(3 * 5 + r) * 64 + cc];
    mod[r * 6144 + item * 64 + cc] = s + p.b_mod[item * 64 + cc];
  }
  __syncthreads();
}

DEV void transpose_tile(const float* __restrict__ src, int N, int K, u16* __restrict__ dst, int tile, float* sm) {
  const int tid = threadIdx.x;
  const int nkt = K >> 6;
  const int kt = tile % nkt, nt = tile / nkt;
  const int k0 = kt * 64, n0 = nt * 64;
  const int c = tid & 63, r = tid >> 6;
#pragma unroll
  for (int rr = 0; rr < 16; ++rr) sm[(rr * 4 + r) * 65 + c] = src[(size_t)(k0 + rr * 4 + r) * N + n0 + c];
  __syncthreads();
  const int nn = tid >> 2, part = tid & 3;
  unsigned w[8];
#pragma unroll
  for (int j = 0; j < 8; ++j) w[j] = pack2(sm[(part * 16 + 2 * j) * 65 + nn], sm[(part * 16 + 2 * j + 1) * 65 + nn]);
  uint4* d = (uint4*)(dst + (size_t)(n0 + nn) * K + k0 + part * 16);
  d[0] = make_uint4(w[0], w[1], w[2], w[3]);
  d[1] = make_uint4(w[4], w[5], w[6], w[7]);
  __syncthreads();
}

DEV void p0_hidden(const Params& p, int item, float* sm) {
  const int tid = threadIdx.x;
  float* z = sm;
  float* h1 = sm + 4 * 36;
  if (tid < 4 * 33) {
    int tt = tid / 33, i = tid % 33;
    int t = item * 4 + tt;
    float v;
    if (i == 0) v = (float)t * (1.f / 4096.f);
    else {
      int band = (i <= 16) ? i : (i - 16);
      float fr = (float)((t * band) & 4095) * (1.f / 4096.f);
      v = (i <= 16) ? cospif(2.f * fr) : sinpif(2.f * fr);
    }
    z[tt * 36 + i] = v;
  }
  __syncthreads();
  const int tt = tid >> 6, j = tid & 63;
  float a = p.hy_fb1[j];
  for (int i = 0; i < 33; ++i) a += z[tt * 36 + i] * p.hy_fw1[i * 64 + j];
  const float fq = p.hy_freq[j];
  h1[tt * 64 + j] = sinf(fq * a);
  __syncthreads();
  float b = p.hy_fb2[j];
  for (int i = 0; i < 64; ++i) b += h1[tt * 64 + i] * p.hy_fw2[i * 64 + j];
  ((float*)(p.ws + OFF_H2F))[(item * 4 + tt) * 64 + j] = sinf(fq * b);
  __syncthreads();
}

DEV void convert_flat(const float* __restrict__ src, u16* __restrict__ dst, size_t n) {
  size_t stride = (size_t)gridDim.x * 256 * 8;
  for (size_t i = ((size_t)blockIdx.x * 256 + threadIdx.x) * 8; i < n; i += stride) {
    float4 a = *(const float4*)(src + i);
    float4 b = *(const float4*)(src + i + 4);
    *(uint4*)(dst + i) = make_uint4(pack2(a.x, a.y), pack2(a.z, a.w), pack2(b.x, b.y), pack2(b.z, b.w));
  }
}

DEV void norm_row(const float* __restrict__ xr, const float* __restrict__ g, const float* __restrict__ sh,
                  const float* __restrict__ sc, u16* __restrict__ dst, int lane) {
  float4 v[4];
  float ss = 0.f;
#pragma unroll
  for (int i = 0; i < 4; ++i) {
    v[i] = ((const float4*)xr)[lane + 64 * i];
    ss += v[i].x * v[i].x + v[i].y * v[i].y + v[i].z * v[i].z + v[i].w * v[i].w;
  }
  ss = wave_sum(ss);
  const float r = rsqrtf(ss * (1.f / 1024.f) + 1e-6f);
#pragma unroll
  for (int i = 0; i < 4; ++i) {
    const int idx = lane + 64 * i;
    float4 gg = ((const float4*)g)[idx], s1 = ((const float4*)sh)[idx], s2 = ((const float4*)sc)[idx];
    float y0 = v[i].x * r * gg.x * (1.f + s2.x) + s1.x;
    float y1 = v[i].y * r * gg.y * (1.f + s2.y) + s1.y;
    float y2 = v[i].z * r * gg.z * (1.f + s2.z) + s1.z;
    float y3 = v[i].w * r * gg.w * (1.f + s2.w) + s1.w;
    *(uint2*)(dst + idx * 4) = make_uint2(pack2(y0, y1), pack2(y2, y3));
  }
}

DEV void p1_filter(const Params& p, int item, float* sm) {
  const int tid = threadIdx.x;
  float* wc = sm;
  float* fb = sm + 512;
  float* dl = sm + 520;
  float* red = sm + 528;
  const int c0 = item * 4;
  for (int i = tid; i < 512; i += 256) {
    int j = i >> 6, k = i & 63;
    int col = (j < 4) ? (c0 + j) : (512 + c0 + j - 4);
    wc[j * 64 + k] = p.hy_fw3[k * 1024 + col];
  }
  if (tid < 8) fb[tid] = p.hy_fb3[(tid < 4) ? (c0 + tid) : (512 + c0 + tid - 4)];
  if (tid < 4) {
    const float a = logf(1e-2f) / 1.5f, b = logf(1e-2f) / 0.3f;
    float d = a + (b - a) * (float)(c0 + tid) / 511.f;
    dl[tid] = fabsf(d);
  }
  __syncthreads();
  u16* G = (u16*)((char*)p.out + OO_G);
  const float* H = (const float*)(p.ws + OFF_H2F);
  float as0 = 0, as1 = 0, as2 = 0, as3 = 0;
  for (int t = tid; t < 4096; t += 256) {
    const float4* hp = (const float4*)(H + t * 64);
    float d[8];
#pragma unroll
    for (int j = 0; j < 8; ++j) d[j] = fb[j];
#pragma unroll 1
    for (int q = 0; q < 16; ++q) {
      float4 hv = hp[q];
#pragma unroll
      for (int j = 0; j < 8; ++j)
        d[j] += hv.x * wc[j * 64 + 4 * q] + hv.y * wc[j * 64 + 4 * q + 1] + hv.z * wc[j * 64 + 4 * q + 2] + hv.w * wc[j * 64 + 4 * q + 3];
    }
    const float tn = (float)t * (1.f / 4096.f);
    float asum[4];
#pragma unroll
    for (int j = 0; j < 4; ++j) {
      float dec = expf(-tn * dl[j]);
      float f = d[j] * dec, bw = d[4 + j] * dec;
      u16* Gc = G + (size_t)(c0 + j) * 8192;
      Gc[4095 - t] = f2bf(f);
      float s = fabsf(f);
      if (t < 4095) { Gc[4096 + t] = f2bf(bw); s += fabsf(bw); }
      else Gc[8191] = 0;
      asum[j] = s;
    }
    as0 += asum[0]; as1 += asum[1]; as2 += asum[2]; as3 += asum[3];
  }
  as0 = wave_sum(as0); as1 = wave_sum(as1); as2 = wave_sum(as2); as3 = wave_sum(as3);
  if ((tid & 63) == 0) {
    int w = tid >> 6;
    red[w * 4 + 0] = as0; red[w * 4 + 1] = as1; red[w * 4 + 2] = as2; red[w * 4 + 3] = as3;
  }
  __syncthreads();
  if (tid < 4) {
    float s = red[tid] + red[4 + tid] + red[8 + tid] + red[12 + tid];
    ((float*)(p.ws + OFF_NINV))[c0 + tid] = 1.f / s;
  }
  __syncthreads();
}

struct Acc { f32x4 v[4][4]; };

DEV void acc_zero(Acc& a) {
#pragma unroll
  for (int i = 0; i < 4; ++i)
#pragma unroll
    for (int j = 0; j < 4; ++j) a.v[i][j] = (f32x4){0.f, 0.f, 0.f, 0.f};
}

DEV void gemm_kloop(const u16* __restrict__ A, int lda, const u16* __restrict__ Bt, int ldb, int K, int m0, int n0,
                    u16* sA, u16* sB, Acc& acc) {
  const int tid = threadIdx.x, lane = tid & 63, wave = tid >> 6, wm = wave >> 1, wn = wave & 1;
  const int l15 = lane & 15, quad = lane >> 4;
  const int srow = tid >> 3, sch = tid & 7;
  const u16* ga = A + (size_t)(m0 + srow) * lda + sch * 8;
  const u16* gb = Bt + (size_t)(n0 + srow) * ldb + sch * 8;
  u32x4 ra[4], rb[4];
#pragma unroll
  for (int i = 0; i < 4; ++i) {
    ra[i] = *(const u32x4*)(ga + (size_t)i * 32 * lda);
    rb[i] = *(const u32x4*)(gb + (size_t)i * 32 * ldb);
  }
  const int nk = K >> 6;
  for (int kt = 0; kt < nk; ++kt) {
#pragma unroll
    for (int i = 0; i < 4; ++i) {
      *(u32x4*)(sA + (srow + i * 32) * 72 + sch * 8) = ra[i];
      *(u32x4*)(sB + (srow + i * 32) * 72 + sch * 8) = rb[i];
    }
    __syncthreads();
    if (kt + 1 < nk) {
#pragma unroll
      for (int i = 0; i < 4; ++i) {
        ra[i] = *(const u32x4*)(ga + (size_t)i * 32 * lda + (kt + 1) * 64);
        rb[i] = *(const u32x4*)(gb + (size_t)i * 32 * ldb + (kt + 1) * 64);
      }
    }
#pragma unroll
    for (int ks = 0; ks < 2; ++ks) {
      bf16x8 af[4], bfr[4];
#pragma unroll
      for (int i = 0; i < 4; ++i) af[i] = *(const bf16x8*)(sB + (wn * 64 + i * 16 + l15) * 72 + ks * 32 + quad * 8);
#pragma unroll
      for (int j = 0; j < 4; ++j) bfr[j] = *(const bf16x8*)(sA + (wm * 64 + j * 16 + l15) * 72 + ks * 32 + quad * 8);
#pragma unroll
      for (int i = 0; i < 4; ++i)
#pragma unroll
        for (int j = 0; j < 4; ++j) acc.v[i][j] = __builtin_amdgcn_mfma_f32_16x16x32_bf16(af[i], bfr[j], acc.v[i][j], 0, 0, 0);
    }
    __syncthreads();
  }
}

DEV void p2_inproj(const Params& p, int tile, u16* sA, u16* sB) {
  const int mt = tile / 34, nt = tile % 34;
  const int m0 = mt * 128, n0 = nt * 128;
  Acc acc; acc_zero(acc);
  gemm_kloop((const u16*)((const char*)p.out + OO_H1), 1024, (const u16*)(p.ws + OFF_WIN), 1024, 1024, m0, n0, sA, sB, acc);
  const int tid = threadIdx.x, lane = tid & 63, wave = tid >> 6, wm = wave >> 1, wn = wave & 1;
  const int l15 = lane & 15, quad = lane >> 4;
  const int mb = m0 + wm * 64, nb = n0 + wn * 64;
  if (nb < 640) {
    const float2* rope = (const float2*)(p.ws + OFF_ROPE);
    const bool isq = nb < 512;
    const float qs = isq ? 0.125f : 1.f;
#pragma unroll
    for (int j = 0; j < 4; ++j) {
      const int m = mb + j * 16 + l15;
      const int b = m >> 12, l = m & 4095;
      const int prow = l >> 6, pcol = l & 63;
      u16* dst;
      if (isq) dst = (u16*)(p.ws + OFF_Q) + ((size_t)(b * 8 + (nb >> 6)) * 4096 + l) * 64;
      else dst = (u16*)(p.ws + OFF_K) + ((size_t)(b * 2 + ((nb - 512) >> 6)) * 4096 + l) * 64;
#pragma unroll
      for (int hh = 0; hh < 2; ++hh) {
        const int pos = hh ? pcol : prow;
        f32x4 x1 = acc.v[hh * 2][j], x2 = acc.v[hh * 2 + 1][j];
        float o1[4], o2[4];
#pragma unroll
        for (int r = 0; r < 4; ++r) {
          float2 cs = rope[pos * 16 + quad * 4 + r];
          o1[r] = (x1[r] * cs.x - x2[r] * cs.y) * qs;
          o2[r] = (x2[r] * cs.x + x1[r] * cs.y) * qs;
        }
        *(uint2*)(dst + hh * 32 + quad * 4) = make_uint2(pack2(o1[0], o1[1]), pack2(o1[2], o1[3]));
        *(uint2*)(dst + hh * 32 + 16 + quad * 4) = make_uint2(pack2(o2[0], o2[1]), pack2(o2[2], o2[3]));
      }
    }
  } else if (nb < 768) {
    const int g = (nb - 640) >> 6;
    u16* vt = (u16*)(p.ws + OFF_VT);
#pragma unroll
    for (int j = 0; j < 4; ++j) {
      const int m = mb + j * 16 + l15;
      const int b = m >> 12, l = m & 4095;
#pragma unroll
      for (int i = 0; i < 4; ++i)
#pragma unroll
        for (int r = 0; r < 4; ++r) {
          const int d = i * 16 + quad * 4 + r;
          vt[((size_t)(b * 2 + g) * 64 + d) * 4096 + l] = f2bf(acc.v[i][j][r]);
        }
    }
  } else if (nb < 2304) {
    u16* z = (u16*)(p.ws + OFF_Z);
#pragma unroll
    for (int j = 0; j < 4; ++j) {
      const int m = mb + j * 16 + l15;
#pragma unroll
      for (int i = 0; i < 4; ++i) {
        const int n = nb - 768 + i * 16 + quad * 4;
        f32x4 a = acc.v[i][j];
        *(uint2*)(z + (size_t)m * 1536 + n) = make_uint2(pack2(a[0], a[1]), pack2(a[2], a[3]));
      }
    }
  } else {
    u16* gt = (u16*)(p.ws + OFF_GATE);
#pragma unroll
    for (int j = 0; j < 4; ++j) {
      const int m = mb + j * 16 + l15;
#pragma unroll
      for (int i = 0; i < 4; ++i) {
        const int n = nb - 2304 + i * 16 + quad * 4;
        f32x4 a = acc.v[i][j];
        float s0 = 1.f / (1.f + __expf(-a[0])), s1 = 1.f / (1.f + __expf(-a[1]));
        float s2 = 1.f / (1.f + __expf(-a[2])), s3 = 1.f / (1.f + __expf(-a[3]));
        *(uint2*)(gt + (size_t)m * 2048 + n) = make_uint2(pack2(s0, s1), pack2(s2, s3));
      }
    }
  }
}

DEV void p2_ctxkv(const Params& p, int tile, u16* sA, u16* sB) {
  const int mt = tile >> 1, nt = tile & 1;
  const int m0 = mt * 128, n0 = nt * 128;
  Acc acc; acc_zero(acc);
  gemm_kloop((const u16*)((const char*)p.out + OO_HC), 1024, (const u16*)(p.ws + OFF_WIN) + (size_t)512 * 1024, 1024, 1024, m0, n0, sA, sB, acc);
  const int tid = threadIdx.x, lane = tid & 63, wave = tid >> 6, wm = wave >> 1, wn = wave & 1;
  const int l15 = lane & 15, quad = lane >> 4;
  const int mb = m0 + wm * 64, nb = n0 + wn * 64;
  const int g = (nb >> 6) & 1;
  if (nb < 128) {
    u16* kc = (u16*)(p.ws + OFF_KC);
#pragma unroll
    for (int j = 0; j < 4; ++j) {
      const int m = mb + j * 16 + l15;
      const int b = m >> 8, c = m & 255;
#pragma unroll
      for (int i = 0; i < 4; ++i) {
        f32x4 a = acc.v[i][j];
        *(uint2*)(kc + ((size_t)(b * 2 + g) * 256 + c) * 64 + i * 16 + quad * 4) = make_uint2(pack2(a[0], a[1]), pack2(a[2], a[3]));
      }
    }
  } else {
    u16* vct = (u16*)(p.ws + OFF_VCT);
#pragma unroll
    for (int j = 0; j < 4; ++j) {
      const int m = mb + j * 16 + l15;
      const int b = m >> 8, c = m & 255;
#pragma unroll
      for (int i = 0; i < 4; ++i)
#pragma unroll
        for (int r = 0; r < 4; ++r) {
          const int d = i * 16 + quad * 4 + r;
          vct[((size_t)(b * 2 + g) * 64 + d) * 256 + c] = f2bf(acc.v[i][j][r]);
        }
    }
  }
}

DEV void p3_attn(const Params& p, int item, u16* sK, u16* sVt) {
  const int tid = threadIdx.x, lane = tid & 63, wave = tid >> 6, l15 = lane & 15, quad = lane >> 4;
  const int n = item & 31, h = (item >> 5) & 7, b = item >> 8;
  const int g = h >> 2;
  const u16* Q = (const u16*)(p.ws + OFF_Q) + ((size_t)(b * 8 + h) * 4096 + n * 128 + wave * 32) * 64;
  bf16x8 bq[2][2];
#pragma unroll
  for (int qt = 0; qt < 2; ++qt)
#pragma unroll
    for (int ks = 0; ks < 2; ++ks) bq[qt][ks] = *(const bf16x8*)(Q + (qt * 16 + l15) * 64 + ks * 32 + quad * 8);
  const float sink = p.attn_sink[h];
  float mrun[2] = {sink, sink};
  float lrun[2];
  lrun[0] = lrun[1] = (quad == 0) ? 1.f : 0.f;
  f32x4 O[4][2];
#pragma unroll
  for (int dt = 0; dt < 4; ++dt)
#pragma unroll
    for (int qt = 0; qt < 2; ++qt) O[dt][qt] = (f32x4){0.f, 0.f, 0.f, 0.f};

  for (int kb = 0; kb < 5; ++kb) {
    const u16* Ksrc;
    const u16* Vsrc;
    int vstride;
    if (kb < 3) {
      const int nbk = n + kb - 1;
      if (nbk < 0 || nbk >= 32) continue;
      Ksrc = (const u16*)(p.ws + OFF_K) + ((size_t)(b * 2 + g) * 4096 + nbk * 128) * 64;
      Vsrc = (const u16*)(p.ws + OFF_VT) + (size_t)(b * 2 + g) * 64 * 4096 + nbk * 128;
      vstride = 4096;
    } else {
      const int cb = kb - 3;
      Ksrc = (const u16*)(p.ws + OFF_KC) + ((size_t)(b * 2 + g) * 256 + cb * 128) * 64;
      Vsrc = (const u16*)(p.ws + OFF_VCT) + (size_t)(b * 2 + g) * 64 * 256 + cb * 128;
      vstride = 256;
    }
#pragma unroll
    for (int i = 0; i < 4; ++i) {
      const int id = tid + i * 256;
      const int kr = id >> 3, kc8 = id & 7;
      *(uint4*)(sK + kr * 72 + kc8 * 8) = *(const uint4*)(Ksrc + kr * 64 + kc8 * 8);
      const int vr = id >> 4, vc = id & 15;
      *(uint4*)(sVt + vr * 136 + vc * 8) = *(const uint4*)(Vsrc + (size_t)vr * vstride + vc * 8);
    }
    __syncthreads();
#pragma unroll 1
    for (int c4 = 0; c4 < 4; ++c4) {
      f32x4 s[2][2];
#pragma unroll
      for (int kt = 0; kt < 2; ++kt) {
        bf16x8 ak0 = *(const bf16x8*)(sK + (c4 * 32 + kt * 16 + l15) * 72 + quad * 8);
        bf16x8 ak1 = *(const bf16x8*)(sK + (c4 * 32 + kt * 16 + l15) * 72 + 32 + quad * 8);
#pragma unroll
        for (int qt = 0; qt < 2; ++qt) {
          f32x4 z = (f32x4){0.f, 0.f, 0.f, 0.f};
          z = __builtin_amdgcn_mfma_f32_16x16x32_bf16(ak0, bq[qt][0], z, 0, 0, 0);
          z = __builtin_amdgcn_mfma_f32_16x16x32_bf16(ak1, bq[qt][1], z, 0, 0, 0);
          s[kt][qt] = z;
        }
      }
      if (kb == 0 || kb == 2) {
#pragma unroll
        for (int kt = 0; kt < 2; ++kt)
#pragma unroll
          for (int qt = 0; qt < 2; ++qt)
#pragma unroll
            for (int r = 0; r < 4; ++r) {
              const int kk = c4 * 32 + kt * 16 + quad * 4 + r;
              const int qq = wave * 32 + qt * 16 + l15;
              const bool valid = (kb == 0) ? (kk >= qq) : (kk <= qq);
              if (!valid) s[kt][qt][r] = -INFINITY;
            }
      }
      bf16x8 bp[2];
#pragma unroll
      for (int qt = 0; qt < 2; ++qt) {
        float cm = fmaxf(fmaxf(fmaxf(s[0][qt][0], s[0][qt][1]), fmaxf(s[0][qt][2], s[0][qt][3])),
                         fmaxf(fmaxf(s[1][qt][0], s[1][qt][1]), fmaxf(s[1][qt][2], s[1][qt][3])));
        cm = fmaxf(cm, __shfl_xor(cm, 16));
        cm = fmaxf(cm, __shfl_xor(cm, 32));
        const float mnew = fmaxf(mrun[qt], cm);
        const float alpha = __expf(mrun[qt] - mnew);
        mrun[qt] = mnew;
        float ps = 0.f;
        float pv[8];
#pragma unroll
        for (int r = 0; r < 4; ++r) {
          pv[r] = __expf(s[0][qt][r] - mnew);
          pv[4 + r] = __expf(s[1][qt][r] - mnew);
          ps += pv[r] + pv[4 + r];
        }
        lrun[qt] = lrun[qt] * alpha + ps;
#pragma unroll
        for (int dt = 0; dt < 4; ++dt) {
          O[dt][qt][0] *= alpha; O[dt][qt][1] *= alpha; O[dt][qt][2] *= alpha; O[dt][qt][3] *= alpha;
        }
        union { bf16x8 v; unsigned u[4]; } pk;
        pk.u[0] = pack2(pv[0], pv[1]); pk.u[1] = pack2(pv[2], pv[3]);
        pk.u[2] = pack2(pv[4], pv[5]); pk.u[3] = pack2(pv[6], pv[7]);
        bp[qt] = pk.v;
      }
#pragma unroll
      for (int dt = 0; dt < 4; ++dt) {
        union { bf16x8 v; uint2 h[2]; } av;
        const u16* vrow = sVt + (dt * 16 + l15) * 136 + c4 * 32 + quad * 4;
        av.h[0] = *(const uint2*)(vrow);
        av.h[1] = *(const uint2*)(vrow + 16);
#pragma unroll
        for (int qt = 0; qt < 2; ++qt) O[dt][qt] = __builtin_amdgcn_mfma_f32_16x16x32_bf16(av.v, bp[qt], O[dt][qt], 0, 0, 0);
      }
    }
    __syncthreads();
  }
  u16* Y = (u16*)(p.ws + OFF_YATT);
#pragma unroll
  for (int qt = 0; qt < 2; ++qt) {
    float l = lrun[qt];
    l += __shfl_xor(l, 16);
    l += __shfl_xor(l, 32);
    const float inv = 1.f / l;
    const int t = b * 4096 + n * 128 + wave * 32 + qt * 16 + l15;
#pragma unroll
    for (int dt = 0; dt < 4; ++dt) {
      f32x4 o = O[dt][qt];
      *(uint2*)(Y + (size_t)t * 512 + h * 64 + dt * 16 + quad * 4) = make_uint2(pack2(o[0] * inv, o[1] * inv), pack2(o[2] * inv, o[3] * inv));
    }
  }
}

DEV void p3_hypre(const Params& p, int item, u16* sm) {
  const int tid = threadIdx.x;
  const int cb = item & 7, tb = (item >> 3) & 63, b = item >> 9;
  const int tq = tid >> 6, ch = tid & 63;
  const int c = cb * 64 + ch;
  u16* su = sm;
  u16* sx = sm + 64 * 66;
  float w[3][3], bias[3];
#pragma unroll
  for (int s = 0; s < 3; ++s) {
#pragma unroll
    for (int k = 0; k < 3; ++k) w[s][k] = p.hy_conv_w[k * 1536 + s * 512 + c];
    bias[s] = p.hy_conv_b[s * 512 + c];
  }
  const u16* Z = (const u16*)(p.ws + OFF_Z) + (size_t)b * 4096 * 1536;
  const int l0 = tb * 64 + tq * 16;
  float prev[3], cur[3], nxt[3];
#pragma unroll
  for (int s = 0; s < 3; ++s) {
    prev[s] = (l0 > 0) ? bf2f(Z[(size_t)(l0 - 1) * 1536 + s * 512 + c]) : 0.f;
    cur[s] = bf2f(Z[(size_t)l0 * 1536 + s * 512 + c]);
  }
  for (int i = 0; i < 16; ++i) {
    const int l = l0 + i;
#pragma unroll
    for (int s = 0; s < 3; ++s) nxt[s] = (l + 1 < 4096) ? bf2f(Z[(size_t)(l + 1) * 1536 + s * 512 + c]) : 0.f;
    float cv[3];
#pragma unroll
    for (int s = 0; s < 3; ++s) cv[s] = prev[s] * w[s][0] + cur[s] * w[s][1] + nxt[s] * w[s][2] + bias[s];
    su[ch * 66 + tq * 16 + i] = f2bf(cv[2] * cv[1]);
    sx[ch * 66 + tq * 16 + i] = f2bf(cv[0]);
#pragma unroll
    for (int s = 0; s < 3; ++s) { prev[s] = cur[s]; cur[s] = nxt[s]; }
  }
  __syncthreads();
  const int chr = tid >> 2, part = tid & 3;
  const int cc = cb * 64 + chr;
  const unsigned* ru = (const unsigned*)(su + chr * 66 + part * 16);
  const unsigned* rx = (const unsigned*)(sx + chr * 66 + part * 16);
  u16* UT = (u16*)((char*)p.out + OO_UT) + ((size_t)(cc * 4 + b) * 4096 + tb * 64 + part * 16);
  u16* XT = (u16*)((char*)p.out + OO_X0T) + ((size_t)(cc * 4 + b) * 4096 + tb * 64 + part * 16);
  ((uint4*)UT)[0] = make_uint4(ru[0], ru[1], ru[2], ru[3]);
  ((uint4*)UT)[1] = make_uint4(ru[4], ru[5], ru[6], ru[7]);
  ((uint4*)XT)[0] = make_uint4(rx[0], rx[1], rx[2], rx[3]);
  ((uint4*)XT)[1] = make_uint4(rx[4], rx[5], rx[6], rx[7]);
  __syncthreads();
}

DEV void p3_toeplitz(const Params& p, int c, char* smem) {
  const int tid = threadIdx.x, lane = tid & 63, wave = tid >> 6, l15 = lane & 15, quad = lane >> 4;
  u16* sG0 = (u16*)smem;
  u16* sG1 = (u16*)(smem + 16384 + 64);
  u16* sU = (u16*)(smem + 32768 + 128);
  u16* sZ = sU + 4 * 64 * 72;
  const u16* G = (const u16*)((const char*)p.out + OO_G) + (size_t)c * 8192;
  const u16* UT = (const u16*)((const char*)p.out + OO_UT) + (size_t)c * 16384;
#pragma unroll
  for (int i = 0; i < 4; ++i) {
    const int id = tid + i * 256;
    *(uint4*)(sG0 + id * 8) = *(const uint4*)(G + id * 8);
  }
#pragma unroll
  for (int i = 0; i < 8; ++i) {
    const int id = tid + i * 256;
    const int bb = id >> 9, blk = (id >> 3) & 63, c8 = id & 7;
    *(uint4*)(sU + (bb * 64 + blk) * 72 + c8 * 8) = *(const uint4*)(UT + id * 8);
  }
  if (tid < 72) sZ[tid] = 0;
  __syncthreads();
  for (int i = tid; i < 8192; i += 256) sG1[i] = (i < 8191) ? sG0[i + 1] : (u16)0;
  __syncthreads();

  Acc acc; acc_zero(acc);
  const u16* gbase = (l15 & 1) ? sG0 : (sG1 - 1);
  const u16* ubase = sU + wave * 64 * 72 + quad * 8;
  const u16* zbase = sZ + quad * 8;
  for (int d = -63; d <= 63; ++d) {
    const int base = 4095 - 64 * d - l15 + quad * 8;
    bf16x8 af[4][2];
#pragma unroll
    for (int mt = 0; mt < 4; ++mt)
#pragma unroll
      for (int ks = 0; ks < 2; ++ks) {
        const unsigned* gp = (const unsigned*)(gbase + base - mt * 16 + ks * 32);
        union { bf16x8 v; unsigned u[4]; } t;
        t.u[0] = gp[0]; t.u[1] = gp[1]; t.u[2] = gp[2]; t.u[3] = gp[3];
        af[mt][ks] = t.v;
      }
#pragma unroll
    for (int nt = 0; nt < 4; ++nt) {
      if (nt * 16 + 15 - d < 0 || nt * 16 - d > 63) continue;
      const int ip = nt * 16 + l15 - d;
      const u16* up = (ip >= 0 && ip < 64) ? (ubase + ip * 72) : zbase;
      bf16x8 b0 = *(const bf16x8*)(up);
      bf16x8 b1 = *(const bf16x8*)(up + 32);
#pragma unroll
      for (int mt = 0; mt < 4; ++mt) {
        acc.v[mt][nt] = __builtin_amdgcn_mfma_f32_16x16x32_bf16(af[mt][0], b0, acc.v[mt][nt], 0, 0, 0);
        acc.v[mt][nt] = __builtin_amdgcn_mfma_f32_16x16x32_bf16(af[mt][1], b1, acc.v[mt][nt], 0, 0, 0);
      }
    }
  }
  const float ninv = ((const float*)(p.ws + OFF_NINV))[c];
  const float skip = p.hy_skip[c];
  const u16* XT = (const u16*)((const char*)p.out + OO_X0T) + ((size_t)(c * 4 + wave) * 4096);
  u16* Y = (u16*)(p.ws + OFF_YHY);
#pragma unroll
  for (int nt = 0; nt < 4; ++nt) {
    const int ib = nt * 16 + l15;
#pragma unroll
    for (int mt = 0; mt < 4; ++mt) {
      const int r0 = mt * 16 + quad * 4;
      const int t = ib * 64 + r0;
      uint2 uu = *(const uint2*)(sU + (wave * 64 + ib) * 72 + r0);
      uint2 xx = *(const uint2*)(XT + t);
      float uv[4] = {bflo(uu.x), bfhi(uu.x), bflo(uu.y), bfhi(uu.y)};
      float xv[4] = {bflo(xx.x), bfhi(xx.x), bflo(xx.y), bfhi(xx.y)};
#pragma unroll
      for (int r = 0; r < 4; ++r) {
        float y = acc.v[mt][nt][r] * ninv + uv[r] * skip;
        Y[(size_t)(wave * 4096 + t + r) * 512 + c] = f2bf(y * xv[r]);
      }
    }
  }
  __syncthreads();
}

DEV void p4_merge(const Params& p, int tile, u16* sA, u16* sB) {
  const int mt = tile >> 3, nt = tile & 7;
  const int m0 = mt * 128, n0 = nt * 128;
  const int tid = threadIdx.x, lane = tid & 63, wave = tid >> 6, wm = wave >> 1, wn = wave & 1;
  const int l15 = lane & 15, quad = lane >> 4;
  const int mb = m0 + wm * 64, nb = n0 + wn * 64;
  const u16* gt = (const u16*)(p.ws + OFF_GATE);
  u16* mg = (u16*)(p.ws + OFF_MERGED);
  Acc a1; acc_zero(a1);
  gemm_kloop((const u16*)(p.ws + OFF_YATT), 512, (const u16*)(p.ws + OFF_WOA), 512, 512, m0, n0, sA, sB, a1);
  asm volatile("" ::: "memory");
#pragma unroll
  for (int j = 0; j < 4; ++j) {
    const int m = mb + j * 16 + l15;
#pragma unroll
    for (int i = 0; i < 4; ++i) {
      const int n = nb + i * 16 + quad * 4;
      uint2 ga = *(const uint2*)(gt + (size_t)m * 2048 + n);
      f32x4 x = a1.v[i][j];
      *(uint2*)(mg + (size_t)m * 1024 + n) = make_uint2(pack2(bflo(ga.x) * x[0], bfhi(ga.x) * x[1]), pack2(bflo(ga.y) * x[2], bfhi(ga.y) * x[3]));
    }
  }
  asm volatile("" ::: "memory");
  acc_zero(a1);
  gemm_kloop((const u16*)(p.ws + OFF_YHY), 512, (const u16*)(p.ws + OFF_WOH), 512, 512, m0, n0, sA, sB, a1);
  asm volatile("" ::: "memory");
#pragma unroll
  for (int j = 0; j < 4; ++j) {
    const int m = mb + j * 16 + l15;
#pragma unroll
    for (int i = 0; i < 4; ++i) {
      const int n = nb + i * 16 + quad * 4;
      uint2 gh = *(const uint2*)(gt + (size_t)m * 2048 + 1024 + n);
      uint2 pv = *(const uint2*)(mg + (size_t)m * 1024 + n);
      f32x4 y = a1.v[i][j];
      float o0 = bflo(pv.x) + bflo(gh.x) * y[0];
      float o1 = bfhi(pv.x) + bfhi(gh.x) * y[1];
      float o2 = bflo(pv.y) + bflo(gh.y) * y[2];
      float o3 = bfhi(pv.y) + bfhi(gh.y) * y[3];
      *(uint2*)(mg + (size_t)m * 1024 + n) = make_uint2(pack2(o0, o1), pack2(o2, o3));
    }
  }
}

DEV void p5_out(const Params& p, int tile, u16* sA, u16* sB) {
  const int mt = tile >> 3, nt = tile & 7;
  const int m0 = mt * 128, n0 = nt * 128;
  Acc acc; acc_zero(acc);
  gemm_kloop((const u16*)(p.ws + OFF_MERGED), 1024, (const u16*)(p.ws + OFF_WOUT), 1024, 1024, m0, n0, sA, sB, acc);
  const int tid = threadIdx.x, lane = tid & 63, wave = tid >> 6, wm = wave >> 1, wn = wave & 1;
  const int l15 = lane & 15, quad = lane >> 4;
  const int mb = m0 + wm * 64, nb = n0 + wn * 64;
  const float* mod = (const float*)(p.ws + OFF_MOD);
#pragma unroll
  for (int j = 0; j < 4; ++j) {
    const int m = mb + j * 16 + l15;
    const int b = m >> 12;
#pragma unroll
    for (int i = 0; i < 4; ++i) {
      const int n = nb + i * 16 + quad * 4;
      float4 g1 = *(const float4*)(mod + b * 6144 + 2048 + n);
      float4 xv = *(const float4*)(p.x + (size_t)m * 1024 + n);
      f32x4 a = acc.v[i][j];
      float4 o = make_float4(xv.x + g1.x * a[0], xv.y + g1.y * a[1], xv.z + g1.z * a[2], xv.w + g1.w * a[3]);
      *(float4*)(p.out + (size_t)m * 1024 + n) = o;
    }
  }
}

DEV void p7_qp(const Params& p, int tile, u16* sA, u16* sB) {
  const int mt = tile >> 3, nt = tile & 7;
  const int m0 = mt * 128, n0 = nt * 128;
  Acc acc; acc_zero(acc);
  gemm_kloop((const u16*)(p.ws + OFF_H2), 1024, (const u16*)(p.ws + OFF_WQ), 1024, 1024, m0, n0, sA, sB, acc);
  const int tid = threadIdx.x, lane = tid & 63, wave = tid >> 6, wm = wave >> 1, wn = wave & 1;
  const int l15 = lane & 15, quad = lane >> 4;
  const int mb = m0 + wm * 64, nb = n0 + wn * 64;
  u16* qp = (u16*)(p.ws + OFF_QP);
#pragma unroll
  for (int j = 0; j < 4; ++j) {
    const int m = mb + j * 16 + l15;
#pragma unroll
    for (int i = 0; i < 4; ++i) {
      const int n = nb + i * 16 + quad * 4;
      f32x4 a = acc.v[i][j];
      *(uint2*)(qp + (size_t)m * 1024 + n) = make_uint2(pack2(a[0], a[1]), pack2(a[2], a[3]));
    }
  }
}

DEV unsigned f2ord(float f) {
  const unsigned u = __float_as_uint(f);
  return u ^ (((int)u >> 31) | 0x80000000u);
}
DEV float ord2f(unsigned k) {
  const unsigned m = (k & 0x80000000u) ? 0x80000000u : 0xffffffffu;
  return __uint_as_float(k ^ m);
}
DEV unsigned umax_(unsigned a, unsigned b) { return a > b ? a : b; }
DEV unsigned umin_(unsigned a, unsigned b) { return a < b ? a : b; }

DEV void sort16_desc(unsigned (&v)[16]) {
#pragma unroll
  for (int k = 2; k <= 16; k <<= 1)
#pragma unroll
    for (int j = k >> 1; j > 0; j >>= 1)
#pragma unroll
      for (int i = 0; i < 16; ++i) {
        const int l = i ^ j;
        if (l > i) {
          const bool desc = ((i & k) == 0);
          const unsigned a = v[i], b = v[l];
          const unsigned hi = umax_(a, b), lo = umin_(a, b);
          v[i] = desc ? hi : lo;
          v[l] = desc ? lo : hi;
        }
      }
}
DEV void merge16_desc(unsigned (&v)[16]) {
#pragma unroll
  for (int j = 8; j > 0; j >>= 1)
#pragma unroll
    for (int i = 0; i < 16; ++i) {
      const int l = i ^ j;
      if (l > i) {
        const unsigned a = v[i], b = v[l];
        v[i] = umax_(a, b);
        v[l] = umin_(a, b);
      }
    }
}
DEV void xmerge16(unsigned (&v)[16], int off) {
  unsigned pr[16];
#pragma unroll
  for (int i = 0; i < 16; ++i) pr[i] = (unsigned)__shfl_xor((int)v[i], off);
#pragma unroll
  for (int i = 0; i < 16; ++i) v[i] = umax_(v[i], pr[15 - i]);
  merge16_desc(v);
}

DEV void route_top16_of_128(const u16* __restrict__ keys, const u16* __restrict__ qp, int l15, int quad, unsigned (&out)[16]) {
  bf16x8 b0 = *(const bf16x8*)(qp);
  bf16x8 b1 = *(const bf16x8*)(qp + 32);
  unsigned ka[16], kb[16];
#pragma unroll
  for (int kt = 0; kt < 8; ++kt) {
    bf16x8 a0 = *(const bf16x8*)(keys + (kt * 16 + l15) * 64 + quad * 8);
    bf16x8 a1 = *(const bf16x8*)(keys + (kt * 16 + l15) * 64 + 32 + quad * 8);
    f32x4 z = (f32x4){0.f, 0.f, 0.f, 0.f};
    z = __builtin_amdgcn_mfma_f32_16x16x32_bf16(a0, b0, z, 0, 0, 0);
    z = __builtin_amdgcn_mfma_f32_16x16x32_bf16(a1, b1, z, 0, 0, 0);
#pragma unroll
    for (int r = 0; r < 4; ++r) {
      const unsigned key = (f2ord(z[r]) & ~127u) | (unsigned)(kt * 16 + quad * 4 + r);
      if (kt < 4) ka[kt * 4 + r] = key; else kb[(kt - 4) * 4 + r] = key;
    }
  }
  sort16_desc(ka);
  sort16_desc(kb);
#pragma unroll
  for (int i = 0; i < 16; ++i) out[i] = umax_(ka[i], kb[15 - i]);
  merge16_desc(out);
  xmerge16(out, 16);
  xmerge16(out, 32);
}

DEV void p8_route(const Params& p, int task, char* wsm) {
  static constexpr unsigned char kTab[52] = {
      0x00, 0x01, 0x02, 0x03, 0x04, 0x05, 0x06, 0x07, 0x08, 0x09, 0x0A, 0x0B, 0x0C, 0x0D, 0x0E, 0x0F,
      0x10, 0x11, 0x12, 0x13, 0x14, 0x15, 0x16, 0x17, 0x20, 0x21, 0x22, 0x23, 0x24, 0x30, 0x31, 0x32, 0x33,
      0x40, 0x41, 0x42, 0x50, 0x51, 0x60, 0x61, 0x70, 0x71, 0x80, 0x90, 0xA0, 0xB0, 0xC0, 0xD0, 0xE0, 0xF0, 0x00, 0x00};
  const int lane = threadIdx.x & 63, l15 = lane & 15, quad = lane >> 4;
  const int h = task & 7, tt = task >> 3;
  const int t0 = tt * 16;
  float* s1v = (float*)wsm;
  float* s2v = s1v + 256;
  int* i1 = (int*)(s2v + 256);
  int* i2 = i1 + 256;
  const u16* keys = (const u16*)(p.ws + OFF_KEYS) + (size_t)(h * 2) * 128 * 64;
  const u16* qp = (const u16*)(p.ws + OFF_QP) + (size_t)(t0 + l15) * 1024 + h * 128 + quad * 8;
  unsigned l1[16], l2[16];
  route_top16_of_128(keys, qp, l15, quad, l1);
  route_top16_of_128(keys + 128 * 64, qp + 64, l15, quad, l2);
  if (quad == 0) {
#pragma unroll
    for (int i = 0; i < 16; ++i) { s1v[l15 * 16 + i] = ord2f(l1[i] & ~127u); i1[l15 * 16 + i] = (int)(l1[i] & 127u); }
  } else if (quad == 1) {
#pragma unroll
    for (int i = 0; i < 16; ++i) { s2v[l15 * 16 + i] = ord2f(l2[i] & ~127u); i2[l15 * 16 + i] = (int)(l2[i] & 127u); }
  }
  __builtin_amdgcn_fence(__ATOMIC_RELEASE, "wavefront");
  __builtin_amdgcn_wave_barrier();
  __builtin_amdgcn_fence(__ATOMIC_ACQUIRE, "wavefront");
  unsigned ck[16];
#pragma unroll
  for (int s = 0; s < 16; ++s) {
    const int c = quad + 4 * s;
    unsigned key = 0u;
    if (s < 13 && c < 50) {
      const unsigned ab = kTab[c];
      const float val = s1v[l15 * 16 + (ab >> 4)] + s2v[l15 * 16 + (ab & 15)];
      key = (f2ord(val) & ~255u) | ab;
    }
    ck[s] = key;
  }
  sort16_desc(ck);
  xmerge16(ck, 16);
  xmerge16(ck, 32);
  if (quad == 0) {
    float e[16];
    const float vmax = ord2f(ck[0] & ~255u);
    float ssum = 0.f;
#pragma unroll
    for (int i = 0; i < 16; ++i) { e[i] = __expf(ord2f(ck[i] & ~255u) - vmax); ssum += e[i]; }
    const float inv = 1.f / ssum;
    int* ridx = (int*)(p.ws + OFF_RIDX) + (size_t)(t0 + l15) * 128 + h * 16;
    float* rw = (float*)(p.ws + OFF_RW) + (size_t)(t0 + l15) * 128 + h * 16;
#pragma unroll
    for (int i = 0; i < 16; i += 4) {
      int ee[4]; float ww[4];
#pragma unroll
      for (int j = 0; j < 4; ++j) {
        const unsigned ab = ck[i + j] & 255u;
        ee[j] = i1[l15 * 16 + (ab >> 4)] * 128 + i2[l15 * 16 + (ab & 15)];
        ww[j] = e[i + j] * inv;
      }
      *(int4*)(ridx + i) = make_int4(ee[0], ee[1], ee[2], ee[3]);
      *(float4*)(rw + i) = make_float4(ww[0], ww[1], ww[2], ww[3]);
    }
  }
  __builtin_amdgcn_fence(__ATOMIC_RELEASE, "wavefront");
  __builtin_amdgcn_wave_barrier();
}

DEV float gelu_tanh(float x) {
  const float u = 0.7978845608028654f * (x + 0.044715f * x * x * x);
  return 0.5f * x * (1.f + tanhf(u));
}

DEV void unpack8(const uint4& q, float* f) {
  f[0] = bflo(q.x); f[1] = bfhi(q.x); f[2] = bflo(q.y); f[3] = bfhi(q.y);
  f[4] = bflo(q.z); f[5] = bfhi(q.z); f[6] = bflo(q.w); f[7] = bfhi(q.w);
}

DEV float dpp_add(float v, const int ctrl_sel) {
  return v;
}
typedef __attribute__((ext_vector_type(2))) __bf16 bf2_t;
DEV float dot2bf(unsigned a, unsigned b, float c) {
  return __builtin_amdgcn_fdot2_f32_bf16(__builtin_bit_cast(bf2_t, a), __builtin_bit_cast(bf2_t, b), c, false);
}
#define DPP_ADD(v, ctrl) ((v) + __builtin_bit_cast(float, __builtin_amdgcn_update_dpp(0, __builtin_bit_cast(int, (v)), (ctrl), 0xF, 0xF, true)))

DEV void p9_experts4(const Params& p, int task, char* wsm) {
  const int lane = threadIdx.x & 63;
  const int t0 = task * 4;
  int* hist = (int*)wsm;
  unsigned* skey = (unsigned*)(wsm + 1024);
  float* swt = (float*)(wsm + 1024 + 2048);
  u16* sh2 = (u16*)(wsm + 1024 + 4096);
  hist[lane] = 0; hist[lane + 64] = 0; hist[lane + 128] = 0; hist[lane + 192] = 0;
  const int* ridx = (const int*)(p.ws + OFF_RIDX) + (size_t)t0 * 128 + lane * 8;
  const float* rw = (const float*)(p.ws + OFF_RW) + (size_t)t0 * 128 + lane * 8;
  int4 ea = *(const int4*)(ridx), eb = *(const int4*)(ridx + 4);
  float4 wa = *(const float4*)(rw), wb = *(const float4*)(rw + 4);
  int e[8] = {ea.x, ea.y, ea.z, ea.w, eb.x, eb.y, eb.z, eb.w};
  float w[8] = {wa.x, wa.y, wa.z, wa.w, wb.x, wb.y, wb.z, wb.w};
  {
    const u16* h2 = (const u16*)(p.ws + OFF_H2) + (size_t)t0 * 1024;
#pragma unroll
    for (int i = 0; i < 8; ++i) *(u32x4*)(sh2 + (lane + 64 * i) * 8) = *(const u32x4*)(h2 + (lane + 64 * i) * 8);
  }
  __builtin_amdgcn_fence(__ATOMIC_RELEASE, "wavefront");
  __builtin_amdgcn_wave_barrier();
  __builtin_amdgcn_fence(__ATOMIC_ACQUIRE, "wavefront");
  int rank[8];
#pragma unroll
  for (int j = 0; j < 8; ++j) rank[j] = atomicAdd(&hist[e[j] >> 6], 1);
  __builtin_amdgcn_fence(__ATOMIC_RELEASE, "wavefront");
  __builtin_amdgcn_wave_barrier();
  __builtin_amdgcn_fence(__ATOMIC_ACQUIRE, "wavefront");
  {
    const int c0 = hist[4 * lane], c1 = hist[4 * lane + 1], c2 = hist[4 * lane + 2], c3 = hist[4 * lane + 3];
    const int tot = c0 + c1 + c2 + c3;
    int x = tot;
#pragma unroll
    for (int o = 1; o < 64; o <<= 1) { const int y = __shfl_up(x, o); if (lane >= o) x += y; }
    const int base = x - tot;
    __builtin_amdgcn_fence(__ATOMIC_RELEASE, "wavefront");
    __builtin_amdgcn_wave_barrier();
    hist[4 * lane] = base; hist[4 * lane + 1] = base + c0; hist[4 * lane + 2] = base + c0 + c1; hist[4 * lane + 3] = base + c0 + c1 + c2;
  }
  __builtin_amdgcn_fence(__ATOMIC_RELEASE, "wavefront");
  __builtin_amdgcn_wave_barrier();
  __builtin_amdgcn_fence(__ATOMIC_ACQUIRE, "wavefront");
  {
    const unsigned slot = (unsigned)(lane >> 4);
#pragma unroll
    for (int j = 0; j < 8; ++j) {
      const int pos = hist[e[j] >> 6] + rank[j];
      skey[pos] = (unsigned)e[j] | (slot << 14);
      swt[pos] = w[j];
    }
  }
  __builtin_amdgcn_fence(__ATOMIC_RELEASE, "wavefront");
  __builtin_amdgcn_wave_barrier();
  __builtin_amdgcn_fence(__ATOMIC_ACQUIRE, "wavefront");

  float o0[16], o1[16], o2[16], o3[16];
#pragma unroll
  for (int k = 0; k < 16; ++k) { o0[k] = 0.f; o1[k] = 0.f; o2[k] = 0.f; o3[k] = 0.f; }
  const u16* U = (const u16*)(p.ws + OFF_UBF);
  const u16* V = (const u16*)(p.ws + OFF_VBF);
#define P9_LOADU(KK, UA, UB, BB)                                                          \
  _Pragma("unroll") for (int i = 0; i < 4; ++i) {                                         \
    KK[i] = (unsigned)__builtin_amdgcn_readfirstlane((int)skey[4 * (BB) + i]);            \
    const u16* ur = U + (size_t)(KK[i] & 16383u) * 1024;                                  \
    UA[i] = *(const u32x4*)(ur + 8 * lane);                                               \
    UB[i] = *(const u32x4*)(ur + 512 + 8 * lane);                                         \
  }
#define P9_LOADV(KK, VA, VB)                                                              \
  _Pragma("unroll") for (int i = 0; i < 4; ++i) {                                         \
    const u16* vr = V + (size_t)(KK[i] & 16383u) * 1024;                                  \
    VA[i] = *(const u32x4*)(vr + 8 * lane);                                               \
    VB[i] = *(const u32x4*)(vr + 512 + 8 * lane);                                         \
  }
#define P9_DOTS(KK, UA, UB, BB, COEFV)                                                    \
  {                                                                                       \
    const float myw = swt[4 * (BB) + (lane >> 4)];                                        \
    float d[4];                                                                           \
    _Pragma("unroll") for (int i = 0; i < 4; ++i) {                                       \
      const unsigned slot = KK[i] >> 14;                                                  \
      const u32x4 ha = *(const u32x4*)(sh2 + slot * 1024 + 8 * lane);                     \
      const u32x4 hb = *(const u32x4*)(sh2 + slot * 1024 + 512 + 8 * lane);               \
      float acc0 = 0.f, acc1 = 0.f, acc2 = 0.f, acc3 = 0.f;                               \
      acc0 = dot2bf(UA[i].x, ha.x, acc0); acc1 = dot2bf(UA[i].y, ha.y, acc1);             \
      acc2 = dot2bf(UA[i].z, ha.z, acc2); acc3 = dot2bf(UA[i].w, ha.w, acc3);             \
      acc0 = dot2bf(UB[i].x, hb.x, acc0); acc1 = dot2bf(UB[i].y, hb.y, acc1);             \
      acc2 = dot2bf(UB[i].z, hb.z, acc2); acc3 = dot2bf(UB[i].w, hb.w, acc3);             \
      acc0 += acc2; acc1 += acc3;                                                         \
      d[i] = acc0 + acc1;                                                                 \
    }                                                                                     \
    const bool up32 = (lane & 32) != 0, up16 = (lane & 16) != 0;                          \
    float k0 = up32 ? d[2] : d[0], k1 = up32 ? d[3] : d[1];                               \
    float s0 = up32 ? d[0] : d[2], s1 = up32 ? d[1] : d[3];                               \
    k0 += __shfl_xor(s0, 32);                                                             \
    k1 += __shfl_xor(s1, 32);                                                             \
    float kq = up16 ? k1 : k0, sq = up16 ? k0 : k1;                                       \
    kq += __shfl_xor(sq, 16);                                                             \
    kq = DPP_ADD(kq, 0xB1);                                                               \
    kq = DPP_ADD(kq, 0x4E);                                                               \
    kq = DPP_ADD(kq, 0x141);                                                              \
    kq = DPP_ADD(kq, 0x140);                                                              \
    COEFV = myw * gelu_tanh(kq);                                                          \
  }
#define P9_ACCUM(KK, VA, VB, COEFV)                                                       \
  _Pragma("unroll") for (int i = 0; i < 4; ++i) {                                         \
    const float ci = __builtin_bit_cast(float, __builtin_amdgcn_readlane(__builtin_bit_cast(int, COEFV), 16 * i)); \
    const unsigned slot = KK[i] >> 14;                                                    \
    float vf[16];                                                                         \
    _Pragma("unroll") for (int q = 0; q < 4; ++q) {                                       \
      vf[2 * q] = bflo(VA[i][q]); vf[2 * q + 1] = bfhi(VA[i][q]);                         \
      vf[8 + 2 * q] = bflo(VB[i][q]); vf[8 + 2 * q + 1] = bfhi(VB[i][q]);                 \
    }                                                                                     \
    if (slot == 0) { _Pragma("unroll") for (int k = 0; k < 16; ++k) o0[k] += ci * vf[k]; }       \
    else if (slot == 1) { _Pragma("unroll") for (int k = 0; k < 16; ++k) o1[k] += ci * vf[k]; }  \
    else if (slot == 2) { _Pragma("unroll") for (int k = 0; k < 16; ++k) o2[k] += ci * vf[k]; }  \
    else { _Pragma("unroll") for (int k = 0; k < 16; ++k) o3[k] += ci * vf[k]; }                 \
  }
  {
    unsigned kkA[4];
    u32x4 uaA[4], ubA[4], vaA[4], vbA[4];
    float cfA;
#pragma unroll 1
    for (int bb = 0; bb < 128; ++bb) {
      P9_LOADU(kkA, uaA, ubA, bb)
      P9_LOADV(kkA, vaA, vbA)
      P9_DOTS(kkA, uaA, ubA, bb, cfA)
      P9_ACCUM(kkA, vaA, vbA, cfA)
    }
  }
#pragma unroll
  for (int s = 0; s < 4; ++s) {
    const int t = t0 + s;
    const int b = t >> 12;
    const float* mod = (const float*)(p.ws + OFF_MOD) + b * 6144 + 5120;
    float* xm = p.out + (size_t)t * 1024;
    float xo[16];
    float ss = 0.f;
#pragma unroll
    for (int hlf = 0; hlf < 2; ++hlf) {
      const int base = hlf * 512 + 8 * lane;
      const float4 x0 = *(const float4*)(xm + base), x1 = *(const float4*)(xm + base + 4);
      const float4 g0 = *(const float4*)(mod + base), g1 = *(const float4*)(mod + base + 4);
      const float* oo = (s == 0) ? o0 : ((s == 1) ? o1 : ((s == 2) ? o2 : o3));
      xo[hlf * 8 + 0] = x0.x + g0.x * oo[hlf * 8 + 0];
      xo[hlf * 8 + 1] = x0.y + g0.y * oo[hlf * 8 + 1];
      xo[hlf * 8 + 2] = x0.z + g0.z * oo[hlf * 8 + 2];
      xo[hlf * 8 + 3] = x0.w + g0.w * oo[hlf * 8 + 3];
      xo[hlf * 8 + 4] = x1.x + g1.x * oo[hlf * 8 + 4];
      xo[hlf * 8 + 5] = x1.y + g1.y * oo[hlf * 8 + 5];
      xo[hlf * 8 + 6] = x1.z + g1.z * oo[hlf * 8 + 6];
      xo[hlf * 8 + 7] = x1.w + g1.w * oo[hlf * 8 + 7];
    }
#pragma unroll
    for (int k = 0; k < 16; ++k) ss += xo[k] * xo[k];
    ss = wave_sum(ss);
    const float r = rsqrtf(ss * (1.f / 1024.f) + 1e-6f);
#pragma unroll
    for (int hlf = 0; hlf < 2; ++hlf) {
      const int base = hlf * 512 + 8 * lane;
      const float4 f0 = *(const float4*)(p.final_g + base), f1 = *(const float4*)(p.final_g + base + 4);
      *(float4*)(xm + base) = make_float4(xo[hlf * 8 + 0] * r * f0.x, xo[hlf * 8 + 1] * r * f0.y, xo[hlf * 8 + 2] * r * f0.z, xo[hlf * 8 + 3] * r * f0.w);
      *(float4*)(xm + base + 4) = make_float4(xo[hlf * 8 + 4] * r * f1.x, xo[hlf * 8 + 5] * r * f1.y, xo[hlf * 8 + 6] * r * f1.z, xo[hlf * 8 + 7] * r * f1.w);
    }
  }
  __builtin_amdgcn_fence(__ATOMIC_RELEASE, "wavefront");
  __builtin_amdgcn_wave_barrier();
}

#define XB_TMO      128
#define XB_XCNT(j)  (256  + 64 * (j))
#define XB_XSUB(j)  (1280 + 64 * (j))
#define XB_XGEN(j)  (2304 + 64 * (j))
#define XB_TOP      3328
#define XB_TOPGEN   3392
#define XCD_BAR_WORDS 3456
#define XB_SPIN_CAP (1u << 18)
#define LAS __attribute__((address_space(3)))

__device__ __forceinline__ unsigned xb_ld(unsigned* p)              { return __hip_atomic_load(p, __ATOMIC_RELAXED, __HIP_MEMORY_SCOPE_AGENT); }
__device__ __forceinline__ unsigned xb_add(unsigned* p, unsigned v) { return __hip_atomic_fetch_add(p, v, __ATOMIC_RELAXED, __HIP_MEMORY_SCOPE_AGENT); }
__device__ __forceinline__ unsigned xb_xcc_id() { return (unsigned)__builtin_amdgcn_s_getreg((3 << 11) | 20) & 0xFu; }
#define XB_SPIN(cond, bar) do { unsigned _sp = 0; while (cond) { __builtin_amdgcn_s_sleep(1); \
    if ((++_sp & 255u) == 0u) { if (xb_ld(&(bar)[XB_TMO])) break; if (_sp > XB_SPIN_CAP) { atomicAdd(&(bar)[XB_TMO], 1u); break; } } } } while (0)

struct XcdBarrier {
    unsigned* bar; unsigned x;
    volatile LAS unsigned* st;
};

__device__ __forceinline__ XcdBarrier xcd_barrier_post(unsigned* bar, volatile LAS unsigned* st) {
    XcdBarrier b; b.bar = bar; b.x = xb_xcc_id(); b.st = st;
    if (threadIdx.x == 0) (void)xb_add(&bar[XB_XCNT(b.x)], 1u);
    return b;
}
__device__ __forceinline__ void xcd_barrier_complete(unsigned* bar, unsigned x, unsigned& nloc, unsigned& nx) {
    const unsigned G = gridDim.x * gridDim.y * gridDim.z;
    unsigned sum, cnt, mine, sp = 0u;
    for (;;) {
        sum = 0u; cnt = 0u; mine = 0u;
#pragma unroll
        for (unsigned j = 0; j < 16; ++j) { const unsigned c = xb_ld(&bar[XB_XCNT(j)]); sum += c; cnt += (c > 0u) ? 1u : 0u; mine = (j == x) ? c : mine; }
        if (sum == G) break;
        __builtin_amdgcn_s_sleep(1);
        if ((++sp & 255u) == 0u) { if (xb_ld(&bar[XB_TMO])) break; if (sp > XB_SPIN_CAP) { atomicAdd(&bar[XB_TMO], 1u); break; } }
    }
    nloc = mine > 0u ? mine : 1u; nx = cnt > 0u ? cnt : 1u;
}

__device__ __forceinline__ void xcd_barrier(const XcdBarrier& b) {
    asm volatile("s_waitcnt vmcnt(0)" ::: "memory");
    __syncthreads();
    if (threadIdx.x == 0) {
        unsigned* bar = b.bar;
        __builtin_amdgcn_s_waitcnt(0);
        unsigned nloc = b.st[0], nx = b.st[1];
        if (nloc == 0u) { xcd_barrier_complete(bar, b.x, nloc, nx); b.st[0] = nloc; b.st[1] = nx; }
        const unsigned old = xb_add(&bar[XB_XSUB(b.x)], 1u);
        const unsigned gen = old / nloc;
        if (old + 1u == (gen + 1u) * nloc) {
            __builtin_amdgcn_fence(__ATOMIC_RELEASE, "agent");
            asm volatile("s_waitcnt vmcnt(0)" ::: "memory");
            const unsigned og = xb_add(&bar[XB_TOP], 1u);
            const unsigned tg = og / nx;
            if (og + 1u == (tg + 1u) * nx) xb_add(&bar[XB_TOPGEN], 1u);
            else XB_SPIN(xb_ld(&bar[XB_TOPGEN]) == tg, bar);
            __builtin_amdgcn_fence(__ATOMIC_ACQUIRE, "agent");
            xb_add(&bar[XB_XGEN(b.x)], 1u);
            asm volatile("s_waitcnt vmcnt(0)" ::: "memory");
        } else {
            XB_SPIN(xb_ld(&bar[XB_XGEN(b.x)]) == gen, bar);
            __builtin_amdgcn_fence(__ATOMIC_ACQUIRE, "agent");
            asm volatile("s_waitcnt vmcnt(0)" ::: "memory");
        }
    }
    __syncthreads();
}


__global__ void __launch_bounds__(256, 2) mega(Params p) {
  extern __shared__ __attribute__((aligned(16))) char smem[];
  cg::grid_group grid = cg::this_grid();
  const int tid = threadIdx.x, lane = tid & 63, wave = tid >> 6;
  const int nb = gridDim.x, bid = blockIdx.x;
  float* smf = (float*)smem;
  if (p.ws == nullptr) grid.sync();
  volatile LAS unsigned* xst = (volatile LAS unsigned*)(smem + SMEM_XB);
  if (tid == 0) { xst[0] = 0u; xst[1] = 0u; }
  __syncthreads();
  const XcdBarrier xb = xcd_barrier_post((unsigned*)(p.ws + OFF_BAR), xst);
  u16* sA = (u16*)smem;
  u16* sB = (u16*)(smem + 128 * 72 * 2);

  for (int rep_ = 0; rep_ < NREP(0); ++rep_) if (PHON(0)) {
    const int N_MOD = 96, N_TIN = 16 * 68, N_TOA = 8 * 16, N_TOH = 8 * 16, N_TOUT = 16 * 16, N_TQ = 16 * 16, N_HID = 1024;
    const int total = N_MOD + N_TIN + N_TOA + N_TOH + N_TOUT + N_TQ + N_HID + 1;
    for (int it = bid; it < total; it += nb) {
      int i = it;
      if (i < N_MOD) { p0_mod(p, i, smf); continue; }
      i -= N_MOD;
      if (i < N_TIN) { transpose_tile(p.w_in, INW, 1024, (u16*)(p.ws + OFF_WIN), i, smf); continue; }
      i -= N_TIN;
      if (i < N_TOA) { transpose_tile(p.w_o_attn, 1024, 512, (u16*)(p.ws + OFF_WOA), i, smf); continue; }
      i -= N_TOA;
      if (i < N_TOH) { transpose_tile(p.w_o_hy, 1024, 512, (u16*)(p.ws + OFF_WOH), i, smf); continue; }
      i -= N_TOH;
      if (i < N_TOUT) { transpose_tile(p.w_out, 1024, 1024, (u16*)(p.ws + OFF_WOUT), i, smf); continue; }
      i -= N_TOUT;
      if (i < N_TQ) { transpose_tile(p.peer_wq, 1024, 1024, (u16*)(p.ws + OFF_WQ), i, smf); continue; }
      i -= N_TQ;
      if (i < N_HID) { p0_hidden(p, i, smf); continue; }
      float2* rope = (float2*)(p.ws + OFF_ROPE);
      for (int idx = tid; idx < 1024; idx += 256) {
        const int pos = idx >> 4, f = idx & 15;
        const float inv = powf(10000.f, -(float)f / 16.f);
        const float ang = (float)pos * inv;
        rope[idx] = make_float2(cosf(ang), sinf(ang));
      }
    }
    convert_flat(p.peer_keys, (u16*)(p.ws + OFF_KEYS), (size_t)131072);
    convert_flat(p.peer_u, (u16*)(p.ws + OFF_UBF), (size_t)16384 * 1024);
    convert_flat(p.peer_v, (u16*)(p.ws + OFF_VBF), (size_t)16384 * 1024);
  }
  xcd_barrier(xb);

  for (int rep_ = 0; rep_ < NREP(1); ++rep_) if (PHON(1)) {
    const float* mod = (const float*)(p.ws + OFF_MOD);
    const int nrows = T_TOK + 1024;
    for (int r = bid * 4 + wave; r < nrows; r += nb * 4) {
      if (r < T_TOK) {
        const int b = r >> 12;
        norm_row(p.x + (size_t)r * 1024, p.norm1_g, mod + b * 6144, mod + b * 6144 + 1024,
                 (u16*)((char*)p.out + OO_H1) + (size_t)r * 1024, lane);
      } else {
        const int rc = r - T_TOK;
        norm_row(p.ctx + (size_t)rc * 1024, p.norm1_g, mod + 4 * 6144, mod + 4 * 6144 + 1024,
                 (u16*)((char*)p.out + OO_HC) + (size_t)rc * 1024, lane);
      }
    }
    for (int it = bid; it < 128; it += nb) p1_filter(p, it, smf);
  }
  xcd_barrier(xb);

  for (int rep_ = 0; rep_ < NREP(2); ++rep_) if (PHON(2)) {
    const int total = 128 * 34 + 16;
    for (int it = bid; it < total; it += nb) {
      if (it < 128 * 34) p2_inproj(p, it, sA, sB);
      else p2_ctxkv(p, it - 128 * 34, sA, sB);
    }
  }
  xcd_barrier(xb);

  for (int rep_ = 0; rep_ < NREP(3); ++rep_) if (PHON(3)) {
    const int total = 1024 + 2048;
    for (int it = bid; it < total; it += nb) {
      if (it < 1024) p3_attn(p, it, (u16*)smem, (u16*)(smem + 128 * 72 * 2));
      else p3_hypre(p, it - 1024, (u16*)smem);
    }
  }
  xcd_barrier(xb);

  for (int rep_ = 0; rep_ < NREP(4); ++rep_) if (PHON(4)) for (int it = bid; it < 512; it += nb) p3_toeplitz(p, it, smem);
  xcd_barrier(xb);

  for (int rep_ = 0; rep_ < NREP(5); ++rep_) if (PHON(5)) for (int it = bid; it < 1024; it += nb) p4_merge(p, it, sA, sB);
  xcd_barrier(xb);

  for (int rep_ = 0; rep_ < NREP(6); ++rep_) if (PHON(6)) for (int it = bid; it < 1024; it += nb) p5_out(p, it, sA, sB);
  xcd_barrier(xb);

  for (int rep_ = 0; rep_ < NREP(7); ++rep_) if (PHON(7)) {
    const float* mod = (const float*)(p.ws + OFF_MOD);
    for (int r = bid * 4 + wave; r < T_TOK; r += nb * 4) {
      const int b = r >> 12;
      norm_row(p.out + (size_t)r * 1024, p.norm2_g, mod + b * 6144 + 3072, mod + b * 6144 + 4096,
               (u16*)(p.ws + OFF_H2) + (size_t)r * 1024, lane);
    }
  }
  xcd_barrier(xb);

  for (int rep_ = 0; rep_ < NREP(8); ++rep_) if (PHON(8)) for (int it = bid; it < 1024; it += nb) p7_qp(p, it, sA, sB);
  xcd_barrier(xb);

  for (int rep_ = 0; rep_ < NREP(9); ++rep_) if (PHON(9)) for (int it = bid * 4 + wave; it < 8192; it += nb * 4) p8_route(p, it, smem + wave * 4096);
  xcd_barrier(xb);

  if (PHON(10)) for (int it = bid * 4 + wave; it < 4096; it += nb * 4) p9_experts4(p, it, smem + wave * 13312);
}

extern "C" void kernel_launch(void* const* d_in, const int* in_sizes, int n_in, void* d_out, int out_size,
                              void* d_ws, size_t ws_size, hipStream_t stream) {
  static int grid_blocks = 0;
  if (!grid_blocks) {
    int dev = 0, cus = 0, per_cu = 0;
    (void)hipGetDevice(&dev);
    (void)hipDeviceGetAttribute(&cus, hipDeviceAttributeMultiprocessorCount, dev);
    (void)hipFuncSetAttribute((const void*)mega, hipFuncAttributeMaxDynamicSharedMemorySize, SMEM_BYTES);
    (void)hipOccupancyMaxActiveBlocksPerMultiprocessor(&per_cu, mega, 256, SMEM_BYTES);
    if (per_cu > 2) per_cu = 2;
    if (per_cu < 1) per_cu = 1;
    grid_blocks = cus * per_cu;
  }
  Params p{};
  const float** pp = (const float**)&p;
  for (int i = 0; i < 28; ++i) pp[i] = (const float*)d_in[i];
  p.out = (float*)d_out;
  p.ws = (char*)d_ws;
  (void)hipMemsetAsync((char*)d_ws + OFF_BAR, 0, XCD_BAR_WORDS * sizeof(unsigned), stream);
  void* args[] = {&p};
  hipError_t e = hipLaunchCooperativeKernel((void*)mega, dim3(grid_blocks), dim3(256), args, SMEM_BYTES, stream);
  if (e != hipSuccess) fprintf(stderr, "cooperative launch failed: %s (grid %d)\n", hipGetErrorString(e), grid_blocks);
}
```

```cpp
#include <hip/hip_runtime.h>
#include <hip/hip_bf16.h>
#include <hip/hip_cooperative_groups.h>
#include <cstdio>
namespace cg = cooperative_groups;

typedef unsigned short u16;
typedef __attribute__((ext_vector_type(8))) short bf16x8;
typedef __attribute__((ext_vector_type(4))) float f32x4;
typedef __attribute__((ext_vector_type(4))) unsigned u32x4;

#define DEV __device__ __forceinline__
#ifndef PH
#define PH -1
#endif
#define PHON(n) (PH < 0 || PH == (n))
#ifndef REP
#define REP -1
#endif
#define NREP(n) ((REP == (n)) ? 2 : 1)

constexpr int T_TOK = 16384;
constexpr int DM = 1024;
constexpr int SEQL = 4096;
constexpr int INW = 4352;

struct Params {
  const float *x, *c, *ctx, *c_ctx, *w_mod, *b_mod, *norm1_g, *w_in, *attn_sink, *hy_conv_w, *hy_conv_b,
      *hy_fw1, *hy_fb1, *hy_fw2, *hy_fb2, *hy_fw3, *hy_fb3, *hy_freq, *hy_skip, *w_o_attn, *w_o_hy, *w_out,
      *norm2_g, *peer_wq, *peer_keys, *peer_u, *peer_v, *final_g;
  float* out;
  char* ws;
};

constexpr size_t MB = 1u << 20;
constexpr size_t OFF_MOD = 0;
constexpr size_t OFF_ROPE = 128 * 1024;
constexpr size_t OFF_NINV = OFF_ROPE + 8192;
constexpr size_t OFF_H2F = 256 * 1024;
constexpr size_t OFF_WIN = OFF_H2F + MB;
constexpr size_t OFF_WOA = OFF_WIN + 9 * MB;
constexpr size_t OFF_WOH = OFF_WOA + MB;
constexpr size_t OFF_WOUT = OFF_WOH + MB;
constexpr size_t OFF_WQ = OFF_WOUT + 2 * MB;
constexpr size_t OFF_KEYS = OFF_WQ + 2 * MB;
constexpr size_t OFF_UBF = OFF_KEYS + MB;
constexpr size_t OFF_VBF = OFF_UBF + 32 * MB;
constexpr size_t OFF_Q = OFF_VBF + 32 * MB;
constexpr size_t OFF_K = OFF_Q + 16 * MB;
constexpr size_t OFF_VT = OFF_K + 4 * MB;
constexpr size_t OFF_KC = OFF_VT + 4 * MB;
constexpr size_t OFF_VCT = OFF_KC + MB / 2;
constexpr size_t OFF_Z = OFF_VCT + MB / 2;
constexpr size_t OFF_GATE = OFF_Z + 48 * MB;
constexpr size_t OFF_YATT = OFF_GATE + 64 * MB;
constexpr size_t OFF_YHY = OFF_YATT + 16 * MB;
constexpr size_t OFF_RIDX = OFF_Q;
constexpr size_t OFF_RW = OFF_Q + 8 * MB;
constexpr size_t OFF_MERGED = OFF_Z;
constexpr size_t OFF_H2 = OFF_GATE;
constexpr size_t OFF_QP = OFF_GATE + 32 * MB;
constexpr size_t OO_H1 = 0;
constexpr size_t OO_UT = 0;
constexpr size_t OO_X0T = 16 * MB;
constexpr size_t OO_HC = 32 * MB;
constexpr size_t OO_G = 34 * MB;

constexpr int SMEM_BYTES = 70144;
constexpr size_t OFF_BAR = 160 * 1024;
constexpr int SMEM_XB = 70016;

DEV u16 f2bf(float f) {
  unsigned u = __float_as_uint(f);
  u += 0x7fffu + ((u >> 16) & 1u);
  return (u16)(u >> 16);
}
DEV float bf2f(u16 h) { return __uint_as_float(((unsigned)h) << 16); }
DEV unsigned pack2(float a, float b) { return (unsigned)f2bf(a) | ((unsigned)f2bf(b) << 16); }
DEV float bflo(unsigned w) { return __uint_as_float(w << 16); }
DEV float bfhi(unsigned w) { return __uint_as_float(w & 0xffff0000u); }
DEV float wave_sum(float v) {
#pragma unroll
  for (int o = 32; o > 0; o >>= 1) v += __shfl_xor(v, o);
  return v;
}
DEV float wave_max(float v) {
#pragma unroll
  for (int o = 32; o > 0; o >>= 1) v = fmaxf(v, __shfl_xor(v, o));
  return v;
}

DEV void p0_mod(const Params& p, int item, float* sm) {
  const int tid = threadIdx.x;
  for (int i = tid; i < 5 * 1024; i += 256) {
    int r = i >> 10, k = i & 1023;
    float c = (r < 4) ? p.c[r * 1024 + k] : p.c_ctx[k];
    sm[i] = c / (1.f + expf(-c));
  }
  __syncthreads();
  const int col = item * 64 + (tid & 63), kg = tid >> 6;
  float a0 = 0, a1 = 0, a2 = 0, a3 = 0, a4 = 0;
  for (int k = kg * 256; k < kg * 256 + 256; ++k) {
    float w = p.w_mod[(size_t)k * 6144 + col];
    a0 += sm[k] * w; a1 += sm[1024 + k] * w; a2 += sm[2048 + k] * w; a3 += sm[3072 + k] * w; a4 += sm[4096 + k] * w;
  }
  float* red = sm + 5 * 1024;
  red[(kg * 5 + 0) * 64 + (tid & 63)] = a0;
  red[(kg * 5 + 1) * 64 + (tid & 63)] = a1;
  red[(kg * 5 + 2) * 64 + (tid & 63)] = a2;
  red[(kg * 5 + 3) * 64 + (tid & 63)] = a3;
  red[(kg * 5 + 4) * 64 + (tid & 63)] = a4;
  __syncthreads();
  float* mod = (float*)(p.ws + OFF_MOD);
  for (int i = tid; i < 320; i += 256) {
    int r = i >> 6, cc = i & 63;
    float s = red[(0 * 5 + r) * 64 + cc] + red[(1 * 5 + r) * 64 + cc] + red[(2 * 5 + r) * 64 + cc] + red[(3 * 5 + r) * 64 + cc];
    mod[r * 6144 + item * 64 + cc] = s + p.b_mod[item * 64 + cc];
  }
  __syncthreads();
}

DEV void transpose_tile(const float* __restrict__ src, int N, int K, u16* __restrict__ dst, int tile, float* sm) {
  const int tid = threadIdx.x;
  const int nkt = K >> 6;
  const int kt = tile % nkt, nt = tile / nkt;
  const int k0 = kt * 64, n0 = nt * 64;
  const int c = tid & 63, r = tid >> 6;
#pragma unroll
  for (int rr = 0; rr < 16; ++rr) sm[(rr * 4 + r) * 65 + c] = src[(size_t)(k0 + rr * 4 + r) * N + n0 + c];
  __syncthreads();
  const int nn = tid >> 2, part = tid & 3;
  unsigned w[8];
#pragma unroll
  for (int j = 0; j < 8; ++j) w[j] = pack2(sm[(part * 16 + 2 * j) * 65 + nn], sm[(part * 16 + 2 * j + 1) * 65 + nn]);
  uint4* d = (uint4*)(dst + (size_t)(n0 + nn) * K + k0 + part * 16);
  d[0] = make_uint4(w[0], w[1], w[2], w[3]);
  d[1] = make_uint4(w[4], w[5], w[6], w[7]);
  __syncthreads();
}

DEV void p0_hidden(const Params& p, int item, float* sm) {
  const int tid = threadIdx.x;
  float* z = sm;
  float* h1 = sm + 4 * 36;
  if (tid < 4 * 33) {
    int tt = tid / 33, i = tid % 33;
    int t = item * 4 + tt;
    float v;
    if (i == 0) v = (float)t * (1.f / 4096.f);
    else {
      int band = (i <= 16) ? i : (i - 16);
      float fr = (float)((t * band) & 4095) * (1.f / 4096.f);
      v = (i <= 16) ? cospif(2.f * fr) : sinpif(2.f * fr);
    }
    z[tt * 36 + i] = v;
  }
  __syncthreads();
  const int tt = tid >> 6, j = tid & 63;
  float a = p.hy_fb1[j];
  for (int i = 0; i < 33; ++i) a += z[tt * 36 + i] * p.hy_fw1[i * 64 + j];
  const float fq = p.hy_freq[j];
  h1[tt * 64 + j] = sinf(fq * a);
  __syncthreads();
  float b = p.hy_fb2[j];
  for (int i = 0; i < 64; ++i) b += h1[tt * 64 + i] * p.hy_fw2[i * 64 + j];
  ((float*)(p.ws + OFF_H2F))[(item * 4 + tt) * 64 + j] = sinf(fq * b);
  __syncthreads();
}

DEV void convert_flat(const float* __restrict__ src, u16* __restrict__ dst, size_t n) {
  size_t stride = (size_t)gridDim.x * 256 * 8;
  for (size_t i = ((size_t)blockIdx.x * 256 + threadIdx.x) * 8; i < n; i += stride) {
    float4 a = *(const float4*)(src + i);
    float4 b = *(const float4*)(src + i + 4);
    *(uint4*)(dst + i) = make_uint4(pack2(a.x, a.y), pack2(a.z, a.w), pack2(b.x, b.y), pack2(b.z, b.w));
  }
}

typedef __attribute__((ext_vector_type(2))) float f32x2;
DEV void convert_flat_fp8(const float* __restrict__ src, unsigned char* __restrict__ dst, size_t n, float scale) {
  size_t stride = (size_t)gridDim.x * 256 * 16;
  for (size_t i = ((size_t)blockIdx.x * 256 + threadIdx.x) * 16; i < n; i += stride) {
    unsigned w[4];
#pragma unroll
    for (int q = 0; q < 4; ++q) {
      float4 a = *(const float4*)(src + i + 4 * q);
      int v = 0;
      v = __builtin_amdgcn_cvt_pk_fp8_f32(a.x * scale, a.y * scale, v, false);
      v = __builtin_amdgcn_cvt_pk_fp8_f32(a.z * scale, a.w * scale, v, true);
      w[q] = (unsigned)v;
    }
    *(uint4*)(dst + i) = make_uint4(w[0], w[1], w[2], w[3]);
  }
}

DEV void norm_row(const float* __restrict__ xr, const float* __restrict__ g, const float* __restrict__ sh,
                  const float* __restrict__ sc, u16* __restrict__ dst, int lane) {
  float4 v[4];
  float ss = 0.f;
#pragma unroll
  for (int i = 0; i < 4; ++i) {
    v[i] = ((const float4*)xr)[lane + 64 * i];
    ss += v[i].x * v[i].x + v[i].y * v[i].y + v[i].z * v[i].z + v[i].w * v[i].w;
  }
  ss = wave_sum(ss);
  const float r = rsqrtf(ss * (1.f / 1024.f) + 1e-6f);
#pragma unroll
  for (int i = 0; i < 4; ++i) {
    const int idx = lane + 64 * i;
    float4 gg = ((const float4*)g)[idx], s1 = ((const float4*)sh)[idx], s2 = ((const float4*)sc)[idx];
    float y0 = v[i].x * r * gg.x * (1.f + s2.x) + s1.x;
    float y1 = v[i].y * r * gg.y * (1.f + s2.y) + s1.y;
    float y2 = v[i].z * r * gg.z * (1.f + s2.z) + s1.z;
    float y3 = v[i].w * r * gg.w * (1.f + s2.w) + s1.w;
    *(uint2*)(dst + idx * 4) = make_uint2(pack2(y0, y1), pack2(y2, y3));
  }
}

DEV void p1_filter(const Params& p, int item, float* sm) {
  const int tid = threadIdx.x;
  float* wc = sm;
  float* fb = sm + 512;
  float* dl = sm + 520;
  float* red = sm + 528;
  const int c0 = item * 4;
  for (int i = tid; i < 512; i += 256) {
    int j = i >> 6, k = i & 63;
    int col = (j < 4) ? (c0 + j) : (512 + c0 + j - 4);
    wc[j * 64 + k] = p.hy_fw3[k * 1024 + col];
  }
  if (tid < 8) fb[tid] = p.hy_fb3[(tid < 4) ? (c0 + tid) : (512 + c0 + tid - 4)];
  if (tid < 4) {
    const float a = logf(1e-2f) / 1.5f, b = logf(1e-2f) / 0.3f;
    float d = a + (b - a) * (float)(c0 + tid) / 511.f;
    dl[tid] = fabsf(d);
  }
  __syncthreads();
  u16* G = (u16*)((char*)p.out + OO_G);
  const float* H = (const float*)(p.ws + OFF_H2F);
  float as0 = 0, as1 = 0, as2 = 0, as3 = 0;
  for (int t = tid; t < 4096; t += 256) {
    const float4* hp = (const float4*)(H + t * 64);
    float d[8];
#pragma unroll
    for (int j = 0; j < 8; ++j) d[j] = fb[j];
#pragma unroll 1
    for (int q = 0; q < 16; ++q) {
      float4 hv = hp[q];
#pragma unroll
      for (int j = 0; j < 8; ++j)
        d[j] += hv.x * wc[j * 64 + 4 * q] + hv.y * wc[j * 64 + 4 * q + 1] + hv.z * wc[j * 64 + 4 * q + 2] + hv.w * wc[j * 64 + 4 * q + 3];
    }
    const float tn = (float)t * (1.f / 4096.f);
    float asum[4];
#pragma unroll
    for (int j = 0; j < 4; ++j) {
      float dec = expf(-tn * dl[j]);
      float f = d[j] * dec, bw = d[4 + j] * dec;
      u16* Gc = G + (size_t)(c0 + j) * 8192;
      Gc[4095 - t] = f2bf(f);
      float s = fabsf(f);
      if (t < 4095) { Gc[4096 + t] = f2bf(bw); s += fabsf(bw); }
      else Gc[8191] = 0;
      asum[j] = s;
    }
    as0 += asum[0]; as1 += asum[1]; as2 += asum[2]; as3 += asum[3];
  }
  as0 = wave_sum(as0); as1 = wave_sum(as1); as2 = wave_sum(as2); as3 = wave_sum(as3);
  if ((tid & 63) == 0) {
    int w = tid >> 6;
    red[w * 4 + 0] = as0; red[w * 4 + 1] = as1; red[w * 4 + 2] = as2; red[w * 4 + 3] = as3;
  }
  __syncthreads();
  if (tid < 4) {
    float s = red[tid] + red[4 + tid] + red[8 + tid] + red[12 + tid];
    ((float*)(p.ws + OFF_NINV))[c0 + tid] = 1.f / s;
  }
  __syncthreads();
}

struct Acc { f32x4 v[4][4]; };

DEV void acc_zero(Acc& a) {
#pragma unroll
  for (int i = 0; i < 4; ++i)
#pragma unroll
    for (int j = 0; j < 4; ++j) a.v[i][j] = (f32x4){0.f, 0.f, 0.f, 0.f};
}

#define LDSAS __attribute__((address_space(3)))
DEV void gemm_kloop(const u16* __restrict__ A, int lda, const u16* __restrict__ Bt, int ldb, int K, int m0, int n0,
                    u16* sA, u16* sB_unused, Acc& acc) {
  const int tid = threadIdx.x, lane = tid & 63, wave = tid >> 6, wm = wave >> 1, wn = wave & 1;
  const int l15 = lane & 15, quad = lane >> 4;
  const int rsw = (l15 >> 1) & 7;
  const int nk = K >> 6;
  const int prow = lane >> 3;
  const int pch = lane & 7;
  const u16* gA[4];
  const u16* gB[4];
#pragma unroll
  for (int i = 0; i < 4; ++i) {
    const int row = (wave * 4 + i) * 8 + prow;
    const int c = pch ^ ((row >> 1) & 7);
    gA[i] = A + (size_t)(m0 + row) * lda + c * 8;
    gB[i] = Bt + (size_t)(n0 + row) * ldb + c * 8;
  }
  LDSAS char* lbase = (LDSAS char*)sA;
#define GEMM_DMA(KT, BUF)                                                                                   \
  _Pragma("unroll") for (int i = 0; i < 4; ++i) {                                                           \
    __builtin_amdgcn_global_load_lds((const unsigned*)(gA[i] + (KT) * 64), (LDSAS unsigned*)(lbase + (BUF) * 32768 + (wave * 4 + i) * 1024), 16, 0, 0);          \
    __builtin_amdgcn_global_load_lds((const unsigned*)(gB[i] + (KT) * 64), (LDSAS unsigned*)(lbase + (BUF) * 32768 + 16384 + (wave * 4 + i) * 1024), 16, 0, 0);  \
  }
  GEMM_DMA(0, 0)
  for (int kt = 0; kt < nk; ++kt) {
    asm volatile("s_waitcnt vmcnt(0)" ::: "memory");
    __syncthreads();
    const int buf = kt & 1;
    if (kt + 1 < nk) { GEMM_DMA(kt + 1, buf ^ 1) }
    const u16* tA = sA + buf * 16384;
    const u16* tB = tA + 8192;
#pragma unroll
    for (int ks = 0; ks < 2; ++ks) {
      const int cs = ((ks * 4 + quad) ^ rsw) * 8;
      bf16x8 af[4], bfr[4];
#pragma unroll
      for (int i = 0; i < 4; ++i) af[i] = *(const bf16x8*)(tB + (wn * 64 + i * 16 + l15) * 64 + cs);
#pragma unroll
      for (int j = 0; j < 4; ++j) bfr[j] = *(const bf16x8*)(tA + (wm * 64 + j * 16 + l15) * 64 + cs);
#pragma unroll
      for (int i = 0; i < 4; ++i)
#pragma unroll
        for (int j = 0; j < 4; ++j) acc.v[i][j] = __builtin_amdgcn_mfma_f32_16x16x32_bf16(af[i], bfr[j], acc.v[i][j], 0, 0, 0);
    }
  }
  __syncthreads();
}

DEV void p2_inproj(const Params& p, int tile, u16* sA, u16* sB) {
  const int mt = tile / 34, nt = tile % 34;
  const int m0 = mt * 128, n0 = nt * 128;
  Acc acc; acc_zero(acc);
  gemm_kloop((const u16*)((const char*)p.out + OO_H1), 1024, (const u16*)(p.ws + OFF_WIN), 1024, 1024, m0, n0, sA, sB, acc);
  const int tid = threadIdx.x, lane = tid & 63, wave = tid >> 6, wm = wave >> 1, wn = wave & 1;
  const int l15 = lane & 15, quad = lane >> 4;
  const int mb = m0 + wm * 64, nb = n0 + wn * 64;
  if (nb < 640) {
    const float2* rope = (const float2*)(p.ws + OFF_ROPE);
    const bool isq = nb < 512;
    const float qs = isq ? 0.125f : 1.f;
#pragma unroll
    for (int j = 0; j < 4; ++j) {
      const int m = mb + j * 16 + l15;
      const int b = m >> 12, l = m & 4095;
      const int prow = l >> 6, pcol = l & 63;
      u16* dst;
      if (isq) dst = (u16*)(p.ws + OFF_Q) + ((size_t)(b * 8 + (nb >> 6)) * 4096 + l) * 64;
      else dst = (u16*)(p.ws + OFF_K) + ((size_t)(b * 2 + ((nb - 512) >> 6)) * 4096 + l) * 64;
#pragma unroll
      for (int hh = 0; hh < 2; ++hh) {
        const int pos = hh ? pcol : prow;
        f32x4 x1 = acc.v[hh * 2][j], x2 = acc.v[hh * 2 + 1][j];
        float o1[4], o2[4];
#pragma unroll
        for (int r = 0; r < 4; ++r) {
          float2 cs = rope[pos * 16 + quad * 4 + r];
          o1[r] = (x1[r] * cs.x - x2[r] * cs.y) * qs;
          o2[r] = (x2[r] * cs.x + x1[r] * cs.y) * qs;
        }
        *(uint2*)(dst + hh * 32 + quad * 4) = make_uint2(pack2(o1[0], o1[1]), pack2(o1[2], o1[3]));
        *(uint2*)(dst + hh * 32 + 16 + quad * 4) = make_uint2(pack2(o2[0], o2[1]), pack2(o2[2], o2[3]));
      }
    }
  } else if (nb < 768) {
    const int g = (nb - 640) >> 6;
    u16* vt = (u16*)(p.ws + OFF_VT);
#pragma unroll
    for (int j = 0; j < 4; ++j) {
      const int m = mb + j * 16 + l15;
      const int b = m >> 12, l = m & 4095;
#pragma unroll
      for (int i = 0; i < 4; ++i)
#pragma unroll
        for (int r = 0; r < 4; ++r) {
          const int d = i * 16 + quad * 4 + r;
          vt[((size_t)(b * 2 + g) * 64 + d) * 4096 + l] = f2bf(acc.v[i][j][r]);
        }
    }
  } else if (nb < 2304) {
    u16* z = (u16*)(p.ws + OFF_Z);
#pragma unroll
    for (int j = 0; j < 4; ++j) {
      const int m = mb + j * 16 + l15;
#pragma unroll
      for (int i = 0; i < 4; ++i) {
        const int n = nb - 768 + i * 16 + quad * 4;
        f32x4 a = acc.v[i][j];
        *(uint2*)(z + (size_t)m * 1536 + n) = make_uint2(pack2(a[0], a[1]), pack2(a[2], a[3]));
      }
    }
  } else {
    u16* gt = (u16*)(p.ws + OFF_GATE);
#pragma unroll
    for (int j = 0; j < 4; ++j) {
      const int m = mb + j * 16 + l15;
#pragma unroll
      for (int i = 0; i < 4; ++i) {
        const int n = nb - 2304 + i * 16 + quad * 4;
        f32x4 a = acc.v[i][j];
        float s0 = 1.f / (1.f + __expf(-a[0])), s1 = 1.f / (1.f + __expf(-a[1]));
        float s2 = 1.f / (1.f + __expf(-a[2])), s3 = 1.f / (1.f + __expf(-a[3]));
        *(uint2*)(gt + (size_t)m * 2048 + n) = make_uint2(pack2(s0, s1), pack2(s2, s3));
      }
    }
  }
}

DEV void p2_ctxkv(const Params& p, int tile, u16* sA, u16* sB) {
  const int mt = tile >> 1, nt = tile & 1;
  const int m0 = mt * 128, n0 = nt * 128;
  Acc acc; acc_zero(acc);
  gemm_kloop((const u16*)((const char*)p.out + OO_HC), 1024, (const u16*)(p.ws + OFF_WIN) + (size_t)512 * 1024, 1024, 1024, m0, n0, sA, sB, acc);
  const int tid = threadIdx.x, lane = tid & 63, wave = tid >> 6, wm = wave >> 1, wn = wave & 1;
  const int l15 = lane & 15, quad = lane >> 4;
  const int mb = m0 + wm * 64, nb = n0 + wn * 64;
  const int g = (nb >> 6) & 1;
  if (nb < 128) {
    u16* kc = (u16*)(p.ws + OFF_KC);
#pragma unroll
    for (int j = 0; j < 4; ++j) {
      const int m = mb + j * 16 + l15;
      const int b = m >> 8, c = m & 255;
#pragma unroll
      for (int i = 0; i < 4; ++i) {
        f32x4 a = acc.v[i][j];
        *(uint2*)(kc + ((size_t)(b * 2 + g) * 256 + c) * 64 + i * 16 + quad * 4) = make_uint2(pack2(a[0], a[1]), pack2(a[2], a[3]));
      }
    }
  } else {
    u16* vct = (u16*)(p.ws + OFF_VCT);
#pragma unroll
    for (int j = 0; j < 4; ++j) {
      const int m = mb + j * 16 + l15;
      const int b = m >> 8, c = m & 255;
#pragma unroll
      for (int i = 0; i < 4; ++i)
#pragma unroll
        for (int r = 0; r < 4; ++r) {
          const int d = i * 16 + quad * 4 + r;
          vct[((size_t)(b * 2 + g) * 64 + d) * 256 + c] = f2bf(acc.v[i][j][r]);
        }
    }
  }
}

DEV void p3_attn(const Params& p, int item, u16* sK, u16* sVt) {
  const int tid = threadIdx.x, lane = tid & 63, wave = tid >> 6, l15 = lane & 15, quad = lane >> 4;
  const int n = item & 31, h = (item >> 5) & 7, b = item >> 8;
  const int g = h >> 2;
  const u16* Q = (const u16*)(p.ws + OFF_Q) + ((size_t)(b * 8 + h) * 4096 + n * 128 + wave * 32) * 64;
  bf16x8 bq[2][2];
#pragma unroll
  for (int qt = 0; qt < 2; ++qt)
#pragma unroll
    for (int ks = 0; ks < 2; ++ks) bq[qt][ks] = *(const bf16x8*)(Q + (qt * 16 + l15) * 64 + ks * 32 + quad * 8);
  const float sink = p.attn_sink[h];
  float mrun[2] = {sink, sink};
  float lrun[2];
  lrun[0] = lrun[1] = (quad == 0) ? 1.f : 0.f;
  f32x4 O[4][2];
#pragma unroll
  for (int dt = 0; dt < 4; ++dt)
#pragma unroll
    for (int qt = 0; qt < 2; ++qt) O[dt][qt] = (f32x4){0.f, 0.f, 0.f, 0.f};

  for (int kb = 0; kb < 5; ++kb) {
    const u16* Ksrc;
    const u16* Vsrc;
    int vstride;
    if (kb < 3) {
      const int nbk = n + kb - 1;
      if (nbk < 0 || nbk >= 32) continue;
      Ksrc = (const u16*)(p.ws + OFF_K) + ((size_t)(b * 2 + g) * 4096 + nbk * 128) * 64;
      Vsrc = (const u16*)(p.ws + OFF_VT) + (size_t)(b * 2 + g) * 64 * 4096 + nbk * 128;
      vstride = 4096;
    } else {
      const int cb = kb - 3;
      Ksrc = (const u16*)(p.ws + OFF_KC) + ((size_t)(b * 2 + g) * 256 + cb * 128) * 64;
      Vsrc = (const u16*)(p.ws + OFF_VCT) + (size_t)(b * 2 + g) * 64 * 256 + cb * 128;
      vstride = 256;
    }
#pragma unroll
    for (int i = 0; i < 4; ++i) {
      const int id = tid + i * 256;
      const int kr = id >> 3, kc8 = id & 7;
      *(uint4*)(sK + kr * 72 + kc8 * 8) = *(const uint4*)(Ksrc + kr * 64 + kc8 * 8);
      const int vr = id >> 4, vc = id & 15;
      *(uint4*)(sVt + vr * 136 + vc * 8) = *(const uint4*)(Vsrc + (size_t)vr * vstride + vc * 8);
    }
    __syncthreads();
#pragma unroll 1
    for (int c4 = 0; c4 < 4; ++c4) {
      f32x4 s[2][2];
#pragma unroll
      for (int kt = 0; kt < 2; ++kt) {
        bf16x8 ak0 = *(const bf16x8*)(sK + (c4 * 32 + kt * 16 + l15) * 72 + quad * 8);
        bf16x8 ak1 = *(const bf16x8*)(sK + (c4 * 32 + kt * 16 + l15) * 72 + 32 + quad * 8);
#pragma unroll
        for (int qt = 0; qt < 2; ++qt) {
          f32x4 z = (f32x4){0.f, 0.f, 0.f, 0.f};
          z = __builtin_amdgcn_mfma_f32_16x16x32_bf16(ak0, bq[qt][0], z, 0, 0, 0);
          z = __builtin_amdgcn_mfma_f32_16x16x32_bf16(ak1, bq[qt][1], z, 0, 0, 0);
          s[kt][qt] = z;
        }
      }
      if (kb == 0 || kb == 2) {
#pragma unroll
        for (int kt = 0; kt < 2; ++kt)
#pragma unroll
          for (int qt = 0; qt < 2; ++qt)
#pragma unroll
            for (int r = 0; r < 4; ++r) {
              const int kk = c4 * 32 + kt * 16 + quad * 4 + r;
              const int qq = wave * 32 + qt * 16 + l15;
              const bool valid = (kb == 0) ? (kk >= qq) : (kk <= qq);
              if (!valid) s[kt][qt][r] = -INFINITY;
            }
      }
      bf16x8 bp[2];
#pragma unroll
      for (int qt = 0; qt < 2; ++qt) {
        float cm = fmaxf(fmaxf(fmaxf(s[0][qt][0], s[0][qt][1]), fmaxf(s[0][qt][2], s[0][qt][3])),
                         fmaxf(fmaxf(s[1][qt][0], s[1][qt][1]), fmaxf(s[1][qt][2], s[1][qt][3])));
        cm = fmaxf(cm, __shfl_xor(cm, 16));
        cm = fmaxf(cm, __shfl_xor(cm, 32));
        const float mnew = fmaxf(mrun[qt], cm);
        const float alpha = __expf(mrun[qt] - mnew);
        mrun[qt] = mnew;
        float ps = 0.f;
        float pv[8];
#pragma unroll
        for (int r = 0; r < 4; ++r) {
          pv[r] = __expf(s[0][qt][r] - mnew);
          pv[4 + r] = __expf(s[1][qt][r] - mnew);
          ps += pv[r] + pv[4 + r];
        }
        lrun[qt] = lrun[qt] * alpha + ps;
#pragma unroll
        for (int dt = 0; dt < 4; ++dt) {
          O[dt][qt][0] *= alpha; O[dt][qt][1] *= alpha; O[dt][qt][2] *= alpha; O[dt][qt][3] *= alpha;
        }
        union { bf16x8 v; unsigned u[4]; } pk;
        pk.u[0] = pack2(pv[0], pv[1]); pk.u[1] = pack2(pv[2], pv[3]);
        pk.u[2] = pack2(pv[4], pv[5]); pk.u[3] = pack2(pv[6], pv[7]);
        bp[qt] = pk.v;
      }
#pragma unroll
      for (int dt = 0; dt < 4; ++dt) {
        union { bf16x8 v; uint2 h[2]; } av;
        const u16* vrow = sVt + (dt * 16 + l15) * 136 + c4 * 32 + quad * 4;
        av.h[0] = *(const uint2*)(vrow);
        av.h[1] = *(const uint2*)(vrow + 16);
#pragma unroll
        for (int qt = 0; qt < 2; ++qt) O[dt][qt] = __builtin_amdgcn_mfma_f32_16x16x32_bf16(av.v, bp[qt], O[dt][qt], 0, 0, 0);
      }
    }
    __syncthreads();
  }
  u16* Y = (u16*)(p.ws + OFF_YATT);
#pragma unroll
  for (int qt = 0; qt < 2; ++qt) {
    float l = lrun[qt];
    l += __shfl_xor(l, 16);
    l += __shfl_xor(l, 32);
    const float inv = 1.f / l;
    const int t = b * 4096 + n * 128 + wave * 32 + qt * 16 + l15;
#pragma unroll
    for (int dt = 0; dt < 4; ++dt) {
      f32x4 o = O[dt][qt];
      *(uint2*)(Y + (size_t)t * 512 + h * 64 + dt * 16 + quad * 4) = make_uint2(pack2(o[0] * inv, o[1] * inv), pack2(o[2] * inv, o[3] * inv));
    }
  }
}

DEV void p3_hypre(const Params& p, int item, u16* sm) {
  const int tid = threadIdx.x;
  const int cb = item & 7, tb = (item >> 3) & 63, b = item >> 9;
  const int tq = tid >> 6, ch = tid & 63;
  const int c = cb * 64 + ch;
  u16* su = sm;
  u16* sx = sm + 64 * 66;
  float w[3][3], bias[3];
#pragma unroll
  for (int s = 0; s < 3; ++s) {
#pragma unroll
    for (int k = 0; k < 3; ++k) w[s][k] = p.hy_conv_w[k * 1536 + s * 512 + c];
    bias[s] = p.hy_conv_b[s * 512 + c];
  }
  const u16* Z = (const u16*)(p.ws + OFF_Z) + (size_t)b * 4096 * 1536;
  const int l0 = tb * 64 + tq * 16;
  float prev[3], cur[3], nxt[3];
#pragma unroll
  for (int s = 0; s < 3; ++s) {
    prev[s] = (l0 > 0) ? bf2f(Z[(size_t)(l0 - 1) * 1536 + s * 512 + c]) : 0.f;
    cur[s] = bf2f(Z[(size_t)l0 * 1536 + s * 512 + c]);
  }
  for (int i = 0; i < 16; ++i) {
    const int l = l0 + i;
#pragma unroll
    for (int s = 0; s < 3; ++s) nxt[s] = (l + 1 < 4096) ? bf2f(Z[(size_t)(l + 1) * 1536 + s * 512 + c]) : 0.f;
    float cv[3];
#pragma unroll
    for (int s = 0; s < 3; ++s) cv[s] = prev[s] * w[s][0] + cur[s] * w[s][1] + nxt[s] * w[s][2] + bias[s];
    su[ch * 66 + tq * 16 + i] = f2bf(cv[2] * cv[1]);
    sx[ch * 66 + tq * 16 + i] = f2bf(cv[0]);
#pragma unroll
    for (int s = 0; s < 3; ++s) { prev[s] = cur[s]; cur[s] = nxt[s]; }
  }
  __syncthreads();
  const int chr = tid >> 2, part = tid & 3;
  const int cc = cb * 64 + chr;
  const unsigned* ru = (const unsigned*)(su + chr * 66 + part * 16);
  const unsigned* rx = (const unsigned*)(sx + chr * 66 + part * 16);
  u16* UT = (u16*)((char*)p.out + OO_UT) + ((size_t)(cc * 4 + b) * 4096 + tb * 64 + part * 16);
  u16* XT = (u16*)((char*)p.out + OO_X0T) + ((size_t)(cc * 4 + b) * 4096 + tb * 64 + part * 16);
  ((uint4*)UT)[0] = make_uint4(ru[0], ru[1], ru[2], ru[3]);
  ((uint4*)UT)[1] = make_uint4(ru[4], ru[5], ru[6], ru[7]);
  ((uint4*)XT)[0] = make_uint4(rx[0], rx[1], rx[2], rx[3]);
  ((uint4*)XT)[1] = make_uint4(rx[4], rx[5], rx[6], rx[7]);
  __syncthreads();
}

DEV void p3_toeplitz(const Params& p, int c, char* smem) {
  const int tid = threadIdx.x, lane = tid & 63, wave = tid >> 6, l15 = lane & 15, quad = lane >> 4;
  u16* sG0 = (u16*)smem;
  u16* sG1 = (u16*)(smem + 16384 + 64);
  u16* sU = (u16*)(smem + 32768 + 128);
  u16* sZ = sU + 4 * 64 * 72;
  const u16* G = (const u16*)((const char*)p.out + OO_G) + (size_t)c * 8192;
  const u16* UT = (const u16*)((const char*)p.out + OO_UT) + (size_t)c * 16384;
#pragma unroll
  for (int i = 0; i < 4; ++i) {
    const int id = tid + i * 256;
    *(uint4*)(sG0 + id * 8) = *(const uint4*)(G + id * 8);
  }
#pragma unroll
  for (int i = 0; i < 8; ++i) {
    const int id = tid + i * 256;
    const int bb = id >> 9, blk = (id >> 3) & 63, c8 = id & 7;
    *(uint4*)(sU + (bb * 64 + blk) * 72 + c8 * 8) = *(const uint4*)(UT + id * 8);
  }
  if (tid < 72) sZ[tid] = 0;
  __syncthreads();
  for (int i = tid; i < 8192; i += 256) sG1[i] = (i < 8191) ? sG0[i + 1] : (u16)0;
  __syncthreads();

  Acc acc; acc_zero(acc);
  const u16* gbase = (l15 & 1) ? sG0 : (sG1 - 1);
  const u16* ubase = sU + wave * 64 * 72 + quad * 8;
  const u16* zbase = sZ + quad * 8;
  for (int d = -63; d <= 63; ++d) {
    const int base = 4095 - 64 * d - l15 + quad * 8;
    bf16x8 af[4][2];
#pragma unroll
    for (int mt = 0; mt < 4; ++mt)
#pragma unroll
      for (int ks = 0; ks < 2; ++ks) {
        const unsigned* gp = (const unsigned*)(gbase + base - mt * 16 + ks * 32);
        union { bf16x8 v; unsigned u[4]; } t;
        t.u[0] = gp[0]; t.u[1] = gp[1]; t.u[2] = gp[2]; t.u[3] = gp[3];
        af[mt][ks] = t.v;
      }
#pragma unroll
    for (int nt = 0; nt < 4; ++nt) {
      if (nt * 16 + 15 - d < 0 || nt * 16 - d > 63) continue;
      const int ip = nt * 16 + l15 - d;
      const u16* up = (ip >= 0 && ip < 64) ? (ubase + ip * 72) : zbase;
      bf16x8 b0 = *(const bf16x8*)(up);
      bf16x8 b1 = *(const bf16x8*)(up + 32);
#pragma unroll
      for (int mt = 0; mt < 4; ++mt) {
        acc.v[mt][nt] = __builtin_amdgcn_mfma_f32_16x16x32_bf16(af[mt][0], b0, acc.v[mt][nt], 0, 0, 0);
        acc.v[mt][nt] = __builtin_amdgcn_mfma_f32_16x16x32_bf16(af[mt][1], b1, acc.v[mt][nt], 0, 0, 0);
      }
    }
  }
  const float ninv = ((const float*)(p.ws + OFF_NINV))[c];
  const float skip = p.hy_skip[c];
  const u16* XT = (const u16*)((const char*)p.out + OO_X0T) + ((size_t)(c * 4 + wave) * 4096);
  u16* Y = (u16*)(p.ws + OFF_YHY);
#pragma unroll
  for (int nt = 0; nt < 4; ++nt) {
    const int ib = nt * 16 + l15;
#pragma unroll
    for (int mt = 0; mt < 4; ++mt) {
      const int r0 = mt * 16 + quad * 4;
      const int t = ib * 64 + r0;
      uint2 uu = *(const uint2*)(sU + (wave * 64 + ib) * 72 + r0);
      uint2 xx = *(const uint2*)(XT + t);
      float uv[4] = {bflo(uu.x), bfhi(uu.x), bflo(uu.y), bfhi(uu.y)};
      float xv[4] = {bflo(xx.x), bfhi(xx.x), bflo(xx.y), bfhi(xx.y)};
#pragma unroll
      for (int r = 0; r < 4; ++r) {
        float y = acc.v[mt][nt][r] * ninv + uv[r] * skip;
        Y[(size_t)(wave * 4096 + t + r) * 512 + c] = f2bf(y * xv[r]);
      }
    }
  }
  __syncthreads();
}

DEV void p4_merge(const Params& p, int tile, u16* sA, u16* sB) {
  const int mt = tile >> 3, nt = tile & 7;
  const int m0 = mt * 128, n0 = nt * 128;
  const int tid = threadIdx.x, lane = tid & 63, wave = tid >> 6, wm = wave >> 1, wn = wave & 1;
  const int l15 = lane & 15, quad = lane >> 4;
  const int mb = m0 + wm * 64, nb = n0 + wn * 64;
  const u16* gt = (const u16*)(p.ws + OFF_GATE);
  u16* mg = (u16*)(p.ws + OFF_MERGED);
  Acc a1; acc_zero(a1);
  gemm_kloop((const u16*)(p.ws + OFF_YATT), 512, (const u16*)(p.ws + OFF_WOA), 512, 512, m0, n0, sA, sB, a1);
  asm volatile("" ::: "memory");
#pragma unroll
  for (int j = 0; j < 4; ++j) {
    const int m = mb + j * 16 + l15;
#pragma unroll
    for (int i = 0; i < 4; ++i) {
      const int n = nb + i * 16 + quad * 4;
      uint2 ga = *(const uint2*)(gt + (size_t)m * 2048 + n);
      f32x4 x = a1.v[i][j];
      *(uint2*)(mg + (size_t)m * 1024 + n) = make_uint2(pack2(bflo(ga.x) * x[0], bfhi(ga.x) * x[1]), pack2(bflo(ga.y) * x[2], bfhi(ga.y) * x[3]));
    }
  }
  asm volatile("" ::: "memory");
  acc_zero(a1);
  gemm_kloop((const u16*)(p.ws + OFF_YHY), 512, (const u16*)(p.ws + OFF_WOH), 512, 512, m0, n0, sA, sB, a1);
  asm volatile("" ::: "memory");
#pragma unroll
  for (int j = 0; j < 4; ++j) {
    const int m = mb + j * 16 + l15;
#pragma unroll
    for (int i = 0; i < 4; ++i) {
      const int n = nb + i * 16 + quad * 4;
      uint2 gh = *(const uint2*)(gt + (size_t)m * 2048 + 1024 + n);
      uint2 pv = *(const uint2*)(mg + (size_t)m * 1024 + n);
      f32x4 y = a1.v[i][j];
      float o0 = bflo(pv.x) + bflo(gh.x) * y[0];
      float o1 = bfhi(pv.x) + bfhi(gh.x) * y[1];
      float o2 = bflo(pv.y) + bflo(gh.y) * y[2];
      float o3 = bfhi(pv.y) + bfhi(gh.y) * y[3];
      *(uint2*)(mg + (size_t)m * 1024 + n) = make_uint2(pack2(o0, o1), pack2(o2, o3));
    }
  }
}

DEV void p5_out(const Params& p, int tile, u16* sA, u16* sB) {
  const int mt = tile >> 3, nt = tile & 7;
  const int m0 = mt * 128, n0 = nt * 128;
  Acc acc; acc_zero(acc);
  gemm_kloop((const u16*)(p.ws + OFF_MERGED), 1024, (const u16*)(p.ws + OFF_WOUT), 1024, 1024, m0, n0, sA, sB, acc);
  const int tid = threadIdx.x, lane = tid & 63, wave = tid >> 6, wm = wave >> 1, wn = wave & 1;
  const int l15 = lane & 15, quad = lane >> 4;
  const int mb = m0 + wm * 64, nb = n0 + wn * 64;
  const float* mod = (const float*)(p.ws + OFF_MOD);
#pragma unroll
  for (int j = 0; j < 4; ++j) {
    const int m = mb + j * 16 + l15;
    const int b = m >> 12;
#pragma unroll
    for (int i = 0; i < 4; ++i) {
      const int n = nb + i * 16 + quad * 4;
      float4 g1 = *(const float4*)(mod + b * 6144 + 2048 + n);
      float4 xv = *(const float4*)(p.x + (size_t)m * 1024 + n);
      f32x4 a = acc.v[i][j];
      float4 o = make_float4(xv.x + g1.x * a[0], xv.y + g1.y * a[1], xv.z + g1.z * a[2], xv.w + g1.w * a[3]);
      *(float4*)(p.out + (size_t)m * 1024 + n) = o;
    }
  }
}

DEV void p7_qp(const Params& p, int tile, u16* sA, u16* sB) {
  const int mt = tile >> 3, nt = tile & 7;
  const int m0 = mt * 128, n0 = nt * 128;
  Acc acc; acc_zero(acc);
  gemm_kloop((const u16*)(p.ws + OFF_H2), 1024, (const u16*)(p.ws + OFF_WQ), 1024, 1024, m0, n0, sA, sB, acc);
  const int tid = threadIdx.x, lane = tid & 63, wave = tid >> 6, wm = wave >> 1, wn = wave & 1;
  const int l15 = lane & 15, quad = lane >> 4;
  const int mb = m0 + wm * 64, nb = n0 + wn * 64;
  u16* qp = (u16*)(p.ws + OFF_QP);
#pragma unroll
  for (int j = 0; j < 4; ++j) {
    const int m = mb + j * 16 + l15;
#pragma unroll
    for (int i = 0; i < 4; ++i) {
      const int n = nb + i * 16 + quad * 4;
      f32x4 a = acc.v[i][j];
      *(uint2*)(qp + (size_t)m * 1024 + n) = make_uint2(pack2(a[0], a[1]), pack2(a[2], a[3]));
    }
  }
}

DEV unsigned f2ord(float f) {
  const unsigned u = __float_as_uint(f);
  return u ^ (((int)u >> 31) | 0x80000000u);
}
DEV float ord2f(unsigned k) {
  const unsigned m = (k & 0x80000000u) ? 0x80000000u : 0xffffffffu;
  return __uint_as_float(k ^ m);
}
DEV unsigned umax_(unsigned a, unsigned b) { return a > b ? a : b; }
DEV unsigned umin_(unsigned a, unsigned b) { return a < b ? a : b; }

DEV void sort16_desc(unsigned (&v)[16]) {
#pragma unroll
  for (int k = 2; k <= 16; k <<= 1)
#pragma unroll
    for (int j = k >> 1; j > 0; j >>= 1)
#pragma unroll
      for (int i = 0; i < 16; ++i) {
        const int l = i ^ j;
        if (l > i) {
          const bool desc = ((i & k) == 0);
          const unsigned a = v[i], b = v[l];
          const unsigned hi = umax_(a, b), lo = umin_(a, b);
          v[i] = desc ? hi : lo;
          v[l] = desc ? lo : hi;
        }
      }
}
DEV void merge16_desc(unsigned (&v)[16]) {
#pragma unroll
  for (int j = 8; j > 0; j >>= 1)
#pragma unroll
    for (int i = 0; i < 16; ++i) {
      const int l = i ^ j;
      if (l > i) {
        const unsigned a = v[i], b = v[l];
        v[i] = umax_(a, b);
        v[l] = umin_(a, b);
      }
    }
}
DEV void xmerge16(unsigned (&v)[16], int off) {
  unsigned pr[16];
#pragma unroll
  for (int i = 0; i < 16; ++i) pr[i] = (unsigned)__shfl_xor((int)v[i], off);
#pragma unroll
  for (int i = 0; i < 16; ++i) v[i] = umax_(v[i], pr[15 - i]);
  merge16_desc(v);
}

DEV void route_top16_of_128(const u16* __restrict__ keys, const u16* __restrict__ qp, int l15, int quad, unsigned (&out)[16]) {
  bf16x8 b0 = *(const bf16x8*)(qp);
  bf16x8 b1 = *(const bf16x8*)(qp + 32);
  unsigned ka[16], kb[16];
#pragma unroll
  for (int kt = 0; kt < 8; ++kt) {
    bf16x8 a0 = *(const bf16x8*)(keys + (kt * 16 + l15) * 64 + quad * 8);
    bf16x8 a1 = *(const bf16x8*)(keys + (kt * 16 + l15) * 64 + 32 + quad * 8);
    f32x4 z = (f32x4){0.f, 0.f, 0.f, 0.f};
    z = __builtin_amdgcn_mfma_f32_16x16x32_bf16(a0, b0, z, 0, 0, 0);
    z = __builtin_amdgcn_mfma_f32_16x16x32_bf16(a1, b1, z, 0, 0, 0);
#pragma unroll
    for (int r = 0; r < 4; ++r) {
      const unsigned key = (f2ord(z[r]) & ~127u) | (unsigned)(kt * 16 + quad * 4 + r);
      if (kt < 4) ka[kt * 4 + r] = key; else kb[(kt - 4) * 4 + r] = key;
    }
  }
  sort16_desc(ka);
  sort16_desc(kb);
#pragma unroll
  for (int i = 0; i < 16; ++i) out[i] = umax_(ka[i], kb[15 - i]);
  merge16_desc(out);
  xmerge16(out, 16);
  xmerge16(out, 32);
}

DEV void p8_route(const Params& p, int task, char* wsm) {
  static constexpr unsigned char kTab[52] = {
      0x00, 0x01, 0x02, 0x03, 0x04, 0x05, 0x06, 0x07, 0x08, 0x09, 0x0A, 0x0B, 0x0C, 0x0D, 0x0E, 0x0F,
      0x10, 0x11, 0x12, 0x13, 0x14, 0x15, 0x16, 0x17, 0x20, 0x21, 0x22, 0x23, 0x24, 0x30, 0x31, 0x32, 0x33,
      0x40, 0x41, 0x42, 0x50, 0x51, 0x60, 0x61, 0x70, 0x71, 0x80, 0x90, 0xA0, 0xB0, 0xC0, 0xD0, 0xE0, 0xF0, 0x00, 0x00};
  const int lane = threadIdx.x & 63, l15 = lane & 15, quad = lane >> 4;
  const int h = task & 7, tt = task >> 3;
  const int t0 = tt * 16;
  float* s1v = (float*)wsm;
  float* s2v = s1v + 256;
  int* i1 = (int*)(s2v + 256);
  int* i2 = i1 + 256;
  const u16* keys = (const u16*)(p.ws + OFF_KEYS) + (size_t)(h * 2) * 128 * 64;
  const u16* qp = (const u16*)(p.ws + OFF_QP) + (size_t)(t0 + l15) * 1024 + h * 128 + quad * 8;
  unsigned l1[16], l2[16];
  route_top16_of_128(keys, qp, l15, quad, l1);
  route_top16_of_128(keys + 128 * 64, qp + 64, l15, quad, l2);
  if (quad == 0) {
#pragma unroll
    for (int i = 0; i < 16; ++i) { s1v[l15 * 16 + i] = ord2f(l1[i] & ~127u); i1[l15 * 16 + i] = (int)(l1[i] & 127u); }
  } else if (quad == 1) {
#pragma unroll
    for (int i = 0; i < 16; ++i) { s2v[l15 * 16 + i] = ord2f(l2[i] & ~127u); i2[l15 * 16 + i] = (int)(l2[i] & 127u); }
  }
  __builtin_amdgcn_fence(__ATOMIC_RELEASE, "wavefront");
  __builtin_amdgcn_wave_barrier();
  __builtin_amdgcn_fence(__ATOMIC_ACQUIRE, "wavefront");
  unsigned ck[16];
#pragma unroll
  for (int s = 0; s < 16; ++s) {
    const int c = quad + 4 * s;
    unsigned key = 0u;
    if (s < 13 && c < 50) {
      const unsigned ab = kTab[c];
      const float val = s1v[l15 * 16 + (ab >> 4)] + s2v[l15 * 16 + (ab & 15)];
      key = (f2ord(val) & ~255u) | ab;
    }
    ck[s] = key;
  }
  sort16_desc(ck);
  xmerge16(ck, 16);
  xmerge16(ck, 32);
  if (quad == 0) {
    float e[16];
    const float vmax = ord2f(ck[0] & ~255u);
    float ssum = 0.f;
#pragma unroll
    for (int i = 0; i < 16; ++i) { e[i] = __expf(ord2f(ck[i] & ~255u) - vmax); ssum += e[i]; }
    const float inv = 1.f / ssum;
    int* ridx = (int*)(p.ws + OFF_RIDX) + (size_t)(t0 + l15) * 128 + h * 16;
    float* rw = (float*)(p.ws + OFF_RW) + (size_t)(t0 + l15) * 128 + h * 16;
#pragma unroll
    for (int i = 0; i < 16; i += 4) {
      int ee[4]; float ww[4];
#pragma unroll
      for (int j = 0; j < 4; ++j) {
        const unsigned ab = ck[i + j] & 255u;
        ee[j] = i1[l15 * 16 + (ab >> 4)] * 128 + i2[l15 * 16 + (ab & 15)];
        ww[j] = e[i + j] * inv;
      }
      *(int4*)(ridx + i) = make_int4(ee[0], ee[1], ee[2], ee[3]);
      *(float4*)(rw + i) = make_float4(ww[0], ww[1], ww[2], ww[3]);
    }
  }
  __builtin_amdgcn_fence(__ATOMIC_RELEASE, "wavefront");
  __builtin_amdgcn_wave_barrier();
}

DEV float gelu_tanh(float x) {
  const float u = 0.7978845608028654f * (x + 0.044715f * x * x * x);
  return 0.5f * x * (1.f + tanhf(u));
}

DEV void unpack8(const uint4& q, float* f) {
  f[0] = bflo(q.x); f[1] = bfhi(q.x); f[2] = bflo(q.y); f[3] = bfhi(q.y);
  f[4] = bflo(q.z); f[5] = bfhi(q.z); f[6] = bflo(q.w); f[7] = bfhi(q.w);
}

DEV float dpp_add(float v, const int ctrl_sel) {
  return v;
}
typedef __attribute__((ext_vector_type(2))) __bf16 bf2_t;
DEV float dot2bf(unsigned a, unsigned b, float c) {
  return __builtin_amdgcn_fdot2_f32_bf16(__builtin_bit_cast(bf2_t, a), __builtin_bit_cast(bf2_t, b), c, false);
}
#define DPP_ADD(v, ctrl) ((v) + __builtin_bit_cast(float, __builtin_amdgcn_update_dpp(0, __builtin_bit_cast(int, (v)), (ctrl), 0xF, 0xF, true)))

DEV void p9_experts4(const Params& p, int task, char* wsm) {
  const int lane = threadIdx.x & 63;
  const int t0 = task * 4;
  int* hist = (int*)wsm;
  unsigned* skey = (unsigned*)(wsm + 1024);
  float* swt = (float*)(wsm + 1024 + 2048);
  u16* sh2 = (u16*)(wsm + 1024 + 4096);
  hist[lane] = 0; hist[lane + 64] = 0; hist[lane + 128] = 0; hist[lane + 192] = 0;
  const int* ridx = (const int*)(p.ws + OFF_RIDX) + (size_t)t0 * 128 + lane * 8;
  const float* rw = (const float*)(p.ws + OFF_RW) + (size_t)t0 * 128 + lane * 8;
  int4 ea = *(const int4*)(ridx), eb = *(const int4*)(ridx + 4);
  float4 wa = *(const float4*)(rw), wb = *(const float4*)(rw + 4);
  int e[8] = {ea.x, ea.y, ea.z, ea.w, eb.x, eb.y, eb.z, eb.w};
  float w[8] = {wa.x, wa.y, wa.z, wa.w, wb.x, wb.y, wb.z, wb.w};
  {
    const u16* h2 = (const u16*)(p.ws + OFF_H2) + (size_t)t0 * 1024;
#pragma unroll
    for (int i = 0; i < 8; ++i) *(u32x4*)(sh2 + (lane + 64 * i) * 8) = *(const u32x4*)(h2 + (lane + 64 * i) * 8);
  }
  __builtin_amdgcn_fence(__ATOMIC_RELEASE, "wavefront");
  __builtin_amdgcn_wave_barrier();
  __builtin_amdgcn_fence(__ATOMIC_ACQUIRE, "wavefront");
  int rank[8];
#pragma unroll
  for (int j = 0; j < 8; ++j) rank[j] = atomicAdd(&hist[e[j] >> 6], 1);
  __builtin_amdgcn_fence(__ATOMIC_RELEASE, "wavefront");
  __builtin_amdgcn_wave_barrier();
  __builtin_amdgcn_fence(__ATOMIC_ACQUIRE, "wavefront");
  {
    const int c0 = hist[4 * lane], c1 = hist[4 * lane + 1], c2 = hist[4 * lane + 2], c3 = hist[4 * lane + 3];
    const int tot = c0 + c1 + c2 + c3;
    int x = tot;
#pragma unroll
    for (int o = 1; o < 64; o <<= 1) { const int y = __shfl_up(x, o); if (lane >= o) x += y; }
    const int base = x - tot;
    __builtin_amdgcn_fence(__ATOMIC_RELEASE, "wavefront");
    __builtin_amdgcn_wave_barrier();
    hist[4 * lane] = base; hist[4 * lane + 1] = base + c0; hist[4 * lane + 2] = base + c0 + c1; hist[4 * lane + 3] = base + c0 + c1 + c2;
  }
  __builtin_amdgcn_fence(__ATOMIC_RELEASE, "wavefront");
  __builtin_amdgcn_wave_barrier();
  __builtin_amdgcn_fence(__ATOMIC_ACQUIRE, "wavefront");
  {
    const unsigned slot = (unsigned)(lane >> 4);
#pragma unroll
    for (int j = 0; j < 8; ++j) {
      const int pos = hist[e[j] >> 6] + rank[j];
      skey[pos] = (unsigned)e[j] | (slot << 14);
      swt[pos] = w[j];
    }
  }
  __builtin_amdgcn_fence(__ATOMIC_RELEASE, "wavefront");
  __builtin_amdgcn_wave_barrier();
  __builtin_amdgcn_fence(__ATOMIC_ACQUIRE, "wavefront");

  float o0[16], o1[16], o2[16], o3[16];
#pragma unroll
  for (int k = 0; k < 16; ++k) { o0[k] = 0.f; o1[k] = 0.f; o2[k] = 0.f; o3[k] = 0.f; }
  const u16* U = (const u16*)(p.ws + OFF_UBF);
  const u16* V = (const u16*)(p.ws + OFF_VBF);
#define P9_LOAD(KK, UU, VV, BB)                                                           \
  _Pragma("unroll") for (int i = 0; i < 4; ++i) {                                         \
    KK[i] = (unsigned)__builtin_amdgcn_readfirstlane((int)skey[4 * (BB) + i]);            \
    const size_t ro = (size_t)(KK[i] & 16383u) * 1024 + 16 * lane;                        \
    UU[i] = *(const u32x4*)(U8 + ro);                                                     \
    VV[i] = *(const u32x4*)(V8 + ro);                                                     \
  }
#define P9_DOTS(KK, UU, BB, COEFV)                                                        \
  {                                                                                       \
    const float myw = swt[4 * (BB) + (lane >> 4)];                                        \
    float d[4];                                                                           \
    _Pragma("unroll") for (int i = 0; i < 4; ++i) {                                       \
      const unsigned slot = KK[i] >> 14;                                                  \
      const u32x4 ha = *(const u32x4*)(sh2 + slot * 1024 + 16 * lane);                    \
      const u32x4 hb = *(const u32x4*)(sh2 + slot * 1024 + 16 * lane + 8);                \
      float acc0 = 0.f, acc1 = 0.f;                                                       \
      {                                                                                   \
        f32x2 l0 = __builtin_amdgcn_cvt_pk_f32_fp8((int)UU[i].x, false), h0 = __builtin_amdgcn_cvt_pk_f32_fp8((int)UU[i].x, true); \
        f32x2 l1 = __builtin_amdgcn_cvt_pk_f32_fp8((int)UU[i].y, false), h1 = __builtin_amdgcn_cvt_pk_f32_fp8((int)UU[i].y, true); \
        f32x2 l2 = __builtin_amdgcn_cvt_pk_f32_fp8((int)UU[i].z, false), h2_ = __builtin_amdgcn_cvt_pk_f32_fp8((int)UU[i].z, true); \
        f32x2 l3 = __builtin_amdgcn_cvt_pk_f32_fp8((int)UU[i].w, false), h3 = __builtin_amdgcn_cvt_pk_f32_fp8((int)UU[i].w, true); \
        acc0 += l0.x * bflo(ha.x) + l0.y * bfhi(ha.x); acc1 += h0.x * bflo(ha.y) + h0.y * bfhi(ha.y);   \
        acc0 += l1.x * bflo(ha.z) + l1.y * bfhi(ha.z); acc1 += h1.x * bflo(ha.w) + h1.y * bfhi(ha.w);   \
        acc0 += l2.x * bflo(hb.x) + l2.y * bfhi(hb.x); acc1 += h2_.x * bflo(hb.y) + h2_.y * bfhi(hb.y); \
        acc0 += l3.x * bflo(hb.z) + l3.y * bfhi(hb.z); acc1 += h3.x * bflo(hb.w) + h3.y * bfhi(hb.w);   \
      }                                                                                   \
      d[i] = acc0 + acc1;                                                                 \
    }                                                                                     \
    const bool up32 = (lane & 32) != 0, up16 = (lane & 16) != 0;                          \
    float k0 = up32 ? d[2] : d[0], k1 = up32 ? d[3] : d[1];                               \
    float s0 = up32 ? d[0] : d[2], s1 = up32 ? d[1] : d[3];                               \
    k0 += __shfl_xor(s0, 32);                                                             \
    k1 += __shfl_xor(s1, 32);                                                             \
    float kq = up16 ? k1 : k0, sq = up16 ? k0 : k1;                                       \
    kq += __shfl_xor(sq, 16);                                                             \
    kq = DPP_ADD(kq, 0xB1);                                                               \
    kq = DPP_ADD(kq, 0x4E);                                                               \
    kq = DPP_ADD(kq, 0x141);                                                              \
    kq = DPP_ADD(kq, 0x140);                                                              \
    COEFV = myw * (1.f / 64.f) * gelu_tanh(kq * (1.f / 512.f));                           \
  }
#define P9_ACCUM(KK, VV, COEFV)                                                           \
  _Pragma("unroll") for (int i = 0; i < 4; ++i) {                                         \
    const float ci = __builtin_bit_cast(float, __builtin_amdgcn_readlane(__builtin_bit_cast(int, COEFV), 16 * i)); \
    const unsigned slot = KK[i] >> 14;                                                    \
    float vf[16];                                                                         \
    {                                                                                     \
      f32x2 t;                                                                            \
      t = __builtin_amdgcn_cvt_pk_f32_fp8((int)VV[i].x, false); vf[0] = t.x; vf[1] = t.y;   \
      t = __builtin_amdgcn_cvt_pk_f32_fp8((int)VV[i].x, true);  vf[2] = t.x; vf[3] = t.y;   \
      t = __builtin_amdgcn_cvt_pk_f32_fp8((int)VV[i].y, false); vf[4] = t.x; vf[5] = t.y;   \
      t = __builtin_amdgcn_cvt_pk_f32_fp8((int)VV[i].y, true);  vf[6] = t.x; vf[7] = t.y;   \
      t = __builtin_amdgcn_cvt_pk_f32_fp8((int)VV[i].z, false); vf[8] = t.x; vf[9] = t.y;   \
      t = __builtin_amdgcn_cvt_pk_f32_fp8((int)VV[i].z, true);  vf[10] = t.x; vf[11] = t.y; \
      t = __builtin_amdgcn_cvt_pk_f32_fp8((int)VV[i].w, false); vf[12] = t.x; vf[13] = t.y; \
      t = __builtin_amdgcn_cvt_pk_f32_fp8((int)VV[i].w, true);  vf[14] = t.x; vf[15] = t.y; \
    }                                                                                     \
    if (slot == 0) { _Pragma("unroll") for (int k = 0; k < 16; ++k) o0[k] += ci * vf[k]; }       \
    else if (slot == 1) { _Pragma("unroll") for (int k = 0; k < 16; ++k) o1[k] += ci * vf[k]; }  \
    else if (slot == 2) { _Pragma("unroll") for (int k = 0; k < 16; ++k) o2[k] += ci * vf[k]; }  \
    else { _Pragma("unroll") for (int k = 0; k < 16; ++k) o3[k] += ci * vf[k]; }                 \
  }
  {
    const unsigned char* U8 = (const unsigned char*)(p.ws + OFF_UBF);
    const unsigned char* V8 = (const unsigned char*)(p.ws + OFF_VBF);
    unsigned kkA[4], kkB[4];
    u32x4 uA[4], vA[4], uB[4], vB[4];
    float cfA, cfB;
    P9_LOAD(kkA, uA, vA, 0)
#pragma unroll 1
    for (int bb = 0; bb < 128; bb += 2) {
      P9_LOAD(kkB, uB, vB, bb + 1)
      P9_DOTS(kkA, uA, bb, cfA)
      P9_ACCUM(kkA, vA, cfA)
      const int n0 = (bb + 2 < 128) ? (bb + 2) : 0;
      P9_LOAD(kkA, uA, vA, n0)
      P9_DOTS(kkB, uB, bb + 1, cfB)
      P9_ACCUM(kkB, vB, cfB)
    }
  }
#pragma unroll
  for (int s = 0; s < 4; ++s) {
    const int t = t0 + s;
    const int b = t >> 12;
    const float* mod = (const float*)(p.ws + OFF_MOD) + b * 6144 + 5120 + 16 * lane;
    float* xm = p.out + (size_t)t * 1024 + 16 * lane;
    const float* oo = (s == 0) ? o0 : ((s == 1) ? o1 : ((s == 2) ? o2 : o3));
    float xo[16];
    float ss = 0.f;
#pragma unroll
    for (int q = 0; q < 4; ++q) {
      const float4 xv = *(const float4*)(xm + 4 * q);
      const float4 gv = *(const float4*)(mod + 4 * q);
      xo[4 * q + 0] = xv.x + gv.x * oo[4 * q + 0];
      xo[4 * q + 1] = xv.y + gv.y * oo[4 * q + 1];
      xo[4 * q + 2] = xv.z + gv.z * oo[4 * q + 2];
      xo[4 * q + 3] = xv.w + gv.w * oo[4 * q + 3];
    }
#pragma unroll
    for (int k = 0; k < 16; ++k) ss += xo[k] * xo[k];
    ss = wave_sum(ss);
    const float r = rsqrtf(ss * (1.f / 1024.f) + 1e-6f);
#pragma unroll
    for (int q = 0; q < 4; ++q) {
      const float4 fg = *(const float4*)(p.final_g + 16 * lane + 4 * q);
      *(float4*)(xm + 4 * q) = make_float4(xo[4 * q] * r * fg.x, xo[4 * q + 1] * r * fg.y, xo[4 * q + 2] * r * fg.z, xo[4 * q + 3] * r * fg.w);
    }
  }
  __builtin_amdgcn_fence(__ATOMIC_RELEASE, "wavefront");
  __builtin_amdgcn_wave_barrier();
}

#define XB_TMO      128
#define XB_XCNT(j)  (256  + 64 * (j))
#define XB_XSUB(j)  (1280 + 64 * (j))
#define XB_XGEN(j)  (2304 + 64 * (j))
#define XB_TOP      3328
#define XB_TOPGEN   3392
#define XCD_BAR_WORDS 3456
#define XB_SPIN_CAP (1u << 18)
#define LAS __attribute__((address_space(3)))

__device__ __forceinline__ unsigned xb_ld(unsigned* p)              { return __hip_atomic_load(p, __ATOMIC_RELAXED, __HIP_MEMORY_SCOPE_AGENT); }
__device__ __forceinline__ unsigned xb_add(unsigned* p, unsigned v) { return __hip_atomic_fetch_add(p, v, __ATOMIC_RELAXED, __HIP_MEMORY_SCOPE_AGENT); }
__device__ __forceinline__ unsigned xb_xcc_id() { return (unsigned)__builtin_amdgcn_s_getreg((3 << 11) | 20) & 0xFu; }
#define XB_SPIN(cond, bar) do { unsigned _sp = 0; while (cond) { __builtin_amdgcn_s_sleep(1); \
    if ((++_sp & 255u) == 0u) { if (xb_ld(&(bar)[XB_TMO])) break; if (_sp > XB_SPIN_CAP) { atomicAdd(&(bar)[XB_TMO], 1u); break; } } } } while (0)

struct XcdBarrier {
    unsigned* bar; unsigned x;
    volatile LAS unsigned* st;
};

__device__ __forceinline__ XcdBarrier xcd_barrier_post(unsigned* bar, volatile LAS unsigned* st) {
    XcdBarrier b; b.bar = bar; b.x = xb_xcc_id(); b.st = st;
    if (threadIdx.x == 0) (void)xb_add(&bar[XB_XCNT(b.x)], 1u);
    return b;
}
__device__ __forceinline__ void xcd_barrier_complete(unsigned* bar, unsigned x, unsigned& nloc, unsigned& nx) {
    const unsigned G = gridDim.x * gridDim.y * gridDim.z;
    unsigned sum, cnt, mine, sp = 0u;
    for (;;) {
        sum = 0u; cnt = 0u; mine = 0u;
#pragma unroll
        for (unsigned j = 0; j < 16; ++j) { const unsigned c = xb_ld(&bar[XB_XCNT(j)]); sum += c; cnt += (c > 0u) ? 1u : 0u; mine = (j == x) ? c : mine; }
        if (sum == G) break;
        __builtin_amdgcn_s_sleep(1);
        if ((++sp & 255u) == 0u) { if (xb_ld(&bar[XB_TMO])) break; if (sp > XB_SPIN_CAP) { atomicAdd(&bar[XB_TMO], 1u); break; } }
    }
    nloc = mine > 0u ? mine : 1u; nx = cnt > 0u ? cnt : 1u;
}

__device__ __forceinline__ void xcd_barrier(const XcdBarrier& b) {
    asm volatile("s_waitcnt vmcnt(0)" ::: "memory");
    __syncthreads();
    if (threadIdx.x == 0) {
        unsigned* bar = b.bar;
        __builtin_amdgcn_s_waitcnt(0);
        unsigned nloc = b.st[0], nx = b.st[1];
        if (nloc == 0u) { xcd_barrier_complete(bar, b.x, nloc, nx); b.st[0] = nloc; b.st[1] = nx; }
        const unsigned old = xb_add(&bar[XB_XSUB(b.x)], 1u);
        const unsigned gen = old / nloc;
        if (old + 1u == (gen + 1u) * nloc) {
            __builtin_amdgcn_fence(__ATOMIC_RELEASE, "agent");
            asm volatile("s_waitcnt vmcnt(0)" ::: "memory");
            const unsigned og = xb_add(&bar[XB_TOP], 1u);
            const unsigned tg = og / nx;
            if (og + 1u == (tg + 1u) * nx) xb_add(&bar[XB_TOPGEN], 1u);
            else XB_SPIN(xb_ld(&bar[XB_TOPGEN]) == tg, bar);
            __builtin_amdgcn_fence(__ATOMIC_ACQUIRE, "agent");
            xb_add(&bar[XB_XGEN(b.x)], 1u);
            asm volatile("s_waitcnt vmcnt(0)" ::: "memory");
        } else {
            XB_SPIN(xb_ld(&bar[XB_XGEN(b.x)]) == gen, bar);
            __builtin_amdgcn_fence(__ATOMIC_ACQUIRE, "agent");
            asm volatile("s_waitcnt vmcnt(0)" ::: "memory");
        }
    }
    __syncthreads();
}


__global__ void __launch_bounds__(256, 2) mega(Params p) {
  extern __shared__ __attribute__((aligned(16))) char smem[];
  cg::grid_group grid = cg::this_grid();
  const int tid = threadIdx.x, lane = tid & 63, wave = tid >> 6;
  const int nb = gridDim.x, bid = blockIdx.x;
  float* smf = (float*)smem;
  if (p.ws == nullptr) grid.sync();
  volatile LAS unsigned* xst = (volatile LAS unsigned*)(smem + SMEM_XB);
  if (tid == 0) { xst[0] = 0u; xst[1] = 0u; }
  __syncthreads();
  const XcdBarrier xb = xcd_barrier_post((unsigned*)(p.ws + OFF_BAR), xst);
  u16* sA = (u16*)smem;
  u16* sB = (u16*)(smem + 128 * 64 * 2);

  for (int rep_ = 0; rep_ < NREP(0); ++rep_) if (PHON(0)) {
    const int N_MOD = 96, N_TIN = 16 * 68, N_TOA = 8 * 16, N_TOH = 8 * 16, N_TOUT = 16 * 16, N_TQ = 16 * 16, N_HID = 1024;
    const int total = N_MOD + N_TIN + N_TOA + N_TOH + N_TOUT + N_TQ + N_HID + 1;
    for (int it = bid; it < total; it += nb) {
      int i = it;
      if (i < N_MOD) { p0_mod(p, i, smf); continue; }
      i -= N_MOD;
      if (i < N_TIN) { transpose_tile(p.w_in, INW, 1024, (u16*)(p.ws + OFF_WIN), i, smf); continue; }
      i -= N_TIN;
      if (i < N_TOA) { transpose_tile(p.w_o_attn, 1024, 512, (u16*)(p.ws + OFF_WOA), i, smf); continue; }
      i -= N_TOA;
      if (i < N_TOH) { transpose_tile(p.w_o_hy, 1024, 512, (u16*)(p.ws + OFF_WOH), i, smf); continue; }
      i -= N_TOH;
      if (i < N_TOUT) { transpose_tile(p.w_out, 1024, 1024, (u16*)(p.ws + OFF_WOUT), i, smf); continue; }
      i -= N_TOUT;
      if (i < N_TQ) { transpose_tile(p.peer_wq, 1024, 1024, (u16*)(p.ws + OFF_WQ), i, smf); continue; }
      i -= N_TQ;
      if (i < N_HID) { p0_hidden(p, i, smf); continue; }
      float2* rope = (float2*)(p.ws + OFF_ROPE);
      for (int idx = tid; idx < 1024; idx += 256) {
        const int pos = idx >> 4, f = idx & 15;
        const float inv = powf(10000.f, -(float)f / 16.f);
        const float ang = (float)pos * inv;
        rope[idx] = make_float2(cosf(ang), sinf(ang));
      }
    }
    convert_flat(p.peer_keys, (u16*)(p.ws + OFF_KEYS), (size_t)131072);
    convert_flat_fp8(p.peer_u, (unsigned char*)(p.ws + OFF_UBF), (size_t)16384 * 1024, 512.f);
    convert_flat_fp8(p.peer_v, (unsigned char*)(p.ws + OFF_VBF), (size_t)16384 * 1024, 64.f);
  }
  xcd_barrier(xb);

  for (int rep_ = 0; rep_ < NREP(1); ++rep_) if (PHON(1)) {
    const float* mod = (const float*)(p.ws + OFF_MOD);
    const int nrows = T_TOK + 1024;
    for (int r = bid * 4 + wave; r < nrows; r += nb * 4) {
      if (r < T_TOK) {
        const int b = r >> 12;
        norm_row(p.x + (size_t)r * 1024, p.norm1_g, mod + b * 6144, mod + b * 6144 + 1024,
                 (u16*)((char*)p.out + OO_H1) + (size_t)r * 1024, lane);
      } else {
        const int rc = r - T_TOK;
        norm_row(p.ctx + (size_t)rc * 1024, p.norm1_g, mod + 4 * 6144, mod + 4 * 6144 + 1024,
                 (u16*)((char*)p.out + OO_HC) + (size_t)rc * 1024, lane);
      }
    }
    for (int it = bid; it < 128; it += nb) p1_filter(p, it, smf);
  }
  xcd_barrier(xb);

  for (int rep_ = 0; rep_ < NREP(2); ++rep_) if (PHON(2)) {
    if (nb == 512) {
      const int xg = bid & 7, slot = bid >> 3;
      for (int r = 0; r < 8; ++r) {
        const int sup = r * 8 + xg;
        const int mt = (sup >> 2) * 8 + (slot >> 3), nt = (sup & 3) * 8 + (slot & 7);
        p2_inproj(p, mt * 34 + nt, sA, sB);
      }
      if (bid < 256) p2_inproj(p, (bid >> 1) * 34 + 32 + (bid & 1), sA, sB);
      else if (bid < 272) p2_ctxkv(p, bid - 256, sA, sB);
    } else {
      const int total = 128 * 34 + 16;
      for (int it = bid; it < total; it += nb) {
        if (it < 128 * 34) p2_inproj(p, it, sA, sB);
        else p2_ctxkv(p, it - 128 * 34, sA, sB);
      }
    }
  }
  xcd_barrier(xb);

  for (int rep_ = 0; rep_ < NREP(3); ++rep_) if (PHON(3)) {
    const int total = 1024 + 2048;
    for (int it = bid; it < total; it += nb) {
      if (it < 1024) p3_attn(p, it, (u16*)smem, (u16*)(smem + 128 * 72 * 2));
      else p3_hypre(p, it - 1024, (u16*)smem);
    }
  }
  xcd_barrier(xb);

  for (int rep_ = 0; rep_ < NREP(4); ++rep_) if (PHON(4)) for (int it = bid; it < 512; it += nb) p3_toeplitz(p, it, smem);
  xcd_barrier(xb);

  for (int rep_ = 0; rep_ < NREP(5); ++rep_) if (PHON(5)) for (int it = bid; it < 1024; it += nb) p4_merge(p, (nb == 512) ? ((((it >> 9) * 8 + (bid & 7)) * 8 + (bid >> 6)) * 8 + ((bid >> 3) & 7)) : it, sA, sB);
  xcd_barrier(xb);

  for (int rep_ = 0; rep_ < NREP(6); ++rep_) if (PHON(6)) for (int it = bid; it < 1024; it += nb) p5_out(p, (nb == 512) ? ((((it >> 9) * 8 + (bid & 7)) * 8 + (bid >> 6)) * 8 + ((bid >> 3) & 7)) : it, sA, sB);
  xcd_barrier(xb);

  for (int rep_ = 0; rep_ < NREP(7); ++rep_) if (PHON(7)) {
    const float* mod = (const float*)(p.ws + OFF_MOD);
    for (int r = bid * 4 + wave; r < T_TOK; r += nb * 4) {
      const int b = r >> 12;
      norm_row(p.out + (size_t)r * 1024, p.norm2_g, mod + b * 6144 + 3072, mod + b * 6144 + 4096,
               (u16*)(p.ws + OFF_H2) + (size_t)r * 1024, lane);
    }
  }
  xcd_barrier(xb);

  for (int rep_ = 0; rep_ < NREP(8); ++rep_) if (PHON(8)) for (int it = bid; it < 1024; it += nb) p7_qp(p, (nb == 512) ? ((((it >> 9) * 8 + (bid & 7)) * 8 + (bid >> 6)) * 8 + ((bid >> 3) & 7)) : it, sA, sB);
  xcd_barrier(xb);

  for (int rep_ = 0; rep_ < NREP(9); ++rep_) if (PHON(9)) for (int it = bid * 4 + wave; it < 8192; it += nb * 4) p8_route(p, it, smem + wave * 4096);
  xcd_barrier(xb);

  if (PHON(10)) for (int it = bid * 4 + wave; it < 4096; it += nb * 4) p9_experts4(p, it, smem + wave * 13312);
}

extern "C" void kernel_launch(void* const* d_in, const int* in_sizes, int n_in, void* d_out, int out_size,
                              void* d_ws, size_t ws_size, hipStream_t stream) {
  static int grid_blocks = 0;
  if (!grid_blocks) {
    int dev = 0, cus = 0, per_cu = 0;
    (void)hipGetDevice(&dev);
    (void)hipDeviceGetAttribute(&cus, hipDeviceAttributeMultiprocessorCount, dev);
    (void)hipFuncSetAttribute((const void*)mega, hipFuncAttributeMaxDynamicSharedMemorySize, SMEM_BYTES);
    (void)hipOccupancyMaxActiveBlocksPerMultiprocessor(&per_cu, mega, 256, SMEM_BYTES);
    if (per_cu > 2) per_cu = 2;
    if (per_cu < 1) per_cu = 1;
    grid_blocks = cus * per_cu;
  }
  Params p{};
  const float** pp = (const float**)&p;
  for (int i = 0; i < 28; ++i) pp[i] = (const float*)d_in[i];
  p.out = (float*)d_out;
  p.ws = (char*)d_ws;
  (void)hipMemsetAsync((char*)d_ws + OFF_BAR, 0, XCD_BAR_WORDS * sizeof(unsigned), stream);
  void* args[] = {&p};
  hipError_t e = hipLaunchCooperativeKernel((void*)mega, dim3(grid_blocks), dim3(256), args, SMEM_BYTES, stream);
  if (e != hipSuccess) fprintf(stderr, "cooperative launch failed: %s (grid %d)\n", hipGetErrorString(e), grid_blocks);
}
```

```cpp
#include <hip/hip_runtime.h>
#include <hip/hip_bf16.h>
#include <hip/hip_cooperative_groups.h>
#include <cstdio>
namespace cg = cooperative_groups;

typedef unsigned short u16;
typedef __attribute__((ext_vector_type(8))) short bf16x8;
typedef __attribute__((ext_vector_type(4))) float f32x4;
typedef __attribute__((ext_vector_type(4))) unsigned u32x4;

#define DEV __device__ __forceinline__
#ifndef PH
#define PH -1
#endif
#define PHON(n) (PH < 0 || PH == (n))
#ifndef REP
#define REP -1
#endif
#define NREP(n) ((REP == (n)) ? 2 : 1)

constexpr int T_TOK = 16384;
constexpr int DM = 1024;
constexpr int SEQL = 4096;
constexpr int INW = 4352;

struct Params {
  const float *x, *c, *ctx, *c_ctx, *w_mod, *b_mod, *norm1_g, *w_in, *attn_sink, *hy_conv_w, *hy_conv_b,
      *hy_fw1, *hy_fb1, *hy_fw2, *hy_fb2, *hy_fw3, *hy_fb3, *hy_freq, *hy_skip, *w_o_attn, *w_o_hy, *w_out,
      *norm2_g, *peer_wq, *peer_keys, *peer_u, *peer_v, *final_g;
  float* out;
  char* ws;
};

constexpr size_t MB = 1u << 20;
constexpr size_t OFF_MOD = 0;
constexpr size_t OFF_ROPE = 128 * 1024;
constexpr size_t OFF_NINV = OFF_ROPE + 8192;
constexpr size_t OFF_H2F = 256 * 1024;
constexpr size_t OFF_WIN = OFF_H2F + MB;
constexpr size_t OFF_WOA = OFF_WIN + 9 * MB;
constexpr size_t OFF_WOH = OFF_WOA + MB;
constexpr size_t OFF_WOUT = OFF_WOH + MB;
constexpr size_t OFF_WQ = OFF_WOUT + 2 * MB;
constexpr size_t OFF_KEYS = OFF_WQ + 2 * MB;
constexpr size_t OFF_UBF = OFF_KEYS + MB;
constexpr size_t OFF_VBF = OFF_UBF + 32 * MB;
constexpr size_t OFF_Q = OFF_VBF + 32 * MB;
constexpr size_t OFF_K = OFF_Q + 16 * MB;
constexpr size_t OFF_VT = OFF_K + 4 * MB;
constexpr size_t OFF_KC = OFF_VT + 4 * MB;
constexpr size_t OFF_VCT = OFF_KC + MB / 2;
constexpr size_t OFF_Z = OFF_VCT + MB / 2;
constexpr size_t OFF_GATE = OFF_Z + 48 * MB;
constexpr size_t OFF_YATT = OFF_GATE + 64 * MB;
constexpr size_t OFF_YHY = OFF_YATT + 16 * MB;
constexpr size_t OFF_RIDX = OFF_Q;
constexpr size_t OFF_RW = OFF_Q + 8 * MB;
constexpr size_t OFF_MERGED = OFF_Z;
constexpr size_t OFF_H2 = OFF_GATE;
constexpr size_t OFF_QP = OFF_GATE + 32 * MB;
constexpr size_t OO_H1 = 0;
constexpr size_t OO_UT = 0;
constexpr size_t OO_X0T = 16 * MB;
constexpr size_t OO_HC = 32 * MB;
constexpr size_t OO_G = 34 * MB;

constexpr int SMEM_BYTES = 70144;
constexpr size_t OFF_BAR = 160 * 1024;
constexpr int SMEM_XB = 70016;

DEV u16 f2bf(float f) {
  unsigned u = __float_as_uint(f);
  u += 0x7fffu + ((u >> 16) & 1u);
  return (u16)(u >> 16);
}
DEV float bf2f(u16 h) { return __uint_as_float(((unsigned)h) << 16); }
DEV unsigned pack2(float a, float b) { return (unsigned)f2bf(a) | ((unsigned)f2bf(b) << 16); }
DEV float bflo(unsigned w) { return __uint_as_float(w << 16); }
DEV float bfhi(unsigned w) { return __uint_as_float(w & 0xffff0000u); }
DEV float wave_sum(float v) {
#pragma unroll
  for (int o = 32; o > 0; o >>= 1) v += __shfl_xor(v, o);
  return v;
}
DEV float wave_max(float v) {
#pragma unroll
  for (int o = 32; o > 0; o >>= 1) v = fmaxf(v, __shfl_xor(v, o));
  return v;
}

DEV void p0_mod(const Params& p, int item, float* sm) {
  const int tid = threadIdx.x;
  for (int i = tid; i < 5 * 1024; i += 256) {
    int r = i >> 10, k = i & 1023;
    float c = (r < 4) ? p.c[r * 1024 + k] : p.c_ctx[k];
    sm[i] = c / (1.f + expf(-c));
  }
  __syncthreads();
  const int col = item * 64 + (tid & 63), kg = tid >> 6;
  float a0 = 0, a1 = 0, a2 = 0, a3 = 0, a4 = 0;
#pragma unroll 16
  for (int k = kg * 256; k < kg * 256 + 256; ++k) {
    float w = p.w_mod[(size_t)k * 6144 + col];
    a0 += sm[k] * w; a1 += sm[1024 + k] * w; a2 += sm[2048 + k] * w; a3 += sm[3072 + k] * w; a4 += sm[4096 + k] * w;
  }
  float* red = sm + 5 * 1024;
  red[(kg * 5 + 0) * 64 + (tid & 63)] = a0;
  red[(kg * 5 + 1) * 64 + (tid & 63)] = a1;
  red[(kg * 5 + 2) * 64 + (tid & 63)] = a2;
  red[(kg * 5 + 3) * 64 + (tid & 63)] = a3;
  red[(kg * 5 + 4) * 64 + (tid & 63)] = a4;
  __syncthreads();
  float* mod = (float*)(p.ws + OFF_MOD);
  for (int i = tid; i < 320; i += 256) {
    int r = i >> 6, cc = i & 63;
    float s = red[(0 * 5 + r) * 64 + cc] + red[(1 * 5 + r) * 64 + cc] + red[(2 * 5 + r) * 64 + cc] + red[(3 * 5 + r) * 64 + cc];
    mod[r * 6144 + item * 64 + cc] = s + p.b_mod[item * 64 + cc];
  }
  __syncthreads();
}

DEV void transpose_tile(const float* __restrict__ src, int N, int K, u16* __restrict__ dst, int tile, float* sm) {
  const int tid = threadIdx.x;
  const int nkt = K >> 6;
  const int kt = tile % nkt, nt = tile / nkt;
  const int k0 = kt * 64, n0 = nt * 64;
  const int c = tid & 63, r = tid >> 6;
#pragma unroll
  for (int rr = 0; rr < 16; ++rr) sm[(rr * 4 + r) * 65 + c] = src[(size_t)(k0 + rr * 4 + r) * N + n0 + c];
  __syncthreads();
  const int nn = tid >> 2, part = tid & 3;
  unsigned w[8];
#pragma unroll
  for (int j = 0; j < 8; ++j) w[j] = pack2(sm[(part * 16 + 2 * j) * 65 + nn], sm[(part * 16 + 2 * j + 1) * 65 + nn]);
  uint4* d = (uint4*)(dst + (size_t)(n0 + nn) * K + k0 + part * 16);
  d[0] = make_uint4(w[0], w[1], w[2], w[3]);
  d[1] = make_uint4(w[4], w[5], w[6], w[7]);
  __syncthreads();
}

DEV void p0_hidden(const Params& p, int item, float* sm) {
  const int tid = threadIdx.x;
  float* z = sm;
  float* h1 = sm + 4 * 36;
  if (tid < 4 * 33) {
    int tt = tid / 33, i = tid % 33;
    int t = item * 4 + tt;
    float v;
    if (i == 0) v = (float)t * (1.f / 4096.f);
    else {
      int band = (i <= 16) ? i : (i - 16);
      float fr = (float)((t * band) & 4095) * (1.f / 4096.f);
      v = (i <= 16) ? cospif(2.f * fr) : sinpif(2.f * fr);
    }
    z[tt * 36 + i] = v;
  }
  __syncthreads();
  const int tt = tid >> 6, j = tid & 63;
  float a = p.hy_fb1[j];
  for (int i = 0; i < 33; ++i) a += z[tt * 36 + i] * p.hy_fw1[i * 64 + j];
  const float fq = p.hy_freq[j];
  h1[tt * 64 + j] = sinf(fq * a);
  __syncthreads();
  float b = p.hy_fb2[j];
  for (int i = 0; i < 64; ++i) b += h1[tt * 64 + i] * p.hy_fw2[i * 64 + j];
  ((float*)(p.ws + OFF_H2F))[(item * 4 + tt) * 64 + j] = sinf(fq * b);
  __syncthreads();
}

DEV void convert_flat(const float* __restrict__ src, u16* __restrict__ dst, size_t n) {
  size_t stride = (size_t)gridDim.x * 256 * 8;
  for (size_t i = ((size_t)blockIdx.x * 256 + threadIdx.x) * 8; i < n; i += stride) {
    float4 a = *(const float4*)(src + i);
    float4 b = *(const float4*)(src + i + 4);
    *(uint4*)(dst + i) = make_uint4(pack2(a.x, a.y), pack2(a.z, a.w), pack2(b.x, b.y), pack2(b.z, b.w));
  }
}

typedef __attribute__((ext_vector_type(2))) float f32x2;
DEV void convert_flat_fp8(const float* __restrict__ src, unsigned char* __restrict__ dst, size_t n, float scale) {
  const size_t half = (size_t)gridDim.x * 256 * 16;
  const size_t stride = half * 2;
  for (size_t i = ((size_t)blockIdx.x * 256 + threadIdx.x) * 16; i < n; i += stride) {
    float4 a[8];
    const bool two = (i + half) < n;
#pragma unroll
    for (int q = 0; q < 4; ++q) a[q] = *(const float4*)(src + i + 4 * q);
    if (two) {
#pragma unroll
      for (int q = 0; q < 4; ++q) a[4 + q] = *(const float4*)(src + i + half + 4 * q);
    }
    unsigned w[8];
#pragma unroll
    for (int q = 0; q < 8; ++q) {
      int v = 0;
      v = __builtin_amdgcn_cvt_pk_fp8_f32(a[q].x * scale, a[q].y * scale, v, false);
      v = __builtin_amdgcn_cvt_pk_fp8_f32(a[q].z * scale, a[q].w * scale, v, true);
      w[q] = (unsigned)v;
    }
    *(uint4*)(dst + i) = make_uint4(w[0], w[1], w[2], w[3]);
    if (two) *(uint4*)(dst + i + half) = make_uint4(w[4], w[5], w[6], w[7]);
  }
}

DEV void norm_row(const float* __restrict__ xr, const float* __restrict__ g, const float* __restrict__ sh,
                  const float* __restrict__ sc, u16* __restrict__ dst, int lane) {
  float4 v[4];
  float ss = 0.f;
#pragma unroll
  for (int i = 0; i < 4; ++i) {
    v[i] = ((const float4*)xr)[lane + 64 * i];
    ss += v[i].x * v[i].x + v[i].y * v[i].y + v[i].z * v[i].z + v[i].w * v[i].w;
  }
  ss = wave_sum(ss);
  const float r = rsqrtf(ss * (1.f / 1024.f) + 1e-6f);
#pragma unroll
  for (int i = 0; i < 4; ++i) {
    const int idx = lane + 64 * i;
    float4 gg = ((const float4*)g)[idx], s1 = ((const float4*)sh)[idx], s2 = ((const float4*)sc)[idx];
    float y0 = v[i].x * r * gg.x * (1.f + s2.x) + s1.x;
    float y1 = v[i].y * r * gg.y * (1.f + s2.y) + s1.y;
    float y2 = v[i].z * r * gg.z * (1.f + s2.z) + s1.z;
    float y3 = v[i].w * r * gg.w * (1.f + s2.w) + s1.w;
    *(uint2*)(dst + idx * 4) = make_uint2(pack2(y0, y1), pack2(y2, y3));
  }
}

DEV void p1_filter(const Params& p, int item, float* sm) {
  const int tid = threadIdx.x;
  float* wc = sm;
  float* fb = sm + 512;
  float* dl = sm + 520;
  float* red = sm + 528;
  const int c0 = item * 4;
  for (int i = tid; i < 512; i += 256) {
    int j = i >> 6, k = i & 63;
    int col = (j < 4) ? (c0 + j) : (512 + c0 + j - 4);
    wc[j * 64 + k] = p.hy_fw3[k * 1024 + col];
  }
  if (tid < 8) fb[tid] = p.hy_fb3[(tid < 4) ? (c0 + tid) : (512 + c0 + tid - 4)];
  if (tid < 4) {
    const float a = logf(1e-2f) / 1.5f, b = logf(1e-2f) / 0.3f;
    float d = a + (b - a) * (float)(c0 + tid) / 511.f;
    dl[tid] = fabsf(d);
  }
  __syncthreads();
  u16* G = (u16*)((char*)p.out + OO_G);
  const float* H = (const float*)(p.ws + OFF_H2F);
  float as0 = 0, as1 = 0, as2 = 0, as3 = 0;
  for (int t = tid; t < 4096; t += 256) {
    const float4* hp = (const float4*)(H + t * 64);
    float d[8];
#pragma unroll
    for (int j = 0; j < 8; ++j) d[j] = fb[j];
#pragma unroll 1
    for (int q4 = 0; q4 < 16; q4 += 4) {
      float4 hv[4];
#pragma unroll
      for (int u = 0; u < 4; ++u) hv[u] = hp[q4 + u];
#pragma unroll
      for (int u = 0; u < 4; ++u)
#pragma unroll
        for (int j = 0; j < 8; ++j) {
          const float4 w = *(const float4*)(wc + j * 64 + 4 * (q4 + u));
          d[j] += hv[u].x * w.x + hv[u].y * w.y + hv[u].z * w.z + hv[u].w * w.w;
        }
    }
    const float tn = (float)t * (1.f / 4096.f);
    float asum[4];
#pragma unroll
    for (int j = 0; j < 4; ++j) {
      float dec = expf(-tn * dl[j]);
      float f = d[j] * dec, bw = d[4 + j] * dec;
      u16* Gc = G + (size_t)(c0 + j) * 8192;
      Gc[4095 - t] = f2bf(f);
      float s = fabsf(f);
      if (t < 4095) { Gc[4096 + t] = f2bf(bw); s += fabsf(bw); }
      else Gc[8191] = 0;
      asum[j] = s;
    }
    as0 += asum[0]; as1 += asum[1]; as2 += asum[2]; as3 += asum[3];
  }
  as0 = wave_sum(as0); as1 = wave_sum(as1); as2 = wave_sum(as2); as3 = wave_sum(as3);
  if ((tid & 63) == 0) {
    int w = tid >> 6;
    red[w * 4 + 0] = as0; red[w * 4 + 1] = as1; red[w * 4 + 2] = as2; red[w * 4 + 3] = as3;
  }
  __syncthreads();
  if (tid < 4) {
    float s = red[tid] + red[4 + tid] + red[8 + tid] + red[12 + tid];
    ((float*)(p.ws + OFF_NINV))[c0 + tid] = 1.f / s;
  }
  __syncthreads();
}

struct Acc { f32x4 v[4][4]; };

DEV void acc_zero(Acc& a) {
#pragma unroll
  for (int i = 0; i < 4; ++i)
#pragma unroll
    for (int j = 0; j < 4; ++j) a.v[i][j] = (f32x4){0.f, 0.f, 0.f, 0.f};
}

#define LDSAS __attribute__((address_space(3)))
DEV void gemm_kloop(const u16* __restrict__ A, int lda, const u16* __restrict__ Bt, int ldb, int K, int m0, int n0,
                    u16* sA, u16* sB_unused, Acc& acc) {
  const int tid = threadIdx.x, lane = tid & 63, wave = tid >> 6, wm = wave >> 1, wn = wave & 1;
  const int l15 = lane & 15, quad = lane >> 4;
  const int rsw = (l15 >> 1) & 7;
  const int nk = K >> 6;
  const int prow = lane >> 3;
  const int pch = lane & 7;
  const u16* gA[4];
  const u16* gB[4];
#pragma unroll
  for (int i = 0; i < 4; ++i) {
    const int row = (wave * 4 + i) * 8 + prow;
    const int c = pch ^ ((row >> 1) & 7);
    gA[i] = A + (size_t)(m0 + row) * lda + c * 8;
    gB[i] = Bt + (size_t)(n0 + row) * ldb + c * 8;
  }
  LDSAS char* lbase = (LDSAS char*)sA;
#define GEMM_DMA(KT, BUF)                                                                                   \
  _Pragma("unroll") for (int i = 0; i < 4; ++i) {                                                           \
    __builtin_amdgcn_global_load_lds((const unsigned*)(gA[i] + (KT) * 64), (LDSAS unsigned*)(lbase + (BUF) * 32768 + (wave * 4 + i) * 1024), 16, 0, 0);          \
    __builtin_amdgcn_global_load_lds((const unsigned*)(gB[i] + (KT) * 64), (LDSAS unsigned*)(lbase + (BUF) * 32768 + 16384 + (wave * 4 + i) * 1024), 16, 0, 0);  \
  }
  GEMM_DMA(0, 0)
  for (int kt = 0; kt < nk; ++kt) {
    asm volatile("s_waitcnt vmcnt(0)" ::: "memory");
    __syncthreads();
    const int buf = kt & 1;
    if (kt + 1 < nk) { GEMM_DMA(kt + 1, buf ^ 1) }
    const u16* tA = sA + buf * 16384;
    const u16* tB = tA + 8192;
#pragma unroll
    for (int ks = 0; ks < 2; ++ks) {
      const int cs = ((ks * 4 + quad) ^ rsw) * 8;
      bf16x8 af[4], bfr[4];
#pragma unroll
      for (int i = 0; i < 4; ++i) af[i] = *(const bf16x8*)(tB + (wn * 64 + i * 16 + l15) * 64 + cs);
#pragma unroll
      for (int j = 0; j < 4; ++j) bfr[j] = *(const bf16x8*)(tA + (wm * 64 + j * 16 + l15) * 64 + cs);
#pragma unroll
      for (int i = 0; i < 4; ++i)
#pragma unroll
        for (int j = 0; j < 4; ++j) acc.v[i][j] = __builtin_amdgcn_mfma_f32_16x16x32_bf16(af[i], bfr[j], acc.v[i][j], 0, 0, 0);
    }
  }
  __syncthreads();
}

DEV void p2_inproj(const Params& p, int tile, u16* sA, u16* sB) {
  const int mt = tile / 34, nt = tile % 34;
  const int m0 = mt * 128, n0 = nt * 128;
  Acc acc; acc_zero(acc);
  gemm_kloop((const u16*)((const char*)p.out + OO_H1), 1024, (const u16*)(p.ws + OFF_WIN), 1024, 1024, m0, n0, sA, sB, acc);
  const int tid = threadIdx.x, lane = tid & 63, wave = tid >> 6, wm = wave >> 1, wn = wave & 1;
  const int l15 = lane & 15, quad = lane >> 4;
  const int mb = m0 + wm * 64, nb = n0 + wn * 64;
  if (nb < 640) {
    const float2* rope = (const float2*)(p.ws + OFF_ROPE);
    const bool isq = nb < 512;
    const float qs = isq ? 0.125f : 1.f;
#pragma unroll
    for (int j = 0; j < 4; ++j) {
      const int m = mb + j * 16 + l15;
      const int b = m >> 12, l = m & 4095;
      const int prow = l >> 6, pcol = l & 63;
      u16* dst;
      if (isq) dst = (u16*)(p.ws + OFF_Q) + ((size_t)(b * 8 + (nb >> 6)) * 4096 + l) * 64;
      else dst = (u16*)(p.ws + OFF_K) + ((size_t)(b * 2 + ((nb - 512) >> 6)) * 4096 + l) * 64;
#pragma unroll
      for (int hh = 0; hh < 2; ++hh) {
        const int pos = hh ? pcol : prow;
        f32x4 x1 = acc.v[hh * 2][j], x2 = acc.v[hh * 2 + 1][j];
        float o1[4], o2[4];
#pragma unroll
        for (int r = 0; r < 4; ++r) {
          float2 cs = rope[pos * 16 + quad * 4 + r];
          o1[r] = (x1[r] * cs.x - x2[r] * cs.y) * qs;
          o2[r] = (x2[r] * cs.x + x1[r] * cs.y) * qs;
        }
        *(uint2*)(dst + hh * 32 + quad * 4) = make_uint2(pack2(o1[0], o1[1]), pack2(o1[2], o1[3]));
        *(uint2*)(dst + hh * 32 + 16 + quad * 4) = make_uint2(pack2(o2[0], o2[1]), pack2(o2[2], o2[3]));
      }
    }
  } else if (nb < 768) {
    const int g = (nb - 640) >> 6;
    u16* vt = (u16*)(p.ws + OFF_VT);
#pragma unroll
    for (int j = 0; j < 4; ++j) {
      const int m = mb + j * 16 + l15;
      const int b = m >> 12, l = m & 4095;
#pragma unroll
      for (int i = 0; i < 4; ++i)
#pragma unroll
        for (int r = 0; r < 4; ++r) {
          const int d = i * 16 + quad * 4 + r;
          vt[((size_t)(b * 2 + g) * 64 + d) * 4096 + l] = f2bf(acc.v[i][j][r]);
        }
    }
  } else if (nb < 2304) {
    u16* z = (u16*)(p.ws + OFF_Z);
#pragma unroll
    for (int j = 0; j < 4; ++j) {
      const int m = mb + j * 16 + l15;
#pragma unroll
      for (int i = 0; i < 4; ++i) {
        const int n = nb - 768 + i * 16 + quad * 4;
        f32x4 a = acc.v[i][j];
        *(uint2*)(z + (size_t)m * 1536 + n) = make_uint2(pack2(a[0], a[1]), pack2(a[2], a[3]));
      }
    }
  } else {
    u16* gt = (u16*)(p.ws + OFF_GATE);
#pragma unroll
    for (int j = 0; j < 4; ++j) {
      const int m = mb + j * 16 + l15;
#pragma unroll
      for (int i = 0; i < 4; ++i) {
        const int n = nb - 2304 + i * 16 + quad * 4;
        f32x4 a = acc.v[i][j];
        float s0 = 1.f / (1.f + __expf(-a[0])), s1 = 1.f / (1.f + __expf(-a[1]));
        float s2 = 1.f / (1.f + __expf(-a[2])), s3 = 1.f / (1.f + __expf(-a[3]));
        *(uint2*)(gt + (size_t)m * 2048 + n) = make_uint2(pack2(s0, s1), pack2(s2, s3));
      }
    }
  }
}

DEV void p2_ctxkv(const Params& p, int tile, u16* sA, u16* sB) {
  const int mt = tile >> 1, nt = tile & 1;
  const int m0 = mt * 128, n0 = nt * 128;
  Acc acc; acc_zero(acc);
  gemm_kloop((const u16*)((const char*)p.out + OO_HC), 1024, (const u16*)(p.ws + OFF_WIN) + (size_t)512 * 1024, 1024, 1024, m0, n0, sA, sB, acc);
  const int tid = threadIdx.x, lane = tid & 63, wave = tid >> 6, wm = wave >> 1, wn = wave & 1;
  const int l15 = lane & 15, quad = lane >> 4;
  const int mb = m0 + wm * 64, nb = n0 + wn * 64;
  const int g = (nb >> 6) & 1;
  if (nb < 128) {
    u16* kc = (u16*)(p.ws + OFF_KC);
#pragma unroll
    for (int j = 0; j < 4; ++j) {
      const int m = mb + j * 16 + l15;
      const int b = m >> 8, c = m & 255;
#pragma unroll
      for (int i = 0; i < 4; ++i) {
        f32x4 a = acc.v[i][j];
        *(uint2*)(kc + ((size_t)(b * 2 + g) * 256 + c) * 64 + i * 16 + quad * 4) = make_uint2(pack2(a[0], a[1]), pack2(a[2], a[3]));
      }
    }
  } else {
    u16* vct = (u16*)(p.ws + OFF_VCT);
#pragma unroll
    for (int j = 0; j < 4; ++j) {
      const int m = mb + j * 16 + l15;
      const int b = m >> 8, c = m & 255;
#pragma unroll
      for (int i = 0; i < 4; ++i)
#pragma unroll
        for (int r = 0; r < 4; ++r) {
          const int d = i * 16 + quad * 4 + r;
          vct[((size_t)(b * 2 + g) * 64 + d) * 256 + c] = f2bf(acc.v[i][j][r]);
        }
    }
  }
}

DEV void p3_attn(const Params& p, int item, u16* sK, u16* sVt) {
  const int tid = threadIdx.x, lane = tid & 63, wave = tid >> 6, l15 = lane & 15, quad = lane >> 4;
  const int n = item & 31, h = (item >> 5) & 7, b = item >> 8;
  const int g = h >> 2;
  const u16* Q = (const u16*)(p.ws + OFF_Q) + ((size_t)(b * 8 + h) * 4096 + n * 128 + wave * 32) * 64;
  bf16x8 bq[2][2];
#pragma unroll
  for (int qt = 0; qt < 2; ++qt)
#pragma unroll
    for (int ks = 0; ks < 2; ++ks) bq[qt][ks] = *(const bf16x8*)(Q + (qt * 16 + l15) * 64 + ks * 32 + quad * 8);
  const float sink = p.attn_sink[h];
  float mrun[2] = {sink, sink};
  float lrun[2];
  lrun[0] = lrun[1] = (quad == 0) ? 1.f : 0.f;
  f32x4 O[4][2];
#pragma unroll
  for (int dt = 0; dt < 4; ++dt)
#pragma unroll
    for (int qt = 0; qt < 2; ++qt) O[dt][qt] = (f32x4){0.f, 0.f, 0.f, 0.f};

  u32x4 pk[4], pv[4];
#define ATT_LOAD(KB)                                                                                  \
  {                                                                                                   \
    const u16* Ksrc; const u16* Vsrc; int vstride;                                                    \
    if ((KB) < 3) {                                                                                   \
      const int nbk = n + (KB) - 1;                                                                   \
      Ksrc = (const u16*)(p.ws + OFF_K) + ((size_t)(b * 2 + g) * 4096 + nbk * 128) * 64;              \
      Vsrc = (const u16*)(p.ws + OFF_VT) + (size_t)(b * 2 + g) * 64 * 4096 + nbk * 128;               \
      vstride = 4096;                                                                                 \
    } else {                                                                                          \
      const int cb = (KB) - 3;                                                                        \
      Ksrc = (const u16*)(p.ws + OFF_KC) + ((size_t)(b * 2 + g) * 256 + cb * 128) * 64;               \
      Vsrc = (const u16*)(p.ws + OFF_VCT) + (size_t)(b * 2 + g) * 64 * 256 + cb * 128;                \
      vstride = 256;                                                                                  \
    }                                                                                                 \
    _Pragma("unroll") for (int i = 0; i < 4; ++i) {                                                   \
      const int id = tid + i * 256;                                                                   \
      pk[i] = *(const u32x4*)(Ksrc + (id >> 3) * 64 + (id & 7) * 8);                                  \
      pv[i] = *(const u32x4*)(Vsrc + (size_t)(id >> 4) * vstride + (id & 15) * 8);                    \
    }                                                                                                 \
  }
  int kb = (n == 0) ? 1 : 0;
  ATT_LOAD(kb)
  while (kb < 5) {
#pragma unroll
    for (int i = 0; i < 4; ++i) {
      const int id = tid + i * 256;
      *(u32x4*)(sK + (id >> 3) * 72 + (id & 7) * 8) = pk[i];
      *(u32x4*)(sVt + (id >> 4) * 136 + (id & 15) * 8) = pv[i];
    }
    __syncthreads();
    int nx = kb + 1;
    if (nx == 2 && n == 31) nx = 3;
    if (nx < 5) ATT_LOAD(nx)
#pragma unroll 1
    for (int c4 = 0; c4 < 4; ++c4) {
      f32x4 s[2][2];
#pragma unroll
      for (int kt = 0; kt < 2; ++kt) {
        bf16x8 ak0 = *(const bf16x8*)(sK + (c4 * 32 + kt * 16 + l15) * 72 + quad * 8);
        bf16x8 ak1 = *(const bf16x8*)(sK + (c4 * 32 + kt * 16 + l15) * 72 + 32 + quad * 8);
#pragma unroll
        for (int qt = 0; qt < 2; ++qt) {
          f32x4 z = (f32x4){0.f, 0.f, 0.f, 0.f};
          z = __builtin_amdgcn_mfma_f32_16x16x32_bf16(ak0, bq[qt][0], z, 0, 0, 0);
          z = __builtin_amdgcn_mfma_f32_16x16x32_bf16(ak1, bq[qt][1], z, 0, 0, 0);
          s[kt][qt] = z;
        }
      }
      if (kb == 0 || kb == 2) {
#pragma unroll
        for (int kt = 0; kt < 2; ++kt)
#pragma unroll
          for (int qt = 0; qt < 2; ++qt)
#pragma unroll
            for (int r = 0; r < 4; ++r) {
              const int kk = c4 * 32 + kt * 16 + quad * 4 + r;
              const int qq = wave * 32 + qt * 16 + l15;
              const bool valid = (kb == 0) ? (kk >= qq) : (kk <= qq);
              if (!valid) s[kt][qt][r] = -INFINITY;
            }
      }
      bf16x8 bp[2];
#pragma unroll
      for (int qt = 0; qt < 2; ++qt) {
        float cm = fmaxf(fmaxf(fmaxf(s[0][qt][0], s[0][qt][1]), fmaxf(s[0][qt][2], s[0][qt][3])),
                         fmaxf(fmaxf(s[1][qt][0], s[1][qt][1]), fmaxf(s[1][qt][2], s[1][qt][3])));
        cm = fmaxf(cm, __shfl_xor(cm, 16));
        cm = fmaxf(cm, __shfl_xor(cm, 32));
        const float mnew = fmaxf(mrun[qt], cm);
        const float alpha = __expf(mrun[qt] - mnew);
        mrun[qt] = mnew;
        float ps = 0.f;
        float pv[8];
#pragma unroll
        for (int r = 0; r < 4; ++r) {
          pv[r] = __expf(s[0][qt][r] - mnew);
          pv[4 + r] = __expf(s[1][qt][r] - mnew);
          ps += pv[r] + pv[4 + r];
        }
        lrun[qt] = lrun[qt] * alpha + ps;
#pragma unroll
        for (int dt = 0; dt < 4; ++dt) {
          O[dt][qt][0] *= alpha; O[dt][qt][1] *= alpha; O[dt][qt][2] *= alpha; O[dt][qt][3] *= alpha;
        }
        union { bf16x8 v; unsigned u[4]; } pk;
        pk.u[0] = pack2(pv[0], pv[1]); pk.u[1] = pack2(pv[2], pv[3]);
        pk.u[2] = pack2(pv[4], pv[5]); pk.u[3] = pack2(pv[6], pv[7]);
        bp[qt] = pk.v;
      }
#pragma unroll
      for (int dt = 0; dt < 4; ++dt) {
        union { bf16x8 v; uint2 h[2]; } av;
        const u16* vrow = sVt + (dt * 16 + l15) * 136 + c4 * 32 + quad * 4;
        av.h[0] = *(const uint2*)(vrow);
        av.h[1] = *(const uint2*)(vrow + 16);
#pragma unroll
        for (int qt = 0; qt < 2; ++qt) O[dt][qt] = __builtin_amdgcn_mfma_f32_16x16x32_bf16(av.v, bp[qt], O[dt][qt], 0, 0, 0);
      }
    }
    __syncthreads();
    kb = nx;
  }
  u16* Y = (u16*)(p.ws + OFF_YATT);
#pragma unroll
  for (int qt = 0; qt < 2; ++qt) {
    float l = lrun[qt];
    l += __shfl_xor(l, 16);
    l += __shfl_xor(l, 32);
    const float inv = 1.f / l;
    const int t = b * 4096 + n * 128 + wave * 32 + qt * 16 + l15;
#pragma unroll
    for (int dt = 0; dt < 4; ++dt) {
      f32x4 o = O[dt][qt];
      *(uint2*)(Y + (size_t)t * 512 + h * 64 + dt * 16 + quad * 4) = make_uint2(pack2(o[0] * inv, o[1] * inv), pack2(o[2] * inv, o[3] * inv));
    }
  }
}

DEV void p3_hypre(const Params& p, int item, u16* sm) {
  const int tid = threadIdx.x;
  const int cb = item & 7, tb = (item >> 3) & 63, b = item >> 9;
  const int tq = tid >> 6, ch = tid & 63;
  const int c = cb * 64 + ch;
  u16* su = sm;
  u16* sx = sm + 64 * 66;
  float w[3][3], bias[3];
#pragma unroll
  for (int s = 0; s < 3; ++s) {
#pragma unroll
    for (int k = 0; k < 3; ++k) w[s][k] = p.hy_conv_w[k * 1536 + s * 512 + c];
    bias[s] = p.hy_conv_b[s * 512 + c];
  }
  const u16* Z = (const u16*)(p.ws + OFF_Z) + (size_t)b * 4096 * 1536;
  const int l0 = tb * 64 + tq * 16;
  float zv[18][3];
#pragma unroll
  for (int i = 0; i < 18; ++i) {
    const int l = l0 - 1 + i;
    const bool ok = (l >= 0) && (l < 4096);
    const int lc = ok ? l : l0;
#pragma unroll
    for (int s2 = 0; s2 < 3; ++s2) {
      const float v = bf2f(Z[(size_t)lc * 1536 + s2 * 512 + c]);
      zv[i][s2] = ok ? v : 0.f;
    }
  }
#pragma unroll
  for (int i = 0; i < 16; ++i) {
    float cv[3];
#pragma unroll
    for (int s2 = 0; s2 < 3; ++s2) cv[s2] = zv[i][s2] * w[s2][0] + zv[i + 1][s2] * w[s2][1] + zv[i + 2][s2] * w[s2][2] + bias[s2];
    su[ch * 66 + tq * 16 + i] = f2bf(cv[2] * cv[1]);
    sx[ch * 66 + tq * 16 + i] = f2bf(cv[0]);
  }
  __syncthreads();
  const int chr = tid >> 2, part = tid & 3;
  const int cc = cb * 64 + chr;
  const unsigned* ru = (const unsigned*)(su + chr * 66 + part * 16);
  const unsigned* rx = (const unsigned*)(sx + chr * 66 + part * 16);
  u16* UT = (u16*)((char*)p.out + OO_UT) + ((size_t)(cc * 4 + b) * 4096 + tb * 64 + part * 16);
  u16* XT = (u16*)((char*)p.out + OO_X0T) + ((size_t)(cc * 4 + b) * 4096 + tb * 64 + part * 16);
  ((uint4*)UT)[0] = make_uint4(ru[0], ru[1], ru[2], ru[3]);
  ((uint4*)UT)[1] = make_uint4(ru[4], ru[5], ru[6], ru[7]);
  ((uint4*)XT)[0] = make_uint4(rx[0], rx[1], rx[2], rx[3]);
  ((uint4*)XT)[1] = make_uint4(rx[4], rx[5], rx[6], rx[7]);
  __syncthreads();
}

DEV void p3_toeplitz(const Params& p, int c, char* smem) {
  const int tid = threadIdx.x, lane = tid & 63, wave = tid >> 6, l15 = lane & 15, quad = lane >> 4;
  u16* sG0 = (u16*)smem;
  u16* sG1 = (u16*)(smem + 16384 + 64);
  u16* sU = (u16*)(smem + 32768 + 128);
  u16* sZ = sU + 4 * 64 * 72;
  const u16* G = (const u16*)((const char*)p.out + OO_G) + (size_t)c * 8192;
  const u16* UT = (const u16*)((const char*)p.out + OO_UT) + (size_t)c * 16384;
#pragma unroll
  for (int i = 0; i < 4; ++i) {
    const int id = tid + i * 256;
    *(uint4*)(sG0 + id * 8) = *(const uint4*)(G + id * 8);
  }
#pragma unroll
  for (int i = 0; i < 8; ++i) {
    const int id = tid + i * 256;
    const int bb = id >> 9, blk = (id >> 3) & 63, c8 = id & 7;
    *(uint4*)(sU + (bb * 64 + blk) * 72 + c8 * 8) = *(const uint4*)(UT + id * 8);
  }
  if (tid < 72) sZ[tid] = 0;
  __syncthreads();
  for (int i = tid; i < 8192; i += 256) sG1[i] = (i < 8191) ? sG0[i + 1] : (u16)0;
  __syncthreads();

  Acc acc; acc_zero(acc);
  const u16* gbase = (l15 & 1) ? sG0 : (sG1 - 1);
  const u16* ubase = sU + wave * 64 * 72 + quad * 8;
  const u16* zbase = sZ + quad * 8;
  for (int d = -63; d <= 63; ++d) {
    const int base = 4095 - 64 * d - l15 + quad * 8;
    bf16x8 af[4][2];
#pragma unroll
    for (int mt = 0; mt < 4; ++mt)
#pragma unroll
      for (int ks = 0; ks < 2; ++ks) {
        const unsigned* gp = (const unsigned*)(gbase + base - mt * 16 + ks * 32);
        union { bf16x8 v; unsigned u[4]; } t;
        t.u[0] = gp[0]; t.u[1] = gp[1]; t.u[2] = gp[2]; t.u[3] = gp[3];
        af[mt][ks] = t.v;
      }
#pragma unroll
    for (int nt = 0; nt < 4; ++nt) {
      if (nt * 16 + 15 - d < 0 || nt * 16 - d > 63) continue;
      const int ip = nt * 16 + l15 - d;
      const u16* up = (ip >= 0 && ip < 64) ? (ubase + ip * 72) : zbase;
      bf16x8 b0 = *(const bf16x8*)(up);
      bf16x8 b1 = *(const bf16x8*)(up + 32);
#pragma unroll
      for (int mt = 0; mt < 4; ++mt) {
        acc.v[mt][nt] = __builtin_amdgcn_mfma_f32_16x16x32_bf16(af[mt][0], b0, acc.v[mt][nt], 0, 0, 0);
        acc.v[mt][nt] = __builtin_amdgcn_mfma_f32_16x16x32_bf16(af[mt][1], b1, acc.v[mt][nt], 0, 0, 0);
      }
    }
  }
  const float ninv = ((const float*)(p.ws + OFF_NINV))[c];
  const float skip = p.hy_skip[c];
  const u16* XT = (const u16*)((const char*)p.out + OO_X0T) + ((size_t)(c * 4 + wave) * 4096);
  u16* Y = (u16*)(p.ws + OFF_YHY);
#pragma unroll
  for (int nt = 0; nt < 4; ++nt) {
    const int ib = nt * 16 + l15;
#pragma unroll
    for (int mt = 0; mt < 4; ++mt) {
      const int r0 = mt * 16 + quad * 4;
      const int t = ib * 64 + r0;
      uint2 uu = *(const uint2*)(sU + (wave * 64 + ib) * 72 + r0);
      uint2 xx = *(const uint2*)(XT + t);
      float uv[4] = {bflo(uu.x), bfhi(uu.x), bflo(uu.y), bfhi(uu.y)};
      float xv[4] = {bflo(xx.x), bfhi(xx.x), bflo(xx.y), bfhi(xx.y)};
#pragma unroll
      for (int r = 0; r < 4; ++r) {
        float y = acc.v[mt][nt][r] * ninv + uv[r] * skip;
        Y[(size_t)(wave * 4096 + t + r) * 512 + c] = f2bf(y * xv[r]);
      }
    }
  }
  __syncthreads();
}

DEV void p4_merge(const Params& p, int tile, u16* sA, u16* sB) {
  const int mt = tile >> 3, nt = tile & 7;
  const int m0 = mt * 128, n0 = nt * 128;
  const int tid = threadIdx.x, lane = tid & 63, wave = tid >> 6, wm = wave >> 1, wn = wave & 1;
  const int l15 = lane & 15, quad = lane >> 4;
  const int mb = m0 + wm * 64, nb = n0 + wn * 64;
  const u16* gt = (const u16*)(p.ws + OFF_GATE);
  u16* mg = (u16*)(p.ws + OFF_MERGED);
  Acc a1; acc_zero(a1);
  gemm_kloop((const u16*)(p.ws + OFF_YATT), 512, (const u16*)(p.ws + OFF_WOA), 512, 512, m0, n0, sA, sB, a1);
  asm volatile("" ::: "memory");
#pragma unroll
  for (int j = 0; j < 4; ++j) {
    const int m = mb + j * 16 + l15;
#pragma unroll
    for (int i = 0; i < 4; ++i) {
      const int n = nb + i * 16 + quad * 4;
      uint2 ga = *(const uint2*)(gt + (size_t)m * 2048 + n);
      f32x4 x = a1.v[i][j];
      *(uint2*)(mg + (size_t)m * 1024 + n) = make_uint2(pack2(bflo(ga.x) * x[0], bfhi(ga.x) * x[1]), pack2(bflo(ga.y) * x[2], bfhi(ga.y) * x[3]));
    }
  }
  asm volatile("" ::: "memory");
  acc_zero(a1);
  gemm_kloop((const u16*)(p.ws + OFF_YHY), 512, (const u16*)(p.ws + OFF_WOH), 512, 512, m0, n0, sA, sB, a1);
  asm volatile("" ::: "memory");
#pragma unroll
  for (int j = 0; j < 4; ++j) {
    const int m = mb + j * 16 + l15;
#pragma unroll
    for (int i = 0; i < 4; ++i) {
      const int n = nb + i * 16 + quad * 4;
      uint2 gh = *(const uint2*)(gt + (size_t)m * 2048 + 1024 + n);
      uint2 pv = *(const uint2*)(mg + (size_t)m * 1024 + n);
      f32x4 y = a1.v[i][j];
      float o0 = bflo(pv.x) + bflo(gh.x) * y[0];
      float o1 = bfhi(pv.x) + bfhi(gh.x) * y[1];
      float o2 = bflo(pv.y) + bflo(gh.y) * y[2];
      float o3 = bfhi(pv.y) + bfhi(gh.y) * y[3];
      *(uint2*)(mg + (size_t)m * 1024 + n) = make_uint2(pack2(o0, o1), pack2(o2, o3));
    }
  }
}

DEV void p5_out(const Params& p, int tile, u16* sA, u16* sB) {
  const int mt = tile >> 3, nt = tile & 7;
  const int m0 = mt * 128, n0 = nt * 128;
  Acc acc; acc_zero(acc);
  gemm_kloop((const u16*)(p.ws + OFF_MERGED), 1024, (const u16*)(p.ws + OFF_WOUT), 1024, 1024, m0, n0, sA, sB, acc);
  const int tid = threadIdx.x, lane = tid & 63, wave = tid >> 6, wm = wave >> 1, wn = wave & 1;
  const int l15 = lane & 15, quad = lane >> 4;
  const int mb = m0 + wm * 64, nb = n0 + wn * 64;
  const float* mod = (const float*)(p.ws + OFF_MOD);
#pragma unroll
  for (int j = 0; j < 4; ++j) {
    const int m = mb + j * 16 + l15;
    const int b = m >> 12;
#pragma unroll
    for (int i = 0; i < 4; ++i) {
      const int n = nb + i * 16 + quad * 4;
      float4 g1 = *(const float4*)(mod + b * 6144 + 2048 + n);
      float4 xv = *(const float4*)(p.x + (size_t)m * 1024 + n);
      f32x4 a = acc.v[i][j];
      float4 o = make_float4(xv.x + g1.x * a[0], xv.y + g1.y * a[1], xv.z + g1.z * a[2], xv.w + g1.w * a[3]);
      *(float4*)(p.out + (size_t)m * 1024 + n) = o;
    }
  }
}

DEV void p7_qp(const Params& p, int tile, u16* sA, u16* sB) {
  const int mt = tile >> 3, nt = tile & 7;
  const int m0 = mt * 128, n0 = nt * 128;
  Acc acc; acc_zero(acc);
  gemm_kloop((const u16*)(p.ws + OFF_H2), 1024, (const u16*)(p.ws + OFF_WQ), 1024, 1024, m0, n0, sA, sB, acc);
  const int tid = threadIdx.x, lane = tid & 63, wave = tid >> 6, wm = wave >> 1, wn = wave & 1;
  const int l15 = lane & 15, quad = lane >> 4;
  const int mb = m0 + wm * 64, nb = n0 + wn * 64;
  u16* qp = (u16*)(p.ws + OFF_QP);
#pragma unroll
  for (int j = 0; j < 4; ++j) {
    const int m = mb + j * 16 + l15;
#pragma unroll
    for (int i = 0; i < 4; ++i) {
      const int n = nb + i * 16 + quad * 4;
      f32x4 a = acc.v[i][j];
      *(uint2*)(qp + (size_t)m * 1024 + n) = make_uint2(pack2(a[0], a[1]), pack2(a[2], a[3]));
    }
  }
}

DEV unsigned f2ord(float f) {
  const unsigned u = __float_as_uint(f);
  return u ^ (((int)u >> 31) | 0x80000000u);
}
DEV float ord2f(unsigned k) {
  const unsigned m = (k & 0x80000000u) ? 0x80000000u : 0xffffffffu;
  return __uint_as_float(k ^ m);
}
DEV unsigned umax_(unsigned a, unsigned b) { return a > b ? a : b; }
DEV unsigned umin_(unsigned a, unsigned b) { return a < b ? a : b; }

DEV void sort16_desc(unsigned (&v)[16]) {
#pragma unroll
  for (int k = 2; k <= 16; k <<= 1)
#pragma unroll
    for (int j = k >> 1; j > 0; j >>= 1)
#pragma unroll
      for (int i = 0; i < 16; ++i) {
        const int l = i ^ j;
        if (l > i) {
          const bool desc = ((i & k) == 0);
          const unsigned a = v[i], b = v[l];
          const unsigned hi = umax_(a, b), lo = umin_(a, b);
          v[i] = desc ? hi : lo;
          v[l] = desc ? lo : hi;
        }
      }
}
DEV void merge16_desc(unsigned (&v)[16]) {
#pragma unroll
  for (int j = 8; j > 0; j >>= 1)
#pragma unroll
    for (int i = 0; i < 16; ++i) {
      const int l = i ^ j;
      if (l > i) {
        const unsigned a = v[i], b = v[l];
        v[i] = umax_(a, b);
        v[l] = umin_(a, b);
      }
    }
}
DEV void xmerge16(unsigned (&v)[16], int off) {
  unsigned pr[16];
#pragma unroll
  for (int i = 0; i < 16; ++i) pr[i] = (unsigned)__shfl_xor((int)v[i], off);
#pragma unroll
  for (int i = 0; i < 16; ++i) v[i] = umax_(v[i], pr[15 - i]);
  merge16_desc(v);
}

DEV void route_top16_of_128(const u16* __restrict__ keys, const u16* __restrict__ qp, int l15, int quad, unsigned (&out)[16]) {
  bf16x8 b0 = *(const bf16x8*)(qp);
  bf16x8 b1 = *(const bf16x8*)(qp + 32);
  unsigned ka[16], kb[16];
#pragma unroll
  for (int kt = 0; kt < 8; ++kt) {
    bf16x8 a0 = *(const bf16x8*)(keys + (kt * 16 + l15) * 64 + quad * 8);
    bf16x8 a1 = *(const bf16x8*)(keys + (kt * 16 + l15) * 64 + 32 + quad * 8);
    f32x4 z = (f32x4){0.f, 0.f, 0.f, 0.f};
    z = __builtin_amdgcn_mfma_f32_16x16x32_bf16(a0, b0, z, 0, 0, 0);
    z = __builtin_amdgcn_mfma_f32_16x16x32_bf16(a1, b1, z, 0, 0, 0);
#pragma unroll
    for (int r = 0; r < 4; ++r) {
      const unsigned key = (f2ord(z[r]) & ~127u) | (unsigned)(kt * 16 + quad * 4 + r);
      if (kt < 4) ka[kt * 4 + r] = key; else kb[(kt - 4) * 4 + r] = key;
    }
  }
  sort16_desc(ka);
  sort16_desc(kb);
#pragma unroll
  for (int i = 0; i < 16; ++i) out[i] = umax_(ka[i], kb[15 - i]);
  merge16_desc(out);
  xmerge16(out, 16);
  xmerge16(out, 32);
}

DEV void p8_route(const Params& p, int task, char* wsm) {
  static constexpr unsigned char kTab[52] = {
      0x00, 0x01, 0x02, 0x03, 0x04, 0x05, 0x06, 0x07, 0x08, 0x09, 0x0A, 0x0B, 0x0C, 0x0D, 0x0E, 0x0F,
      0x10, 0x11, 0x12, 0x13, 0x14, 0x15, 0x16, 0x17, 0x20, 0x21, 0x22, 0x23, 0x24, 0x30, 0x31, 0x32, 0x33,
      0x40, 0x41, 0x42, 0x50, 0x51, 0x60, 0x61, 0x70, 0x71, 0x80, 0x90, 0xA0, 0xB0, 0xC0, 0xD0, 0xE0, 0xF0, 0x00, 0x00};
  const int lane = threadIdx.x & 63, l15 = lane & 15, quad = lane >> 4;
  const int h = task & 7, tt = task >> 3;
  const int t0 = tt * 16;
  float* s1v = (float*)wsm;
  float* s2v = s1v + 256;
  int* i1 = (int*)(s2v + 256);
  int* i2 = i1 + 256;
  const u16* keys = (const u16*)(p.ws + OFF_KEYS) + (size_t)(h * 2) * 128 * 64;
  const u16* qp = (const u16*)(p.ws + OFF_QP) + (size_t)(t0 + l15) * 1024 + h * 128 + quad * 8;
  unsigned l1[16], l2[16];
  route_top16_of_128(keys, qp, l15, quad, l1);
  route_top16_of_128(keys + 128 * 64, qp + 64, l15, quad, l2);
  if (quad == 0) {
#pragma unroll
    for (int i = 0; i < 16; ++i) { s1v[l15 * 16 + i] = ord2f(l1[i] & ~127u); i1[l15 * 16 + i] = (int)(l1[i] & 127u); }
  } else if (quad == 1) {
#pragma unroll
    for (int i = 0; i < 16; ++i) { s2v[l15 * 16 + i] = ord2f(l2[i] & ~127u); i2[l15 * 16 + i] = (int)(l2[i] & 127u); }
  }
  __builtin_amdgcn_fence(__ATOMIC_RELEASE, "wavefront");
  __builtin_amdgcn_wave_barrier();
  __builtin_amdgcn_fence(__ATOMIC_ACQUIRE, "wavefront");
  unsigned ck[16];
#pragma unroll
  for (int s = 0; s < 16; ++s) {
    const int c = quad + 4 * s;
    unsigned key = 0u;
    if (s < 13 && c < 50) {
      const unsigned ab = kTab[c];
      const float val = s1v[l15 * 16 + (ab >> 4)] + s2v[l15 * 16 + (ab & 15)];
      key = (f2ord(val) & ~255u) | ab;
    }
    ck[s] = key;
  }
  sort16_desc(ck);
  xmerge16(ck, 16);
  xmerge16(ck, 32);
  if (quad == 0) {
    float e[16];
    const float vmax = ord2f(ck[0] & ~255u);
    float ssum = 0.f;
#pragma unroll
    for (int i = 0; i < 16; ++i) { e[i] = __expf(ord2f(ck[i] & ~255u) - vmax); ssum += e[i]; }
    const float inv = 1.f / ssum;
    int* ridx = (int*)(p.ws + OFF_RIDX) + (size_t)(t0 + l15) * 128 + h * 16;
    float* rw = (float*)(p.ws + OFF_RW) + (size_t)(t0 + l15) * 128 + h * 16;
#pragma unroll
    for (int i = 0; i < 16; i += 4) {
      int ee[4]; float ww[4];
#pragma unroll
      for (int j = 0; j < 4; ++j) {
        const unsigned ab = ck[i + j] & 255u;
        ee[j] = i1[l15 * 16 + (ab >> 4)] * 128 + i2[l15 * 16 + (ab & 15)];
        ww[j] = e[i + j] * inv;
      }
      *(int4*)(ridx + i) = make_int4(ee[0], ee[1], ee[2], ee[3]);
      *(float4*)(rw + i) = make_float4(ww[0], ww[1], ww[2], ww[3]);
    }
  }
  __builtin_amdgcn_fence(__ATOMIC_RELEASE, "wavefront");
  __builtin_amdgcn_wave_barrier();
}

DEV float gelu_tanh(float x) {
  const float u = 0.7978845608028654f * (x + 0.044715f * x * x * x);
  return 0.5f * x * (1.f + tanhf(u));
}

DEV void unpack8(const uint4& q, float* f) {
  f[0] = bflo(q.x); f[1] = bfhi(q.x); f[2] = bflo(q.y); f[3] = bfhi(q.y);
  f[4] = bflo(q.z); f[5] = bfhi(q.z); f[6] = bflo(q.w); f[7] = bfhi(q.w);
}

DEV float dpp_add(float v, const int ctrl_sel) {
  return v;
}
typedef __attribute__((ext_vector_type(2))) __bf16 bf2_t;
DEV float dot2bf(unsigned a, unsigned b, float c) {
  return __builtin_amdgcn_fdot2_f32_bf16(__builtin_bit_cast(bf2_t, a), __builtin_bit_cast(bf2_t, b), c, false);
}
#define DPP_ADD(v, ctrl) ((v) + __builtin_bit_cast(float, __builtin_amdgcn_update_dpp(0, __builtin_bit_cast(int, (v)), (ctrl), 0xF, 0xF, true)))

DEV void p9_experts4(const Params& p, int task, char* wsm) {
  const int lane = threadIdx.x & 63;
  const int t0 = task * 4;
  int* hist = (int*)wsm;
  unsigned* skey = (unsigned*)(wsm + 1024);
  float* swt = (float*)(wsm + 1024 + 2048);
  u16* sh2 = (u16*)(wsm + 1024 + 4096);
  hist[lane] = 0; hist[lane + 64] = 0; hist[lane + 128] = 0; hist[lane + 192] = 0;
  const int* ridx = (const int*)(p.ws + OFF_RIDX) + (size_t)t0 * 128 + lane * 8;
  const float* rw = (const float*)(p.ws + OFF_RW) + (size_t)t0 * 128 + lane * 8;
  int4 ea = *(const int4*)(ridx), eb = *(const int4*)(ridx + 4);
  float4 wa = *(const float4*)(rw), wb = *(const float4*)(rw + 4);
  int e[8] = {ea.x, ea.y, ea.z, ea.w, eb.x, eb.y, eb.z, eb.w};
  float w[8] = {wa.x, wa.y, wa.z, wa.w, wb.x, wb.y, wb.z, wb.w};
  {
    const u16* h2 = (const u16*)(p.ws + OFF_H2) + (size_t)t0 * 1024;
#pragma unroll
    for (int i = 0; i < 8; ++i) *(u32x4*)(sh2 + (lane + 64 * i) * 8) = *(const u32x4*)(h2 + (lane + 64 * i) * 8);
  }
  __builtin_amdgcn_fence(__ATOMIC_RELEASE, "wavefront");
  __builtin_amdgcn_wave_barrier();
  __builtin_amdgcn_fence(__ATOMIC_ACQUIRE, "wavefront");
  int rank[8];
#pragma unroll
  for (int j = 0; j < 8; ++j) rank[j] = atomicAdd(&hist[e[j] >> 6], 1);
  __builtin_amdgcn_fence(__ATOMIC_RELEASE, "wavefront");
  __builtin_amdgcn_wave_barrier();
  __builtin_amdgcn_fence(__ATOMIC_ACQUIRE, "wavefront");
  {
    const int c0 = hist[4 * lane], c1 = hist[4 * lane + 1], c2 = hist[4 * lane + 2], c3 = hist[4 * lane + 3];
    const int tot = c0 + c1 + c2 + c3;
    int x = tot;
#pragma unroll
    for (int o = 1; o < 64; o <<= 1) { const int y = __shfl_up(x, o); if (lane >= o) x += y; }
    const int base = x - tot;
    __builtin_amdgcn_fence(__ATOMIC_RELEASE, "wavefront");
    __builtin_amdgcn_wave_barrier();
    hist[4 * lane] = base; hist[4 * lane + 1] = base + c0; hist[4 * lane + 2] = base + c0 + c1; hist[4 * lane + 3] = base + c0 + c1 + c2;
  }
  __builtin_amdgcn_fence(__ATOMIC_RELEASE, "wavefront");
  __builtin_amdgcn_wave_barrier();
  __builtin_amdgcn_fence(__ATOMIC_ACQUIRE, "wavefront");
  {
    const unsigned slot = (unsigned)(lane >> 4);
#pragma unroll
    for (int j = 0; j < 8; ++j) {
      const int pos = hist[e[j] >> 6] + rank[j];
      skey[pos] = (unsigned)e[j] | (slot << 14);
      swt[pos] = w[j];
    }
  }
  __builtin_amdgcn_fence(__ATOMIC_RELEASE, "wavefront");
  __builtin_amdgcn_wave_barrier();
  __builtin_amdgcn_fence(__ATOMIC_ACQUIRE, "wavefront");

  float o0[16], o1[16], o2[16], o3[16];
#pragma unroll
  for (int k = 0; k < 16; ++k) { o0[k] = 0.f; o1[k] = 0.f; o2[k] = 0.f; o3[k] = 0.f; }
  const u16* U = (const u16*)(p.ws + OFF_UBF);
  const u16* V = (const u16*)(p.ws + OFF_VBF);
#define P9_LOAD(KK, UU, VV, BB)                                                           \
  _Pragma("unroll") for (int i = 0; i < 4; ++i) {                                         \
    KK[i] = (unsigned)__builtin_amdgcn_readfirstlane((int)skey[4 * (BB) + i]);            \
    const size_t ro = (size_t)(KK[i] & 16383u) * 1024 + 16 * lane;                        \
    UU[i] = *(const u32x4*)(U8 + ro);                                                     \
    VV[i] = *(const u32x4*)(V8 + ro);                                                     \
  }
#define P9_DOTS(KK, UU, BB, COEFV)                                                        \
  {                                                                                       \
    const float myw = swt[4 * (BB) + (lane >> 4)];                                        \
    float d[4];                                                                           \
    _Pragma("unroll") for (int i = 0; i < 4; ++i) {                                       \
      const unsigned slot = KK[i] >> 14;                                                  \
      const u32x4 ha = *(const u32x4*)(sh2 + slot * 1024 + 16 * lane);                    \
      const u32x4 hb = *(const u32x4*)(sh2 + slot * 1024 + 16 * lane + 8);                \
      float acc0 = 0.f, acc1 = 0.f;                                                       \
      {                                                                                   \
        f32x2 l0 = __builtin_amdgcn_cvt_pk_f32_fp8((int)UU[i].x, false), h0 = __builtin_amdgcn_cvt_pk_f32_fp8((int)UU[i].x, true); \
        f32x2 l1 = __builtin_amdgcn_cvt_pk_f32_fp8((int)UU[i].y, false), h1 = __builtin_amdgcn_cvt_pk_f32_fp8((int)UU[i].y, true); \
        f32x2 l2 = __builtin_amdgcn_cvt_pk_f32_fp8((int)UU[i].z, false), h2_ = __builtin_amdgcn_cvt_pk_f32_fp8((int)UU[i].z, true); \
        f32x2 l3 = __builtin_amdgcn_cvt_pk_f32_fp8((int)UU[i].w, false), h3 = __builtin_amdgcn_cvt_pk_f32_fp8((int)UU[i].w, true); \
        acc0 += l0.x * bflo(ha.x) + l0.y * bfhi(ha.x); acc1 += h0.x * bflo(ha.y) + h0.y * bfhi(ha.y);   \
        acc0 += l1.x * bflo(ha.z) + l1.y * bfhi(ha.z); acc1 += h1.x * bflo(ha.w) + h1.y * bfhi(ha.w);   \
        acc0 += l2.x * bflo(hb.x) + l2.y * bfhi(hb.x); acc1 += h2_.x * bflo(hb.y) + h2_.y * bfhi(hb.y); \
        acc0 += l3.x * bflo(hb.z) + l3.y * bfhi(hb.z); acc1 += h3.x * bflo(hb.w) + h3.y * bfhi(hb.w);   \
      }                                                                                   \
      d[i] = acc0 + acc1;                                                                 \
    }                                                                                     \
    const bool up32 = (lane & 32) != 0, up16 = (lane & 16) != 0;                          \
    float k0 = up32 ? d[2] : d[0], k1 = up32 ? d[3] : d[1];                               \
    float s0 = up32 ? d[0] : d[2], s1 = up32 ? d[1] : d[3];                               \
    k0 += __shfl_xor(s0, 32);                                                             \
    k1 += __shfl_xor(s1, 32);                                                             \
    float kq = up16 ? k1 : k0, sq = up16 ? k0 : k1;                                       \
    kq += __shfl_xor(sq, 16);                                                             \
    kq = DPP_ADD(kq, 0xB1);                                                               \
    kq = DPP_ADD(kq, 0x4E);                                                               \
    kq = DPP_ADD(kq, 0x141);                                                              \
    kq = DPP_ADD(kq, 0x140);                                                              \
    COEFV = myw * (1.f / 64.f) * gelu_tanh(kq * (1.f / 512.f));                           \
  }
#define P9_ACCUM(KK, VV, COEFV)                                                           \
  _Pragma("unroll") for (int i = 0; i < 4; ++i) {                                         \
    const float ci = __builtin_bit_cast(float, __builtin_amdgcn_readlane(__builtin_bit_cast(int, COEFV), 16 * i)); \
    const unsigned slot = KK[i] >> 14;                                                    \
    float vf[16];                                                                         \
    {                                                                                     \
      f32x2 t;                                                                            \
      t = __builtin_amdgcn_cvt_pk_f32_fp8((int)VV[i].x, false); vf[0] = t.x; vf[1] = t.y;   \
      t = __builtin_amdgcn_cvt_pk_f32_fp8((int)VV[i].x, true);  vf[2] = t.x; vf[3] = t.y;   \
      t = __builtin_amdgcn_cvt_pk_f32_fp8((int)VV[i].y, false); vf[4] = t.x; vf[5] = t.y;   \
      t = __builtin_amdgcn_cvt_pk_f32_fp8((int)VV[i].y, true);  vf[6] = t.x; vf[7] = t.y;   \
      t = __builtin_amdgcn_cvt_pk_f32_fp8((int)VV[i].z, false); vf[8] = t.x; vf[9] = t.y;   \
      t = __builtin_amdgcn_cvt_pk_f32_fp8((int)VV[i].z, true);  vf[10] = t.x; vf[11] = t.y; \
      t = __builtin_amdgcn_cvt_pk_f32_fp8((int)VV[i].w, false); vf[12] = t.x; vf[13] = t.y; \
      t = __builtin_amdgcn_cvt_pk_f32_fp8((int)VV[i].w, true);  vf[14] = t.x; vf[15] = t.y; \
    }                                                                                     \
    if (slot == 0) { _Pragma("unroll") for (int k = 0; k < 16; ++k) o0[k] += ci * vf[k]; }       \
    else if (slot == 1) { _Pragma("unroll") for (int k = 0; k < 16; ++k) o1[k] += ci * vf[k]; }  \
    else if (slot == 2) { _Pragma("unroll") for (int k = 0; k < 16; ++k) o2[k] += ci * vf[k]; }  \
    else { _Pragma("unroll") for (int k = 0; k < 16; ++k) o3[k] += ci * vf[k]; }                 \
  }
  {
    const unsigned char* U8 = (const unsigned char*)(p.ws + OFF_UBF);
    const unsigned char* V8 = (const unsigned char*)(p.ws + OFF_VBF);
    unsigned kkA[4], kkB[4];
    u32x4 uA[4], vA[4], uB[4], vB[4];
    float cfA, cfB;
    P9_LOAD(kkA, uA, vA, 0)
#pragma unroll 1
    for (int bb = 0; bb < 128; bb += 2) {
      P9_LOAD(kkB, uB, vB, bb + 1)
      P9_DOTS(kkA, uA, bb, cfA)
      P9_ACCUM(kkA, vA, cfA)
      const int n0 = (bb + 2 < 128) ? (bb + 2) : 0;
      P9_LOAD(kkA, uA, vA, n0)
      P9_DOTS(kkB, uB, bb + 1, cfB)
      P9_ACCUM(kkB, vB, cfB)
    }
  }
#pragma unroll
  for (int s = 0; s < 4; ++s) {
    const int t = t0 + s;
    const int b = t >> 12;
    const float* mod = (const float*)(p.ws + OFF_MOD) + b * 6144 + 5120 + 16 * lane;
    float* xm = p.out + (size_t)t * 1024 + 16 * lane;
    const float* oo = (s == 0) ? o0 : ((s == 1) ? o1 : ((s == 2) ? o2 : o3));
    float xo[16];
    float ss = 0.f;
#pragma unroll
    for (int q = 0; q < 4; ++q) {
      const float4 xv = *(const float4*)(xm + 4 * q);
      const float4 gv = *(const float4*)(mod + 4 * q);
      xo[4 * q + 0] = xv.x + gv.x * oo[4 * q + 0];
      xo[4 * q + 1] = xv.y + gv.y * oo[4 * q + 1];
      xo[4 * q + 2] = xv.z + gv.z * oo[4 * q + 2];
      xo[4 * q + 3] = xv.w + gv.w * oo[4 * q + 3];
    }
#pragma unroll
    for (int k = 0; k < 16; ++k) ss += xo[k] * xo[k];
    ss = wave_sum(ss);
    const float r = rsqrtf(ss * (1.f / 1024.f) + 1e-6f);
#pragma unroll
    for (int q = 0; q < 4; ++q) {
      const float4 fg = *(const float4*)(p.final_g + 16 * lane + 4 * q);
      *(float4*)(xm + 4 * q) = make_float4(xo[4 * q] * r * fg.x, xo[4 * q + 1] * r * fg.y, xo[4 * q + 2] * r * fg.z, xo[4 * q + 3] * r * fg.w);
    }
  }
  __builtin_amdgcn_fence(__ATOMIC_RELEASE, "wavefront");
  __builtin_amdgcn_wave_barrier();
}

#define XB_TMO      128
#define XB_XCNT(j)  (256  + 64 * (j))
#define XB_XSUB(j)  (1280 + 64 * (j))
#define XB_XGEN(j)  (2304 + 64 * (j))
#define XB_TOP      3328
#define XB_TOPGEN   3392
#define XCD_BAR_WORDS 3456
#define XB_SPIN_CAP (1u << 18)
#define LAS __attribute__((address_space(3)))

__device__ __forceinline__ unsigned xb_ld(unsigned* p)              { return __hip_atomic_load(p, __ATOMIC_RELAXED, __HIP_MEMORY_SCOPE_AGENT); }
__device__ __forceinline__ unsigned xb_add(unsigned* p, unsigned v) { return __hip_atomic_fetch_add(p, v, __ATOMIC_RELAXED, __HIP_MEMORY_SCOPE_AGENT); }
__device__ __forceinline__ unsigned xb_xcc_id() { return (unsigned)__builtin_amdgcn_s_getreg((3 << 11) | 20) & 0xFu; }
#define XB_SPIN(cond, bar) do { unsigned _sp = 0; while (cond) { __builtin_amdgcn_s_sleep(1); \
    if ((++_sp & 255u) == 0u) { if (xb_ld(&(bar)[XB_TMO])) break; if (_sp > XB_SPIN_CAP) { atomicAdd(&(bar)[XB_TMO], 1u); break; } } } } while (0)

struct XcdBarrier {
    unsigned* bar; unsigned x;
    volatile LAS unsigned* st;
};

__device__ __forceinline__ XcdBarrier xcd_barrier_post(unsigned* bar, volatile LAS unsigned* st) {
    XcdBarrier b; b.bar = bar; b.x = xb_xcc_id(); b.st = st;
    if (threadIdx.x == 0) (void)xb_add(&bar[XB_XCNT(b.x)], 1u);
    return b;
}
__device__ __forceinline__ void xcd_barrier_complete(unsigned* bar, unsigned x, unsigned& nloc, unsigned& nx) {
    const unsigned G = gridDim.x * gridDim.y * gridDim.z;
    unsigned sum, cnt, mine, sp = 0u;
    for (;;) {
        sum = 0u; cnt = 0u; mine = 0u;
#pragma unroll
        for (unsigned j = 0; j < 16; ++j) { const unsigned c = xb_ld(&bar[XB_XCNT(j)]); sum += c; cnt += (c > 0u) ? 1u : 0u; mine = (j == x) ? c : mine; }
        if (sum == G) break;
        __builtin_amdgcn_s_sleep(1);
        if ((++sp & 255u) == 0u) { if (xb_ld(&bar[XB_TMO])) break; if (sp > XB_SPIN_CAP) { atomicAdd(&bar[XB_TMO], 1u); break; } }
    }
    nloc = mine > 0u ? mine : 1u; nx = cnt > 0u ? cnt : 1u;
}

__device__ __forceinline__ void xcd_barrier(const XcdBarrier& b) {
    asm volatile("s_waitcnt vmcnt(0)" ::: "memory");
    __syncthreads();
    if (threadIdx.x == 0) {
        unsigned* bar = b.bar;
        __builtin_amdgcn_s_waitcnt(0);
        unsigned nloc = b.st[0], nx = b.st[1];
        if (nloc == 0u) { xcd_barrier_complete(bar, b.x, nloc, nx); b.st[0] = nloc; b.st[1] = nx; }
        const unsigned old = xb_add(&bar[XB_XSUB(b.x)], 1u);
        const unsigned gen = old / nloc;
        if (old + 1u == (gen + 1u) * nloc) {
            __builtin_amdgcn_fence(__ATOMIC_RELEASE, "agent");
            asm volatile("s_waitcnt vmcnt(0)" ::: "memory");
            const unsigned og = xb_add(&bar[XB_TOP], 1u);
            const unsigned tg = og / nx;
            if (og + 1u == (tg + 1u) * nx) xb_add(&bar[XB_TOPGEN], 1u);
            else XB_SPIN(xb_ld(&bar[XB_TOPGEN]) == tg, bar);
            __builtin_amdgcn_fence(__ATOMIC_ACQUIRE, "agent");
            xb_add(&bar[XB_XGEN(b.x)], 1u);
            asm volatile("s_waitcnt vmcnt(0)" ::: "memory");
        } else {
            XB_SPIN(xb_ld(&bar[XB_XGEN(b.x)]) == gen, bar);
            __builtin_amdgcn_fence(__ATOMIC_ACQUIRE, "agent");
            asm volatile("s_waitcnt vmcnt(0)" ::: "memory");
        }
    }
    __syncthreads();
}


__global__ void __launch_bounds__(256, 2) mega(Params p) {
  extern __shared__ __attribute__((aligned(16))) char smem[];
  cg::grid_group grid = cg::this_grid();
  const int tid = threadIdx.x, lane = tid & 63, wave = tid >> 6;
  const int nb = gridDim.x, bid = blockIdx.x;
  float* smf = (float*)smem;
  if (p.ws == nullptr) grid.sync();
  volatile LAS unsigned* xst = (volatile LAS unsigned*)(smem + SMEM_XB);
  if (tid == 0) { xst[0] = 0u; xst[1] = 0u; }
  __syncthreads();
  const XcdBarrier xb = xcd_barrier_post((unsigned*)(p.ws + OFF_BAR), xst);
  u16* sA = (u16*)smem;
  u16* sB = (u16*)(smem + 128 * 64 * 2);

  for (int rep_ = 0; rep_ < NREP(0); ++rep_) if (PHON(0)) {
    const int N_MOD = 96, N_TIN = 16 * 68, N_TOA = 8 * 16, N_TOH = 8 * 16, N_TOUT = 16 * 16, N_TQ = 16 * 16, N_HID = 1024;
    const int total = N_MOD + N_TIN + N_TOA + N_TOH + N_TOUT + N_TQ + N_HID + 1;
    for (int it = bid; it < total; it += nb) {
      int i = it;
      if (i < N_MOD) { p0_mod(p, i, smf); continue; }
      i -= N_MOD;
      if (i < N_TIN) { transpose_tile(p.w_in, INW, 1024, (u16*)(p.ws + OFF_WIN), i, smf); continue; }
      i -= N_TIN;
      if (i < N_TOA) { transpose_tile(p.w_o_attn, 1024, 512, (u16*)(p.ws + OFF_WOA), i, smf); continue; }
      i -= N_TOA;
      if (i < N_TOH) { transpose_tile(p.w_o_hy, 1024, 512, (u16*)(p.ws + OFF_WOH), i, smf); continue; }
      i -= N_TOH;
      if (i < N_TOUT) { transpose_tile(p.w_out, 1024, 1024, (u16*)(p.ws + OFF_WOUT), i, smf); continue; }
      i -= N_TOUT;
      if (i < N_TQ) { transpose_tile(p.peer_wq, 1024, 1024, (u16*)(p.ws + OFF_WQ), i, smf); continue; }
      i -= N_TQ;
      if (i < N_HID) { p0_hidden(p, i, smf); continue; }
      float2* rope = (float2*)(p.ws + OFF_ROPE);
      for (int idx = tid; idx < 1024; idx += 256) {
        const int pos = idx >> 4, f = idx & 15;
        const float inv = powf(10000.f, -(float)f / 16.f);
        const float ang = (float)pos * inv;
        rope[idx] = make_float2(cosf(ang), sinf(ang));
      }
    }
    convert_flat(p.peer_keys, (u16*)(p.ws + OFF_KEYS), (size_t)131072);
    convert_flat_fp8(p.peer_u, (unsigned char*)(p.ws + OFF_UBF), (size_t)16384 * 1024, 512.f);
    convert_flat_fp8(p.peer_v, (unsigned char*)(p.ws + OFF_VBF), (size_t)16384 * 1024, 64.f);
  }
  xcd_barrier(xb);

  for (int rep_ = 0; rep_ < NREP(1); ++rep_) if (PHON(1)) {
    const float* mod = (const float*)(p.ws + OFF_MOD);
    const int nrows = T_TOK + 1024;
    for (int r = bid * 4 + wave; r < nrows; r += nb * 4) {
      if (r < T_TOK) {
        const int b = r >> 12;
        norm_row(p.x + (size_t)r * 1024, p.norm1_g, mod + b * 6144, mod + b * 6144 + 1024,
                 (u16*)((char*)p.out + OO_H1) + (size_t)r * 1024, lane);
      } else {
        const int rc = r - T_TOK;
        norm_row(p.ctx + (size_t)rc * 1024, p.norm1_g, mod + 4 * 6144, mod + 4 * 6144 + 1024,
                 (u16*)((char*)p.out + OO_HC) + (size_t)rc * 1024, lane);
      }
    }
    for (int it = bid; it < 128; it += nb) p1_filter(p, it, smf);
  }
  xcd_barrier(xb);

  for (int rep_ = 0; rep_ < NREP(2); ++rep_) if (PHON(2)) {
    if (nb == 512) {
      const int xg = bid & 7, slot = bid >> 3;
      for (int r = 0; r < 8; ++r) {
        const int sup = r * 8 + xg;
        const int mt = (sup >> 2) * 8 + (slot >> 3), nt = (sup & 3) * 8 + (slot & 7);
        p2_inproj(p, mt * 34 + nt, sA, sB);
      }
      if (bid < 256) p2_inproj(p, (bid >> 1) * 34 + 32 + (bid & 1), sA, sB);
      else if (bid < 272) p2_ctxkv(p, bid - 256, sA, sB);
    } else {
      const int total = 128 * 34 + 16;
      for (int it = bid; it < total; it += nb) {
        if (it < 128 * 34) p2_inproj(p, it, sA, sB);
        else p2_ctxkv(p, it - 128 * 34, sA, sB);
      }
    }
  }
  xcd_barrier(xb);

  for (int rep_ = 0; rep_ < NREP(3); ++rep_) if (PHON(3)) {
    const int total = 1024 + 2048;
    for (int it = bid; it < total; it += nb) {
      if (it < 1024) p3_attn(p, it, (u16*)smem, (u16*)(smem + 128 * 72 * 2));
      else p3_hypre(p, it - 1024, (u16*)smem);
    }
  }
  xcd_barrier(xb);

  for (int rep_ = 0; rep_ < NREP(4); ++rep_) if (PHON(4)) for (int it = bid; it < 512; it += nb) p3_toeplitz(p, it, smem);
  xcd_barrier(xb);

  for (int rep_ = 0; rep_ < NREP(5); ++rep_) if (PHON(5)) for (int it = bid; it < 1024; it += nb) p4_merge(p, (nb == 512) ? ((((it >> 9) * 8 + (bid & 7)) * 8 + (bid >> 6)) * 8 + ((bid >> 3) & 7)) : it, sA, sB);
  xcd_barrier(xb);

  for (int rep_ = 0; rep_ < NREP(6); ++rep_) if (PHON(6)) for (int it = bid; it < 1024; it += nb) p5_out(p, (nb == 512) ? ((((it >> 9) * 8 + (bid & 7)) * 8 + (bid >> 6)) * 8 + ((bid >> 3) & 7)) : it, sA, sB);
  xcd_barrier(xb);

  for (int rep_ = 0; rep_ < NREP(7); ++rep_) if (PHON(7)) {
    const float* mod = (const float*)(p.ws + OFF_MOD);
    for (int r = bid * 4 + wave; r < T_TOK; r += nb * 4) {
      const int b = r >> 12;
      norm_row(p.out + (size_t)r * 1024, p.norm2_g, mod + b * 6144 + 3072, mod + b * 6144 + 4096,
               (u16*)(p.ws + OFF_H2) + (size_t)r * 1024, lane);
    }
  }
  xcd_barrier(xb);

  for (int rep_ = 0; rep_ < NREP(8); ++rep_) if (PHON(8)) for (int it = bid; it < 1024; it += nb) p7_qp(p, (nb == 512) ? ((((it >> 9) * 8 + (bid & 7)) * 8 + (bid >> 6)) * 8 + ((bid >> 3) & 7)) : it, sA, sB);
  xcd_barrier(xb);

  for (int rep_ = 0; rep_ < NREP(9); ++rep_) if (PHON(9)) for (int it = bid * 4 + wave; it < 8192; it += nb * 4) p8_route(p, it, smem + wave * 4096);
  xcd_barrier(xb);

  if (PHON(10)) for (int it = bid * 4 + wave; it < 4096; it += nb * 4) p9_experts4(p, it, smem + wave * 13312);
}

extern "C" void kernel_launch(void* const* d_in, const int* in_sizes, int n_in, void* d_out, int out_size,
                              void* d_ws, size_t ws_size, hipStream_t stream) {
  static int grid_blocks = 0;
  if (!grid_blocks) {
    int dev = 0, cus = 0, per_cu = 0;
    (void)hipGetDevice(&dev);
    (void)hipDeviceGetAttribute(&cus, hipDeviceAttributeMultiprocessorCount, dev);
    (void)hipFuncSetAttribute((const void*)mega, hipFuncAttributeMaxDynamicSharedMemorySize, SMEM_BYTES);
    (void)hipOccupancyMaxActiveBlocksPerMultiprocessor(&per_cu, mega, 256, SMEM_BYTES);
    if (per_cu > 2) per_cu = 2;
    if (per_cu < 1) per_cu = 1;
    grid_blocks = cus * per_cu;
  }
  Params p{};
  const float** pp = (const float**)&p;
  for (int i = 0; i < 28; ++i) pp[i] = (const float*)d_in[i];
  p.out = (float*)d_out;
  p.ws = (char*)d_ws;
  (void)hipMemsetAsync((char*)d_ws + OFF_BAR, 0, XCD_BAR_WORDS * sizeof(unsigned), stream);
  void* args[] = {&p};
  hipError_t e = hipLaunchCooperativeKernel((void*)mega, dim3(grid_blocks), dim3(256), args, SMEM_BYTES, stream);
  if (e != hipSuccess) fprintf(stderr, "cooperative launch failed: %s (grid %d)\n", hipGetErrorString(e), grid_blocks);
}
```

```cpp
#include <hip/hip_runtime.h>
#include <hip/hip_bf16.h>
#include <hip/hip_cooperative_groups.h>
#include <cstdio>
namespace cg = cooperative_groups;

typedef unsigned short u16;
typedef __attribute__((ext_vector_type(8))) short bf16x8;
typedef __attribute__((ext_vector_type(4))) float f32x4;
typedef __attribute__((ext_vector_type(4))) unsigned u32x4;

#define DEV __device__ __forceinline__
#ifndef PH
#define PH -1
#endif
#define PHON(n) (PH < 0 || PH == (n))
#ifndef REP
#define REP -1
#endif
#define NREP(n) ((REP == (n)) ? 2 : 1)

constexpr int T_TOK = 16384;
constexpr int DM = 1024;
constexpr int SEQL = 4096;
constexpr int INW = 4352;

struct Params {
  const float *x, *c, *ctx, *c_ctx, *w_mod, *b_mod, *norm1_g, *w_in, *attn_sink, *hy_conv_w, *hy_conv_b,
      *hy_fw1, *hy_fb1, *hy_fw2, *hy_fb2, *hy_fw3, *hy_fb3, *hy_freq, *hy_skip, *w_o_attn, *w_o_hy, *w_out,
      *norm2_g, *peer_wq, *peer_keys, *peer_u, *peer_v, *final_g;
  float* out;
  char* ws;
};

constexpr size_t MB = 1u << 20;
constexpr size_t OFF_MOD = 0;
constexpr size_t OFF_ROPE = 128 * 1024;
constexpr size_t OFF_NINV = OFF_ROPE + 8192;
constexpr size_t OFF_H2F = 256 * 1024;
constexpr size_t OFF_WIN = OFF_H2F + MB;
constexpr size_t OFF_WOA = OFF_WIN + 9 * MB;
constexpr size_t OFF_WOH = OFF_WOA + MB;
constexpr size_t OFF_WOUT = OFF_WOH + MB;
constexpr size_t OFF_WQ = OFF_WOUT + 2 * MB;
constexpr size_t OFF_KEYS = OFF_WQ + 2 * MB;
constexpr size_t OFF_UBF = OFF_KEYS + MB;
constexpr size_t OFF_VBF = OFF_UBF + 32 * MB;
constexpr size_t OFF_Q = OFF_VBF + 32 * MB;
constexpr size_t OFF_K = OFF_Q + 16 * MB;
constexpr size_t OFF_VT = OFF_K + 4 * MB;
constexpr size_t OFF_KC = OFF_VT + 4 * MB;
constexpr size_t OFF_VCT = OFF_KC + MB / 2;
constexpr size_t OFF_Z = OFF_VCT + MB / 2;
constexpr size_t OFF_GATE = OFF_Z + 48 * MB;
constexpr size_t OFF_YATT = OFF_GATE + 64 * MB;
constexpr size_t OFF_YHY = OFF_YATT + 16 * MB;
constexpr size_t OFF_RIDX = OFF_Q;
constexpr size_t OFF_RW = OFF_Q + 8 * MB;
constexpr size_t OFF_MERGED = OFF_Z;
constexpr size_t OFF_H2 = OFF_GATE;
constexpr size_t OFF_QP = OFF_GATE + 32 * MB;
constexpr size_t OO_H1 = 0;
constexpr size_t OO_UT = 0;
constexpr size_t OO_X0T = 16 * MB;
constexpr size_t OO_HC = 32 * MB;
constexpr size_t OO_G = 34 * MB;

constexpr int SMEM_BYTES = 70144;
constexpr size_t OFF_BAR = 160 * 1024;
constexpr int SMEM_XB = 70016;

DEV u16 f2bf(float f) {
  unsigned u = __float_as_uint(f);
  u += 0x7fffu + ((u >> 16) & 1u);
  return (u16)(u >> 16);
}
DEV float bf2f(u16 h) { return __uint_as_float(((unsigned)h) << 16); }
DEV unsigned pack2(float a, float b) { return (unsigned)f2bf(a) | ((unsigned)f2bf(b) << 16); }
DEV float bflo(unsigned w) { return __uint_as_float(w << 16); }
DEV float bfhi(unsigned w) { return __uint_as_float(w & 0xffff0000u); }
DEV float wave_sum(float v) {
#pragma unroll
  for (int o = 32; o > 0; o >>= 1) v += __shfl_xor(v, o);
  return v;
}
DEV float wave_max(float v) {
#pragma unroll
  for (int o = 32; o > 0; o >>= 1) v = fmaxf(v, __shfl_xor(v, o));
  return v;
}

DEV void p0_mod(const Params& p, int item, float* sm) {
  const int tid = threadIdx.x;
  for (int i = tid; i < 5 * 1024; i += 256) {
    int r = i >> 10, k = i & 1023;
    float c = (r < 4) ? p.c[r * 1024 + k] : p.c_ctx[k];
    sm[i] = c / (1.f + expf(-c));
  }
  __syncthreads();
  const int col = item * 64 + (tid & 63), kg = tid >> 6;
  float a0 = 0, a1 = 0, a2 = 0, a3 = 0, a4 = 0;
#pragma unroll 16
  for (int k = kg * 256; k < kg * 256 + 256; ++k) {
    float w = p.w_mod[(size_t)k * 6144 + col];
    a0 += sm[k] * w; a1 += sm[1024 + k] * w; a2 += sm[2048 + k] * w; a3 += sm[3072 + k] * w; a4 += sm[4096 + k] * w;
  }
  float* red = sm + 5 * 1024;
  red[(kg * 5 + 0) * 64 + (tid & 63)] = a0;
  red[(kg * 5 + 1) * 64 + (tid & 63)] = a1;
  red[(kg * 5 + 2) * 64 + (tid & 63)] = a2;
  red[(kg * 5 + 3) * 64 + (tid & 63)] = a3;
  red[(kg * 5 + 4) * 64 + (tid & 63)] = a4;
  __syncthreads();
  float* mod = (float*)(p.ws + OFF_MOD);
  for (int i = tid; i < 320; i += 256) {
    int r = i >> 6, cc = i & 63;
    float s = red[(0 * 5 + r) * 64 + cc] + red[(1 * 5 + r) * 64 + cc] + red[(2 * 5 + r) * 64 + cc] + red[(3 * 5 + r) * 64 + cc];
    mod[r * 6144 + item * 64 + cc] = s + p.b_mod[item * 64 + cc];
  }
  __syncthreads();
}

DEV void transpose_tile(const float* __restrict__ src, int N, int K, u16* __restrict__ dst, int tile, float* sm) {
  const int tid = threadIdx.x;
  const int nkt = K >> 6;
  const int kt = tile % nkt, nt = tile / nkt;
  const int k0 = kt * 64, n0 = nt * 64;
  const int c = tid & 63, r = tid >> 6;
#pragma unroll
  for (int rr = 0; rr < 16; ++rr) sm[(rr * 4 + r) * 65 + c] = src[(size_t)(k0 + rr * 4 + r) * N + n0 + c];
  __syncthreads();
  const int nn = tid >> 2, part = tid & 3;
  unsigned w[8];
#pragma unroll
  for (int j = 0; j < 8; ++j) w[j] = pack2(sm[(part * 16 + 2 * j) * 65 + nn], sm[(part * 16 + 2 * j + 1) * 65 + nn]);
  uint4* d = (uint4*)(dst + (size_t)(n0 + nn) * K + k0 + part * 16);
  d[0] = make_uint4(w[0], w[1], w[2], w[3]);
  d[1] = make_uint4(w[4], w[5], w[6], w[7]);
  __syncthreads();
}

DEV void p0_hidden(const Params& p, int item, float* sm) {
  const int tid = threadIdx.x;
  float* z = sm;
  float* h1 = sm + 4 * 36;
  if (tid < 4 * 33) {
    int tt = tid / 33, i = tid % 33;
    int t = item * 4 + tt;
    float v;
    if (i == 0) v = (float)t * (1.f / 4096.f);
    else {
      int band = (i <= 16) ? i : (i - 16);
      float fr = (float)((t * band) & 4095) * (1.f / 4096.f);
      v = (i <= 16) ? cospif(2.f * fr) : sinpif(2.f * fr);
    }
    z[tt * 36 + i] = v;
  }
  __syncthreads();
  const int tt = tid >> 6, j = tid & 63;
  float a = p.hy_fb1[j];
  for (int i = 0; i < 33; ++i) a += z[tt * 36 + i] * p.hy_fw1[i * 64 + j];
  const float fq = p.hy_freq[j];
  h1[tt * 64 + j] = sinf(fq * a);
  __syncthreads();
  float b = p.hy_fb2[j];
  for (int i = 0; i < 64; ++i) b += h1[tt * 64 + i] * p.hy_fw2[i * 64 + j];
  ((float*)(p.ws + OFF_H2F))[(item * 4 + tt) * 64 + j] = sinf(fq * b);
  __syncthreads();
}

DEV void convert_flat(const float* __restrict__ src, u16* __restrict__ dst, size_t n) {
  size_t stride = (size_t)gridDim.x * 256 * 8;
  for (size_t i = ((size_t)blockIdx.x * 256 + threadIdx.x) * 8; i < n; i += stride) {
    float4 a = *(const float4*)(src + i);
    float4 b = *(const float4*)(src + i + 4);
    *(uint4*)(dst + i) = make_uint4(pack2(a.x, a.y), pack2(a.z, a.w), pack2(b.x, b.y), pack2(b.z, b.w));
  }
}

typedef __attribute__((ext_vector_type(2))) float f32x2;
DEV void convert_flat_fp8(const float* __restrict__ src, unsigned char* __restrict__ dst, size_t n, float scale) {
  const size_t half = (size_t)gridDim.x * 256 * 16;
  const size_t stride = half * 2;
  for (size_t i = ((size_t)blockIdx.x * 256 + threadIdx.x) * 16; i < n; i += stride) {
    float4 a[8];
    const bool two = (i + half) < n;
#pragma unroll
    for (int q = 0; q < 4; ++q) a[q] = *(const float4*)(src + i + 4 * q);
    if (two) {
#pragma unroll
      for (int q = 0; q < 4; ++q) a[4 + q] = *(const float4*)(src + i + half + 4 * q);
    }
    unsigned w[8];
#pragma unroll
    for (int q = 0; q < 8; ++q) {
      int v = 0;
      v = __builtin_amdgcn_cvt_pk_fp8_f32(a[q].x * scale, a[q].y * scale, v, false);
      v = __builtin_amdgcn_cvt_pk_fp8_f32(a[q].z * scale, a[q].w * scale, v, true);
      w[q] = (unsigned)v;
    }
    *(uint4*)(dst + i) = make_uint4(w[0], w[1], w[2], w[3]);
    if (two) *(uint4*)(dst + i + half) = make_uint4(w[4], w[5], w[6], w[7]);
  }
}

DEV void norm_row(const float* __restrict__ xr, const float* __restrict__ g, const float* __restrict__ sh,
                  const float* __restrict__ sc, u16* __restrict__ dst, int lane) {
  float4 v[4];
  float ss = 0.f;
#pragma unroll
  for (int i = 0; i < 4; ++i) {
    v[i] = ((const float4*)xr)[lane + 64 * i];
    ss += v[i].x * v[i].x + v[i].y * v[i].y + v[i].z * v[i].z + v[i].w * v[i].w;
  }
  ss = wave_sum(ss);
  const float r = rsqrtf(ss * (1.f / 1024.f) + 1e-6f);
#pragma unroll
  for (int i = 0; i < 4; ++i) {
    const int idx = lane + 64 * i;
    float4 gg = ((const float4*)g)[idx], s1 = ((const float4*)sh)[idx], s2 = ((const float4*)sc)[idx];
    float y0 = v[i].x * r * gg.x * (1.f + s2.x) + s1.x;
    float y1 = v[i].y * r * gg.y * (1.f + s2.y) + s1.y;
    float y2 = v[i].z * r * gg.z * (1.f + s2.z) + s1.z;
    float y3 = v[i].w * r * gg.w * (1.f + s2.w) + s1.w;
    *(uint2*)(dst + idx * 4) = make_uint2(pack2(y0, y1), pack2(y2, y3));
  }
}

DEV void p1_filter(const Params& p, int item, float* sm) {
  const int tid = threadIdx.x;
  float* wc = sm;
  float* fb = sm + 512;
  float* dl = sm + 520;
  float* red = sm + 528;
  const int c0 = item * 4;
  for (int i = tid; i < 512; i += 256) {
    int j = i >> 6, k = i & 63;
    int col = (j < 4) ? (c0 + j) : (512 + c0 + j - 4);
    wc[j * 64 + k] = p.hy_fw3[k * 1024 + col];
  }
  if (tid < 8) fb[tid] = p.hy_fb3[(tid < 4) ? (c0 + tid) : (512 + c0 + tid - 4)];
  if (tid < 4) {
    const float a = logf(1e-2f) / 1.5f, b = logf(1e-2f) / 0.3f;
    float d = a + (b - a) * (float)(c0 + tid) / 511.f;
    dl[tid] = fabsf(d);
  }
  __syncthreads();
  u16* G = (u16*)((char*)p.out + OO_G);
  const float* H = (const float*)(p.ws + OFF_H2F);
  float as0 = 0, as1 = 0, as2 = 0, as3 = 0;
  for (int t = tid; t < 4096; t += 256) {
    const float4* hp = (const float4*)(H + t * 64);
    float d[8];
#pragma unroll
    for (int j = 0; j < 8; ++j) d[j] = fb[j];
#pragma unroll 1
    for (int q4 = 0; q4 < 16; q4 += 4) {
      float4 hv[4];
#pragma unroll
      for (int u = 0; u < 4; ++u) hv[u] = hp[q4 + u];
#pragma unroll
      for (int u = 0; u < 4; ++u)
#pragma unroll
        for (int j = 0; j < 8; ++j) {
          const float4 w = *(const float4*)(wc + j * 64 + 4 * (q4 + u));
          d[j] += hv[u].x * w.x + hv[u].y * w.y + hv[u].z * w.z + hv[u].w * w.w;
        }
    }
    const float tn = (float)t * (1.f / 4096.f);
    float asum[4];
#pragma unroll
    for (int j = 0; j < 4; ++j) {
      float dec = expf(-tn * dl[j]);
      float f = d[j] * dec, bw = d[4 + j] * dec;
      u16* Gc = G + (size_t)(c0 + j) * 8192;
      Gc[4095 - t] = f2bf(f);
      float s = fabsf(f);
      if (t < 4095) { Gc[4096 + t] = f2bf(bw); s += fabsf(bw); }
      else Gc[8191] = 0;
      asum[j] = s;
    }
    as0 += asum[0]; as1 += asum[1]; as2 += asum[2]; as3 += asum[3];
  }
  as0 = wave_sum(as0); as1 = wave_sum(as1); as2 = wave_sum(as2); as3 = wave_sum(as3);
  if ((tid & 63) == 0) {
    int w = tid >> 6;
    red[w * 4 + 0] = as0; red[w * 4 + 1] = as1; red[w * 4 + 2] = as2; red[w * 4 + 3] = as3;
  }
  __syncthreads();
  if (tid < 4) {
    float s = red[tid] + red[4 + tid] + red[8 + tid] + red[12 + tid];
    ((float*)(p.ws + OFF_NINV))[c0 + tid] = 1.f / s;
  }
  __syncthreads();
}

struct Acc { f32x4 v[4][4]; };

DEV void acc_zero(Acc& a) {
#pragma unroll
  for (int i = 0; i < 4; ++i)
#pragma unroll
    for (int j = 0; j < 4; ++j) a.v[i][j] = (f32x4){0.f, 0.f, 0.f, 0.f};
}

#define LDSAS __attribute__((address_space(3)))
DEV void gemm_kloop(const u16* __restrict__ A, int lda, const u16* __restrict__ Bt, int ldb, int K, int m0, int n0,
                    u16* sA, u16* sB_unused, Acc& acc) {
  const int tid = threadIdx.x, lane = tid & 63, wave = tid >> 6, wm = wave >> 1, wn = wave & 1;
  const int l15 = lane & 15, quad = lane >> 4;
  const int rsw = (l15 >> 1) & 7;
  const int nk = K >> 6;
  const int prow = lane >> 3;
  const int pch = lane & 7;
  unsigned oA[4], oB[4];
#pragma unroll
  for (int i = 0; i < 4; ++i) {
    const int row = (wave * 4 + i) * 8 + prow;
    const int c = pch ^ ((row >> 1) & 7);
    oA[i] = (unsigned)(row * lda + c * 8) * 2u;
    oB[i] = (unsigned)(row * ldb + c * 8) * 2u;
  }
  const char* bA = (const char*)(A + (size_t)m0 * lda);
  const char* bB = (const char*)(Bt + (size_t)n0 * ldb);
  LDSAS char* lbase = (LDSAS char*)sA;
#define GEMM_DMA(KT, BUF)                                                                                   \
  _Pragma("unroll") for (int i = 0; i < 4; ++i) {                                                           \
    __builtin_amdgcn_global_load_lds((const unsigned*)(bA + (KT) * 128 + oA[i]), (LDSAS unsigned*)(lbase + (BUF) * 32768 + (wave * 4 + i) * 1024), 16, 0, 0);          \
    __builtin_amdgcn_global_load_lds((const unsigned*)(bB + (KT) * 128 + oB[i]), (LDSAS unsigned*)(lbase + (BUF) * 32768 + 16384 + (wave * 4 + i) * 1024), 16, 0, 0);  \
  }
  GEMM_DMA(0, 0)
  for (int kt = 0; kt < nk; ++kt) {
    asm volatile("s_waitcnt vmcnt(0)" ::: "memory");
    __syncthreads();
    const int buf = kt & 1;
    if (kt + 1 < nk) { GEMM_DMA(kt + 1, buf ^ 1) }
    const u16* tA = sA + buf * 16384;
    const u16* tB = tA + 8192;
    bf16x8 af[2][4], bfr[2][4];
#pragma unroll
    for (int ks = 0; ks < 2; ++ks) {
      const int cs = ((ks * 4 + quad) ^ rsw) * 8;
#pragma unroll
      for (int i = 0; i < 4; ++i) af[ks][i] = *(const bf16x8*)(tB + (wn * 64 + i * 16 + l15) * 64 + cs);
#pragma unroll
      for (int j = 0; j < 4; ++j) bfr[ks][j] = *(const bf16x8*)(tA + (wm * 64 + j * 16 + l15) * 64 + cs);
    }
    __builtin_amdgcn_s_setprio(1);
#pragma unroll
    for (int ks = 0; ks < 2; ++ks)
#pragma unroll
      for (int i = 0; i < 4; ++i)
#pragma unroll
        for (int j = 0; j < 4; ++j) acc.v[i][j] = __builtin_amdgcn_mfma_f32_16x16x32_bf16(af[ks][i], bfr[ks][j], acc.v[i][j], 0, 0, 0);
    __builtin_amdgcn_s_setprio(0);
  }
  __syncthreads();
}

DEV void p2_inproj(const Params& p, int tile, u16* sA, u16* sB) {
  const int mt = tile / 34, nt = tile % 34;
  const int m0 = mt * 128, n0 = nt * 128;
  Acc acc; acc_zero(acc);
  gemm_kloop((const u16*)((const char*)p.out + OO_H1), 1024, (const u16*)(p.ws + OFF_WIN), 1024, 1024, m0, n0, sA, sB, acc);
  asm volatile("" ::: "memory");
  const int tid = threadIdx.x, lane = tid & 63, wave = tid >> 6, wm = wave >> 1, wn = wave & 1;
  int l15 = lane & 15, quad = lane >> 4;
  int mb = m0 + wm * 64, nb = n0 + wn * 64;
  asm volatile("" : "+v"(l15), "+v"(quad), "+v"(mb), "+v"(nb));
  mb = __builtin_amdgcn_readfirstlane(mb); nb = __builtin_amdgcn_readfirstlane(nb);
  if (nb < 640) {
    const float2* rope = (const float2*)(p.ws + OFF_ROPE);
    const bool isq = nb < 512;
    const float qs = isq ? 0.125f : 1.f;
#pragma unroll
    for (int j = 0; j < 4; ++j) {
      const int m = mb + j * 16 + l15;
      const int b = m >> 12, l = m & 4095;
      const int prow = l >> 6, pcol = l & 63;
      u16* dst;
      if (isq) dst = (u16*)(p.ws + OFF_Q) + ((size_t)(b * 8 + (nb >> 6)) * 4096 + l) * 64;
      else dst = (u16*)(p.ws + OFF_K) + ((size_t)(b * 2 + ((nb - 512) >> 6)) * 4096 + l) * 64;
#pragma unroll
      for (int hh = 0; hh < 2; ++hh) {
        const int pos = hh ? pcol : prow;
        f32x4 x1 = acc.v[hh * 2][j], x2 = acc.v[hh * 2 + 1][j];
        float o1[4], o2[4];
#pragma unroll
        for (int r = 0; r < 4; ++r) {
          float2 cs = rope[pos * 16 + quad * 4 + r];
          o1[r] = (x1[r] * cs.x - x2[r] * cs.y) * qs;
          o2[r] = (x2[r] * cs.x + x1[r] * cs.y) * qs;
        }
        *(uint2*)(dst + hh * 32 + quad * 4) = make_uint2(pack2(o1[0], o1[1]), pack2(o1[2], o1[3]));
        *(uint2*)(dst + hh * 32 + 16 + quad * 4) = make_uint2(pack2(o2[0], o2[1]), pack2(o2[2], o2[3]));
      }
    }
  } else if (nb < 768) {
    const int g = (nb - 640) >> 6;
    u16* vt = (u16*)(p.ws + OFF_VT);
#pragma unroll
    for (int j = 0; j < 4; ++j) {
      const int m = mb + j * 16 + l15;
      const int b = m >> 12, l = m & 4095;
#pragma unroll
      for (int i = 0; i < 4; ++i)
#pragma unroll
        for (int r = 0; r < 4; ++r) {
          const int d = i * 16 + quad * 4 + r;
          vt[((size_t)(b * 2 + g) * 64 + d) * 4096 + l] = f2bf(acc.v[i][j][r]);
        }
    }
  } else if (nb < 2304) {
    u16* z = (u16*)(p.ws + OFF_Z);
#pragma unroll
    for (int j = 0; j < 4; ++j) {
      const int m = mb + j * 16 + l15;
#pragma unroll
      for (int i = 0; i < 4; ++i) {
        const int n = nb - 768 + i * 16 + quad * 4;
        f32x4 a = acc.v[i][j];
        *(uint2*)(z + (size_t)m * 1536 + n) = make_uint2(pack2(a[0], a[1]), pack2(a[2], a[3]));
      }
    }
  } else {
    u16* gt = (u16*)(p.ws + OFF_GATE);
#pragma unroll
    for (int j = 0; j < 4; ++j) {
      const int m = mb + j * 16 + l15;
#pragma unroll
      for (int i = 0; i < 4; ++i) {
        const int n = nb - 2304 + i * 16 + quad * 4;
        f32x4 a = acc.v[i][j];
        float s0 = 1.f / (1.f + __expf(-a[0])), s1 = 1.f / (1.f + __expf(-a[1]));
        float s2 = 1.f / (1.f + __expf(-a[2])), s3 = 1.f / (1.f + __expf(-a[3]));
        *(uint2*)(gt + (size_t)m * 2048 + n) = make_uint2(pack2(s0, s1), pack2(s2, s3));
      }
    }
  }
}

DEV void p2_ctxkv(const Params& p, int tile, u16* sA, u16* sB) {
  const int mt = tile >> 1, nt = tile & 1;
  const int m0 = mt * 128, n0 = nt * 128;
  Acc acc; acc_zero(acc);
  gemm_kloop((const u16*)((const char*)p.out + OO_HC), 1024, (const u16*)(p.ws + OFF_WIN) + (size_t)512 * 1024, 1024, 1024, m0, n0, sA, sB, acc);
  const int tid = threadIdx.x, lane = tid & 63, wave = tid >> 6, wm = wave >> 1, wn = wave & 1;
  const int l15 = lane & 15, quad = lane >> 4;
  const int mb = m0 + wm * 64, nb = n0 + wn * 64;
  const int g = (nb >> 6) & 1;
  if (nb < 128) {
    u16* kc = (u16*)(p.ws + OFF_KC);
#pragma unroll
    for (int j = 0; j < 4; ++j) {
      const int m = mb + j * 16 + l15;
      const int b = m >> 8, c = m & 255;
#pragma unroll
      for (int i = 0; i < 4; ++i) {
        f32x4 a = acc.v[i][j];
        *(uint2*)(kc + ((size_t)(b * 2 + g) * 256 + c) * 64 + i * 16 + quad * 4) = make_uint2(pack2(a[0], a[1]), pack2(a[2], a[3]));
      }
    }
  } else {
    u16* vct = (u16*)(p.ws + OFF_VCT);
#pragma unroll
    for (int j = 0; j < 4; ++j) {
      const int m = mb + j * 16 + l15;
      const int b = m >> 8, c = m & 255;
#pragma unroll
      for (int i = 0; i < 4; ++i)
#pragma unroll
        for (int r = 0; r < 4; ++r) {
          const int d = i * 16 + quad * 4 + r;
          vct[((size_t)(b * 2 + g) * 64 + d) * 256 + c] = f2bf(acc.v[i][j][r]);
        }
    }
  }
}

DEV void p3_attn(const Params& p, int item, u16* sK, u16* sVt) {
  const int tid = threadIdx.x, lane = tid & 63, wave = tid >> 6, l15 = lane & 15, quad = lane >> 4;
  const int n = item & 31, h = (item >> 5) & 7, b = item >> 8;
  const int g = h >> 2;
  const u16* Q = (const u16*)(p.ws + OFF_Q) + ((size_t)(b * 8 + h) * 4096 + n * 128 + wave * 32) * 64;
  bf16x8 bq[2][2];
#pragma unroll
  for (int qt = 0; qt < 2; ++qt)
#pragma unroll
    for (int ks = 0; ks < 2; ++ks) bq[qt][ks] = *(const bf16x8*)(Q + (qt * 16 + l15) * 64 + ks * 32 + quad * 8);
  const float sink = p.attn_sink[h];
  float mrun[2] = {sink, sink};
  float lrun[2];
  lrun[0] = lrun[1] = (quad == 0) ? 1.f : 0.f;
  f32x4 O[4][2];
#pragma unroll
  for (int dt = 0; dt < 4; ++dt)
#pragma unroll
    for (int qt = 0; qt < 2; ++qt) O[dt][qt] = (f32x4){0.f, 0.f, 0.f, 0.f};

  u32x4 pk[4], pv[4];
#define ATT_LOAD(KB)                                                                                  \
  {                                                                                                   \
    const u16* Ksrc; const u16* Vsrc; int vstride;                                                    \
    if ((KB) < 3) {                                                                                   \
      const int nbk = n + (KB) - 1;                                                                   \
      Ksrc = (const u16*)(p.ws + OFF_K) + ((size_t)(b * 2 + g) * 4096 + nbk * 128) * 64;              \
      Vsrc = (const u16*)(p.ws + OFF_VT) + (size_t)(b * 2 + g) * 64 * 4096 + nbk * 128;               \
      vstride = 4096;                                                                                 \
    } else {                                                                                          \
      const int cb = (KB) - 3;                                                                        \
      Ksrc = (const u16*)(p.ws + OFF_KC) + ((size_t)(b * 2 + g) * 256 + cb * 128) * 64;               \
      Vsrc = (const u16*)(p.ws + OFF_VCT) + (size_t)(b * 2 + g) * 64 * 256 + cb * 128;                \
      vstride = 256;                                                                                  \
    }                                                                                                 \
    _Pragma("unroll") for (int i = 0; i < 4; ++i) {                                                   \
      const int id = tid + i * 256;                                                                   \
      pk[i] = *(const u32x4*)(Ksrc + (id >> 3) * 64 + (id & 7) * 8);                                  \
      pv[i] = *(const u32x4*)(Vsrc + (size_t)(id >> 4) * vstride + (id & 15) * 8);                    \
    }                                                                                                 \
  }
  int kb = (n == 0) ? 1 : 0;
  ATT_LOAD(kb)
  while (kb < 5) {
#pragma unroll
    for (int i = 0; i < 4; ++i) {
      const int id = tid + i * 256;
      *(u32x4*)(sK + (id >> 3) * 72 + (id & 7) * 8) = pk[i];
      *(u32x4*)(sVt + (id >> 4) * 136 + (id & 15) * 8) = pv[i];
    }
    __syncthreads();
    int nx = kb + 1;
    if (nx == 2 && n == 31) nx = 3;
    if (nx < 5) ATT_LOAD(nx)
#pragma unroll 1
    for (int c4 = 0; c4 < 4; ++c4) {
      f32x4 s[2][2];
#pragma unroll
      for (int kt = 0; kt < 2; ++kt) {
        bf16x8 ak0 = *(const bf16x8*)(sK + (c4 * 32 + kt * 16 + l15) * 72 + quad * 8);
        bf16x8 ak1 = *(const bf16x8*)(sK + (c4 * 32 + kt * 16 + l15) * 72 + 32 + quad * 8);
#pragma unroll
        for (int qt = 0; qt < 2; ++qt) {
          f32x4 z = (f32x4){0.f, 0.f, 0.f, 0.f};
          z = __builtin_amdgcn_mfma_f32_16x16x32_bf16(ak0, bq[qt][0], z, 0, 0, 0);
          z = __builtin_amdgcn_mfma_f32_16x16x32_bf16(ak1, bq[qt][1], z, 0, 0, 0);
          s[kt][qt] = z;
        }
      }
      if (kb == 0 || kb == 2) {
#pragma unroll
        for (int kt = 0; kt < 2; ++kt)
#pragma unroll
          for (int qt = 0; qt < 2; ++qt)
#pragma unroll
            for (int r = 0; r < 4; ++r) {
              const int kk = c4 * 32 + kt * 16 + quad * 4 + r;
              const int qq = wave * 32 + qt * 16 + l15;
              const bool valid = (kb == 0) ? (kk >= qq) : (kk <= qq);
              if (!valid) s[kt][qt][r] = -INFINITY;
            }
      }
      bf16x8 bp[2];
#pragma unroll
      for (int qt = 0; qt < 2; ++qt) {
        float cm = fmaxf(fmaxf(fmaxf(s[0][qt][0], s[0][qt][1]), fmaxf(s[0][qt][2], s[0][qt][3])),
                         fmaxf(fmaxf(s[1][qt][0], s[1][qt][1]), fmaxf(s[1][qt][2], s[1][qt][3])));
        cm = fmaxf(cm, __shfl_xor(cm, 16));
        cm = fmaxf(cm, __shfl_xor(cm, 32));
        const float mnew = fmaxf(mrun[qt], cm);
        const float alpha = __expf(mrun[qt] - mnew);
        mrun[qt] = mnew;
        float ps = 0.f;
        float pv[8];
#pragma unroll
        for (int r = 0; r < 4; ++r) {
          pv[r] = __expf(s[0][qt][r] - mnew);
          pv[4 + r] = __expf(s[1][qt][r] - mnew);
          ps += pv[r] + pv[4 + r];
        }
        lrun[qt] = lrun[qt] * alpha + ps;
#pragma unroll
        for (int dt = 0; dt < 4; ++dt) {
          O[dt][qt][0] *= alpha; O[dt][qt][1] *= alpha; O[dt][qt][2] *= alpha; O[dt][qt][3] *= alpha;
        }
        union { bf16x8 v; unsigned u[4]; } pk;
        pk.u[0] = pack2(pv[0], pv[1]); pk.u[1] = pack2(pv[2], pv[3]);
        pk.u[2] = pack2(pv[4], pv[5]); pk.u[3] = pack2(pv[6], pv[7]);
        bp[qt] = pk.v;
      }
#pragma unroll
      for (int dt = 0; dt < 4; ++dt) {
        union { bf16x8 v; uint2 h[2]; } av;
        const u16* vrow = sVt + (dt * 16 + l15) * 136 + c4 * 32 + quad * 4;
        av.h[0] = *(const uint2*)(vrow);
        av.h[1] = *(const uint2*)(vrow + 16);
#pragma unroll
        for (int qt = 0; qt < 2; ++qt) O[dt][qt] = __builtin_amdgcn_mfma_f32_16x16x32_bf16(av.v, bp[qt], O[dt][qt], 0, 0, 0);
      }
    }
    __syncthreads();
    kb = nx;
  }
  u16* Y = (u16*)(p.ws + OFF_YATT);
#pragma unroll
  for (int qt = 0; qt < 2; ++qt) {
    float l = lrun[qt];
    l += __shfl_xor(l, 16);
    l += __shfl_xor(l, 32);
    const float inv = 1.f / l;
    const int t = b * 4096 + n * 128 + wave * 32 + qt * 16 + l15;
#pragma unroll
    for (int dt = 0; dt < 4; ++dt) {
      f32x4 o = O[dt][qt];
      *(uint2*)(Y + (size_t)t * 512 + h * 64 + dt * 16 + quad * 4) = make_uint2(pack2(o[0] * inv, o[1] * inv), pack2(o[2] * inv, o[3] * inv));
    }
  }
}

DEV void p3_hypre(const Params& p, int item, u16* sm) {
  const int tid = threadIdx.x;
  const int cb = item & 7, tb = (item >> 3) & 63, b = item >> 9;
  const int tq = tid >> 6, ch = tid & 63;
  const int c = cb * 64 + ch;
  u16* su = sm;
  u16* sx = sm + 64 * 66;
  float w[3][3], bias[3];
#pragma unroll
  for (int s = 0; s < 3; ++s) {
#pragma unroll
    for (int k = 0; k < 3; ++k) w[s][k] = p.hy_conv_w[k * 1536 + s * 512 + c];
    bias[s] = p.hy_conv_b[s * 512 + c];
  }
  const u16* Z = (const u16*)(p.ws + OFF_Z) + (size_t)b * 4096 * 1536;
  const int l0 = tb * 64 + tq * 16;
  float zv[18][3];
#pragma unroll
  for (int i = 0; i < 18; ++i) {
    const int l = l0 - 1 + i;
    const bool ok = (l >= 0) && (l < 4096);
    const int lc = ok ? l : l0;
#pragma unroll
    for (int s2 = 0; s2 < 3; ++s2) {
      const float v = bf2f(Z[(size_t)lc * 1536 + s2 * 512 + c]);
      zv[i][s2] = ok ? v : 0.f;
    }
  }
#pragma unroll
  for (int i = 0; i < 16; ++i) {
    float cv[3];
#pragma unroll
    for (int s2 = 0; s2 < 3; ++s2) cv[s2] = zv[i][s2] * w[s2][0] + zv[i + 1][s2] * w[s2][1] + zv[i + 2][s2] * w[s2][2] + bias[s2];
    su[ch * 66 + tq * 16 + i] = f2bf(cv[2] * cv[1]);
    sx[ch * 66 + tq * 16 + i] = f2bf(cv[0]);
  }
  __syncthreads();
  const int chr = tid >> 2, part = tid & 3;
  const int cc = cb * 64 + chr;
  const unsigned* ru = (const unsigned*)(su + chr * 66 + part * 16);
  const unsigned* rx = (const unsigned*)(sx + chr * 66 + part * 16);
  u16* UT = (u16*)((char*)p.out + OO_UT) + ((size_t)(cc * 4 + b) * 4096 + tb * 64 + part * 16);
  u16* XT = (u16*)((char*)p.out + OO_X0T) + ((size_t)(cc * 4 + b) * 4096 + tb * 64 + part * 16);
  ((uint4*)UT)[0] = make_uint4(ru[0], ru[1], ru[2], ru[3]);
  ((uint4*)UT)[1] = make_uint4(ru[4], ru[5], ru[6], ru[7]);
  ((uint4*)XT)[0] = make_uint4(rx[0], rx[1], rx[2], rx[3]);
  ((uint4*)XT)[1] = make_uint4(rx[4], rx[5], rx[6], rx[7]);
  __syncthreads();
}

DEV void p3_toeplitz(const Params& p, int c, char* smem) {
  const int tid = threadIdx.x, lane = tid & 63, wave = tid >> 6, l15 = lane & 15, quad = lane >> 4;
  u16* sG0 = (u16*)smem;
  u16* sG1 = (u16*)(smem + 16384 + 64);
  u16* sU = (u16*)(smem + 32768 + 128);
  u16* sZ = sU + 4 * 64 * 72;
  const u16* G = (const u16*)((const char*)p.out + OO_G) + (size_t)c * 8192;
  const u16* UT = (const u16*)((const char*)p.out + OO_UT) + (size_t)c * 16384;
#pragma unroll
  for (int i = 0; i < 4; ++i) {
    const int id = tid + i * 256;
    *(uint4*)(sG0 + id * 8) = *(const uint4*)(G + id * 8);
  }
#pragma unroll
  for (int i = 0; i < 8; ++i) {
    const int id = tid + i * 256;
    const int bb = id >> 9, blk = (id >> 3) & 63, c8 = id & 7;
    *(uint4*)(sU + (bb * 64 + blk) * 72 + c8 * 8) = *(const uint4*)(UT + id * 8);
  }
  if (tid < 72) sZ[tid] = 0;
  __syncthreads();
  for (int i = tid; i < 8192; i += 256) sG1[i] = (i < 8191) ? sG0[i + 1] : (u16)0;
  __syncthreads();

  Acc acc; acc_zero(acc);
  const u16* gbase = (l15 & 1) ? sG0 : (sG1 - 1);
  const u16* ubase = sU + wave * 64 * 72 + quad * 8;
  const u16* zbase = sZ + quad * 8;
  for (int d = -63; d <= 63; ++d) {
    const int base = 4095 - 64 * d - l15 + quad * 8;
    bf16x8 af[4][2];
#pragma unroll
    for (int mt = 0; mt < 4; ++mt)
#pragma unroll
      for (int ks = 0; ks < 2; ++ks) {
        const unsigned* gp = (const unsigned*)(gbase + base - mt * 16 + ks * 32);
        union { bf16x8 v; unsigned u[4]; } t;
        t.u[0] = gp[0]; t.u[1] = gp[1]; t.u[2] = gp[2]; t.u[3] = gp[3];
        af[mt][ks] = t.v;
      }
#pragma unroll
    for (int nt = 0; nt < 4; ++nt) {
      if (nt * 16 + 15 - d < 0 || nt * 16 - d > 63) continue;
      const int ip = nt * 16 + l15 - d;
      const u16* up = (ip >= 0 && ip < 64) ? (ubase + ip * 72) : zbase;
      bf16x8 b0 = *(const bf16x8*)(up);
      bf16x8 b1 = *(const bf16x8*)(up + 32);
#pragma unroll
      for (int mt = 0; mt < 4; ++mt) {
        acc.v[mt][nt] = __builtin_amdgcn_mfma_f32_16x16x32_bf16(af[mt][0], b0, acc.v[mt][nt], 0, 0, 0);
        acc.v[mt][nt] = __builtin_amdgcn_mfma_f32_16x16x32_bf16(af[mt][1], b1, acc.v[mt][nt], 0, 0, 0);
      }
    }
  }
  const float ninv = ((const float*)(p.ws + OFF_NINV))[c];
  const float skip = p.hy_skip[c];
  const u16* XT = (const u16*)((const char*)p.out + OO_X0T) + ((size_t)(c * 4 + wave) * 4096);
  u16* Y = (u16*)(p.ws + OFF_YHY);
#pragma unroll
  for (int nt = 0; nt < 4; ++nt) {
    const int ib = nt * 16 + l15;
#pragma unroll
    for (int mt = 0; mt < 4; ++mt) {
      const int r0 = mt * 16 + quad * 4;
      const int t = ib * 64 + r0;
      uint2 uu = *(const uint2*)(sU + (wave * 64 + ib) * 72 + r0);
      uint2 xx = *(const uint2*)(XT + t);
      float uv[4] = {bflo(uu.x), bfhi(uu.x), bflo(uu.y), bfhi(uu.y)};
      float xv[4] = {bflo(xx.x), bfhi(xx.x), bflo(xx.y), bfhi(xx.y)};
#pragma unroll
      for (int r = 0; r < 4; ++r) {
        float y = acc.v[mt][nt][r] * ninv + uv[r] * skip;
        Y[(size_t)(wave * 4096 + t + r) * 512 + c] = f2bf(y * xv[r]);
      }
    }
  }
  __syncthreads();
}

DEV void p4_merge(const Params& p, int tile, u16* sA, u16* sB) {
  const int mt = tile >> 3, nt = tile & 7;
  const int m0 = mt * 128, n0 = nt * 128;
  const int tid = threadIdx.x, lane = tid & 63, wave = tid >> 6, wm = wave >> 1, wn = wave & 1;
  const int l15 = lane & 15, quad = lane >> 4;
  const int mb = m0 + wm * 64, nb = n0 + wn * 64;
  const u16* gt = (const u16*)(p.ws + OFF_GATE);
  u16* mg = (u16*)(p.ws + OFF_MERGED);
  Acc a1; acc_zero(a1);
  gemm_kloop((const u16*)(p.ws + OFF_YATT), 512, (const u16*)(p.ws + OFF_WOA), 512, 512, m0, n0, sA, sB, a1);
  asm volatile("" ::: "memory");
#pragma unroll
  for (int j = 0; j < 4; ++j) {
    const int m = mb + j * 16 + l15;
#pragma unroll
    for (int i = 0; i < 4; ++i) {
      const int n = nb + i * 16 + quad * 4;
      uint2 ga = *(const uint2*)(gt + (size_t)m * 2048 + n);
      f32x4 x = a1.v[i][j];
      *(uint2*)(mg + (size_t)m * 1024 + n) = make_uint2(pack2(bflo(ga.x) * x[0], bfhi(ga.x) * x[1]), pack2(bflo(ga.y) * x[2], bfhi(ga.y) * x[3]));
    }
  }
  asm volatile("" ::: "memory");
  acc_zero(a1);
  gemm_kloop((const u16*)(p.ws + OFF_YHY), 512, (const u16*)(p.ws + OFF_WOH), 512, 512, m0, n0, sA, sB, a1);
  asm volatile("" ::: "memory");
#pragma unroll
  for (int j = 0; j < 4; ++j) {
    const int m = mb + j * 16 + l15;
#pragma unroll
    for (int i = 0; i < 4; ++i) {
      const int n = nb + i * 16 + quad * 4;
      uint2 gh = *(const uint2*)(gt + (size_t)m * 2048 + 1024 + n);
      uint2 pv = *(const uint2*)(mg + (size_t)m * 1024 + n);
      f32x4 y = a1.v[i][j];
      float o0 = bflo(pv.x) + bflo(gh.x) * y[0];
      float o1 = bfhi(pv.x) + bfhi(gh.x) * y[1];
      float o2 = bflo(pv.y) + bflo(gh.y) * y[2];
      float o3 = bfhi(pv.y) + bfhi(gh.y) * y[3];
      *(uint2*)(mg + (size_t)m * 1024 + n) = make_uint2(pack2(o0, o1), pack2(o2, o3));
    }
  }
}

DEV void p5_out(const Params& p, int tile, u16* sA, u16* sB) {
  const int mt = tile >> 3, nt = tile & 7;
  const int m0 = mt * 128, n0 = nt * 128;
  Acc acc; acc_zero(acc);
  gemm_kloop((const u16*)(p.ws + OFF_MERGED), 1024, (const u16*)(p.ws + OFF_WOUT), 1024, 1024, m0, n0, sA, sB, acc);
  const int tid = threadIdx.x, lane = tid & 63, wave = tid >> 6, wm = wave >> 1, wn = wave & 1;
  const int l15 = lane & 15, quad = lane >> 4;
  const int mb = m0 + wm * 64, nb = n0 + wn * 64;
  const float* mod = (const float*)(p.ws + OFF_MOD);
#pragma unroll
  for (int j = 0; j < 4; ++j) {
    const int m = mb + j * 16 + l15;
    const int b = m >> 12;
#pragma unroll
    for (int i = 0; i < 4; ++i) {
      const int n = nb + i * 16 + quad * 4;
      float4 g1 = *(const float4*)(mod + b * 6144 + 2048 + n);
      float4 xv = *(const float4*)(p.x + (size_t)m * 1024 + n);
      f32x4 a = acc.v[i][j];
      float4 o = make_float4(xv.x + g1.x * a[0], xv.y + g1.y * a[1], xv.z + g1.z * a[2], xv.w + g1.w * a[3]);
      *(float4*)(p.out + (size_t)m * 1024 + n) = o;
    }
  }
}

DEV void p7_qp(const Params& p, int tile, u16* sA, u16* sB) {
  const int mt = tile >> 3, nt = tile & 7;
  const int m0 = mt * 128, n0 = nt * 128;
  Acc acc; acc_zero(acc);
  gemm_kloop((const u16*)(p.ws + OFF_H2), 1024, (const u16*)(p.ws + OFF_WQ), 1024, 1024, m0, n0, sA, sB, acc);
  const int tid = threadIdx.x, lane = tid & 63, wave = tid >> 6, wm = wave >> 1, wn = wave & 1;
  const int l15 = lane & 15, quad = lane >> 4;
  const int mb = m0 + wm * 64, nb = n0 + wn * 64;
  u16* qp = (u16*)(p.ws + OFF_QP);
#pragma unroll
  for (int j = 0; j < 4; ++j) {
    const int m = mb + j * 16 + l15;
#pragma unroll
    for (int i = 0; i < 4; ++i) {
      const int n = nb + i * 16 + quad * 4;
      f32x4 a = acc.v[i][j];
      *(uint2*)(qp + (size_t)m * 1024 + n) = make_uint2(pack2(a[0], a[1]), pack2(a[2], a[3]));
    }
  }
}

DEV unsigned f2ord(float f) {
  const unsigned u = __float_as_uint(f);
  return u ^ (((int)u >> 31) | 0x80000000u);
}
DEV float ord2f(unsigned k) {
  const unsigned m = (k & 0x80000000u) ? 0x80000000u : 0xffffffffu;
  return __uint_as_float(k ^ m);
}
DEV unsigned umax_(unsigned a, unsigned b) { return a > b ? a : b; }
DEV unsigned umin_(unsigned a, unsigned b) { return a < b ? a : b; }

DEV void sort16_desc(unsigned (&v)[16]) {
#pragma unroll
  for (int k = 2; k <= 16; k <<= 1)
#pragma unroll
    for (int j = k >> 1; j > 0; j >>= 1)
#pragma unroll
      for (int i = 0; i < 16; ++i) {
        const int l = i ^ j;
        if (l > i) {
          const bool desc = ((i & k) == 0);
          const unsigned a = v[i], b = v[l];
          const unsigned hi = umax_(a, b), lo = umin_(a, b);
          v[i] = desc ? hi : lo;
          v[l] = desc ? lo : hi;
        }
      }
}
DEV void merge16_desc(unsigned (&v)[16]) {
#pragma unroll
  for (int j = 8; j > 0; j >>= 1)
#pragma unroll
    for (int i = 0; i < 16; ++i) {
      const int l = i ^ j;
      if (l > i) {
        const unsigned a = v[i], b = v[l];
        v[i] = umax_(a, b);
        v[l] = umin_(a, b);
      }
    }
}
DEV void xmerge16(unsigned (&v)[16], int off) {
  unsigned pr[16];
#pragma unroll
  for (int i = 0; i < 16; ++i) pr[i] = (unsigned)__shfl_xor((int)v[i], off);
#pragma unroll
  for (int i = 0; i < 16; ++i) v[i] = umax_(v[i], pr[15 - i]);
  merge16_desc(v);
}

DEV void route_top16_of_128(const u16* __restrict__ keys, const u16* __restrict__ qp, int l15, int quad, unsigned (&out)[16]) {
  bf16x8 b0 = *(const bf16x8*)(qp);
  bf16x8 b1 = *(const bf16x8*)(qp + 32);
  unsigned ka[16], kb[16];
#pragma unroll
  for (int kt = 0; kt < 8; ++kt) {
    bf16x8 a0 = *(const bf16x8*)(keys + (kt * 16 + l15) * 64 + quad * 8);
    bf16x8 a1 = *(const bf16x8*)(keys + (kt * 16 + l15) * 64 + 32 + quad * 8);
    f32x4 z = (f32x4){0.f, 0.f, 0.f, 0.f};
    z = __builtin_amdgcn_mfma_f32_16x16x32_bf16(a0, b0, z, 0, 0, 0);
    z = __builtin_amdgcn_mfma_f32_16x16x32_bf16(a1, b1, z, 0, 0, 0);
#pragma unroll
    for (int r = 0; r < 4; ++r) {
      const unsigned key = (f2ord(z[r]) & ~127u) | (unsigned)(kt * 16 + quad * 4 + r);
      if (kt < 4) ka[kt * 4 + r] = key; else kb[(kt - 4) * 4 + r] = key;
    }
  }
  sort16_desc(ka);
  sort16_desc(kb);
#pragma unroll
  for (int i = 0; i < 16; ++i) out[i] = umax_(ka[i], kb[15 - i]);
  merge16_desc(out);
  xmerge16(out, 16);
  xmerge16(out, 32);
}

DEV void p8_route(const Params& p, int task, char* wsm) {
  static constexpr unsigned char kTab[52] = {
      0x00, 0x01, 0x02, 0x03, 0x04, 0x05, 0x06, 0x07, 0x08, 0x09, 0x0A, 0x0B, 0x0C, 0x0D, 0x0E, 0x0F,
      0x10, 0x11, 0x12, 0x13, 0x14, 0x15, 0x16, 0x17, 0x20, 0x21, 0x22, 0x23, 0x24, 0x30, 0x31, 0x32, 0x33,
      0x40, 0x41, 0x42, 0x50, 0x51, 0x60, 0x61, 0x70, 0x71, 0x80, 0x90, 0xA0, 0xB0, 0xC0, 0xD0, 0xE0, 0xF0, 0x00, 0x00};
  const int lane = threadIdx.x & 63, l15 = lane & 15, quad = lane >> 4;
  const int h = task & 7, tt = task >> 3;
  const int t0 = tt * 16;
  float* s1v = (float*)wsm;
  float* s2v = s1v + 256;
  int* i1 = (int*)(s2v + 256);
  int* i2 = i1 + 256;
  const u16* keys = (const u16*)(p.ws + OFF_KEYS) + (size_t)(h * 2) * 128 * 64;
  const u16* qp = (const u16*)(p.ws + OFF_QP) + (size_t)(t0 + l15) * 1024 + h * 128 + quad * 8;
  unsigned l1[16], l2[16];
  route_top16_of_128(keys, qp, l15, quad, l1);
  route_top16_of_128(keys + 128 * 64, qp + 64, l15, quad, l2);
  if (quad == 0) {
#pragma unroll
    for (int i = 0; i < 16; ++i) { s1v[l15 * 16 + i] = ord2f(l1[i] & ~127u); i1[l15 * 16 + i] = (int)(l1[i] & 127u); }
  } else if (quad == 1) {
#pragma unroll
    for (int i = 0; i < 16; ++i) { s2v[l15 * 16 + i] = ord2f(l2[i] & ~127u); i2[l15 * 16 + i] = (int)(l2[i] & 127u); }
  }
  __builtin_amdgcn_fence(__ATOMIC_RELEASE, "wavefront");
  __builtin_amdgcn_wave_barrier();
  __builtin_amdgcn_fence(__ATOMIC_ACQUIRE, "wavefront");
  unsigned ck[16];
#pragma unroll
  for (int s = 0; s < 16; ++s) {
    const int c = quad + 4 * s;
    unsigned key = 0u;
    if (s < 13 && c < 50) {
      const unsigned ab = kTab[c];
      const float val = s1v[l15 * 16 + (ab >> 4)] + s2v[l15 * 16 + (ab & 15)];
      key = (f2ord(val) & ~255u) | ab;
    }
    ck[s] = key;
  }
  sort16_desc(ck);
  xmerge16(ck, 16);
  xmerge16(ck, 32);
  if (quad == 0) {
    float e[16];
    const float vmax = ord2f(ck[0] & ~255u);
    float ssum = 0.f;
#pragma unroll
    for (int i = 0; i < 16; ++i) { e[i] = __expf(ord2f(ck[i] & ~255u) - vmax); ssum += e[i]; }
    const float inv = 1.f / ssum;
    int* ridx = (int*)(p.ws + OFF_RIDX) + (size_t)(t0 + l15) * 128 + h * 16;
    float* rw = (float*)(p.ws + OFF_RW) + (size_t)(t0 + l15) * 128 + h * 16;
#pragma unroll
    for (int i = 0; i < 16; i += 4) {
      int ee[4]; float ww[4];
#pragma unroll
      for (int j = 0; j < 4; ++j) {
        const unsigned ab = ck[i + j] & 255u;
        ee[j] = i1[l15 * 16 + (ab >> 4)] * 128 + i2[l15 * 16 + (ab & 15)];
        ww[j] = e[i + j] * inv;
      }
      *(int4*)(ridx + i) = make_int4(ee[0], ee[1], ee[2], ee[3]);
      *(float4*)(rw + i) = make_float4(ww[0], ww[1], ww[2], ww[3]);
    }
  }
  __builtin_amdgcn_fence(__ATOMIC_RELEASE, "wavefront");
  __builtin_amdgcn_wave_barrier();
}

DEV float gelu_tanh(float x) {
  const float u = 0.7978845608028654f * (x + 0.044715f * x * x * x);
  return 0.5f * x * (1.f + tanhf(u));
}

DEV void unpack8(const uint4& q, float* f) {
  f[0] = bflo(q.x); f[1] = bfhi(q.x); f[2] = bflo(q.y); f[3] = bfhi(q.y);
  f[4] = bflo(q.z); f[5] = bfhi(q.z); f[6] = bflo(q.w); f[7] = bfhi(q.w);
}

DEV float dpp_add(float v, const int ctrl_sel) {
  return v;
}
typedef __attribute__((ext_vector_type(2))) __bf16 bf2_t;
DEV float dot2bf(unsigned a, unsigned b, float c) {
  return __builtin_amdgcn_fdot2_f32_bf16(__builtin_bit_cast(bf2_t, a), __builtin_bit_cast(bf2_t, b), c, false);
}
#define DPP_ADD(v, ctrl) ((v) + __builtin_bit_cast(float, __builtin_amdgcn_update_dpp(0, __builtin_bit_cast(int, (v)), (ctrl), 0xF, 0xF, true)))

DEV float reduce4_rows(float d0, float d1, float d2, float d3, int lane) {
  const bool up32 = (lane & 32) != 0, up16 = (lane & 16) != 0;
  float k0 = up32 ? d2 : d0, k1 = up32 ? d3 : d1;
  const float s0 = up32 ? d0 : d2, s1 = up32 ? d1 : d3;
  k0 += __shfl_xor(s0, 32);
  k1 += __shfl_xor(s1, 32);
  float kq = up16 ? k1 : k0;
  const float sq = up16 ? k0 : k1;
  kq += __shfl_xor(sq, 16);
  kq = DPP_ADD(kq, 0xB1);
  kq = DPP_ADD(kq, 0x4E);
  kq = DPP_ADD(kq, 0x141);
  kq = DPP_ADD(kq, 0x140);
  return kq;
}

DEV void p9_token(const Params& p, int t, int tnext, int lane, int2& e2n, float2& w2n, u32x4& han, u32x4& hbn) {
  const unsigned char* U8 = (const unsigned char*)(p.ws + OFF_UBF);
  const unsigned char* V8 = (const unsigned char*)(p.ws + OFF_VBF);
  const int2 e2 = e2n;
  const float2 w2 = w2n;
  const u32x4 ha = han, hb = hbn;
  {
    e2n = *(const int2*)((const int*)(p.ws + OFF_RIDX) + (size_t)tnext * 128 + 2 * lane);
    w2n = *(const float2*)((const float*)(p.ws + OFF_RW) + (size_t)tnext * 128 + 2 * lane);
    const u16* h2 = (const u16*)(p.ws + OFF_H2) + (size_t)tnext * 1024 + 16 * lane;
    han = *(const u32x4*)(h2);
    hbn = *(const u32x4*)(h2 + 8);
  }
  float hf[16];
  hf[0] = bflo(ha.x); hf[1] = bfhi(ha.x); hf[2] = bflo(ha.y); hf[3] = bfhi(ha.y);
  hf[4] = bflo(ha.z); hf[5] = bfhi(ha.z); hf[6] = bflo(ha.w); hf[7] = bfhi(ha.w);
  hf[8] = bflo(hb.x); hf[9] = bfhi(hb.x); hf[10] = bflo(hb.y); hf[11] = bfhi(hb.y);
  hf[12] = bflo(hb.z); hf[13] = bfhi(hb.z); hf[14] = bflo(hb.w); hf[15] = bfhi(hb.w);
  float o[16];
#pragma unroll
  for (int k = 0; k < 16; ++k) o[k] = 0.f;
#pragma unroll 1
  for (int g = 0; g < 128; g += 16) {
    u32x4 uu[16], vv[16];
    float wj[16];
#pragma unroll
    for (int j = 0; j < 16; ++j) {
      const int src = (g >> 1) + (j >> 1);
      const int ej = (j & 1) ? __builtin_amdgcn_readlane(e2.y, src) : __builtin_amdgcn_readlane(e2.x, src);
      wj[j] = __builtin_bit_cast(float, (j & 1) ? __builtin_amdgcn_readlane(__builtin_bit_cast(int, w2.y), src)
                                                : __builtin_amdgcn_readlane(__builtin_bit_cast(int, w2.x), src));
      const size_t ro = (size_t)ej * 1024 + 16 * lane;
      uu[j] = *(const u32x4*)(U8 + ro);
      vv[j] = *(const u32x4*)(V8 + ro);
    }
    float d[16];
#pragma unroll
    for (int j = 0; j < 16; ++j) {
      const f32x2 l0 = __builtin_amdgcn_cvt_pk_f32_fp8((int)uu[j].x, false), h0 = __builtin_amdgcn_cvt_pk_f32_fp8((int)uu[j].x, true);
      const f32x2 l1 = __builtin_amdgcn_cvt_pk_f32_fp8((int)uu[j].y, false), h1 = __builtin_amdgcn_cvt_pk_f32_fp8((int)uu[j].y, true);
      const f32x2 l2 = __builtin_amdgcn_cvt_pk_f32_fp8((int)uu[j].z, false), h2v = __builtin_amdgcn_cvt_pk_f32_fp8((int)uu[j].z, true);
      const f32x2 l3 = __builtin_amdgcn_cvt_pk_f32_fp8((int)uu[j].w, false), h3 = __builtin_amdgcn_cvt_pk_f32_fp8((int)uu[j].w, true);
      float a0 = l0.x * hf[0] + l0.y * hf[1], a1 = h0.x * hf[2] + h0.y * hf[3];
      a0 += l1.x * hf[4] + l1.y * hf[5]; a1 += h1.x * hf[6] + h1.y * hf[7];
      a0 += l2.x * hf[8] + l2.y * hf[9]; a1 += h2v.x * hf[10] + h2v.y * hf[11];
      a0 += l3.x * hf[12] + l3.y * hf[13]; a1 += h3.x * hf[14] + h3.y * hf[15];
      d[j] = a0 + a1;
    }
#pragma unroll
    for (int q = 0; q < 4; ++q) {
      const float dot = reduce4_rows(d[4 * q], d[4 * q + 1], d[4 * q + 2], d[4 * q + 3], lane);
      const float gl = gelu_tanh(dot * (1.f / 512.f)) * (1.f / 64.f);
#pragma unroll
      for (int i = 0; i < 4; ++i) {
        const int j = 4 * q + i;
        const float ci = wj[j] * __builtin_bit_cast(float, __builtin_amdgcn_readlane(__builtin_bit_cast(int, gl), 16 * i));
        f32x2 tq;
        tq = __builtin_amdgcn_cvt_pk_f32_fp8((int)vv[j].x, false); o[0] += ci * tq.x; o[1] += ci * tq.y;
        tq = __builtin_amdgcn_cvt_pk_f32_fp8((int)vv[j].x, true);  o[2] += ci * tq.x; o[3] += ci * tq.y;
        tq = __builtin_amdgcn_cvt_pk_f32_fp8((int)vv[j].y, false); o[4] += ci * tq.x; o[5] += ci * tq.y;
        tq = __builtin_amdgcn_cvt_pk_f32_fp8((int)vv[j].y, true);  o[6] += ci * tq.x; o[7] += ci * tq.y;
        tq = __builtin_amdgcn_cvt_pk_f32_fp8((int)vv[j].z, false); o[8] += ci * tq.x; o[9] += ci * tq.y;
        tq = __builtin_amdgcn_cvt_pk_f32_fp8((int)vv[j].z, true);  o[10] += ci * tq.x; o[11] += ci * tq.y;
        tq = __builtin_amdgcn_cvt_pk_f32_fp8((int)vv[j].w, false); o[12] += ci * tq.x; o[13] += ci * tq.y;
        tq = __builtin_amdgcn_cvt_pk_f32_fp8((int)vv[j].w, true);  o[14] += ci * tq.x; o[15] += ci * tq.y;
      }
    }
  }
  const int b = t >> 12;
  const float* mod = (const float*)(p.ws + OFF_MOD) + b * 6144 + 5120 + 16 * lane;
  float* xm = p.out + (size_t)t * 1024 + 16 * lane;
  float xo[16];
  float ss = 0.f;
#pragma unroll
  for (int q = 0; q < 4; ++q) {
    const float4 xv = *(const float4*)(xm + 4 * q);
    const float4 gv = *(const float4*)(mod + 4 * q);
    xo[4 * q + 0] = xv.x + gv.x * o[4 * q + 0];
    xo[4 * q + 1] = xv.y + gv.y * o[4 * q + 1];
    xo[4 * q + 2] = xv.z + gv.z * o[4 * q + 2];
    xo[4 * q + 3] = xv.w + gv.w * o[4 * q + 3];
  }
#pragma unroll
  for (int k = 0; k < 16; ++k) ss += xo[k] * xo[k];
  ss = wave_sum(ss);
  const float r = rsqrtf(ss * (1.f / 1024.f) + 1e-6f);
#pragma unroll
  for (int q = 0; q < 4; ++q) {
    const float4 fg = *(const float4*)(p.final_g + 16 * lane + 4 * q);
    *(float4*)(xm + 4 * q) = make_float4(xo[4 * q] * r * fg.x, xo[4 * q + 1] * r * fg.y, xo[4 * q + 2] * r * fg.z, xo[4 * q + 3] * r * fg.w);
  }
}

DEV void p9_experts4(const Params& p, int task, char* wsm) {
  const int lane = threadIdx.x & 63;
  const int t0 = task * 4;
  int* hist = (int*)wsm;
  unsigned* skey = (unsigned*)(wsm + 1024);
  float* swt = (float*)(wsm + 1024 + 2048);
  u16* sh2 = (u16*)(wsm + 1024 + 4096);
  hist[lane] = 0; hist[lane + 64] = 0; hist[lane + 128] = 0; hist[lane + 192] = 0;
  const int* ridx = (const int*)(p.ws + OFF_RIDX) + (size_t)t0 * 128 + lane * 8;
  const float* rw = (const float*)(p.ws + OFF_RW) + (size_t)t0 * 128 + lane * 8;
  int4 ea = *(const int4*)(ridx), eb = *(const int4*)(ridx + 4);
  float4 wa = *(const float4*)(rw), wb = *(const float4*)(rw + 4);
  int e[8] = {ea.x, ea.y, ea.z, ea.w, eb.x, eb.y, eb.z, eb.w};
  float w[8] = {wa.x, wa.y, wa.z, wa.w, wb.x, wb.y, wb.z, wb.w};
  {
    const u16* h2 = (const u16*)(p.ws + OFF_H2) + (size_t)t0 * 1024;
#pragma unroll
    for (int i = 0; i < 8; ++i) *(u32x4*)(sh2 + (lane + 64 * i) * 8) = *(const u32x4*)(h2 + (lane + 64 * i) * 8);
  }
  __builtin_amdgcn_fence(__ATOMIC_RELEASE, "wavefront");
  __builtin_amdgcn_wave_barrier();
  __builtin_amdgcn_fence(__ATOMIC_ACQUIRE, "wavefront");
  int rank[8];
#pragma unroll
  for (int j = 0; j < 8; ++j) rank[j] = atomicAdd(&hist[e[j] >> 6], 1);
  __builtin_amdgcn_fence(__ATOMIC_RELEASE, "wavefront");
  __builtin_amdgcn_wave_barrier();
  __builtin_amdgcn_fence(__ATOMIC_ACQUIRE, "wavefront");
  {
    const int c0 = hist[4 * lane], c1 = hist[4 * lane + 1], c2 = hist[4 * lane + 2], c3 = hist[4 * lane + 3];
    const int tot = c0 + c1 + c2 + c3;
    int x = tot;
#pragma unroll
    for (int o = 1; o < 64; o <<= 1) { const int y = __shfl_up(x, o); if (lane >= o) x += y; }
    const int base = x - tot;
    __builtin_amdgcn_fence(__ATOMIC_RELEASE, "wavefront");
    __builtin_amdgcn_wave_barrier();
    hist[4 * lane] = base; hist[4 * lane + 1] = base + c0; hist[4 * lane + 2] = base + c0 + c1; hist[4 * lane + 3] = base + c0 + c1 + c2;
  }
  __builtin_amdgcn_fence(__ATOMIC_RELEASE, "wavefront");
  __builtin_amdgcn_wave_barrier();
  __builtin_amdgcn_fence(__ATOMIC_ACQUIRE, "wavefront");
  {
    const unsigned slot = (unsigned)(lane >> 4);
#pragma unroll
    for (int j = 0; j < 8; ++j) {
      const int pos = hist[e[j] >> 6] + rank[j];
      skey[pos] = (unsigned)e[j] | (slot << 14);
      swt[pos] = w[j];
    }
  }
  __builtin_amdgcn_fence(__ATOMIC_RELEASE, "wavefront");
  __builtin_amdgcn_wave_barrier();
  __builtin_amdgcn_fence(__ATOMIC_ACQUIRE, "wavefront");

  float o0[16], o1[16], o2[16], o3[16];
#pragma unroll
  for (int k = 0; k < 16; ++k) { o0[k] = 0.f; o1[k] = 0.f; o2[k] = 0.f; o3[k] = 0.f; }
  const u16* U = (const u16*)(p.ws + OFF_UBF);
  const u16* V = (const u16*)(p.ws + OFF_VBF);
#define P9_LOAD(KK, UU, VV, BB)                                                           \
  _Pragma("unroll") for (int i = 0; i < 4; ++i) {                                         \
    KK[i] = (unsigned)__builtin_amdgcn_readfirstlane((int)skey[4 * (BB) + i]);            \
    const size_t ro = (size_t)(KK[i] & 16383u) * 1024 + 16 * lane;                        \
    UU[i] = *(const u32x4*)(U8 + ro);                                                     \
    VV[i] = *(const u32x4*)(V8 + ro);                                                     \
  }
#define P9_DOTS(KK, UU, BB, COEFV)                                                        \
  {                                                                                       \
    const float myw = swt[4 * (BB) + (lane >> 4)];                                        \
    float d[4];                                                                           \
    _Pragma("unroll") for (int i = 0; i < 4; ++i) {                                       \
      const unsigned slot = KK[i] >> 14;                                                  \
      const u32x4 ha = *(const u32x4*)(sh2 + slot * 1024 + 16 * lane);                    \
      const u32x4 hb = *(const u32x4*)(sh2 + slot * 1024 + 16 * lane + 8);                \
      float acc0 = 0.f, acc1 = 0.f;                                                       \
      {                                                                                   \
        f32x2 l0 = __builtin_amdgcn_cvt_pk_f32_fp8((int)UU[i].x, false), h0 = __builtin_amdgcn_cvt_pk_f32_fp8((int)UU[i].x, true); \
        f32x2 l1 = __builtin_amdgcn_cvt_pk_f32_fp8((int)UU[i].y, false), h1 = __builtin_amdgcn_cvt_pk_f32_fp8((int)UU[i].y, true); \
        f32x2 l2 = __builtin_amdgcn_cvt_pk_f32_fp8((int)UU[i].z, false), h2_ = __builtin_amdgcn_cvt_pk_f32_fp8((int)UU[i].z, true); \
        f32x2 l3 = __builtin_amdgcn_cvt_pk_f32_fp8((int)UU[i].w, false), h3 = __builtin_amdgcn_cvt_pk_f32_fp8((int)UU[i].w, true); \
        acc0 += l0.x * bflo(ha.x) + l0.y * bfhi(ha.x); acc1 += h0.x * bflo(ha.y) + h0.y * bfhi(ha.y);   \
        acc0 += l1.x * bflo(ha.z) + l1.y * bfhi(ha.z); acc1 += h1.x * bflo(ha.w) + h1.y * bfhi(ha.w);   \
        acc0 += l2.x * bflo(hb.x) + l2.y * bfhi(hb.x); acc1 += h2_.x * bflo(hb.y) + h2_.y * bfhi(hb.y); \
        acc0 += l3.x * bflo(hb.z) + l3.y * bfhi(hb.z); acc1 += h3.x * bflo(hb.w) + h3.y * bfhi(hb.w);   \
      }                                                                                   \
      d[i] = acc0 + acc1;                                                                 \
    }                                                                                     \
    const bool up32 = (lane & 32) != 0, up16 = (lane & 16) != 0;                          \
    float k0 = up32 ? d[2] : d[0], k1 = up32 ? d[3] : d[1];                               \
    float s0 = up32 ? d[0] : d[2], s1 = up32 ? d[1] : d[3];                               \
    k0 += __shfl_xor(s0, 32);                                                             \
    k1 += __shfl_xor(s1, 32);                                                             \
    float kq = up16 ? k1 : k0, sq = up16 ? k0 : k1;                                       \
    kq += __shfl_xor(sq, 16);                                                             \
    kq = DPP_ADD(kq, 0xB1);                                                               \
    kq = DPP_ADD(kq, 0x4E);                                                               \
    kq = DPP_ADD(kq, 0x141);                                                              \
    kq = DPP_ADD(kq, 0x140);                                                              \
    COEFV = myw * (1.f / 64.f) * gelu_tanh(kq * (1.f / 512.f));                           \
  }
#define P9_ACCUM(KK, VV, COEFV)                                                           \
  _Pragma("unroll") for (int i = 0; i < 4; ++i) {                                         \
    const float ci = __builtin_bit_cast(float, __builtin_amdgcn_readlane(__builtin_bit_cast(int, COEFV), 16 * i)); \
    const unsigned slot = KK[i] >> 14;                                                    \
    float vf[16];                                                                         \
    {                                                                                     \
      f32x2 t;                                                                            \
      t = __builtin_amdgcn_cvt_pk_f32_fp8((int)VV[i].x, false); vf[0] = t.x; vf[1] = t.y;   \
      t = __builtin_amdgcn_cvt_pk_f32_fp8((int)VV[i].x, true);  vf[2] = t.x; vf[3] = t.y;   \
      t = __builtin_amdgcn_cvt_pk_f32_fp8((int)VV[i].y, false); vf[4] = t.x; vf[5] = t.y;   \
      t = __builtin_amdgcn_cvt_pk_f32_fp8((int)VV[i].y, true);  vf[6] = t.x; vf[7] = t.y;   \
      t = __builtin_amdgcn_cvt_pk_f32_fp8((int)VV[i].z, false); vf[8] = t.x; vf[9] = t.y;   \
      t = __builtin_amdgcn_cvt_pk_f32_fp8((int)VV[i].z, true);  vf[10] = t.x; vf[11] = t.y; \
      t = __builtin_amdgcn_cvt_pk_f32_fp8((int)VV[i].w, false); vf[12] = t.x; vf[13] = t.y; \
      t = __builtin_amdgcn_cvt_pk_f32_fp8((int)VV[i].w, true);  vf[14] = t.x; vf[15] = t.y; \
    }                                                                                     \
    if (slot == 0) { _Pragma("unroll") for (int k = 0; k < 16; ++k) o0[k] += ci * vf[k]; }       \
    else if (slot == 1) { _Pragma("unroll") for (int k = 0; k < 16; ++k) o1[k] += ci * vf[k]; }  \
    else if (slot == 2) { _Pragma("unroll") for (int k = 0; k < 16; ++k) o2[k] += ci * vf[k]; }  \
    else { _Pragma("unroll") for (int k = 0; k < 16; ++k) o3[k] += ci * vf[k]; }                 \
  }
  {
    const unsigned char* U8 = (const unsigned char*)(p.ws + OFF_UBF);
    const unsigned char* V8 = (const unsigned char*)(p.ws + OFF_VBF);
    unsigned kkA[4], kkB[4];
    u32x4 uA[4], vA[4], uB[4], vB[4];
    float cfA, cfB;
    P9_LOAD(kkA, uA, vA, 0)
#pragma unroll 1
    for (int bb = 0; bb < 128; bb += 2) {
      P9_LOAD(kkB, uB, vB, bb + 1)
      P9_DOTS(kkA, uA, bb, cfA)
      P9_ACCUM(kkA, vA, cfA)
      const int n0 = (bb + 2 < 128) ? (bb + 2) : 0;
      P9_LOAD(kkA, uA, vA, n0)
      P9_DOTS(kkB, uB, bb + 1, cfB)
      P9_ACCUM(kkB, vB, cfB)
    }
  }
#pragma unroll
  for (int s = 0; s < 4; ++s) {
    const int t = t0 + s;
    const int b = t >> 12;
    const float* mod = (const float*)(p.ws + OFF_MOD) + b * 6144 + 5120 + 16 * lane;
    float* xm = p.out + (size_t)t * 1024 + 16 * lane;
    const float* oo = (s == 0) ? o0 : ((s == 1) ? o1 : ((s == 2) ? o2 : o3));
    float xo[16];
    float ss = 0.f;
#pragma unroll
    for (int q = 0; q < 4; ++q) {
      const float4 xv = *(const float4*)(xm + 4 * q);
      const float4 gv = *(const float4*)(mod + 4 * q);
      xo[4 * q + 0] = xv.x + gv.x * oo[4 * q + 0];
      xo[4 * q + 1] = xv.y + gv.y * oo[4 * q + 1];
      xo[4 * q + 2] = xv.z + gv.z * oo[4 * q + 2];
      xo[4 * q + 3] = xv.w + gv.w * oo[4 * q + 3];
    }
#pragma unroll
    for (int k = 0; k < 16; ++k) ss += xo[k] * xo[k];
    ss = wave_sum(ss);
    const float r = rsqrtf(ss * (1.f / 1024.f) + 1e-6f);
#pragma unroll
    for (int q = 0; q < 4; ++q) {
      const float4 fg = *(const float4*)(p.final_g + 16 * lane + 4 * q);
      *(float4*)(xm + 4 * q) = make_float4(xo[4 * q] * r * fg.x, xo[4 * q + 1] * r * fg.y, xo[4 * q + 2] * r * fg.z, xo[4 * q + 3] * r * fg.w);
    }
  }
  __builtin_amdgcn_fence(__ATOMIC_RELEASE, "wavefront");
  __builtin_amdgcn_wave_barrier();
}

#define XB_TMO      128
#define XB_XCNT(j)  (256  + 64 * (j))
#define XB_XSUB(j)  (1280 + 64 * (j))
#define XB_XGEN(j)  (2304 + 64 * (j))
#define XB_TOP      3328
#define XB_TOPGEN   3392
#define XCD_BAR_WORDS 3456
#define XB_SPIN_CAP (1u << 18)
#define LAS __attribute__((address_space(3)))

__device__ __forceinline__ unsigned xb_ld(unsigned* p)              { return __hip_atomic_load(p, __ATOMIC_RELAXED, __HIP_MEMORY_SCOPE_AGENT); }
__device__ __forceinline__ unsigned xb_add(unsigned* p, unsigned v) { return __hip_atomic_fetch_add(p, v, __ATOMIC_RELAXED, __HIP_MEMORY_SCOPE_AGENT); }
__device__ __forceinline__ unsigned xb_xcc_id() { return (unsigned)__builtin_amdgcn_s_getreg((3 << 11) | 20) & 0xFu; }
#define XB_SPIN(cond, bar) do { unsigned _sp = 0; while (cond) { __builtin_amdgcn_s_sleep(1); \
    if ((++_sp & 255u) == 0u) { if (xb_ld(&(bar)[XB_TMO])) break; if (_sp > XB_SPIN_CAP) { atomicAdd(&(bar)[XB_TMO], 1u); break; } } } } while (0)

struct XcdBarrier {
    unsigned* bar; unsigned x;
    volatile LAS unsigned* st;
};

__device__ __forceinline__ XcdBarrier xcd_barrier_post(unsigned* bar, volatile LAS unsigned* st) {
    XcdBarrier b; b.bar = bar; b.x = xb_xcc_id(); b.st = st;
    if (threadIdx.x == 0) (void)xb_add(&bar[XB_XCNT(b.x)], 1u);
    return b;
}
__device__ __forceinline__ void xcd_barrier_complete(unsigned* bar, unsigned x, unsigned& nloc, unsigned& nx) {
    const unsigned G = gridDim.x * gridDim.y * gridDim.z;
    unsigned sum, cnt, mine, sp = 0u;
    for (;;) {
        sum = 0u; cnt = 0u; mine = 0u;
#pragma unroll
        for (unsigned j = 0; j < 16; ++j) { const unsigned c = xb_ld(&bar[XB_XCNT(j)]); sum += c; cnt += (c > 0u) ? 1u : 0u; mine = (j == x) ? c : mine; }
        if (sum == G) break;
        __builtin_amdgcn_s_sleep(1);
        if ((++sp & 255u) == 0u) { if (xb_ld(&bar[XB_TMO])) break; if (sp > XB_SPIN_CAP) { atomicAdd(&bar[XB_TMO], 1u); break; } }
    }
    nloc = mine > 0u ? mine : 1u; nx = cnt > 0u ? cnt : 1u;
}

__device__ __forceinline__ void xcd_barrier(const XcdBarrier& b) {
    asm volatile("s_waitcnt vmcnt(0)" ::: "memory");
    __syncthreads();
    if (threadIdx.x == 0) {
        unsigned* bar = b.bar;
        __builtin_amdgcn_s_waitcnt(0);
        unsigned nloc = b.st[0], nx = b.st[1];
        if (nloc == 0u) { xcd_barrier_complete(bar, b.x, nloc, nx); b.st[0] = nloc; b.st[1] = nx; }
        const unsigned old = xb_add(&bar[XB_XSUB(b.x)], 1u);
        const unsigned gen = old / nloc;
        if (old + 1u == (gen + 1u) * nloc) {
            __builtin_amdgcn_fence(__ATOMIC_RELEASE, "agent");
            asm volatile("s_waitcnt vmcnt(0)" ::: "memory");
            const unsigned og = xb_add(&bar[XB_TOP], 1u);
            const unsigned tg = og / nx;
            if (og + 1u == (tg + 1u) * nx) xb_add(&bar[XB_TOPGEN], 1u);
            else XB_SPIN(xb_ld(&bar[XB_TOPGEN]) == tg, bar);
            __builtin_amdgcn_fence(__ATOMIC_ACQUIRE, "agent");
            xb_add(&bar[XB_XGEN(b.x)], 1u);
            asm volatile("s_waitcnt vmcnt(0)" ::: "memory");
        } else {
            XB_SPIN(xb_ld(&bar[XB_XGEN(b.x)]) == gen, bar);
            __builtin_amdgcn_fence(__ATOMIC_ACQUIRE, "agent");
            asm volatile("s_waitcnt vmcnt(0)" ::: "memory");
        }
    }
    __syncthreads();
}


__global__ void __launch_bounds__(256, 2) mega(Params p) {
  extern __shared__ __attribute__((aligned(16))) char smem[];
  cg::grid_group grid = cg::this_grid();
  const int tid = threadIdx.x, lane = tid & 63, wave = tid >> 6;
  const int nb = gridDim.x, bid = blockIdx.x;
  float* smf = (float*)smem;
  if (p.ws == nullptr) grid.sync();
  volatile LAS unsigned* xst = (volatile LAS unsigned*)(smem + SMEM_XB);
  if (tid == 0) { xst[0] = 0u; xst[1] = 0u; }
  __syncthreads();
  const XcdBarrier xb = xcd_barrier_post((unsigned*)(p.ws + OFF_BAR), xst);
  u16* sA = (u16*)smem;
  u16* sB = (u16*)(smem + 128 * 64 * 2);

  for (int rep_ = 0; rep_ < NREP(0); ++rep_) if (PHON(0)) {
    const int N_MOD = 96, N_TIN = 16 * 68, N_TOA = 8 * 16, N_TOH = 8 * 16, N_TOUT = 16 * 16, N_TQ = 16 * 16, N_HID = 1024;
    const int total = N_MOD + N_TIN + N_TOA + N_TOH + N_TOUT + N_TQ + N_HID + 1;
    for (int it = bid; it < total; it += nb) {
      int i = it;
      if (i < N_MOD) { p0_mod(p, i, smf); continue; }
      i -= N_MOD;
      if (i < N_TIN) { transpose_tile(p.w_in, INW, 1024, (u16*)(p.ws + OFF_WIN), i, smf); continue; }
      i -= N_TIN;
      if (i < N_TOA) { transpose_tile(p.w_o_attn, 1024, 512, (u16*)(p.ws + OFF_WOA), i, smf); continue; }
      i -= N_TOA;
      if (i < N_TOH) { transpose_tile(p.w_o_hy, 1024, 512, (u16*)(p.ws + OFF_WOH), i, smf); continue; }
      i -= N_TOH;
      if (i < N_TOUT) { transpose_tile(p.w_out, 1024, 1024, (u16*)(p.ws + OFF_WOUT), i, smf); continue; }
      i -= N_TOUT;
      if (i < N_TQ) { transpose_tile(p.peer_wq, 1024, 1024, (u16*)(p.ws + OFF_WQ), i, smf); continue; }
      i -= N_TQ;
      if (i < N_HID) { p0_hidden(p, i, smf); continue; }
      float2* rope = (float2*)(p.ws + OFF_ROPE);
      for (int idx = tid; idx < 1024; idx += 256) {
        const int pos = idx >> 4, f = idx & 15;
        const float inv = powf(10000.f, -(float)f / 16.f);
        const float ang = (float)pos * inv;
        rope[idx] = make_float2(cosf(ang), sinf(ang));
      }
    }
    convert_flat(p.peer_keys, (u16*)(p.ws + OFF_KEYS), (size_t)131072);
    convert_flat_fp8(p.peer_u, (unsigned char*)(p.ws + OFF_UBF), (size_t)16384 * 1024, 512.f);
    convert_flat_fp8(p.peer_v, (unsigned char*)(p.ws + OFF_VBF), (size_t)16384 * 1024, 64.f);
  }
  xcd_barrier(xb);

  for (int rep_ = 0; rep_ < NREP(1); ++rep_) if (PHON(1)) {
    const float* mod = (const float*)(p.ws + OFF_MOD);
    const int nrows = T_TOK + 1024;
    for (int r = bid * 4 + wave; r < nrows; r += nb * 4) {
      if (r < T_TOK) {
        const int b = r >> 12;
        norm_row(p.x + (size_t)r * 1024, p.norm1_g, mod + b * 6144, mod + b * 6144 + 1024,
                 (u16*)((char*)p.out + OO_H1) + (size_t)r * 1024, lane);
      } else {
        const int rc = r - T_TOK;
        norm_row(p.ctx + (size_t)rc * 1024, p.norm1_g, mod + 4 * 6144, mod + 4 * 6144 + 1024,
                 (u16*)((char*)p.out + OO_HC) + (size_t)rc * 1024, lane);
      }
    }
    for (int it = bid; it < 128; it += nb) p1_filter(p, it, smf);
  }
  xcd_barrier(xb);

  for (int rep_ = 0; rep_ < NREP(2); ++rep_) if (PHON(2)) {
    if (nb == 512) {
      const int xg = bid & 7, slot = bid >> 3;
      for (int r = 0; r < 8; ++r) {
        const int sup = r * 8 + xg;
        const int mt = (sup >> 2) * 8 + (slot >> 3), nt = (sup & 3) * 8 + (slot & 7);
        p2_inproj(p, mt * 34 + nt, sA, sB);
      }
      if (bid < 256) p2_inproj(p, (bid >> 1) * 34 + 32 + (bid & 1), sA, sB);
      else if (bid < 272) p2_ctxkv(p, bid - 256, sA, sB);
    } else {
      const int total = 128 * 34 + 16;
      for (int it = bid; it < total; it += nb) {
        if (it < 128 * 34) p2_inproj(p, it, sA, sB);
        else p2_ctxkv(p, it - 128 * 34, sA, sB);
      }
    }
  }
  xcd_barrier(xb);

  for (int rep_ = 0; rep_ < NREP(3); ++rep_) if (PHON(3)) {
    const int total = 1024 + 2048;
    for (int it = bid; it < total; it += nb) {
      if (it < 1024) p3_attn(p, it, (u16*)smem, (u16*)(smem + 128 * 72 * 2));
      else p3_hypre(p, it - 1024, (u16*)smem);
    }
  }
  xcd_barrier(xb);

  for (int rep_ = 0; rep_ < NREP(4); ++rep_) if (PHON(4)) for (int it = bid; it < 512; it += nb) p3_toeplitz(p, it, smem);
  xcd_barrier(xb);

  for (int rep_ = 0; rep_ < NREP(5); ++rep_) if (PHON(5)) for (int it = bid; it < 1024; it += nb) p4_merge(p, (nb == 512) ? ((((it >> 9) * 8 + (bid & 7)) * 8 + (bid >> 6)) * 8 + ((bid >> 3) & 7)) : it, sA, sB);
  xcd_barrier(xb);

  for (int rep_ = 0; rep_ < NREP(6); ++rep_) if (PHON(6)) for (int it = bid; it < 1024; it += nb) p5_out(p, (nb == 512) ? ((((it >> 9) * 8 + (bid & 7)) * 8 + (bid >> 6)) * 8 + ((bid >> 3) & 7)) : it, sA, sB);
  xcd_barrier(xb);

  for (int rep_ = 0; rep_ < NREP(7); ++rep_) if (PHON(7)) {
    const float* mod = (const float*)(p.ws + OFF_MOD);
    for (int r = bid * 4 + wave; r < T_TOK; r += nb * 4) {
      const int b = r >> 12;
      norm_row(p.out + (size_t)r * 1024, p.norm2_g, mod + b * 6144 + 3072, mod + b * 6144 + 4096,
               (u16*)(p.ws + OFF_H2) + (size_t)r * 1024, lane);
    }
  }
  xcd_barrier(xb);

  for (int rep_ = 0; rep_ < NREP(8); ++rep_) if (PHON(8)) for (int it = bid; it < 1024; it += nb) p7_qp(p, (nb == 512) ? ((((it >> 9) * 8 + (bid & 7)) * 8 + (bid >> 6)) * 8 + ((bid >> 3) & 7)) : it, sA, sB);
  xcd_barrier(xb);

  for (int rep_ = 0; rep_ < NREP(9); ++rep_) if (PHON(9)) for (int it = bid * 4 + wave; it < 8192; it += nb * 4) p8_route(p, it, smem + wave * 4096);
  xcd_barrier(xb);

  if (PHON(10)) {
    const int nw = nb * 4;
    int t = bid * 4 + wave;
    if (t < T_TOK) {
      int2 e2n = *(const int2*)((const int*)(p.ws + OFF_RIDX) + (size_t)t * 128 + 2 * lane);
      float2 w2n = *(const float2*)((const float*)(p.ws + OFF_RW) + (size_t)t * 128 + 2 * lane);
      u32x4 han = *(const u32x4*)((const u16*)(p.ws + OFF_H2) + (size_t)t * 1024 + 16 * lane);
      u32x4 hbn = *(const u32x4*)((const u16*)(p.ws + OFF_H2) + (size_t)t * 1024 + 16 * lane + 8);
      for (; t < T_TOK; t += nw) {
        const int tn = (t + nw < T_TOK) ? (t + nw) : t;
        p9_token(p, t, tn, lane, e2n, w2n, han, hbn);
      }
    }
  }
}

extern "C" void kernel_launch(void* const* d_in, const int* in_sizes, int n_in, void* d_out, int out_size,
                              void* d_ws, size_t ws_size, hipStream_t stream) {
  static int grid_blocks = 0;
  if (!grid_blocks) {
    int dev = 0, cus = 0, per_cu = 0;
    (void)hipGetDevice(&dev);
    (void)hipDeviceGetAttribute(&cus, hipDeviceAttributeMultiprocessorCount, dev);
    (void)hipFuncSetAttribute((const void*)mega, hipFuncAttributeMaxDynamicSharedMemorySize, SMEM_BYTES);
    (void)hipOccupancyMaxActiveBlocksPerMultiprocessor(&per_cu, mega, 256, SMEM_BYTES);
    if (per_cu > 2) per_cu = 2;
    if (per_cu < 1) per_cu = 1;
    grid_blocks = cus * per_cu;
  }
  Params p{};
  const float** pp = (const float**)&p;
  for (int i = 0; i < 28; ++i) pp[i] = (const float*)d_in[i];
  p.out = (float*)d_out;
  p.ws = (char*)d_ws;
  (void)hipMemsetAsync((char*)d_ws + OFF_BAR, 0, XCD_BAR_WORDS * sizeof(unsigned), stream);
  void* args[] = {&p};
  hipError_t e = hipLaunchCooperativeKernel((void*)mega, dim3(grid_blocks), dim3(256), args, SMEM_BYTES, stream);
  if (e != hipSuccess) fprintf(stderr, "cooperative launch failed: %s (grid %d)\n", hipGetErrorString(e), grid_blocks);
}
```

```cpp
#include <hip/hip_runtime.h>
#include <hip/hip_bf16.h>
#include <hip/hip_cooperative_groups.h>
#include <cstdio>
namespace cg = cooperative_groups;

typedef unsigned short u16;
typedef __attribute__((ext_vector_type(8))) short bf16x8;
typedef __attribute__((ext_vector_type(4))) float f32x4;
typedef __attribute__((ext_vector_type(4))) unsigned u32x4;

#define DEV __device__ __forceinline__
#ifndef PH
#define PH -1
#endif
#define PHON(n) (PH < 0 || PH == (n))
#ifndef REP
#define REP -1
#endif
#define NREP(n) ((REP == (n)) ? 2 : 1)

constexpr int T_TOK = 16384;
constexpr int DM = 1024;
constexpr int SEQL = 4096;
constexpr int INW = 4352;

struct Params {
  const float *x, *c, *ctx, *c_ctx, *w_mod, *b_mod, *norm1_g, *w_in, *attn_sink, *hy_conv_w, *hy_conv_b,
      *hy_fw1, *hy_fb1, *hy_fw2, *hy_fb2, *hy_fw3, *hy_fb3, *hy_freq, *hy_skip, *w_o_attn, *w_o_hy, *w_out,
      *norm2_g, *peer_wq, *peer_keys, *peer_u, *peer_v, *final_g;
  float* out;
  char* ws;
};

constexpr size_t MB = 1u << 20;
constexpr size_t OFF_MOD = 0;
constexpr size_t OFF_ROPE = 128 * 1024;
constexpr size_t OFF_NINV = OFF_ROPE + 8192;
constexpr size_t OFF_H2F = 256 * 1024;
constexpr size_t OFF_WIN = OFF_H2F + MB;
constexpr size_t OFF_WOA = OFF_WIN + 9 * MB;
constexpr size_t OFF_WOH = OFF_WOA + MB;
constexpr size_t OFF_WOUT = OFF_WOH + MB;
constexpr size_t OFF_WQ = OFF_WOUT + 2 * MB;
constexpr size_t OFF_KEYS = OFF_WQ + 2 * MB;
constexpr size_t OFF_UBF = OFF_KEYS + MB;
constexpr size_t OFF_VBF = OFF_UBF + 32 * MB;
constexpr size_t OFF_Q = OFF_VBF + 32 * MB;
constexpr size_t OFF_K = OFF_Q + 16 * MB;
constexpr size_t OFF_VT = OFF_K + 4 * MB;
constexpr size_t OFF_KC = OFF_VT + 4 * MB;
constexpr size_t OFF_VCT = OFF_KC + MB / 2;
constexpr size_t OFF_Z = OFF_VCT + MB / 2;
constexpr size_t OFF_GATE = OFF_Z + 48 * MB;
constexpr size_t OFF_YATT = OFF_GATE + 64 * MB;
constexpr size_t OFF_YHY = OFF_YATT + 16 * MB;
constexpr size_t OFF_RIDX = OFF_Q;
constexpr size_t OFF_RW = OFF_Q + 8 * MB;
constexpr size_t OFF_MERGED = OFF_Z;
constexpr size_t OFF_H2 = OFF_GATE;
constexpr size_t OFF_QP = OFF_GATE + 32 * MB;
constexpr size_t OO_H1 = 0;
constexpr size_t OO_UT = 0;
constexpr size_t OO_X0T = 16 * MB;
constexpr size_t OO_HC = 32 * MB;
constexpr size_t OO_G = 34 * MB;

constexpr int SMEM_BYTES = 70144;
constexpr size_t OFF_BAR = 160 * 1024;
constexpr int SMEM_XB = 70016;

DEV u16 f2bf(float f) {
  unsigned u = __float_as_uint(f);
  u += 0x7fffu + ((u >> 16) & 1u);
  return (u16)(u >> 16);
}
DEV float bf2f(u16 h) { return __uint_as_float(((unsigned)h) << 16); }
DEV unsigned pack2(float a, float b) { return (unsigned)f2bf(a) | ((unsigned)f2bf(b) << 16); }
DEV float bflo(unsigned w) { return __uint_as_float(w << 16); }
DEV float bfhi(unsigned w) { return __uint_as_float(w & 0xffff0000u); }
#define DPP_ADD(v, ctrl) ((v) + __builtin_bit_cast(float, __builtin_amdgcn_update_dpp(0, __builtin_bit_cast(int, (v)), (ctrl), 0xF, 0xF, true)))
DEV float wave_sum(float v) {
#pragma unroll
  for (int o = 32; o > 0; o >>= 1) v += __shfl_xor(v, o);
  return v;
}
DEV float wave_max(float v) {
#pragma unroll
  for (int o = 32; o > 0; o >>= 1) v = fmaxf(v, __shfl_xor(v, o));
  return v;
}

DEV void p0_mod(const Params& p, int item, float* sm) {
  const int tid = threadIdx.x;
  const int cblk = item >> 2, kq = item & 3;
  for (int i = tid; i < 5 * 256; i += 256) {
    const int r = i >> 8, k = kq * 256 + (i & 255);
    const float c = (r < 4) ? p.c[r * 1024 + k] : p.c_ctx[k];
    sm[i] = c / (1.f + expf(-c));
  }
  __syncthreads();
  const int col = cblk * 64 + (tid & 63), sub = tid >> 6;
  float a0 = 0, a1 = 0, a2 = 0, a3 = 0, a4 = 0;
  const float* wp = p.w_mod + (size_t)(kq * 256 + sub * 64) * 6144 + col;
#pragma unroll 16
  for (int k = 0; k < 64; ++k) {
    const float w = wp[(size_t)k * 6144];
    const int kk = sub * 64 + k;
    a0 += sm[kk] * w; a1 += sm[256 + kk] * w; a2 += sm[512 + kk] * w; a3 += sm[768 + kk] * w; a4 += sm[1024 + kk] * w;
  }
  float* red = sm + 5 * 256;
  red[(sub * 5 + 0) * 64 + (tid & 63)] = a0;
  red[(sub * 5 + 1) * 64 + (tid & 63)] = a1;
  red[(sub * 5 + 2) * 64 + (tid & 63)] = a2;
  red[(sub * 5 + 3) * 64 + (tid & 63)] = a3;
  red[(sub * 5 + 4) * 64 + (tid & 63)] = a4;
  __syncthreads();
  float* mod = (float*)(p.ws + OFF_MOD);
  for (int i = tid; i < 320; i += 256) {
    const int r = i >> 6, cc = i & 63;
    float sacc = red[(0 * 5 + r) * 64 + cc] + red[(1 * 5 + r) * 64 + cc] + red[(2 * 5 + r) * 64 + cc] + red[(3 * 5 + r) * 64 + cc];
    if (kq == 0) sacc += p.b_mod[cblk * 64 + cc];
    atomicAdd(mod + r * 6144 + cblk * 64 + cc, sacc);
  }
  __syncthreads();
}

DEV void transpose_tile(const float* __restrict__ src, int N, int K, u16* __restrict__ dst, int tile, float* sm) {
  const int tid = threadIdx.x;
  const int nkt = K >> 6;
  const int kt = tile % nkt, nt = tile / nkt;
  const int k0 = kt * 64, n0 = nt * 64;
  const int c = tid & 63, r = tid >> 6;
#pragma unroll
  for (int rr = 0; rr < 16; ++rr) sm[(rr * 4 + r) * 65 + c] = src[(size_t)(k0 + rr * 4 + r) * N + n0 + c];
  __syncthreads();
  const int nn = tid >> 2, part = tid & 3;
  unsigned w[8];
#pragma unroll
  for (int j = 0; j < 8; ++j) w[j] = pack2(sm[(part * 16 + 2 * j) * 65 + nn], sm[(part * 16 + 2 * j + 1) * 65 + nn]);
  uint4* d = (uint4*)(dst + (size_t)(n0 + nn) * K + k0 + part * 16);
  d[0] = make_uint4(w[0], w[1], w[2], w[3]);
  d[1] = make_uint4(w[4], w[5], w[6], w[7]);
  __syncthreads();
}

DEV void p0_hidden(const Params& p, int item, float* sm) {
  const int tid = threadIdx.x;
  float* z = sm;
  float* h1 = sm + 4 * 36;
  if (tid < 4 * 33) {
    int tt = tid / 33, i = tid % 33;
    int t = item * 4 + tt;
    float v;
    if (i == 0) v = (float)t * (1.f / 4096.f);
    else {
      int band = (i <= 16) ? i : (i - 16);
      float fr = (float)((t * band) & 4095) * (1.f / 4096.f);
      v = (i <= 16) ? cospif(2.f * fr) : sinpif(2.f * fr);
    }
    z[tt * 36 + i] = v;
  }
  __syncthreads();
  const int tt = tid >> 6, j = tid & 63;
  float a = p.hy_fb1[j];
  for (int i = 0; i < 33; ++i) a += z[tt * 36 + i] * p.hy_fw1[i * 64 + j];
  const float fq = p.hy_freq[j];
  h1[tt * 64 + j] = sinf(fq * a);
  __syncthreads();
  float b = p.hy_fb2[j];
  for (int i = 0; i < 64; ++i) b += h1[tt * 64 + i] * p.hy_fw2[i * 64 + j];
  ((u16*)(p.ws + OFF_H2F))[(item * 4 + tt) * 64 + j] = f2bf(sinf(fq * b));
  __syncthreads();
}

DEV void convert_flat(const float* __restrict__ src, u16* __restrict__ dst, size_t n) {
  size_t stride = (size_t)gridDim.x * 256 * 8;
  for (size_t i = ((size_t)blockIdx.x * 256 + threadIdx.x) * 8; i < n; i += stride) {
    float4 a = *(const float4*)(src + i);
    float4 b = *(const float4*)(src + i + 4);
    *(uint4*)(dst + i) = make_uint4(pack2(a.x, a.y), pack2(a.z, a.w), pack2(b.x, b.y), pack2(b.z, b.w));
  }
}

typedef __attribute__((ext_vector_type(2))) float f32x2;
DEV void convert_flat_fp8(const float* __restrict__ src, unsigned char* __restrict__ dst, size_t n, float scale) {
  const size_t q4 = (size_t)gridDim.x * 256 * 16;
  const size_t stride = q4 * 4;
  for (size_t i = ((size_t)blockIdx.x * 256 + threadIdx.x) * 16; i < n; i += stride) {
    float4 a[16];
#pragma unroll
    for (int c = 0; c < 4; ++c) {
      const size_t off = i + c * q4;
      if (off < n) {
#pragma unroll
        for (int q = 0; q < 4; ++q) a[c * 4 + q] = *(const float4*)(src + off + 4 * q);
      }
    }
#pragma unroll
    for (int c = 0; c < 4; ++c) {
      const size_t off = i + c * q4;
      if (off < n) {
        unsigned w[4];
#pragma unroll
        for (int q = 0; q < 4; ++q) {
          int v = 0;
          v = __builtin_amdgcn_cvt_pk_fp8_f32(a[c * 4 + q].x * scale, a[c * 4 + q].y * scale, v, false);
          v = __builtin_amdgcn_cvt_pk_fp8_f32(a[c * 4 + q].z * scale, a[c * 4 + q].w * scale, v, true);
          w[q] = (unsigned)v;
        }
        *(uint4*)(dst + off) = make_uint4(w[0], w[1], w[2], w[3]);
      }
    }
  }
}

DEV void norm_row(const float* __restrict__ xr, const float* __restrict__ g, const float* __restrict__ sh,
                  const float* __restrict__ sc, u16* __restrict__ dst, int lane) {
  float4 v[4];
  float ss = 0.f;
#pragma unroll
  for (int i = 0; i < 4; ++i) {
    v[i] = ((const float4*)xr)[lane + 64 * i];
    ss += v[i].x * v[i].x + v[i].y * v[i].y + v[i].z * v[i].z + v[i].w * v[i].w;
  }
  ss = wave_sum(ss);
  const float r = rsqrtf(ss * (1.f / 1024.f) + 1e-6f);
#pragma unroll
  for (int i = 0; i < 4; ++i) {
    const int idx = lane + 64 * i;
    float4 gg = ((const float4*)g)[idx], s1 = ((const float4*)sh)[idx], s2 = ((const float4*)sc)[idx];
    float y0 = v[i].x * r * gg.x * (1.f + s2.x) + s1.x;
    float y1 = v[i].y * r * gg.y * (1.f + s2.y) + s1.y;
    float y2 = v[i].z * r * gg.z * (1.f + s2.z) + s1.z;
    float y3 = v[i].w * r * gg.w * (1.f + s2.w) + s1.w;
    *(uint2*)(dst + idx * 4) = make_uint2(pack2(y0, y1), pack2(y2, y3));
  }
}

DEV void p1_filter(const Params& p, int item, float* sm) {
  const int tid = threadIdx.x;
  const int c0 = (item >> 2) * 4, tq = item & 3;
  float* wc = sm;
  float* red = sm + 512;
  for (int i = tid; i < 512; i += 256) {
    const int j = i >> 6, k = i & 63;
    wc[i] = p.hy_fw3[k * 1024 + ((j < 4) ? (c0 + j) : (512 + c0 + j - 4))];
  }
  __syncthreads();
  float fb[8], dl[4];
#pragma unroll
  for (int j = 0; j < 8; ++j) fb[j] = p.hy_fb3[(j < 4) ? (c0 + j) : (512 + c0 + j - 4)];
  const float da = logf(1e-2f) / 1.5f, db = logf(1e-2f) / 0.3f;
#pragma unroll
  for (int j = 0; j < 4; ++j) dl[j] = fabsf(da + (db - da) * (float)(c0 + j) / 511.f);
  u16* G = (u16*)((char*)p.out + OO_G);
  const float* H = (const float*)(p.ws + OFF_H2F);
  float as[4] = {0.f, 0.f, 0.f, 0.f};
#pragma unroll 1
  for (int i = 0; i < 4; ++i) {
    const int t = tq * 1024 + i * 256 + tid;
    const float4* hp = (const float4*)(H + t * 64);
    float d[8];
#pragma unroll
    for (int j = 0; j < 8; ++j) d[j] = fb[j];
#pragma unroll 1
    for (int q8 = 0; q8 < 16; q8 += 8) {
      float4 hv[8];
#pragma unroll
      for (int u = 0; u < 8; ++u) hv[u] = hp[q8 + u];
#pragma unroll
      for (int u = 0; u < 8; ++u)
#pragma unroll
        for (int j = 0; j < 8; ++j) {
          const float4 w = *(const float4*)(wc + j * 64 + 4 * (q8 + u));
          d[j] += hv[u].x * w.x + hv[u].y * w.y + hv[u].z * w.z + hv[u].w * w.w;
        }
    }
    const float tn = (float)t * (1.f / 4096.f);
#pragma unroll
    for (int j = 0; j < 4; ++j) {
      const float dec = expf(-tn * dl[j]);
      const float f = d[j] * dec, bw = d[4 + j] * dec;
      u16* Gc = G + (size_t)(c0 + j) * 8192;
      Gc[4095 - t] = f2bf(f);
      as[j] += fabsf(f);
      if (t < 4095) { Gc[4096 + t] = f2bf(bw); as[j] += fabsf(bw); }
      else Gc[8191] = 0;
    }
  }
#pragma unroll
  for (int j = 0; j < 4; ++j) {
    const float v = wave_sum(as[j]);
    if ((tid & 63) == 0) red[(tid >> 6) * 4 + j] = v;
  }
  __syncthreads();
  if (tid < 4) atomicAdd((float*)(p.ws + OFF_BAR + 20480) + c0 + tid, red[tid] + red[4 + tid] + red[8 + tid] + red[12 + tid]);
  __syncthreads();
}

struct Acc { f32x4 v[4][4]; };

DEV void acc_zero(Acc& a) {
#pragma unroll
  for (int i = 0; i < 4; ++i)
#pragma unroll
    for (int j = 0; j < 4; ++j) a.v[i][j] = (f32x4){0.f, 0.f, 0.f, 0.f};
}

#define LDSAS __attribute__((address_space(3)))
DEV void gemm_kloop(const u16* __restrict__ A, int lda, const u16* __restrict__ Bt, int ldb, int K, int m0, int n0,
                    u16* sA, u16* sB_unused, Acc& acc) {
  const int tid = threadIdx.x, lane = tid & 63, wave = tid >> 6, wm = wave >> 1, wn = wave & 1;
  const int l15 = lane & 15, quad = lane >> 4;
  const int rsw = (l15 >> 1) & 7;
  const int nk = K >> 6;
  const int prow = lane >> 3;
  const int pch = lane & 7;
  unsigned oA[4], oB[4];
#pragma unroll
  for (int i = 0; i < 4; ++i) {
    const int row = (wave * 4 + i) * 8 + prow;
    const int c = pch ^ ((row >> 1) & 7);
    oA[i] = (unsigned)(row * lda + c * 8) * 2u;
    oB[i] = (unsigned)(row * ldb + c * 8) * 2u;
  }
  const char* bA = (const char*)(A + (size_t)m0 * lda);
  const char* bB = (const char*)(Bt + (size_t)n0 * ldb);
  LDSAS char* lbase = (LDSAS char*)sA;
#define GEMM_DMA(KT, BUF)                                                                                   \
  _Pragma("unroll") for (int i = 0; i < 4; ++i) {                                                           \
    __builtin_amdgcn_global_load_lds((const unsigned*)(bA + (KT) * 128 + oA[i]), (LDSAS unsigned*)(lbase + (BUF) * 32768 + (wave * 4 + i) * 1024), 16, 0, 0);          \
    __builtin_amdgcn_global_load_lds((const unsigned*)(bB + (KT) * 128 + oB[i]), (LDSAS unsigned*)(lbase + (BUF) * 32768 + 16384 + (wave * 4 + i) * 1024), 16, 0, 0);  \
  }
  GEMM_DMA(0, 0)
  for (int kt = 0; kt < nk; ++kt) {
    asm volatile("s_waitcnt vmcnt(0)" ::: "memory");
    __syncthreads();
    const int buf = kt & 1;
    if (kt + 1 < nk) { GEMM_DMA(kt + 1, buf ^ 1) }
    const u16* tA = sA + buf * 16384;
    const u16* tB = tA + 8192;
    bf16x8 af[2][4], bfr[2][4];
#pragma unroll
    for (int ks = 0; ks < 2; ++ks) {
      const int cs = ((ks * 4 + quad) ^ rsw) * 8;
#pragma unroll
      for (int i = 0; i < 4; ++i) af[ks][i] = *(const bf16x8*)(tB + (wn * 64 + i * 16 + l15) * 64 + cs);
#pragma unroll
      for (int j = 0; j < 4; ++j) bfr[ks][j] = *(const bf16x8*)(tA + (wm * 64 + j * 16 + l15) * 64 + cs);
    }
    __builtin_amdgcn_s_setprio(1);
#pragma unroll
    for (int ks = 0; ks < 2; ++ks)
#pragma unroll
      for (int i = 0; i < 4; ++i)
#pragma unroll
        for (int j = 0; j < 4; ++j) acc.v[i][j] = __builtin_amdgcn_mfma_f32_16x16x32_bf16(af[ks][i], bfr[ks][j], acc.v[i][j], 0, 0, 0);
    __builtin_amdgcn_s_setprio(0);
  }
  __syncthreads();
}

DEV void p1_filter_tile(const Params& p, int tile, u16* sA, u16* sB) {
  const int mt = tile >> 3, nt = tile & 7;
  const int m0 = mt * 128, n0 = nt * 128;
  Acc acc; acc_zero(acc);
  gemm_kloop((const u16*)(p.ws + OFF_H2F), 64, (const u16*)(p.ws + OFF_H2F + 512 * 1024), 64, 64, m0, n0, sA, sB, acc);
  asm volatile("" ::: "memory");
  const int tid = threadIdx.x, lane = tid & 63, wave = tid >> 6, wm = wave >> 1, wn = wave & 1;
  const int l15 = lane & 15, quad = lane >> 4;
  const int mb = m0 + wm * 64, nbase = n0 + wn * 64;
  u16* G = (u16*)((char*)p.out + OO_G);
  float* nsum = (float*)(p.ws + OFF_BAR + 20480);
  const float da = logf(1e-2f) / 1.5f, db = logf(1e-2f) / 0.3f;
  const bool bwd = nbase >= 512;
#pragma unroll
  for (int i = 0; i < 4; ++i)
#pragma unroll
    for (int r = 0; r < 4; ++r) {
      const int col = nbase + i * 16 + quad * 4 + r;
      const int c = col & 511;
      const float fbv = p.hy_fb3[col];
      const float dlc = fabsf(da + (db - da) * (float)c / 511.f);
      u16* Gc = G + (size_t)c * 8192;
      float sum = 0.f;
#pragma unroll
      for (int j = 0; j < 4; ++j) {
        const int t = mb + j * 16 + l15;
        const float val = (acc.v[i][j][r] + fbv) * expf(-(float)t * (1.f / 4096.f) * dlc);
        if (!bwd) { Gc[4095 - t] = f2bf(val); sum += fabsf(val); }
        else if (t < 4095) { Gc[4096 + t] = f2bf(val); sum += fabsf(val); }
        else Gc[8191] = 0;
      }
      sum = DPP_ADD(sum, 0xB1);
      sum = DPP_ADD(sum, 0x4E);
      sum = DPP_ADD(sum, 0x141);
      sum = DPP_ADD(sum, 0x140);
      if (l15 == 0) atomicAdd(nsum + c, sum);
    }
}

DEV void p2_inproj(const Params& p, int tile, u16* sA, u16* sB) {
  const int mt = tile / 34, nt = tile % 34;
  const int m0 = mt * 128, n0 = nt * 128;
  Acc acc; acc_zero(acc);
  gemm_kloop((const u16*)((const char*)p.out + OO_H1), 1024, (const u16*)(p.ws + OFF_WIN), 1024, 1024, m0, n0, sA, sB, acc);
  asm volatile("" ::: "memory");
  const int tid = threadIdx.x, lane = tid & 63, wave = tid >> 6, wm = wave >> 1, wn = wave & 1;
  int l15 = lane & 15, quad = lane >> 4;
  int mb = m0 + wm * 64, nb = n0 + wn * 64;
  asm volatile("" : "+v"(l15), "+v"(quad), "+v"(mb), "+v"(nb));
  mb = __builtin_amdgcn_readfirstlane(mb); nb = __builtin_amdgcn_readfirstlane(nb);
  if (nb < 640) {
    const float2* rope = (const float2*)(p.ws + OFF_ROPE);
    const bool isq = nb < 512;
    const float qs = isq ? 0.125f : 1.f;
#pragma unroll
    for (int j = 0; j < 4; ++j) {
      const int m = mb + j * 16 + l15;
      const int b = m >> 12, l = m & 4095;
      const int prow = l >> 6, pcol = l & 63;
      u16* dst;
      if (isq) dst = (u16*)(p.ws + OFF_Q) + ((size_t)(b * 8 + (nb >> 6)) * 4096 + l) * 64;
      else dst = (u16*)(p.ws + OFF_K) + ((size_t)(b * 2 + ((nb - 512) >> 6)) * 4096 + l) * 64;
#pragma unroll
      for (int hh = 0; hh < 2; ++hh) {
        const int pos = hh ? pcol : prow;
        f32x4 x1 = acc.v[hh * 2][j], x2 = acc.v[hh * 2 + 1][j];
        float o1[4], o2[4];
#pragma unroll
        for (int r = 0; r < 4; ++r) {
          float2 cs = rope[pos * 16 + quad * 4 + r];
          o1[r] = (x1[r] * cs.x - x2[r] * cs.y) * qs;
          o2[r] = (x2[r] * cs.x + x1[r] * cs.y) * qs;
        }
        *(uint2*)(dst + hh * 32 + quad * 4) = make_uint2(pack2(o1[0], o1[1]), pack2(o1[2], o1[3]));
        *(uint2*)(dst + hh * 32 + 16 + quad * 4) = make_uint2(pack2(o2[0], o2[1]), pack2(o2[2], o2[3]));
      }
    }
  } else if (nb < 768) {
    const int g = (nb - 640) >> 6;
    u16* vt = (u16*)(p.ws + OFF_VT);
#pragma unroll
    for (int j = 0; j < 4; ++j) {
      const int m = mb + j * 16 + l15;
      const int b = m >> 12, l = m & 4095;
#pragma unroll
      for (int i = 0; i < 4; ++i)
#pragma unroll
        for (int r = 0; r < 4; ++r) {
          const int d = i * 16 + quad * 4 + r;
          vt[((size_t)(b * 2 + g) * 64 + d) * 4096 + l] = f2bf(acc.v[i][j][r]);
        }
    }
  } else if (nb < 2304) {
    u16* z = (u16*)(p.ws + OFF_Z);
#pragma unroll
    for (int j = 0; j < 4; ++j) {
      const int m = mb + j * 16 + l15;
#pragma unroll
      for (int i = 0; i < 4; ++i) {
        const int n = nb - 768 + i * 16 + quad * 4;
        f32x4 a = acc.v[i][j];
        *(uint2*)(z + (size_t)m * 1536 + n) = make_uint2(pack2(a[0], a[1]), pack2(a[2], a[3]));
      }
    }
  } else {
    u16* gt = (u16*)(p.ws + OFF_GATE);
#pragma unroll
    for (int j = 0; j < 4; ++j) {
      const int m = mb + j * 16 + l15;
#pragma unroll
      for (int i = 0; i < 4; ++i) {
        const int n = nb - 2304 + i * 16 + quad * 4;
        f32x4 a = acc.v[i][j];
        float s0 = 1.f / (1.f + __expf(-a[0])), s1 = 1.f / (1.f + __expf(-a[1]));
        float s2 = 1.f / (1.f + __expf(-a[2])), s3 = 1.f / (1.f + __expf(-a[3]));
        *(uint2*)(gt + (size_t)m * 2048 + n) = make_uint2(pack2(s0, s1), pack2(s2, s3));
      }
    }
  }
}

DEV void p2_ctxkv(const Params& p, int tile, u16* sA, u16* sB) {
  const int mt = tile >> 1, nt = tile & 1;
  const int m0 = mt * 128, n0 = nt * 128;
  Acc acc; acc_zero(acc);
  gemm_kloop((const u16*)((const char*)p.out + OO_HC), 1024, (const u16*)(p.ws + OFF_WIN) + (size_t)512 * 1024, 1024, 1024, m0, n0, sA, sB, acc);
  const int tid = threadIdx.x, lane = tid & 63, wave = tid >> 6, wm = wave >> 1, wn = wave & 1;
  const int l15 = lane & 15, quad = lane >> 4;
  const int mb = m0 + wm * 64, nb = n0 + wn * 64;
  const int g = (nb >> 6) & 1;
  if (nb < 128) {
    u16* kc = (u16*)(p.ws + OFF_KC);
#pragma unroll
    for (int j = 0; j < 4; ++j) {
      const int m = mb + j * 16 + l15;
      const int b = m >> 8, c = m & 255;
#pragma unroll
      for (int i = 0; i < 4; ++i) {
        f32x4 a = acc.v[i][j];
        *(uint2*)(kc + ((size_t)(b * 2 + g) * 256 + c) * 64 + i * 16 + quad * 4) = make_uint2(pack2(a[0], a[1]), pack2(a[2], a[3]));
      }
    }
  } else {
    u16* vct = (u16*)(p.ws + OFF_VCT);
#pragma unroll
    for (int j = 0; j < 4; ++j) {
      const int m = mb + j * 16 + l15;
      const int b = m >> 8, c = m & 255;
#pragma unroll
      for (int i = 0; i < 4; ++i)
#pragma unroll
        for (int r = 0; r < 4; ++r) {
          const int d = i * 16 + quad * 4 + r;
          vct[((size_t)(b * 2 + g) * 64 + d) * 256 + c] = f2bf(acc.v[i][j][r]);
        }
    }
  }
}

DEV void p3_attn(const Params& p, int item, u16* sK, u16* sVt) {
  const int tid = threadIdx.x, lane = tid & 63, wave = tid >> 6, l15 = lane & 15, quad = lane >> 4;
  const int n = item & 31, h = (item >> 5) & 7, b = item >> 8;
  const int g = h >> 2;
  const u16* Q = (const u16*)(p.ws + OFF_Q) + ((size_t)(b * 8 + h) * 4096 + n * 128 + wave * 32) * 64;
  bf16x8 bq[2][2];
#pragma unroll
  for (int qt = 0; qt < 2; ++qt)
#pragma unroll
    for (int ks = 0; ks < 2; ++ks) bq[qt][ks] = *(const bf16x8*)(Q + (qt * 16 + l15) * 64 + ks * 32 + quad * 8);
  const float sink = p.attn_sink[h];
  float mrun[2] = {sink, sink};
  float lrun[2];
  lrun[0] = lrun[1] = (quad == 0) ? 1.f : 0.f;
  f32x4 O[4][2];
#pragma unroll
  for (int dt = 0; dt < 4; ++dt)
#pragma unroll
    for (int qt = 0; qt < 2; ++qt) O[dt][qt] = (f32x4){0.f, 0.f, 0.f, 0.f};

  u32x4 pk[4], pv[4];
#define ATT_LOAD(KB)                                                                                  \
  {                                                                                                   \
    const u16* Ksrc; const u16* Vsrc; int vstride;                                                    \
    if ((KB) < 3) {                                                                                   \
      const int nbk = n + (KB) - 1;                                                                   \
      Ksrc = (const u16*)(p.ws + OFF_K) + ((size_t)(b * 2 + g) * 4096 + nbk * 128) * 64;              \
      Vsrc = (const u16*)(p.ws + OFF_VT) + (size_t)(b * 2 + g) * 64 * 4096 + nbk * 128;               \
      vstride = 4096;                                                                                 \
    } else {                                                                                          \
      const int cb = (KB) - 3;                                                                        \
      Ksrc = (const u16*)(p.ws + OFF_KC) + ((size_t)(b * 2 + g) * 256 + cb * 128) * 64;               \
      Vsrc = (const u16*)(p.ws + OFF_VCT) + (size_t)(b * 2 + g) * 64 * 256 + cb * 128;                \
      vstride = 256;                                                                                  \
    }                                                                                                 \
    _Pragma("unroll") for (int i = 0; i < 4; ++i) {                                                   \
      const int id = tid + i * 256;                                                                   \
      pk[i] = *(const u32x4*)(Ksrc + (id >> 3) * 64 + (id & 7) * 8);                                  \
      pv[i] = *(const u32x4*)(Vsrc + (size_t)(id >> 4) * vstride + (id & 15) * 8);                    \
    }                                                                                                 \
  }
  int kb = (n == 0) ? 1 : 0;
  ATT_LOAD(kb)
  while (kb < 5) {
#pragma unroll
    for (int i = 0; i < 4; ++i) {
      const int id = tid + i * 256;
      *(u32x4*)(sK + (id >> 3) * 72 + (id & 7) * 8) = pk[i];
      *(u32x4*)(sVt + (id >> 4) * 136 + (id & 15) * 8) = pv[i];
    }
    __syncthreads();
    int nx = kb + 1;
    if (nx == 2 && n == 31) nx = 3;
    if (nx < 5) ATT_LOAD(nx)
#pragma unroll 1
    for (int c4 = 0; c4 < 4; ++c4) {
      f32x4 s[2][2];
#pragma unroll
      for (int kt = 0; kt < 2; ++kt) {
        bf16x8 ak0 = *(const bf16x8*)(sK + (c4 * 32 + kt * 16 + l15) * 72 + quad * 8);
        bf16x8 ak1 = *(const bf16x8*)(sK + (c4 * 32 + kt * 16 + l15) * 72 + 32 + quad * 8);
#pragma unroll
        for (int qt = 0; qt < 2; ++qt) {
          f32x4 z = (f32x4){0.f, 0.f, 0.f, 0.f};
          z = __builtin_amdgcn_mfma_f32_16x16x32_bf16(ak0, bq[qt][0], z, 0, 0, 0);
          z = __builtin_amdgcn_mfma_f32_16x16x32_bf16(ak1, bq[qt][1], z, 0, 0, 0);
          s[kt][qt] = z;
        }
      }
      if (kb == 0 || kb == 2) {
#pragma unroll
        for (int kt = 0; kt < 2; ++kt)
#pragma unroll
          for (int qt = 0; qt < 2; ++qt)
#pragma unroll
            for (int r = 0; r < 4; ++r) {
              const int kk = c4 * 32 + kt * 16 + quad * 4 + r;
              const int qq = wave * 32 + qt * 16 + l15;
              const bool valid = (kb == 0) ? (kk >= qq) : (kk <= qq);
              if (!valid) s[kt][qt][r] = -INFINITY;
            }
      }
      bf16x8 bp[2];
#pragma unroll
      for (int qt = 0; qt < 2; ++qt) {
        float cm = fmaxf(fmaxf(fmaxf(s[0][qt][0], s[0][qt][1]), fmaxf(s[0][qt][2], s[0][qt][3])),
                         fmaxf(fmaxf(s[1][qt][0], s[1][qt][1]), fmaxf(s[1][qt][2], s[1][qt][3])));
        cm = fmaxf(cm, __shfl_xor(cm, 16));
        cm = fmaxf(cm, __shfl_xor(cm, 32));
        const float mnew = fmaxf(mrun[qt], cm);
        const float alpha = __expf(mrun[qt] - mnew);
        mrun[qt] = mnew;
        float ps = 0.f;
        float pv[8];
#pragma unroll
        for (int r = 0; r < 4; ++r) {
          pv[r] = __expf(s[0][qt][r] - mnew);
          pv[4 + r] = __expf(s[1][qt][r] - mnew);
          ps += pv[r] + pv[4 + r];
        }
        lrun[qt] = lrun[qt] * alpha + ps;
#pragma unroll
        for (int dt = 0; dt < 4; ++dt) {
          O[dt][qt][0] *= alpha; O[dt][qt][1] *= alpha; O[dt][qt][2] *= alpha; O[dt][qt][3] *= alpha;
        }
        union { bf16x8 v; unsigned u[4]; } pk;
        pk.u[0] = pack2(pv[0], pv[1]); pk.u[1] = pack2(pv[2], pv[3]);
        pk.u[2] = pack2(pv[4], pv[5]); pk.u[3] = pack2(pv[6], pv[7]);
        bp[qt] = pk.v;
      }
#pragma unroll
      for (int dt = 0; dt < 4; ++dt) {
        union { bf16x8 v; uint2 h[2]; } av;
        const u16* vrow = sVt + (dt * 16 + l15) * 136 + c4 * 32 + quad * 4;
        av.h[0] = *(const uint2*)(vrow);
        av.h[1] = *(const uint2*)(vrow + 16);
#pragma unroll
        for (int qt = 0; qt < 2; ++qt) O[dt][qt] = __builtin_amdgcn_mfma_f32_16x16x32_bf16(av.v, bp[qt], O[dt][qt], 0, 0, 0);
      }
    }
    __syncthreads();
    kb = nx;
  }
  u16* Y = (u16*)(p.ws + OFF_YATT);
#pragma unroll
  for (int qt = 0; qt < 2; ++qt) {
    float l = lrun[qt];
    l += __shfl_xor(l, 16);
    l += __shfl_xor(l, 32);
    const float inv = 1.f / l;
    const int t = b * 4096 + n * 128 + wave * 32 + qt * 16 + l15;
#pragma unroll
    for (int dt = 0; dt < 4; ++dt) {
      f32x4 o = O[dt][qt];
      *(uint2*)(Y + (size_t)t * 512 + h * 64 + dt * 16 + quad * 4) = make_uint2(pack2(o[0] * inv, o[1] * inv), pack2(o[2] * inv, o[3] * inv));
    }
  }
}

DEV void p3_hypre(const Params& p, int item, u16* sm) {
  const int tid = threadIdx.x;
  const int cb = item & 7, tb = (item >> 3) & 63, b = item >> 9;
  const int tq = tid >> 6, ch = tid & 63;
  const int c = cb * 64 + ch;
  u16* su = sm;
  u16* sx = sm + 64 * 66;
  float w[3][3], bias[3];
#pragma unroll
  for (int s = 0; s < 3; ++s) {
#pragma unroll
    for (int k = 0; k < 3; ++k) w[s][k] = p.hy_conv_w[k * 1536 + s * 512 + c];
    bias[s] = p.hy_conv_b[s * 512 + c];
  }
  const u16* Z = (const u16*)(p.ws + OFF_Z) + (size_t)b * 4096 * 1536;
  const int l0 = tb * 64 + tq * 16;
  float zv[18][3];
#pragma unroll
  for (int i = 0; i < 18; ++i) {
    const int l = l0 - 1 + i;
    const bool ok = (l >= 0) && (l < 4096);
    const int lc = ok ? l : l0;
#pragma unroll
    for (int s2 = 0; s2 < 3; ++s2) {
      const float v = bf2f(Z[(size_t)lc * 1536 + s2 * 512 + c]);
      zv[i][s2] = ok ? v : 0.f;
    }
  }
#pragma unroll
  for (int i = 0; i < 16; ++i) {
    float cv[3];
#pragma unroll
    for (int s2 = 0; s2 < 3; ++s2) cv[s2] = zv[i][s2] * w[s2][0] + zv[i + 1][s2] * w[s2][1] + zv[i + 2][s2] * w[s2][2] + bias[s2];
    su[ch * 66 + tq * 16 + i] = f2bf(cv[2] * cv[1]);
    sx[ch * 66 + tq * 16 + i] = f2bf(cv[0]);
  }
  __syncthreads();
  const int chr = tid >> 2, part = tid & 3;
  const int cc = cb * 64 + chr;
  const unsigned* ru = (const unsigned*)(su + chr * 66 + part * 16);
  const unsigned* rx = (const unsigned*)(sx + chr * 66 + part * 16);
  u16* UT = (u16*)((char*)p.out + OO_UT) + ((size_t)(cc * 4 + b) * 4096 + tb * 64 + part * 16);
  u16* XT = (u16*)((char*)p.out + OO_X0T) + ((size_t)(cc * 4 + b) * 4096 + tb * 64 + part * 16);
  ((uint4*)UT)[0] = make_uint4(ru[0], ru[1], ru[2], ru[3]);
  ((uint4*)UT)[1] = make_uint4(ru[4], ru[5], ru[6], ru[7]);
  ((uint4*)XT)[0] = make_uint4(rx[0], rx[1], rx[2], rx[3]);
  ((uint4*)XT)[1] = make_uint4(rx[4], rx[5], rx[6], rx[7]);
  __syncthreads();
}

DEV void p3_toeplitz(const Params& p, int c, char* smem) {
  const int tid = threadIdx.x, lane = tid & 63, wave = tid >> 6, l15 = lane & 15, quad = lane >> 4;
  u16* sG0 = (u16*)smem;
  u16* sG1 = (u16*)(smem + 16384 + 64);
  u16* sU = (u16*)(smem + 32768 + 128);
  u16* sZ = sU + 4 * 64 * 72;
  const u16* G = (const u16*)((const char*)p.out + OO_G) + (size_t)c * 8192;
  const u16* UT = (const u16*)((const char*)p.out + OO_UT) + (size_t)c * 16384;
#pragma unroll
  for (int i = 0; i < 4; ++i) {
    const int id = tid + i * 256;
    *(uint4*)(sG0 + id * 8) = *(const uint4*)(G + id * 8);
  }
#pragma unroll
  for (int i = 0; i < 8; ++i) {
    const int id = tid + i * 256;
    const int bb = id >> 9, blk = (id >> 3) & 63, c8 = id & 7;
    *(uint4*)(sU + (bb * 64 + blk) * 72 + c8 * 8) = *(const uint4*)(UT + id * 8);
  }
  if (tid < 72) sZ[tid] = 0;
  __syncthreads();
  for (int i = tid; i < 8192; i += 256) sG1[i] = (i < 8191) ? sG0[i + 1] : (u16)0;
  __syncthreads();

  Acc acc; acc_zero(acc);
  const u16* gbase = (l15 & 1) ? sG0 : (sG1 - 1);
  const u16* ubase = sU + wave * 64 * 72 + quad * 8;
  const u16* zbase = sZ + quad * 8;
  for (int d = -63; d <= 63; ++d) {
    const int base = 4095 - 64 * d - l15 + quad * 8;
    bf16x8 af[4][2];
#pragma unroll
    for (int mt = 0; mt < 4; ++mt)
#pragma unroll
      for (int ks = 0; ks < 2; ++ks) {
        const unsigned* gp = (const unsigned*)(gbase + base - mt * 16 + ks * 32);
        union { bf16x8 v; unsigned u[4]; } t;
        t.u[0] = gp[0]; t.u[1] = gp[1]; t.u[2] = gp[2]; t.u[3] = gp[3];
        af[mt][ks] = t.v;
      }
#pragma unroll
    for (int nt = 0; nt < 4; ++nt) {
      if (nt * 16 + 15 - d < 0 || nt * 16 - d > 63) continue;
      const int ip = nt * 16 + l15 - d;
      const u16* up = (ip >= 0 && ip < 64) ? (ubase + ip * 72) : zbase;
      bf16x8 b0 = *(const bf16x8*)(up);
      bf16x8 b1 = *(const bf16x8*)(up + 32);
#pragma unroll
      for (int mt = 0; mt < 4; ++mt) {
        acc.v[mt][nt] = __builtin_amdgcn_mfma_f32_16x16x32_bf16(af[mt][0], b0, acc.v[mt][nt], 0, 0, 0);
        acc.v[mt][nt] = __builtin_amdgcn_mfma_f32_16x16x32_bf16(af[mt][1], b1, acc.v[mt][nt], 0, 0, 0);
      }
    }
  }
  const float ninv = 1.f / ((const float*)(p.ws + OFF_BAR + 20480))[c];
  const float skip = p.hy_skip[c];
  const u16* XT = (const u16*)((const char*)p.out + OO_X0T) + ((size_t)(c * 4 + wave) * 4096);
  u16* Y = (u16*)(p.ws + OFF_YHY);
#pragma unroll
  for (int nt = 0; nt < 4; ++nt) {
    const int ib = nt * 16 + l15;
#pragma unroll
    for (int mt = 0; mt < 4; ++mt) {
      const int r0 = mt * 16 + quad * 4;
      const int t = ib * 64 + r0;
      uint2 uu = *(const uint2*)(sU + (wave * 64 + ib) * 72 + r0);
      uint2 xx = *(const uint2*)(XT + t);
      float uv[4] = {bflo(uu.x), bfhi(uu.x), bflo(uu.y), bfhi(uu.y)};
      float xv[4] = {bflo(xx.x), bfhi(xx.x), bflo(xx.y), bfhi(xx.y)};
#pragma unroll
      for (int r = 0; r < 4; ++r) {
        float y = acc.v[mt][nt][r] * ninv + uv[r] * skip;
        Y[(size_t)(wave * 4096 + t + r) * 512 + c] = f2bf(y * xv[r]);
      }
    }
  }
  __syncthreads();
}

DEV void p4_merge(const Params& p, int tile, u16* sA, u16* sB) {
  const int mt = tile >> 3, nt = tile & 7;
  const int m0 = mt * 128, n0 = nt * 128;
  const int tid = threadIdx.x, lane = tid & 63, wave = tid >> 6, wm = wave >> 1, wn = wave & 1;
  const int l15 = lane & 15, quad = lane >> 4;
  const int mb = m0 + wm * 64, nb = n0 + wn * 64;
  const u16* gt = (const u16*)(p.ws + OFF_GATE);
  u16* mg = (u16*)(p.ws + OFF_MERGED);
  Acc a1; acc_zero(a1);
  gemm_kloop((const u16*)(p.ws + OFF_YATT), 512, (const u16*)(p.ws + OFF_WOA), 512, 512, m0, n0, sA, sB, a1);
  asm volatile("" ::: "memory");
#pragma unroll
  for (int j = 0; j < 4; ++j) {
    const int m = mb + j * 16 + l15;
#pragma unroll
    for (int i = 0; i < 4; ++i) {
      const int n = nb + i * 16 + quad * 4;
      uint2 ga = *(const uint2*)(gt + (size_t)m * 2048 + n);
      f32x4 x = a1.v[i][j];
      *(uint2*)(mg + (size_t)m * 1024 + n) = make_uint2(pack2(bflo(ga.x) * x[0], bfhi(ga.x) * x[1]), pack2(bflo(ga.y) * x[2], bfhi(ga.y) * x[3]));
    }
  }
  asm volatile("" ::: "memory");
  acc_zero(a1);
  gemm_kloop((const u16*)(p.ws + OFF_YHY), 512, (const u16*)(p.ws + OFF_WOH), 512, 512, m0, n0, sA, sB, a1);
  asm volatile("" ::: "memory");
#pragma unroll
  for (int j = 0; j < 4; ++j) {
    const int m = mb + j * 16 + l15;
#pragma unroll
    for (int i = 0; i < 4; ++i) {
      const int n = nb + i * 16 + quad * 4;
      uint2 gh = *(const uint2*)(gt + (size_t)m * 2048 + 1024 + n);
      uint2 pv = *(const uint2*)(mg + (size_t)m * 1024 + n);
      f32x4 y = a1.v[i][j];
      float o0 = bflo(pv.x) + bflo(gh.x) * y[0];
      float o1 = bfhi(pv.x) + bfhi(gh.x) * y[1];
      float o2 = bflo(pv.y) + bflo(gh.y) * y[2];
      float o3 = bfhi(pv.y) + bfhi(gh.y) * y[3];
      *(uint2*)(mg + (size_t)m * 1024 + n) = make_uint2(pack2(o0, o1), pack2(o2, o3));
    }
  }
}

DEV void p5_out(const Params& p, int tile, u16* sA, u16* sB) {
  const int mt = tile >> 3, nt = tile & 7;
  const int m0 = mt * 128, n0 = nt * 128;
  Acc acc; acc_zero(acc);
  gemm_kloop((const u16*)(p.ws + OFF_MERGED), 1024, (const u16*)(p.ws + OFF_WOUT), 1024, 1024, m0, n0, sA, sB, acc);
  const int tid = threadIdx.x, lane = tid & 63, wave = tid >> 6, wm = wave >> 1, wn = wave & 1;
  const int l15 = lane & 15, quad = lane >> 4;
  const int mb = m0 + wm * 64, nb = n0 + wn * 64;
  const float* mod = (const float*)(p.ws + OFF_MOD);
#pragma unroll
  for (int j = 0; j < 4; ++j) {
    const int m = mb + j * 16 + l15;
    const int b = m >> 12;
#pragma unroll
    for (int i = 0; i < 4; ++i) {
      const int n = nb + i * 16 + quad * 4;
      float4 g1 = *(const float4*)(mod + b * 6144 + 2048 + n);
      float4 xv = *(const float4*)(p.x + (size_t)m * 1024 + n);
      f32x4 a = acc.v[i][j];
      float4 o = make_float4(xv.x + g1.x * a[0], xv.y + g1.y * a[1], xv.z + g1.z * a[2], xv.w + g1.w * a[3]);
      *(float4*)(p.out + (size_t)m * 1024 + n) = o;
    }
  }
}

DEV void p7_qp(const Params& p, int tile, u16* sA, u16* sB) {
  const int mt = tile >> 3, nt = tile & 7;
  const int m0 = mt * 128, n0 = nt * 128;
  Acc acc; acc_zero(acc);
  gemm_kloop((const u16*)(p.ws + OFF_H2), 1024, (const u16*)(p.ws + OFF_WQ), 1024, 1024, m0, n0, sA, sB, acc);
  const int tid = threadIdx.x, lane = tid & 63, wave = tid >> 6, wm = wave >> 1, wn = wave & 1;
  const int l15 = lane & 15, quad = lane >> 4;
  const int mb = m0 + wm * 64, nb = n0 + wn * 64;
  u16* qp = (u16*)(p.ws + OFF_QP);
#pragma unroll
  for (int j = 0; j < 4; ++j) {
    const int m = mb + j * 16 + l15;
#pragma unroll
    for (int i = 0; i < 4; ++i) {
      const int n = nb + i * 16 + quad * 4;
      f32x4 a = acc.v[i][j];
      *(uint2*)(qp + (size_t)m * 1024 + n) = make_uint2(pack2(a[0], a[1]), pack2(a[2], a[3]));
    }
  }
}

DEV unsigned f2ord(float f) {
  const unsigned u = __float_as_uint(f);
  return u ^ (((int)u >> 31) | 0x80000000u);
}
DEV float ord2f(unsigned k) {
  const unsigned m = (k & 0x80000000u) ? 0x80000000u : 0xffffffffu;
  return __uint_as_float(k ^ m);
}
DEV unsigned umax_(unsigned a, unsigned b) { return a > b ? a : b; }
DEV unsigned umin_(unsigned a, unsigned b) { return a < b ? a : b; }

DEV void sort16_desc(unsigned (&v)[16]) {
#pragma unroll
  for (int k = 2; k <= 16; k <<= 1)
#pragma unroll
    for (int j = k >> 1; j > 0; j >>= 1)
#pragma unroll
      for (int i = 0; i < 16; ++i) {
        const int l = i ^ j;
        if (l > i) {
          const bool desc = ((i & k) == 0);
          const unsigned a = v[i], b = v[l];
          const unsigned hi = umax_(a, b), lo = umin_(a, b);
          v[i] = desc ? hi : lo;
          v[l] = desc ? lo : hi;
        }
      }
}
DEV void merge16_desc(unsigned (&v)[16]) {
#pragma unroll
  for (int j = 8; j > 0; j >>= 1)
#pragma unroll
    for (int i = 0; i < 16; ++i) {
      const int l = i ^ j;
      if (l > i) {
        const unsigned a = v[i], b = v[l];
        v[i] = umax_(a, b);
        v[l] = umin_(a, b);
      }
    }
}
DEV void xmerge16(unsigned (&v)[16], int off) {
  unsigned pr[16];
#pragma unroll
  for (int i = 0; i < 16; ++i) pr[i] = (unsigned)__shfl_xor((int)v[i], off);
#pragma unroll
  for (int i = 0; i < 16; ++i) v[i] = umax_(v[i], pr[15 - i]);
  merge16_desc(v);
}

DEV void route_top16_of_128(const u16* __restrict__ keys, const u16* __restrict__ qp, int l15, int quad, unsigned (&out)[16]) {
  bf16x8 b0 = *(const bf16x8*)(qp);
  bf16x8 b1 = *(const bf16x8*)(qp + 32);
  unsigned ka[16], kb[16];
#pragma unroll
  for (int kt = 0; kt < 8; ++kt) {
    bf16x8 a0 = *(const bf16x8*)(keys + (kt * 16 + l15) * 64 + quad * 8);
    bf16x8 a1 = *(const bf16x8*)(keys + (kt * 16 + l15) * 64 + 32 + quad * 8);
    f32x4 z = (f32x4){0.f, 0.f, 0.f, 0.f};
    z = __builtin_amdgcn_mfma_f32_16x16x32_bf16(a0, b0, z, 0, 0, 0);
    z = __builtin_amdgcn_mfma_f32_16x16x32_bf16(a1, b1, z, 0, 0, 0);
#pragma unroll
    for (int r = 0; r < 4; ++r) {
      const unsigned key = (f2ord(z[r]) & ~127u) | (unsigned)(kt * 16 + quad * 4 + r);
      if (kt < 4) ka[kt * 4 + r] = key; else kb[(kt - 4) * 4 + r] = key;
    }
  }
  sort16_desc(ka);
  sort16_desc(kb);
#pragma unroll
  for (int i = 0; i < 16; ++i) out[i] = umax_(ka[i], kb[15 - i]);
  merge16_desc(out);
  xmerge16(out, 16);
  xmerge16(out, 32);
}

DEV void p8_route(const Params& p, int task, char* wsm) {
  static constexpr unsigned char kTab[52] = {
      0x00, 0x01, 0x02, 0x03, 0x04, 0x05, 0x06, 0x07, 0x08, 0x09, 0x0A, 0x0B, 0x0C, 0x0D, 0x0E, 0x0F,
      0x10, 0x11, 0x12, 0x13, 0x14, 0x15, 0x16, 0x17, 0x20, 0x21, 0x22, 0x23, 0x24, 0x30, 0x31, 0x32, 0x33,
      0x40, 0x41, 0x42, 0x50, 0x51, 0x60, 0x61, 0x70, 0x71, 0x80, 0x90, 0xA0, 0xB0, 0xC0, 0xD0, 0xE0, 0xF0, 0x00, 0x00};
  const int lane = threadIdx.x & 63, l15 = lane & 15, quad = lane >> 4;
  const int h = task & 7, tt = task >> 3;
  const int t0 = tt * 16;
  float* s1v = (float*)wsm;
  float* s2v = s1v + 256;
  int* i1 = (int*)(s2v + 256);
  int* i2 = i1 + 256;
  const u16* keys = (const u16*)(p.ws + OFF_KEYS) + (size_t)(h * 2) * 128 * 64;
  const u16* qp = (const u16*)(p.ws + OFF_QP) + (size_t)(t0 + l15) * 1024 + h * 128 + quad * 8;
  unsigned l1[16], l2[16];
  route_top16_of_128(keys, qp, l15, quad, l1);
  route_top16_of_128(keys + 128 * 64, qp + 64, l15, quad, l2);
  if (quad == 0) {
#pragma unroll
    for (int i = 0; i < 16; ++i) { s1v[l15 * 16 + i] = ord2f(l1[i] & ~127u); i1[l15 * 16 + i] = (int)(l1[i] & 127u); }
  } else if (quad == 1) {
#pragma unroll
    for (int i = 0; i < 16; ++i) { s2v[l15 * 16 + i] = ord2f(l2[i] & ~127u); i2[l15 * 16 + i] = (int)(l2[i] & 127u); }
  }
  __builtin_amdgcn_fence(__ATOMIC_RELEASE, "wavefront");
  __builtin_amdgcn_wave_barrier();
  __builtin_amdgcn_fence(__ATOMIC_ACQUIRE, "wavefront");
  unsigned ck[16];
#pragma unroll
  for (int s = 0; s < 16; ++s) {
    const int c = quad + 4 * s;
    unsigned key = 0u;
    if (s < 13 && c < 50) {
      const unsigned ab = kTab[c];
      const float val = s1v[l15 * 16 + (ab >> 4)] + s2v[l15 * 16 + (ab & 15)];
      key = (f2ord(val) & ~255u) | ab;
    }
    ck[s] = key;
  }
  sort16_desc(ck);
  xmerge16(ck, 16);
  xmerge16(ck, 32);
  if (quad == 0) {
    float e[16];
    const float vmax = ord2f(ck[0] & ~255u);
    float ssum = 0.f;
#pragma unroll
    for (int i = 0; i < 16; ++i) { e[i] = __expf(ord2f(ck[i] & ~255u) - vmax); ssum += e[i]; }
    const float inv = 1.f / ssum;
    int* ridx = (int*)(p.ws + OFF_RIDX) + (size_t)(t0 + l15) * 128 + h * 16;
    float* rw = (float*)(p.ws + OFF_RW) + (size_t)(t0 + l15) * 128 + h * 16;
#pragma unroll
    for (int i = 0; i < 16; i += 4) {
      int ee[4]; float ww[4];
#pragma unroll
      for (int j = 0; j < 4; ++j) {
        const unsigned ab = ck[i + j] & 255u;
        ee[j] = i1[l15 * 16 + (ab >> 4)] * 128 + i2[l15 * 16 + (ab & 15)];
        ww[j] = e[i + j] * inv;
      }
      *(int4*)(ridx + i) = make_int4(ee[0], ee[1], ee[2], ee[3]);
      *(float4*)(rw + i) = make_float4(ww[0], ww[1], ww[2], ww[3]);
    }
  }
  __builtin_amdgcn_fence(__ATOMIC_RELEASE, "wavefront");
  __builtin_amdgcn_wave_barrier();
}

DEV float gelu_tanh(float x) {
  const float u2 = 1.5957691216057308f * (x + 0.044715f * x * x * x);
  return x * __frcp_rn(1.f + __expf(-u2));
}

DEV void unpack8(const uint4& q, float* f) {
  f[0] = bflo(q.x); f[1] = bfhi(q.x); f[2] = bflo(q.y); f[3] = bfhi(q.y);
  f[4] = bflo(q.z); f[5] = bfhi(q.z); f[6] = bflo(q.w); f[7] = bfhi(q.w);
}

DEV float dpp_add(float v, const int ctrl_sel) {
  return v;
}
typedef __attribute__((ext_vector_type(2))) __bf16 bf2_t;
DEV float dot2bf(unsigned a, unsigned b, float c) {
  return __builtin_amdgcn_fdot2_f32_bf16(__builtin_bit_cast(bf2_t, a), __builtin_bit_cast(bf2_t, b), c, false);
}

DEV float reduce4_rows(float d0, float d1, float d2, float d3, int lane) {
  const bool up32 = (lane & 32) != 0, up16 = (lane & 16) != 0;
  float k0 = up32 ? d2 : d0, k1 = up32 ? d3 : d1;
  const float s0 = up32 ? d0 : d2, s1 = up32 ? d1 : d3;
  k0 += __shfl_xor(s0, 32);
  k1 += __shfl_xor(s1, 32);
  float kq = up16 ? k1 : k0;
  const float sq = up16 ? k0 : k1;
  kq += __shfl_xor(sq, 16);
  kq = DPP_ADD(kq, 0xB1);
  kq = DPP_ADD(kq, 0x4E);
  kq = DPP_ADD(kq, 0x141);
  kq = DPP_ADD(kq, 0x140);
  return kq;
}

DEV void p9_token(const Params& p, int t, int tnext, int lane, int2& e2n, float2& w2n, u32x4& han, u32x4& hbn) {
  const unsigned char* U8 = (const unsigned char*)(p.ws + OFF_UBF);
  const unsigned char* V8 = (const unsigned char*)(p.ws + OFF_VBF);
  const int2 e2 = e2n;
  const float2 w2 = w2n;
  const u32x4 ha = han, hb = hbn;
  {
    e2n = *(const int2*)((const int*)(p.ws + OFF_RIDX) + (size_t)tnext * 128 + 2 * lane);
    w2n = *(const float2*)((const float*)(p.ws + OFF_RW) + (size_t)tnext * 128 + 2 * lane);
    const u16* h2 = (const u16*)(p.ws + OFF_H2) + (size_t)tnext * 1024 + 16 * lane;
    han = *(const u32x4*)(h2);
    hbn = *(const u32x4*)(h2 + 8);
  }
  float hf[16];
  hf[0] = bflo(ha.x); hf[1] = bfhi(ha.x); hf[2] = bflo(ha.y); hf[3] = bfhi(ha.y);
  hf[4] = bflo(ha.z); hf[5] = bfhi(ha.z); hf[6] = bflo(ha.w); hf[7] = bfhi(ha.w);
  hf[8] = bflo(hb.x); hf[9] = bfhi(hb.x); hf[10] = bflo(hb.y); hf[11] = bfhi(hb.y);
  hf[12] = bflo(hb.z); hf[13] = bfhi(hb.z); hf[14] = bflo(hb.w); hf[15] = bfhi(hb.w);
  float o[16];
#pragma unroll
  for (int k = 0; k < 16; ++k) o[k] = 0.f;
#pragma unroll 1
  for (int g = 0; g < 128; g += 16) {
    u32x4 uu[16], vv[16];
    float wj[16];
#pragma unroll
    for (int j = 0; j < 16; ++j) {
      const int src = (g >> 1) + (j >> 1);
      const int ej = (j & 1) ? __builtin_amdgcn_readlane(e2.y, src) : __builtin_amdgcn_readlane(e2.x, src);
      wj[j] = __builtin_bit_cast(float, (j & 1) ? __builtin_amdgcn_readlane(__builtin_bit_cast(int, w2.y), src)
                                                : __builtin_amdgcn_readlane(__builtin_bit_cast(int, w2.x), src));
      const size_t ro = (size_t)ej * 1024 + 16 * lane;
      uu[j] = *(const u32x4*)(U8 + ro);
      vv[j] = *(const u32x4*)(V8 + ro);
    }
    float d[16];
#pragma unroll
    for (int j = 0; j < 16; ++j) {
      const f32x2 l0 = __builtin_amdgcn_cvt_pk_f32_fp8((int)uu[j].x, false), h0 = __builtin_amdgcn_cvt_pk_f32_fp8((int)uu[j].x, true);
      const f32x2 l1 = __builtin_amdgcn_cvt_pk_f32_fp8((int)uu[j].y, false), h1 = __builtin_amdgcn_cvt_pk_f32_fp8((int)uu[j].y, true);
      const f32x2 l2 = __builtin_amdgcn_cvt_pk_f32_fp8((int)uu[j].z, false), h2v = __builtin_amdgcn_cvt_pk_f32_fp8((int)uu[j].z, true);
      const f32x2 l3 = __builtin_amdgcn_cvt_pk_f32_fp8((int)uu[j].w, false), h3 = __builtin_amdgcn_cvt_pk_f32_fp8((int)uu[j].w, true);
      float a0 = l0.x * hf[0] + l0.y * hf[1], a1 = h0.x * hf[2] + h0.y * hf[3];
      a0 += l1.x * hf[4] + l1.y * hf[5]; a1 += h1.x * hf[6] + h1.y * hf[7];
      a0 += l2.x * hf[8] + l2.y * hf[9]; a1 += h2v.x * hf[10] + h2v.y * hf[11];
      a0 += l3.x * hf[12] + l3.y * hf[13]; a1 += h3.x * hf[14] + h3.y * hf[15];
      d[j] = a0 + a1;
    }
#pragma unroll
    for (int q = 0; q < 4; ++q) {
      const float dot = reduce4_rows(d[4 * q], d[4 * q + 1], d[4 * q + 2], d[4 * q + 3], lane);
      const float gl = gelu_tanh(dot * (1.f / 512.f)) * (1.f / 64.f);
#pragma unroll
      for (int i = 0; i < 4; ++i) {
        const int j = 4 * q + i;
        const float ci = wj[j] * __builtin_bit_cast(float, __builtin_amdgcn_readlane(__builtin_bit_cast(int, gl), 16 * i));
        f32x2 tq;
        tq = __builtin_amdgcn_cvt_pk_f32_fp8((int)vv[j].x, false); o[0] += ci * tq.x; o[1] += ci * tq.y;
        tq = __builtin_amdgcn_cvt_pk_f32_fp8((int)vv[j].x, true);  o[2] += ci * tq.x; o[3] += ci * tq.y;
        tq = __builtin_amdgcn_cvt_pk_f32_fp8((int)vv[j].y, false); o[4] += ci * tq.x; o[5] += ci * tq.y;
        tq = __builtin_amdgcn_cvt_pk_f32_fp8((int)vv[j].y, true);  o[6] += ci * tq.x; o[7] += ci * tq.y;
        tq = __builtin_amdgcn_cvt_pk_f32_fp8((int)vv[j].z, false); o[8] += ci * tq.x; o[9] += ci * tq.y;
        tq = __builtin_amdgcn_cvt_pk_f32_fp8((int)vv[j].z, true);  o[10] += ci * tq.x; o[11] += ci * tq.y;
        tq = __builtin_amdgcn_cvt_pk_f32_fp8((int)vv[j].w, false); o[12] += ci * tq.x; o[13] += ci * tq.y;
        tq = __builtin_amdgcn_cvt_pk_f32_fp8((int)vv[j].w, true);  o[14] += ci * tq.x; o[15] += ci * tq.y;
      }
    }
  }
  const int b = t >> 12;
  const float* mod = (const float*)(p.ws + OFF_MOD) + b * 6144 + 5120 + 16 * lane;
  float* xm = p.out + (size_t)t * 1024 + 16 * lane;
  float xo[16];
  float ss = 0.f;
#pragma unroll
  for (int q = 0; q < 4; ++q) {
    const float4 xv = *(const float4*)(xm + 4 * q);
    const float4 gv = *(const float4*)(mod + 4 * q);
    xo[4 * q + 0] = xv.x + gv.x * o[4 * q + 0];
    xo[4 * q + 1] = xv.y + gv.y * o[4 * q + 1];
    xo[4 * q + 2] = xv.z + gv.z * o[4 * q + 2];
    xo[4 * q + 3] = xv.w + gv.w * o[4 * q + 3];
  }
#pragma unroll
  for (int k = 0; k < 16; ++k) ss += xo[k] * xo[k];
  ss = wave_sum(ss);
  const float r = rsqrtf(ss * (1.f / 1024.f) + 1e-6f);
#pragma unroll
  for (int q = 0; q < 4; ++q) {
    const float4 fg = *(const float4*)(p.final_g + 16 * lane + 4 * q);
    *(float4*)(xm + 4 * q) = make_float4(xo[4 * q] * r * fg.x, xo[4 * q + 1] * r * fg.y, xo[4 * q + 2] * r * fg.z, xo[4 * q + 3] * r * fg.w);
  }
}

DEV void p9_experts4(const Params& p, int task, char* wsm) {
  const int lane = threadIdx.x & 63;
  const int t0 = task * 4;
  int* hist = (int*)wsm;
  unsigned* skey = (unsigned*)(wsm + 1024);
  float* swt = (float*)(wsm + 1024 + 2048);
  u16* sh2 = (u16*)(wsm + 1024 + 4096);
  hist[lane] = 0; hist[lane + 64] = 0; hist[lane + 128] = 0; hist[lane + 192] = 0;
  const int* ridx = (const int*)(p.ws + OFF_RIDX) + (size_t)t0 * 128 + lane * 8;
  const float* rw = (const float*)(p.ws + OFF_RW) + (size_t)t0 * 128 + lane * 8;
  int4 ea = *(const int4*)(ridx), eb = *(const int4*)(ridx + 4);
  float4 wa = *(const float4*)(rw), wb = *(const float4*)(rw + 4);
  int e[8] = {ea.x, ea.y, ea.z, ea.w, eb.x, eb.y, eb.z, eb.w};
  float w[8] = {wa.x, wa.y, wa.z, wa.w, wb.x, wb.y, wb.z, wb.w};
  {
    const u16* h2 = (const u16*)(p.ws + OFF_H2) + (size_t)t0 * 1024;
#pragma unroll
    for (int i = 0; i < 8; ++i) *(u32x4*)(sh2 + (lane + 64 * i) * 8) = *(const u32x4*)(h2 + (lane + 64 * i) * 8);
  }
  __builtin_amdgcn_fence(__ATOMIC_RELEASE, "wavefront");
  __builtin_amdgcn_wave_barrier();
  __builtin_amdgcn_fence(__ATOMIC_ACQUIRE, "wavefront");
  int rank[8];
#pragma unroll
  for (int j = 0; j < 8; ++j) rank[j] = atomicAdd(&hist[e[j] >> 6], 1);
  __builtin_amdgcn_fence(__ATOMIC_RELEASE, "wavefront");
  __builtin_amdgcn_wave_barrier();
  __builtin_amdgcn_fence(__ATOMIC_ACQUIRE, "wavefront");
  {
    const int c0 = hist[4 * lane], c1 = hist[4 * lane + 1], c2 = hist[4 * lane + 2], c3 = hist[4 * lane + 3];
    const int tot = c0 + c1 + c2 + c3;
    int x = tot;
#pragma unroll
    for (int o = 1; o < 64; o <<= 1) { const int y = __shfl_up(x, o); if (lane >= o) x += y; }
    const int base = x - tot;
    __builtin_amdgcn_fence(__ATOMIC_RELEASE, "wavefront");
    __builtin_amdgcn_wave_barrier();
    hist[4 * lane] = base; hist[4 * lane + 1] = base + c0; hist[4 * lane + 2] = base + c0 + c1; hist[4 * lane + 3] = base + c0 + c1 + c2;
  }
  __builtin_amdgcn_fence(__ATOMIC_RELEASE, "wavefront");
  __builtin_amdgcn_wave_barrier();
  __builtin_amdgcn_fence(__ATOMIC_ACQUIRE, "wavefront");
  {
    const unsigned slot = (unsigned)(lane >> 4);
#pragma unroll
    for (int j = 0; j < 8; ++j) {
      const int pos = hist[e[j] >> 6] + rank[j];
      skey[pos] = (unsigned)e[j] | (slot << 14);
      swt[pos] = w[j];
    }
  }
  __builtin_amdgcn_fence(__ATOMIC_RELEASE, "wavefront");
  __builtin_amdgcn_wave_barrier();
  __builtin_amdgcn_fence(__ATOMIC_ACQUIRE, "wavefront");

  float o0[16], o1[16], o2[16], o3[16];
#pragma unroll
  for (int k = 0; k < 16; ++k) { o0[k] = 0.f; o1[k] = 0.f; o2[k] = 0.f; o3[k] = 0.f; }
  const u16* U = (const u16*)(p.ws + OFF_UBF);
  const u16* V = (const u16*)(p.ws + OFF_VBF);
#define P9_LOAD(KK, UU, VV, BB)                                                           \
  _Pragma("unroll") for (int i = 0; i < 4; ++i) {                                         \
    KK[i] = (unsigned)__builtin_amdgcn_readfirstlane((int)skey[4 * (BB) + i]);            \
    const size_t ro = (size_t)(KK[i] & 16383u) * 1024 + 16 * lane;                        \
    UU[i] = *(const u32x4*)(U8 + ro);                                                     \
    VV[i] = *(const u32x4*)(V8 + ro);                                                     \
  }
#define P9_DOTS(KK, UU, BB, COEFV)                                                        \
  {                                                                                       \
    const float myw = swt[4 * (BB) + (lane >> 4)];                                        \
    float d[4];                                                                           \
    _Pragma("unroll") for (int i = 0; i < 4; ++i) {                                       \
      const unsigned slot = KK[i] >> 14;                                                  \
      const u32x4 ha = *(const u32x4*)(sh2 + slot * 1024 + 16 * lane);                    \
      const u32x4 hb = *(const u32x4*)(sh2 + slot * 1024 + 16 * lane + 8);                \
      float acc0 = 0.f, acc1 = 0.f;                                                       \
      {                                                                                   \
        f32x2 l0 = __builtin_amdgcn_cvt_pk_f32_fp8((int)UU[i].x, false), h0 = __builtin_amdgcn_cvt_pk_f32_fp8((int)UU[i].x, true); \
        f32x2 l1 = __builtin_amdgcn_cvt_pk_f32_fp8((int)UU[i].y, false), h1 = __builtin_amdgcn_cvt_pk_f32_fp8((int)UU[i].y, true); \
        f32x2 l2 = __builtin_amdgcn_cvt_pk_f32_fp8((int)UU[i].z, false), h2_ = __builtin_amdgcn_cvt_pk_f32_fp8((int)UU[i].z, true); \
        f32x2 l3 = __builtin_amdgcn_cvt_pk_f32_fp8((int)UU[i].w, false), h3 = __builtin_amdgcn_cvt_pk_f32_fp8((int)UU[i].w, true); \
        acc0 += l0.x * bflo(ha.x) + l0.y * bfhi(ha.x); acc1 += h0.x * bflo(ha.y) + h0.y * bfhi(ha.y);   \
        acc0 += l1.x * bflo(ha.z) + l1.y * bfhi(ha.z); acc1 += h1.x * bflo(ha.w) + h1.y * bfhi(ha.w);   \
        acc0 += l2.x * bflo(hb.x) + l2.y * bfhi(hb.x); acc1 += h2_.x * bflo(hb.y) + h2_.y * bfhi(hb.y); \
        acc0 += l3.x * bflo(hb.z) + l3.y * bfhi(hb.z); acc1 += h3.x * bflo(hb.w) + h3.y * bfhi(hb.w);   \
      }                                                                                   \
      d[i] = acc0 + acc1;                                                                 \
    }                                                                                     \
    const bool up32 = (lane & 32) != 0, up16 = (lane & 16) != 0;                          \
    float k0 = up32 ? d[2] : d[0], k1 = up32 ? d[3] : d[1];                               \
    float s0 = up32 ? d[0] : d[2], s1 = up32 ? d[1] : d[3];                               \
    k0 += __shfl_xor(s0, 32);                                                             \
    k1 += __shfl_xor(s1, 32);                                                             \
    float kq = up16 ? k1 : k0, sq = up16 ? k0 : k1;                                       \
    kq += __shfl_xor(sq, 16);                                                             \
    kq = DPP_ADD(kq, 0xB1);                                                               \
    kq = DPP_ADD(kq, 0x4E);                                                               \
    kq = DPP_ADD(kq, 0x141);                                                              \
    kq = DPP_ADD(kq, 0x140);                                                              \
    COEFV = myw * (1.f / 64.f) * gelu_tanh(kq * (1.f / 512.f));                           \
  }
#define P9_ACCUM(KK, VV, COEFV)                                                           \
  _Pragma("unroll") for (int i = 0; i < 4; ++i) {                                         \
    const float ci = __builtin_bit_cast(float, __builtin_amdgcn_readlane(__builtin_bit_cast(int, COEFV), 16 * i)); \
    const unsigned slot = KK[i] >> 14;                                                    \
    float vf[16];                                                                         \
    {                                                                                     \
      f32x2 t;                                                                            \
      t = __builtin_amdgcn_cvt_pk_f32_fp8((int)VV[i].x, false); vf[0] = t.x; vf[1] = t.y;   \
      t = __builtin_amdgcn_cvt_pk_f32_fp8((int)VV[i].x, true);  vf[2] = t.x; vf[3] = t.y;   \
      t = __builtin_amdgcn_cvt_pk_f32_fp8((int)VV[i].y, false); vf[4] = t.x; vf[5] = t.y;   \
      t = __builtin_amdgcn_cvt_pk_f32_fp8((int)VV[i].y, true);  vf[6] = t.x; vf[7] = t.y;   \
      t = __builtin_amdgcn_cvt_pk_f32_fp8((int)VV[i].z, false); vf[8] = t.x; vf[9] = t.y;   \
      t = __builtin_amdgcn_cvt_pk_f32_fp8((int)VV[i].z, true);  vf[10] = t.x; vf[11] = t.y; \
      t = __builtin_amdgcn_cvt_pk_f32_fp8((int)VV[i].w, false); vf[12] = t.x; vf[13] = t.y; \
      t = __builtin_amdgcn_cvt_pk_f32_fp8((int)VV[i].w, true);  vf[14] = t.x; vf[15] = t.y; \
    }                                                                                     \
    if (slot == 0) { _Pragma("unroll") for (int k = 0; k < 16; ++k) o0[k] += ci * vf[k]; }       \
    else if (slot == 1) { _Pragma("unroll") for (int k = 0; k < 16; ++k) o1[k] += ci * vf[k]; }  \
    else if (slot == 2) { _Pragma("unroll") for (int k = 0; k < 16; ++k) o2[k] += ci * vf[k]; }  \
    else { _Pragma("unroll") for (int k = 0; k < 16; ++k) o3[k] += ci * vf[k]; }                 \
  }
  {
    const unsigned char* U8 = (const unsigned char*)(p.ws + OFF_UBF);
    const unsigned char* V8 = (const unsigned char*)(p.ws + OFF_VBF);
    unsigned kkA[4], kkB[4];
    u32x4 uA[4], vA[4], uB[4], vB[4];
    float cfA, cfB;
    P9_LOAD(kkA, uA, vA, 0)
#pragma unroll 1
    for (int bb = 0; bb < 128; bb += 2) {
      P9_LOAD(kkB, uB, vB, bb + 1)
      P9_DOTS(kkA, uA, bb, cfA)
      P9_ACCUM(kkA, vA, cfA)
      const int n0 = (bb + 2 < 128) ? (bb + 2) : 0;
      P9_LOAD(kkA, uA, vA, n0)
      P9_DOTS(kkB, uB, bb + 1, cfB)
      P9_ACCUM(kkB, vB, cfB)
    }
  }
#pragma unroll
  for (int s = 0; s < 4; ++s) {
    const int t = t0 + s;
    const int b = t >> 12;
    const float* mod = (const float*)(p.ws + OFF_MOD) + b * 6144 + 5120 + 16 * lane;
    float* xm = p.out + (size_t)t * 1024 + 16 * lane;
    const float* oo = (s == 0) ? o0 : ((s == 1) ? o1 : ((s == 2) ? o2 : o3));
    float xo[16];
    float ss = 0.f;
#pragma unroll
    for (int q = 0; q < 4; ++q) {
      const float4 xv = *(const float4*)(xm + 4 * q);
      const float4 gv = *(const float4*)(mod + 4 * q);
      xo[4 * q + 0] = xv.x + gv.x * oo[4 * q + 0];
      xo[4 * q + 1] = xv.y + gv.y * oo[4 * q + 1];
      xo[4 * q + 2] = xv.z + gv.z * oo[4 * q + 2];
      xo[4 * q + 3] = xv.w + gv.w * oo[4 * q + 3];
    }
#pragma unroll
    for (int k = 0; k < 16; ++k) ss += xo[k] * xo[k];
    ss = wave_sum(ss);
    const float r = rsqrtf(ss * (1.f / 1024.f) + 1e-6f);
#pragma unroll
    for (int q = 0; q < 4; ++q) {
      const float4 fg = *(const float4*)(p.final_g + 16 * lane + 4 * q);
      *(float4*)(xm + 4 * q) = make_float4(xo[4 * q] * r * fg.x, xo[4 * q + 1] * r * fg.y, xo[4 * q + 2] * r * fg.z, xo[4 * q + 3] * r * fg.w);
    }
  }
  __builtin_amdgcn_fence(__ATOMIC_RELEASE, "wavefront");
  __builtin_amdgcn_wave_barrier();
}

#define XB_TMO      128
#define XB_XCNT(j)  (256  + 64 * (j))
#define XB_XSUB(j)  (1280 + 64 * (j))
#define XB_XGEN(j)  (2304 + 64 * (j))
#define XB_TOP      3328
#define XB_TOPGEN   3392
#define XCD_BAR_WORDS 3456
#define XB_SPIN_CAP (1u << 18)
#define LAS __attribute__((address_space(3)))

__device__ __forceinline__ unsigned xb_ld(unsigned* p)              { return __hip_atomic_load(p, __ATOMIC_RELAXED, __HIP_MEMORY_SCOPE_AGENT); }
__device__ __forceinline__ unsigned xb_add(unsigned* p, unsigned v) { return __hip_atomic_fetch_add(p, v, __ATOMIC_RELAXED, __HIP_MEMORY_SCOPE_AGENT); }
__device__ __forceinline__ unsigned xb_xcc_id() { return (unsigned)__builtin_amdgcn_s_getreg((3 << 11) | 20) & 0xFu; }
#define XB_SPIN(cond, bar) do { unsigned _sp = 0; while (cond) { __builtin_amdgcn_s_sleep(1); \
    if ((++_sp & 255u) == 0u) { if (xb_ld(&(bar)[XB_TMO])) break; if (_sp > XB_SPIN_CAP) { atomicAdd(&(bar)[XB_TMO], 1u); break; } } } } while (0)

struct XcdBarrier {
    unsigned* bar; unsigned x;
    volatile LAS unsigned* st;
};

__device__ __forceinline__ XcdBarrier xcd_barrier_post(unsigned* bar, volatile LAS unsigned* st) {
    XcdBarrier b; b.bar = bar; b.x = xb_xcc_id(); b.st = st;
    if (threadIdx.x == 0) (void)xb_add(&bar[XB_XCNT(b.x)], 1u);
    return b;
}
__device__ __forceinline__ void xcd_barrier_complete(unsigned* bar, unsigned x, unsigned& nloc, unsigned& nx) {
    const unsigned G = gridDim.x * gridDim.y * gridDim.z;
    unsigned sum, cnt, mine, sp = 0u;
    for (;;) {
        sum = 0u; cnt = 0u; mine = 0u;
#pragma unroll
        for (unsigned j = 0; j < 16; ++j) { const unsigned c = xb_ld(&bar[XB_XCNT(j)]); sum += c; cnt += (c > 0u) ? 1u : 0u; mine = (j == x) ? c : mine; }
        if (sum == G) break;
        __builtin_amdgcn_s_sleep(1);
        if ((++sp & 255u) == 0u) { if (xb_ld(&bar[XB_TMO])) break; if (sp > XB_SPIN_CAP) { atomicAdd(&bar[XB_TMO], 1u); break; } }
    }
    nloc = mine > 0u ? mine : 1u; nx = cnt > 0u ? cnt : 1u;
}

__device__ __forceinline__ void xcd_barrier(const XcdBarrier& b) {
    asm volatile("s_waitcnt vmcnt(0)" ::: "memory");
    __syncthreads();
    if (threadIdx.x == 0) {
        unsigned* bar = b.bar;
        __builtin_amdgcn_s_waitcnt(0);
        unsigned nloc = b.st[0], nx = b.st[1];
        if (nloc == 0u) { xcd_barrier_complete(bar, b.x, nloc, nx); b.st[0] = nloc; b.st[1] = nx; }
        const unsigned old = xb_add(&bar[XB_XSUB(b.x)], 1u);
        const unsigned gen = old / nloc;
        if (old + 1u == (gen + 1u) * nloc) {
            __builtin_amdgcn_fence(__ATOMIC_RELEASE, "agent");
            asm volatile("s_waitcnt vmcnt(0)" ::: "memory");
            const unsigned og = xb_add(&bar[XB_TOP], 1u);
            const unsigned tg = og / nx;
            if (og + 1u == (tg + 1u) * nx) xb_add(&bar[XB_TOPGEN], 1u);
            else XB_SPIN(xb_ld(&bar[XB_TOPGEN]) == tg, bar);
            __builtin_amdgcn_fence(__ATOMIC_ACQUIRE, "agent");
            xb_add(&bar[XB_XGEN(b.x)], 1u);
            asm volatile("s_waitcnt vmcnt(0)" ::: "memory");
        } else {
            XB_SPIN(xb_ld(&bar[XB_XGEN(b.x)]) == gen, bar);
            __builtin_amdgcn_fence(__ATOMIC_ACQUIRE, "agent");
            asm volatile("s_waitcnt vmcnt(0)" ::: "memory");
        }
    }
    __syncthreads();
}


__global__ void __launch_bounds__(256, 2) mega(Params p) {
  extern __shared__ __attribute__((aligned(16))) char smem[];
  cg::grid_group grid = cg::this_grid();
  const int tid = threadIdx.x, lane = tid & 63, wave = tid >> 6;
  const int nb = gridDim.x, bid = blockIdx.x;
  float* smf = (float*)smem;
  if (p.ws == nullptr) grid.sync();
  volatile LAS unsigned* xst = (volatile LAS unsigned*)(smem + SMEM_XB);
  if (tid == 0) { xst[0] = 0u; xst[1] = 0u; }
  __syncthreads();
  const XcdBarrier xb = xcd_barrier_post((unsigned*)(p.ws + OFF_BAR), xst);
  u16* sA = (u16*)smem;
  u16* sB = (u16*)(smem + 128 * 64 * 2);

  for (int rep_ = 0; rep_ < NREP(0); ++rep_) if (PHON(0)) {
    const int N_MOD = 384, N_TIN = 16 * 68, N_TOA = 8 * 16, N_TOH = 8 * 16, N_TOUT = 16 * 16, N_TQ = 16 * 16, N_HID = 1024;
    const int total = N_MOD + N_TIN + N_TOA + N_TOH + N_TOUT + N_TQ + N_HID + 16 + 1;
    for (int it = bid; it < total; it += nb) {
      int i = it;
      if (i < N_MOD) { p0_mod(p, i, smf); continue; }
      i -= N_MOD;
      if (i < N_TIN) { transpose_tile(p.w_in, INW, 1024, (u16*)(p.ws + OFF_WIN), i, smf); continue; }
      i -= N_TIN;
      if (i < N_TOA) { transpose_tile(p.w_o_attn, 1024, 512, (u16*)(p.ws + OFF_WOA), i, smf); continue; }
      i -= N_TOA;
      if (i < N_TOH) { transpose_tile(p.w_o_hy, 1024, 512, (u16*)(p.ws + OFF_WOH), i, smf); continue; }
      i -= N_TOH;
      if (i < N_TOUT) { transpose_tile(p.w_out, 1024, 1024, (u16*)(p.ws + OFF_WOUT), i, smf); continue; }
      i -= N_TOUT;
      if (i < N_TQ) { transpose_tile(p.peer_wq, 1024, 1024, (u16*)(p.ws + OFF_WQ), i, smf); continue; }
      i -= N_TQ;
      if (i < N_HID) { p0_hidden(p, i, smf); continue; }
      i -= N_HID;
      if (i < 16) { transpose_tile(p.hy_fw3, 1024, 64, (u16*)(p.ws + OFF_H2F + 512 * 1024), i, smf); continue; }
      float2* rope = (float2*)(p.ws + OFF_ROPE);
      for (int idx = tid; idx < 1024; idx += 256) {
        const int pos = idx >> 4, f = idx & 15;
        const float inv = powf(10000.f, -(float)f / 16.f);
        const float ang = (float)pos * inv;
        rope[idx] = make_float2(cosf(ang), sinf(ang));
      }
    }
    convert_flat(p.peer_keys, (u16*)(p.ws + OFF_KEYS), (size_t)131072);
    convert_flat_fp8(p.peer_u, (unsigned char*)(p.ws + OFF_UBF), (size_t)16384 * 1024, 512.f);
    convert_flat_fp8(p.peer_v, (unsigned char*)(p.ws + OFF_VBF), (size_t)16384 * 1024, 64.f);
  }
  xcd_barrier(xb);

  for (int rep_ = 0; rep_ < NREP(1); ++rep_) if (PHON(1)) {
    const float* mod = (const float*)(p.ws + OFF_MOD);
    const int nrows = T_TOK + 1024;
    for (int r = bid * 4 + wave; r < nrows; r += nb * 4) {
      if (r < T_TOK) {
        const int b = r >> 12;
        norm_row(p.x + (size_t)r * 1024, p.norm1_g, mod + b * 6144, mod + b * 6144 + 1024,
                 (u16*)((char*)p.out + OO_H1) + (size_t)r * 1024, lane);
      } else {
        const int rc = r - T_TOK;
        norm_row(p.ctx + (size_t)rc * 1024, p.norm1_g, mod + 4 * 6144, mod + 4 * 6144 + 1024,
                 (u16*)((char*)p.out + OO_HC) + (size_t)rc * 1024, lane);
      }
    }
    for (int it = bid; it < 256; it += nb) p1_filter_tile(p, (it + 256 < nb) ? it : it, sA, sB);
  }
  xcd_barrier(xb);

  for (int rep_ = 0; rep_ < NREP(2); ++rep_) if (PHON(2)) {
    if (nb == 512) {
      const int xg = bid & 7, slot = bid >> 3;
      for (int r = 0; r < 8; ++r) {
        const int sup = r * 8 + xg;
        const int mt = (sup >> 2) * 8 + (slot >> 3), nt = (sup & 3) * 8 + (slot & 7);
        p2_inproj(p, mt * 34 + nt, sA, sB);
      }
      if (bid < 256) p2_inproj(p, (bid >> 1) * 34 + 32 + (bid & 1), sA, sB);
      else if (bid < 272) p2_ctxkv(p, bid - 256, sA, sB);
    } else {
      const int total = 128 * 34 + 16;
      for (int it = bid; it < total; it += nb) {
        if (it < 128 * 34) p2_inproj(p, it, sA, sB);
        else p2_ctxkv(p, it - 128 * 34, sA, sB);
      }
    }
  }
  xcd_barrier(xb);

  for (int rep_ = 0; rep_ < NREP(3); ++rep_) if (PHON(3)) {
    const int total = 1024 + 2048;
    for (int it = bid; it < total; it += nb) {
      if (it < 1024) p3_attn(p, it, (u16*)smem, (u16*)(smem + 128 * 72 * 2));
      else p3_hypre(p, it - 1024, (u16*)smem);
    }
  }
  xcd_barrier(xb);

  for (int rep_ = 0; rep_ < NREP(4); ++rep_) if (PHON(4)) for (int it = bid; it < 512; it += nb) p3_toeplitz(p, it, smem);
  xcd_barrier(xb);

  for (int rep_ = 0; rep_ < NREP(5); ++rep_) if (PHON(5)) for (int it = bid; it < 1024; it += nb) p4_merge(p, (nb == 512) ? ((((it >> 9) * 8 + (bid & 7)) * 8 + (bid >> 6)) * 8 + ((bid >> 3) & 7)) : it, sA, sB);
  xcd_barrier(xb);

  for (int rep_ = 0; rep_ < NREP(6); ++rep_) if (PHON(6)) for (int it = bid; it < 1024; it += nb) p5_out(p, (nb == 512) ? ((((it >> 9) * 8 + (bid & 7)) * 8 + (bid >> 6)) * 8 + ((bid >> 3) & 7)) : it, sA, sB);
  xcd_barrier(xb);

  for (int rep_ = 0; rep_ < NREP(7); ++rep_) if (PHON(7)) {
    const float* mod = (const float*)(p.ws + OFF_MOD);
    for (int r = bid * 4 + wave; r < T_TOK; r += nb * 4) {
      const int b = r >> 12;
      norm_row(p.out + (size_t)r * 1024, p.norm2_g, mod + b * 6144 + 3072, mod + b * 6144 + 4096,
               (u16*)(p.ws + OFF_H2) + (size_t)r * 1024, lane);
    }
  }
  xcd_barrier(xb);

  for (int rep_ = 0; rep_ < NREP(8); ++rep_) if (PHON(8)) for (int it = bid; it < 1024; it += nb) p7_qp(p, (nb == 512) ? ((((it >> 9) * 8 + (bid & 7)) * 8 + (bid >> 6)) * 8 + ((bid >> 3) & 7)) : it, sA, sB);
  xcd_barrier(xb);

  for (int rep_ = 0; rep_ < NREP(9); ++rep_) if (PHON(9)) for (int it = bid * 4 + wave; it < 8192; it += nb * 4) p8_route(p, it, smem + wave * 4096);
  xcd_barrier(xb);

  if (PHON(10)) {
    const int nw = nb * 4;
    int t = bid * 4 + wave;
    if (t < T_TOK) {
      int2 e2n = *(const int2*)((const int*)(p.ws + OFF_RIDX) + (size_t)t * 128 + 2 * lane);
      float2 w2n = *(const float2*)((const float*)(p.ws + OFF_RW) + (size_t)t * 128 + 2 * lane);
      u32x4 han = *(const u32x4*)((const u16*)(p.ws + OFF_H2) + (size_t)t * 1024 + 16 * lane);
      u32x4 hbn = *(const u32x4*)((const u16*)(p.ws + OFF_H2) + (size_t)t * 1024 + 16 * lane + 8);
      for (; t < T_TOK; t += nw) {
        const int tn = (t + nw < T_TOK) ? (t + nw) : t;
        p9_token(p, t, tn, lane, e2n, w2n, han, hbn);
      }
    }
  }
}

extern "C" void kernel_launch(void* const* d_in, const int* in_sizes, int n_in, void* d_out, int out_size,
                              void* d_ws, size_t ws_size, hipStream_t stream) {
  static int grid_blocks = 0;
  if (!grid_blocks) {
    int dev = 0, cus = 0, per_cu = 0;
    (void)hipGetDevice(&dev);
    (void)hipDeviceGetAttribute(&cus, hipDeviceAttributeMultiprocessorCount, dev);
    (void)hipFuncSetAttribute((const void*)mega, hipFuncAttributeMaxDynamicSharedMemorySize, SMEM_BYTES);
    (void)hipOccupancyMaxActiveBlocksPerMultiprocessor(&per_cu, mega, 256, SMEM_BYTES);
    if (per_cu > 2) per_cu = 2;
    if (per_cu < 1) per_cu = 1;
    grid_blocks = cus * per_cu;
  }
  Params p{};
  const float** pp = (const float**)&p;
  for (int i = 0; i < 28; ++i) pp[i] = (const float*)d_in[i];
  p.out = (float*)d_out;
  p.ws = (char*)d_ws;
  (void)hipMemsetAsync((char*)d_ws, 0, OFF_BAR + 24576, stream);
  void* args[] = {&p};
  hipError_t e = hipLaunchCooperativeKernel((void*)mega, dim3(grid_blocks), dim3(256), args, SMEM_BYTES, stream);
  if (e != hipSuccess) fprintf(stderr, "cooperative launch failed: %s (grid %d)\n", hipGetErrorString(e), grid_blocks);
}
```

```cpp
#include <hip/hip_runtime.h>
#include <hip/hip_bf16.h>
#include <hip/hip_cooperative_groups.h>
#include <cstdio>
namespace cg = cooperative_groups;

typedef unsigned short u16;
typedef __attribute__((ext_vector_type(8))) short bf16x8;
typedef __attribute__((ext_vector_type(4))) float f32x4;
typedef __attribute__((ext_vector_type(4))) unsigned u32x4;

#define DEV __device__ __forceinline__
#ifndef PH
#define PH -1
#endif
#define PHON(n) (PH < 0 || PH == (n))
#ifndef REP
#define REP -1
#endif
#define NREP(n) ((REP == (n)) ? 2 : 1)

constexpr int T_TOK = 16384;
constexpr int DM = 1024;
constexpr int SEQL = 4096;
constexpr int INW = 4352;

struct Params {
  const float *x, *c, *ctx, *c_ctx, *w_mod, *b_mod, *norm1_g, *w_in, *attn_sink, *hy_conv_w, *hy_conv_b,
      *hy_fw1, *hy_fb1, *hy_fw2, *hy_fb2, *hy_fw3, *hy_fb3, *hy_freq, *hy_skip, *w_o_attn, *w_o_hy, *w_out,
      *norm2_g, *peer_wq, *peer_keys, *peer_u, *peer_v, *final_g;
  float* out;
  char* ws;
};

constexpr size_t MB = 1u << 20;
constexpr size_t OFF_MOD = 0;
constexpr size_t OFF_ROPE = 128 * 1024;
constexpr size_t OFF_NINV = OFF_ROPE + 8192;
constexpr size_t OFF_H2F = 256 * 1024;
constexpr size_t OFF_WIN = OFF_H2F + MB;
constexpr size_t OFF_WOA = OFF_WIN + 9 * MB;
constexpr size_t OFF_WOH = OFF_WOA + MB;
constexpr size_t OFF_WOUT = OFF_WOH + MB;
constexpr size_t OFF_WQ = OFF_WOUT + 2 * MB;
constexpr size_t OFF_KEYS = OFF_WQ + 2 * MB;
constexpr size_t OFF_UBF = OFF_KEYS + MB;
constexpr size_t OFF_VBF = OFF_UBF + 32 * MB;
constexpr size_t OFF_Q = OFF_VBF + 32 * MB;
constexpr size_t OFF_K = OFF_Q + 16 * MB;
constexpr size_t OFF_VT = OFF_K + 4 * MB;
constexpr size_t OFF_KC = OFF_VT + 4 * MB;
constexpr size_t OFF_VCT = OFF_KC + MB / 2;
constexpr size_t OFF_Z = OFF_VCT + MB / 2;
constexpr size_t OFF_GATE = OFF_Z + 48 * MB;
constexpr size_t OFF_YATT = OFF_GATE + 64 * MB;
constexpr size_t OFF_YHY = OFF_YATT + 16 * MB;
constexpr size_t OFF_RIDX = OFF_Q;
constexpr size_t OFF_RW = OFF_Q + 8 * MB;
constexpr size_t OFF_MERGED = OFF_Z;
constexpr size_t OFF_H2 = OFF_GATE;
constexpr size_t OFF_QP = OFF_GATE + 32 * MB;
constexpr size_t OO_H1 = 0;
constexpr size_t OO_UT = 0;
constexpr size_t OO_X0T = 16 * MB;
constexpr size_t OO_HC = 32 * MB;
constexpr size_t OO_G = 34 * MB;

constexpr int SMEM_BYTES = 70144;
constexpr size_t OFF_BAR = 160 * 1024;
constexpr int SMEM_XB = 70016;

DEV u16 f2bf(float f) {
  unsigned u = __float_as_uint(f);
  u += 0x7fffu + ((u >> 16) & 1u);
  return (u16)(u >> 16);
}
DEV float bf2f(u16 h) { return __uint_as_float(((unsigned)h) << 16); }
DEV unsigned pack2(float a, float b) { return (unsigned)f2bf(a) | ((unsigned)f2bf(b) << 16); }
DEV float bflo(unsigned w) { return __uint_as_float(w << 16); }
DEV float bfhi(unsigned w) { return __uint_as_float(w & 0xffff0000u); }
#define DPP_ADD(v, ctrl) ((v) + __builtin_bit_cast(float, __builtin_amdgcn_update_dpp(0, __builtin_bit_cast(int, (v)), (ctrl), 0xF, 0xF, true)))
DEV float wave_sum(float v) {
#pragma unroll
  for (int o = 32; o > 0; o >>= 1) v += __shfl_xor(v, o);
  return v;
}
DEV float wave_max(float v) {
#pragma unroll
  for (int o = 32; o > 0; o >>= 1) v = fmaxf(v, __shfl_xor(v, o));
  return v;
}

DEV void p0_mod(const Params& p, int item, float* sm) {
  const int tid = threadIdx.x;
  const int cblk = item >> 2, kq = item & 3;
  for (int i = tid; i < 5 * 256; i += 256) {
    const int r = i >> 8, k = kq * 256 + (i & 255);
    const float c = (r < 4) ? p.c[r * 1024 + k] : p.c_ctx[k];
    sm[i] = c / (1.f + expf(-c));
  }
  __syncthreads();
  const int col = cblk * 64 + (tid & 63), sub = tid >> 6;
  float a0 = 0, a1 = 0, a2 = 0, a3 = 0, a4 = 0;
  const float* wp = p.w_mod + (size_t)(kq * 256 + sub * 64) * 6144 + col;
#pragma unroll 16
  for (int k = 0; k < 64; ++k) {
    const float w = wp[(size_t)k * 6144];
    const int kk = sub * 64 + k;
    a0 += sm[kk] * w; a1 += sm[256 + kk] * w; a2 += sm[512 + kk] * w; a3 += sm[768 + kk] * w; a4 += sm[1024 + kk] * w;
  }
  float* red = sm + 5 * 256;
  red[(sub * 5 + 0) * 64 + (tid & 63)] = a0;
  red[(sub * 5 + 1) * 64 + (tid & 63)] = a1;
  red[(sub * 5 + 2) * 64 + (tid & 63)] = a2;
  red[(sub * 5 + 3) * 64 + (tid & 63)] = a3;
  red[(sub * 5 + 4) * 64 + (tid & 63)] = a4;
  __syncthreads();
  float* mod = (float*)(p.ws + OFF_MOD);
  for (int i = tid; i < 320; i += 256) {
    const int r = i >> 6, cc = i & 63;
    float sacc = red[(0 * 5 + r) * 64 + cc] + red[(1 * 5 + r) * 64 + cc] + red[(2 * 5 + r) * 64 + cc] + red[(3 * 5 + r) * 64 + cc];
    if (kq == 0) sacc += p.b_mod[cblk * 64 + cc];
    atomicAdd(mod + r * 6144 + cblk * 64 + cc, sacc);
  }
  __syncthreads();
}

DEV void transpose_tile(const float* __restrict__ src, int N, int K, u16* __restrict__ dst, int tile, float* sm) {
  const int tid = threadIdx.x;
  const int nkt = K >> 6;
  const int kt = tile % nkt, nt = tile / nkt;
  const int k0 = kt * 64, n0 = nt * 64;
  const int c = tid & 63, r = tid >> 6;
#pragma unroll
  for (int rr = 0; rr < 16; ++rr) sm[(rr * 4 + r) * 65 + c] = src[(size_t)(k0 + rr * 4 + r) * N + n0 + c];
  __syncthreads();
  const int nn = tid >> 2, part = tid & 3;
  unsigned w[8];
#pragma unroll
  for (int j = 0; j < 8; ++j) w[j] = pack2(sm[(part * 16 + 2 * j) * 65 + nn], sm[(part * 16 + 2 * j + 1) * 65 + nn]);
  uint4* d = (uint4*)(dst + (size_t)(n0 + nn) * K + k0 + part * 16);
  d[0] = make_uint4(w[0], w[1], w[2], w[3]);
  d[1] = make_uint4(w[4], w[5], w[6], w[7]);
  __syncthreads();
}

DEV void p0_hidden(const Params& p, int item, float* sm) {
  const int tid = threadIdx.x;
  float* z = sm;
  float* h1 = sm + 4 * 36;
  if (tid < 4 * 33) {
    int tt = tid / 33, i = tid % 33;
    int t = item * 4 + tt;
    float v;
    if (i == 0) v = (float)t * (1.f / 4096.f);
    else {
      int band = (i <= 16) ? i : (i - 16);
      float fr = (float)((t * band) & 4095) * (1.f / 4096.f);
      v = (i <= 16) ? cospif(2.f * fr) : sinpif(2.f * fr);
    }
    z[tt * 36 + i] = v;
  }
  __syncthreads();
  const int tt = tid >> 6, j = tid & 63;
  float a = p.hy_fb1[j];
  for (int i = 0; i < 33; ++i) a += z[tt * 36 + i] * p.hy_fw1[i * 64 + j];
  const float fq = p.hy_freq[j];
  h1[tt * 64 + j] = sinf(fq * a);
  __syncthreads();
  float b = p.hy_fb2[j];
  for (int i = 0; i < 64; ++i) b += h1[tt * 64 + i] * p.hy_fw2[i * 64 + j];
  ((u16*)(p.ws + OFF_H2F))[(item * 4 + tt) * 64 + j] = f2bf(sinf(fq * b));
  __syncthreads();
}

DEV void convert_flat(const float* __restrict__ src, u16* __restrict__ dst, size_t n) {
  size_t stride = (size_t)gridDim.x * 256 * 8;
  for (size_t i = ((size_t)blockIdx.x * 256 + threadIdx.x) * 8; i < n; i += stride) {
    float4 a = *(const float4*)(src + i);
    float4 b = *(const float4*)(src + i + 4);
    *(uint4*)(dst + i) = make_uint4(pack2(a.x, a.y), pack2(a.z, a.w), pack2(b.x, b.y), pack2(b.z, b.w));
  }
}

typedef __attribute__((ext_vector_type(2))) float f32x2;
DEV void convert_flat_fp8(const float* __restrict__ src, unsigned char* __restrict__ dst, size_t n, float scale) {
  const size_t q4 = (size_t)gridDim.x * 256 * 16;
  const size_t stride = q4 * 4;
  for (size_t i = ((size_t)blockIdx.x * 256 + threadIdx.x) * 16; i < n; i += stride) {
    float4 a[16];
#pragma unroll
    for (int c = 0; c < 4; ++c) {
      const size_t off = i + c * q4;
      if (off < n) {
#pragma unroll
        for (int q = 0; q < 4; ++q) a[c * 4 + q] = *(const float4*)(src + off + 4 * q);
      }
    }
#pragma unroll
    for (int c = 0; c < 4; ++c) {
      const size_t off = i + c * q4;
      if (off < n) {
        unsigned w[4];
#pragma unroll
        for (int q = 0; q < 4; ++q) {
          int v = 0;
          v = __builtin_amdgcn_cvt_pk_fp8_f32(a[c * 4 + q].x * scale, a[c * 4 + q].y * scale, v, false);
          v = __builtin_amdgcn_cvt_pk_fp8_f32(a[c * 4 + q].z * scale, a[c * 4 + q].w * scale, v, true);
          w[q] = (unsigned)v;
        }
        *(uint4*)(dst + off) = make_uint4(w[0], w[1], w[2], w[3]);
      }
    }
  }
}

DEV void norm_row(const float* __restrict__ xr, const float* __restrict__ g, const float* __restrict__ sh,
                  const float* __restrict__ sc, u16* __restrict__ dst, int lane) {
  float4 v[4];
  float ss = 0.f;
#pragma unroll
  for (int i = 0; i < 4; ++i) {
    v[i] = ((const float4*)xr)[lane + 64 * i];
    ss += v[i].x * v[i].x + v[i].y * v[i].y + v[i].z * v[i].z + v[i].w * v[i].w;
  }
  ss = wave_sum(ss);
  const float r = rsqrtf(ss * (1.f / 1024.f) + 1e-6f);
#pragma unroll
  for (int i = 0; i < 4; ++i) {
    const int idx = lane + 64 * i;
    float4 gg = ((const float4*)g)[idx], s1 = ((const float4*)sh)[idx], s2 = ((const float4*)sc)[idx];
    float y0 = v[i].x * r * gg.x * (1.f + s2.x) + s1.x;
    float y1 = v[i].y * r * gg.y * (1.f + s2.y) + s1.y;
    float y2 = v[i].z * r * gg.z * (1.f + s2.z) + s1.z;
    float y3 = v[i].w * r * gg.w * (1.f + s2.w) + s1.w;
    *(uint2*)(dst + idx * 4) = make_uint2(pack2(y0, y1), pack2(y2, y3));
  }
}

DEV void p1_filter(const Params& p, int item, float* sm) {
  const int tid = threadIdx.x;
  const int c0 = (item >> 2) * 4, tq = item & 3;
  float* wc = sm;
  float* red = sm + 512;
  for (int i = tid; i < 512; i += 256) {
    const int j = i >> 6, k = i & 63;
    wc[i] = p.hy_fw3[k * 1024 + ((j < 4) ? (c0 + j) : (512 + c0 + j - 4))];
  }
  __syncthreads();
  float fb[8], dl[4];
#pragma unroll
  for (int j = 0; j < 8; ++j) fb[j] = p.hy_fb3[(j < 4) ? (c0 + j) : (512 + c0 + j - 4)];
  const float da = logf(1e-2f) / 1.5f, db = logf(1e-2f) / 0.3f;
#pragma unroll
  for (int j = 0; j < 4; ++j) dl[j] = fabsf(da + (db - da) * (float)(c0 + j) / 511.f);
  u16* G = (u16*)((char*)p.out + OO_G);
  const float* H = (const float*)(p.ws + OFF_H2F);
  float as[4] = {0.f, 0.f, 0.f, 0.f};
#pragma unroll 1
  for (int i = 0; i < 4; ++i) {
    const int t = tq * 1024 + i * 256 + tid;
    const float4* hp = (const float4*)(H + t * 64);
    float d[8];
#pragma unroll
    for (int j = 0; j < 8; ++j) d[j] = fb[j];
#pragma unroll 1
    for (int q8 = 0; q8 < 16; q8 += 8) {
      float4 hv[8];
#pragma unroll
      for (int u = 0; u < 8; ++u) hv[u] = hp[q8 + u];
#pragma unroll
      for (int u = 0; u < 8; ++u)
#pragma unroll
        for (int j = 0; j < 8; ++j) {
          const float4 w = *(const float4*)(wc + j * 64 + 4 * (q8 + u));
          d[j] += hv[u].x * w.x + hv[u].y * w.y + hv[u].z * w.z + hv[u].w * w.w;
        }
    }
    const float tn = (float)t * (1.f / 4096.f);
#pragma unroll
    for (int j = 0; j < 4; ++j) {
      const float dec = expf(-tn * dl[j]);
      const float f = d[j] * dec, bw = d[4 + j] * dec;
      u16* Gc = G + (size_t)(c0 + j) * 8192;
      Gc[4095 - t] = f2bf(f);
      as[j] += fabsf(f);
      if (t < 4095) { Gc[4096 + t] = f2bf(bw); as[j] += fabsf(bw); }
      else Gc[8191] = 0;
    }
  }
#pragma unroll
  for (int j = 0; j < 4; ++j) {
    const float v = wave_sum(as[j]);
    if ((tid & 63) == 0) red[(tid >> 6) * 4 + j] = v;
  }
  __syncthreads();
  if (tid < 4) atomicAdd((float*)(p.ws + OFF_BAR + 20480) + c0 + tid, red[tid] + red[4 + tid] + red[8 + tid] + red[12 + tid]);
  __syncthreads();
}

struct Acc { f32x4 v[4][4]; };

DEV void acc_zero(Acc& a) {
#pragma unroll
  for (int i = 0; i < 4; ++i)
#pragma unroll
    for (int j = 0; j < 4; ++j) a.v[i][j] = (f32x4){0.f, 0.f, 0.f, 0.f};
}

#define LDSAS __attribute__((address_space(3)))
DEV void gemm_kloop(const u16* __restrict__ A, int lda, const u16* __restrict__ Bt, int ldb, int K, int m0, int n0,
                    u16* sA, u16* sB_unused, Acc& acc) {
  const int tid = threadIdx.x, lane = tid & 63, wave = tid >> 6, wm = wave >> 1, wn = wave & 1;
  const int l15 = lane & 15, quad = lane >> 4;
  const int rsw = (l15 >> 1) & 7;
  const int nk = K >> 6;
  const int prow = lane >> 3;
  const int pch = lane & 7;
  unsigned oA[4], oB[4];
#pragma unroll
  for (int i = 0; i < 4; ++i) {
    const int row = (wave * 4 + i) * 8 + prow;
    const int c = pch ^ ((row >> 1) & 7);
    oA[i] = (unsigned)(row * lda + c * 8) * 2u;
    oB[i] = (unsigned)(row * ldb + c * 8) * 2u;
  }
  const char* bA = (const char*)(A + (size_t)m0 * lda);
  const char* bB = (const char*)(Bt + (size_t)n0 * ldb);
  LDSAS char* lbase = (LDSAS char*)sA;
#define GEMM_DMA(KT, BUF)                                                                                   \
  _Pragma("unroll") for (int i = 0; i < 4; ++i) {                                                           \
    __builtin_amdgcn_global_load_lds((const unsigned*)(bA + (KT) * 128 + oA[i]), (LDSAS unsigned*)(lbase + (BUF) * 32768 + (wave * 4 + i) * 1024), 16, 0, 0);          \
    __builtin_amdgcn_global_load_lds((const unsigned*)(bB + (KT) * 128 + oB[i]), (LDSAS unsigned*)(lbase + (BUF) * 32768 + 16384 + (wave * 4 + i) * 1024), 16, 0, 0);  \
  }
  GEMM_DMA(0, 0)
  for (int kt = 0; kt < nk; ++kt) {
    asm volatile("s_waitcnt vmcnt(0)" ::: "memory");
    __syncthreads();
    const int buf = kt & 1;
    if (kt + 1 < nk) { GEMM_DMA(kt + 1, buf ^ 1) }
    const u16* tA = sA + buf * 16384;
    const u16* tB = tA + 8192;
    bf16x8 af[2][4], bfr[2][4];
#pragma unroll
    for (int ks = 0; ks < 2; ++ks) {
      const int cs = ((ks * 4 + quad) ^ rsw) * 8;
#pragma unroll
      for (int i = 0; i < 4; ++i) af[ks][i] = *(const bf16x8*)(tB + (wn * 64 + i * 16 + l15) * 64 + cs);
#pragma unroll
      for (int j = 0; j < 4; ++j) bfr[ks][j] = *(const bf16x8*)(tA + (wm * 64 + j * 16 + l15) * 64 + cs);
    }
    __builtin_amdgcn_s_setprio(1);
#pragma unroll
    for (int ks = 0; ks < 2; ++ks)
#pragma unroll
      for (int i = 0; i < 4; ++i)
#pragma unroll
        for (int j = 0; j < 4; ++j) acc.v[i][j] = __builtin_amdgcn_mfma_f32_16x16x32_bf16(af[ks][i], bfr[ks][j], acc.v[i][j], 0, 0, 0);
    __builtin_amdgcn_s_setprio(0);
  }
  __syncthreads();
}

DEV void p1_filter_tile(const Params& p, int tile, u16* sA, u16* sB) {
  const int mt = tile >> 3, nt = tile & 7;
  const int m0 = mt * 128, n0 = nt * 128;
  Acc acc; acc_zero(acc);
  gemm_kloop((const u16*)(p.ws + OFF_H2F), 64, (const u16*)(p.ws + OFF_H2F + 512 * 1024), 64, 64, m0, n0, sA, sB, acc);
  asm volatile("" ::: "memory");
  const int tid = threadIdx.x, lane = tid & 63, wave = tid >> 6, wm = wave >> 1, wn = wave & 1;
  const int l15 = lane & 15, quad = lane >> 4;
  const int mb = m0 + wm * 64, nbase = n0 + wn * 64;
  u16* G = (u16*)((char*)p.out + OO_G);
  float* nsum = (float*)(p.ws + OFF_BAR + 20480);
  const float da = logf(1e-2f) / 1.5f, db = logf(1e-2f) / 0.3f;
  const bool bwd = nbase >= 512;
#pragma unroll
  for (int i = 0; i < 4; ++i)
#pragma unroll
    for (int r = 0; r < 4; ++r) {
      const int col = nbase + i * 16 + quad * 4 + r;
      const int c = col & 511;
      const float fbv = p.hy_fb3[col];
      const float dlc = fabsf(da + (db - da) * (float)c / 511.f);
      u16* Gc = G + (size_t)c * 8192;
      float sum = 0.f;
#pragma unroll
      for (int j = 0; j < 4; ++j) {
        const int t = mb + j * 16 + l15;
        const float val = (acc.v[i][j][r] + fbv) * expf(-(float)t * (1.f / 4096.f) * dlc);
        if (!bwd) { Gc[4095 - t] = f2bf(val); sum += fabsf(val); }
        else if (t < 4095) { Gc[4096 + t] = f2bf(val); sum += fabsf(val); }
        else Gc[8191] = 0;
      }
      sum = DPP_ADD(sum, 0xB1);
      sum = DPP_ADD(sum, 0x4E);
      sum = DPP_ADD(sum, 0x141);
      sum = DPP_ADD(sum, 0x140);
      if (l15 == 0) atomicAdd(nsum + c, sum);
    }
}

DEV void p2_inproj(const Params& p, int tile, u16* sA, u16* sB) {
  const int mt = tile / 34, nt = tile % 34;
  const int m0 = mt * 128, n0 = nt * 128;
  Acc acc; acc_zero(acc);
  gemm_kloop((const u16*)((const char*)p.out + OO_H1), 1024, (const u16*)(p.ws + OFF_WIN), 1024, 1024, m0, n0, sA, sB, acc);
  asm volatile("" ::: "memory");
  const int tid = threadIdx.x, lane = tid & 63, wave = tid >> 6, wm = wave >> 1, wn = wave & 1;
  int l15 = lane & 15, quad = lane >> 4;
  int mb = m0 + wm * 64, nb = n0 + wn * 64;
  asm volatile("" : "+v"(l15), "+v"(quad), "+v"(mb), "+v"(nb));
  mb = __builtin_amdgcn_readfirstlane(mb); nb = __builtin_amdgcn_readfirstlane(nb);
  if (nb < 640) {
    const float2* rope = (const float2*)(p.ws + OFF_ROPE);
    const bool isq = nb < 512;
    const float qs = isq ? 0.125f : 1.f;
#pragma unroll
    for (int j = 0; j < 4; ++j) {
      const int m = mb + j * 16 + l15;
      const int b = m >> 12, l = m & 4095;
      const int prow = l >> 6, pcol = l & 63;
      u16* dst;
      if (isq) dst = (u16*)(p.ws + OFF_Q) + ((size_t)(b * 8 + (nb >> 6)) * 4096 + l) * 64;
      else dst = (u16*)(p.ws + OFF_K) + ((size_t)(b * 2 + ((nb - 512) >> 6)) * 4096 + l) * 64;
#pragma unroll
      for (int hh = 0; hh < 2; ++hh) {
        const int pos = hh ? pcol : prow;
        f32x4 x1 = acc.v[hh * 2][j], x2 = acc.v[hh * 2 + 1][j];
        float o1[4], o2[4];
#pragma unroll
        for (int r = 0; r < 4; ++r) {
          float2 cs = rope[pos * 16 + quad * 4 + r];
          o1[r] = (x1[r] * cs.x - x2[r] * cs.y) * qs;
          o2[r] = (x2[r] * cs.x + x1[r] * cs.y) * qs;
        }
        *(uint2*)(dst + hh * 32 + quad * 4) = make_uint2(pack2(o1[0], o1[1]), pack2(o1[2], o1[3]));
        *(uint2*)(dst + hh * 32 + 16 + quad * 4) = make_uint2(pack2(o2[0], o2[1]), pack2(o2[2], o2[3]));
      }
    }
  } else if (nb < 768) {
    const int g = (nb - 640) >> 6;
    u16* vt = (u16*)(p.ws + OFF_VT);
#pragma unroll
    for (int j = 0; j < 4; ++j) {
      const int m = mb + j * 16 + l15;
      const int b = m >> 12, l = m & 4095;
#pragma unroll
      for (int i = 0; i < 4; ++i)
#pragma unroll
        for (int r = 0; r < 4; ++r) {
          const int d = i * 16 + quad * 4 + r;
          vt[((size_t)(b * 2 + g) * 64 + d) * 4096 + l] = f2bf(acc.v[i][j][r]);
        }
    }
  } else if (nb < 2304) {
    u16* z = (u16*)(p.ws + OFF_Z);
#pragma unroll
    for (int j = 0; j < 4; ++j) {
      const int m = mb + j * 16 + l15;
#pragma unroll
      for (int i = 0; i < 4; ++i) {
        const int n = nb - 768 + i * 16 + quad * 4;
        f32x4 a = acc.v[i][j];
        *(uint2*)(z + (size_t)m * 1536 + n) = make_uint2(pack2(a[0], a[1]), pack2(a[2], a[3]));
      }
    }
  } else {
    u16* gt = (u16*)(p.ws + OFF_GATE);
#pragma unroll
    for (int j = 0; j < 4; ++j) {
      const int m = mb + j * 16 + l15;
#pragma unroll
      for (int i = 0; i < 4; ++i) {
        const int n = nb - 2304 + i * 16 + quad * 4;
        f32x4 a = acc.v[i][j];
        float s0 = 1.f / (1.f + __expf(-a[0])), s1 = 1.f / (1.f + __expf(-a[1]));
        float s2 = 1.f / (1.f + __expf(-a[2])), s3 = 1.f / (1.f + __expf(-a[3]));
        *(uint2*)(gt + (size_t)m * 2048 + n) = make_uint2(pack2(s0, s1), pack2(s2, s3));
      }
    }
  }
}

DEV void p2_ctxkv(const Params& p, int tile, u16* sA, u16* sB) {
  const int mt = tile >> 1, nt = tile & 1;
  const int m0 = mt * 128, n0 = nt * 128;
  Acc acc; acc_zero(acc);
  gemm_kloop((const u16*)((const char*)p.out + OO_HC), 1024, (const u16*)(p.ws + OFF_WIN) + (size_t)512 * 1024, 1024, 1024, m0, n0, sA, sB, acc);
  const int tid = threadIdx.x, lane = tid & 63, wave = tid >> 6, wm = wave >> 1, wn = wave & 1;
  const int l15 = lane & 15, quad = lane >> 4;
  const int mb = m0 + wm * 64, nb = n0 + wn * 64;
  const int g = (nb >> 6) & 1;
  if (nb < 128) {
    u16* kc = (u16*)(p.ws + OFF_KC);
#pragma unroll
    for (int j = 0; j < 4; ++j) {
      const int m = mb + j * 16 + l15;
      const int b = m >> 8, c = m & 255;
#pragma unroll
      for (int i = 0; i < 4; ++i) {
        f32x4 a = acc.v[i][j];
        *(uint2*)(kc + ((size_t)(b * 2 + g) * 256 + c) * 64 + i * 16 + quad * 4) = make_uint2(pack2(a[0], a[1]), pack2(a[2], a[3]));
      }
    }
  } else {
    u16* vct = (u16*)(p.ws + OFF_VCT);
#pragma unroll
    for (int j = 0; j < 4; ++j) {
      const int m = mb + j * 16 + l15;
      const int b = m >> 8, c = m & 255;
#pragma unroll
      for (int i = 0; i < 4; ++i)
#pragma unroll
        for (int r = 0; r < 4; ++r) {
          const int d = i * 16 + quad * 4 + r;
          vct[((size_t)(b * 2 + g) * 64 + d) * 256 + c] = f2bf(acc.v[i][j][r]);
        }
    }
  }
}

DEV void p3_attn(const Params& p, int item, u16* sK, u16* sVt) {
  const int tid = threadIdx.x, lane = tid & 63, wave = tid >> 6, l15 = lane & 15, quad = lane >> 4;
  const int n = item & 31, h = (item >> 5) & 7, b = item >> 8;
  const int g = h >> 2;
  const u16* Q = (const u16*)(p.ws + OFF_Q) + ((size_t)(b * 8 + h) * 4096 + n * 128 + wave * 32) * 64;
  bf16x8 bq[2][2];
#pragma unroll
  for (int qt = 0; qt < 2; ++qt)
#pragma unroll
    for (int ks = 0; ks < 2; ++ks) bq[qt][ks] = *(const bf16x8*)(Q + (qt * 16 + l15) * 64 + ks * 32 + quad * 8);
  const float sink = p.attn_sink[h];
  float mrun[2] = {sink, sink};
  float lrun[2];
  lrun[0] = lrun[1] = (quad == 0) ? 1.f : 0.f;
  f32x4 O[4][2];
#pragma unroll
  for (int dt = 0; dt < 4; ++dt)
#pragma unroll
    for (int qt = 0; qt < 2; ++qt) O[dt][qt] = (f32x4){0.f, 0.f, 0.f, 0.f};

  u32x4 pk[4], pv[4];
#define ATT_LOAD(KB)                                                                                  \
  {                                                                                                   \
    const u16* Ksrc; const u16* Vsrc; int vstride;                                                    \
    if ((KB) < 3) {                                                                                   \
      const int nbk = n + (KB) - 1;                                                                   \
      Ksrc = (const u16*)(p.ws + OFF_K) + ((size_t)(b * 2 + g) * 4096 + nbk * 128) * 64;              \
      Vsrc = (const u16*)(p.ws + OFF_VT) + (size_t)(b * 2 + g) * 64 * 4096 + nbk * 128;               \
      vstride = 4096;                                                                                 \
    } else {                                                                                          \
      const int cb = (KB) - 3;                                                                        \
      Ksrc = (const u16*)(p.ws + OFF_KC) + ((size_t)(b * 2 + g) * 256 + cb * 128) * 64;               \
      Vsrc = (const u16*)(p.ws + OFF_VCT) + (size_t)(b * 2 + g) * 64 * 256 + cb * 128;                \
      vstride = 256;                                                                                  \
    }                                                                                                 \
    _Pragma("unroll") for (int i = 0; i < 4; ++i) {                                                   \
      const int id = tid + i * 256;                                                                   \
      pk[i] = *(const u32x4*)(Ksrc + (id >> 3) * 64 + (id & 7) * 8);                                  \
      pv[i] = *(const u32x4*)(Vsrc + (size_t)(id >> 4) * vstride + (id & 15) * 8);                    \
    }                                                                                                 \
  }
  int kb = (n == 0) ? 1 : 0;
  ATT_LOAD(kb)
  while (kb < 5) {
#pragma unroll
    for (int i = 0; i < 4; ++i) {
      const int id = tid + i * 256;
      *(u32x4*)(sK + (id >> 3) * 72 + (id & 7) * 8) = pk[i];
      *(u32x4*)(sVt + (id >> 4) * 136 + (id & 15) * 8) = pv[i];
    }
    __syncthreads();
    int nx = kb + 1;
    if (nx == 2 && n == 31) nx = 3;
    if (nx < 5) ATT_LOAD(nx)
#pragma unroll 1
    for (int c4 = 0; c4 < 4; ++c4) {
      f32x4 s[2][2];
#pragma unroll
      for (int kt = 0; kt < 2; ++kt) {
        bf16x8 ak0 = *(const bf16x8*)(sK + (c4 * 32 + kt * 16 + l15) * 72 + quad * 8);
        bf16x8 ak1 = *(const bf16x8*)(sK + (c4 * 32 + kt * 16 + l15) * 72 + 32 + quad * 8);
#pragma unroll
        for (int qt = 0; qt < 2; ++qt) {
          f32x4 z = (f32x4){0.f, 0.f, 0.f, 0.f};
          z = __builtin_amdgcn_mfma_f32_16x16x32_bf16(ak0, bq[qt][0], z, 0, 0, 0);
          z = __builtin_amdgcn_mfma_f32_16x16x32_bf16(ak1, bq[qt][1], z, 0, 0, 0);
          s[kt][qt] = z;
        }
      }
      if (kb == 0 || kb == 2) {
#pragma unroll
        for (int kt = 0; kt < 2; ++kt)
#pragma unroll
          for (int qt = 0; qt < 2; ++qt)
#pragma unroll
            for (int r = 0; r < 4; ++r) {
              const int kk = c4 * 32 + kt * 16 + quad * 4 + r;
              const int qq = wave * 32 + qt * 16 + l15;
              const bool valid = (kb == 0) ? (kk >= qq) : (kk <= qq);
              if (!valid) s[kt][qt][r] = -INFINITY;
            }
      }
      bf16x8 bp[2];
#pragma unroll
      for (int qt = 0; qt < 2; ++qt) {
        float cm = fmaxf(fmaxf(fmaxf(s[0][qt][0], s[0][qt][1]), fmaxf(s[0][qt][2], s[0][qt][3])),
                         fmaxf(fmaxf(s[1][qt][0], s[1][qt][1]), fmaxf(s[1][qt][2], s[1][qt][3])));
        cm = fmaxf(cm, __shfl_xor(cm, 16));
        cm = fmaxf(cm, __shfl_xor(cm, 32));
        const float mnew = fmaxf(mrun[qt], cm);
        const float alpha = __expf(mrun[qt] - mnew);
        mrun[qt] = mnew;
        float ps = 0.f;
        float pv[8];
#pragma unroll
        for (int r = 0; r < 4; ++r) {
          pv[r] = __expf(s[0][qt][r] - mnew);
          pv[4 + r] = __expf(s[1][qt][r] - mnew);
          ps += pv[r] + pv[4 + r];
        }
        lrun[qt] = lrun[qt] * alpha + ps;
#pragma unroll
        for (int dt = 0; dt < 4; ++dt) {
          O[dt][qt][0] *= alpha; O[dt][qt][1] *= alpha; O[dt][qt][2] *= alpha; O[dt][qt][3] *= alpha;
        }
        union { bf16x8 v; unsigned u[4]; } pk;
        pk.u[0] = pack2(pv[0], pv[1]); pk.u[1] = pack2(pv[2], pv[3]);
        pk.u[2] = pack2(pv[4], pv[5]); pk.u[3] = pack2(pv[6], pv[7]);
        bp[qt] = pk.v;
      }
#pragma unroll
      for (int dt = 0; dt < 4; ++dt) {
        union { bf16x8 v; uint2 h[2]; } av;
        const u16* vrow = sVt + (dt * 16 + l15) * 136 + c4 * 32 + quad * 4;
        av.h[0] = *(const uint2*)(vrow);
        av.h[1] = *(const uint2*)(vrow + 16);
#pragma unroll
        for (int qt = 0; qt < 2; ++qt) O[dt][qt] = __builtin_amdgcn_mfma_f32_16x16x32_bf16(av.v, bp[qt], O[dt][qt], 0, 0, 0);
      }
    }
    __syncthreads();
    kb = nx;
  }
  u16* Y = (u16*)(p.ws + OFF_YATT);
#pragma unroll
  for (int qt = 0; qt < 2; ++qt) {
    float l = lrun[qt];
    l += __shfl_xor(l, 16);
    l += __shfl_xor(l, 32);
    const float inv = 1.f / l;
    const int t = b * 4096 + n * 128 + wave * 32 + qt * 16 + l15;
#pragma unroll
    for (int dt = 0; dt < 4; ++dt) {
      f32x4 o = O[dt][qt];
      *(uint2*)(Y + (size_t)t * 512 + h * 64 + dt * 16 + quad * 4) = make_uint2(pack2(o[0] * inv, o[1] * inv), pack2(o[2] * inv, o[3] * inv));
    }
  }
}

DEV void p3_hypre(const Params& p, int item, u16* sm) {
  const int tid = threadIdx.x;
  const int cb = item & 7, tb = (item >> 3) & 63, b = item >> 9;
  const int tq = tid >> 6, ch = tid & 63;
  const int c = cb * 64 + ch;
  u16* su = sm;
  u16* sx = sm + 64 * 66;
  float w[3][3], bias[3];
#pragma unroll
  for (int s = 0; s < 3; ++s) {
#pragma unroll
    for (int k = 0; k < 3; ++k) w[s][k] = p.hy_conv_w[k * 1536 + s * 512 + c];
    bias[s] = p.hy_conv_b[s * 512 + c];
  }
  const u16* Z = (const u16*)(p.ws + OFF_Z) + (size_t)b * 4096 * 1536;
  const int l0 = tb * 64 + tq * 16;
  float zv[18][3];
#pragma unroll
  for (int i = 0; i < 18; ++i) {
    const int l = l0 - 1 + i;
    const bool ok = (l >= 0) && (l < 4096);
    const int lc = ok ? l : l0;
#pragma unroll
    for (int s2 = 0; s2 < 3; ++s2) {
      const float v = bf2f(Z[(size_t)lc * 1536 + s2 * 512 + c]);
      zv[i][s2] = ok ? v : 0.f;
    }
  }
#pragma unroll
  for (int i = 0; i < 16; ++i) {
    float cv[3];
#pragma unroll
    for (int s2 = 0; s2 < 3; ++s2) cv[s2] = zv[i][s2] * w[s2][0] + zv[i + 1][s2] * w[s2][1] + zv[i + 2][s2] * w[s2][2] + bias[s2];
    su[ch * 66 + tq * 16 + i] = f2bf(cv[2] * cv[1]);
    sx[ch * 66 + tq * 16 + i] = f2bf(cv[0]);
  }
  __syncthreads();
  const int chr = tid >> 2, part = tid & 3;
  const int cc = cb * 64 + chr;
  const unsigned* ru = (const unsigned*)(su + chr * 66 + part * 16);
  const unsigned* rx = (const unsigned*)(sx + chr * 66 + part * 16);
  u16* UT = (u16*)((char*)p.out + OO_UT) + ((size_t)(cc * 4 + b) * 4096 + tb * 64 + part * 16);
  u16* XT = (u16*)((char*)p.out + OO_X0T) + ((size_t)(cc * 4 + b) * 4096 + tb * 64 + part * 16);
  ((uint4*)UT)[0] = make_uint4(ru[0], ru[1], ru[2], ru[3]);
  ((uint4*)UT)[1] = make_uint4(ru[4], ru[5], ru[6], ru[7]);
  ((uint4*)XT)[0] = make_uint4(rx[0], rx[1], rx[2], rx[3]);
  ((uint4*)XT)[1] = make_uint4(rx[4], rx[5], rx[6], rx[7]);
  __syncthreads();
}

DEV void p3_toeplitz(const Params& p, int c, char* smem) {
  const int tid = threadIdx.x, lane = tid & 63, wave = tid >> 6, l15 = lane & 15, quad = lane >> 4;
  u16* sG0 = (u16*)smem;
  u16* sG1 = (u16*)(smem + 16384 + 64);
  u16* sU = (u16*)(smem + 32768 + 128);
  u16* sZ = sU + 4 * 64 * 72;
  const u16* G = (const u16*)((const char*)p.out + OO_G) + (size_t)c * 8192;
  const u16* UT = (const u16*)((const char*)p.out + OO_UT) + (size_t)c * 16384;
#pragma unroll
  for (int i = 0; i < 4; ++i) {
    const int id = tid + i * 256;
    *(uint4*)(sG0 + id * 8) = *(const uint4*)(G + id * 8);
  }
#pragma unroll
  for (int i = 0; i < 8; ++i) {
    const int id = tid + i * 256;
    const int bb = id >> 9, blk = (id >> 3) & 63, c8 = id & 7;
    *(uint4*)(sU + (bb * 64 + blk) * 72 + c8 * 8) = *(const uint4*)(UT + id * 8);
  }
  if (tid < 72) sZ[tid] = 0;
  __syncthreads();
  for (int i = tid; i < 8192; i += 256) sG1[i] = (i < 8191) ? sG0[i + 1] : (u16)0;
  __syncthreads();

  Acc acc; acc_zero(acc);
  const u16* gbase = (l15 & 1) ? sG0 : (sG1 - 1);
  const u16* ubase = sU + wave * 64 * 72 + quad * 8;
  const u16* zbase = sZ + quad * 8;
#define TOEP_LOADA(AF, D)                                                                 \
  {                                                                                       \
    const int base_ = 4095 - 64 * (D) - l15 + quad * 8;                                   \
    _Pragma("unroll") for (int mt = 0; mt < 4; ++mt)                                      \
      _Pragma("unroll") for (int ks = 0; ks < 2; ++ks) {                                  \
        const unsigned* gp = (const unsigned*)(gbase + base_ - mt * 16 + ks * 32);        \
        union { bf16x8 v; unsigned u[4]; } t_;                                            \
        t_.u[0] = gp[0]; t_.u[1] = gp[1]; t_.u[2] = gp[2]; t_.u[3] = gp[3];               \
        AF[mt][ks] = t_.v;                                                                \
      }                                                                                   \
  }
#define TOEP_MMA(AF, D)                                                                   \
  _Pragma("unroll") for (int nt = 0; nt < 4; ++nt) {                                      \
    if (!(nt * 16 + 15 - (D) < 0 || nt * 16 - (D) > 63)) {                                \
      const int ip = nt * 16 + l15 - (D);                                                 \
      const u16* up = (ip >= 0 && ip < 64) ? (ubase + ip * 72) : zbase;                   \
      bf16x8 b0 = *(const bf16x8*)(up);                                                   \
      bf16x8 b1 = *(const bf16x8*)(up + 32);                                              \
      _Pragma("unroll") for (int mt = 0; mt < 4; ++mt) {                                  \
        acc.v[mt][nt] = __builtin_amdgcn_mfma_f32_16x16x32_bf16(AF[mt][0], b0, acc.v[mt][nt], 0, 0, 0); \
        acc.v[mt][nt] = __builtin_amdgcn_mfma_f32_16x16x32_bf16(AF[mt][1], b1, acc.v[mt][nt], 0, 0, 0); \
      }                                                                                   \
    }                                                                                     \
  }
  {
    bf16x8 afA[4][2], afB[4][2];
    TOEP_LOADA(afA, -63)
#pragma unroll 1
    for (int d = -63; d <= 63; d += 2) {
      if (d + 1 <= 63) TOEP_LOADA(afB, d + 1)
      TOEP_MMA(afA, d)
      if (d + 1 <= 63) {
        if (d + 2 <= 63) TOEP_LOADA(afA, d + 2)
        TOEP_MMA(afB, d + 1)
      }
    }
  }
  const float ninv = 1.f / ((const float*)(p.ws + OFF_BAR + 20480))[c];
  const float skip = p.hy_skip[c];
  const u16* XT = (const u16*)((const char*)p.out + OO_X0T) + ((size_t)(c * 4 + wave) * 4096);
  u16* Y = (u16*)(p.ws + OFF_YHY);
#pragma unroll
  for (int nt = 0; nt < 4; ++nt) {
    const int ib = nt * 16 + l15;
#pragma unroll
    for (int mt = 0; mt < 4; ++mt) {
      const int r0 = mt * 16 + quad * 4;
      const int t = ib * 64 + r0;
      uint2 uu = *(const uint2*)(sU + (wave * 64 + ib) * 72 + r0);
      uint2 xx = *(const uint2*)(XT + t);
      float uv[4] = {bflo(uu.x), bfhi(uu.x), bflo(uu.y), bfhi(uu.y)};
      float xv[4] = {bflo(xx.x), bfhi(xx.x), bflo(xx.y), bfhi(xx.y)};
#pragma unroll
      for (int r = 0; r < 4; ++r) {
        float y = acc.v[mt][nt][r] * ninv + uv[r] * skip;
        Y[(size_t)(wave * 4096 + t + r) * 512 + c] = f2bf(y * xv[r]);
      }
    }
  }
  __syncthreads();
}

DEV void p4_merge(const Params& p, int tile, u16* sA, u16* sB) {
  const int mt = tile >> 3, nt = tile & 7;
  const int m0 = mt * 128, n0 = nt * 128;
  const int tid = threadIdx.x, lane = tid & 63, wave = tid >> 6, wm = wave >> 1, wn = wave & 1;
  const int l15 = lane & 15, quad = lane >> 4;
  const int mb = m0 + wm * 64, nb = n0 + wn * 64;
  const u16* gt = (const u16*)(p.ws + OFF_GATE);
  u16* mg = (u16*)(p.ws + OFF_MERGED);
  Acc a1; acc_zero(a1);
  gemm_kloop((const u16*)(p.ws + OFF_YATT), 512, (const u16*)(p.ws + OFF_WOA), 512, 512, m0, n0, sA, sB, a1);
  asm volatile("" ::: "memory");
#pragma unroll
  for (int j = 0; j < 4; ++j) {
    const int m = mb + j * 16 + l15;
#pragma unroll
    for (int i = 0; i < 4; ++i) {
      const int n = nb + i * 16 + quad * 4;
      uint2 ga = *(const uint2*)(gt + (size_t)m * 2048 + n);
      f32x4 x = a1.v[i][j];
      *(uint2*)(mg + (size_t)m * 1024 + n) = make_uint2(pack2(bflo(ga.x) * x[0], bfhi(ga.x) * x[1]), pack2(bflo(ga.y) * x[2], bfhi(ga.y) * x[3]));
    }
  }
  asm volatile("" ::: "memory");
  acc_zero(a1);
  gemm_kloop((const u16*)(p.ws + OFF_YHY), 512, (const u16*)(p.ws + OFF_WOH), 512, 512, m0, n0, sA, sB, a1);
  asm volatile("" ::: "memory");
#pragma unroll
  for (int j = 0; j < 4; ++j) {
    const int m = mb + j * 16 + l15;
#pragma unroll
    for (int i = 0; i < 4; ++i) {
      const int n = nb + i * 16 + quad * 4;
      uint2 gh = *(const uint2*)(gt + (size_t)m * 2048 + 1024 + n);
      uint2 pv = *(const uint2*)(mg + (size_t)m * 1024 + n);
      f32x4 y = a1.v[i][j];
      float o0 = bflo(pv.x) + bflo(gh.x) * y[0];
      float o1 = bfhi(pv.x) + bfhi(gh.x) * y[1];
      float o2 = bflo(pv.y) + bflo(gh.y) * y[2];
      float o3 = bfhi(pv.y) + bfhi(gh.y) * y[3];
      *(uint2*)(mg + (size_t)m * 1024 + n) = make_uint2(pack2(o0, o1), pack2(o2, o3));
    }
  }
}

DEV void p5_out(const Params& p, int tile, u16* sA, u16* sB) {
  const int mt = tile >> 3, nt = tile & 7;
  const int m0 = mt * 128, n0 = nt * 128;
  Acc acc; acc_zero(acc);
  gemm_kloop((const u16*)(p.ws + OFF_MERGED), 1024, (const u16*)(p.ws + OFF_WOUT), 1024, 1024, m0, n0, sA, sB, acc);
  const int tid = threadIdx.x, lane = tid & 63, wave = tid >> 6, wm = wave >> 1, wn = wave & 1;
  const int l15 = lane & 15, quad = lane >> 4;
  const int mb = m0 + wm * 64, nb = n0 + wn * 64;
  const float* mod = (const float*)(p.ws + OFF_MOD);
#pragma unroll
  for (int j = 0; j < 4; ++j) {
    const int m = mb + j * 16 + l15;
    const int b = m >> 12;
#pragma unroll
    for (int i = 0; i < 4; ++i) {
      const int n = nb + i * 16 + quad * 4;
      float4 g1 = *(const float4*)(mod + b * 6144 + 2048 + n);
      float4 xv = *(const float4*)(p.x + (size_t)m * 1024 + n);
      f32x4 a = acc.v[i][j];
      float4 o = make_float4(xv.x + g1.x * a[0], xv.y + g1.y * a[1], xv.z + g1.z * a[2], xv.w + g1.w * a[3]);
      *(float4*)(p.out + (size_t)m * 1024 + n) = o;
    }
  }
}

DEV void p7_qp(const Params& p, int tile, u16* sA, u16* sB) {
  const int mt = tile >> 3, nt = tile & 7;
  const int m0 = mt * 128, n0 = nt * 128;
  Acc acc; acc_zero(acc);
  gemm_kloop((const u16*)(p.ws + OFF_H2), 1024, (const u16*)(p.ws + OFF_WQ), 1024, 1024, m0, n0, sA, sB, acc);
  const int tid = threadIdx.x, lane = tid & 63, wave = tid >> 6, wm = wave >> 1, wn = wave & 1;
  const int l15 = lane & 15, quad = lane >> 4;
  const int mb = m0 + wm * 64, nb = n0 + wn * 64;
  u16* qp = (u16*)(p.ws + OFF_QP);
#pragma unroll
  for (int j = 0; j < 4; ++j) {
    const int m = mb + j * 16 + l15;
#pragma unroll
    for (int i = 0; i < 4; ++i) {
      const int n = nb + i * 16 + quad * 4;
      f32x4 a = acc.v[i][j];
      *(uint2*)(qp + (size_t)m * 1024 + n) = make_uint2(pack2(a[0], a[1]), pack2(a[2], a[3]));
    }
  }
}

DEV unsigned f2ord(float f) {
  const unsigned u = __float_as_uint(f);
  return u ^ (((int)u >> 31) | 0x80000000u);
}
DEV float ord2f(unsigned k) {
  const unsigned m = (k & 0x80000000u) ? 0x80000000u : 0xffffffffu;
  return __uint_as_float(k ^ m);
}
DEV unsigned umax_(unsigned a, unsigned b) { return a > b ? a : b; }
DEV unsigned umin_(unsigned a, unsigned b) { return a < b ? a : b; }

DEV void sort16_desc(unsigned (&v)[16]) {
#pragma unroll
  for (int k = 2; k <= 16; k <<= 1)
#pragma unroll
    for (int j = k >> 1; j > 0; j >>= 1)
#pragma unroll
      for (int i = 0; i < 16; ++i) {
        const int l = i ^ j;
        if (l > i) {
          const bool desc = ((i & k) == 0);
          const unsigned a = v[i], b = v[l];
          const unsigned hi = umax_(a, b), lo = umin_(a, b);
          v[i] = desc ? hi : lo;
          v[l] = desc ? lo : hi;
        }
      }
}
DEV void merge16_desc(unsigned (&v)[16]) {
#pragma unroll
  for (int j = 8; j > 0; j >>= 1)
#pragma unroll
    for (int i = 0; i < 16; ++i) {
      const int l = i ^ j;
      if (l > i) {
        const unsigned a = v[i], b = v[l];
        v[i] = umax_(a, b);
        v[l] = umin_(a, b);
      }
    }
}
DEV void xmerge16(unsigned (&v)[16], int off) {
  unsigned pr[16];
#pragma unroll
  for (int i = 0; i < 16; ++i) pr[i] = (unsigned)__shfl_xor((int)v[i], off);
#pragma unroll
  for (int i = 0; i < 16; ++i) v[i] = umax_(v[i], pr[15 - i]);
  merge16_desc(v);
}

DEV void route_top16_of_128(const u16* __restrict__ keys, const u16* __restrict__ qp, int l15, int quad, unsigned (&out)[16]) {
  bf16x8 b0 = *(const bf16x8*)(qp);
  bf16x8 b1 = *(const bf16x8*)(qp + 32);
  unsigned ka[16], kb[16];
#pragma unroll
  for (int kt = 0; kt < 8; ++kt) {
    bf16x8 a0 = *(const bf16x8*)(keys + (kt * 16 + l15) * 64 + quad * 8);
    bf16x8 a1 = *(const bf16x8*)(keys + (kt * 16 + l15) * 64 + 32 + quad * 8);
    f32x4 z = (f32x4){0.f, 0.f, 0.f, 0.f};
    z = __builtin_amdgcn_mfma_f32_16x16x32_bf16(a0, b0, z, 0, 0, 0);
    z = __builtin_amdgcn_mfma_f32_16x16x32_bf16(a1, b1, z, 0, 0, 0);
#pragma unroll
    for (int r = 0; r < 4; ++r) {
      const unsigned key = (f2ord(z[r]) & ~127u) | (unsigned)(kt * 16 + quad * 4 + r);
      if (kt < 4) ka[kt * 4 + r] = key; else kb[(kt - 4) * 4 + r] = key;
    }
  }
  sort16_desc(ka);
  sort16_desc(kb);
#pragma unroll
  for (int i = 0; i < 16; ++i) out[i] = umax_(ka[i], kb[15 - i]);
  merge16_desc(out);
  xmerge16(out, 16);
  xmerge16(out, 32);
}

DEV void p8_route(const Params& p, int task, char* wsm) {
  static constexpr unsigned char kTab[52] = {
      0x00, 0x01, 0x02, 0x03, 0x04, 0x05, 0x06, 0x07, 0x08, 0x09, 0x0A, 0x0B, 0x0C, 0x0D, 0x0E, 0x0F,
      0x10, 0x11, 0x12, 0x13, 0x14, 0x15, 0x16, 0x17, 0x20, 0x21, 0x22, 0x23, 0x24, 0x30, 0x31, 0x32, 0x33,
      0x40, 0x41, 0x42, 0x50, 0x51, 0x60, 0x61, 0x70, 0x71, 0x80, 0x90, 0xA0, 0xB0, 0xC0, 0xD0, 0xE0, 0xF0, 0x00, 0x00};
  const int lane = threadIdx.x & 63, l15 = lane & 15, quad = lane >> 4;
  const int h = task & 7, tt = task >> 3;
  const int t0 = tt * 16;
  float* s1v = (float*)wsm;
  float* s2v = s1v + 256;
  int* i1 = (int*)(s2v + 256);
  int* i2 = i1 + 256;
  const u16* keys = (const u16*)(p.ws + OFF_KEYS) + (size_t)(h * 2) * 128 * 64;
  const u16* qp = (const u16*)(p.ws + OFF_QP) + (size_t)(t0 + l15) * 1024 + h * 128 + quad * 8;
  unsigned l1[16], l2[16];
  route_top16_of_128(keys, qp, l15, quad, l1);
  route_top16_of_128(keys + 128 * 64, qp + 64, l15, quad, l2);
  if (quad == 0) {
#pragma unroll
    for (int i = 0; i < 16; ++i) { s1v[l15 * 16 + i] = ord2f(l1[i] & ~127u); i1[l15 * 16 + i] = (int)(l1[i] & 127u); }
  } else if (quad == 1) {
#pragma unroll
    for (int i = 0; i < 16; ++i) { s2v[l15 * 16 + i] = ord2f(l2[i] & ~127u); i2[l15 * 16 + i] = (int)(l2[i] & 127u); }
  }
  __builtin_amdgcn_fence(__ATOMIC_RELEASE, "wavefront");
  __builtin_amdgcn_wave_barrier();
  __builtin_amdgcn_fence(__ATOMIC_ACQUIRE, "wavefront");
  unsigned ck[16];
#pragma unroll
  for (int s = 0; s < 16; ++s) {
    const int c = quad + 4 * s;
    unsigned key = 0u;
    if (s < 13 && c < 50) {
      const unsigned ab = kTab[c];
      const float val = s1v[l15 * 16 + (ab >> 4)] + s2v[l15 * 16 + (ab & 15)];
      key = (f2ord(val) & ~255u) | ab;
    }
    ck[s] = key;
  }
  sort16_desc(ck);
  xmerge16(ck, 16);
  xmerge16(ck, 32);
  if (quad == 0) {
    float e[16];
    const float vmax = ord2f(ck[0] & ~255u);
    float ssum = 0.f;
#pragma unroll
    for (int i = 0; i < 16; ++i) { e[i] = __expf(ord2f(ck[i] & ~255u) - vmax); ssum += e[i]; }
    const float inv = 1.f / ssum;
    int* ridx = (int*)(p.ws + OFF_RIDX) + (size_t)(t0 + l15) * 128 + h * 16;
    float* rw = (float*)(p.ws + OFF_RW) + (size_t)(t0 + l15) * 128 + h * 16;
#pragma unroll
    for (int i = 0; i < 16; i += 4) {
      int ee[4]; float ww[4];
#pragma unroll
      for (int j = 0; j < 4; ++j) {
        const unsigned ab = ck[i + j] & 255u;
        ee[j] = i1[l15 * 16 + (ab >> 4)] * 128 + i2[l15 * 16 + (ab & 15)];
        ww[j] = e[i + j] * inv;
      }
      *(int4*)(ridx + i) = make_int4(ee[0], ee[1], ee[2], ee[3]);
      *(float4*)(rw + i) = make_float4(ww[0], ww[1], ww[2], ww[3]);
    }
  }
  __builtin_amdgcn_fence(__ATOMIC_RELEASE, "wavefront");
  __builtin_amdgcn_wave_barrier();
}

DEV float gelu_tanh(float x) {
  const float u2 = 1.5957691216057308f * (x + 0.044715f * x * x * x);
  return x * __frcp_rn(1.f + __expf(-u2));
}

DEV void unpack8(const uint4& q, float* f) {
  f[0] = bflo(q.x); f[1] = bfhi(q.x); f[2] = bflo(q.y); f[3] = bfhi(q.y);
  f[4] = bflo(q.z); f[5] = bfhi(q.z); f[6] = bflo(q.w); f[7] = bfhi(q.w);
}

DEV float dpp_add(float v, const int ctrl_sel) {
  return v;
}
typedef __attribute__((ext_vector_type(2))) __bf16 bf2_t;
DEV float dot2bf(unsigned a, unsigned b, float c) {
  return __builtin_amdgcn_fdot2_f32_bf16(__builtin_bit_cast(bf2_t, a), __builtin_bit_cast(bf2_t, b), c, false);
}

DEV float reduce4_rows(float d0, float d1, float d2, float d3, int lane) {
  const bool up32 = (lane & 32) != 0, up16 = (lane & 16) != 0;
  float k0 = up32 ? d2 : d0, k1 = up32 ? d3 : d1;
  const float s0 = up32 ? d0 : d2, s1 = up32 ? d1 : d3;
  k0 += __shfl_xor(s0, 32);
  k1 += __shfl_xor(s1, 32);
  float kq = up16 ? k1 : k0;
  const float sq = up16 ? k0 : k1;
  kq += __shfl_xor(sq, 16);
  kq = DPP_ADD(kq, 0xB1);
  kq = DPP_ADD(kq, 0x4E);
  kq = DPP_ADD(kq, 0x141);
  kq = DPP_ADD(kq, 0x140);
  return kq;
}

DEV void p9_token(const Params& p, int t, int tnext, int lane, int2& e2n, float2& w2n, u32x4& han, u32x4& hbn) {
  const unsigned char* U8 = (const unsigned char*)(p.ws + OFF_UBF);
  const unsigned char* V8 = (const unsigned char*)(p.ws + OFF_VBF);
  const int2 e2 = e2n;
  const float2 w2 = w2n;
  const u32x4 ha = han, hb = hbn;
  {
    e2n = *(const int2*)((const int*)(p.ws + OFF_RIDX) + (size_t)tnext * 128 + 2 * lane);
    w2n = *(const float2*)((const float*)(p.ws + OFF_RW) + (size_t)tnext * 128 + 2 * lane);
    const u16* h2 = (const u16*)(p.ws + OFF_H2) + (size_t)tnext * 1024 + 16 * lane;
    han = *(const u32x4*)(h2);
    hbn = *(const u32x4*)(h2 + 8);
  }
  float hf[16];
  hf[0] = bflo(ha.x); hf[1] = bfhi(ha.x); hf[2] = bflo(ha.y); hf[3] = bfhi(ha.y);
  hf[4] = bflo(ha.z); hf[5] = bfhi(ha.z); hf[6] = bflo(ha.w); hf[7] = bfhi(ha.w);
  hf[8] = bflo(hb.x); hf[9] = bfhi(hb.x); hf[10] = bflo(hb.y); hf[11] = bfhi(hb.y);
  hf[12] = bflo(hb.z); hf[13] = bfhi(hb.z); hf[14] = bflo(hb.w); hf[15] = bfhi(hb.w);
  float o[16];
#pragma unroll
  for (int k = 0; k < 16; ++k) o[k] = 0.f;
#pragma unroll 1
  for (int g = 0; g < 128; g += 16) {
    u32x4 uu[16], vv[16];
    float wj[16];
#pragma unroll
    for (int j = 0; j < 16; ++j) {
      const int src = (g >> 1) + (j >> 1);
      const int ej = (j & 1) ? __builtin_amdgcn_readlane(e2.y, src) : __builtin_amdgcn_readlane(e2.x, src);
      wj[j] = __builtin_bit_cast(float, (j & 1) ? __builtin_amdgcn_readlane(__builtin_bit_cast(int, w2.y), src)
                                                : __builtin_amdgcn_readlane(__builtin_bit_cast(int, w2.x), src));
      const size_t ro = (size_t)ej * 1024 + 16 * lane;
      uu[j] = *(const u32x4*)(U8 + ro);
      vv[j] = *(const u32x4*)(V8 + ro);
    }
    float d[16];
#pragma unroll
    for (int j = 0; j < 16; ++j) {
      const f32x2 l0 = __builtin_amdgcn_cvt_pk_f32_fp8((int)uu[j].x, false), h0 = __builtin_amdgcn_cvt_pk_f32_fp8((int)uu[j].x, true);
      const f32x2 l1 = __builtin_amdgcn_cvt_pk_f32_fp8((int)uu[j].y, false), h1 = __builtin_amdgcn_cvt_pk_f32_fp8((int)uu[j].y, true);
      const f32x2 l2 = __builtin_amdgcn_cvt_pk_f32_fp8((int)uu[j].z, false), h2v = __builtin_amdgcn_cvt_pk_f32_fp8((int)uu[j].z, true);
      const f32x2 l3 = __builtin_amdgcn_cvt_pk_f32_fp8((int)uu[j].w, false), h3 = __builtin_amdgcn_cvt_pk_f32_fp8((int)uu[j].w, true);
      float a0 = l0.x * hf[0] + l0.y * hf[1], a1 = h0.x * hf[2] + h0.y * hf[3];
      a0 += l1.x * hf[4] + l1.y * hf[5]; a1 += h1.x * hf[6] + h1.y * hf[7];
      a0 += l2.x * hf[8] + l2.y * hf[9]; a1 += h2v.x * hf[10] + h2v.y * hf[11];
      a0 += l3.x * hf[12] + l3.y * hf[13]; a1 += h3.x * hf[14] + h3.y * hf[15];
      d[j] = a0 + a1;
    }
#pragma unroll
    for (int q = 0; q < 4; ++q) {
      const float dot = reduce4_rows(d[4 * q], d[4 * q + 1], d[4 * q + 2], d[4 * q + 3], lane);
      const float gl = gelu_tanh(dot * (1.f / 512.f)) * (1.f / 64.f);
#pragma unroll
      for (int i = 0; i < 4; ++i) {
        const int j = 4 * q + i;
        const float ci = wj[j] * __builtin_bit_cast(float, __builtin_amdgcn_readlane(__builtin_bit_cast(int, gl), 16 * i));
        f32x2 tq;
        tq = __builtin_amdgcn_cvt_pk_f32_fp8((int)vv[j].x, false); o[0] += ci * tq.x; o[1] += ci * tq.y;
        tq = __builtin_amdgcn_cvt_pk_f32_fp8((int)vv[j].x, true);  o[2] += ci * tq.x; o[3] += ci * tq.y;
        tq = __builtin_amdgcn_cvt_pk_f32_fp8((int)vv[j].y, false); o[4] += ci * tq.x; o[5] += ci * tq.y;
        tq = __builtin_amdgcn_cvt_pk_f32_fp8((int)vv[j].y, true);  o[6] += ci * tq.x; o[7] += ci * tq.y;
        tq = __builtin_amdgcn_cvt_pk_f32_fp8((int)vv[j].z, false); o[8] += ci * tq.x; o[9] += ci * tq.y;
        tq = __builtin_amdgcn_cvt_pk_f32_fp8((int)vv[j].z, true);  o[10] += ci * tq.x; o[11] += ci * tq.y;
        tq = __builtin_amdgcn_cvt_pk_f32_fp8((int)vv[j].w, false); o[12] += ci * tq.x; o[13] += ci * tq.y;
        tq = __builtin_amdgcn_cvt_pk_f32_fp8((int)vv[j].w, true);  o[14] += ci * tq.x; o[15] += ci * tq.y;
      }
    }
  }
  const int b = t >> 12;
  const float* mod = (const float*)(p.ws + OFF_MOD) + b * 6144 + 5120 + 16 * lane;
  float* xm = p.out + (size_t)t * 1024 + 16 * lane;
  float xo[16];
  float ss = 0.f;
#pragma unroll
  for (int q = 0; q < 4; ++q) {
    const float4 xv = *(const float4*)(xm + 4 * q);
    const float4 gv = *(const float4*)(mod + 4 * q);
    xo[4 * q + 0] = xv.x + gv.x * o[4 * q + 0];
    xo[4 * q + 1] = xv.y + gv.y * o[4 * q + 1];
    xo[4 * q + 2] = xv.z + gv.z * o[4 * q + 2];
    xo[4 * q + 3] = xv.w + gv.w * o[4 * q + 3];
  }
#pragma unroll
  for (int k = 0; k < 16; ++k) ss += xo[k] * xo[k];
  ss = wave_sum(ss);
  const float r = rsqrtf(ss * (1.f / 1024.f) + 1e-6f);
#pragma unroll
  for (int q = 0; q < 4; ++q) {
    const float4 fg = *(const float4*)(p.final_g + 16 * lane + 4 * q);
    *(float4*)(xm + 4 * q) = make_float4(xo[4 * q] * r * fg.x, xo[4 * q + 1] * r * fg.y, xo[4 * q + 2] * r * fg.z, xo[4 * q + 3] * r * fg.w);
  }
}

DEV void p9_experts4(const Params& p, int task, char* wsm) {
  const int lane = threadIdx.x & 63;
  const int t0 = task * 4;
  int* hist = (int*)wsm;
  unsigned* skey = (unsigned*)(wsm + 1024);
  float* swt = (float*)(wsm + 1024 + 2048);
  u16* sh2 = (u16*)(wsm + 1024 + 4096);
  hist[lane] = 0; hist[lane + 64] = 0; hist[lane + 128] = 0; hist[lane + 192] = 0;
  const int* ridx = (const int*)(p.ws + OFF_RIDX) + (size_t)t0 * 128 + lane * 8;
  const float* rw = (const float*)(p.ws + OFF_RW) + (size_t)t0 * 128 + lane * 8;
  int4 ea = *(const int4*)(ridx), eb = *(const int4*)(ridx + 4);
  float4 wa = *(const float4*)(rw), wb = *(const float4*)(rw + 4);
  int e[8] = {ea.x, ea.y, ea.z, ea.w, eb.x, eb.y, eb.z, eb.w};
  float w[8] = {wa.x, wa.y, wa.z, wa.w, wb.x, wb.y, wb.z, wb.w};
  {
    const u16* h2 = (const u16*)(p.ws + OFF_H2) + (size_t)t0 * 1024;
#pragma unroll
    for (int i = 0; i < 8; ++i) *(u32x4*)(sh2 + (lane + 64 * i) * 8) = *(const u32x4*)(h2 + (lane + 64 * i) * 8);
  }
  __builtin_amdgcn_fence(__ATOMIC_RELEASE, "wavefront");
  __builtin_amdgcn_wave_barrier();
  __builtin_amdgcn_fence(__ATOMIC_ACQUIRE, "wavefront");
  int rank[8];
#pragma unroll
  for (int j = 0; j < 8; ++j) rank[j] = atomicAdd(&hist[e[j] >> 6], 1);
  __builtin_amdgcn_fence(__ATOMIC_RELEASE, "wavefront");
  __builtin_amdgcn_wave_barrier();
  __builtin_amdgcn_fence(__ATOMIC_ACQUIRE, "wavefront");
  {
    const int c0 = hist[4 * lane], c1 = hist[4 * lane + 1], c2 = hist[4 * lane + 2], c3 = hist[4 * lane + 3];
    const int tot = c0 + c1 + c2 + c3;
    int x = tot;
#pragma unroll
    for (int o = 1; o < 64; o <<= 1) { const int y = __shfl_up(x, o); if (lane >= o) x += y; }
    const int base = x - tot;
    __builtin_amdgcn_fence(__ATOMIC_RELEASE, "wavefront");
    __builtin_amdgcn_wave_barrier();
    hist[4 * lane] = base; hist[4 * lane + 1] = base + c0; hist[4 * lane + 2] = base + c0 + c1; hist[4 * lane + 3] = base + c0 + c1 + c2;
  }
  __builtin_amdgcn_fence(__ATOMIC_RELEASE, "wavefront");
  __builtin_amdgcn_wave_barrier();
  __builtin_amdgcn_fence(__ATOMIC_ACQUIRE, "wavefront");
  {
    const unsigned slot = (unsigned)(lane >> 4);
#pragma unroll
    for (int j = 0; j < 8; ++j) {
      const int pos = hist[e[j] >> 6] + rank[j];
      skey[pos] = (unsigned)e[j] | (slot << 14);
      swt[pos] = w[j];
    }
  }
  __builtin_amdgcn_fence(__ATOMIC_RELEASE, "wavefront");
  __builtin_amdgcn_wave_barrier();
  __builtin_amdgcn_fence(__ATOMIC_ACQUIRE, "wavefront");

  float o0[16], o1[16], o2[16], o3[16];
#pragma unroll
  for (int k = 0; k < 16; ++k) { o0[k] = 0.f; o1[k] = 0.f; o2[k] = 0.f; o3[k] = 0.f; }
  const u16* U = (const u16*)(p.ws + OFF_UBF);
  const u16* V = (const u16*)(p.ws + OFF_VBF);
#define P9_LOAD(KK, UU, VV, BB)                                                           \
  _Pragma("unroll") for (int i = 0; i < 4; ++i) {                                         \
    KK[i] = (unsigned)__builtin_amdgcn_readfirstlane((int)skey[4 * (BB) + i]);            \
    const size_t ro = (size_t)(KK[i] & 16383u) * 1024 + 16 * lane;                        \
    UU[i] = *(const u32x4*)(U8 + ro);                                                     \
    VV[i] = *(const u32x4*)(V8 + ro);                                                     \
  }
#define P9_DOTS(KK, UU, BB, COEFV)                                                        \
  {                                                                                       \
    const float myw = swt[4 * (BB) + (lane >> 4)];                                        \
    float d[4];                                                                           \
    _Pragma("unroll") for (int i = 0; i < 4; ++i) {                                       \
      const unsigned slot = KK[i] >> 14;                                                  \
      const u32x4 ha = *(const u32x4*)(sh2 + slot * 1024 + 16 * lane);                    \
      const u32x4 hb = *(const u32x4*)(sh2 + slot * 1024 + 16 * lane + 8);                \
      float acc0 = 0.f, acc1 = 0.f;                                                       \
      {                                                                                   \
        f32x2 l0 = __builtin_amdgcn_cvt_pk_f32_fp8((int)UU[i].x, false), h0 = __builtin_amdgcn_cvt_pk_f32_fp8((int)UU[i].x, true); \
        f32x2 l1 = __builtin_amdgcn_cvt_pk_f32_fp8((int)UU[i].y, false), h1 = __builtin_amdgcn_cvt_pk_f32_fp8((int)UU[i].y, true); \
        f32x2 l2 = __builtin_amdgcn_cvt_pk_f32_fp8((int)UU[i].z, false), h2_ = __builtin_amdgcn_cvt_pk_f32_fp8((int)UU[i].z, true); \
        f32x2 l3 = __builtin_amdgcn_cvt_pk_f32_fp8((int)UU[i].w, false), h3 = __builtin_amdgcn_cvt_pk_f32_fp8((int)UU[i].w, true); \
        acc0 += l0.x * bflo(ha.x) + l0.y * bfhi(ha.x); acc1 += h0.x * bflo(ha.y) + h0.y * bfhi(ha.y);   \
        acc0 += l1.x * bflo(ha.z) + l1.y * bfhi(ha.z); acc1 += h1.x * bflo(ha.w) + h1.y * bfhi(ha.w);   \
        acc0 += l2.x * bflo(hb.x) + l2.y * bfhi(hb.x); acc1 += h2_.x * bflo(hb.y) + h2_.y * bfhi(hb.y); \
        acc0 += l3.x * bflo(hb.z) + l3.y * bfhi(hb.z); acc1 += h3.x * bflo(hb.w) + h3.y * bfhi(hb.w);   \
      }                                                                                   \
      d[i] = acc0 + acc1;                                                                 \
    }                                                                                     \
    const bool up32 = (lane & 32) != 0, up16 = (lane & 16) != 0;                          \
    float k0 = up32 ? d[2] : d[0], k1 = up32 ? d[3] : d[1];                               \
    float s0 = up32 ? d[0] : d[2], s1 = up32 ? d[1] : d[3];                               \
    k0 += __shfl_xor(s0, 32);                                                             \
    k1 += __shfl_xor(s1, 32);                                                             \
    float kq = up16 ? k1 : k0, sq = up16 ? k0 : k1;                                       \
    kq += __shfl_xor(sq, 16);                                                             \
    kq = DPP_ADD(kq, 0xB1);                                                               \
    kq = DPP_ADD(kq, 0x4E);                                                               \
    kq = DPP_ADD(kq, 0x141);                                                              \
    kq = DPP_ADD(kq, 0x140);                                                              \
    COEFV = myw * (1.f / 64.f) * gelu_tanh(kq * (1.f / 512.f));                           \
  }
#define P9_ACCUM(KK, VV, COEFV)                                                           \
  _Pragma("unroll") for (int i = 0; i < 4; ++i) {                                         \
    const float ci = __builtin_bit_cast(float, __builtin_amdgcn_readlane(__builtin_bit_cast(int, COEFV), 16 * i)); \
    const unsigned slot = KK[i] >> 14;                                                    \
    float vf[16];                                                                         \
    {                                                                                     \
      f32x2 t;                                                                            \
      t = __builtin_amdgcn_cvt_pk_f32_fp8((int)VV[i].x, false); vf[0] = t.x; vf[1] = t.y;   \
      t = __builtin_amdgcn_cvt_pk_f32_fp8((int)VV[i].x, true);  vf[2] = t.x; vf[3] = t.y;   \
      t = __builtin_amdgcn_cvt_pk_f32_fp8((int)VV[i].y, false); vf[4] = t.x; vf[5] = t.y;   \
      t = __builtin_amdgcn_cvt_pk_f32_fp8((int)VV[i].y, true);  vf[6] = t.x; vf[7] = t.y;   \
      t = __builtin_amdgcn_cvt_pk_f32_fp8((int)VV[i].z, false); vf[8] = t.x; vf[9] = t.y;   \
      t = __builtin_amdgcn_cvt_pk_f32_fp8((int)VV[i].z, true);  vf[10] = t.x; vf[11] = t.y; \
      t = __builtin_amdgcn_cvt_pk_f32_fp8((int)VV[i].w, false); vf[12] = t.x; vf[13] = t.y; \
      t = __builtin_amdgcn_cvt_pk_f32_fp8((int)VV[i].w, true);  vf[14] = t.x; vf[15] = t.y; \
    }                                                                                     \
    if (slot == 0) { _Pragma("unroll") for (int k = 0; k < 16; ++k) o0[k] += ci * vf[k]; }       \
    else if (slot == 1) { _Pragma("unroll") for (int k = 0; k < 16; ++k) o1[k] += ci * vf[k]; }  \
    else if (slot == 2) { _Pragma("unroll") for (int k = 0; k < 16; ++k) o2[k] += ci * vf[k]; }  \
    else { _Pragma("unroll") for (int k = 0; k < 16; ++k) o3[k] += ci * vf[k]; }                 \
  }
  {
    const unsigned char* U8 = (const unsigned char*)(p.ws + OFF_UBF);
    const unsigned char* V8 = (const unsigned char*)(p.ws + OFF_VBF);
    unsigned kkA[4], kkB[4];
    u32x4 uA[4], vA[4], uB[4], vB[4];
    float cfA, cfB;
    P9_LOAD(kkA, uA, vA, 0)
#pragma unroll 1
    for (int bb = 0; bb < 128; bb += 2) {
      P9_LOAD(kkB, uB, vB, bb + 1)
      P9_DOTS(kkA, uA, bb, cfA)
      P9_ACCUM(kkA, vA, cfA)
      const int n0 = (bb + 2 < 128) ? (bb + 2) : 0;
      P9_LOAD(kkA, uA, vA, n0)
      P9_DOTS(kkB, uB, bb + 1, cfB)
      P9_ACCUM(kkB, vB, cfB)
    }
  }
#pragma unroll
  for (int s = 0; s < 4; ++s) {
    const int t = t0 + s;
    const int b = t >> 12;
    const float* mod = (const float*)(p.ws + OFF_MOD) + b * 6144 + 5120 + 16 * lane;
    float* xm = p.out + (size_t)t * 1024 + 16 * lane;
    const float* oo = (s == 0) ? o0 : ((s == 1) ? o1 : ((s == 2) ? o2 : o3));
    float xo[16];
    float ss = 0.f;
#pragma unroll
    for (int q = 0; q < 4; ++q) {
      const float4 xv = *(const float4*)(xm + 4 * q);
      const float4 gv = *(const float4*)(mod + 4 * q);
      xo[4 * q + 0] = xv.x + gv.x * oo[4 * q + 0];
      xo[4 * q + 1] = xv.y + gv.y * oo[4 * q + 1];
      xo[4 * q + 2] = xv.z + gv.z * oo[4 * q + 2];
      xo[4 * q + 3] = xv.w + gv.w * oo[4 * q + 3];
    }
#pragma unroll
    for (int k = 0; k < 16; ++k) ss += xo[k] * xo[k];
    ss = wave_sum(ss);
    const float r = rsqrtf(ss * (1.f / 1024.f) + 1e-6f);
#pragma unroll
    for (int q = 0; q < 4; ++q) {
      const float4 fg = *(const float4*)(p.final_g + 16 * lane + 4 * q);
      *(float4*)(xm + 4 * q) = make_float4(xo[4 * q] * r * fg.x, xo[4 * q + 1] * r * fg.y, xo[4 * q + 2] * r * fg.z, xo[4 * q + 3] * r * fg.w);
    }
  }
  __builtin_amdgcn_fence(__ATOMIC_RELEASE, "wavefront");
  __builtin_amdgcn_wave_barrier();
}

#define XB_TMO      128
#define XB_XCNT(j)  (256  + 64 * (j))
#define XB_XSUB(j)  (1280 + 64 * (j))
#define XB_XGEN(j)  (2304 + 64 * (j))
#define XB_TOP      3328
#define XB_TOPGEN   3392
#define XCD_BAR_WORDS 3456
#define XB_SPIN_CAP (1u << 18)
#define LAS __attribute__((address_space(3)))

__device__ __forceinline__ unsigned xb_ld(unsigned* p)              { return __hip_atomic_load(p, __ATOMIC_RELAXED, __HIP_MEMORY_SCOPE_AGENT); }
__device__ __forceinline__ unsigned xb_add(unsigned* p, unsigned v) { return __hip_atomic_fetch_add(p, v, __ATOMIC_RELAXED, __HIP_MEMORY_SCOPE_AGENT); }
__device__ __forceinline__ unsigned xb_xcc_id() { return (unsigned)__builtin_amdgcn_s_getreg((3 << 11) | 20) & 0xFu; }
#define XB_SPIN(cond, bar) do { unsigned _sp = 0; while (cond) { __builtin_amdgcn_s_sleep(1); \
    if ((++_sp & 255u) == 0u) { if (xb_ld(&(bar)[XB_TMO])) break; if (_sp > XB_SPIN_CAP) { atomicAdd(&(bar)[XB_TMO], 1u); break; } } } } while (0)

struct XcdBarrier {
    unsigned* bar; unsigned x;
    volatile LAS unsigned* st;
};

__device__ __forceinline__ XcdBarrier xcd_barrier_post(unsigned* bar, volatile LAS unsigned* st) {
    XcdBarrier b; b.bar = bar; b.x = xb_xcc_id(); b.st = st;
    if (threadIdx.x == 0) (void)xb_add(&bar[XB_XCNT(b.x)], 1u);
    return b;
}
__device__ __forceinline__ void xcd_barrier_complete(unsigned* bar, unsigned x, unsigned& nloc, unsigned& nx) {
    const unsigned G = gridDim.x * gridDim.y * gridDim.z;
    unsigned sum, cnt, mine, sp = 0u;
    for (;;) {
        sum = 0u; cnt = 0u; mine = 0u;
#pragma unroll
        for (unsigned j = 0; j < 16; ++j) { const unsigned c = xb_ld(&bar[XB_XCNT(j)]); sum += c; cnt += (c > 0u) ? 1u : 0u; mine = (j == x) ? c : mine; }
        if (sum == G) break;
        __builtin_amdgcn_s_sleep(1);
        if ((++sp & 255u) == 0u) { if (xb_ld(&bar[XB_TMO])) break; if (sp > XB_SPIN_CAP) { atomicAdd(&bar[XB_TMO], 1u); break; } }
    }
    nloc = mine > 0u ? mine : 1u; nx = cnt > 0u ? cnt : 1u;
}

__device__ __forceinline__ void xcd_barrier(const XcdBarrier& b) {
    asm volatile("s_waitcnt vmcnt(0)" ::: "memory");
    __syncthreads();
    if (threadIdx.x == 0) {
        unsigned* bar = b.bar;
        __builtin_amdgcn_s_waitcnt(0);
        unsigned nloc = b.st[0], nx = b.st[1];
        if (nloc == 0u) { xcd_barrier_complete(bar, b.x, nloc, nx); b.st[0] = nloc; b.st[1] = nx; }
        const unsigned old = xb_add(&bar[XB_XSUB(b.x)], 1u);
        const unsigned gen = old / nloc;
        if (old + 1u == (gen + 1u) * nloc) {
            __builtin_amdgcn_fence(__ATOMIC_RELEASE, "agent");
            asm volatile("s_waitcnt vmcnt(0)" ::: "memory");
            const unsigned og = xb_add(&bar[XB_TOP], 1u);
            const unsigned tg = og / nx;
            if (og + 1u == (tg + 1u) * nx) xb_add(&bar[XB_TOPGEN], 1u);
            else XB_SPIN(xb_ld(&bar[XB_TOPGEN]) == tg, bar);
            __builtin_amdgcn_fence(__ATOMIC_ACQUIRE, "agent");
            xb_add(&bar[XB_XGEN(b.x)], 1u);
            asm volatile("s_waitcnt vmcnt(0)" ::: "memory");
        } else {
            XB_SPIN(xb_ld(&bar[XB_XGEN(b.x)]) == gen, bar);
            __builtin_amdgcn_fence(__ATOMIC_ACQUIRE, "agent");
            asm volatile("s_waitcnt vmcnt(0)" ::: "memory");
        }
    }
    __syncthreads();
}


__global__ void __launch_bounds__(256, 2) mega(Params p) {
  extern __shared__ __attribute__((aligned(16))) char smem[];
  cg::grid_group grid = cg::this_grid();
  const int tid = threadIdx.x, lane = tid & 63, wave = tid >> 6;
  const int nb = gridDim.x, bid = blockIdx.x;
  float* smf = (float*)smem;
  if (p.ws == nullptr) grid.sync();
  volatile LAS unsigned* xst = (volatile LAS unsigned*)(smem + SMEM_XB);
  if (tid == 0) { xst[0] = 0u; xst[1] = 0u; }
  __syncthreads();
  const XcdBarrier xb = xcd_barrier_post((unsigned*)(p.ws + OFF_BAR), xst);
  u16* sA = (u16*)smem;
  u16* sB = (u16*)(smem + 128 * 64 * 2);

  for (int rep_ = 0; rep_ < NREP(0); ++rep_) if (PHON(0)) {
    const int N_MOD = 384, N_TIN = 16 * 68, N_TOA = 8 * 16, N_TOH = 8 * 16, N_TOUT = 16 * 16, N_TQ = 16 * 16, N_HID = 1024;
    const int total = N_MOD + N_TIN + N_TOA + N_TOH + N_TOUT + N_TQ + N_HID + 16 + 1;
    for (int it = bid; it < total; it += nb) {
      int i = it;
      if (i < N_MOD) { p0_mod(p, i, smf); continue; }
      i -= N_MOD;
      if (i < N_TIN) { transpose_tile(p.w_in, INW, 1024, (u16*)(p.ws + OFF_WIN), i, smf); continue; }
      i -= N_TIN;
      if (i < N_TOA) { transpose_tile(p.w_o_attn, 1024, 512, (u16*)(p.ws + OFF_WOA), i, smf); continue; }
      i -= N_TOA;
      if (i < N_TOH) { transpose_tile(p.w_o_hy, 1024, 512, (u16*)(p.ws + OFF_WOH), i, smf); continue; }
      i -= N_TOH;
      if (i < N_TOUT) { transpose_tile(p.w_out, 1024, 1024, (u16*)(p.ws + OFF_WOUT), i, smf); continue; }
      i -= N_TOUT;
      if (i < N_TQ) { transpose_tile(p.peer_wq, 1024, 1024, (u16*)(p.ws + OFF_WQ), i, smf); continue; }
      i -= N_TQ;
      if (i < N_HID) { p0_hidden(p, i, smf); continue; }
      i -= N_HID;
      if (i < 16) { transpose_tile(p.hy_fw3, 1024, 64, (u16*)(p.ws + OFF_H2F + 512 * 1024), i, smf); continue; }
      float2* rope = (float2*)(p.ws + OFF_ROPE);
      for (int idx = tid; idx < 1024; idx += 256) {
        const int pos = idx >> 4, f = idx & 15;
        const float inv = powf(10000.f, -(float)f / 16.f);
        const float ang = (float)pos * inv;
        rope[idx] = make_float2(cosf(ang), sinf(ang));
      }
    }
    convert_flat(p.peer_keys, (u16*)(p.ws + OFF_KEYS), (size_t)131072);
    convert_flat_fp8(p.peer_u, (unsigned char*)(p.ws + OFF_UBF), (size_t)16384 * 1024, 512.f);
    convert_flat_fp8(p.peer_v, (unsigned char*)(p.ws + OFF_VBF), (size_t)16384 * 1024, 64.f);
  }
  xcd_barrier(xb);

  for (int rep_ = 0; rep_ < NREP(1); ++rep_) if (PHON(1)) {
    const float* mod = (const float*)(p.ws + OFF_MOD);
    const int nrows = T_TOK + 1024;
    for (int r = bid * 4 + wave; r < nrows; r += nb * 4) {
      if (r < T_TOK) {
        const int b = r >> 12;
        norm_row(p.x + (size_t)r * 1024, p.norm1_g, mod + b * 6144, mod + b * 6144 + 1024,
                 (u16*)((char*)p.out + OO_H1) + (size_t)r * 1024, lane);
      } else {
        const int rc = r - T_TOK;
        norm_row(p.ctx + (size_t)rc * 1024, p.norm1_g, mod + 4 * 6144, mod + 4 * 6144 + 1024,
                 (u16*)((char*)p.out + OO_HC) + (size_t)rc * 1024, lane);
      }
    }
    for (int it = bid; it < 256; it += nb) p1_filter_tile(p, (it + 256 < nb) ? it : it, sA, sB);
  }
  xcd_barrier(xb);

  for (int rep_ = 0; rep_ < NREP(2); ++rep_) if (PHON(2)) {
    if (nb == 512) {
      const int xg = bid & 7, slot = bid >> 3;
      for (int r = 0; r < 8; ++r) {
        const int sup = r * 8 + xg;
        const int mt = (sup >> 2) * 8 + (slot >> 3), nt = (sup & 3) * 8 + (slot & 7);
        p2_inproj(p, mt * 34 + nt, sA, sB);
      }
      if (bid < 256) p2_inproj(p, (bid >> 1) * 34 + 32 + (bid & 1), sA, sB);
      else if (bid < 272) p2_ctxkv(p, bid - 256, sA, sB);
    } else {
      const int total = 128 * 34 + 16;
      for (int it = bid; it < total; it += nb) {
        if (it < 128 * 34) p2_inproj(p, it, sA, sB);
        else p2_ctxkv(p, it - 128 * 34, sA, sB);
      }
    }
  }
  xcd_barrier(xb);

  for (int rep_ = 0; rep_ < NREP(3); ++rep_) if (PHON(3)) {
    const int total = 1024 + 2048;
    for (int it = bid; it < total; it += nb) {
      if (it < 1024) p3_attn(p, it, (u16*)smem, (u16*)(smem + 128 * 72 * 2));
      else p3_hypre(p, it - 1024, (u16*)smem);
    }
  }
  xcd_barrier(xb);

  for (int rep_ = 0; rep_ < NREP(4); ++rep_) if (PHON(4)) for (int it = bid; it < 512; it += nb) p3_toeplitz(p, it, smem);
  xcd_barrier(xb);

  for (int rep_ = 0; rep_ < NREP(5); ++rep_) if (PHON(5)) for (int it = bid; it < 1024; it += nb) p4_merge(p, (nb == 512) ? ((((it >> 9) * 8 + (bid & 7)) * 8 + (bid >> 6)) * 8 + ((bid >> 3) & 7)) : it, sA, sB);
  xcd_barrier(xb);

  for (int rep_ = 0; rep_ < NREP(6); ++rep_) if (PHON(6)) for (int it = bid; it < 1024; it += nb) p5_out(p, (nb == 512) ? ((((it >> 9) * 8 + (bid & 7)) * 8 + (bid >> 6)) * 8 + ((bid >> 3) & 7)) : it, sA, sB);
  xcd_barrier(xb);

  for (int rep_ = 0; rep_ < NREP(7); ++rep_) if (PHON(7)) {
    const float* mod = (const float*)(p.ws + OFF_MOD);
    for (int r = bid * 4 + wave; r < T_TOK; r += nb * 4) {
      const int b = r >> 12;
      norm_row(p.out + (size_t)r * 1024, p.norm2_g, mod + b * 6144 + 3072, mod + b * 6144 + 4096,
               (u16*)(p.ws + OFF_H2) + (size_t)r * 1024, lane);
    }
  }
  xcd_barrier(xb);

  for (int rep_ = 0; rep_ < NREP(8); ++rep_) if (PHON(8)) for (int it = bid; it < 1024; it += nb) p7_qp(p, (nb == 512) ? ((((it >> 9) * 8 + (bid & 7)) * 8 + (bid >> 6)) * 8 + ((bid >> 3) & 7)) : it, sA, sB);
  xcd_barrier(xb);

  for (int rep_ = 0; rep_ < NREP(9); ++rep_) if (PHON(9)) for (int it = bid * 4 + wave; it < 8192; it += nb * 4) p8_route(p, it, smem + wave * 4096);
  xcd_barrier(xb);

  if (PHON(10)) {
    const int nw = nb * 4;
    int t = bid * 4 + wave;
    if (t < T_TOK) {
      int2 e2n = *(const int2*)((const int*)(p.ws + OFF_RIDX) + (size_t)t * 128 + 2 * lane);
      float2 w2n = *(const float2*)((const float*)(p.ws + OFF_RW) + (size_t)t * 128 + 2 * lane);
      u32x4 han = *(const u32x4*)((const u16*)(p.ws + OFF_H2) + (size_t)t * 1024 + 16 * lane);
      u32x4 hbn = *(const u32x4*)((const u16*)(p.ws + OFF_H2) + (size_t)t * 1024 + 16 * lane + 8);
      for (; t < T_TOK; t += nw) {
        const int tn = (t + nw < T_TOK) ? (t + nw) : t;
        p9_token(p, t, tn, lane, e2n, w2n, han, hbn);
      }
    }
  }
}

extern "C" void kernel_launch(void* const* d_in, const int* in_sizes, int n_in, void* d_out, int out_size,
                              void* d_ws, size_t ws_size, hipStream_t stream) {
  static int grid_blocks = 0;
  if (!grid_blocks) {
    int dev = 0, cus = 0, per_cu = 0;
    (void)hipGetDevice(&dev);
    (void)hipDeviceGetAttribute(&cus, hipDeviceAttributeMultiprocessorCount, dev);
    (void)hipFuncSetAttribute((const void*)mega, hipFuncAttributeMaxDynamicSharedMemorySize, SMEM_BYTES);
    (void)hipOccupancyMaxActiveBlocksPerMultiprocessor(&per_cu, mega, 256, SMEM_BYTES);
    if (per_cu > 2) per_cu = 2;
    if (per_cu < 1) per_cu = 1;
    grid_blocks = cus * per_cu;
  }
  Params p{};
  const float** pp = (const float**)&p;
  for (int i = 0; i < 28; ++i) pp[i] = (const float*)d_in[i];
  p.out = (float*)d_out;
  p.ws = (char*)d_ws;
  (void)hipMemsetAsync((char*)d_ws, 0, OFF_BAR + 24576, stream);
  void* args[] = {&p};
  hipError_t e = hipLaunchCooperativeKernel((void*)mega, dim3(grid_blocks), dim3(256), args, SMEM_BYTES, stream);
  if (e != hipSuccess) fprintf(stderr, "cooperative launch failed: %s (grid %d)\n", hipGetErrorString(e), grid_blocks);
}
```

```cpp
#include <hip/hip_runtime.h>
#include <hip/hip_bf16.h>
#include <hip/hip_cooperative_groups.h>
#include <cstdio>
namespace cg = cooperative_groups;

typedef unsigned short u16;
typedef __attribute__((ext_vector_type(8))) short bf16x8;
typedef __attribute__((ext_vector_type(4))) float f32x4;
typedef __attribute__((ext_vector_type(4))) unsigned u32x4;

#define DEV __device__ __forceinline__
#ifndef PH
#define PH -1
#endif
#define PHON(n) (PH < 0 || PH == (n))
#ifndef REP
#define REP -1
#endif
#define NREP(n) ((REP == (n)) ? 2 : 1)

constexpr int T_TOK = 16384;
constexpr int DM = 1024;
constexpr int SEQL = 4096;
constexpr int INW = 4352;

struct Params {
  const float *x, *c, *ctx, *c_ctx, *w_mod, *b_mod, *norm1_g, *w_in, *attn_sink, *hy_conv_w, *hy_conv_b,
      *hy_fw1, *hy_fb1, *hy_fw2, *hy_fb2, *hy_fw3, *hy_fb3, *hy_freq, *hy_skip, *w_o_attn, *w_o_hy, *w_out,
      *norm2_g, *peer_wq, *peer_keys, *peer_u, *peer_v, *final_g;
  float* out;
  char* ws;
};

constexpr size_t MB = 1u << 20;
constexpr size_t OFF_MOD = 0;
constexpr size_t OFF_ROPE = 128 * 1024;
constexpr size_t OFF_NINV = OFF_ROPE + 8192;
constexpr size_t OFF_H2F = 256 * 1024;
constexpr size_t OFF_WIN = OFF_H2F + MB;
constexpr size_t OFF_WOA = OFF_WIN + 9 * MB;
constexpr size_t OFF_WOH = OFF_WOA + MB;
constexpr size_t OFF_WOUT = OFF_WOH + MB;
constexpr size_t OFF_WQ = OFF_WOUT + 2 * MB;
constexpr size_t OFF_KEYS = OFF_WQ + 2 * MB;
constexpr size_t OFF_UBF = OFF_KEYS + MB;
constexpr size_t OFF_VBF = OFF_UBF + 32 * MB;
constexpr size_t OFF_Q = OFF_VBF + 32 * MB;
constexpr size_t OFF_K = OFF_Q + 16 * MB;
constexpr size_t OFF_VT = OFF_K + 4 * MB;
constexpr size_t OFF_KC = OFF_VT + 4 * MB;
constexpr size_t OFF_VCT = OFF_KC + MB / 2;
constexpr size_t OFF_Z = OFF_VCT + MB / 2;
constexpr size_t OFF_GATE = OFF_Z + 48 * MB;
constexpr size_t OFF_YATT = OFF_GATE + 64 * MB;
constexpr size_t OFF_YHY = OFF_YATT + 16 * MB;
constexpr size_t OFF_RIDX = OFF_Q;
constexpr size_t OFF_RW = OFF_Q + 8 * MB;
constexpr size_t OFF_MERGED = OFF_Z;
constexpr size_t OFF_H2 = OFF_GATE;
constexpr size_t OFF_QP = OFF_GATE + 32 * MB;
constexpr size_t OO_H1 = 0;
constexpr size_t OO_UT = 0;
constexpr size_t OO_X0T = 16 * MB;
constexpr size_t OO_HC = 32 * MB;
constexpr size_t OO_G = 34 * MB;

constexpr int SMEM_BYTES = 70144;
constexpr size_t OFF_BAR = 160 * 1024;
constexpr int SMEM_XB = 70016;

DEV u16 f2bf(float f) {
  unsigned u = __float_as_uint(f);
  u += 0x7fffu + ((u >> 16) & 1u);
  return (u16)(u >> 16);
}
DEV float bf2f(u16 h) { return __uint_as_float(((unsigned)h) << 16); }
DEV unsigned pack2(float a, float b) { return (unsigned)f2bf(a) | ((unsigned)f2bf(b) << 16); }
DEV float bflo(unsigned w) { return __uint_as_float(w << 16); }
DEV float bfhi(unsigned w) { return __uint_as_float(w & 0xffff0000u); }
#define DPP_ADD(v, ctrl) ((v) + __builtin_bit_cast(float, __builtin_amdgcn_update_dpp(0, __builtin_bit_cast(int, (v)), (ctrl), 0xF, 0xF, true)))
DEV float wave_sum(float v) {
#pragma unroll
  for (int o = 32; o > 0; o >>= 1) v += __shfl_xor(v, o);
  return v;
}
DEV float wave_max(float v) {
#pragma unroll
  for (int o = 32; o > 0; o >>= 1) v = fmaxf(v, __shfl_xor(v, o));
  return v;
}

DEV void p0_mod(const Params& p, int item, float* sm) {
  const int tid = threadIdx.x;
  const int cblk = item >> 2, kq = item & 3;
  for (int i = tid; i < 5 * 256; i += 256) {
    const int r = i >> 8, k = kq * 256 + (i & 255);
    const float c = (r < 4) ? p.c[r * 1024 + k] : p.c_ctx[k];
    sm[i] = c / (1.f + expf(-c));
  }
  __syncthreads();
  const int col = cblk * 64 + (tid & 63), sub = tid >> 6;
  float a0 = 0, a1 = 0, a2 = 0, a3 = 0, a4 = 0;
  const float* wp = p.w_mod + (size_t)(kq * 256 + sub * 64) * 6144 + col;
#pragma unroll 16
  for (int k = 0; k < 64; ++k) {
    const float w = wp[(size_t)k * 6144];
    const int kk = sub * 64 + k;
    a0 += sm[kk] * w; a1 += sm[256 + kk] * w; a2 += sm[512 + kk] * w; a3 += sm[768 + kk] * w; a4 += sm[1024 + kk] * w;
  }
  float* red = sm + 5 * 256;
  red[(sub * 5 + 0) * 64 + (tid & 63)] = a0;
  red[(sub * 5 + 1) * 64 + (tid & 63)] = a1;
  red[(sub * 5 + 2) * 64 + (tid & 63)] = a2;
  red[(sub * 5 + 3) * 64 + (tid & 63)] = a3;
  red[(sub * 5 + 4) * 64 + (tid & 63)] = a4;
  __syncthreads();
  float* mod = (float*)(p.ws + OFF_MOD);
  for (int i = tid; i < 320; i += 256) {
    const int r = i >> 6, cc = i & 63;
    float sacc = red[(0 * 5 + r) * 64 + cc] + red[(1 * 5 + r) * 64 + cc] + red[(2 * 5 + r) * 64 + cc] + red[(3 * 5 + r) * 64 + cc];
    if (kq == 0) sacc += p.b_mod[cblk * 64 + cc];
    atomicAdd(mod + r * 6144 + cblk * 64 + cc, sacc);
  }
  __syncthreads();
}

DEV void transpose_tile(const float* __restrict__ src, int N, int K, u16* __restrict__ dst, int tile, float* sm) {
  const int tid = threadIdx.x;
  const int nkt = K >> 6;
  const int kt = tile % nkt, nt = tile / nkt;
  const int k0 = kt * 64, n0 = nt * 64;
  const int c4 = tid & 15, r = tid >> 4;
  float4 tv[4];
#pragma unroll
  for (int rr = 0; rr < 4; ++rr) tv[rr] = *(const float4*)(src + (size_t)(k0 + rr * 16 + r) * N + n0 + c4 * 4);
#pragma unroll
  for (int rr = 0; rr < 4; ++rr) {
    float* d0 = sm + (rr * 16 + r) * 65 + c4 * 4;
    d0[0] = tv[rr].x; d0[1] = tv[rr].y; d0[2] = tv[rr].z; d0[3] = tv[rr].w;
  }
  __syncthreads();
  const int nn = tid >> 2, part = tid & 3;
  unsigned w[8];
#pragma unroll
  for (int j = 0; j < 8; ++j) w[j] = pack2(sm[(part * 16 + 2 * j) * 65 + nn], sm[(part * 16 + 2 * j + 1) * 65 + nn]);
  uint4* d = (uint4*)(dst + (size_t)(n0 + nn) * K + k0 + part * 16);
  d[0] = make_uint4(w[0], w[1], w[2], w[3]);
  d[1] = make_uint4(w[4], w[5], w[6], w[7]);
  __syncthreads();
}

DEV void p0_hidden(const Params& p, int item, float* sm) {
  const int tid = threadIdx.x;
  float* z = sm;
  float* h1 = sm + 4 * 36;
  if (tid < 4 * 33) {
    int tt = tid / 33, i = tid % 33;
    int t = item * 4 + tt;
    float v;
    if (i == 0) v = (float)t * (1.f / 4096.f);
    else {
      int band = (i <= 16) ? i : (i - 16);
      float fr = (float)((t * band) & 4095) * (1.f / 4096.f);
      v = (i <= 16) ? cospif(2.f * fr) : sinpif(2.f * fr);
    }
    z[tt * 36 + i] = v;
  }
  __syncthreads();
  const int tt = tid >> 6, j = tid & 63;
  float a = p.hy_fb1[j];
  for (int i = 0; i < 33; ++i) a += z[tt * 36 + i] * p.hy_fw1[i * 64 + j];
  const float fq = p.hy_freq[j];
  h1[tt * 64 + j] = sinf(fq * a);
  __syncthreads();
  float b = p.hy_fb2[j];
  for (int i = 0; i < 64; ++i) b += h1[tt * 64 + i] * p.hy_fw2[i * 64 + j];
  ((u16*)(p.ws + OFF_H2F))[(item * 4 + tt) * 64 + j] = f2bf(sinf(fq * b));
  __syncthreads();
}

DEV void convert_flat(const float* __restrict__ src, u16* __restrict__ dst, size_t n) {
  size_t stride = (size_t)gridDim.x * 256 * 8;
  for (size_t i = ((size_t)blockIdx.x * 256 + threadIdx.x) * 8; i < n; i += stride) {
    float4 a = *(const float4*)(src + i);
    float4 b = *(const float4*)(src + i + 4);
    *(uint4*)(dst + i) = make_uint4(pack2(a.x, a.y), pack2(a.z, a.w), pack2(b.x, b.y), pack2(b.z, b.w));
  }
}

typedef __attribute__((ext_vector_type(2))) float f32x2;
DEV void convert_flat_fp8(const float* __restrict__ src, unsigned char* __restrict__ dst, size_t n, float scale) {
  const size_t q4 = (size_t)gridDim.x * 256 * 16;
  const size_t stride = q4 * 4;
  for (size_t i = ((size_t)blockIdx.x * 256 + threadIdx.x) * 16; i < n; i += stride) {
    float4 a[16];
#pragma unroll
    for (int c = 0; c < 4; ++c) {
      const size_t off = i + c * q4;
      if (off < n) {
#pragma unroll
        for (int q = 0; q < 4; ++q) a[c * 4 + q] = *(const float4*)(src + off + 4 * q);
      }
    }
#pragma unroll
    for (int c = 0; c < 4; ++c) {
      const size_t off = i + c * q4;
      if (off < n) {
        unsigned w[4];
#pragma unroll
        for (int q = 0; q < 4; ++q) {
          int v = 0;
          v = __builtin_amdgcn_cvt_pk_fp8_f32(a[c * 4 + q].x * scale, a[c * 4 + q].y * scale, v, false);
          v = __builtin_amdgcn_cvt_pk_fp8_f32(a[c * 4 + q].z * scale, a[c * 4 + q].w * scale, v, true);
          w[q] = (unsigned)v;
        }
        *(uint4*)(dst + off) = make_uint4(w[0], w[1], w[2], w[3]);
      }
    }
  }
}

DEV void norm_row(const float* __restrict__ xr, const float* __restrict__ g, const float* __restrict__ sh,
                  const float* __restrict__ sc, u16* __restrict__ dst, int lane) {
  float4 v[4];
  float ss = 0.f;
#pragma unroll
  for (int i = 0; i < 4; ++i) {
    v[i] = ((const float4*)xr)[lane + 64 * i];
    ss += v[i].x * v[i].x + v[i].y * v[i].y + v[i].z * v[i].z + v[i].w * v[i].w;
  }
  ss = wave_sum(ss);
  const float r = rsqrtf(ss * (1.f / 1024.f) + 1e-6f);
#pragma unroll
  for (int i = 0; i < 4; ++i) {
    const int idx = lane + 64 * i;
    float4 gg = ((const float4*)g)[idx], s1 = ((const float4*)sh)[idx], s2 = ((const float4*)sc)[idx];
    float y0 = v[i].x * r * gg.x * (1.f + s2.x) + s1.x;
    float y1 = v[i].y * r * gg.y * (1.f + s2.y) + s1.y;
    float y2 = v[i].z * r * gg.z * (1.f + s2.z) + s1.z;
    float y3 = v[i].w * r * gg.w * (1.f + s2.w) + s1.w;
    *(uint2*)(dst + idx * 4) = make_uint2(pack2(y0, y1), pack2(y2, y3));
  }
}

DEV void p1_filter(const Params& p, int item, float* sm) {
  const int tid = threadIdx.x;
  const int c0 = (item >> 2) * 4, tq = item & 3;
  float* wc = sm;
  float* red = sm + 512;
  for (int i = tid; i < 512; i += 256) {
    const int j = i >> 6, k = i & 63;
    wc[i] = p.hy_fw3[k * 1024 + ((j < 4) ? (c0 + j) : (512 + c0 + j - 4))];
  }
  __syncthreads();
  float fb[8], dl[4];
#pragma unroll
  for (int j = 0; j < 8; ++j) fb[j] = p.hy_fb3[(j < 4) ? (c0 + j) : (512 + c0 + j - 4)];
  const float da = logf(1e-2f) / 1.5f, db = logf(1e-2f) / 0.3f;
#pragma unroll
  for (int j = 0; j < 4; ++j) dl[j] = fabsf(da + (db - da) * (float)(c0 + j) / 511.f);
  u16* G = (u16*)((char*)p.out + OO_G);
  const float* H = (const float*)(p.ws + OFF_H2F);
  float as[4] = {0.f, 0.f, 0.f, 0.f};
#pragma unroll 1
  for (int i = 0; i < 4; ++i) {
    const int t = tq * 1024 + i * 256 + tid;
    const float4* hp = (const float4*)(H + t * 64);
    float d[8];
#pragma unroll
    for (int j = 0; j < 8; ++j) d[j] = fb[j];
#pragma unroll 1
    for (int q8 = 0; q8 < 16; q8 += 8) {
      float4 hv[8];
#pragma unroll
      for (int u = 0; u < 8; ++u) hv[u] = hp[q8 + u];
#pragma unroll
      for (int u = 0; u < 8; ++u)
#pragma unroll
        for (int j = 0; j < 8; ++j) {
          const float4 w = *(const float4*)(wc + j * 64 + 4 * (q8 + u));
          d[j] += hv[u].x * w.x + hv[u].y * w.y + hv[u].z * w.z + hv[u].w * w.w;
        }
    }
    const float tn = (float)t * (1.f / 4096.f);
#pragma unroll
    for (int j = 0; j < 4; ++j) {
      const float dec = expf(-tn * dl[j]);
      const float f = d[j] * dec, bw = d[4 + j] * dec;
      u16* Gc = G + (size_t)(c0 + j) * 8192;
      Gc[4095 - t] = f2bf(f);
      as[j] += fabsf(f);
      if (t < 4095) { Gc[4096 + t] = f2bf(bw); as[j] += fabsf(bw); }
      else Gc[8191] = 0;
    }
  }
#pragma unroll
  for (int j = 0; j < 4; ++j) {
    const float v = wave_sum(as[j]);
    if ((tid & 63) == 0) red[(tid >> 6) * 4 + j] = v;
  }
  __syncthreads();
  if (tid < 4) atomicAdd((float*)(p.ws + OFF_BAR + 20480) + c0 + tid, red[tid] + red[4 + tid] + red[8 + tid] + red[12 + tid]);
  __syncthreads();
}

struct Acc { f32x4 v[4][4]; };

DEV void acc_zero(Acc& a) {
#pragma unroll
  for (int i = 0; i < 4; ++i)
#pragma unroll
    for (int j = 0; j < 4; ++j) a.v[i][j] = (f32x4){0.f, 0.f, 0.f, 0.f};
}

#define LDSAS __attribute__((address_space(3)))
DEV void gemm_kloop(const u16* __restrict__ A, int lda, const u16* __restrict__ Bt, int ldb, int K, int m0, int n0,
                    u16* sA, u16* sB_unused, Acc& acc) {
  const int tid = threadIdx.x, lane = tid & 63, wave = tid >> 6, wm = wave >> 1, wn = wave & 1;
  const int l15 = lane & 15, quad = lane >> 4;
  const int rsw = (l15 >> 1) & 7;
  const int nk = K >> 6;
  const int prow = lane >> 3;
  const int pch = lane & 7;
  unsigned oA[4], oB[4];
#pragma unroll
  for (int i = 0; i < 4; ++i) {
    const int row = (wave * 4 + i) * 8 + prow;
    const int c = pch ^ ((row >> 1) & 7);
    oA[i] = (unsigned)(row * lda + c * 8) * 2u;
    oB[i] = (unsigned)(row * ldb + c * 8) * 2u;
  }
  const char* bA = (const char*)(A + (size_t)m0 * lda);
  const char* bB = (const char*)(Bt + (size_t)n0 * ldb);
  LDSAS char* lbase = (LDSAS char*)sA;
#define GEMM_DMA(KT, BUF)                                                                                   \
  _Pragma("unroll") for (int i = 0; i < 4; ++i) {                                                           \
    __builtin_amdgcn_global_load_lds((const unsigned*)(bA + (KT) * 128 + oA[i]), (LDSAS unsigned*)(lbase + (BUF) * 32768 + (wave * 4 + i) * 1024), 16, 0, 0);          \
    __builtin_amdgcn_global_load_lds((const unsigned*)(bB + (KT) * 128 + oB[i]), (LDSAS unsigned*)(lbase + (BUF) * 32768 + 16384 + (wave * 4 + i) * 1024), 16, 0, 0);  \
  }
  GEMM_DMA(0, 0)
  for (int kt = 0; kt < nk; ++kt) {
    asm volatile("s_waitcnt vmcnt(0)" ::: "memory");
    __syncthreads();
    const int buf = kt & 1;
    if (kt + 1 < nk) { GEMM_DMA(kt + 1, buf ^ 1) }
    const u16* tA = sA + buf * 16384;
    const u16* tB = tA + 8192;
    bf16x8 af[2][4], bfr[2][4];
#pragma unroll
    for (int ks = 0; ks < 2; ++ks) {
      const int cs = ((ks * 4 + quad) ^ rsw) * 8;
#pragma unroll
      for (int i = 0; i < 4; ++i) af[ks][i] = *(const bf16x8*)(tB + (wn * 64 + i * 16 + l15) * 64 + cs);
#pragma unroll
      for (int j = 0; j < 4; ++j) bfr[ks][j] = *(const bf16x8*)(tA + (wm * 64 + j * 16 + l15) * 64 + cs);
    }
    __builtin_amdgcn_s_setprio(1);
#pragma unroll
    for (int ks = 0; ks < 2; ++ks)
#pragma unroll
      for (int i = 0; i < 4; ++i)
#pragma unroll
        for (int j = 0; j < 4; ++j) acc.v[i][j] = __builtin_amdgcn_mfma_f32_16x16x32_bf16(af[ks][i], bfr[ks][j], acc.v[i][j], 0, 0, 0);
    __builtin_amdgcn_s_setprio(0);
  }
  __syncthreads();
}

DEV void p1_filter_tile(const Params& p, int tile, u16* sA, u16* sB) {
  const int mt = tile >> 3, nt = tile & 7;
  const int m0 = mt * 128, n0 = nt * 128;
  Acc acc; acc_zero(acc);
  gemm_kloop((const u16*)(p.ws + OFF_H2F), 64, (const u16*)(p.ws + OFF_H2F + 512 * 1024), 64, 64, m0, n0, sA, sB, acc);
  asm volatile("" ::: "memory");
  const int tid = threadIdx.x, lane = tid & 63, wave = tid >> 6, wm = wave >> 1, wn = wave & 1;
  const int l15 = lane & 15, quad = lane >> 4;
  const int mb = m0 + wm * 64, nbase = n0 + wn * 64;
  u16* G = (u16*)((char*)p.out + OO_G);
  float* nsum = (float*)(p.ws + OFF_BAR + 20480);
  const float da = logf(1e-2f) / 1.5f, db = logf(1e-2f) / 0.3f;
  const bool bwd = nbase >= 512;
#pragma unroll
  for (int i = 0; i < 4; ++i)
#pragma unroll
    for (int r = 0; r < 4; ++r) {
      const int col = nbase + i * 16 + quad * 4 + r;
      const int c = col & 511;
      const float fbv = p.hy_fb3[col];
      const float dlc = fabsf(da + (db - da) * (float)c / 511.f);
      u16* Gc = G + (size_t)c * 8192;
      float sum = 0.f;
#pragma unroll
      for (int j = 0; j < 4; ++j) {
        const int t = mb + j * 16 + l15;
        const float val = (acc.v[i][j][r] + fbv) * expf(-(float)t * (1.f / 4096.f) * dlc);
        if (!bwd) { Gc[4095 - t] = f2bf(val); sum += fabsf(val); }
        else if (t < 4095) { Gc[4096 + t] = f2bf(val); sum += fabsf(val); }
        else Gc[8191] = 0;
      }
      sum = DPP_ADD(sum, 0xB1);
      sum = DPP_ADD(sum, 0x4E);
      sum = DPP_ADD(sum, 0x141);
      sum = DPP_ADD(sum, 0x140);
      if (l15 == 0) atomicAdd(nsum + c, sum);
    }
}

DEV void p2_inproj(const Params& p, int tile, u16* sA, u16* sB) {
  const int mt = tile / 34, nt = tile % 34;
  const int m0 = mt * 128, n0 = nt * 128;
  Acc acc; acc_zero(acc);
  gemm_kloop((const u16*)((const char*)p.out + OO_H1), 1024, (const u16*)(p.ws + OFF_WIN), 1024, 1024, m0, n0, sA, sB, acc);
  asm volatile("" ::: "memory");
  const int tid = threadIdx.x, lane = tid & 63, wave = tid >> 6, wm = wave >> 1, wn = wave & 1;
  int l15 = lane & 15, quad = lane >> 4;
  int mb = m0 + wm * 64, nb = n0 + wn * 64;
  asm volatile("" : "+v"(l15), "+v"(quad), "+v"(mb), "+v"(nb));
  mb = __builtin_amdgcn_readfirstlane(mb); nb = __builtin_amdgcn_readfirstlane(nb);
  if (nb < 640) {
    const float2* rope = (const float2*)(p.ws + OFF_ROPE);
    const bool isq = nb < 512;
    const float qs = isq ? 0.125f : 1.f;
#pragma unroll
    for (int j = 0; j < 4; ++j) {
      const int m = mb + j * 16 + l15;
      const int b = m >> 12, l = m & 4095;
      const int prow = l >> 6, pcol = l & 63;
      u16* dst;
      if (isq) dst = (u16*)(p.ws + OFF_Q) + ((size_t)(b * 8 + (nb >> 6)) * 4096 + l) * 64;
      else dst = (u16*)(p.ws + OFF_K) + ((size_t)(b * 2 + ((nb - 512) >> 6)) * 4096 + l) * 64;
#pragma unroll
      for (int hh = 0; hh < 2; ++hh) {
        const int pos = hh ? pcol : prow;
        f32x4 x1 = acc.v[hh * 2][j], x2 = acc.v[hh * 2 + 1][j];
        float o1[4], o2[4];
#pragma unroll
        for (int r = 0; r < 4; ++r) {
          float2 cs = rope[pos * 16 + quad * 4 + r];
          o1[r] = (x1[r] * cs.x - x2[r] * cs.y) * qs;
          o2[r] = (x2[r] * cs.x + x1[r] * cs.y) * qs;
        }
        *(uint2*)(dst + hh * 32 + quad * 4) = make_uint2(pack2(o1[0], o1[1]), pack2(o1[2], o1[3]));
        *(uint2*)(dst + hh * 32 + 16 + quad * 4) = make_uint2(pack2(o2[0], o2[1]), pack2(o2[2], o2[3]));
      }
    }
  } else if (nb < 768) {
    const int g = (nb - 640) >> 6;
    u16* vt = (u16*)(p.ws + OFF_VT);
#pragma unroll
    for (int j = 0; j < 4; ++j) {
      const int m = mb + j * 16 + l15;
      const int b = m >> 12, l = m & 4095;
#pragma unroll
      for (int i = 0; i < 4; ++i)
#pragma unroll
        for (int r = 0; r < 4; ++r) {
          const int d = i * 16 + quad * 4 + r;
          vt[((size_t)(b * 2 + g) * 64 + d) * 4096 + l] = f2bf(acc.v[i][j][r]);
        }
    }
  } else if (nb < 2304) {
    u16* z = (u16*)(p.ws + OFF_Z);
#pragma unroll
    for (int j = 0; j < 4; ++j) {
      const int m = mb + j * 16 + l15;
#pragma unroll
      for (int i = 0; i < 4; ++i) {
        const int n = nb - 768 + i * 16 + quad * 4;
        f32x4 a = acc.v[i][j];
        *(uint2*)(z + (size_t)m * 1536 + n) = make_uint2(pack2(a[0], a[1]), pack2(a[2], a[3]));
      }
    }
  } else {
    u16* gt = (u16*)(p.ws + OFF_GATE);
#pragma unroll
    for (int j = 0; j < 4; ++j) {
      const int m = mb + j * 16 + l15;
#pragma unroll
      for (int i = 0; i < 4; ++i) {
        const int n = nb - 2304 + i * 16 + quad * 4;
        f32x4 a = acc.v[i][j];
        float s0 = 1.f / (1.f + __expf(-a[0])), s1 = 1.f / (1.f + __expf(-a[1]));
        float s2 = 1.f / (1.f + __expf(-a[2])), s3 = 1.f / (1.f + __expf(-a[3]));
        *(uint2*)(gt + (size_t)m * 2048 + n) = make_uint2(pack2(s0, s1), pack2(s2, s3));
      }
    }
  }
}

DEV void p2_ctxkv(const Params& p, int tile, u16* sA, u16* sB) {
  const int mt = tile >> 1, nt = tile & 1;
  const int m0 = mt * 128, n0 = nt * 128;
  Acc acc; acc_zero(acc);
  gemm_kloop((const u16*)((const char*)p.out + OO_HC), 1024, (const u16*)(p.ws + OFF_WIN) + (size_t)512 * 1024, 1024, 1024, m0, n0, sA, sB, acc);
  const int tid = threadIdx.x, lane = tid & 63, wave = tid >> 6, wm = wave >> 1, wn = wave & 1;
  const int l15 = lane & 15, quad = lane >> 4;
  const int mb = m0 + wm * 64, nb = n0 + wn * 64;
  const int g = (nb >> 6) & 1;
  if (nb < 128) {
    u16* kc = (u16*)(p.ws + OFF_KC);
#pragma unroll
    for (int j = 0; j < 4; ++j) {
      const int m = mb + j * 16 + l15;
      const int b = m >> 8, c = m & 255;
#pragma unroll
      for (int i = 0; i < 4; ++i) {
        f32x4 a = acc.v[i][j];
        *(uint2*)(kc + ((size_t)(b * 2 + g) * 256 + c) * 64 + i * 16 + quad * 4) = make_uint2(pack2(a[0], a[1]), pack2(a[2], a[3]));
      }
    }
  } else {
    u16* vct = (u16*)(p.ws + OFF_VCT);
#pragma unroll
    for (int j = 0; j < 4; ++j) {
      const int m = mb + j * 16 + l15;
      const int b = m >> 8, c = m & 255;
#pragma unroll
      for (int i = 0; i < 4; ++i)
#pragma unroll
        for (int r = 0; r < 4; ++r) {
          const int d = i * 16 + quad * 4 + r;
          vct[((size_t)(b * 2 + g) * 64 + d) * 256 + c] = f2bf(acc.v[i][j][r]);
        }
    }
  }
}

DEV void p3_attn(const Params& p, int item, u16* sK, u16* sVt) {
  const int tid = threadIdx.x, lane = tid & 63, wave = tid >> 6, l15 = lane & 15, quad = lane >> 4;
  const int n = item & 31, h = (item >> 5) & 7, b = item >> 8;
  const int g = h >> 2;
  const u16* Q = (const u16*)(p.ws + OFF_Q) + ((size_t)(b * 8 + h) * 4096 + n * 128 + wave * 32) * 64;
  bf16x8 bq[2][2];
#pragma unroll
  for (int qt = 0; qt < 2; ++qt)
#pragma unroll
    for (int ks = 0; ks < 2; ++ks) bq[qt][ks] = *(const bf16x8*)(Q + (qt * 16 + l15) * 64 + ks * 32 + quad * 8);
  const float sink = p.attn_sink[h];
  float mrun[2] = {sink, sink};
  float lrun[2];
  lrun[0] = lrun[1] = (quad == 0) ? 1.f : 0.f;
  f32x4 O[4][2];
#pragma unroll
  for (int dt = 0; dt < 4; ++dt)
#pragma unroll
    for (int qt = 0; qt < 2; ++qt) O[dt][qt] = (f32x4){0.f, 0.f, 0.f, 0.f};

  u32x4 pk[4], pv[4];
#define ATT_LOAD(KB)                                                                                  \
  {                                                                                                   \
    const u16* Ksrc; const u16* Vsrc; int vstride;                                                    \
    if ((KB) < 3) {                                                                                   \
      const int nbk = n + (KB) - 1;                                                                   \
      Ksrc = (const u16*)(p.ws + OFF_K) + ((size_t)(b * 2 + g) * 4096 + nbk * 128) * 64;              \
      Vsrc = (const u16*)(p.ws + OFF_VT) + (size_t)(b * 2 + g) * 64 * 4096 + nbk * 128;               \
      vstride = 4096;                                                                                 \
    } else {                                                                                          \
      const int cb = (KB) - 3;                                                                        \
      Ksrc = (const u16*)(p.ws + OFF_KC) + ((size_t)(b * 2 + g) * 256 + cb * 128) * 64;               \
      Vsrc = (const u16*)(p.ws + OFF_VCT) + (size_t)(b * 2 + g) * 64 * 256 + cb * 128;                \
      vstride = 256;                                                                                  \
    }                                                                                                 \
    _Pragma("unroll") for (int i = 0; i < 4; ++i) {                                                   \
      const int id = tid + i * 256;                                                                   \
      pk[i] = *(const u32x4*)(Ksrc + (id >> 3) * 64 + (id & 7) * 8);                                  \
      pv[i] = *(const u32x4*)(Vsrc + (size_t)(id >> 4) * vstride + (id & 15) * 8);                    \
    }                                                                                                 \
  }
  int kb = (n == 0) ? 1 : 0;
  ATT_LOAD(kb)
  while (kb < 5) {
#pragma unroll
    for (int i = 0; i < 4; ++i) {
      const int id = tid + i * 256;
      *(u32x4*)(sK + (id >> 3) * 72 + (id & 7) * 8) = pk[i];
      *(u32x4*)(sVt + (id >> 4) * 136 + (id & 15) * 8) = pv[i];
    }
    __syncthreads();
    int nx = kb + 1;
    if (nx == 2 && n == 31) nx = 3;
    if (nx < 5) ATT_LOAD(nx)
#pragma unroll 1
    for (int c4 = 0; c4 < 4; ++c4) {
      f32x4 s[2][2];
#pragma unroll
      for (int kt = 0; kt < 2; ++kt) {
        bf16x8 ak0 = *(const bf16x8*)(sK + (c4 * 32 + kt * 16 + l15) * 72 + quad * 8);
        bf16x8 ak1 = *(const bf16x8*)(sK + (c4 * 32 + kt * 16 + l15) * 72 + 32 + quad * 8);
#pragma unroll
        for (int qt = 0; qt < 2; ++qt) {
          f32x4 z = (f32x4){0.f, 0.f, 0.f, 0.f};
          z = __builtin_amdgcn_mfma_f32_16x16x32_bf16(ak0, bq[qt][0], z, 0, 0, 0);
          z = __builtin_amdgcn_mfma_f32_16x16x32_bf16(ak1, bq[qt][1], z, 0, 0, 0);
          s[kt][qt] = z;
        }
      }
      if (kb == 0 || kb == 2) {
#pragma unroll
        for (int kt = 0; kt < 2; ++kt)
#pragma unroll
          for (int qt = 0; qt < 2; ++qt)
#pragma unroll
            for (int r = 0; r < 4; ++r) {
              const int kk = c4 * 32 + kt * 16 + quad * 4 + r;
              const int qq = wave * 32 + qt * 16 + l15;
              const bool valid = (kb == 0) ? (kk >= qq) : (kk <= qq);
              if (!valid) s[kt][qt][r] = -INFINITY;
            }
      }
      bf16x8 bp[2];
#pragma unroll
      for (int qt = 0; qt < 2; ++qt) {
        float cm = fmaxf(fmaxf(fmaxf(s[0][qt][0], s[0][qt][1]), fmaxf(s[0][qt][2], s[0][qt][3])),
                         fmaxf(fmaxf(s[1][qt][0], s[1][qt][1]), fmaxf(s[1][qt][2], s[1][qt][3])));
        cm = fmaxf(cm, __shfl_xor(cm, 16));
        cm = fmaxf(cm, __shfl_xor(cm, 32));
        const float mnew = fmaxf(mrun[qt], cm);
        const float alpha = __expf(mrun[qt] - mnew);
        mrun[qt] = mnew;
        float ps = 0.f;
        float pv[8];
#pragma unroll
        for (int r = 0; r < 4; ++r) {
          pv[r] = __expf(s[0][qt][r] - mnew);
          pv[4 + r] = __expf(s[1][qt][r] - mnew);
          ps += pv[r] + pv[4 + r];
        }
        lrun[qt] = lrun[qt] * alpha + ps;
#pragma unroll
        for (int dt = 0; dt < 4; ++dt) {
          O[dt][qt][0] *= alpha; O[dt][qt][1] *= alpha; O[dt][qt][2] *= alpha; O[dt][qt][3] *= alpha;
        }
        union { bf16x8 v; unsigned u[4]; } pk;
        pk.u[0] = pack2(pv[0], pv[1]); pk.u[1] = pack2(pv[2], pv[3]);
        pk.u[2] = pack2(pv[4], pv[5]); pk.u[3] = pack2(pv[6], pv[7]);
        bp[qt] = pk.v;
      }
#pragma unroll
      for (int dt = 0; dt < 4; ++dt) {
        union { bf16x8 v; uint2 h[2]; } av;
        const u16* vrow = sVt + (dt * 16 + l15) * 136 + c4 * 32 + quad * 4;
        av.h[0] = *(const uint2*)(vrow);
        av.h[1] = *(const uint2*)(vrow + 16);
#pragma unroll
        for (int qt = 0; qt < 2; ++qt) O[dt][qt] = __builtin_amdgcn_mfma_f32_16x16x32_bf16(av.v, bp[qt], O[dt][qt], 0, 0, 0);
      }
    }
    __syncthreads();
    kb = nx;
  }
  u16* Y = (u16*)(p.ws + OFF_YATT);
#pragma unroll
  for (int qt = 0; qt < 2; ++qt) {
    float l = lrun[qt];
    l += __shfl_xor(l, 16);
    l += __shfl_xor(l, 32);
    const float inv = 1.f / l;
    const int t = b * 4096 + n * 128 + wave * 32 + qt * 16 + l15;
#pragma unroll
    for (int dt = 0; dt < 4; ++dt) {
      f32x4 o = O[dt][qt];
      *(uint2*)(Y + (size_t)t * 512 + h * 64 + dt * 16 + quad * 4) = make_uint2(pack2(o[0] * inv, o[1] * inv), pack2(o[2] * inv, o[3] * inv));
    }
  }
}

DEV void p3_hypre(const Params& p, int item, u16* sm) {
  const int tid = threadIdx.x;
  const int cb = item & 3, tb = (item >> 2) & 63, b = item >> 8;
  const int tq = tid >> 6, ch2 = tid & 63;
  const int c = cb * 128 + ch2 * 2;
  u16* su = sm;
  u16* sx = sm + 128 * 66;
  float w[3][3][2], bias[3][2];
#pragma unroll
  for (int s = 0; s < 3; ++s) {
#pragma unroll
    for (int k = 0; k < 3; ++k) {
      const float2 wv = *(const float2*)(p.hy_conv_w + k * 1536 + s * 512 + c);
      w[s][k][0] = wv.x; w[s][k][1] = wv.y;
    }
    const float2 bv = *(const float2*)(p.hy_conv_b + s * 512 + c);
    bias[s][0] = bv.x; bias[s][1] = bv.y;
  }
  const u16* Z = (const u16*)(p.ws + OFF_Z) + (size_t)b * 4096 * 1536;
  const int l0 = tb * 64 + tq * 16;
  unsigned zr[18][3];
#pragma unroll
  for (int i = 0; i < 18; ++i) {
    const int l = l0 - 1 + i;
    const bool ok = (l >= 0) && (l < 4096);
    const int lc = ok ? l : l0;
#pragma unroll
    for (int s2 = 0; s2 < 3; ++s2) {
      const unsigned v = *(const unsigned*)(Z + (size_t)lc * 1536 + s2 * 512 + c);
      zr[i][s2] = ok ? v : 0u;
    }
  }
#pragma unroll
  for (int i = 0; i < 16; ++i) {
    float cv0[3], cv1[3];
#pragma unroll
    for (int s2 = 0; s2 < 3; ++s2) {
      cv0[s2] = bflo(zr[i][s2]) * w[s2][0][0] + bflo(zr[i + 1][s2]) * w[s2][1][0] + bflo(zr[i + 2][s2]) * w[s2][2][0] + bias[s2][0];
      cv1[s2] = bfhi(zr[i][s2]) * w[s2][0][1] + bfhi(zr[i + 1][s2]) * w[s2][1][1] + bfhi(zr[i + 2][s2]) * w[s2][2][1] + bias[s2][1];
    }
    su[(ch2 * 2) * 66 + tq * 16 + i] = f2bf(cv0[2] * cv0[1]);
    su[(ch2 * 2 + 1) * 66 + tq * 16 + i] = f2bf(cv1[2] * cv1[1]);
    sx[(ch2 * 2) * 66 + tq * 16 + i] = f2bf(cv0[0]);
    sx[(ch2 * 2 + 1) * 66 + tq * 16 + i] = f2bf(cv1[0]);
  }
  __syncthreads();
  const int chr = tid >> 1, part = tid & 1;
  const int cc = cb * 128 + chr;
  const unsigned* ru = (const unsigned*)(su + chr * 66 + part * 32);
  const unsigned* rx = (const unsigned*)(sx + chr * 66 + part * 32);
  u16* UT = (u16*)((char*)p.out + OO_UT) + ((size_t)(cc * 4 + b) * 4096 + tb * 64 + part * 32);
  u16* XT = (u16*)((char*)p.out + OO_X0T) + ((size_t)(cc * 4 + b) * 4096 + tb * 64 + part * 32);
#pragma unroll
  for (int q = 0; q < 4; ++q) {
    ((uint4*)UT)[q] = make_uint4(ru[4 * q], ru[4 * q + 1], ru[4 * q + 2], ru[4 * q + 3]);
    ((uint4*)XT)[q] = make_uint4(rx[4 * q], rx[4 * q + 1], rx[4 * q + 2], rx[4 * q + 3]);
  }
  __syncthreads();
}

DEV void p3_toeplitz(const Params& p, int c, char* smem) {
  const int tid = threadIdx.x, lane = tid & 63, wave = tid >> 6, l15 = lane & 15, quad = lane >> 4;
  u16* sG0 = (u16*)smem;
  u16* sG1 = (u16*)(smem + 16384 + 64);
  u16* sU = (u16*)(smem + 32768 + 128);
  u16* sZ = sU + 4 * 64 * 72;
  const u16* G = (const u16*)((const char*)p.out + OO_G) + (size_t)c * 8192;
  const u16* UT = (const u16*)((const char*)p.out + OO_UT) + (size_t)c * 16384;
#pragma unroll
  for (int i = 0; i < 4; ++i) {
    const int id = tid + i * 256;
    *(uint4*)(sG0 + id * 8) = *(const uint4*)(G + id * 8);
  }
#pragma unroll
  for (int i = 0; i < 8; ++i) {
    const int id = tid + i * 256;
    const int bb = id >> 9, blk = (id >> 3) & 63, c8 = id & 7;
    *(uint4*)(sU + (bb * 64 + blk) * 72 + c8 * 8) = *(const uint4*)(UT + id * 8);
  }
  if (tid < 72) sZ[tid] = 0;
  __syncthreads();
  for (int i = tid; i < 8192; i += 256) sG1[i] = (i < 8191) ? sG0[i + 1] : (u16)0;
  __syncthreads();

  Acc acc; acc_zero(acc);
  const u16* gbase = (l15 & 1) ? sG0 : (sG1 - 1);
  const u16* ubase = sU + wave * 64 * 72 + quad * 8;
  const u16* zbase = sZ + quad * 8;
#define TOEP_LOADA(AF, D)                                                                 \
  {                                                                                       \
    const int base_ = 4095 - 64 * (D) - l15 + quad * 8;                                   \
    _Pragma("unroll") for (int mt = 0; mt < 4; ++mt)                                      \
      _Pragma("unroll") for (int ks = 0; ks < 2; ++ks) {                                  \
        const unsigned* gp = (const unsigned*)(gbase + base_ - mt * 16 + ks * 32);        \
        union { bf16x8 v; unsigned u[4]; } t_;                                            \
        t_.u[0] = gp[0]; t_.u[1] = gp[1]; t_.u[2] = gp[2]; t_.u[3] = gp[3];               \
        AF[mt][ks] = t_.v;                                                                \
      }                                                                                   \
  }
#define TOEP_MMA(AF, D)                                                                   \
  _Pragma("unroll") for (int nt = 0; nt < 4; ++nt) {                                      \
    if (!(nt * 16 + 15 - (D) < 0 || nt * 16 - (D) > 63)) {                                \
      const int ip = nt * 16 + l15 - (D);                                                 \
      const u16* up = (ip >= 0 && ip < 64) ? (ubase + ip * 72) : zbase;                   \
      bf16x8 b0 = *(const bf16x8*)(up);                                                   \
      bf16x8 b1 = *(const bf16x8*)(up + 32);                                              \
      _Pragma("unroll") for (int mt = 0; mt < 4; ++mt) {                                  \
        acc.v[mt][nt] = __builtin_amdgcn_mfma_f32_16x16x32_bf16(AF[mt][0], b0, acc.v[mt][nt], 0, 0, 0); \
        acc.v[mt][nt] = __builtin_amdgcn_mfma_f32_16x16x32_bf16(AF[mt][1], b1, acc.v[mt][nt], 0, 0, 0); \
      }                                                                                   \
    }                                                                                     \
  }
  {
    bf16x8 afA[4][2], afB[4][2];
    TOEP_LOADA(afA, -63)
#pragma unroll 1
    for (int d = -63; d <= 63; d += 2) {
      if (d + 1 <= 63) TOEP_LOADA(afB, d + 1)
      TOEP_MMA(afA, d)
      if (d + 1 <= 63) {
        if (d + 2 <= 63) TOEP_LOADA(afA, d + 2)
        TOEP_MMA(afB, d + 1)
      }
    }
  }
  const float ninv = 1.f / ((const float*)(p.ws + OFF_BAR + 20480))[c];
  const float skip = p.hy_skip[c];
  const u16* XT = (const u16*)((const char*)p.out + OO_X0T) + ((size_t)(c * 4 + wave) * 4096);
  u16* Y = (u16*)(p.ws + OFF_YHY);
#pragma unroll
  for (int nt = 0; nt < 4; ++nt) {
    const int ib = nt * 16 + l15;
#pragma unroll
    for (int mt = 0; mt < 4; ++mt) {
      const int r0 = mt * 16 + quad * 4;
      const int t = ib * 64 + r0;
      uint2 uu = *(const uint2*)(sU + (wave * 64 + ib) * 72 + r0);
      uint2 xx = *(const uint2*)(XT + t);
      float uv[4] = {bflo(uu.x), bfhi(uu.x), bflo(uu.y), bfhi(uu.y)};
      float xv[4] = {bflo(xx.x), bfhi(xx.x), bflo(xx.y), bfhi(xx.y)};
#pragma unroll
      for (int r = 0; r < 4; ++r) {
        float y = acc.v[mt][nt][r] * ninv + uv[r] * skip;
        Y[(size_t)(wave * 4096 + t + r) * 512 + c] = f2bf(y * xv[r]);
      }
    }
  }
  __syncthreads();
}

DEV void p4_merge(const Params& p, int tile, u16* sA, u16* sB) {
  const int mt = tile >> 3, nt = tile & 7;
  const int m0 = mt * 128, n0 = nt * 128;
  const int tid = threadIdx.x, lane = tid & 63, wave = tid >> 6, wm = wave >> 1, wn = wave & 1;
  const int l15 = lane & 15, quad = lane >> 4;
  const int mb = m0 + wm * 64, nb = n0 + wn * 64;
  const u16* gt = (const u16*)(p.ws + OFF_GATE);
  u16* mg = (u16*)(p.ws + OFF_MERGED);
  Acc a1; acc_zero(a1);
  gemm_kloop((const u16*)(p.ws + OFF_YATT), 512, (const u16*)(p.ws + OFF_WOA), 512, 512, m0, n0, sA, sB, a1);
  asm volatile("" ::: "memory");
#pragma unroll
  for (int j = 0; j < 4; ++j) {
    const int m = mb + j * 16 + l15;
#pragma unroll
    for (int i = 0; i < 4; ++i) {
      const int n = nb + i * 16 + quad * 4;
      uint2 ga = *(const uint2*)(gt + (size_t)m * 2048 + n);
      f32x4 x = a1.v[i][j];
      *(uint2*)(mg + (size_t)m * 1024 + n) = make_uint2(pack2(bflo(ga.x) * x[0], bfhi(ga.x) * x[1]), pack2(bflo(ga.y) * x[2], bfhi(ga.y) * x[3]));
    }
  }
  asm volatile("" ::: "memory");
  acc_zero(a1);
  gemm_kloop((const u16*)(p.ws + OFF_YHY), 512, (const u16*)(p.ws + OFF_WOH), 512, 512, m0, n0, sA, sB, a1);
  asm volatile("" ::: "memory");
#pragma unroll
  for (int j = 0; j < 4; ++j) {
    const int m = mb + j * 16 + l15;
#pragma unroll
    for (int i = 0; i < 4; ++i) {
      const int n = nb + i * 16 + quad * 4;
      uint2 gh = *(const uint2*)(gt + (size_t)m * 2048 + 1024 + n);
      uint2 pv = *(const uint2*)(mg + (size_t)m * 1024 + n);
      f32x4 y = a1.v[i][j];
      float o0 = bflo(pv.x) + bflo(gh.x) * y[0];
      float o1 = bfhi(pv.x) + bfhi(gh.x) * y[1];
      float o2 = bflo(pv.y) + bflo(gh.y) * y[2];
      float o3 = bfhi(pv.y) + bfhi(gh.y) * y[3];
      *(uint2*)(mg + (size_t)m * 1024 + n) = make_uint2(pack2(o0, o1), pack2(o2, o3));
    }
  }
}

DEV void p5_out(const Params& p, int tile, u16* sA, u16* sB) {
  const int mt = tile >> 3, nt = tile & 7;
  const int m0 = mt * 128, n0 = nt * 128;
  Acc acc; acc_zero(acc);
  gemm_kloop((const u16*)(p.ws + OFF_MERGED), 1024, (const u16*)(p.ws + OFF_WOUT), 1024, 1024, m0, n0, sA, sB, acc);
  const int tid = threadIdx.x, lane = tid & 63, wave = tid >> 6, wm = wave >> 1, wn = wave & 1;
  const int l15 = lane & 15, quad = lane >> 4;
  const int mb = m0 + wm * 64, nb = n0 + wn * 64;
  const float* mod = (const float*)(p.ws + OFF_MOD);
#pragma unroll
  for (int j = 0; j < 4; ++j) {
    const int m = mb + j * 16 + l15;
    const int b = m >> 12;
#pragma unroll
    for (int i = 0; i < 4; ++i) {
      const int n = nb + i * 16 + quad * 4;
      float4 g1 = *(const float4*)(mod + b * 6144 + 2048 + n);
      float4 xv = *(const float4*)(p.x + (size_t)m * 1024 + n);
      f32x4 a = acc.v[i][j];
      float4 o = make_float4(xv.x + g1.x * a[0], xv.y + g1.y * a[1], xv.z + g1.z * a[2], xv.w + g1.w * a[3]);
      *(float4*)(p.out + (size_t)m * 1024 + n) = o;
    }
  }
}

DEV void p7_qp(const Params& p, int tile, u16* sA, u16* sB) {
  const int mt = tile >> 3, nt = tile & 7;
  const int m0 = mt * 128, n0 = nt * 128;
  Acc acc; acc_zero(acc);
  gemm_kloop((const u16*)(p.ws + OFF_H2), 1024, (const u16*)(p.ws + OFF_WQ), 1024, 1024, m0, n0, sA, sB, acc);
  const int tid = threadIdx.x, lane = tid & 63, wave = tid >> 6, wm = wave >> 1, wn = wave & 1;
  const int l15 = lane & 15, quad = lane >> 4;
  const int mb = m0 + wm * 64, nb = n0 + wn * 64;
  u16* qp = (u16*)(p.ws + OFF_QP);
#pragma unroll
  for (int j = 0; j < 4; ++j) {
    const int m = mb + j * 16 + l15;
#pragma unroll
    for (int i = 0; i < 4; ++i) {
      const int n = nb + i * 16 + quad * 4;
      f32x4 a = acc.v[i][j];
      *(uint2*)(qp + (size_t)m * 1024 + n) = make_uint2(pack2(a[0], a[1]), pack2(a[2], a[3]));
    }
  }
}

DEV unsigned f2ord(float f) {
  const unsigned u = __float_as_uint(f);
  return u ^ (((int)u >> 31) | 0x80000000u);
}
DEV float ord2f(unsigned k) {
  const unsigned m = (k & 0x80000000u) ? 0x80000000u : 0xffffffffu;
  return __uint_as_float(k ^ m);
}
DEV unsigned umax_(unsigned a, unsigned b) { return a > b ? a : b; }
DEV unsigned umin_(unsigned a, unsigned b) { return a < b ? a : b; }

DEV void sort16_desc(unsigned (&v)[16]) {
#pragma unroll
  for (int k = 2; k <= 16; k <<= 1)
#pragma unroll
    for (int j = k >> 1; j > 0; j >>= 1)
#pragma unroll
      for (int i = 0; i < 16; ++i) {
        const int l = i ^ j;
        if (l > i) {
          const bool desc = ((i & k) == 0);
          const unsigned a = v[i], b = v[l];
          const unsigned hi = umax_(a, b), lo = umin_(a, b);
          v[i] = desc ? hi : lo;
          v[l] = desc ? lo : hi;
        }
      }
}
DEV void merge16_desc(unsigned (&v)[16]) {
#pragma unroll
  for (int j = 8; j > 0; j >>= 1)
#pragma unroll
    for (int i = 0; i < 16; ++i) {
      const int l = i ^ j;
      if (l > i) {
        const unsigned a = v[i], b = v[l];
        v[i] = umax_(a, b);
        v[l] = umin_(a, b);
      }
    }
}
DEV void xmerge16(unsigned (&v)[16], int off) {
  unsigned pr[16];
#pragma unroll
  for (int i = 0; i < 16; ++i) pr[i] = (unsigned)__shfl_xor((int)v[i], off);
#pragma unroll
  for (int i = 0; i < 16; ++i) v[i] = umax_(v[i], pr[15 - i]);
  merge16_desc(v);
}

DEV void route_top16_of_128(const u16* __restrict__ keys, const u16* __restrict__ qp, int l15, int quad, unsigned (&out)[16]) {
  bf16x8 b0 = *(const bf16x8*)(qp);
  bf16x8 b1 = *(const bf16x8*)(qp + 32);
  unsigned ka[16], kb[16];
#pragma unroll
  for (int kt = 0; kt < 8; ++kt) {
    bf16x8 a0 = *(const bf16x8*)(keys + (kt * 16 + l15) * 64 + quad * 8);
    bf16x8 a1 = *(const bf16x8*)(keys + (kt * 16 + l15) * 64 + 32 + quad * 8);
    f32x4 z = (f32x4){0.f, 0.f, 0.f, 0.f};
    z = __builtin_amdgcn_mfma_f32_16x16x32_bf16(a0, b0, z, 0, 0, 0);
    z = __builtin_amdgcn_mfma_f32_16x16x32_bf16(a1, b1, z, 0, 0, 0);
#pragma unroll
    for (int r = 0; r < 4; ++r) {
      const unsigned key = (f2ord(z[r]) & ~127u) | (unsigned)(kt * 16 + quad * 4 + r);
      if (kt < 4) ka[kt * 4 + r] = key; else kb[(kt - 4) * 4 + r] = key;
    }
  }
  sort16_desc(ka);
  sort16_desc(kb);
#pragma unroll
  for (int i = 0; i < 16; ++i) out[i] = umax_(ka[i], kb[15 - i]);
  merge16_desc(out);
  xmerge16(out, 16);
  xmerge16(out, 32);
}

DEV void p8_route(const Params& p, int task, char* wsm) {
  static constexpr unsigned char kTab[52] = {
      0x00, 0x01, 0x02, 0x03, 0x04, 0x05, 0x06, 0x07, 0x08, 0x09, 0x0A, 0x0B, 0x0C, 0x0D, 0x0E, 0x0F,
      0x10, 0x11, 0x12, 0x13, 0x14, 0x15, 0x16, 0x17, 0x20, 0x21, 0x22, 0x23, 0x24, 0x30, 0x31, 0x32, 0x33,
      0x40, 0x41, 0x42, 0x50, 0x51, 0x60, 0x61, 0x70, 0x71, 0x80, 0x90, 0xA0, 0xB0, 0xC0, 0xD0, 0xE0, 0xF0, 0x00, 0x00};
  const int lane = threadIdx.x & 63, l15 = lane & 15, quad = lane >> 4;
  const int h = task & 7, tt = task >> 3;
  const int t0 = tt * 16;
  float* s1v = (float*)wsm;
  float* s2v = s1v + 256;
  int* i1 = (int*)(s2v + 256);
  int* i2 = i1 + 256;
  const u16* keys = (const u16*)(p.ws + OFF_KEYS) + (size_t)(h * 2) * 128 * 64;
  const u16* qp = (const u16*)(p.ws + OFF_QP) + (size_t)(t0 + l15) * 1024 + h * 128 + quad * 8;
  unsigned l1[16], l2[16];
  route_top16_of_128(keys, qp, l15, quad, l1);
  route_top16_of_128(keys + 128 * 64, qp + 64, l15, quad, l2);
  if (quad == 0) {
#pragma unroll
    for (int i = 0; i < 16; ++i) { s1v[l15 * 16 + i] = ord2f(l1[i] & ~127u); i1[l15 * 16 + i] = (int)(l1[i] & 127u); }
  } else if (quad == 1) {
#pragma unroll
    for (int i = 0; i < 16; ++i) { s2v[l15 * 16 + i] = ord2f(l2[i] & ~127u); i2[l15 * 16 + i] = (int)(l2[i] & 127u); }
  }
  __builtin_amdgcn_fence(__ATOMIC_RELEASE, "wavefront");
  __builtin_amdgcn_wave_barrier();
  __builtin_amdgcn_fence(__ATOMIC_ACQUIRE, "wavefront");
  unsigned ck[16];
#pragma unroll
  for (int s = 0; s < 16; ++s) {
    const int c = quad + 4 * s;
    unsigned key = 0u;
    if (s < 13 && c < 50) {
      const unsigned ab = kTab[c];
      const float val = s1v[l15 * 16 + (ab >> 4)] + s2v[l15 * 16 + (ab & 15)];
      key = (f2ord(val) & ~255u) | ab;
    }
    ck[s] = key;
  }
  sort16_desc(ck);
  xmerge16(ck, 16);
  xmerge16(ck, 32);
  if (quad == 0) {
    float e[16];
    const float vmax = ord2f(ck[0] & ~255u);
    float ssum = 0.f;
#pragma unroll
    for (int i = 0; i < 16; ++i) { e[i] = __expf(ord2f(ck[i] & ~255u) - vmax); ssum += e[i]; }
    const float inv = 1.f / ssum;
    int* ridx = (int*)(p.ws + OFF_RIDX) + (size_t)(t0 + l15) * 128 + h * 16;
    float* rw = (float*)(p.ws + OFF_RW) + (size_t)(t0 + l15) * 128 + h * 16;
#pragma unroll
    for (int i = 0; i < 16; i += 4) {
      int ee[4]; float ww[4];
#pragma unroll
      for (int j = 0; j < 4; ++j) {
        const unsigned ab = ck[i + j] & 255u;
        ee[j] = i1[l15 * 16 + (ab >> 4)] * 128 + i2[l15 * 16 + (ab & 15)];
        ww[j] = e[i + j] * inv;
      }
      *(int4*)(ridx + i) = make_int4(ee[0], ee[1], ee[2], ee[3]);
      *(float4*)(rw + i) = make_float4(ww[0], ww[1], ww[2], ww[3]);
    }
  }
  __builtin_amdgcn_fence(__ATOMIC_RELEASE, "wavefront");
  __builtin_amdgcn_wave_barrier();
}

DEV float gelu_tanh(float x) {
  const float u2 = 1.5957691216057308f * (x + 0.044715f * x * x * x);
  return x * __frcp_rn(1.f + __expf(-u2));
}

DEV void unpack8(const uint4& q, float* f) {
  f[0] = bflo(q.x); f[1] = bfhi(q.x); f[2] = bflo(q.y); f[3] = bfhi(q.y);
  f[4] = bflo(q.z); f[5] = bfhi(q.z); f[6] = bflo(q.w); f[7] = bfhi(q.w);
}

DEV float dpp_add(float v, const int ctrl_sel) {
  return v;
}
typedef __attribute__((ext_vector_type(2))) __bf16 bf2_t;
DEV float dot2bf(unsigned a, unsigned b, float c) {
  return __builtin_amdgcn_fdot2_f32_bf16(__builtin_bit_cast(bf2_t, a), __builtin_bit_cast(bf2_t, b), c, false);
}

DEV float reduce4_rows(float d0, float d1, float d2, float d3, int lane) {
  const bool up32 = (lane & 32) != 0, up16 = (lane & 16) != 0;
  float k0 = up32 ? d2 : d0, k1 = up32 ? d3 : d1;
  const float s0 = up32 ? d0 : d2, s1 = up32 ? d1 : d3;
  k0 += __shfl_xor(s0, 32);
  k1 += __shfl_xor(s1, 32);
  float kq = up16 ? k1 : k0;
  const float sq = up16 ? k0 : k1;
  kq += __shfl_xor(sq, 16);
  kq = DPP_ADD(kq, 0xB1);
  kq = DPP_ADD(kq, 0x4E);
  kq = DPP_ADD(kq, 0x141);
  kq = DPP_ADD(kq, 0x140);
  return kq;
}

DEV void p9_token(const Params& p, int t, int tnext, int lane, int2& e2n, float2& w2n, u32x4& han, u32x4& hbn) {
  const unsigned char* U8 = (const unsigned char*)(p.ws + OFF_UBF);
  const unsigned char* V8 = (const unsigned char*)(p.ws + OFF_VBF);
  const int2 e2 = e2n;
  const float2 w2 = w2n;
  const u32x4 ha = han, hb = hbn;
  {
    e2n = *(const int2*)((const int*)(p.ws + OFF_RIDX) + (size_t)tnext * 128 + 2 * lane);
    w2n = *(const float2*)((const float*)(p.ws + OFF_RW) + (size_t)tnext * 128 + 2 * lane);
    const u16* h2 = (const u16*)(p.ws + OFF_H2) + (size_t)tnext * 1024 + 16 * lane;
    han = *(const u32x4*)(h2);
    hbn = *(const u32x4*)(h2 + 8);
  }
  float hf[16];
  hf[0] = bflo(ha.x); hf[1] = bfhi(ha.x); hf[2] = bflo(ha.y); hf[3] = bfhi(ha.y);
  hf[4] = bflo(ha.z); hf[5] = bfhi(ha.z); hf[6] = bflo(ha.w); hf[7] = bfhi(ha.w);
  hf[8] = bflo(hb.x); hf[9] = bfhi(hb.x); hf[10] = bflo(hb.y); hf[11] = bfhi(hb.y);
  hf[12] = bflo(hb.z); hf[13] = bfhi(hb.z); hf[14] = bflo(hb.w); hf[15] = bfhi(hb.w);
  float o[16];
#pragma unroll
  for (int k = 0; k < 16; ++k) o[k] = 0.f;
#pragma unroll 1
  for (int g = 0; g < 128; g += 16) {
    u32x4 uu[16], vv[16];
    float wj[16];
#pragma unroll
    for (int j = 0; j < 16; ++j) {
      const int src = (g >> 1) + (j >> 1);
      const int ej = (j & 1) ? __builtin_amdgcn_readlane(e2.y, src) : __builtin_amdgcn_readlane(e2.x, src);
      wj[j] = __builtin_bit_cast(float, (j & 1) ? __builtin_amdgcn_readlane(__builtin_bit_cast(int, w2.y), src)
                                                : __builtin_amdgcn_readlane(__builtin_bit_cast(int, w2.x), src));
      const size_t ro = (size_t)ej * 1024 + 16 * lane;
      uu[j] = *(const u32x4*)(U8 + ro);
      vv[j] = *(const u32x4*)(V8 + ro);
    }
    float d[16];
#pragma unroll
    for (int j = 0; j < 16; ++j) {
      const f32x2 l0 = __builtin_amdgcn_cvt_pk_f32_fp8((int)uu[j].x, false), h0 = __builtin_amdgcn_cvt_pk_f32_fp8((int)uu[j].x, true);
      const f32x2 l1 = __builtin_amdgcn_cvt_pk_f32_fp8((int)uu[j].y, false), h1 = __builtin_amdgcn_cvt_pk_f32_fp8((int)uu[j].y, true);
      const f32x2 l2 = __builtin_amdgcn_cvt_pk_f32_fp8((int)uu[j].z, false), h2v = __builtin_amdgcn_cvt_pk_f32_fp8((int)uu[j].z, true);
      const f32x2 l3 = __builtin_amdgcn_cvt_pk_f32_fp8((int)uu[j].w, false), h3 = __builtin_amdgcn_cvt_pk_f32_fp8((int)uu[j].w, true);
      float a0 = l0.x * hf[0] + l0.y * hf[1], a1 = h0.x * hf[2] + h0.y * hf[3];
      a0 += l1.x * hf[4] + l1.y * hf[5]; a1 += h1.x * hf[6] + h1.y * hf[7];
      a0 += l2.x * hf[8] + l2.y * hf[9]; a1 += h2v.x * hf[10] + h2v.y * hf[11];
      a0 += l3.x * hf[12] + l3.y * hf[13]; a1 += h3.x * hf[14] + h3.y * hf[15];
      d[j] = a0 + a1;
    }
#pragma unroll
    for (int q = 0; q < 4; ++q) {
      const float dot = reduce4_rows(d[4 * q], d[4 * q + 1], d[4 * q + 2], d[4 * q + 3], lane);
      const float gl = gelu_tanh(dot * (1.f / 512.f)) * (1.f / 64.f);
#pragma unroll
      for (int i = 0; i < 4; ++i) {
        const int j = 4 * q + i;
        const float ci = wj[j] * __builtin_bit_cast(float, __builtin_amdgcn_readlane(__builtin_bit_cast(int, gl), 16 * i));
        f32x2 tq;
        tq = __builtin_amdgcn_cvt_pk_f32_fp8((int)vv[j].x, false); o[0] += ci * tq.x; o[1] += ci * tq.y;
        tq = __builtin_amdgcn_cvt_pk_f32_fp8((int)vv[j].x, true);  o[2] += ci * tq.x; o[3] += ci * tq.y;
        tq = __builtin_amdgcn_cvt_pk_f32_fp8((int)vv[j].y, false); o[4] += ci * tq.x; o[5] += ci * tq.y;
        tq = __builtin_amdgcn_cvt_pk_f32_fp8((int)vv[j].y, true);  o[6] += ci * tq.x; o[7] += ci * tq.y;
        tq = __builtin_amdgcn_cvt_pk_f32_fp8((int)vv[j].z, false); o[8] += ci * tq.x; o[9] += ci * tq.y;
        tq = __builtin_amdgcn_cvt_pk_f32_fp8((int)vv[j].z, true);  o[10] += ci * tq.x; o[11] += ci * tq.y;
        tq = __builtin_amdgcn_cvt_pk_f32_fp8((int)vv[j].w, false); o[12] += ci * tq.x; o[13] += ci * tq.y;
        tq = __builtin_amdgcn_cvt_pk_f32_fp8((int)vv[j].w, true);  o[14] += ci * tq.x; o[15] += ci * tq.y;
      }
    }
  }
  const int b = t >> 12;
  const float* mod = (const float*)(p.ws + OFF_MOD) + b * 6144 + 5120 + 16 * lane;
  float* xm = p.out + (size_t)t * 1024 + 16 * lane;
  float xo[16];
  float ss = 0.f;
#pragma unroll
  for (int q = 0; q < 4; ++q) {
    const float4 xv = *(const float4*)(xm + 4 * q);
    const float4 gv = *(const float4*)(mod + 4 * q);
    xo[4 * q + 0] = xv.x + gv.x * o[4 * q + 0];
    xo[4 * q + 1] = xv.y + gv.y * o[4 * q + 1];
    xo[4 * q + 2] = xv.z + gv.z * o[4 * q + 2];
    xo[4 * q + 3] = xv.w + gv.w * o[4 * q + 3];
  }
#pragma unroll
  for (int k = 0; k < 16; ++k) ss += xo[k] * xo[k];
  ss = wave_sum(ss);
  const float r = rsqrtf(ss * (1.f / 1024.f) + 1e-6f);
#pragma unroll
  for (int q = 0; q < 4; ++q) {
    const float4 fg = *(const float4*)(p.final_g + 16 * lane + 4 * q);
    *(float4*)(xm + 4 * q) = make_float4(xo[4 * q] * r * fg.x, xo[4 * q + 1] * r * fg.y, xo[4 * q + 2] * r * fg.z, xo[4 * q + 3] * r * fg.w);
  }
}

DEV void p9_experts4(const Params& p, int task, char* wsm) {
  const int lane = threadIdx.x & 63;
  const int t0 = task * 4;
  int* hist = (int*)wsm;
  unsigned* skey = (unsigned*)(wsm + 1024);
  float* swt = (float*)(wsm + 1024 + 2048);
  u16* sh2 = (u16*)(wsm + 1024 + 4096);
  hist[lane] = 0; hist[lane + 64] = 0; hist[lane + 128] = 0; hist[lane + 192] = 0;
  const int* ridx = (const int*)(p.ws + OFF_RIDX) + (size_t)t0 * 128 + lane * 8;
  const float* rw = (const float*)(p.ws + OFF_RW) + (size_t)t0 * 128 + lane * 8;
  int4 ea = *(const int4*)(ridx), eb = *(const int4*)(ridx + 4);
  float4 wa = *(const float4*)(rw), wb = *(const float4*)(rw + 4);
  int e[8] = {ea.x, ea.y, ea.z, ea.w, eb.x, eb.y, eb.z, eb.w};
  float w[8] = {wa.x, wa.y, wa.z, wa.w, wb.x, wb.y, wb.z, wb.w};
  {
    const u16* h2 = (const u16*)(p.ws + OFF_H2) + (size_t)t0 * 1024;
#pragma unroll
    for (int i = 0; i < 8; ++i) *(u32x4*)(sh2 + (lane + 64 * i) * 8) = *(const u32x4*)(h2 + (lane + 64 * i) * 8);
  }
  __builtin_amdgcn_fence(__ATOMIC_RELEASE, "wavefront");
  __builtin_amdgcn_wave_barrier();
  __builtin_amdgcn_fence(__ATOMIC_ACQUIRE, "wavefront");
  int rank[8];
#pragma unroll
  for (int j = 0; j < 8; ++j) rank[j] = atomicAdd(&hist[e[j] >> 6], 1);
  __builtin_amdgcn_fence(__ATOMIC_RELEASE, "wavefront");
  __builtin_amdgcn_wave_barrier();
  __builtin_amdgcn_fence(__ATOMIC_ACQUIRE, "wavefront");
  {
    const int c0 = hist[4 * lane], c1 = hist[4 * lane + 1], c2 = hist[4 * lane + 2], c3 = hist[4 * lane + 3];
    const int tot = c0 + c1 + c2 + c3;
    int x = tot;
#pragma unroll
    for (int o = 1; o < 64; o <<= 1) { const int y = __shfl_up(x, o); if (lane >= o) x += y; }
    const int base = x - tot;
    __builtin_amdgcn_fence(__ATOMIC_RELEASE, "wavefront");
    __builtin_amdgcn_wave_barrier();
    hist[4 * lane] = base; hist[4 * lane + 1] = base + c0; hist[4 * lane + 2] = base + c0 + c1; hist[4 * lane + 3] = base + c0 + c1 + c2;
  }
  __builtin_amdgcn_fence(__ATOMIC_RELEASE, "wavefront");
  __builtin_amdgcn_wave_barrier();
  __builtin_amdgcn_fence(__ATOMIC_ACQUIRE, "wavefront");
  {
    const unsigned slot = (unsigned)(lane >> 4);
#pragma unroll
    for (int j = 0; j < 8; ++j) {
      const int pos = hist[e[j] >> 6] + rank[j];
      skey[pos] = (unsigned)e[j] | (slot << 14);
      swt[pos] = w[j];
    }
  }
  __builtin_amdgcn_fence(__ATOMIC_RELEASE, "wavefront");
  __builtin_amdgcn_wave_barrier();
  __builtin_amdgcn_fence(__ATOMIC_ACQUIRE, "wavefront");

  float o0[16], o1[16], o2[16], o3[16];
#pragma unroll
  for (int k = 0; k < 16; ++k) { o0[k] = 0.f; o1[k] = 0.f; o2[k] = 0.f; o3[k] = 0.f; }
  const u16* U = (const u16*)(p.ws + OFF_UBF);
  const u16* V = (const u16*)(p.ws + OFF_VBF);
#define P9_LOAD(KK, UU, VV, BB)                                                           \
  _Pragma("unroll") for (int i = 0; i < 4; ++i) {                                         \
    KK[i] = (unsigned)__builtin_amdgcn_readfirstlane((int)skey[4 * (BB) + i]);            \
    const size_t ro = (size_t)(KK[i] & 16383u) * 1024 + 16 * lane;                        \
    UU[i] = *(const u32x4*)(U8 + ro);                                                     \
    VV[i] = *(const u32x4*)(V8 + ro);                                                     \
  }
#define P9_DOTS(KK, UU, BB, COEFV)                                                        \
  {                                                                                       \
    const float myw = swt[4 * (BB) + (lane >> 4)];                                        \
    float d[4];                                                                           \
    _Pragma("unroll") for (int i = 0; i < 4; ++i) {                                       \
      const unsigned slot = KK[i] >> 14;                                                  \
      const u32x4 ha = *(const u32x4*)(sh2 + slot * 1024 + 16 * lane);                    \
      const u32x4 hb = *(const u32x4*)(sh2 + slot * 1024 + 16 * lane + 8);                \
      float acc0 = 0.f, acc1 = 0.f;                                                       \
      {                                                                                   \
        f32x2 l0 = __builtin_amdgcn_cvt_pk_f32_fp8((int)UU[i].x, false), h0 = __builtin_amdgcn_cvt_pk_f32_fp8((int)UU[i].x, true); \
        f32x2 l1 = __builtin_amdgcn_cvt_pk_f32_fp8((int)UU[i].y, false), h1 = __builtin_amdgcn_cvt_pk_f32_fp8((int)UU[i].y, true); \
        f32x2 l2 = __builtin_amdgcn_cvt_pk_f32_fp8((int)UU[i].z, false), h2_ = __builtin_amdgcn_cvt_pk_f32_fp8((int)UU[i].z, true); \
        f32x2 l3 = __builtin_amdgcn_cvt_pk_f32_fp8((int)UU[i].w, false), h3 = __builtin_amdgcn_cvt_pk_f32_fp8((int)UU[i].w, true); \
        acc0 += l0.x * bflo(ha.x) + l0.y * bfhi(ha.x); acc1 += h0.x * bflo(ha.y) + h0.y * bfhi(ha.y);   \
        acc0 += l1.x * bflo(ha.z) + l1.y * bfhi(ha.z); acc1 += h1.x * bflo(ha.w) + h1.y * bfhi(ha.w);   \
        acc0 += l2.x * bflo(hb.x) + l2.y * bfhi(hb.x); acc1 += h2_.x * bflo(hb.y) + h2_.y * bfhi(hb.y); \
        acc0 += l3.x * bflo(hb.z) + l3.y * bfhi(hb.z); acc1 += h3.x * bflo(hb.w) + h3.y * bfhi(hb.w);   \
      }                                                                                   \
      d[i] = acc0 + acc1;                                                                 \
    }                                                                                     \
    const bool up32 = (lane & 32) != 0, up16 = (lane & 16) != 0;                          \
    float k0 = up32 ? d[2] : d[0], k1 = up32 ? d[3] : d[1];                               \
    float s0 = up32 ? d[0] : d[2], s1 = up32 ? d[1] : d[3];                               \
    k0 += __shfl_xor(s0, 32);                                                             \
    k1 += __shfl_xor(s1, 32);                                                             \
    float kq = up16 ? k1 : k0, sq = up16 ? k0 : k1;                                       \
    kq += __shfl_xor(sq, 16);                                                             \
    kq = DPP_ADD(kq, 0xB1);                                                               \
    kq = DPP_ADD(kq, 0x4E);                                                               \
    kq = DPP_ADD(kq, 0x141);                                                              \
    kq = DPP_ADD(kq, 0x140);                                                              \
    COEFV = myw * (1.f / 64.f) * gelu_tanh(kq * (1.f / 512.f));                           \
  }
#define P9_ACCUM(KK, VV, COEFV)                                                           \
  _Pragma("unroll") for (int i = 0; i < 4; ++i) {                                         \
    const float ci = __builtin_bit_cast(float, __builtin_amdgcn_readlane(__builtin_bit_cast(int, COEFV), 16 * i)); \
    const unsigned slot = KK[i] >> 14;                                                    \
    float vf[16];                                                                         \
    {                                                                                     \
      f32x2 t;                                                                            \
      t = __builtin_amdgcn_cvt_pk_f32_fp8((int)VV[i].x, false); vf[0] = t.x; vf[1] = t.y;   \
      t = __builtin_amdgcn_cvt_pk_f32_fp8((int)VV[i].x, true);  vf[2] = t.x; vf[3] = t.y;   \
      t = __builtin_amdgcn_cvt_pk_f32_fp8((int)VV[i].y, false); vf[4] = t.x; vf[5] = t.y;   \
      t = __builtin_amdgcn_cvt_pk_f32_fp8((int)VV[i].y, true);  vf[6] = t.x; vf[7] = t.y;   \
      t = __builtin_amdgcn_cvt_pk_f32_fp8((int)VV[i].z, false); vf[8] = t.x; vf[9] = t.y;   \
      t = __builtin_amdgcn_cvt_pk_f32_fp8((int)VV[i].z, true);  vf[10] = t.x; vf[11] = t.y; \
      t = __builtin_amdgcn_cvt_pk_f32_fp8((int)VV[i].w, false); vf[12] = t.x; vf[13] = t.y; \
      t = __builtin_amdgcn_cvt_pk_f32_fp8((int)VV[i].w, true);  vf[14] = t.x; vf[15] = t.y; \
    }                                                                                     \
    if (slot == 0) { _Pragma("unroll") for (int k = 0; k < 16; ++k) o0[k] += ci * vf[k]; }       \
    else if (slot == 1) { _Pragma("unroll") for (int k = 0; k < 16; ++k) o1[k] += ci * vf[k]; }  \
    else if (slot == 2) { _Pragma("unroll") for (int k = 0; k < 16; ++k) o2[k] += ci * vf[k]; }  \
    else { _Pragma("unroll") for (int k = 0; k < 16; ++k) o3[k] += ci * vf[k]; }                 \
  }
  {
    const unsigned char* U8 = (const unsigned char*)(p.ws + OFF_UBF);
    const unsigned char* V8 = (const unsigned char*)(p.ws + OFF_VBF);
    unsigned kkA[4], kkB[4];
    u32x4 uA[4], vA[4], uB[4], vB[4];
    float cfA, cfB;
    P9_LOAD(kkA, uA, vA, 0)
#pragma unroll 1
    for (int bb = 0; bb < 128; bb += 2) {
      P9_LOAD(kkB, uB, vB, bb + 1)
      P9_DOTS(kkA, uA, bb, cfA)
      P9_ACCUM(kkA, vA, cfA)
      const int n0 = (bb + 2 < 128) ? (bb + 2) : 0;
      P9_LOAD(kkA, uA, vA, n0)
      P9_DOTS(kkB, uB, bb + 1, cfB)
      P9_ACCUM(kkB, vB, cfB)
    }
  }
#pragma unroll
  for (int s = 0; s < 4; ++s) {
    const int t = t0 + s;
    const int b = t >> 12;
    const float* mod = (const float*)(p.ws + OFF_MOD) + b * 6144 + 5120 + 16 * lane;
    float* xm = p.out + (size_t)t * 1024 + 16 * lane;
    const float* oo = (s == 0) ? o0 : ((s == 1) ? o1 : ((s == 2) ? o2 : o3));
    float xo[16];
    float ss = 0.f;
#pragma unroll
    for (int q = 0; q < 4; ++q) {
      const float4 xv = *(const float4*)(xm + 4 * q);
      const float4 gv = *(const float4*)(mod + 4 * q);
      xo[4 * q + 0] = xv.x + gv.x * oo[4 * q + 0];
      xo[4 * q + 1] = xv.y + gv.y * oo[4 * q + 1];
      xo[4 * q + 2] = xv.z + gv.z * oo[4 * q + 2];
      xo[4 * q + 3] = xv.w + gv.w * oo[4 * q + 3];
    }
#pragma unroll
    for (int k = 0; k < 16; ++k) ss += xo[k] * xo[k];
    ss = wave_sum(ss);
    const float r = rsqrtf(ss * (1.f / 1024.f) + 1e-6f);
#pragma unroll
    for (int q = 0; q < 4; ++q) {
      const float4 fg = *(const float4*)(p.final_g + 16 * lane + 4 * q);
      *(float4*)(xm + 4 * q) = make_float4(xo[4 * q] * r * fg.x, xo[4 * q + 1] * r * fg.y, xo[4 * q + 2] * r * fg.z, xo[4 * q + 3] * r * fg.w);
    }
  }
  __builtin_amdgcn_fence(__ATOMIC_RELEASE, "wavefront");
  __builtin_amdgcn_wave_barrier();
}

#define XB_TMO      128
#define XB_XCNT(j)  (256  + 64 * (j))
#define XB_XSUB(j)  (1280 + 64 * (j))
#define XB_XGEN(j)  (2304 + 64 * (j))
#define XB_TOP      3328
#define XB_TOPGEN   3392
#define XCD_BAR_WORDS 3456
#define XB_SPIN_CAP (1u << 18)
#define LAS __attribute__((address_space(3)))

__device__ __forceinline__ unsigned xb_ld(unsigned* p)              { return __hip_atomic_load(p, __ATOMIC_RELAXED, __HIP_MEMORY_SCOPE_AGENT); }
__device__ __forceinline__ unsigned xb_add(unsigned* p, unsigned v) { return __hip_atomic_fetch_add(p, v, __ATOMIC_RELAXED, __HIP_MEMORY_SCOPE_AGENT); }
__device__ __forceinline__ unsigned xb_xcc_id() { return (unsigned)__builtin_amdgcn_s_getreg((3 << 11) | 20) & 0xFu; }
#define XB_SPIN(cond, bar) do { unsigned _sp = 0; while (cond) { __builtin_amdgcn_s_sleep(1); \
    if ((++_sp & 255u) == 0u) { if (xb_ld(&(bar)[XB_TMO])) break; if (_sp > XB_SPIN_CAP) { atomicAdd(&(bar)[XB_TMO], 1u); break; } } } } while (0)

struct XcdBarrier {
    unsigned* bar; unsigned x;
    volatile LAS unsigned* st;
};

__device__ __forceinline__ XcdBarrier xcd_barrier_post(unsigned* bar, volatile LAS unsigned* st) {
    XcdBarrier b; b.bar = bar; b.x = xb_xcc_id(); b.st = st;
    if (threadIdx.x == 0) (void)xb_add(&bar[XB_XCNT(b.x)], 1u);
    return b;
}
__device__ __forceinline__ void xcd_barrier_complete(unsigned* bar, unsigned x, unsigned& nloc, unsigned& nx) {
    const unsigned G = gridDim.x * gridDim.y * gridDim.z;
    unsigned sum, cnt, mine, sp = 0u;
    for (;;) {
        sum = 0u; cnt = 0u; mine = 0u;
#pragma unroll
        for (unsigned j = 0; j < 16; ++j) { const unsigned c = xb_ld(&bar[XB_XCNT(j)]); sum += c; cnt += (c > 0u) ? 1u : 0u; mine = (j == x) ? c : mine; }
        if (sum == G) break;
        __builtin_amdgcn_s_sleep(1);
        if ((++sp & 255u) == 0u) { if (xb_ld(&bar[XB_TMO])) break; if (sp > XB_SPIN_CAP) { atomicAdd(&bar[XB_TMO], 1u); break; } }
    }
    nloc = mine > 0u ? mine : 1u; nx = cnt > 0u ? cnt : 1u;
}

__device__ __forceinline__ void xcd_barrier(const XcdBarrier& b) {
    asm volatile("s_waitcnt vmcnt(0)" ::: "memory");
    __syncthreads();
    if (threadIdx.x == 0) {
        unsigned* bar = b.bar;
        __builtin_amdgcn_s_waitcnt(0);
        unsigned nloc = b.st[0], nx = b.st[1];
        if (nloc == 0u) { xcd_barrier_complete(bar, b.x, nloc, nx); b.st[0] = nloc; b.st[1] = nx; }
        const unsigned old = xb_add(&bar[XB_XSUB(b.x)], 1u);
        const unsigned gen = old / nloc;
        if (old + 1u == (gen + 1u) * nloc) {
            __builtin_amdgcn_fence(__ATOMIC_RELEASE, "agent");
            asm volatile("s_waitcnt vmcnt(0)" ::: "memory");
            const unsigned og = xb_add(&bar[XB_TOP], 1u);
            const unsigned tg = og / nx;
            if (og + 1u == (tg + 1u) * nx) xb_add(&bar[XB_TOPGEN], 1u);
            else XB_SPIN(xb_ld(&bar[XB_TOPGEN]) == tg, bar);
            __builtin_amdgcn_fence(__ATOMIC_ACQUIRE, "agent");
            xb_add(&bar[XB_XGEN(b.x)], 1u);
            asm volatile("s_waitcnt vmcnt(0)" ::: "memory");
        } else {
            XB_SPIN(xb_ld(&bar[XB_XGEN(b.x)]) == gen, bar);
            __builtin_amdgcn_fence(__ATOMIC_ACQUIRE, "agent");
            asm volatile("s_waitcnt vmcnt(0)" ::: "memory");
        }
    }
    __syncthreads();
}


__global__ void __launch_bounds__(256, 2) mega(Params p) {
  extern __shared__ __attribute__((aligned(16))) char smem[];
  cg::grid_group grid = cg::this_grid();
  const int tid = threadIdx.x, lane = tid & 63, wave = tid >> 6;
  const int nb = gridDim.x, bid = blockIdx.x;
  float* smf = (float*)smem;
  if (p.ws == nullptr) grid.sync();
  volatile LAS unsigned* xst = (volatile LAS unsigned*)(smem + SMEM_XB);
  if (tid == 0) { xst[0] = 0u; xst[1] = 0u; }
  __syncthreads();
  const XcdBarrier xb = xcd_barrier_post((unsigned*)(p.ws + OFF_BAR), xst);
  u16* sA = (u16*)smem;
  u16* sB = (u16*)(smem + 128 * 64 * 2);

  for (int rep_ = 0; rep_ < NREP(0); ++rep_) if (PHON(0)) {
    const int N_MOD = 384, N_TIN = 16 * 68, N_TOA = 8 * 16, N_TOH = 8 * 16, N_TOUT = 16 * 16, N_TQ = 16 * 16, N_HID = 1024;
    const int total = N_MOD + N_TIN + N_TOA + N_TOH + N_TOUT + N_TQ + N_HID + 16 + 1;
    for (int it = bid; it < total; it += nb) {
      int i = it;
      if (i < N_MOD) { p0_mod(p, i, smf); continue; }
      i -= N_MOD;
      if (i < N_TIN) { transpose_tile(p.w_in, INW, 1024, (u16*)(p.ws + OFF_WIN), i, smf); continue; }
      i -= N_TIN;
      if (i < N_TOA) { transpose_tile(p.w_o_attn, 1024, 512, (u16*)(p.ws + OFF_WOA), i, smf); continue; }
      i -= N_TOA;
      if (i < N_TOH) { transpose_tile(p.w_o_hy, 1024, 512, (u16*)(p.ws + OFF_WOH), i, smf); continue; }
      i -= N_TOH;
      if (i < N_TOUT) { transpose_tile(p.w_out, 1024, 1024, (u16*)(p.ws + OFF_WOUT), i, smf); continue; }
      i -= N_TOUT;
      if (i < N_TQ) { transpose_tile(p.peer_wq, 1024, 1024, (u16*)(p.ws + OFF_WQ), i, smf); continue; }
      i -= N_TQ;
      if (i < N_HID) { p0_hidden(p, i, smf); continue; }
      i -= N_HID;
      if (i < 16) { transpose_tile(p.hy_fw3, 1024, 64, (u16*)(p.ws + OFF_H2F + 512 * 1024), i, smf); continue; }
      float2* rope = (float2*)(p.ws + OFF_ROPE);
      for (int idx = tid; idx < 1024; idx += 256) {
        const int pos = idx >> 4, f = idx & 15;
        const float inv = powf(10000.f, -(float)f / 16.f);
        const float ang = (float)pos * inv;
        rope[idx] = make_float2(cosf(ang), sinf(ang));
      }
    }
    convert_flat(p.peer_keys, (u16*)(p.ws + OFF_KEYS), (size_t)131072);
    convert_flat_fp8(p.peer_u, (unsigned char*)(p.ws + OFF_UBF), (size_t)16384 * 1024, 512.f);
    convert_flat_fp8(p.peer_v, (unsigned char*)(p.ws + OFF_VBF), (size_t)16384 * 1024, 64.f);
  }
  xcd_barrier(xb);

  for (int rep_ = 0; rep_ < NREP(1); ++rep_) if (PHON(1)) {
    const float* mod = (const float*)(p.ws + OFF_MOD);
    const int nrows = T_TOK + 1024;
    for (int r = bid * 4 + wave; r < nrows; r += nb * 4) {
      if (r < T_TOK) {
        const int b = r >> 12;
        norm_row(p.x + (size_t)r * 1024, p.norm1_g, mod + b * 6144, mod + b * 6144 + 1024,
                 (u16*)((char*)p.out + OO_H1) + (size_t)r * 1024, lane);
      } else {
        const int rc = r - T_TOK;
        norm_row(p.ctx + (size_t)rc * 1024, p.norm1_g, mod + 4 * 6144, mod + 4 * 6144 + 1024,
                 (u16*)((char*)p.out + OO_HC) + (size_t)rc * 1024, lane);
      }
    }
    for (int it = bid; it < 256; it += nb) p1_filter_tile(p, (it + 256 < nb) ? it : it, sA, sB);
  }
  xcd_barrier(xb);

  for (int rep_ = 0; rep_ < NREP(2); ++rep_) if (PHON(2)) {
    if (nb == 512) {
      const int xg = bid & 7, slot = bid >> 3;
      for (int r = 0; r < 8; ++r) {
        const int sup = r * 8 + xg;
        const int mt = (sup >> 2) * 8 + (slot >> 3), nt = (sup & 3) * 8 + (slot & 7);
        p2_inproj(p, mt * 34 + nt, sA, sB);
      }
      if (bid < 256) p2_inproj(p, (bid >> 1) * 34 + 32 + (bid & 1), sA, sB);
      else if (bid < 272) p2_ctxkv(p, bid - 256, sA, sB);
    } else {
      const int total = 128 * 34 + 16;
      for (int it = bid; it < total; it += nb) {
        if (it < 128 * 34) p2_inproj(p, it, sA, sB);
        else p2_ctxkv(p, it - 128 * 34, sA, sB);
      }
    }
  }
  xcd_barrier(xb);

  for (int rep_ = 0; rep_ < NREP(3); ++rep_) if (PHON(3)) {
    const int total = 1024 + 1024;
    for (int it = bid; it < total; it += nb) {
      if (it < 1024) p3_attn(p, it, (u16*)smem, (u16*)(smem + 128 * 72 * 2));
      else p3_hypre(p, it - 1024, (u16*)smem);
    }
  }
  xcd_barrier(xb);

  for (int rep_ = 0; rep_ < NREP(4); ++rep_) if (PHON(4)) for (int it = bid; it < 512; it += nb) p3_toeplitz(p, it, smem);
  xcd_barrier(xb);

  for (int rep_ = 0; rep_ < NREP(5); ++rep_) if (PHON(5)) for (int it = bid; it < 1024; it += nb) p4_merge(p, (nb == 512) ? ((((it >> 9) * 8 + (bid & 7)) * 8 + (bid >> 6)) * 8 + ((bid >> 3) & 7)) : it, sA, sB);
  xcd_barrier(xb);

  for (int rep_ = 0; rep_ < NREP(6); ++rep_) if (PHON(6)) for (int it = bid; it < 1024; it += nb) p5_out(p, (nb == 512) ? ((((it >> 9) * 8 + (bid & 7)) * 8 + (bid >> 6)) * 8 + ((bid >> 3) & 7)) : it, sA, sB);
  xcd_barrier(xb);

  for (int rep_ = 0; rep_ < NREP(7); ++rep_) if (PHON(7)) {
    const float* mod = (const float*)(p.ws + OFF_MOD);
    for (int r = bid * 4 + wave; r < T_TOK; r += nb * 4) {
      const int b = r >> 12;
      norm_row(p.out + (size_t)r * 1024, p.norm2_g, mod + b * 6144 + 3072, mod + b * 6144 + 4096,
               (u16*)(p.ws + OFF_H2) + (size_t)r * 1024, lane);
    }
  }
  xcd_barrier(xb);

  for (int rep_ = 0; rep_ < NREP(8); ++rep_) if (PHON(8)) for (int it = bid; it < 1024; it += nb) p7_qp(p, (nb == 512) ? ((((it >> 9) * 8 + (bid & 7)) * 8 + (bid >> 6)) * 8 + ((bid >> 3) & 7)) : it, sA, sB);
  xcd_barrier(xb);

  for (int rep_ = 0; rep_ < NREP(9); ++rep_) if (PHON(9)) for (int it = bid * 4 + wave; it < 8192; it += nb * 4) p8_route(p, it, smem + wave * 4096);
  xcd_barrier(xb);

  if (PHON(10)) {
    const int nw = nb * 4;
    int t = bid * 4 + wave;
    if (t < T_TOK) {
      int2 e2n = *(const int2*)((const int*)(p.ws + OFF_RIDX) + (size_t)t * 128 + 2 * lane);
      float2 w2n = *(const float2*)((const float*)(p.ws + OFF_RW) + (size_t)t * 128 + 2 * lane);
      u32x4 han = *(const u32x4*)((const u16*)(p.ws + OFF_H2) + (size_t)t * 1024 + 16 * lane);
      u32x4 hbn = *(const u32x4*)((const u16*)(p.ws + OFF_H2) + (size_t)t * 1024 + 16 * lane + 8);
      for (; t < T_TOK; t += nw) {
        const int tn = (t + nw < T_TOK) ? (t + nw) : t;
        p9_token(p, t, tn, lane, e2n, w2n, han, hbn);
      }
    }
  }
}

extern "C" void kernel_launch(void* const* d_in, const int* in_sizes, int n_in, void* d_out, int out_size,
                              void* d_ws, size_t ws_size, hipStream_t stream) {
  static int grid_blocks = 0;
  if (!grid_blocks) {
    int dev = 0, cus = 0, per_cu = 0;
    (void)hipGetDevice(&dev);
    (void)hipDeviceGetAttribute(&cus, hipDeviceAttributeMultiprocessorCount, dev);
    (void)hipFuncSetAttribute((const void*)mega, hipFuncAttributeMaxDynamicSharedMemorySize, SMEM_BYTES);
    (void)hipOccupancyMaxActiveBlocksPerMultiprocessor(&per_cu, mega, 256, SMEM_BYTES);
    if (per_cu > 2) per_cu = 2;
    if (per_cu < 1) per_cu = 1;
    grid_blocks = cus * per_cu;
  }
  Params p{};
  const float** pp = (const float**)&p;
  for (int i = 0; i < 28; ++i) pp[i] = (const float*)d_in[i];
  p.out = (float*)d_out;
  p.ws = (char*)d_ws;
  (void)hipMemsetAsync((char*)d_ws, 0, OFF_BAR + 24576, stream);
  void* args[] = {&p};
  hipError_t e = hipLaunchCooperativeKernel((void*)mega, dim3(grid_blocks), dim3(256), args, SMEM_BYTES, stream);
  if (e != hipSuccess) fprintf(stderr, "cooperative launch failed: %s (grid %d)\n", hipGetErrorString(e), grid_blocks);
}
```

```cpp
#include <hip/hip_runtime.h>
#include <hip/hip_bf16.h>
#include <hip/hip_cooperative_groups.h>
#include <cstdio>
namespace cg = cooperative_groups;

typedef unsigned short u16;
typedef __attribute__((ext_vector_type(8))) short bf16x8;
typedef __attribute__((ext_vector_type(4))) float f32x4;
typedef __attribute__((ext_vector_type(4))) unsigned u32x4;

#define DEV __device__ __forceinline__
#ifndef PH
#define PH -1
#endif
#define PHON(n) (PH < 0 || PH == (n))
#ifndef REP
#define REP -1
#endif
#define NREP(n) ((REP == (n)) ? 2 : 1)

constexpr int T_TOK = 16384;
constexpr int DM = 1024;
constexpr int SEQL = 4096;
constexpr int INW = 4352;

struct Params {
  const float *x, *c, *ctx, *c_ctx, *w_mod, *b_mod, *norm1_g, *w_in, *attn_sink, *hy_conv_w, *hy_conv_b,
      *hy_fw1, *hy_fb1, *hy_fw2, *hy_fb2, *hy_fw3, *hy_fb3, *hy_freq, *hy_skip, *w_o_attn, *w_o_hy, *w_out,
      *norm2_g, *peer_wq, *peer_keys, *peer_u, *peer_v, *final_g;
  float* out;
  char* ws;
};

constexpr size_t MB = 1u << 20;
constexpr size_t OFF_MOD = 0;
constexpr size_t OFF_ROPE = 128 * 1024;
constexpr size_t OFF_NINV = OFF_ROPE + 8192;
constexpr size_t OFF_H2F = 256 * 1024;
constexpr size_t OFF_WIN = OFF_H2F + MB;
constexpr size_t OFF_WOA = OFF_WIN + 9 * MB;
constexpr size_t OFF_WOH = OFF_WOA + MB;
constexpr size_t OFF_WOUT = OFF_WOH + MB;
constexpr size_t OFF_WQ = OFF_WOUT + 2 * MB;
constexpr size_t OFF_KEYS = OFF_WQ + 2 * MB;
constexpr size_t OFF_UBF = OFF_KEYS + MB;
constexpr size_t OFF_VBF = OFF_UBF + 32 * MB;
constexpr size_t OFF_Q = OFF_VBF + 32 * MB;
constexpr size_t OFF_K = OFF_Q + 16 * MB;
constexpr size_t OFF_VT = OFF_K + 4 * MB;
constexpr size_t OFF_KC = OFF_VT + 4 * MB;
constexpr size_t OFF_VCT = OFF_KC + MB / 2;
constexpr size_t OFF_Z = OFF_VCT + MB / 2;
constexpr size_t OFF_GATE = OFF_Z + 48 * MB;
constexpr size_t OFF_YATT = OFF_GATE + 64 * MB;
constexpr size_t OFF_YHY = OFF_YATT + 16 * MB;
constexpr size_t OFF_RIDX = OFF_Q;
constexpr size_t OFF_RW = OFF_Q + 8 * MB;
constexpr size_t OFF_MERGED = OFF_Z;
constexpr size_t OFF_H2 = OFF_GATE;
constexpr size_t OFF_QP = OFF_GATE + 32 * MB;
constexpr size_t OO_H1 = 0;
constexpr size_t OO_UT = 0;
constexpr size_t OO_X0T = 16 * MB;
constexpr size_t OO_HC = 32 * MB;
constexpr size_t OO_G = 34 * MB;

constexpr int SMEM_BYTES = 70144;
constexpr size_t OFF_BAR = 160 * 1024;
constexpr int SMEM_XB = 70016;

typedef __attribute__((ext_vector_type(2))) float pk_f2;
typedef __attribute__((ext_vector_type(2))) __bf16 pk_b2;
DEV unsigned pack2(float a, float b) {
  pk_f2 v = {a, b};
  return __builtin_bit_cast(unsigned, __builtin_convertvector(v, pk_b2));
}
DEV u16 f2bf(float f) { return (u16)(pack2(f, 0.f) & 0xffffu); }
DEV float bf2f(u16 h) { return __uint_as_float(((unsigned)h) << 16); }
DEV float bflo(unsigned w) { return __uint_as_float(w << 16); }
DEV float bfhi(unsigned w) { return __uint_as_float(w & 0xffff0000u); }
#define DPP_ADD(v, ctrl) ((v) + __builtin_bit_cast(float, __builtin_amdgcn_update_dpp(0, __builtin_bit_cast(int, (v)), (ctrl), 0xF, 0xF, true)))
DEV float wave_sum(float v) {
#pragma unroll
  for (int o = 32; o > 0; o >>= 1) v += __shfl_xor(v, o);
  return v;
}
DEV float wave_max(float v) {
#pragma unroll
  for (int o = 32; o > 0; o >>= 1) v = fmaxf(v, __shfl_xor(v, o));
  return v;
}

DEV void p0_mod(const Params& p, int item, float* sm) {
  const int tid = threadIdx.x;
  const int cblk = item >> 2, kq = item & 3;
  for (int i = tid; i < 5 * 256; i += 256) {
    const int r = i >> 8, k = kq * 256 + (i & 255);
    const float c = (r < 4) ? p.c[r * 1024 + k] : p.c_ctx[k];
    sm[i] = c / (1.f + expf(-c));
  }
  __syncthreads();
  const int col = cblk * 64 + (tid & 63), sub = tid >> 6;
  float a0 = 0, a1 = 0, a2 = 0, a3 = 0, a4 = 0;
  const float* wp = p.w_mod + (size_t)(kq * 256 + sub * 64) * 6144 + col;
#pragma unroll 16
  for (int k = 0; k < 64; ++k) {
    const float w = wp[(size_t)k * 6144];
    const int kk = sub * 64 + k;
    a0 += sm[kk] * w; a1 += sm[256 + kk] * w; a2 += sm[512 + kk] * w; a3 += sm[768 + kk] * w; a4 += sm[1024 + kk] * w;
  }
  float* red = sm + 5 * 256;
  red[(sub * 5 + 0) * 64 + (tid & 63)] = a0;
  red[(sub * 5 + 1) * 64 + (tid & 63)] = a1;
  red[(sub * 5 + 2) * 64 + (tid & 63)] = a2;
  red[(sub * 5 + 3) * 64 + (tid & 63)] = a3;
  red[(sub * 5 + 4) * 64 + (tid & 63)] = a4;
  __syncthreads();
  float* mod = (float*)(p.ws + OFF_MOD);
  for (int i = tid; i < 320; i += 256) {
    const int r = i >> 6, cc = i & 63;
    float sacc = red[(0 * 5 + r) * 64 + cc] + red[(1 * 5 + r) * 64 + cc] + red[(2 * 5 + r) * 64 + cc] + red[(3 * 5 + r) * 64 + cc];
    if (kq == 0) sacc += p.b_mod[cblk * 64 + cc];
    atomicAdd(mod + r * 6144 + cblk * 64 + cc, sacc);
  }
  __syncthreads();
}

DEV void transpose_tile(const float* __restrict__ src, int N, int K, u16* __restrict__ dst, int tile, float* sm) {
  const int tid = threadIdx.x;
  const int nkt = K >> 6;
  const int kt = tile % nkt, nt = tile / nkt;
  const int k0 = kt * 64, n0 = nt * 64;
  const int c4 = tid & 15, r = tid >> 4;
  float4 tv[4];
#pragma unroll
  for (int rr = 0; rr < 4; ++rr) tv[rr] = *(const float4*)(src + (size_t)(k0 + rr * 16 + r) * N + n0 + c4 * 4);
#pragma unroll
  for (int rr = 0; rr < 4; ++rr) {
    float* d0 = sm + (rr * 16 + r) * 65 + c4 * 4;
    d0[0] = tv[rr].x; d0[1] = tv[rr].y; d0[2] = tv[rr].z; d0[3] = tv[rr].w;
  }
  __syncthreads();
  const int nn = tid >> 2, part = tid & 3;
  unsigned w[8];
#pragma unroll
  for (int j = 0; j < 8; ++j) w[j] = pack2(sm[(part * 16 + 2 * j) * 65 + nn], sm[(part * 16 + 2 * j + 1) * 65 + nn]);
  uint4* d = (uint4*)(dst + (size_t)(n0 + nn) * K + k0 + part * 16);
  d[0] = make_uint4(w[0], w[1], w[2], w[3]);
  d[1] = make_uint4(w[4], w[5], w[6], w[7]);
  __syncthreads();
}

DEV void p0_hidden(const Params& p, int item, float* sm) {
  const int tid = threadIdx.x;
  float* z = sm;
  float* h1 = sm + 4 * 36;
  if (tid < 4 * 33) {
    int tt = tid / 33, i = tid % 33;
    int t = item * 4 + tt;
    float v;
    if (i == 0) v = (float)t * (1.f / 4096.f);
    else {
      int band = (i <= 16) ? i : (i - 16);
      float fr = (float)((t * band) & 4095) * (1.f / 4096.f);
      v = (i <= 16) ? cospif(2.f * fr) : sinpif(2.f * fr);
    }
    z[tt * 36 + i] = v;
  }
  __syncthreads();
  const int tt = tid >> 6, j = tid & 63;
  float a = p.hy_fb1[j];
  for (int i = 0; i < 33; ++i) a += z[tt * 36 + i] * p.hy_fw1[i * 64 + j];
  const float fq = p.hy_freq[j];
  h1[tt * 64 + j] = sinf(fq * a);
  __syncthreads();
  float b = p.hy_fb2[j];
  for (int i = 0; i < 64; ++i) b += h1[tt * 64 + i] * p.hy_fw2[i * 64 + j];
  ((u16*)(p.ws + OFF_H2F))[(item * 4 + tt) * 64 + j] = f2bf(sinf(fq * b));
  __syncthreads();
}

DEV void convert_flat(const float* __restrict__ src, u16* __restrict__ dst, size_t n) {
  size_t stride = (size_t)gridDim.x * 256 * 8;
  for (size_t i = ((size_t)blockIdx.x * 256 + threadIdx.x) * 8; i < n; i += stride) {
    float4 a = *(const float4*)(src + i);
    float4 b = *(const float4*)(src + i + 4);
    *(uint4*)(dst + i) = make_uint4(pack2(a.x, a.y), pack2(a.z, a.w), pack2(b.x, b.y), pack2(b.z, b.w));
  }
}

typedef __attribute__((ext_vector_type(2))) float f32x2;
DEV void convert_flat_fp8(const float* __restrict__ src, unsigned char* __restrict__ dst, size_t n, float scale) {
  const size_t q4 = (size_t)gridDim.x * 256 * 16;
  const size_t stride = q4 * 4;
  for (size_t i = ((size_t)blockIdx.x * 256 + threadIdx.x) * 16; i < n; i += stride) {
    float4 a[16];
#pragma unroll
    for (int c = 0; c < 4; ++c) {
      const size_t off = i + c * q4;
      if (off < n) {
#pragma unroll
        for (int q = 0; q < 4; ++q) a[c * 4 + q] = *(const float4*)(src + off + 4 * q);
      }
    }
#pragma unroll
    for (int c = 0; c < 4; ++c) {
      const size_t off = i + c * q4;
      if (off < n) {
        unsigned w[4];
#pragma unroll
        for (int q = 0; q < 4; ++q) {
          int v = 0;
          v = __builtin_amdgcn_cvt_pk_fp8_f32(a[c * 4 + q].x * scale, a[c * 4 + q].y * scale, v, false);
          v = __builtin_amdgcn_cvt_pk_fp8_f32(a[c * 4 + q].z * scale, a[c * 4 + q].w * scale, v, true);
          w[q] = (unsigned)v;
        }
        *(uint4*)(dst + off) = make_uint4(w[0], w[1], w[2], w[3]);
      }
    }
  }
}

DEV void norm_row(const float* __restrict__ xr, const float* __restrict__ g, const float* __restrict__ sh,
                  const float* __restrict__ sc, u16* __restrict__ dst, int lane) {
  float4 v[4];
  float ss = 0.f;
#pragma unroll
  for (int i = 0; i < 4; ++i) {
    v[i] = ((const float4*)xr)[lane + 64 * i];
    ss += v[i].x * v[i].x + v[i].y * v[i].y + v[i].z * v[i].z + v[i].w * v[i].w;
  }
  ss = wave_sum(ss);
  const float r = rsqrtf(ss * (1.f / 1024.f) + 1e-6f);
#pragma unroll
  for (int i = 0; i < 4; ++i) {
    const int idx = lane + 64 * i;
    float4 gg = ((const float4*)g)[idx], s1 = ((const float4*)sh)[idx], s2 = ((const float4*)sc)[idx];
    float y0 = v[i].x * r * gg.x * (1.f + s2.x) + s1.x;
    float y1 = v[i].y * r * gg.y * (1.f + s2.y) + s1.y;
    float y2 = v[i].z * r * gg.z * (1.f + s2.z) + s1.z;
    float y3 = v[i].w * r * gg.w * (1.f + s2.w) + s1.w;
    *(uint2*)(dst + idx * 4) = make_uint2(pack2(y0, y1), pack2(y2, y3));
  }
}

DEV void p1_filter(const Params& p, int item, float* sm) {
  const int tid = threadIdx.x;
  const int c0 = (item >> 2) * 4, tq = item & 3;
  float* wc = sm;
  float* red = sm + 512;
  for (int i = tid; i < 512; i += 256) {
    const int j = i >> 6, k = i & 63;
    wc[i] = p.hy_fw3[k * 1024 + ((j < 4) ? (c0 + j) : (512 + c0 + j - 4))];
  }
  __syncthreads();
  float fb[8], dl[4];
#pragma unroll
  for (int j = 0; j < 8; ++j) fb[j] = p.hy_fb3[(j < 4) ? (c0 + j) : (512 + c0 + j - 4)];
  const float da = logf(1e-2f) / 1.5f, db = logf(1e-2f) / 0.3f;
#pragma unroll
  for (int j = 0; j < 4; ++j) dl[j] = fabsf(da + (db - da) * (float)(c0 + j) / 511.f);
  u16* G = (u16*)((char*)p.out + OO_G);
  const float* H = (const float*)(p.ws + OFF_H2F);
  float as[4] = {0.f, 0.f, 0.f, 0.f};
#pragma unroll 1
  for (int i = 0; i < 4; ++i) {
    const int t = tq * 1024 + i * 256 + tid;
    const float4* hp = (const float4*)(H + t * 64);
    float d[8];
#pragma unroll
    for (int j = 0; j < 8; ++j) d[j] = fb[j];
#pragma unroll 1
    for (int q8 = 0; q8 < 16; q8 += 8) {
      float4 hv[8];
#pragma unroll
      for (int u = 0; u < 8; ++u) hv[u] = hp[q8 + u];
#pragma unroll
      for (int u = 0; u < 8; ++u)
#pragma unroll
        for (int j = 0; j < 8; ++j) {
          const float4 w = *(const float4*)(wc + j * 64 + 4 * (q8 + u));
          d[j] += hv[u].x * w.x + hv[u].y * w.y + hv[u].z * w.z + hv[u].w * w.w;
        }
    }
    const float tn = (float)t * (1.f / 4096.f);
#pragma unroll
    for (int j = 0; j < 4; ++j) {
      const float dec = expf(-tn * dl[j]);
      const float f = d[j] * dec, bw = d[4 + j] * dec;
      u16* Gc = G + (size_t)(c0 + j) * 8192;
      Gc[4095 - t] = f2bf(f);
      as[j] += fabsf(f);
      if (t < 4095) { Gc[4096 + t] = f2bf(bw); as[j] += fabsf(bw); }
      else Gc[8191] = 0;
    }
  }
#pragma unroll
  for (int j = 0; j < 4; ++j) {
    const float v = wave_sum(as[j]);
    if ((tid & 63) == 0) red[(tid >> 6) * 4 + j] = v;
  }
  __syncthreads();
  if (tid < 4) atomicAdd((float*)(p.ws + OFF_BAR + 20480) + c0 + tid, red[tid] + red[4 + tid] + red[8 + tid] + red[12 + tid]);
  __syncthreads();
}

struct Acc { f32x4 v[4][4]; };

DEV void acc_zero(Acc& a) {
#pragma unroll
  for (int i = 0; i < 4; ++i)
#pragma unroll
    for (int j = 0; j < 4; ++j) a.v[i][j] = (f32x4){0.f, 0.f, 0.f, 0.f};
}

#define LDSAS __attribute__((address_space(3)))
DEV void gemm_kloop(const u16* __restrict__ A, int lda, const u16* __restrict__ Bt, int ldb, int K, int m0, int n0,
                    u16* sA, u16* sB_unused, Acc& acc) {
  const int tid = threadIdx.x, lane = tid & 63, wave = tid >> 6, wm = wave >> 1, wn = wave & 1;
  const int l15 = lane & 15, quad = lane >> 4;
  const int rsw = (l15 >> 1) & 7;
  const int nk = K >> 6;
  const int prow = lane >> 3;
  const int pch = lane & 7;
  unsigned oA[4], oB[4];
#pragma unroll
  for (int i = 0; i < 4; ++i) {
    const int row = (wave * 4 + i) * 8 + prow;
    const int c = pch ^ ((row >> 1) & 7);
    oA[i] = (unsigned)(row * lda + c * 8) * 2u;
    oB[i] = (unsigned)(row * ldb + c * 8) * 2u;
  }
  const char* bA = (const char*)(A + (size_t)m0 * lda);
  const char* bB = (const char*)(Bt + (size_t)n0 * ldb);
  LDSAS char* lbase = (LDSAS char*)sA;
#define GEMM_DMA(KT, BUF)                                                                                   \
  _Pragma("unroll") for (int i = 0; i < 4; ++i) {                                                           \
    __builtin_amdgcn_global_load_lds((const unsigned*)(bA + (KT) * 128 + oA[i]), (LDSAS unsigned*)(lbase + (BUF) * 32768 + (wave * 4 + i) * 1024), 16, 0, 0);          \
    __builtin_amdgcn_global_load_lds((const unsigned*)(bB + (KT) * 128 + oB[i]), (LDSAS unsigned*)(lbase + (BUF) * 32768 + 16384 + (wave * 4 + i) * 1024), 16, 0, 0);  \
  }
  GEMM_DMA(0, 0)
  for (int kt = 0; kt < nk; ++kt) {
    asm volatile("s_waitcnt vmcnt(0)" ::: "memory");
    __syncthreads();
    const int buf = kt & 1;
    if (kt + 1 < nk) { GEMM_DMA(kt + 1, buf ^ 1) }
    const u16* tA = sA + buf * 16384;
    const u16* tB = tA + 8192;
    bf16x8 af[2][4], bfr[2][4];
#pragma unroll
    for (int ks = 0; ks < 2; ++ks) {
      const int cs = ((ks * 4 + quad) ^ rsw) * 8;
#pragma unroll
      for (int i = 0; i < 4; ++i) af[ks][i] = *(const bf16x8*)(tB + (wn * 64 + i * 16 + l15) * 64 + cs);
#pragma unroll
      for (int j = 0; j < 4; ++j) bfr[ks][j] = *(const bf16x8*)(tA + (wm * 64 + j * 16 + l15) * 64 + cs);
    }
    __builtin_amdgcn_s_setprio(1);
#pragma unroll
    for (int ks = 0; ks < 2; ++ks)
#pragma unroll
      for (int i = 0; i < 4; ++i)
#pragma unroll
        for (int j = 0; j < 4; ++j) acc.v[i][j] = __builtin_amdgcn_mfma_f32_16x16x32_bf16(af[ks][i], bfr[ks][j], acc.v[i][j], 0, 0, 0);
    __builtin_amdgcn_s_setprio(0);
  }
  __syncthreads();
}

DEV void p1_filter_tile(const Params& p, int tile, u16* sA, u16* sB) {
  const int mt = tile >> 3, nt = tile & 7;
  const int m0 = mt * 128, n0 = nt * 128;
  Acc acc; acc_zero(acc);
  gemm_kloop((const u16*)(p.ws + OFF_H2F), 64, (const u16*)(p.ws + OFF_H2F + 512 * 1024), 64, 64, m0, n0, sA, sB, acc);
  asm volatile("" ::: "memory");
  const int tid = threadIdx.x, lane = tid & 63, wave = tid >> 6, wm = wave >> 1, wn = wave & 1;
  const int l15 = lane & 15, quad = lane >> 4;
  const int mb = m0 + wm * 64, nbase = n0 + wn * 64;
  u16* G = (u16*)((char*)p.out + OO_G);
  float* nsum = (float*)(p.ws + OFF_BAR + 20480);
  const float da = logf(1e-2f) / 1.5f, db = logf(1e-2f) / 0.3f;
  const bool bwd = nbase >= 512;
#pragma unroll
  for (int i = 0; i < 4; ++i)
#pragma unroll
    for (int r = 0; r < 4; ++r) {
      const int col = nbase + i * 16 + quad * 4 + r;
      const int c = col & 511;
      const float fbv = p.hy_fb3[col];
      const float dlc = fabsf(da + (db - da) * (float)c / 511.f);
      u16* Gc = G + (size_t)c * 8192;
      float sum = 0.f;
#pragma unroll
      for (int j = 0; j < 4; ++j) {
        const int t = mb + j * 16 + l15;
        const float val = (acc.v[i][j][r] + fbv) * expf(-(float)t * (1.f / 4096.f) * dlc);
        if (!bwd) { Gc[4095 - t] = f2bf(val); sum += fabsf(val); }
        else if (t < 4095) { Gc[4096 + t] = f2bf(val); sum += fabsf(val); }
        else Gc[8191] = 0;
      }
      sum = DPP_ADD(sum, 0xB1);
      sum = DPP_ADD(sum, 0x4E);
      sum = DPP_ADD(sum, 0x141);
      sum = DPP_ADD(sum, 0x140);
      if (l15 == 0) atomicAdd(nsum + c, sum);
    }
}

DEV void p2_inproj(const Params& p, int tile, u16* sA, u16* sB) {
  const int mt = tile / 34, nt = tile % 34;
  const int m0 = mt * 128, n0 = nt * 128;
  Acc acc; acc_zero(acc);
  gemm_kloop((const u16*)((const char*)p.out + OO_H1), 1024, (const u16*)(p.ws + OFF_WIN), 1024, 1024, m0, n0, sA, sB, acc);
  asm volatile("" ::: "memory");
  const int tid = threadIdx.x, lane = tid & 63, wave = tid >> 6, wm = wave >> 1, wn = wave & 1;
  int l15 = lane & 15, quad = lane >> 4;
  int mb = m0 + wm * 64, nb = n0 + wn * 64;
  asm volatile("" : "+v"(l15), "+v"(quad), "+v"(mb), "+v"(nb));
  mb = __builtin_amdgcn_readfirstlane(mb); nb = __builtin_amdgcn_readfirstlane(nb);
  if (nb < 640) {
    const float2* rope = (const float2*)(p.ws + OFF_ROPE);
    const bool isq = nb < 512;
    const float qs = isq ? 0.125f : 1.f;
#pragma unroll
    for (int j = 0; j < 4; ++j) {
      const int m = mb + j * 16 + l15;
      const int b = m >> 12, l = m & 4095;
      const int prow = l >> 6, pcol = l & 63;
      u16* dst;
      if (isq) dst = (u16*)(p.ws + OFF_Q) + ((size_t)(b * 8 + (nb >> 6)) * 4096 + l) * 64;
      else dst = (u16*)(p.ws + OFF_K) + ((size_t)(b * 2 + ((nb - 512) >> 6)) * 4096 + l) * 64;
#pragma unroll
      for (int hh = 0; hh < 2; ++hh) {
        const int pos = hh ? pcol : prow;
        f32x4 x1 = acc.v[hh * 2][j], x2 = acc.v[hh * 2 + 1][j];
        float o1[4], o2[4];
#pragma unroll
        for (int r = 0; r < 4; ++r) {
          float2 cs = rope[pos * 16 + quad * 4 + r];
          o1[r] = (x1[r] * cs.x - x2[r] * cs.y) * qs;
          o2[r] = (x2[r] * cs.x + x1[r] * cs.y) * qs;
        }
        *(uint2*)(dst + hh * 32 + quad * 4) = make_uint2(pack2(o1[0], o1[1]), pack2(o1[2], o1[3]));
        *(uint2*)(dst + hh * 32 + 16 + quad * 4) = make_uint2(pack2(o2[0], o2[1]), pack2(o2[2], o2[3]));
      }
    }
  } else if (nb < 768) {
    const int g = (nb - 640) >> 6;
    u16* vt = (u16*)(p.ws + OFF_VT);
#pragma unroll
    for (int j = 0; j < 4; ++j) {
      const int m = mb + j * 16 + l15;
      const int b = m >> 12, l = m & 4095;
#pragma unroll
      for (int i = 0; i < 4; ++i)
#pragma unroll
        for (int r = 0; r < 4; ++r) {
          const int d = i * 16 + quad * 4 + r;
          vt[((size_t)(b * 2 + g) * 64 + d) * 4096 + l] = f2bf(acc.v[i][j][r]);
        }
    }
  } else if (nb < 2304) {
    u16* z = (u16*)(p.ws + OFF_Z);
#pragma unroll
    for (int j = 0; j < 4; ++j) {
      const int m = mb + j * 16 + l15;
#pragma unroll
      for (int i = 0; i < 4; ++i) {
        const int n = nb - 768 + i * 16 + quad * 4;
        f32x4 a = acc.v[i][j];
        *(uint2*)(z + (size_t)m * 1536 + n) = make_uint2(pack2(a[0], a[1]), pack2(a[2], a[3]));
      }
    }
  } else {
    u16* gt = (u16*)(p.ws + OFF_GATE);
#pragma unroll
    for (int j = 0; j < 4; ++j) {
      const int m = mb + j * 16 + l15;
#pragma unroll
      for (int i = 0; i < 4; ++i) {
        const int n = nb - 2304 + i * 16 + quad * 4;
        f32x4 a = acc.v[i][j];
        float s0 = __builtin_amdgcn_rcpf(1.f + __expf(-a[0])), s1 = __builtin_amdgcn_rcpf(1.f + __expf(-a[1]));
        float s2 = __builtin_amdgcn_rcpf(1.f + __expf(-a[2])), s3 = __builtin_amdgcn_rcpf(1.f + __expf(-a[3]));
        *(uint2*)(gt + (size_t)m * 2048 + n) = make_uint2(pack2(s0, s1), pack2(s2, s3));
      }
    }
  }
}

DEV void p2_ctxkv(const Params& p, int tile, u16* sA, u16* sB) {
  const int mt = tile >> 1, nt = tile & 1;
  const int m0 = mt * 128, n0 = nt * 128;
  Acc acc; acc_zero(acc);
  gemm_kloop((const u16*)((const char*)p.out + OO_HC), 1024, (const u16*)(p.ws + OFF_WIN) + (size_t)512 * 1024, 1024, 1024, m0, n0, sA, sB, acc);
  const int tid = threadIdx.x, lane = tid & 63, wave = tid >> 6, wm = wave >> 1, wn = wave & 1;
  const int l15 = lane & 15, quad = lane >> 4;
  const int mb = m0 + wm * 64, nb = n0 + wn * 64;
  const int g = (nb >> 6) & 1;
  if (nb < 128) {
    u16* kc = (u16*)(p.ws + OFF_KC);
#pragma unroll
    for (int j = 0; j < 4; ++j) {
      const int m = mb + j * 16 + l15;
      const int b = m >> 8, c = m & 255;
#pragma unroll
      for (int i = 0; i < 4; ++i) {
        f32x4 a = acc.v[i][j];
        *(uint2*)(kc + ((size_t)(b * 2 + g) * 256 + c) * 64 + i * 16 + quad * 4) = make_uint2(pack2(a[0], a[1]), pack2(a[2], a[3]));
      }
    }
  } else {
    u16* vct = (u16*)(p.ws + OFF_VCT);
#pragma unroll
    for (int j = 0; j < 4; ++j) {
      const int m = mb + j * 16 + l15;
      const int b = m >> 8, c = m & 255;
#pragma unroll
      for (int i = 0; i < 4; ++i)
#pragma unroll
        for (int r = 0; r < 4; ++r) {
          const int d = i * 16 + quad * 4 + r;
          vct[((size_t)(b * 2 + g) * 64 + d) * 256 + c] = f2bf(acc.v[i][j][r]);
        }
    }
  }
}

DEV void p3_attn(const Params& p, int item, u16* sK, u16* sVt) {
  const int tid = threadIdx.x, lane = tid & 63, wave = tid >> 6, l15 = lane & 15, quad = lane >> 4;
  const int n = item & 31, h = (item >> 5) & 7, b = item >> 8;
  const int g = h >> 2;
  const u16* Q = (const u16*)(p.ws + OFF_Q) + ((size_t)(b * 8 + h) * 4096 + n * 128 + wave * 32) * 64;
  bf16x8 bq[2][2];
#pragma unroll
  for (int qt = 0; qt < 2; ++qt)
#pragma unroll
    for (int ks = 0; ks < 2; ++ks) bq[qt][ks] = *(const bf16x8*)(Q + (qt * 16 + l15) * 64 + ks * 32 + quad * 8);
  const float sink = p.attn_sink[h];
  float mrun[2] = {sink, sink};
  float lrun[2];
  lrun[0] = lrun[1] = (quad == 0) ? 1.f : 0.f;
  f32x4 O[4][2];
#pragma unroll
  for (int dt = 0; dt < 4; ++dt)
#pragma unroll
    for (int qt = 0; qt < 2; ++qt) O[dt][qt] = (f32x4){0.f, 0.f, 0.f, 0.f};

  u32x4 pk[4], pv[4];
#define ATT_LOAD(KB)                                                                                  \
  {                                                                                                   \
    const u16* Ksrc; const u16* Vsrc; int vstride;                                                    \
    if ((KB) < 3) {                                                                                   \
      const int nbk = n + (KB) - 1;                                                                   \
      Ksrc = (const u16*)(p.ws + OFF_K) + ((size_t)(b * 2 + g) * 4096 + nbk * 128) * 64;              \
      Vsrc = (const u16*)(p.ws + OFF_VT) + (size_t)(b * 2 + g) * 64 * 4096 + nbk * 128;               \
      vstride = 4096;                                                                                 \
    } else {                                                                                          \
      const int cb = (KB) - 3;                                                                        \
      Ksrc = (const u16*)(p.ws + OFF_KC) + ((size_t)(b * 2 + g) * 256 + cb * 128) * 64;               \
      Vsrc = (const u16*)(p.ws + OFF_VCT) + (size_t)(b * 2 + g) * 64 * 256 + cb * 128;                \
      vstride = 256;                                                                                  \
    }                                                                                                 \
    _Pragma("unroll") for (int i = 0; i < 4; ++i) {                                                   \
      const int id = tid + i * 256;                                                                   \
      pk[i] = *(const u32x4*)(Ksrc + (id >> 3) * 64 + (id & 7) * 8);                                  \
      pv[i] = *(const u32x4*)(Vsrc + (size_t)(id >> 4) * vstride + (id & 15) * 8);                    \
    }                                                                                                 \
  }
  int kb = (n == 0) ? 1 : 0;
  ATT_LOAD(kb)
  while (kb < 5) {
#pragma unroll
    for (int i = 0; i < 4; ++i) {
      const int id = tid + i * 256;
      *(u32x4*)(sK + (id >> 3) * 72 + (id & 7) * 8) = pk[i];
      *(u32x4*)(sVt + (id >> 4) * 136 + (id & 15) * 8) = pv[i];
    }
    __syncthreads();
    int nx = kb + 1;
    if (nx == 2 && n == 31) nx = 3;
    if (nx < 5) ATT_LOAD(nx)
#pragma unroll 1
    for (int c4 = 0; c4 < 4; ++c4) {
      f32x4 s[2][2];
#pragma unroll
      for (int kt = 0; kt < 2; ++kt) {
        bf16x8 ak0 = *(const bf16x8*)(sK + (c4 * 32 + kt * 16 + l15) * 72 + quad * 8);
        bf16x8 ak1 = *(const bf16x8*)(sK + (c4 * 32 + kt * 16 + l15) * 72 + 32 + quad * 8);
#pragma unroll
        for (int qt = 0; qt < 2; ++qt) {
          f32x4 z = (f32x4){0.f, 0.f, 0.f, 0.f};
          z = __builtin_amdgcn_mfma_f32_16x16x32_bf16(ak0, bq[qt][0], z, 0, 0, 0);
          z = __builtin_amdgcn_mfma_f32_16x16x32_bf16(ak1, bq[qt][1], z, 0, 0, 0);
          s[kt][qt] = z;
        }
      }
      if (kb == 0 || kb == 2) {
#pragma unroll
        for (int kt = 0; kt < 2; ++kt)
#pragma unroll
          for (int qt = 0; qt < 2; ++qt)
#pragma unroll
            for (int r = 0; r < 4; ++r) {
              const int kk = c4 * 32 + kt * 16 + quad * 4 + r;
              const int qq = wave * 32 + qt * 16 + l15;
              const bool valid = (kb == 0) ? (kk >= qq) : (kk <= qq);
              if (!valid) s[kt][qt][r] = -INFINITY;
            }
      }
      bf16x8 bp[2];
#pragma unroll
      for (int qt = 0; qt < 2; ++qt) {
        float cm = fmaxf(fmaxf(fmaxf(s[0][qt][0], s[0][qt][1]), fmaxf(s[0][qt][2], s[0][qt][3])),
                         fmaxf(fmaxf(s[1][qt][0], s[1][qt][1]), fmaxf(s[1][qt][2], s[1][qt][3])));
        cm = fmaxf(cm, __shfl_xor(cm, 16));
        cm = fmaxf(cm, __shfl_xor(cm, 32));
        const float mnew = fmaxf(mrun[qt], cm);
        const float alpha = __expf(mrun[qt] - mnew);
        mrun[qt] = mnew;
        float ps = 0.f;
        float pv[8];
#pragma unroll
        for (int r = 0; r < 4; ++r) {
          pv[r] = __expf(s[0][qt][r] - mnew);
          pv[4 + r] = __expf(s[1][qt][r] - mnew);
          ps += pv[r] + pv[4 + r];
        }
        lrun[qt] = lrun[qt] * alpha + ps;
#pragma unroll
        for (int dt = 0; dt < 4; ++dt) {
          O[dt][qt][0] *= alpha; O[dt][qt][1] *= alpha; O[dt][qt][2] *= alpha; O[dt][qt][3] *= alpha;
        }
        union { bf16x8 v; unsigned u[4]; } pk;
        pk.u[0] = pack2(pv[0], pv[1]); pk.u[1] = pack2(pv[2], pv[3]);
        pk.u[2] = pack2(pv[4], pv[5]); pk.u[3] = pack2(pv[6], pv[7]);
        bp[qt] = pk.v;
      }
#pragma unroll
      for (int dt = 0; dt < 4; ++dt) {
        union { bf16x8 v; uint2 h[2]; } av;
        const u16* vrow = sVt + (dt * 16 + l15) * 136 + c4 * 32 + quad * 4;
        av.h[0] = *(const uint2*)(vrow);
        av.h[1] = *(const uint2*)(vrow + 16);
#pragma unroll
        for (int qt = 0; qt < 2; ++qt) O[dt][qt] = __builtin_amdgcn_mfma_f32_16x16x32_bf16(av.v, bp[qt], O[dt][qt], 0, 0, 0);
      }
    }
    __syncthreads();
    kb = nx;
  }
  u16* Y = (u16*)(p.ws + OFF_YATT);
#pragma unroll
  for (int qt = 0; qt < 2; ++qt) {
    float l = lrun[qt];
    l += __shfl_xor(l, 16);
    l += __shfl_xor(l, 32);
    const float inv = 1.f / l;
    const int t = b * 4096 + n * 128 + wave * 32 + qt * 16 + l15;
#pragma unroll
    for (int dt = 0; dt < 4; ++dt) {
      f32x4 o = O[dt][qt];
      *(uint2*)(Y + (size_t)t * 512 + h * 64 + dt * 16 + quad * 4) = make_uint2(pack2(o[0] * inv, o[1] * inv), pack2(o[2] * inv, o[3] * inv));
    }
  }
}

DEV void p3_hypre(const Params& p, int item, u16* sm) {
  const int tid = threadIdx.x;
  const int cb = item & 3, tb = (item >> 2) & 63, b = item >> 8;
  const int tq = tid >> 6, ch2 = tid & 63;
  const int c = cb * 128 + ch2 * 2;
  u16* su = sm;
  u16* sx = sm + 128 * 66;
  float w[3][3][2], bias[3][2];
#pragma unroll
  for (int s = 0; s < 3; ++s) {
#pragma unroll
    for (int k = 0; k < 3; ++k) {
      const float2 wv = *(const float2*)(p.hy_conv_w + k * 1536 + s * 512 + c);
      w[s][k][0] = wv.x; w[s][k][1] = wv.y;
    }
    const float2 bv = *(const float2*)(p.hy_conv_b + s * 512 + c);
    bias[s][0] = bv.x; bias[s][1] = bv.y;
  }
  const u16* Z = (const u16*)(p.ws + OFF_Z) + (size_t)b * 4096 * 1536;
  const int l0 = tb * 64 + tq * 16;
  unsigned zr[18][3];
#pragma unroll
  for (int i = 0; i < 18; ++i) {
    const int l = l0 - 1 + i;
    const bool ok = (l >= 0) && (l < 4096);
    const int lc = ok ? l : l0;
#pragma unroll
    for (int s2 = 0; s2 < 3; ++s2) {
      const unsigned v = *(const unsigned*)(Z + (size_t)lc * 1536 + s2 * 512 + c);
      zr[i][s2] = ok ? v : 0u;
    }
  }
#pragma unroll
  for (int i = 0; i < 16; ++i) {
    float cv0[3], cv1[3];
#pragma unroll
    for (int s2 = 0; s2 < 3; ++s2) {
      cv0[s2] = bflo(zr[i][s2]) * w[s2][0][0] + bflo(zr[i + 1][s2]) * w[s2][1][0] + bflo(zr[i + 2][s2]) * w[s2][2][0] + bias[s2][0];
      cv1[s2] = bfhi(zr[i][s2]) * w[s2][0][1] + bfhi(zr[i + 1][s2]) * w[s2][1][1] + bfhi(zr[i + 2][s2]) * w[s2][2][1] + bias[s2][1];
    }
    su[(ch2 * 2) * 66 + tq * 16 + i] = f2bf(cv0[2] * cv0[1]);
    su[(ch2 * 2 + 1) * 66 + tq * 16 + i] = f2bf(cv1[2] * cv1[1]);
    sx[(ch2 * 2) * 66 + tq * 16 + i] = f2bf(cv0[0]);
    sx[(ch2 * 2 + 1) * 66 + tq * 16 + i] = f2bf(cv1[0]);
  }
  __syncthreads();
  const int chr = tid >> 1, part = tid & 1;
  const int cc = cb * 128 + chr;
  const unsigned* ru = (const unsigned*)(su + chr * 66 + part * 32);
  const unsigned* rx = (const unsigned*)(sx + chr * 66 + part * 32);
  u16* UT = (u16*)((char*)p.out + OO_UT) + ((size_t)(cc * 4 + b) * 4096 + tb * 64 + part * 32);
  u16* XT = (u16*)((char*)p.out + OO_X0T) + ((size_t)(cc * 4 + b) * 4096 + tb * 64 + part * 32);
#pragma unroll
  for (int q = 0; q < 4; ++q) {
    ((uint4*)UT)[q] = make_uint4(ru[4 * q], ru[4 * q + 1], ru[4 * q + 2], ru[4 * q + 3]);
    ((uint4*)XT)[q] = make_uint4(rx[4 * q], rx[4 * q + 1], rx[4 * q + 2], rx[4 * q + 3]);
  }
  __syncthreads();
}

DEV void p3_toeplitz(const Params& p, int c, char* smem) {
  const int tid = threadIdx.x, lane = tid & 63, wave = tid >> 6, l15 = lane & 15, quad = lane >> 4;
  u16* sG0 = (u16*)smem;
  u16* sG1 = (u16*)(smem + 16384 + 64);
  u16* sU = (u16*)(smem + 32768 + 128);
  u16* sZ = sU + 4 * 64 * 72;
  const u16* G = (const u16*)((const char*)p.out + OO_G) + (size_t)c * 8192;
  const u16* UT = (const u16*)((const char*)p.out + OO_UT) + (size_t)c * 16384;
#pragma unroll
  for (int i = 0; i < 4; ++i) {
    const int id = tid + i * 256;
    *(uint4*)(sG0 + id * 8) = *(const uint4*)(G + id * 8);
  }
#pragma unroll
  for (int i = 0; i < 8; ++i) {
    const int id = tid + i * 256;
    const int bb = id >> 9, blk = (id >> 3) & 63, c8 = id & 7;
    *(uint4*)(sU + (bb * 64 + blk) * 72 + c8 * 8) = *(const uint4*)(UT + id * 8);
  }
  if (tid < 72) sZ[tid] = 0;
  __syncthreads();
  for (int i = tid; i < 8192; i += 256) sG1[i] = (i < 8191) ? sG0[i + 1] : (u16)0;
  __syncthreads();

  Acc acc; acc_zero(acc);
  const u16* gbase = (l15 & 1) ? sG0 : (sG1 - 1);
  const u16* ubase = sU + wave * 64 * 72 + quad * 8;
  const u16* zbase = sZ + quad * 8;
#define TOEP_LOADA(AF, D)                                                                 \
  {                                                                                       \
    const int base_ = 4095 - 64 * (D) - l15 + quad * 8;                                   \
    _Pragma("unroll") for (int mt = 0; mt < 4; ++mt)                                      \
      _Pragma("unroll") for (int ks = 0; ks < 2; ++ks) {                                  \
        const unsigned* gp = (const unsigned*)(gbase + base_ - mt * 16 + ks * 32);        \
        union { bf16x8 v; unsigned u[4]; } t_;                                            \
        t_.u[0] = gp[0]; t_.u[1] = gp[1]; t_.u[2] = gp[2]; t_.u[3] = gp[3];               \
        AF[mt][ks] = t_.v;                                                                \
      }                                                                                   \
  }
#define TOEP_MMA(AF, D)                                                                   \
  _Pragma("unroll") for (int nt = 0; nt < 4; ++nt) {                                      \
    if (!(nt * 16 + 15 - (D) < 0 || nt * 16 - (D) > 63)) {                                \
      const int ip = nt * 16 + l15 - (D);                                                 \
      const u16* up = (ip >= 0 && ip < 64) ? (ubase + ip * 72) : zbase;                   \
      bf16x8 b0 = *(const bf16x8*)(up);                                                   \
      bf16x8 b1 = *(const bf16x8*)(up + 32);                                              \
      _Pragma("unroll") for (int mt = 0; mt < 4; ++mt) {                                  \
        acc.v[mt][nt] = __builtin_amdgcn_mfma_f32_16x16x32_bf16(AF[mt][0], b0, acc.v[mt][nt], 0, 0, 0); \
        acc.v[mt][nt] = __builtin_amdgcn_mfma_f32_16x16x32_bf16(AF[mt][1], b1, acc.v[mt][nt], 0, 0, 0); \
      }                                                                                   \
    }                                                                                     \
  }
  {
    bf16x8 afA[4][2], afB[4][2];
    TOEP_LOADA(afA, -63)
#pragma unroll 1
    for (int d = -63; d <= 63; d += 2) {
      if (d + 1 <= 63) TOEP_LOADA(afB, d + 1)
      TOEP_MMA(afA, d)
      if (d + 1 <= 63) {
        if (d + 2 <= 63) TOEP_LOADA(afA, d + 2)
        TOEP_MMA(afB, d + 1)
      }
    }
  }
  const float ninv = 1.f / ((const float*)(p.ws + OFF_BAR + 20480))[c];
  const float skip = p.hy_skip[c];
  const u16* XT = (const u16*)((const char*)p.out + OO_X0T) + ((size_t)(c * 4 + wave) * 4096);
  u16* Y = (u16*)(p.ws + OFF_YHY);
#pragma unroll
  for (int nt = 0; nt < 4; ++nt) {
    const int ib = nt * 16 + l15;
#pragma unroll
    for (int mt = 0; mt < 4; ++mt) {
      const int r0 = mt * 16 + quad * 4;
      const int t = ib * 64 + r0;
      uint2 uu = *(const uint2*)(sU + (wave * 64 + ib) * 72 + r0);
      uint2 xx = *(const uint2*)(XT + t);
      float uv[4] = {bflo(uu.x), bfhi(uu.x), bflo(uu.y), bfhi(uu.y)};
      float xv[4] = {bflo(xx.x), bfhi(xx.x), bflo(xx.y), bfhi(xx.y)};
#pragma unroll
      for (int r = 0; r < 4; ++r) {
        float y = acc.v[mt][nt][r] * ninv + uv[r] * skip;
        Y[(size_t)(wave * 4096 + t + r) * 512 + c] = f2bf(y * xv[r]);
      }
    }
  }
  __syncthreads();
}

DEV void p4_merge(const Params& p, int tile, u16* sA, u16* sB) {
  const int mt = tile >> 3, nt = tile & 7;
  const int m0 = mt * 128, n0 = nt * 128;
  const int tid = threadIdx.x, lane = tid & 63, wave = tid >> 6, wm = wave >> 1, wn = wave & 1;
  const int l15 = lane & 15, quad = lane >> 4;
  const int mb = m0 + wm * 64, nb = n0 + wn * 64;
  const u16* gt = (const u16*)(p.ws + OFF_GATE);
  u16* mg = (u16*)(p.ws + OFF_MERGED);
  Acc a1; acc_zero(a1);
  gemm_kloop((const u16*)(p.ws + OFF_YATT), 512, (const u16*)(p.ws + OFF_WOA), 512, 512, m0, n0, sA, sB, a1);
  asm volatile("" ::: "memory");
#pragma unroll
  for (int j = 0; j < 4; ++j) {
    const int m = mb + j * 16 + l15;
#pragma unroll
    for (int i = 0; i < 4; ++i) {
      const int n = nb + i * 16 + quad * 4;
      uint2 ga = *(const uint2*)(gt + (size_t)m * 2048 + n);
      f32x4 x = a1.v[i][j];
      *(uint2*)(mg + (size_t)m * 1024 + n) = make_uint2(pack2(bflo(ga.x) * x[0], bfhi(ga.x) * x[1]), pack2(bflo(ga.y) * x[2], bfhi(ga.y) * x[3]));
    }
  }
  asm volatile("" ::: "memory");
  acc_zero(a1);
  gemm_kloop((const u16*)(p.ws + OFF_YHY), 512, (const u16*)(p.ws + OFF_WOH), 512, 512, m0, n0, sA, sB, a1);
  asm volatile("" ::: "memory");
#pragma unroll
  for (int j = 0; j < 4; ++j) {
    const int m = mb + j * 16 + l15;
#pragma unroll
    for (int i = 0; i < 4; ++i) {
      const int n = nb + i * 16 + quad * 4;
      uint2 gh = *(const uint2*)(gt + (size_t)m * 2048 + 1024 + n);
      uint2 pv = *(const uint2*)(mg + (size_t)m * 1024 + n);
      f32x4 y = a1.v[i][j];
      float o0 = bflo(pv.x) + bflo(gh.x) * y[0];
      float o1 = bfhi(pv.x) + bfhi(gh.x) * y[1];
      float o2 = bflo(pv.y) + bflo(gh.y) * y[2];
      float o3 = bfhi(pv.y) + bfhi(gh.y) * y[3];
      *(uint2*)(mg + (size_t)m * 1024 + n) = make_uint2(pack2(o0, o1), pack2(o2, o3));
    }
  }
}

DEV void p5_out(const Params& p, int tile, u16* sA, u16* sB) {
  const int mt = tile >> 3, nt = tile & 7;
  const int m0 = mt * 128, n0 = nt * 128;
  Acc acc; acc_zero(acc);
  gemm_kloop((const u16*)(p.ws + OFF_MERGED), 1024, (const u16*)(p.ws + OFF_WOUT), 1024, 1024, m0, n0, sA, sB, acc);
  const int tid = threadIdx.x, lane = tid & 63, wave = tid >> 6, wm = wave >> 1, wn = wave & 1;
  const int l15 = lane & 15, quad = lane >> 4;
  const int mb = m0 + wm * 64, nb = n0 + wn * 64;
  const float* mod = (const float*)(p.ws + OFF_MOD);
#pragma unroll
  for (int j = 0; j < 4; ++j) {
    const int m = mb + j * 16 + l15;
    const int b = m >> 12;
#pragma unroll
    for (int i = 0; i < 4; ++i) {
      const int n = nb + i * 16 + quad * 4;
      float4 g1 = *(const float4*)(mod + b * 6144 + 2048 + n);
      float4 xv = *(const float4*)(p.x + (size_t)m * 1024 + n);
      f32x4 a = acc.v[i][j];
      float4 o = make_float4(xv.x + g1.x * a[0], xv.y + g1.y * a[1], xv.z + g1.z * a[2], xv.w + g1.w * a[3]);
      *(float4*)(p.out + (size_t)m * 1024 + n) = o;
    }
  }
}

DEV void p7_qp(const Params& p, int tile, u16* sA, u16* sB) {
  const int mt = tile >> 3, nt = tile & 7;
  const int m0 = mt * 128, n0 = nt * 128;
  Acc acc; acc_zero(acc);
  gemm_kloop((const u16*)(p.ws + OFF_H2), 1024, (const u16*)(p.ws + OFF_WQ), 1024, 1024, m0, n0, sA, sB, acc);
  const int tid = threadIdx.x, lane = tid & 63, wave = tid >> 6, wm = wave >> 1, wn = wave & 1;
  const int l15 = lane & 15, quad = lane >> 4;
  const int mb = m0 + wm * 64, nb = n0 + wn * 64;
  u16* qp = (u16*)(p.ws + OFF_QP);
#pragma unroll
  for (int j = 0; j < 4; ++j) {
    const int m = mb + j * 16 + l15;
#pragma unroll
    for (int i = 0; i < 4; ++i) {
      const int n = nb + i * 16 + quad * 4;
      f32x4 a = acc.v[i][j];
      *(uint2*)(qp + (size_t)m * 1024 + n) = make_uint2(pack2(a[0], a[1]), pack2(a[2], a[3]));
    }
  }
}

DEV unsigned f2ord(float f) {
  const unsigned u = __float_as_uint(f);
  return u ^ (((int)u >> 31) | 0x80000000u);
}
DEV float ord2f(unsigned k) {
  const unsigned m = (k & 0x80000000u) ? 0x80000000u : 0xffffffffu;
  return __uint_as_float(k ^ m);
}
DEV unsigned umax_(unsigned a, unsigned b) { return a > b ? a : b; }
DEV unsigned umin_(unsigned a, unsigned b) { return a < b ? a : b; }

DEV void sort16_desc(unsigned (&v)[16]) {
#pragma unroll
  for (int k = 2; k <= 16; k <<= 1)
#pragma unroll
    for (int j = k >> 1; j > 0; j >>= 1)
#pragma unroll
      for (int i = 0; i < 16; ++i) {
        const int l = i ^ j;
        if (l > i) {
          const bool desc = ((i & k) == 0);
          const unsigned a = v[i], b = v[l];
          const unsigned hi = umax_(a, b), lo = umin_(a, b);
          v[i] = desc ? hi : lo;
          v[l] = desc ? lo : hi;
        }
      }
}
DEV void merge16_desc(unsigned (&v)[16]) {
#pragma unroll
  for (int j = 8; j > 0; j >>= 1)
#pragma unroll
    for (int i = 0; i < 16; ++i) {
      const int l = i ^ j;
      if (l > i) {
        const unsigned a = v[i], b = v[l];
        v[i] = umax_(a, b);
        v[l] = umin_(a, b);
      }
    }
}
DEV void xmerge16(unsigned (&v)[16], int off) {
  unsigned pr[16];
#pragma unroll
  for (int i = 0; i < 16; ++i) pr[i] = (unsigned)__shfl_xor((int)v[i], off);
#pragma unroll
  for (int i = 0; i < 16; ++i) v[i] = umax_(v[i], pr[15 - i]);
  merge16_desc(v);
}

DEV void route_top16_of_128(const u16* __restrict__ keys, const u16* __restrict__ qp, int l15, int quad, unsigned (&out)[16]) {
  bf16x8 b0 = *(const bf16x8*)(qp);
  bf16x8 b1 = *(const bf16x8*)(qp + 32);
  unsigned ka[16], kb[16];
#pragma unroll
  for (int kt = 0; kt < 8; ++kt) {
    bf16x8 a0 = *(const bf16x8*)(keys + (kt * 16 + l15) * 64 + quad * 8);
    bf16x8 a1 = *(const bf16x8*)(keys + (kt * 16 + l15) * 64 + 32 + quad * 8);
    f32x4 z = (f32x4){0.f, 0.f, 0.f, 0.f};
    z = __builtin_amdgcn_mfma_f32_16x16x32_bf16(a0, b0, z, 0, 0, 0);
    z = __builtin_amdgcn_mfma_f32_16x16x32_bf16(a1, b1, z, 0, 0, 0);
#pragma unroll
    for (int r = 0; r < 4; ++r) {
      const unsigned key = (f2ord(z[r]) & ~127u) | (unsigned)(kt * 16 + quad * 4 + r);
      if (kt < 4) ka[kt * 4 + r] = key; else kb[(kt - 4) * 4 + r] = key;
    }
  }
  sort16_desc(ka);
  sort16_desc(kb);
#pragma unroll
  for (int i = 0; i < 16; ++i) out[i] = umax_(ka[i], kb[15 - i]);
  merge16_desc(out);
  xmerge16(out, 16);
  xmerge16(out, 32);
}

DEV void p8_route(const Params& p, int task, char* wsm) {
  static constexpr unsigned char kTab[52] = {
      0x00, 0x01, 0x02, 0x03, 0x04, 0x05, 0x06, 0x07, 0x08, 0x09, 0x0A, 0x0B, 0x0C, 0x0D, 0x0E, 0x0F,
      0x10, 0x11, 0x12, 0x13, 0x14, 0x15, 0x16, 0x17, 0x20, 0x21, 0x22, 0x23, 0x24, 0x30, 0x31, 0x32, 0x33,
      0x40, 0x41, 0x42, 0x50, 0x51, 0x60, 0x61, 0x70, 0x71, 0x80, 0x90, 0xA0, 0xB0, 0xC0, 0xD0, 0xE0, 0xF0, 0x00, 0x00};
  const int lane = threadIdx.x & 63, l15 = lane & 15, quad = lane >> 4;
  const int h = task & 7, tt = task >> 3;
  const int t0 = tt * 16;
  float* s1v = (float*)wsm;
  float* s2v = s1v + 256;
  int* i1 = (int*)(s2v + 256);
  int* i2 = i1 + 256;
  const u16* keys = (const u16*)(p.ws + OFF_KEYS) + (size_t)(h * 2) * 128 * 64;
  const u16* qp = (const u16*)(p.ws + OFF_QP) + (size_t)(t0 + l15) * 1024 + h * 128 + quad * 8;
  unsigned l1[16], l2[16];
  route_top16_of_128(keys, qp, l15, quad, l1);
  route_top16_of_128(keys + 128 * 64, qp + 64, l15, quad, l2);
  if (quad == 0) {
#pragma unroll
    for (int i = 0; i < 16; ++i) { s1v[l15 * 16 + i] = ord2f(l1[i] & ~127u); i1[l15 * 16 + i] = (int)(l1[i] & 127u); }
  } else if (quad == 1) {
#pragma unroll
    for (int i = 0; i < 16; ++i) { s2v[l15 * 16 + i] = ord2f(l2[i] & ~127u); i2[l15 * 16 + i] = (int)(l2[i] & 127u); }
  }
  __builtin_amdgcn_fence(__ATOMIC_RELEASE, "wavefront");
  __builtin_amdgcn_wave_barrier();
  __builtin_amdgcn_fence(__ATOMIC_ACQUIRE, "wavefront");
  unsigned ck[16];
#pragma unroll
  for (int s = 0; s < 16; ++s) {
    const int c = quad + 4 * s;
    unsigned key = 0u;
    if (s < 13 && c < 50) {
      const unsigned ab = kTab[c];
      const float val = s1v[l15 * 16 + (ab >> 4)] + s2v[l15 * 16 + (ab & 15)];
      key = (f2ord(val) & ~255u) | ab;
    }
    ck[s] = key;
  }
  sort16_desc(ck);
  xmerge16(ck, 16);
  xmerge16(ck, 32);
  if (quad == 0) {
    float e[16];
    const float vmax = ord2f(ck[0] & ~255u);
    float ssum = 0.f;
#pragma unroll
    for (int i = 0; i < 16; ++i) { e[i] = __expf(ord2f(ck[i] & ~255u) - vmax); ssum += e[i]; }
    const float inv = 1.f / ssum;
    int* ridx = (int*)(p.ws + OFF_RIDX) + (size_t)(t0 + l15) * 128 + h * 16;
    float* rw = (float*)(p.ws + OFF_RW) + (size_t)(t0 + l15) * 128 + h * 16;
#pragma unroll
    for (int i = 0; i < 16; i += 4) {
      int ee[4]; float ww[4];
#pragma unroll
      for (int j = 0; j < 4; ++j) {
        const unsigned ab = ck[i + j] & 255u;
        ee[j] = i1[l15 * 16 + (ab >> 4)] * 128 + i2[l15 * 16 + (ab & 15)];
        ww[j] = e[i + j] * inv;
      }
      *(int4*)(ridx + i) = make_int4(ee[0], ee[1], ee[2], ee[3]);
      *(float4*)(rw + i) = make_float4(ww[0], ww[1], ww[2], ww[3]);
    }
  }
  __builtin_amdgcn_fence(__ATOMIC_RELEASE, "wavefront");
  __builtin_amdgcn_wave_barrier();
}

DEV float gelu_tanh(float x) {
  const float u2 = 1.5957691216057308f * (x + 0.044715f * x * x * x);
  return x * __frcp_rn(1.f + __expf(-u2));
}

DEV void unpack8(const uint4& q, float* f) {
  f[0] = bflo(q.x); f[1] = bfhi(q.x); f[2] = bflo(q.y); f[3] = bfhi(q.y);
  f[4] = bflo(q.z); f[5] = bfhi(q.z); f[6] = bflo(q.w); f[7] = bfhi(q.w);
}

DEV float dpp_add(float v, const int ctrl_sel) {
  return v;
}
typedef __attribute__((ext_vector_type(2))) __bf16 bf2_t;
DEV float dot2bf(unsigned a, unsigned b, float c) {
  return __builtin_amdgcn_fdot2_f32_bf16(__builtin_bit_cast(bf2_t, a), __builtin_bit_cast(bf2_t, b), c, false);
}

DEV float reduce4_rows(float d0, float d1, float d2, float d3, int lane) {
  const bool up32 = (lane & 32) != 0, up16 = (lane & 16) != 0;
  float k0 = up32 ? d2 : d0, k1 = up32 ? d3 : d1;
  const float s0 = up32 ? d0 : d2, s1 = up32 ? d1 : d3;
  k0 += __shfl_xor(s0, 32);
  k1 += __shfl_xor(s1, 32);
  float kq = up16 ? k1 : k0;
  const float sq = up16 ? k0 : k1;
  kq += __shfl_xor(sq, 16);
  kq = DPP_ADD(kq, 0xB1);
  kq = DPP_ADD(kq, 0x4E);
  kq = DPP_ADD(kq, 0x141);
  kq = DPP_ADD(kq, 0x140);
  return kq;
}

DEV void p9_token(const Params& p, int t, int tnext, int lane, int2& e2n, float2& w2n, u32x4& han, u32x4& hbn) {
  const unsigned char* U8 = (const unsigned char*)(p.ws + OFF_UBF);
  const unsigned char* V8 = (const unsigned char*)(p.ws + OFF_VBF);
  const int2 e2 = e2n;
  const float2 w2 = w2n;
  const u32x4 ha = han, hb = hbn;
  {
    e2n = *(const int2*)((const int*)(p.ws + OFF_RIDX) + (size_t)tnext * 128 + 2 * lane);
    w2n = *(const float2*)((const float*)(p.ws + OFF_RW) + (size_t)tnext * 128 + 2 * lane);
    const u16* h2 = (const u16*)(p.ws + OFF_H2) + (size_t)tnext * 1024 + 16 * lane;
    han = *(const u32x4*)(h2);
    hbn = *(const u32x4*)(h2 + 8);
  }
  float hf[16];
  hf[0] = bflo(ha.x); hf[1] = bfhi(ha.x); hf[2] = bflo(ha.y); hf[3] = bfhi(ha.y);
  hf[4] = bflo(ha.z); hf[5] = bfhi(ha.z); hf[6] = bflo(ha.w); hf[7] = bfhi(ha.w);
  hf[8] = bflo(hb.x); hf[9] = bfhi(hb.x); hf[10] = bflo(hb.y); hf[11] = bfhi(hb.y);
  hf[12] = bflo(hb.z); hf[13] = bfhi(hb.z); hf[14] = bflo(hb.w); hf[15] = bfhi(hb.w);
  float o[16];
#pragma unroll
  for (int k = 0; k < 16; ++k) o[k] = 0.f;
#pragma unroll 1
  for (int g = 0; g < 128; g += 16) {
    u32x4 uu[16], vv[16];
    float wj[16];
#pragma unroll
    for (int j = 0; j < 16; ++j) {
      const int src = (g >> 1) + (j >> 1);
      const int ej = (j & 1) ? __builtin_amdgcn_readlane(e2.y, src) : __builtin_amdgcn_readlane(e2.x, src);
      wj[j] = __builtin_bit_cast(float, (j & 1) ? __builtin_amdgcn_readlane(__builtin_bit_cast(int, w2.y), src)
                                                : __builtin_amdgcn_readlane(__builtin_bit_cast(int, w2.x), src));
      const size_t ro = (size_t)ej * 1024 + 16 * lane;
      uu[j] = *(const u32x4*)(U8 + ro);
      vv[j] = *(const u32x4*)(V8 + ro);
    }
    float d[16];
#pragma unroll
    for (int j = 0; j < 16; ++j) {
      const f32x2 l0 = __builtin_amdgcn_cvt_pk_f32_fp8((int)uu[j].x, false), h0 = __builtin_amdgcn_cvt_pk_f32_fp8((int)uu[j].x, true);
      const f32x2 l1 = __builtin_amdgcn_cvt_pk_f32_fp8((int)uu[j].y, false), h1 = __builtin_amdgcn_cvt_pk_f32_fp8((int)uu[j].y, true);
      const f32x2 l2 = __builtin_amdgcn_cvt_pk_f32_fp8((int)uu[j].z, false), h2v = __builtin_amdgcn_cvt_pk_f32_fp8((int)uu[j].z, true);
      const f32x2 l3 = __builtin_amdgcn_cvt_pk_f32_fp8((int)uu[j].w, false), h3 = __builtin_amdgcn_cvt_pk_f32_fp8((int)uu[j].w, true);
      float a0 = l0.x * hf[0] + l0.y * hf[1], a1 = h0.x * hf[2] + h0.y * hf[3];
      a0 += l1.x * hf[4] + l1.y * hf[5]; a1 += h1.x * hf[6] + h1.y * hf[7];
      a0 += l2.x * hf[8] + l2.y * hf[9]; a1 += h2v.x * hf[10] + h2v.y * hf[11];
      a0 += l3.x * hf[12] + l3.y * hf[13]; a1 += h3.x * hf[14] + h3.y * hf[15];
      d[j] = a0 + a1;
    }
#pragma unroll
    for (int q = 0; q < 4; ++q) {
      const float dot = reduce4_rows(d[4 * q], d[4 * q + 1], d[4 * q + 2], d[4 * q + 3], lane);
      const float gl = gelu_tanh(dot * (1.f / 512.f)) * (1.f / 64.f);
#pragma unroll
      for (int i = 0; i < 4; ++i) {
        const int j = 4 * q + i;
        const float ci = wj[j] * __builtin_bit_cast(float, __builtin_amdgcn_readlane(__builtin_bit_cast(int, gl), 16 * i));
        f32x2 tq;
        tq = __builtin_amdgcn_cvt_pk_f32_fp8((int)vv[j].x, false); o[0] += ci * tq.x; o[1] += ci * tq.y;
        tq = __builtin_amdgcn_cvt_pk_f32_fp8((int)vv[j].x, true);  o[2] += ci * tq.x; o[3] += ci * tq.y;
        tq = __builtin_amdgcn_cvt_pk_f32_fp8((int)vv[j].y, false); o[4] += ci * tq.x; o[5] += ci * tq.y;
        tq = __builtin_amdgcn_cvt_pk_f32_fp8((int)vv[j].y, true);  o[6] += ci * tq.x; o[7] += ci * tq.y;
        tq = __builtin_amdgcn_cvt_pk_f32_fp8((int)vv[j].z, false); o[8] += ci * tq.x; o[9] += ci * tq.y;
        tq = __builtin_amdgcn_cvt_pk_f32_fp8((int)vv[j].z, true);  o[10] += ci * tq.x; o[11] += ci * tq.y;
        tq = __builtin_amdgcn_cvt_pk_f32_fp8((int)vv[j].w, false); o[12] += ci * tq.x; o[13] += ci * tq.y;
        tq = __builtin_amdgcn_cvt_pk_f32_fp8((int)vv[j].w, true);  o[14] += ci * tq.x; o[15] += ci * tq.y;
      }
    }
  }
  const int b = t >> 12;
  const float* mod = (const float*)(p.ws + OFF_MOD) + b * 6144 + 5120 + 16 * lane;
  float* xm = p.out + (size_t)t * 1024 + 16 * lane;
  float xo[16];
  float ss = 0.f;
#pragma unroll
  for (int q = 0; q < 4; ++q) {
    const float4 xv = *(const float4*)(xm + 4 * q);
    const float4 gv = *(const float4*)(mod + 4 * q);
    xo[4 * q + 0] = xv.x + gv.x * o[4 * q + 0];
    xo[4 * q + 1] = xv.y + gv.y * o[4 * q + 1];
    xo[4 * q + 2] = xv.z + gv.z * o[4 * q + 2];
    xo[4 * q + 3] = xv.w + gv.w * o[4 * q + 3];
  }
#pragma unroll
  for (int k = 0; k < 16; ++k) ss += xo[k] * xo[k];
  ss = wave_sum(ss);
  const float r = rsqrtf(ss * (1.f / 1024.f) + 1e-6f);
#pragma unroll
  for (int q = 0; q < 4; ++q) {
    const float4 fg = *(const float4*)(p.final_g + 16 * lane + 4 * q);
    *(float4*)(xm + 4 * q) = make_float4(xo[4 * q] * r * fg.x, xo[4 * q + 1] * r * fg.y, xo[4 * q + 2] * r * fg.z, xo[4 * q + 3] * r * fg.w);
  }
}

DEV void p9_experts4(const Params& p, int task, char* wsm) {
  const int lane = threadIdx.x & 63;
  const int t0 = task * 4;
  int* hist = (int*)wsm;
  unsigned* skey = (unsigned*)(wsm + 1024);
  float* swt = (float*)(wsm + 1024 + 2048);
  u16* sh2 = (u16*)(wsm + 1024 + 4096);
  hist[lane] = 0; hist[lane + 64] = 0; hist[lane + 128] = 0; hist[lane + 192] = 0;
  const int* ridx = (const int*)(p.ws + OFF_RIDX) + (size_t)t0 * 128 + lane * 8;
  const float* rw = (const float*)(p.ws + OFF_RW) + (size_t)t0 * 128 + lane * 8;
  int4 ea = *(const int4*)(ridx), eb = *(const int4*)(ridx + 4);
  float4 wa = *(const float4*)(rw), wb = *(const float4*)(rw + 4);
  int e[8] = {ea.x, ea.y, ea.z, ea.w, eb.x, eb.y, eb.z, eb.w};
  float w[8] = {wa.x, wa.y, wa.z, wa.w, wb.x, wb.y, wb.z, wb.w};
  {
    const u16* h2 = (const u16*)(p.ws + OFF_H2) + (size_t)t0 * 1024;
#pragma unroll
    for (int i = 0; i < 8; ++i) *(u32x4*)(sh2 + (lane + 64 * i) * 8) = *(const u32x4*)(h2 + (lane + 64 * i) * 8);
  }
  __builtin_amdgcn_fence(__ATOMIC_RELEASE, "wavefront");
  __builtin_amdgcn_wave_barrier();
  __builtin_amdgcn_fence(__ATOMIC_ACQUIRE, "wavefront");
  int rank[8];
#pragma unroll
  for (int j = 0; j < 8; ++j) rank[j] = atomicAdd(&hist[e[j] >> 6], 1);
  __builtin_amdgcn_fence(__ATOMIC_RELEASE, "wavefront");
  __builtin_amdgcn_wave_barrier();
  __builtin_amdgcn_fence(__ATOMIC_ACQUIRE, "wavefront");
  {
    const int c0 = hist[4 * lane], c1 = hist[4 * lane + 1], c2 = hist[4 * lane + 2], c3 = hist[4 * lane + 3];
    const int tot = c0 + c1 + c2 + c3;
    int x = tot;
#pragma unroll
    for (int o = 1; o < 64; o <<= 1) { const int y = __shfl_up(x, o); if (lane >= o) x += y; }
    const int base = x - tot;
    __builtin_amdgcn_fence(__ATOMIC_RELEASE, "wavefront");
    __builtin_amdgcn_wave_barrier();
    hist[4 * lane] = base; hist[4 * lane + 1] = base + c0; hist[4 * lane + 2] = base + c0 + c1; hist[4 * lane + 3] = base + c0 + c1 + c2;
  }
  __builtin_amdgcn_fence(__ATOMIC_RELEASE, "wavefront");
  __builtin_amdgcn_wave_barrier();
  __builtin_amdgcn_fence(__ATOMIC_ACQUIRE, "wavefront");
  {
    const unsigned slot = (unsigned)(lane >> 4);
#pragma unroll
    for (int j = 0; j < 8; ++j) {
      const int pos = hist[e[j] >> 6] + rank[j];
      skey[pos] = (unsigned)e[j] | (slot << 14);
      swt[pos] = w[j];
    }
  }
  __builtin_amdgcn_fence(__ATOMIC_RELEASE, "wavefront");
  __builtin_amdgcn_wave_barrier();
  __builtin_amdgcn_fence(__ATOMIC_ACQUIRE, "wavefront");

  float o0[16], o1[16], o2[16], o3[16];
#pragma unroll
  for (int k = 0; k < 16; ++k) { o0[k] = 0.f; o1[k] = 0.f; o2[k] = 0.f; o3[k] = 0.f; }
  const u16* U = (const u16*)(p.ws + OFF_UBF);
  const u16* V = (const u16*)(p.ws + OFF_VBF);
#define P9_LOAD(KK, UU, VV, BB)                                                           \
  _Pragma("unroll") for (int i = 0; i < 4; ++i) {                                         \
    KK[i] = (unsigned)__builtin_amdgcn_readfirstlane((int)skey[4 * (BB) + i]);            \
    const size_t ro = (size_t)(KK[i] & 16383u) * 1024 + 16 * lane;                        \
    UU[i] = *(const u32x4*)(U8 + ro);                                                     \
    VV[i] = *(const u32x4*)(V8 + ro);                                                     \
  }
#define P9_DOTS(KK, UU, BB, COEFV)                                                        \
  {                                                                                       \
    const float myw = swt[4 * (BB) + (lane >> 4)];                                        \
    float d[4];                                                                           \
    _Pragma("unroll") for (int i = 0; i < 4; ++i) {                                       \
      const unsigned slot = KK[i] >> 14;                                                  \
      const u32x4 ha = *(const u32x4*)(sh2 + slot * 1024 + 16 * lane);                    \
      const u32x4 hb = *(const u32x4*)(sh2 + slot * 1024 + 16 * lane + 8);                \
      float acc0 = 0.f, acc1 = 0.f;                                                       \
      {                                                                                   \
        f32x2 l0 = __builtin_amdgcn_cvt_pk_f32_fp8((int)UU[i].x, false), h0 = __builtin_amdgcn_cvt_pk_f32_fp8((int)UU[i].x, true); \
        f32x2 l1 = __builtin_amdgcn_cvt_pk_f32_fp8((int)UU[i].y, false), h1 = __builtin_amdgcn_cvt_pk_f32_fp8((int)UU[i].y, true); \
        f32x2 l2 = __builtin_amdgcn_cvt_pk_f32_fp8((int)UU[i].z, false), h2_ = __builtin_amdgcn_cvt_pk_f32_fp8((int)UU[i].z, true); \
        f32x2 l3 = __builtin_amdgcn_cvt_pk_f32_fp8((int)UU[i].w, false), h3 = __builtin_amdgcn_cvt_pk_f32_fp8((int)UU[i].w, true); \
        acc0 += l0.x * bflo(ha.x) + l0.y * bfhi(ha.x); acc1 += h0.x * bflo(ha.y) + h0.y * bfhi(ha.y);   \
        acc0 += l1.x * bflo(ha.z) + l1.y * bfhi(ha.z); acc1 += h1.x * bflo(ha.w) + h1.y * bfhi(ha.w);   \
        acc0 += l2.x * bflo(hb.x) + l2.y * bfhi(hb.x); acc1 += h2_.x * bflo(hb.y) + h2_.y * bfhi(hb.y); \
        acc0 += l3.x * bflo(hb.z) + l3.y * bfhi(hb.z); acc1 += h3.x * bflo(hb.w) + h3.y * bfhi(hb.w);   \
      }                                                                                   \
      d[i] = acc0 + acc1;                                                                 \
    }                                                                                     \
    const bool up32 = (lane & 32) != 0, up16 = (lane & 16) != 0;                          \
    float k0 = up32 ? d[2] : d[0], k1 = up32 ? d[3] : d[1];                               \
    float s0 = up32 ? d[0] : d[2], s1 = up32 ? d[1] : d[3];                               \
    k0 += __shfl_xor(s0, 32);                                                             \
    k1 += __shfl_xor(s1, 32);                                                             \
    float kq = up16 ? k1 : k0, sq = up16 ? k0 : k1;                                       \
    kq += __shfl_xor(sq, 16);                                                             \
    kq = DPP_ADD(kq, 0xB1);                                                               \
    kq = DPP_ADD(kq, 0x4E);                                                               \
    kq = DPP_ADD(kq, 0x141);                                                              \
    kq = DPP_ADD(kq, 0x140);                                                              \
    COEFV = myw * (1.f / 64.f) * gelu_tanh(kq * (1.f / 512.f));                           \
  }
#define P9_ACCUM(KK, VV, COEFV)                                                           \
  _Pragma("unroll") for (int i = 0; i < 4; ++i) {                                         \
    const float ci = __builtin_bit_cast(float, __builtin_amdgcn_readlane(__builtin_bit_cast(int, COEFV), 16 * i)); \
    const unsigned slot = KK[i] >> 14;                                                    \
    float vf[16];                                                                         \
    {                                                                                     \
      f32x2 t;                                                                            \
      t = __builtin_amdgcn_cvt_pk_f32_fp8((int)VV[i].x, false); vf[0] = t.x; vf[1] = t.y;   \
      t = __builtin_amdgcn_cvt_pk_f32_fp8((int)VV[i].x, true);  vf[2] = t.x; vf[3] = t.y;   \
      t = __builtin_amdgcn_cvt_pk_f32_fp8((int)VV[i].y, false); vf[4] = t.x; vf[5] = t.y;   \
      t = __builtin_amdgcn_cvt_pk_f32_fp8((int)VV[i].y, true);  vf[6] = t.x; vf[7] = t.y;   \
      t = __builtin_amdgcn_cvt_pk_f32_fp8((int)VV[i].z, false); vf[8] = t.x; vf[9] = t.y;   \
      t = __builtin_amdgcn_cvt_pk_f32_fp8((int)VV[i].z, true);  vf[10] = t.x; vf[11] = t.y; \
      t = __builtin_amdgcn_cvt_pk_f32_fp8((int)VV[i].w, false); vf[12] = t.x; vf[13] = t.y; \
      t = __builtin_amdgcn_cvt_pk_f32_fp8((int)VV[i].w, true);  vf[14] = t.x; vf[15] = t.y; \
    }                                                                                     \
    if (slot == 0) { _Pragma("unroll") for (int k = 0; k < 16; ++k) o0[k] += ci * vf[k]; }       \
    else if (slot == 1) { _Pragma("unroll") for (int k = 0; k < 16; ++k) o1[k] += ci * vf[k]; }  \
    else if (slot == 2) { _Pragma("unroll") for (int k = 0; k < 16; ++k) o2[k] += ci * vf[k]; }  \
    else { _Pragma("unroll") for (int k = 0; k < 16; ++k) o3[k] += ci * vf[k]; }                 \
  }
  {
    const unsigned char* U8 = (const unsigned char*)(p.ws + OFF_UBF);
    const unsigned char* V8 = (const unsigned char*)(p.ws + OFF_VBF);
    unsigned kkA[4], kkB[4];
    u32x4 uA[4], vA[4], uB[4], vB[4];
    float cfA, cfB;
    P9_LOAD(kkA, uA, vA, 0)
#pragma unroll 1
    for (int bb = 0; bb < 128; bb += 2) {
      P9_LOAD(kkB, uB, vB, bb + 1)
      P9_DOTS(kkA, uA, bb, cfA)
      P9_ACCUM(kkA, vA, cfA)
      const int n0 = (bb + 2 < 128) ? (bb + 2) : 0;
      P9_LOAD(kkA, uA, vA, n0)
      P9_DOTS(kkB, uB, bb + 1, cfB)
      P9_ACCUM(kkB, vB, cfB)
    }
  }
#pragma unroll
  for (int s = 0; s < 4; ++s) {
    const int t = t0 + s;
    const int b = t >> 12;
    const float* mod = (const float*)(p.ws + OFF_MOD) + b * 6144 + 5120 + 16 * lane;
    float* xm = p.out + (size_t)t * 1024 + 16 * lane;
    const float* oo = (s == 0) ? o0 : ((s == 1) ? o1 : ((s == 2) ? o2 : o3));
    float xo[16];
    float ss = 0.f;
#pragma unroll
    for (int q = 0; q < 4; ++q) {
      const float4 xv = *(const float4*)(xm + 4 * q);
      const float4 gv = *(const float4*)(mod + 4 * q);
      xo[4 * q + 0] = xv.x + gv.x * oo[4 * q + 0];
      xo[4 * q + 1] = xv.y + gv.y * oo[4 * q + 1];
      xo[4 * q + 2] = xv.z + gv.z * oo[4 * q + 2];
      xo[4 * q + 3] = xv.w + gv.w * oo[4 * q + 3];
    }
#pragma unroll
    for (int k = 0; k < 16; ++k) ss += xo[k] * xo[k];
    ss = wave_sum(ss);
    const float r = rsqrtf(ss * (1.f / 1024.f) + 1e-6f);
#pragma unroll
    for (int q = 0; q < 4; ++q) {
      const float4 fg = *(const float4*)(p.final_g + 16 * lane + 4 * q);
      *(float4*)(xm + 4 * q) = make_float4(xo[4 * q] * r * fg.x, xo[4 * q + 1] * r * fg.y, xo[4 * q + 2] * r * fg.z, xo[4 * q + 3] * r * fg.w);
    }
  }
  __builtin_amdgcn_fence(__ATOMIC_RELEASE, "wavefront");
  __builtin_amdgcn_wave_barrier();
}

#define XB_TMO      128
#define XB_XCNT(j)  (256  + 64 * (j))
#define XB_XSUB(j)  (1280 + 64 * (j))
#define XB_XGEN(j)  (2304 + 64 * (j))
#define XB_TOP      3328
#define XB_TOPGEN   3392
#define XCD_BAR_WORDS 3456
#define XB_SPIN_CAP (1u << 18)
#define LAS __attribute__((address_space(3)))

__device__ __forceinline__ unsigned xb_ld(unsigned* p)              { return __hip_atomic_load(p, __ATOMIC_RELAXED, __HIP_MEMORY_SCOPE_AGENT); }
__device__ __forceinline__ unsigned xb_add(unsigned* p, unsigned v) { return __hip_atomic_fetch_add(p, v, __ATOMIC_RELAXED, __HIP_MEMORY_SCOPE_AGENT); }
__device__ __forceinline__ unsigned xb_xcc_id() { return (unsigned)__builtin_amdgcn_s_getreg((3 << 11) | 20) & 0xFu; }
#define XB_SPIN(cond, bar) do { unsigned _sp = 0; while (cond) { __builtin_amdgcn_s_sleep(1); \
    if ((++_sp & 255u) == 0u) { if (xb_ld(&(bar)[XB_TMO])) break; if (_sp > XB_SPIN_CAP) { atomicAdd(&(bar)[XB_TMO], 1u); break; } } } } while (0)

struct XcdBarrier {
    unsigned* bar; unsigned x;
    volatile LAS unsigned* st;
};

__device__ __forceinline__ XcdBarrier xcd_barrier_post(unsigned* bar, volatile LAS unsigned* st) {
    XcdBarrier b; b.bar = bar; b.x = xb_xcc_id(); b.st = st;
    if (threadIdx.x == 0) (void)xb_add(&bar[XB_XCNT(b.x)], 1u);
    return b;
}
__device__ __forceinline__ void xcd_barrier_complete(unsigned* bar, unsigned x, unsigned& nloc, unsigned& nx) {
    const unsigned G = gridDim.x * gridDim.y * gridDim.z;
    unsigned sum, cnt, mine, sp = 0u;
    for (;;) {
        sum = 0u; cnt = 0u; mine = 0u;
#pragma unroll
        for (unsigned j = 0; j < 16; ++j) { const unsigned c = xb_ld(&bar[XB_XCNT(j)]); sum += c; cnt += (c > 0u) ? 1u : 0u; mine = (j == x) ? c : mine; }
        if (sum == G) break;
        __builtin_amdgcn_s_sleep(1);
        if ((++sp & 255u) == 0u) { if (xb_ld(&bar[XB_TMO])) break; if (sp > XB_SPIN_CAP) { atomicAdd(&bar[XB_TMO], 1u); break; } }
    }
    nloc = mine > 0u ? mine : 1u; nx = cnt > 0u ? cnt : 1u;
}

__device__ __forceinline__ void xcd_barrier(const XcdBarrier& b) {
    asm volatile("s_waitcnt vmcnt(0)" ::: "memory");
    __syncthreads();
    if (threadIdx.x == 0) {
        unsigned* bar = b.bar;
        __builtin_amdgcn_s_waitcnt(0);
        unsigned nloc = b.st[0], nx = b.st[1];
        if (nloc == 0u) { xcd_barrier_complete(bar, b.x, nloc, nx); b.st[0] = nloc; b.st[1] = nx; }
        const unsigned old = xb_add(&bar[XB_XSUB(b.x)], 1u);
        const unsigned gen = old / nloc;
        if (old + 1u == (gen + 1u) * nloc) {
            __builtin_amdgcn_fence(__ATOMIC_RELEASE, "agent");
            asm volatile("s_waitcnt vmcnt(0)" ::: "memory");
            const unsigned og = xb_add(&bar[XB_TOP], 1u);
            const unsigned tg = og / nx;
            if (og + 1u == (tg + 1u) * nx) xb_add(&bar[XB_TOPGEN], 1u);
            else XB_SPIN(xb_ld(&bar[XB_TOPGEN]) == tg, bar);
            __builtin_amdgcn_fence(__ATOMIC_ACQUIRE, "agent");
            xb_add(&bar[XB_XGEN(b.x)], 1u);
            asm volatile("s_waitcnt vmcnt(0)" ::: "memory");
        } else {
            XB_SPIN(xb_ld(&bar[XB_XGEN(b.x)]) == gen, bar);
            __builtin_amdgcn_fence(__ATOMIC_ACQUIRE, "agent");
            asm volatile("s_waitcnt vmcnt(0)" ::: "memory");
        }
    }
    __syncthreads();
}


__global__ void __launch_bounds__(256, 2) mega(Params p) {
  extern __shared__ __attribute__((aligned(16))) char smem[];
  cg::grid_group grid = cg::this_grid();
  const int tid = threadIdx.x, lane = tid & 63, wave = tid >> 6;
  const int nb = gridDim.x, bid = blockIdx.x;
  float* smf = (float*)smem;
  if (p.ws == nullptr) grid.sync();
  volatile LAS unsigned* xst = (volatile LAS unsigned*)(smem + SMEM_XB);
  if (tid == 0) { xst[0] = 0u; xst[1] = 0u; }
  __syncthreads();
  const XcdBarrier xb = xcd_barrier_post((unsigned*)(p.ws + OFF_BAR), xst);
  u16* sA = (u16*)smem;
  u16* sB = (u16*)(smem + 128 * 64 * 2);

  for (int rep_ = 0; rep_ < NREP(0); ++rep_) if (PHON(0)) {
    const int N_MOD = 384, N_TIN = 16 * 68, N_TOA = 8 * 16, N_TOH = 8 * 16, N_TOUT = 16 * 16, N_TQ = 16 * 16, N_HID = 1024;
    const int total = N_MOD + N_TIN + N_TOA + N_TOH + N_TOUT + N_TQ + N_HID + 16 + 1;
    for (int it = bid; it < total; it += nb) {
      int i = it;
      if (i < N_MOD) { p0_mod(p, i, smf); continue; }
      i -= N_MOD;
      if (i < N_TIN) { transpose_tile(p.w_in, INW, 1024, (u16*)(p.ws + OFF_WIN), i, smf); continue; }
      i -= N_TIN;
      if (i < N_TOA) { transpose_tile(p.w_o_attn, 1024, 512, (u16*)(p.ws + OFF_WOA), i, smf); continue; }
      i -= N_TOA;
      if (i < N_TOH) { transpose_tile(p.w_o_hy, 1024, 512, (u16*)(p.ws + OFF_WOH), i, smf); continue; }
      i -= N_TOH;
      if (i < N_TOUT) { transpose_tile(p.w_out, 1024, 1024, (u16*)(p.ws + OFF_WOUT), i, smf); continue; }
      i -= N_TOUT;
      if (i < N_TQ) { transpose_tile(p.peer_wq, 1024, 1024, (u16*)(p.ws + OFF_WQ), i, smf); continue; }
      i -= N_TQ;
      if (i < N_HID) { p0_hidden(p, i, smf); continue; }
      i -= N_HID;
      if (i < 16) { transpose_tile(p.hy_fw3, 1024, 64, (u16*)(p.ws + OFF_H2F + 512 * 1024), i, smf); continue; }
      float2* rope = (float2*)(p.ws + OFF_ROPE);
      for (int idx = tid; idx < 1024; idx += 256) {
        const int pos = idx >> 4, f = idx & 15;
        const float inv = powf(10000.f, -(float)f / 16.f);
        const float ang = (float)pos * inv;
        rope[idx] = make_float2(cosf(ang), sinf(ang));
      }
    }
    convert_flat(p.peer_keys, (u16*)(p.ws + OFF_KEYS), (size_t)131072);
    convert_flat_fp8(p.peer_u, (unsigned char*)(p.ws + OFF_UBF), (size_t)16384 * 1024, 512.f);
    convert_flat_fp8(p.peer_v, (unsigned char*)(p.ws + OFF_VBF), (size_t)16384 * 1024, 64.f);
  }
  xcd_barrier(xb);

  for (int rep_ = 0; rep_ < NREP(1); ++rep_) if (PHON(1)) {
    const float* mod = (const float*)(p.ws + OFF_MOD);
    const int nrows = T_TOK + 1024;
    for (int r = bid * 4 + wave; r < nrows; r += nb * 4) {
      if (r < T_TOK) {
        const int b = r >> 12;
        norm_row(p.x + (size_t)r * 1024, p.norm1_g, mod + b * 6144, mod + b * 6144 + 1024,
                 (u16*)((char*)p.out + OO_H1) + (size_t)r * 1024, lane);
      } else {
        const int rc = r - T_TOK;
        norm_row(p.ctx + (size_t)rc * 1024, p.norm1_g, mod + 4 * 6144, mod + 4 * 6144 + 1024,
                 (u16*)((char*)p.out + OO_HC) + (size_t)rc * 1024, lane);
      }
    }
    for (int it = bid; it < 256; it += nb) p1_filter_tile(p, (it + 256 < nb) ? it : it, sA, sB);
  }
  xcd_barrier(xb);

  for (int rep_ = 0; rep_ < NREP(2); ++rep_) if (PHON(2)) {
    if (nb == 512) {
      const int xg = bid & 7, slot = bid >> 3;
      for (int r = 0; r < 8; ++r) {
        const int sup = r * 8 + xg;
        const int mt = (sup >> 2) * 8 + (slot >> 3), nt = (sup & 3) * 8 + (slot & 7);
        p2_inproj(p, mt * 34 + nt, sA, sB);
      }
      if (bid < 256) p2_inproj(p, (bid >> 1) * 34 + 32 + (bid & 1), sA, sB);
      else if (bid < 272) p2_ctxkv(p, bid - 256, sA, sB);
    } else {
      const int total = 128 * 34 + 16;
      for (int it = bid; it < total; it += nb) {
        if (it < 128 * 34) p2_inproj(p, it, sA, sB);
        else p2_ctxkv(p, it - 128 * 34, sA, sB);
      }
    }
  }
  xcd_barrier(xb);

  for (int rep_ = 0; rep_ < NREP(3); ++rep_) if (PHON(3)) {
    const int total = 1024 + 1024;
    for (int it = bid; it < total; it += nb) {
      if (it < 1024) p3_attn(p, it, (u16*)smem, (u16*)(smem + 128 * 72 * 2));
      else p3_hypre(p, it - 1024, (u16*)smem);
    }
  }
  xcd_barrier(xb);

  for (int rep_ = 0; rep_ < NREP(4); ++rep_) if (PHON(4)) for (int it = bid; it < 512; it += nb) p3_toeplitz(p, it, smem);
  xcd_barrier(xb);

  for (int rep_ = 0; rep_ < NREP(5); ++rep_) if (PHON(5)) for (int it = bid; it < 1024; it += nb) p4_merge(p, (nb == 512) ? ((((it >> 9) * 8 + (bid & 7)) * 8 + (bid >> 6)) * 8 + ((bid >> 3) & 7)) : it, sA, sB);
  xcd_barrier(xb);

  for (int rep_ = 0; rep_ < NREP(6); ++rep_) if (PHON(6)) for (int it = bid; it < 1024; it += nb) p5_out(p, (nb == 512) ? ((((it >> 9) * 8 + (bid & 7)) * 8 + (bid >> 6)) * 8 + ((bid >> 3) & 7)) : it, sA, sB);
  xcd_barrier(xb);

  for (int rep_ = 0; rep_ < NREP(7); ++rep_) if (PHON(7)) {
    const float* mod = (const float*)(p.ws + OFF_MOD);
    for (int r = bid * 4 + wave; r < T_TOK; r += nb * 4) {
      const int b = r >> 12;
      norm_row(p.out + (size_t)r * 1024, p.norm2_g, mod + b * 6144 + 3072, mod + b * 6144 + 4096,
               (u16*)(p.ws + OFF_H2) + (size_t)r * 1024, lane);
    }
  }
  xcd_barrier(xb);

  for (int rep_ = 0; rep_ < NREP(8); ++rep_) if (PHON(8)) for (int it = bid; it < 1024; it += nb) p7_qp(p, (nb == 512) ? ((((it >> 9) * 8 + (bid & 7)) * 8 + (bid >> 6)) * 8 + ((bid >> 3) & 7)) : it, sA, sB);
  xcd_barrier(xb);

  for (int rep_ = 0; rep_ < NREP(9); ++rep_) if (PHON(9)) for (int it = bid * 4 + wave; it < 8192; it += nb * 4) p8_route(p, it, smem + wave * 4096);
  xcd_barrier(xb);

  if (PHON(10)) {
    const int nw = nb * 4;
    int t = bid * 4 + wave;
    if (t < T_TOK) {
      int2 e2n = *(const int2*)((const int*)(p.ws + OFF_RIDX) + (size_t)t * 128 + 2 * lane);
      float2 w2n = *(const float2*)((const float*)(p.ws + OFF_RW) + (size_t)t * 128 + 2 * lane);
      u32x4 han = *(const u32x4*)((const u16*)(p.ws + OFF_H2) + (size_t)t * 1024 + 16 * lane);
      u32x4 hbn = *(const u32x4*)((const u16*)(p.ws + OFF_H2) + (size_t)t * 1024 + 16 * lane + 8);
      for (; t < T_TOK; t += nw) {
        const int tn = (t + nw < T_TOK) ? (t + nw) : t;
        p9_token(p, t, tn, lane, e2n, w2n, han, hbn);
      }
    }
  }
}

extern "C" void kernel_launch(void* const* d_in, const int* in_sizes, int n_in, void* d_out, int out_size,
                              void* d_ws, size_t ws_size, hipStream_t stream) {
  static int grid_blocks = 0;
  if (!grid_blocks) {
    int dev = 0, cus = 0, per_cu = 0;
    (void)hipGetDevice(&dev);
    (void)hipDeviceGetAttribute(&cus, hipDeviceAttributeMultiprocessorCount, dev);
    (void)hipFuncSetAttribute((const void*)mega, hipFuncAttributeMaxDynamicSharedMemorySize, SMEM_BYTES);
    (void)hipOccupancyMaxActiveBlocksPerMultiprocessor(&per_cu, mega, 256, SMEM_BYTES);
    if (per_cu > 2) per_cu = 2;
    if (per_cu < 1) per_cu = 1;
    grid_blocks = cus * per_cu;
  }
  Params p{};
  const float** pp = (const float**)&p;
  for (int i = 0; i < 28; ++i) pp[i] = (const float*)d_in[i];
  p.out = (float*)d_out;
  p.ws = (char*)d_ws;
  (void)hipMemsetAsync((char*)d_ws, 0, OFF_BAR + 24576, stream);
  void* args[] = {&p};
  hipError_t e = hipLaunchCooperativeKernel((void*)mega, dim3(grid_blocks), dim3(256), args, SMEM_BYTES, stream);
  if (e != hipSuccess) fprintf(stderr, "cooperative launch failed: %s (grid %d)\n", hipGetErrorString(e), grid_blocks);
}
```

```cpp
#include <hip/hip_runtime.h>
#include <hip/hip_bf16.h>
#include <hip/hip_cooperative_groups.h>
#include <cstdio>
namespace cg = cooperative_groups;

typedef unsigned short u16;
typedef __attribute__((ext_vector_type(8))) short bf16x8;
typedef __attribute__((ext_vector_type(4))) float f32x4;
typedef __attribute__((ext_vector_type(4))) unsigned u32x4;

#define DEV __device__ __forceinline__
#ifndef PH
#define PH -1
#endif
#define PHON(n) (PH < 0 || PH == (n))
#ifndef REP
#define REP -1
#endif
#define NREP(n) ((REP == (n)) ? 2 : 1)

constexpr int T_TOK = 16384;
constexpr int DM = 1024;
constexpr int SEQL = 4096;
constexpr int INW = 4352;

struct Params {
  const float *x, *c, *ctx, *c_ctx, *w_mod, *b_mod, *norm1_g, *w_in, *attn_sink, *hy_conv_w, *hy_conv_b,
      *hy_fw1, *hy_fb1, *hy_fw2, *hy_fb2, *hy_fw3, *hy_fb3, *hy_freq, *hy_skip, *w_o_attn, *w_o_hy, *w_out,
      *norm2_g, *peer_wq, *peer_keys, *peer_u, *peer_v, *final_g;
  float* out;
  char* ws;
};

constexpr size_t MB = 1u << 20;
constexpr size_t OFF_MOD = 0;
constexpr size_t OFF_ROPE = 128 * 1024;
constexpr size_t OFF_NINV = OFF_ROPE + 8192;
constexpr size_t OFF_H2F = 256 * 1024;
constexpr size_t OFF_WIN = OFF_H2F + MB;
constexpr size_t OFF_WOA = OFF_WIN + 9 * MB;
constexpr size_t OFF_WOH = OFF_WOA + MB;
constexpr size_t OFF_WOUT = OFF_WOH + MB;
constexpr size_t OFF_WQ = OFF_WOUT + 2 * MB;
constexpr size_t OFF_KEYS = OFF_WQ + 2 * MB;
constexpr size_t OFF_UBF = OFF_KEYS + MB;
constexpr size_t OFF_VBF = OFF_UBF + 32 * MB;
constexpr size_t OFF_Q = OFF_VBF + 32 * MB;
constexpr size_t OFF_K = OFF_Q + 16 * MB;
constexpr size_t OFF_VT = OFF_K + 4 * MB;
constexpr size_t OFF_KC = OFF_VT + 4 * MB;
constexpr size_t OFF_VCT = OFF_KC + MB / 2;
constexpr size_t OFF_Z = OFF_VCT + MB / 2;
constexpr size_t OFF_GATE = OFF_Z + 48 * MB;
constexpr size_t OFF_YATT = OFF_GATE + 64 * MB;
constexpr size_t OFF_YHY = OFF_YATT + 16 * MB;
constexpr size_t OFF_RIDX = OFF_Q;
constexpr size_t OFF_RW = OFF_Q + 8 * MB;
constexpr size_t OFF_MERGED = OFF_Z;
constexpr size_t OFF_H2 = OFF_GATE;
constexpr size_t OFF_QP = OFF_GATE + 32 * MB;
constexpr size_t OO_H1 = 0;
constexpr size_t OO_UT = 0;
constexpr size_t OO_X0T = 16 * MB;
constexpr size_t OO_HC = 32 * MB;
constexpr size_t OO_G = 34 * MB;

constexpr int SMEM_BYTES = 70144;
constexpr size_t OFF_BAR = 160 * 1024;
constexpr int SMEM_XB = 70016;

typedef __attribute__((ext_vector_type(2))) float pk_f2;
typedef __attribute__((ext_vector_type(2))) __bf16 pk_b2;
DEV unsigned pack2(float a, float b) {
  pk_f2 v = {a, b};
  return __builtin_bit_cast(unsigned, __builtin_convertvector(v, pk_b2));
}
DEV u16 f2bf(float f) { return (u16)(pack2(f, 0.f) & 0xffffu); }
DEV float bf2f(u16 h) { return __uint_as_float(((unsigned)h) << 16); }
DEV float bflo(unsigned w) { return __uint_as_float(w << 16); }
DEV float bfhi(unsigned w) { return __uint_as_float(w & 0xffff0000u); }
#define DPP_ADD(v, ctrl) ((v) + __builtin_bit_cast(float, __builtin_amdgcn_update_dpp(0, __builtin_bit_cast(int, (v)), (ctrl), 0xF, 0xF, true)))
DEV float wave_sum(float v) {
  v = DPP_ADD(v, 0xB1);
  v = DPP_ADD(v, 0x4E);
  v = DPP_ADD(v, 0x141);
  v = DPP_ADD(v, 0x140);
  v += __shfl_xor(v, 16);
  v += __shfl_xor(v, 32);
  return v;
}
DEV float wave_max(float v) {
#pragma unroll
  for (int o = 32; o > 0; o >>= 1) v = fmaxf(v, __shfl_xor(v, o));
  return v;
}

DEV void p0_mod(const Params& p, int item, float* sm) {
  const int tid = threadIdx.x;
  const int cblk = item >> 2, kq = item & 3;
  for (int i = tid; i < 5 * 256; i += 256) {
    const int r = i >> 8, k = kq * 256 + (i & 255);
    const float c = (r < 4) ? p.c[r * 1024 + k] : p.c_ctx[k];
    sm[i] = c * __builtin_amdgcn_rcpf(1.f + __expf(-c));
  }
  __syncthreads();
  const int col = cblk * 64 + (tid & 63), sub = tid >> 6;
  float a0 = 0, a1 = 0, a2 = 0, a3 = 0, a4 = 0;
  const float* wp = p.w_mod + (size_t)(kq * 256 + sub * 64) * 6144 + col;
#pragma unroll 16
  for (int k = 0; k < 64; ++k) {
    const float w = wp[(size_t)k * 6144];
    const int kk = sub * 64 + k;
    a0 += sm[kk] * w; a1 += sm[256 + kk] * w; a2 += sm[512 + kk] * w; a3 += sm[768 + kk] * w; a4 += sm[1024 + kk] * w;
  }
  float* red = sm + 5 * 256;
  red[(sub * 5 + 0) * 64 + (tid & 63)] = a0;
  red[(sub * 5 + 1) * 64 + (tid & 63)] = a1;
  red[(sub * 5 + 2) * 64 + (tid & 63)] = a2;
  red[(sub * 5 + 3) * 64 + (tid & 63)] = a3;
  red[(sub * 5 + 4) * 64 + (tid & 63)] = a4;
  __syncthreads();
  float* mod = (float*)(p.ws + OFF_MOD);
  for (int i = tid; i < 320; i += 256) {
    const int r = i >> 6, cc = i & 63;
    float sacc = red[(0 * 5 + r) * 64 + cc] + red[(1 * 5 + r) * 64 + cc] + red[(2 * 5 + r) * 64 + cc] + red[(3 * 5 + r) * 64 + cc];
    if (kq == 0) sacc += p.b_mod[cblk * 64 + cc];
    atomicAdd(mod + r * 6144 + cblk * 64 + cc, sacc);
  }
  __syncthreads();
}

DEV void transpose_tile(const float* __restrict__ src, int N, int K, u16* __restrict__ dst, int tile, float* sm) {
  const int tid = threadIdx.x;
  const int nkt = K >> 6;
  const int kt = tile % nkt, nt = tile / nkt;
  const int k0 = kt * 64, n0 = nt * 64;
  const int c4 = tid & 15, r = tid >> 4;
  float4 tv[4];
#pragma unroll
  for (int rr = 0; rr < 4; ++rr) tv[rr] = *(const float4*)(src + (size_t)(k0 + rr * 16 + r) * N + n0 + c4 * 4);
#pragma unroll
  for (int rr = 0; rr < 4; ++rr) {
    float* d0 = sm + (rr * 16 + r) * 65 + c4 * 4;
    d0[0] = tv[rr].x; d0[1] = tv[rr].y; d0[2] = tv[rr].z; d0[3] = tv[rr].w;
  }
  __syncthreads();
  const int nn = tid >> 2, part = tid & 3;
  unsigned w[8];
#pragma unroll
  for (int j = 0; j < 8; ++j) w[j] = pack2(sm[(part * 16 + 2 * j) * 65 + nn], sm[(part * 16 + 2 * j + 1) * 65 + nn]);
  uint4* d = (uint4*)(dst + (size_t)(n0 + nn) * K + k0 + part * 16);
  d[0] = make_uint4(w[0], w[1], w[2], w[3]);
  d[1] = make_uint4(w[4], w[5], w[6], w[7]);
  __syncthreads();
}

DEV void p0_hidden(const Params& p, int item, float* sm) {
  const int tid = threadIdx.x;
  float* z = sm;
  float* h1 = sm + 4 * 36;
  if (tid < 4 * 33) {
    int tt = tid / 33, i = tid % 33;
    int t = item * 4 + tt;
    float v;
    if (i == 0) v = (float)t * (1.f / 4096.f);
    else {
      int band = (i <= 16) ? i : (i - 16);
      float fr = (float)((t * band) & 4095) * (1.f / 4096.f);
      v = (i <= 16) ? cospif(2.f * fr) : sinpif(2.f * fr);
    }
    z[tt * 36 + i] = v;
  }
  __syncthreads();
  const int tt = tid >> 6, j = tid & 63;
  float a = p.hy_fb1[j];
  for (int i = 0; i < 33; ++i) a += z[tt * 36 + i] * p.hy_fw1[i * 64 + j];
  const float fq = p.hy_freq[j];
  h1[tt * 64 + j] = sinf(fq * a);
  __syncthreads();
  float b = p.hy_fb2[j];
  for (int i = 0; i < 64; ++i) b += h1[tt * 64 + i] * p.hy_fw2[i * 64 + j];
  ((u16*)(p.ws + OFF_H2F))[(item * 4 + tt) * 64 + j] = f2bf(sinf(fq * b));
  __syncthreads();
}

DEV void convert_flat(const float* __restrict__ src, u16* __restrict__ dst, size_t n) {
  size_t stride = (size_t)gridDim.x * 256 * 8;
  for (size_t i = ((size_t)blockIdx.x * 256 + threadIdx.x) * 8; i < n; i += stride) {
    float4 a = *(const float4*)(src + i);
    float4 b = *(const float4*)(src + i + 4);
    *(uint4*)(dst + i) = make_uint4(pack2(a.x, a.y), pack2(a.z, a.w), pack2(b.x, b.y), pack2(b.z, b.w));
  }
}

typedef __attribute__((ext_vector_type(2))) float f32x2;
DEV void convert_flat_fp8(const float* __restrict__ src, unsigned char* __restrict__ dst, size_t n, float scale) {
  const size_t q4 = (size_t)gridDim.x * 256 * 16;
  const size_t stride = q4 * 4;
  for (size_t i = ((size_t)blockIdx.x * 256 + threadIdx.x) * 16; i < n; i += stride) {
    float4 a[16];
#pragma unroll
    for (int c = 0; c < 4; ++c) {
      const size_t off = i + c * q4;
      if (off < n) {
#pragma unroll
        for (int q = 0; q < 4; ++q) a[c * 4 + q] = *(const float4*)(src + off + 4 * q);
      }
    }
#pragma unroll
    for (int c = 0; c < 4; ++c) {
      const size_t off = i + c * q4;
      if (off < n) {
        unsigned w[4];
#pragma unroll
        for (int q = 0; q < 4; ++q) {
          int v = 0;
          v = __builtin_amdgcn_cvt_pk_fp8_f32(a[c * 4 + q].x * scale, a[c * 4 + q].y * scale, v, false);
          v = __builtin_amdgcn_cvt_pk_fp8_f32(a[c * 4 + q].z * scale, a[c * 4 + q].w * scale, v, true);
          w[q] = (unsigned)v;
        }
        *(uint4*)(dst + off) = make_uint4(w[0], w[1], w[2], w[3]);
      }
    }
  }
}

DEV void norm_row(const float* __restrict__ xr, const float* __restrict__ g, const float* __restrict__ sh,
                  const float* __restrict__ sc, u16* __restrict__ dst, int lane) {
  float4 v[4];
  float ss = 0.f;
#pragma unroll
  for (int i = 0; i < 4; ++i) {
    v[i] = ((const float4*)xr)[lane + 64 * i];
    ss += v[i].x * v[i].x + v[i].y * v[i].y + v[i].z * v[i].z + v[i].w * v[i].w;
  }
  ss = wave_sum(ss);
  const float r = rsqrtf(ss * (1.f / 1024.f) + 1e-6f);
#pragma unroll
  for (int i = 0; i < 4; ++i) {
    const int idx = lane + 64 * i;
    float4 gg = ((const float4*)g)[idx], s1 = ((const float4*)sh)[idx], s2 = ((const float4*)sc)[idx];
    float y0 = v[i].x * r * gg.x * (1.f + s2.x) + s1.x;
    float y1 = v[i].y * r * gg.y * (1.f + s2.y) + s1.y;
    float y2 = v[i].z * r * gg.z * (1.f + s2.z) + s1.z;
    float y3 = v[i].w * r * gg.w * (1.f + s2.w) + s1.w;
    *(uint2*)(dst + idx * 4) = make_uint2(pack2(y0, y1), pack2(y2, y3));
  }
}

DEV void p1_filter(const Params& p, int item, float* sm) {
  const int tid = threadIdx.x;
  const int c0 = (item >> 2) * 4, tq = item & 3;
  float* wc = sm;
  float* red = sm + 512;
  for (int i = tid; i < 512; i += 256) {
    const int j = i >> 6, k = i & 63;
    wc[i] = p.hy_fw3[k * 1024 + ((j < 4) ? (c0 + j) : (512 + c0 + j - 4))];
  }
  __syncthreads();
  float fb[8], dl[4];
#pragma unroll
  for (int j = 0; j < 8; ++j) fb[j] = p.hy_fb3[(j < 4) ? (c0 + j) : (512 + c0 + j - 4)];
  const float da = logf(1e-2f) / 1.5f, db = logf(1e-2f) / 0.3f;
#pragma unroll
  for (int j = 0; j < 4; ++j) dl[j] = fabsf(da + (db - da) * (float)(c0 + j) / 511.f);
  u16* G = (u16*)((char*)p.out + OO_G);
  const float* H = (const float*)(p.ws + OFF_H2F);
  float as[4] = {0.f, 0.f, 0.f, 0.f};
#pragma unroll 1
  for (int i = 0; i < 4; ++i) {
    const int t = tq * 1024 + i * 256 + tid;
    const float4* hp = (const float4*)(H + t * 64);
    float d[8];
#pragma unroll
    for (int j = 0; j < 8; ++j) d[j] = fb[j];
#pragma unroll 1
    for (int q8 = 0; q8 < 16; q8 += 8) {
      float4 hv[8];
#pragma unroll
      for (int u = 0; u < 8; ++u) hv[u] = hp[q8 + u];
#pragma unroll
      for (int u = 0; u < 8; ++u)
#pragma unroll
        for (int j = 0; j < 8; ++j) {
          const float4 w = *(const float4*)(wc + j * 64 + 4 * (q8 + u));
          d[j] += hv[u].x * w.x + hv[u].y * w.y + hv[u].z * w.z + hv[u].w * w.w;
        }
    }
    const float tn = (float)t * (1.f / 4096.f);
#pragma unroll
    for (int j = 0; j < 4; ++j) {
      const float dec = expf(-tn * dl[j]);
      const float f = d[j] * dec, bw = d[4 + j] * dec;
      u16* Gc = G + (size_t)(c0 + j) * 8192;
      Gc[4095 - t] = f2bf(f);
      as[j] += fabsf(f);
      if (t < 4095) { Gc[4096 + t] = f2bf(bw); as[j] += fabsf(bw); }
      else Gc[8191] = 0;
    }
  }
#pragma unroll
  for (int j = 0; j < 4; ++j) {
    const float v = wave_sum(as[j]);
    if ((tid & 63) == 0) red[(tid >> 6) * 4 + j] = v;
  }
  __syncthreads();
  if (tid < 4) atomicAdd((float*)(p.ws + OFF_BAR + 20480) + c0 + tid, red[tid] + red[4 + tid] + red[8 + tid] + red[12 + tid]);
  __syncthreads();
}

struct Acc { f32x4 v[4][4]; };

DEV void acc_zero(Acc& a) {
#pragma unroll
  for (int i = 0; i < 4; ++i)
#pragma unroll
    for (int j = 0; j < 4; ++j) a.v[i][j] = (f32x4){0.f, 0.f, 0.f, 0.f};
}

#define LDSAS __attribute__((address_space(3)))
DEV void gemm_kloop(const u16* __restrict__ A, int lda, const u16* __restrict__ Bt, int ldb, int K, int m0, int n0,
                    u16* sA, u16* sB_unused, Acc& acc) {
  const int tid = threadIdx.x, lane = tid & 63, wave = tid >> 6, wm = wave >> 1, wn = wave & 1;
  const int l15 = lane & 15, quad = lane >> 4;
  const int rsw = (l15 >> 1) & 7;
  const int nk = K >> 6;
  const int prow = lane >> 3;
  const int pch = lane & 7;
  unsigned oA[4], oB[4];
#pragma unroll
  for (int i = 0; i < 4; ++i) {
    const int row = (wave * 4 + i) * 8 + prow;
    const int c = pch ^ ((row >> 1) & 7);
    oA[i] = (unsigned)(row * lda + c * 8) * 2u;
    oB[i] = (unsigned)(row * ldb + c * 8) * 2u;
  }
  const char* bA = (const char*)(A + (size_t)m0 * lda);
  const char* bB = (const char*)(Bt + (size_t)n0 * ldb);
  LDSAS char* lbase = (LDSAS char*)sA;
#define GEMM_DMA(KT, BUF)                                                                                   \
  _Pragma("unroll") for (int i = 0; i < 4; ++i) {                                                           \
    __builtin_amdgcn_global_load_lds((const unsigned*)(bA + (KT) * 128 + oA[i]), (LDSAS unsigned*)(lbase + (BUF) * 32768 + (wave * 4 + i) * 1024), 16, 0, 0);          \
    __builtin_amdgcn_global_load_lds((const unsigned*)(bB + (KT) * 128 + oB[i]), (LDSAS unsigned*)(lbase + (BUF) * 32768 + 16384 + (wave * 4 + i) * 1024), 16, 0, 0);  \
  }
  GEMM_DMA(0, 0)
  for (int kt = 0; kt < nk; ++kt) {
    asm volatile("s_waitcnt vmcnt(0)" ::: "memory");
    __syncthreads();
    const int buf = kt & 1;
    if (kt + 1 < nk) { GEMM_DMA(kt + 1, buf ^ 1) }
    const u16* tA = sA + buf * 16384;
    const u16* tB = tA + 8192;
    bf16x8 af[2][4], bfr[2][4];
#pragma unroll
    for (int ks = 0; ks < 2; ++ks) {
      const int cs = ((ks * 4 + quad) ^ rsw) * 8;
#pragma unroll
      for (int i = 0; i < 4; ++i) af[ks][i] = *(const bf16x8*)(tB + (wn * 64 + i * 16 + l15) * 64 + cs);
#pragma unroll
      for (int j = 0; j < 4; ++j) bfr[ks][j] = *(const bf16x8*)(tA + (wm * 64 + j * 16 + l15) * 64 + cs);
    }
    __builtin_amdgcn_s_setprio(1);
#pragma unroll
    for (int ks = 0; ks < 2; ++ks)
#pragma unroll
      for (int i = 0; i < 4; ++i)
#pragma unroll
        for (int j = 0; j < 4; ++j) acc.v[i][j] = __builtin_amdgcn_mfma_f32_16x16x32_bf16(af[ks][i], bfr[ks][j], acc.v[i][j], 0, 0, 0);
    __builtin_amdgcn_s_setprio(0);
  }
  __syncthreads();
}

DEV void p1_filter_tile(const Params& p, int tile, u16* sA, u16* sB) {
  const int mt = tile >> 3, nt = tile & 7;
  const int m0 = mt * 128, n0 = nt * 128;
  Acc acc; acc_zero(acc);
  gemm_kloop((const u16*)(p.ws + OFF_H2F), 64, (const u16*)(p.ws + OFF_H2F + 512 * 1024), 64, 64, m0, n0, sA, sB, acc);
  asm volatile("" ::: "memory");
  const int tid = threadIdx.x, lane = tid & 63, wave = tid >> 6, wm = wave >> 1, wn = wave & 1;
  const int l15 = lane & 15, quad = lane >> 4;
  const int mb = m0 + wm * 64, nbase = n0 + wn * 64;
  u16* G = (u16*)((char*)p.out + OO_G);
  float* nsum = (float*)(p.ws + OFF_BAR + 20480);
  const float da = logf(1e-2f) / 1.5f, db = logf(1e-2f) / 0.3f;
  const bool bwd = nbase >= 512;
#pragma unroll
  for (int i = 0; i < 4; ++i)
#pragma unroll
    for (int r = 0; r < 4; ++r) {
      const int col = nbase + i * 16 + quad * 4 + r;
      const int c = col & 511;
      const float fbv = p.hy_fb3[col];
      const float dlc = fabsf(da + (db - da) * (float)c / 511.f);
      u16* Gc = G + (size_t)c * 8192;
      float sum = 0.f;
#pragma unroll
      for (int j = 0; j < 4; ++j) {
        const int t = mb + j * 16 + l15;
        const float val = (acc.v[i][j][r] + fbv) * __expf(-(float)t * (1.f / 4096.f) * dlc);
        if (!bwd) { Gc[4095 - t] = f2bf(val); sum += fabsf(val); }
        else if (t < 4095) { Gc[4096 + t] = f2bf(val); sum += fabsf(val); }
        else Gc[8191] = 0;
      }
      sum = DPP_ADD(sum, 0xB1);
      sum = DPP_ADD(sum, 0x4E);
      sum = DPP_ADD(sum, 0x141);
      sum = DPP_ADD(sum, 0x140);
      if (l15 == 0) atomicAdd(nsum + c, sum);
    }
}

DEV void p2_inproj(const Params& p, int tile, u16* sA, u16* sB) {
  const int mt = tile / 34, nt = tile % 34;
  const int m0 = mt * 128, n0 = nt * 128;
  Acc acc; acc_zero(acc);
  gemm_kloop((const u16*)((const char*)p.out + OO_H1), 1024, (const u16*)(p.ws + OFF_WIN), 1024, 1024, m0, n0, sA, sB, acc);
  asm volatile("" ::: "memory");
  const int tid = threadIdx.x, lane = tid & 63, wave = tid >> 6, wm = wave >> 1, wn = wave & 1;
  int l15 = lane & 15, quad = lane >> 4;
  int mb = m0 + wm * 64, nb = n0 + wn * 64;
  asm volatile("" : "+v"(l15), "+v"(quad), "+v"(mb), "+v"(nb));
  mb = __builtin_amdgcn_readfirstlane(mb); nb = __builtin_amdgcn_readfirstlane(nb);
  if (nb < 640) {
    const float2* rope = (const float2*)(p.ws + OFF_ROPE);
    const bool isq = nb < 512;
    const float qs = isq ? 0.125f : 1.f;
#pragma unroll
    for (int j = 0; j < 4; ++j) {
      const int m = mb + j * 16 + l15;
      const int b = m >> 12, l = m & 4095;
      const int prow = l >> 6, pcol = l & 63;
      u16* dst;
      if (isq) dst = (u16*)(p.ws + OFF_Q) + ((size_t)(b * 8 + (nb >> 6)) * 4096 + l) * 64;
      else dst = (u16*)(p.ws + OFF_K) + ((size_t)(b * 2 + ((nb - 512) >> 6)) * 4096 + l) * 64;
#pragma unroll
      for (int hh = 0; hh < 2; ++hh) {
        const int pos = hh ? pcol : prow;
        f32x4 x1 = acc.v[hh * 2][j], x2 = acc.v[hh * 2 + 1][j];
        float o1[4], o2[4];
#pragma unroll
        for (int r = 0; r < 4; ++r) {
          float2 cs = rope[pos * 16 + quad * 4 + r];
          o1[r] = (x1[r] * cs.x - x2[r] * cs.y) * qs;
          o2[r] = (x2[r] * cs.x + x1[r] * cs.y) * qs;
        }
        *(uint2*)(dst + hh * 32 + quad * 4) = make_uint2(pack2(o1[0], o1[1]), pack2(o1[2], o1[3]));
        *(uint2*)(dst + hh * 32 + 16 + quad * 4) = make_uint2(pack2(o2[0], o2[1]), pack2(o2[2], o2[3]));
      }
    }
  } else if (nb < 768) {
    const int g = (nb - 640) >> 6;
    u16* vt = (u16*)(p.ws + OFF_VT);
#pragma unroll
    for (int j = 0; j < 4; ++j) {
      const int m = mb + j * 16 + l15;
      const int b = m >> 12, l = m & 4095;
#pragma unroll
      for (int i = 0; i < 4; ++i)
#pragma unroll
        for (int r = 0; r < 4; ++r) {
          const int d = i * 16 + quad * 4 + r;
          vt[((size_t)(b * 2 + g) * 64 + d) * 4096 + l] = f2bf(acc.v[i][j][r]);
        }
    }
  } else if (nb < 2304) {
    u16* z = (u16*)(p.ws + OFF_Z);
#pragma unroll
    for (int j = 0; j < 4; ++j) {
      const int m = mb + j * 16 + l15;
#pragma unroll
      for (int i = 0; i < 4; ++i) {
        const int n = nb - 768 + i * 16 + quad * 4;
        f32x4 a = acc.v[i][j];
        *(uint2*)(z + (size_t)m * 1536 + n) = make_uint2(pack2(a[0], a[1]), pack2(a[2], a[3]));
      }
    }
  } else {
    u16* gt = (u16*)(p.ws + OFF_GATE);
#pragma unroll
    for (int j = 0; j < 4; ++j) {
      const int m = mb + j * 16 + l15;
#pragma unroll
      for (int i = 0; i < 4; ++i) {
        const int n = nb - 2304 + i * 16 + quad * 4;
        f32x4 a = acc.v[i][j];
        float s0 = __builtin_amdgcn_rcpf(1.f + __expf(-a[0])), s1 = __builtin_amdgcn_rcpf(1.f + __expf(-a[1]));
        float s2 = __builtin_amdgcn_rcpf(1.f + __expf(-a[2])), s3 = __builtin_amdgcn_rcpf(1.f + __expf(-a[3]));
        *(uint2*)(gt + (size_t)m * 2048 + n) = make_uint2(pack2(s0, s1), pack2(s2, s3));
      }
    }
  }
}

DEV void p2_ctxkv(const Params& p, int tile, u16* sA, u16* sB) {
  const int mt = tile >> 1, nt = tile & 1;
  const int m0 = mt * 128, n0 = nt * 128;
  Acc acc; acc_zero(acc);
  gemm_kloop((const u16*)((const char*)p.out + OO_HC), 1024, (const u16*)(p.ws + OFF_WIN) + (size_t)512 * 1024, 1024, 1024, m0, n0, sA, sB, acc);
  const int tid = threadIdx.x, lane = tid & 63, wave = tid >> 6, wm = wave >> 1, wn = wave & 1;
  const int l15 = lane & 15, quad = lane >> 4;
  const int mb = m0 + wm * 64, nb = n0 + wn * 64;
  const int g = (nb >> 6) & 1;
  if (nb < 128) {
    u16* kc = (u16*)(p.ws + OFF_KC);
#pragma unroll
    for (int j = 0; j < 4; ++j) {
      const int m = mb + j * 16 + l15;
      const int b = m >> 8, c = m & 255;
#pragma unroll
      for (int i = 0; i < 4; ++i) {
        f32x4 a = acc.v[i][j];
        *(uint2*)(kc + ((size_t)(b * 2 + g) * 256 + c) * 64 + i * 16 + quad * 4) = make_uint2(pack2(a[0], a[1]), pack2(a[2], a[3]));
      }
    }
  } else {
    u16* vct = (u16*)(p.ws + OFF_VCT);
#pragma unroll
    for (int j = 0; j < 4; ++j) {
      const int m = mb + j * 16 + l15;
      const int b = m >> 8, c = m & 255;
#pragma unroll
      for (int i = 0; i < 4; ++i)
#pragma unroll
        for (int r = 0; r < 4; ++r) {
          const int d = i * 16 + quad * 4 + r;
          vct[((size_t)(b * 2 + g) * 64 + d) * 256 + c] = f2bf(acc.v[i][j][r]);
        }
    }
  }
}

DEV void p3_attn(const Params& p, int item, u16* sK, u16* sVt) {
  const int tid = threadIdx.x, lane = tid & 63, wave = tid >> 6, l15 = lane & 15, quad = lane >> 4;
  const int n = item & 31, h = (item >> 5) & 7, b = item >> 8;
  const int g = h >> 2;
  const u16* Q = (const u16*)(p.ws + OFF_Q) + ((size_t)(b * 8 + h) * 4096 + n * 128 + wave * 32) * 64;
  bf16x8 bq[2][2];
#pragma unroll
  for (int qt = 0; qt < 2; ++qt)
#pragma unroll
    for (int ks = 0; ks < 2; ++ks) bq[qt][ks] = *(const bf16x8*)(Q + (qt * 16 + l15) * 64 + ks * 32 + quad * 8);
  const float sink = p.attn_sink[h];
  float mrun[2] = {sink, sink};
  float lrun[2];
  lrun[0] = lrun[1] = (quad == 0) ? 1.f : 0.f;
  f32x4 O[4][2];
#pragma unroll
  for (int dt = 0; dt < 4; ++dt)
#pragma unroll
    for (int qt = 0; qt < 2; ++qt) O[dt][qt] = (f32x4){0.f, 0.f, 0.f, 0.f};

  u32x4 pk[4], pv[4];
#define ATT_LOAD(KB)                                                                                  \
  {                                                                                                   \
    const u16* Ksrc; const u16* Vsrc; int vstride;                                                    \
    if ((KB) < 3) {                                                                                   \
      const int nbk = n + (KB) - 1;                                                                   \
      Ksrc = (const u16*)(p.ws + OFF_K) + ((size_t)(b * 2 + g) * 4096 + nbk * 128) * 64;              \
      Vsrc = (const u16*)(p.ws + OFF_VT) + (size_t)(b * 2 + g) * 64 * 4096 + nbk * 128;               \
      vstride = 4096;                                                                                 \
    } else {                                                                                          \
      const int cb = (KB) - 3;                                                                        \
      Ksrc = (const u16*)(p.ws + OFF_KC) + ((size_t)(b * 2 + g) * 256 + cb * 128) * 64;               \
      Vsrc = (const u16*)(p.ws + OFF_VCT) + (size_t)(b * 2 + g) * 64 * 256 + cb * 128;                \
      vstride = 256;                                                                                  \
    }                                                                                                 \
    _Pragma("unroll") for (int i = 0; i < 4; ++i) {                                                   \
      const int id = tid + i * 256;                                                                   \
      pk[i] = *(const u32x4*)(Ksrc + (id >> 3) * 64 + (id & 7) * 8);                                  \
      pv[i] = *(const u32x4*)(Vsrc + (size_t)(id >> 4) * vstride + (id & 15) * 8);                    \
    }                                                                                                 \
  }
  int kb = (n == 0) ? 1 : 0;
  ATT_LOAD(kb)
  while (kb < 5) {
#pragma unroll
    for (int i = 0; i < 4; ++i) {
      const int id = tid + i * 256;
      *(u32x4*)(sK + (id >> 3) * 72 + (id & 7) * 8) = pk[i];
      *(u32x4*)(sVt + (id >> 4) * 136 + (id & 15) * 8) = pv[i];
    }
    __syncthreads();
    int nx = kb + 1;
    if (nx == 2 && n == 31) nx = 3;
    if (nx < 5) ATT_LOAD(nx)
#pragma unroll 1
    for (int c4 = 0; c4 < 4; ++c4) {
      f32x4 s[2][2];
#pragma unroll
      for (int kt = 0; kt < 2; ++kt) {
        bf16x8 ak0 = *(const bf16x8*)(sK + (c4 * 32 + kt * 16 + l15) * 72 + quad * 8);
        bf16x8 ak1 = *(const bf16x8*)(sK + (c4 * 32 + kt * 16 + l15) * 72 + 32 + quad * 8);
#pragma unroll
        for (int qt = 0; qt < 2; ++qt) {
          f32x4 z = (f32x4){0.f, 0.f, 0.f, 0.f};
          z = __builtin_amdgcn_mfma_f32_16x16x32_bf16(ak0, bq[qt][0], z, 0, 0, 0);
          z = __builtin_amdgcn_mfma_f32_16x16x32_bf16(ak1, bq[qt][1], z, 0, 0, 0);
          s[kt][qt] = z;
        }
      }
      if (kb == 0 || kb == 2) {
#pragma unroll
        for (int kt = 0; kt < 2; ++kt)
#pragma unroll
          for (int qt = 0; qt < 2; ++qt)
#pragma unroll
            for (int r = 0; r < 4; ++r) {
              const int kk = c4 * 32 + kt * 16 + quad * 4 + r;
              const int qq = wave * 32 + qt * 16 + l15;
              const bool valid = (kb == 0) ? (kk >= qq) : (kk <= qq);
              if (!valid) s[kt][qt][r] = -INFINITY;
            }
      }
      bf16x8 bp[2];
#pragma unroll
      for (int qt = 0; qt < 2; ++qt) {
        float cm = fmaxf(fmaxf(fmaxf(s[0][qt][0], s[0][qt][1]), fmaxf(s[0][qt][2], s[0][qt][3])),
                         fmaxf(fmaxf(s[1][qt][0], s[1][qt][1]), fmaxf(s[1][qt][2], s[1][qt][3])));
        cm = fmaxf(cm, __shfl_xor(cm, 16));
        cm = fmaxf(cm, __shfl_xor(cm, 32));
        const float mnew = fmaxf(mrun[qt], cm);
        const float alpha = __expf(mrun[qt] - mnew);
        mrun[qt] = mnew;
        float ps = 0.f;
        float pv[8];
#pragma unroll
        for (int r = 0; r < 4; ++r) {
          pv[r] = __expf(s[0][qt][r] - mnew);
          pv[4 + r] = __expf(s[1][qt][r] - mnew);
          ps += pv[r] + pv[4 + r];
        }
        lrun[qt] = lrun[qt] * alpha + ps;
#pragma unroll
        for (int dt = 0; dt < 4; ++dt) {
          O[dt][qt][0] *= alpha; O[dt][qt][1] *= alpha; O[dt][qt][2] *= alpha; O[dt][qt][3] *= alpha;
        }
        union { bf16x8 v; unsigned u[4]; } pk;
        pk.u[0] = pack2(pv[0], pv[1]); pk.u[1] = pack2(pv[2], pv[3]);
        pk.u[2] = pack2(pv[4], pv[5]); pk.u[3] = pack2(pv[6], pv[7]);
        bp[qt] = pk.v;
      }
#pragma unroll
      for (int dt = 0; dt < 4; ++dt) {
        union { bf16x8 v; uint2 h[2]; } av;
        const u16* vrow = sVt + (dt * 16 + l15) * 136 + c4 * 32 + quad * 4;
        av.h[0] = *(const uint2*)(vrow);
        av.h[1] = *(const uint2*)(vrow + 16);
#pragma unroll
        for (int qt = 0; qt < 2; ++qt) O[dt][qt] = __builtin_amdgcn_mfma_f32_16x16x32_bf16(av.v, bp[qt], O[dt][qt], 0, 0, 0);
      }
    }
    __syncthreads();
    kb = nx;
  }
  u16* Y = (u16*)(p.ws + OFF_YATT);
#pragma unroll
  for (int qt = 0; qt < 2; ++qt) {
    float l = lrun[qt];
    l += __shfl_xor(l, 16);
    l += __shfl_xor(l, 32);
    const float inv = __builtin_amdgcn_rcpf(l);
    const int t = b * 4096 + n * 128 + wave * 32 + qt * 16 + l15;
#pragma unroll
    for (int dt = 0; dt < 4; ++dt) {
      f32x4 o = O[dt][qt];
      *(uint2*)(Y + (size_t)t * 512 + h * 64 + dt * 16 + quad * 4) = make_uint2(pack2(o[0] * inv, o[1] * inv), pack2(o[2] * inv, o[3] * inv));
    }
  }
}

DEV void p3_hypre(const Params& p, int item, u16* sm) {
  const int tid = threadIdx.x;
  const int cb = item & 3, tb = (item >> 2) & 63, b = item >> 8;
  const int tq = tid >> 6, ch2 = tid & 63;
  const int c = cb * 128 + ch2 * 2;
  u16* su = sm;
  u16* sx = sm + 128 * 66;
  float w[3][3][2], bias[3][2];
#pragma unroll
  for (int s = 0; s < 3; ++s) {
#pragma unroll
    for (int k = 0; k < 3; ++k) {
      const float2 wv = *(const float2*)(p.hy_conv_w + k * 1536 + s * 512 + c);
      w[s][k][0] = wv.x; w[s][k][1] = wv.y;
    }
    const float2 bv = *(const float2*)(p.hy_conv_b + s * 512 + c);
    bias[s][0] = bv.x; bias[s][1] = bv.y;
  }
  const u16* Z = (const u16*)(p.ws + OFF_Z) + (size_t)b * 4096 * 1536;
  const int l0 = tb * 64 + tq * 16;
  unsigned zr[18][3];
#pragma unroll
  for (int i = 0; i < 18; ++i) {
    const int l = l0 - 1 + i;
    const bool ok = (l >= 0) && (l < 4096);
    const int lc = ok ? l : l0;
#pragma unroll
    for (int s2 = 0; s2 < 3; ++s2) {
      const unsigned v = *(const unsigned*)(Z + (size_t)lc * 1536 + s2 * 512 + c);
      zr[i][s2] = ok ? v : 0u;
    }
  }
#pragma unroll
  for (int i = 0; i < 16; ++i) {
    float cv0[3], cv1[3];
#pragma unroll
    for (int s2 = 0; s2 < 3; ++s2) {
      cv0[s2] = bflo(zr[i][s2]) * w[s2][0][0] + bflo(zr[i + 1][s2]) * w[s2][1][0] + bflo(zr[i + 2][s2]) * w[s2][2][0] + bias[s2][0];
      cv1[s2] = bfhi(zr[i][s2]) * w[s2][0][1] + bfhi(zr[i + 1][s2]) * w[s2][1][1] + bfhi(zr[i + 2][s2]) * w[s2][2][1] + bias[s2][1];
    }
    su[(ch2 * 2) * 66 + tq * 16 + i] = f2bf(cv0[2] * cv0[1]);
    su[(ch2 * 2 + 1) * 66 + tq * 16 + i] = f2bf(cv1[2] * cv1[1]);
    sx[(ch2 * 2) * 66 + tq * 16 + i] = f2bf(cv0[0]);
    sx[(ch2 * 2 + 1) * 66 + tq * 16 + i] = f2bf(cv1[0]);
  }
  __syncthreads();
  const int chr = tid >> 1, part = tid & 1;
  const int cc = cb * 128 + chr;
  const unsigned* ru = (const unsigned*)(su + chr * 66 + part * 32);
  const unsigned* rx = (const unsigned*)(sx + chr * 66 + part * 32);
  u16* UT = (u16*)((char*)p.out + OO_UT) + ((size_t)(cc * 4 + b) * 4096 + tb * 64 + part * 32);
  u16* XT = (u16*)((char*)p.out + OO_X0T) + ((size_t)(cc * 4 + b) * 4096 + tb * 64 + part * 32);
#pragma unroll
  for (int q = 0; q < 4; ++q) {
    ((uint4*)UT)[q] = make_uint4(ru[4 * q], ru[4 * q + 1], ru[4 * q + 2], ru[4 * q + 3]);
    ((uint4*)XT)[q] = make_uint4(rx[4 * q], rx[4 * q + 1], rx[4 * q + 2], rx[4 * q + 3]);
  }
  __syncthreads();
}

DEV void p3_toeplitz(const Params& p, int c, char* smem) {
  const int tid = threadIdx.x, lane = tid & 63, wave = tid >> 6, l15 = lane & 15, quad = lane >> 4;
  u16* sG0 = (u16*)smem;
  u16* sG1 = (u16*)(smem + 16384 + 64);
  u16* sU = (u16*)(smem + 32768 + 128);
  u16* sZ = sU + 4 * 64 * 72;
  const u16* G = (const u16*)((const char*)p.out + OO_G) + (size_t)c * 8192;
  const u16* UT = (const u16*)((const char*)p.out + OO_UT) + (size_t)c * 16384;
#pragma unroll
  for (int i = 0; i < 4; ++i) {
    const int id = tid + i * 256;
    *(uint4*)(sG0 + id * 8) = *(const uint4*)(G + id * 8);
  }
#pragma unroll
  for (int i = 0; i < 8; ++i) {
    const int id = tid + i * 256;
    const int bb = id >> 9, blk = (id >> 3) & 63, c8 = id & 7;
    *(uint4*)(sU + (bb * 64 + blk) * 72 + c8 * 8) = *(const uint4*)(UT + id * 8);
  }
  if (tid < 72) sZ[tid] = 0;
  __syncthreads();
  for (int i = tid; i < 8192; i += 256) sG1[i] = (i < 8191) ? sG0[i + 1] : (u16)0;
  __syncthreads();

  Acc acc; acc_zero(acc);
  const u16* gbase = (l15 & 1) ? sG0 : (sG1 - 1);
  const u16* ubase = sU + wave * 64 * 72 + quad * 8;
  const u16* zbase = sZ + quad * 8;
#define TOEP_LOADA(AF, D)                                                                 \
  {                                                                                       \
    const int base_ = 4095 - 64 * (D) - l15 + quad * 8;                                   \
    _Pragma("unroll") for (int mt = 0; mt < 4; ++mt)                                      \
      _Pragma("unroll") for (int ks = 0; ks < 2; ++ks) {                                  \
        const unsigned* gp = (const unsigned*)(gbase + base_ - mt * 16 + ks * 32);        \
        union { bf16x8 v; unsigned u[4]; } t_;                                            \
        t_.u[0] = gp[0]; t_.u[1] = gp[1]; t_.u[2] = gp[2]; t_.u[3] = gp[3];               \
        AF[mt][ks] = t_.v;                                                                \
      }                                                                                   \
  }
#define TOEP_MMA(AF, D)                                                                   \
  _Pragma("unroll") for (int nt = 0; nt < 4; ++nt) {                                      \
    if (!(nt * 16 + 15 - (D) < 0 || nt * 16 - (D) > 63)) {                                \
      const int ip = nt * 16 + l15 - (D);                                                 \
      const u16* up = (ip >= 0 && ip < 64) ? (ubase + ip * 72) : zbase;                   \
      bf16x8 b0 = *(const bf16x8*)(up);                                                   \
      bf16x8 b1 = *(const bf16x8*)(up + 32);                                              \
      _Pragma("unroll") for (int mt = 0; mt < 4; ++mt) {                                  \
        acc.v[mt][nt] = __builtin_amdgcn_mfma_f32_16x16x32_bf16(AF[mt][0], b0, acc.v[mt][nt], 0, 0, 0); \
        acc.v[mt][nt] = __builtin_amdgcn_mfma_f32_16x16x32_bf16(AF[mt][1], b1, acc.v[mt][nt], 0, 0, 0); \
      }                                                                                   \
    }                                                                                     \
  }
  {
    bf16x8 afA[4][2], afB[4][2];
    TOEP_LOADA(afA, -63)
#pragma unroll 1
    for (int d = -63; d <= 63; d += 2) {
      if (d + 1 <= 63) TOEP_LOADA(afB, d + 1)
      TOEP_MMA(afA, d)
      if (d + 1 <= 63) {
        if (d + 2 <= 63) TOEP_LOADA(afA, d + 2)
        TOEP_MMA(afB, d + 1)
      }
    }
  }
  const float ninv = 1.f / ((const float*)(p.ws + OFF_BAR + 20480))[c];
  const float skip = p.hy_skip[c];
  const u16* XT = (const u16*)((const char*)p.out + OO_X0T) + ((size_t)(c * 4 + wave) * 4096);
  u16* Y = (u16*)(p.ws + OFF_YHY);
#pragma unroll
  for (int nt = 0; nt < 4; ++nt) {
    const int ib = nt * 16 + l15;
#pragma unroll
    for (int mt = 0; mt < 4; ++mt) {
      const int r0 = mt * 16 + quad * 4;
      const int t = ib * 64 + r0;
      uint2 uu = *(const uint2*)(sU + (wave * 64 + ib) * 72 + r0);
      uint2 xx = *(const uint2*)(XT + t);
      float uv[4] = {bflo(uu.x), bfhi(uu.x), bflo(uu.y), bfhi(uu.y)};
      float xv[4] = {bflo(xx.x), bfhi(xx.x), bflo(xx.y), bfhi(xx.y)};
#pragma unroll
      for (int r = 0; r < 4; ++r) {
        float y = acc.v[mt][nt][r] * ninv + uv[r] * skip;
        Y[(size_t)(wave * 4096 + t + r) * 512 + c] = f2bf(y * xv[r]);
      }
    }
  }
  __syncthreads();
}

DEV void p4_merge(const Params& p, int tile, u16* sA, u16* sB) {
  const int mt = tile >> 3, nt = tile & 7;
  const int m0 = mt * 128, n0 = nt * 128;
  const int tid = threadIdx.x, lane = tid & 63, wave = tid >> 6, wm = wave >> 1, wn = wave & 1;
  const int l15 = lane & 15, quad = lane >> 4;
  const int mb = m0 + wm * 64, nb = n0 + wn * 64;
  const u16* gt = (const u16*)(p.ws + OFF_GATE);
  u16* mg = (u16*)(p.ws + OFF_MERGED);
  Acc a1; acc_zero(a1);
  gemm_kloop((const u16*)(p.ws + OFF_YATT), 512, (const u16*)(p.ws + OFF_WOA), 512, 512, m0, n0, sA, sB, a1);
  asm volatile("" ::: "memory");
#pragma unroll
  for (int j = 0; j < 4; ++j) {
    const int m = mb + j * 16 + l15;
#pragma unroll
    for (int i = 0; i < 4; ++i) {
      const int n = nb + i * 16 + quad * 4;
      uint2 ga = *(const uint2*)(gt + (size_t)m * 2048 + n);
      f32x4 x = a1.v[i][j];
      *(uint2*)(mg + (size_t)m * 1024 + n) = make_uint2(pack2(bflo(ga.x) * x[0], bfhi(ga.x) * x[1]), pack2(bflo(ga.y) * x[2], bfhi(ga.y) * x[3]));
    }
  }
  asm volatile("" ::: "memory");
  acc_zero(a1);
  gemm_kloop((const u16*)(p.ws + OFF_YHY), 512, (const u16*)(p.ws + OFF_WOH), 512, 512, m0, n0, sA, sB, a1);
  asm volatile("" ::: "memory");
#pragma unroll
  for (int j = 0; j < 4; ++j) {
    const int m = mb + j * 16 + l15;
#pragma unroll
    for (int i = 0; i < 4; ++i) {
      const int n = nb + i * 16 + quad * 4;
      uint2 gh = *(const uint2*)(gt + (size_t)m * 2048 + 1024 + n);
      uint2 pv = *(const uint2*)(mg + (size_t)m * 1024 + n);
      f32x4 y = a1.v[i][j];
      float o0 = bflo(pv.x) + bflo(gh.x) * y[0];
      float o1 = bfhi(pv.x) + bfhi(gh.x) * y[1];
      float o2 = bflo(pv.y) + bflo(gh.y) * y[2];
      float o3 = bfhi(pv.y) + bfhi(gh.y) * y[3];
      *(uint2*)(mg + (size_t)m * 1024 + n) = make_uint2(pack2(o0, o1), pack2(o2, o3));
    }
  }
}

DEV void p5_out(const Params& p, int tile, u16* sA, u16* sB) {
  const int mt = tile >> 3, nt = tile & 7;
  const int m0 = mt * 128, n0 = nt * 128;
  Acc acc; acc_zero(acc);
  gemm_kloop((const u16*)(p.ws + OFF_MERGED), 1024, (const u16*)(p.ws + OFF_WOUT), 1024, 1024, m0, n0, sA, sB, acc);
  const int tid = threadIdx.x, lane = tid & 63, wave = tid >> 6, wm = wave >> 1, wn = wave & 1;
  const int l15 = lane & 15, quad = lane >> 4;
  const int mb = m0 + wm * 64, nb = n0 + wn * 64;
  const float* mod = (const float*)(p.ws + OFF_MOD);
#pragma unroll
  for (int j = 0; j < 4; ++j) {
    const int m = mb + j * 16 + l15;
    const int b = m >> 12;
#pragma unroll
    for (int i = 0; i < 4; ++i) {
      const int n = nb + i * 16 + quad * 4;
      float4 g1 = *(const float4*)(mod + b * 6144 + 2048 + n);
      float4 xv = *(const float4*)(p.x + (size_t)m * 1024 + n);
      f32x4 a = acc.v[i][j];
      float4 o = make_float4(xv.x + g1.x * a[0], xv.y + g1.y * a[1], xv.z + g1.z * a[2], xv.w + g1.w * a[3]);
      *(float4*)(p.out + (size_t)m * 1024 + n) = o;
    }
  }
}

DEV void p7_qp(const Params& p, int tile, u16* sA, u16* sB) {
  const int mt = tile >> 3, nt = tile & 7;
  const int m0 = mt * 128, n0 = nt * 128;
  Acc acc; acc_zero(acc);
  gemm_kloop((const u16*)(p.ws + OFF_H2), 1024, (const u16*)(p.ws + OFF_WQ), 1024, 1024, m0, n0, sA, sB, acc);
  const int tid = threadIdx.x, lane = tid & 63, wave = tid >> 6, wm = wave >> 1, wn = wave & 1;
  const int l15 = lane & 15, quad = lane >> 4;
  const int mb = m0 + wm * 64, nb = n0 + wn * 64;
  u16* qp = (u16*)(p.ws + OFF_QP);
#pragma unroll
  for (int j = 0; j < 4; ++j) {
    const int m = mb + j * 16 + l15;
#pragma unroll
    for (int i = 0; i < 4; ++i) {
      const int n = nb + i * 16 + quad * 4;
      f32x4 a = acc.v[i][j];
      *(uint2*)(qp + (size_t)m * 1024 + n) = make_uint2(pack2(a[0], a[1]), pack2(a[2], a[3]));
    }
  }
}

DEV unsigned f2ord(float f) {
  const unsigned u = __float_as_uint(f);
  return u ^ (((int)u >> 31) | 0x80000000u);
}
DEV float ord2f(unsigned k) {
  const unsigned m = (k & 0x80000000u) ? 0x80000000u : 0xffffffffu;
  return __uint_as_float(k ^ m);
}
DEV unsigned umax_(unsigned a, unsigned b) { return a > b ? a : b; }
DEV unsigned umin_(unsigned a, unsigned b) { return a < b ? a : b; }

DEV void sort16_desc(unsigned (&v)[16]) {
#pragma unroll
  for (int k = 2; k <= 16; k <<= 1)
#pragma unroll
    for (int j = k >> 1; j > 0; j >>= 1)
#pragma unroll
      for (int i = 0; i < 16; ++i) {
        const int l = i ^ j;
        if (l > i) {
          const bool desc = ((i & k) == 0);
          const unsigned a = v[i], b = v[l];
          const unsigned hi = umax_(a, b), lo = umin_(a, b);
          v[i] = desc ? hi : lo;
          v[l] = desc ? lo : hi;
        }
      }
}
DEV void merge16_desc(unsigned (&v)[16]) {
#pragma unroll
  for (int j = 8; j > 0; j >>= 1)
#pragma unroll
    for (int i = 0; i < 16; ++i) {
      const int l = i ^ j;
      if (l > i) {
        const unsigned a = v[i], b = v[l];
        v[i] = umax_(a, b);
        v[l] = umin_(a, b);
      }
    }
}
DEV void xmerge16(unsigned (&v)[16], int off) {
  unsigned pr[16];
#pragma unroll
  for (int i = 0; i < 16; ++i) pr[i] = (unsigned)__shfl_xor((int)v[i], off);
#pragma unroll
  for (int i = 0; i < 16; ++i) v[i] = umax_(v[i], pr[15 - i]);
  merge16_desc(v);
}

DEV void route_top16_of_128(const u16* __restrict__ keys, const u16* __restrict__ qp, int l15, int quad, unsigned (&out)[16]) {
  bf16x8 b0 = *(const bf16x8*)(qp);
  bf16x8 b1 = *(const bf16x8*)(qp + 32);
  unsigned ka[16], kb[16];
#pragma unroll
  for (int kt = 0; kt < 8; ++kt) {
    bf16x8 a0 = *(const bf16x8*)(keys + (kt * 16 + l15) * 64 + quad * 8);
    bf16x8 a1 = *(const bf16x8*)(keys + (kt * 16 + l15) * 64 + 32 + quad * 8);
    f32x4 z = (f32x4){0.f, 0.f, 0.f, 0.f};
    z = __builtin_amdgcn_mfma_f32_16x16x32_bf16(a0, b0, z, 0, 0, 0);
    z = __builtin_amdgcn_mfma_f32_16x16x32_bf16(a1, b1, z, 0, 0, 0);
#pragma unroll
    for (int r = 0; r < 4; ++r) {
      const unsigned key = (f2ord(z[r]) & ~127u) | (unsigned)(kt * 16 + quad * 4 + r);
      if (kt < 4) ka[kt * 4 + r] = key; else kb[(kt - 4) * 4 + r] = key;
    }
  }
  sort16_desc(ka);
  sort16_desc(kb);
#pragma unroll
  for (int i = 0; i < 16; ++i) out[i] = umax_(ka[i], kb[15 - i]);
  merge16_desc(out);
  xmerge16(out, 16);
  xmerge16(out, 32);
}

DEV void p8_route(const Params& p, int task, char* wsm) {
  static constexpr unsigned char kTab[52] = {
      0x00, 0x01, 0x02, 0x03, 0x04, 0x05, 0x06, 0x07, 0x08, 0x09, 0x0A, 0x0B, 0x0C, 0x0D, 0x0E, 0x0F,
      0x10, 0x11, 0x12, 0x13, 0x14, 0x15, 0x16, 0x17, 0x20, 0x21, 0x22, 0x23, 0x24, 0x30, 0x31, 0x32, 0x33,
      0x40, 0x41, 0x42, 0x50, 0x51, 0x60, 0x61, 0x70, 0x71, 0x80, 0x90, 0xA0, 0xB0, 0xC0, 0xD0, 0xE0, 0xF0, 0x00, 0x00};
  const int lane = threadIdx.x & 63, l15 = lane & 15, quad = lane >> 4;
  const int h = task & 7, tt = task >> 3;
  const int t0 = tt * 16;
  float* s1v = (float*)wsm;
  float* s2v = s1v + 256;
  int* i1 = (int*)(s2v + 256);
  int* i2 = i1 + 256;
  const u16* keys = (const u16*)(p.ws + OFF_KEYS) + (size_t)(h * 2) * 128 * 64;
  const u16* qp = (const u16*)(p.ws + OFF_QP) + (size_t)(t0 + l15) * 1024 + h * 128 + quad * 8;
  unsigned l1[16], l2[16];
  route_top16_of_128(keys, qp, l15, quad, l1);
  route_top16_of_128(keys + 128 * 64, qp + 64, l15, quad, l2);
  if (quad == 0) {
#pragma unroll
    for (int i = 0; i < 16; ++i) { s1v[l15 * 16 + i] = ord2f(l1[i] & ~127u); i1[l15 * 16 + i] = (int)(l1[i] & 127u); }
  } else if (quad == 1) {
#pragma unroll
    for (int i = 0; i < 16; ++i) { s2v[l15 * 16 + i] = ord2f(l2[i] & ~127u); i2[l15 * 16 + i] = (int)(l2[i] & 127u); }
  }
  __builtin_amdgcn_fence(__ATOMIC_RELEASE, "wavefront");
  __builtin_amdgcn_wave_barrier();
  __builtin_amdgcn_fence(__ATOMIC_ACQUIRE, "wavefront");
  unsigned ck[16];
#pragma unroll
  for (int s = 0; s < 16; ++s) {
    const int c = quad + 4 * s;
    unsigned key = 0u;
    if (s < 13 && c < 50) {
      const unsigned ab = kTab[c];
      const float val = s1v[l15 * 16 + (ab >> 4)] + s2v[l15 * 16 + (ab & 15)];
      key = (f2ord(val) & ~255u) | ab;
    }
    ck[s] = key;
  }
  sort16_desc(ck);
  xmerge16(ck, 16);
  xmerge16(ck, 32);
  if (quad == 0) {
    float e[16];
    const float vmax = ord2f(ck[0] & ~255u);
    float ssum = 0.f;
#pragma unroll
    for (int i = 0; i < 16; ++i) { e[i] = __expf(ord2f(ck[i] & ~255u) - vmax); ssum += e[i]; }
    const float inv = __builtin_amdgcn_rcpf(ssum);
    int* ridx = (int*)(p.ws + OFF_RIDX) + (size_t)(t0 + l15) * 128 + h * 16;
    float* rw = (float*)(p.ws + OFF_RW) + (size_t)(t0 + l15) * 128 + h * 16;
#pragma unroll
    for (int i = 0; i < 16; i += 4) {
      int ee[4]; float ww[4];
#pragma unroll
      for (int j = 0; j < 4; ++j) {
        const unsigned ab = ck[i + j] & 255u;
        ee[j] = i1[l15 * 16 + (ab >> 4)] * 128 + i2[l15 * 16 + (ab & 15)];
        ww[j] = e[i + j] * inv;
      }
      *(int4*)(ridx + i) = make_int4(ee[0], ee[1], ee[2], ee[3]);
      *(float4*)(rw + i) = make_float4(ww[0], ww[1], ww[2], ww[3]);
    }
  }
  __builtin_amdgcn_fence(__ATOMIC_RELEASE, "wavefront");
  __builtin_amdgcn_wave_barrier();
}

DEV float gelu_tanh(float x) {
  const float u2 = 1.5957691216057308f * (x + 0.044715f * x * x * x);
  return x * __frcp_rn(1.f + __expf(-u2));
}

DEV void unpack8(const uint4& q, float* f) {
  f[0] = bflo(q.x); f[1] = bfhi(q.x); f[2] = bflo(q.y); f[3] = bfhi(q.y);
  f[4] = bflo(q.z); f[5] = bfhi(q.z); f[6] = bflo(q.w); f[7] = bfhi(q.w);
}

DEV float dpp_add(float v, const int ctrl_sel) {
  return v;
}
typedef __attribute__((ext_vector_type(2))) __bf16 bf2_t;
DEV float dot2bf(unsigned a, unsigned b, float c) {
  return __builtin_amdgcn_fdot2_f32_bf16(__builtin_bit_cast(bf2_t, a), __builtin_bit_cast(bf2_t, b), c, false);
}

DEV float reduce4_rows(float d0, float d1, float d2, float d3, int lane) {
  const bool up32 = (lane & 32) != 0, up16 = (lane & 16) != 0;
  float k0 = up32 ? d2 : d0, k1 = up32 ? d3 : d1;
  const float s0 = up32 ? d0 : d2, s1 = up32 ? d1 : d3;
  k0 += __shfl_xor(s0, 32);
  k1 += __shfl_xor(s1, 32);
  float kq = up16 ? k1 : k0;
  const float sq = up16 ? k0 : k1;
  kq += __shfl_xor(sq, 16);
  kq = DPP_ADD(kq, 0xB1);
  kq = DPP_ADD(kq, 0x4E);
  kq = DPP_ADD(kq, 0x141);
  kq = DPP_ADD(kq, 0x140);
  return kq;
}

DEV void p9_token(const Params& p, int t, int tnext, int lane, int2& e2n, float2& w2n, u32x4& han, u32x4& hbn) {
  const unsigned char* U8 = (const unsigned char*)(p.ws + OFF_UBF);
  const unsigned char* V8 = (const unsigned char*)(p.ws + OFF_VBF);
  const int2 e2 = e2n;
  const float2 w2 = w2n;
  const u32x4 ha = han, hb = hbn;
  {
    e2n = *(const int2*)((const int*)(p.ws + OFF_RIDX) + (size_t)tnext * 128 + 2 * lane);
    w2n = *(const float2*)((const float*)(p.ws + OFF_RW) + (size_t)tnext * 128 + 2 * lane);
    const u16* h2 = (const u16*)(p.ws + OFF_H2) + (size_t)tnext * 1024 + 16 * lane;
    han = *(const u32x4*)(h2);
    hbn = *(const u32x4*)(h2 + 8);
  }
  float hf[16];
  hf[0] = bflo(ha.x); hf[1] = bfhi(ha.x); hf[2] = bflo(ha.y); hf[3] = bfhi(ha.y);
  hf[4] = bflo(ha.z); hf[5] = bfhi(ha.z); hf[6] = bflo(ha.w); hf[7] = bfhi(ha.w);
  hf[8] = bflo(hb.x); hf[9] = bfhi(hb.x); hf[10] = bflo(hb.y); hf[11] = bfhi(hb.y);
  hf[12] = bflo(hb.z); hf[13] = bfhi(hb.z); hf[14] = bflo(hb.w); hf[15] = bfhi(hb.w);
  float o[16];
#pragma unroll
  for (int k = 0; k < 16; ++k) o[k] = 0.f;
#pragma unroll 1
  for (int g = 0; g < 128; g += 16) {
    u32x4 uu[16], vv[16];
    float wj[16];
#pragma unroll
    for (int j = 0; j < 16; ++j) {
      const int src = (g >> 1) + (j >> 1);
      const int ej = (j & 1) ? __builtin_amdgcn_readlane(e2.y, src) : __builtin_amdgcn_readlane(e2.x, src);
      wj[j] = __builtin_bit_cast(float, (j & 1) ? __builtin_amdgcn_readlane(__builtin_bit_cast(int, w2.y), src)
                                                : __builtin_amdgcn_readlane(__builtin_bit_cast(int, w2.x), src));
      const size_t ro = (size_t)ej * 1024 + 16 * lane;
      uu[j] = *(const u32x4*)(U8 + ro);
      vv[j] = *(const u32x4*)(V8 + ro);
    }
    float d[16];
#pragma unroll
    for (int j = 0; j < 16; ++j) {
      const f32x2 l0 = __builtin_amdgcn_cvt_pk_f32_fp8((int)uu[j].x, false), h0 = __builtin_amdgcn_cvt_pk_f32_fp8((int)uu[j].x, true);
      const f32x2 l1 = __builtin_amdgcn_cvt_pk_f32_fp8((int)uu[j].y, false), h1 = __builtin_amdgcn_cvt_pk_f32_fp8((int)uu[j].y, true);
      const f32x2 l2 = __builtin_amdgcn_cvt_pk_f32_fp8((int)uu[j].z, false), h2v = __builtin_amdgcn_cvt_pk_f32_fp8((int)uu[j].z, true);
      const f32x2 l3 = __builtin_amdgcn_cvt_pk_f32_fp8((int)uu[j].w, false), h3 = __builtin_amdgcn_cvt_pk_f32_fp8((int)uu[j].w, true);
      float a0 = l0.x * hf[0] + l0.y * hf[1], a1 = h0.x * hf[2] + h0.y * hf[3];
      a0 += l1.x * hf[4] + l1.y * hf[5]; a1 += h1.x * hf[6] + h1.y * hf[7];
      a0 += l2.x * hf[8] + l2.y * hf[9]; a1 += h2v.x * hf[10] + h2v.y * hf[11];
      a0 += l3.x * hf[12] + l3.y * hf[13]; a1 += h3.x * hf[14] + h3.y * hf[15];
      d[j] = a0 + a1;
    }
#pragma unroll
    for (int q = 0; q < 4; ++q) {
      const float dot = reduce4_rows(d[4 * q], d[4 * q + 1], d[4 * q + 2], d[4 * q + 3], lane);
      const float gl = gelu_tanh(dot * (1.f / 512.f)) * (1.f / 64.f);
#pragma unroll
      for (int i = 0; i < 4; ++i) {
        const int j = 4 * q + i;
        const float ci = wj[j] * __builtin_bit_cast(float, __builtin_amdgcn_readlane(__builtin_bit_cast(int, gl), 16 * i));
        f32x2 tq;
        tq = __builtin_amdgcn_cvt_pk_f32_fp8((int)vv[j].x, false); o[0] += ci * tq.x; o[1] += ci * tq.y;
        tq = __builtin_amdgcn_cvt_pk_f32_fp8((int)vv[j].x, true);  o[2] += ci * tq.x; o[3] += ci * tq.y;
        tq = __builtin_amdgcn_cvt_pk_f32_fp8((int)vv[j].y, false); o[4] += ci * tq.x; o[5] += ci * tq.y;
        tq = __builtin_amdgcn_cvt_pk_f32_fp8((int)vv[j].y, true);  o[6] += ci * tq.x; o[7] += ci * tq.y;
        tq = __builtin_amdgcn_cvt_pk_f32_fp8((int)vv[j].z, false); o[8] += ci * tq.x; o[9] += ci * tq.y;
        tq = __builtin_amdgcn_cvt_pk_f32_fp8((int)vv[j].z, true);  o[10] += ci * tq.x; o[11] += ci * tq.y;
        tq = __builtin_amdgcn_cvt_pk_f32_fp8((int)vv[j].w, false); o[12] += ci * tq.x; o[13] += ci * tq.y;
        tq = __builtin_amdgcn_cvt_pk_f32_fp8((int)vv[j].w, true);  o[14] += ci * tq.x; o[15] += ci * tq.y;
      }
    }
  }
  const int b = t >> 12;
  const float* mod = (const float*)(p.ws + OFF_MOD) + b * 6144 + 5120 + 16 * lane;
  float* xm = p.out + (size_t)t * 1024 + 16 * lane;
  float xo[16];
  float ss = 0.f;
#pragma unroll
  for (int q = 0; q < 4; ++q) {
    const float4 xv = *(const float4*)(xm + 4 * q);
    const float4 gv = *(const float4*)(mod + 4 * q);
    xo[4 * q + 0] = xv.x + gv.x * o[4 * q + 0];
    xo[4 * q + 1] = xv.y + gv.y * o[4 * q + 1];
    xo[4 * q + 2] = xv.z + gv.z * o[4 * q + 2];
    xo[4 * q + 3] = xv.w + gv.w * o[4 * q + 3];
  }
#pragma unroll
  for (int k = 0; k < 16; ++k) ss += xo[k] * xo[k];
  ss = wave_sum(ss);
  const float r = rsqrtf(ss * (1.f / 1024.f) + 1e-6f);
#pragma unroll
  for (int q = 0; q < 4; ++q) {
    const float4 fg = *(const float4*)(p.final_g + 16 * lane + 4 * q);
    *(float4*)(xm + 4 * q) = make_float4(xo[4 * q] * r * fg.x, xo[4 * q + 1] * r * fg.y, xo[4 * q + 2] * r * fg.z, xo[4 * q + 3] * r * fg.w);
  }
}

DEV void p9_experts4(const Params& p, int task, char* wsm) {
  const int lane = threadIdx.x & 63;
  const int t0 = task * 4;
  int* hist = (int*)wsm;
  unsigned* skey = (unsigned*)(wsm + 1024);
  float* swt = (float*)(wsm + 1024 + 2048);
  u16* sh2 = (u16*)(wsm + 1024 + 4096);
  hist[lane] = 0; hist[lane + 64] = 0; hist[lane + 128] = 0; hist[lane + 192] = 0;
  const int* ridx = (const int*)(p.ws + OFF_RIDX) + (size_t)t0 * 128 + lane * 8;
  const float* rw = (const float*)(p.ws + OFF_RW) + (size_t)t0 * 128 + lane * 8;
  int4 ea = *(const int4*)(ridx), eb = *(const int4*)(ridx + 4);
  float4 wa = *(const float4*)(rw), wb = *(const float4*)(rw + 4);
  int e[8] = {ea.x, ea.y, ea.z, ea.w, eb.x, eb.y, eb.z, eb.w};
  float w[8] = {wa.x, wa.y, wa.z, wa.w, wb.x, wb.y, wb.z, wb.w};
  {
    const u16* h2 = (const u16*)(p.ws + OFF_H2) + (size_t)t0 * 1024;
#pragma unroll
    for (int i = 0; i < 8; ++i) *(u32x4*)(sh2 + (lane + 64 * i) * 8) = *(const u32x4*)(h2 + (lane + 64 * i) * 8);
  }
  __builtin_amdgcn_fence(__ATOMIC_RELEASE, "wavefront");
  __builtin_amdgcn_wave_barrier();
  __builtin_amdgcn_fence(__ATOMIC_ACQUIRE, "wavefront");
  int rank[8];
#pragma unroll
  for (int j = 0; j < 8; ++j) rank[j] = atomicAdd(&hist[e[j] >> 6], 1);
  __builtin_amdgcn_fence(__ATOMIC_RELEASE, "wavefront");
  __builtin_amdgcn_wave_barrier();
  __builtin_amdgcn_fence(__ATOMIC_ACQUIRE, "wavefront");
  {
    const int c0 = hist[4 * lane], c1 = hist[4 * lane + 1], c2 = hist[4 * lane + 2], c3 = hist[4 * lane + 3];
    const int tot = c0 + c1 + c2 + c3;
    int x = tot;
#pragma unroll
    for (int o = 1; o < 64; o <<= 1) { const int y = __shfl_up(x, o); if (lane >= o) x += y; }
    const int base = x - tot;
    __builtin_amdgcn_fence(__ATOMIC_RELEASE, "wavefront");
    __builtin_amdgcn_wave_barrier();
    hist[4 * lane] = base; hist[4 * lane + 1] = base + c0; hist[4 * lane + 2] = base + c0 + c1; hist[4 * lane + 3] = base + c0 + c1 + c2;
  }
  __builtin_amdgcn_fence(__ATOMIC_RELEASE, "wavefront");
  __builtin_amdgcn_wave_barrier();
  __builtin_amdgcn_fence(__ATOMIC_ACQUIRE, "wavefront");
  {
    const unsigned slot = (unsigned)(lane >> 4);
#pragma unroll
    for (int j = 0; j < 8; ++j) {
      const int pos = hist[e[j] >> 6] + rank[j];
      skey[pos] = (unsigned)e[j] | (slot << 14);
      swt[pos] = w[j];
    }
  }
  __builtin_amdgcn_fence(__ATOMIC_RELEASE, "wavefront");
  __builtin_amdgcn_wave_barrier();
  __builtin_amdgcn_fence(__ATOMIC_ACQUIRE, "wavefront");

  float o0[16], o1[16], o2[16], o3[16];
#pragma unroll
  for (int k = 0; k < 16; ++k) { o0[k] = 0.f; o1[k] = 0.f; o2[k] = 0.f; o3[k] = 0.f; }
  const u16* U = (const u16*)(p.ws + OFF_UBF);
  const u16* V = (const u16*)(p.ws + OFF_VBF);
#define P9_LOAD(KK, UU, VV, BB)                                                           \
  _Pragma("unroll") for (int i = 0; i < 4; ++i) {                                         \
    KK[i] = (unsigned)__builtin_amdgcn_readfirstlane((int)skey[4 * (BB) + i]);            \
    const size_t ro = (size_t)(KK[i] & 16383u) * 1024 + 16 * lane;                        \
    UU[i] = *(const u32x4*)(U8 + ro);                                                     \
    VV[i] = *(const u32x4*)(V8 + ro);                                                     \
  }
#define P9_DOTS(KK, UU, BB, COEFV)                                                        \
  {                                                                                       \
    const float myw = swt[4 * (BB) + (lane >> 4)];                                        \
    float d[4];                                                                           \
    _Pragma("unroll") for (int i = 0; i < 4; ++i) {                                       \
      const unsigned slot = KK[i] >> 14;                                                  \
      const u32x4 ha = *(const u32x4*)(sh2 + slot * 1024 + 16 * lane);                    \
      const u32x4 hb = *(const u32x4*)(sh2 + slot * 1024 + 16 * lane + 8);                \
      float acc0 = 0.f, acc1 = 0.f;                                                       \
      {                                                                                   \
        f32x2 l0 = __builtin_amdgcn_cvt_pk_f32_fp8((int)UU[i].x, false), h0 = __builtin_amdgcn_cvt_pk_f32_fp8((int)UU[i].x, true); \
        f32x2 l1 = __builtin_amdgcn_cvt_pk_f32_fp8((int)UU[i].y, false), h1 = __builtin_amdgcn_cvt_pk_f32_fp8((int)UU[i].y, true); \
        f32x2 l2 = __builtin_amdgcn_cvt_pk_f32_fp8((int)UU[i].z, false), h2_ = __builtin_amdgcn_cvt_pk_f32_fp8((int)UU[i].z, true); \
        f32x2 l3 = __builtin_amdgcn_cvt_pk_f32_fp8((int)UU[i].w, false), h3 = __builtin_amdgcn_cvt_pk_f32_fp8((int)UU[i].w, true); \
        acc0 += l0.x * bflo(ha.x) + l0.y * bfhi(ha.x); acc1 += h0.x * bflo(ha.y) + h0.y * bfhi(ha.y);   \
        acc0 += l1.x * bflo(ha.z) + l1.y * bfhi(ha.z); acc1 += h1.x * bflo(ha.w) + h1.y * bfhi(ha.w);   \
        acc0 += l2.x * bflo(hb.x) + l2.y * bfhi(hb.x); acc1 += h2_.x * bflo(hb.y) + h2_.y * bfhi(hb.y); \
        acc0 += l3.x * bflo(hb.z) + l3.y * bfhi(hb.z); acc1 += h3.x * bflo(hb.w) + h3.y * bfhi(hb.w);   \
      }                                                                                   \
      d[i] = acc0 + acc1;                                                                 \
    }                                                                                     \
    const bool up32 = (lane & 32) != 0, up16 = (lane & 16) != 0;                          \
    float k0 = up32 ? d[2] : d[0], k1 = up32 ? d[3] : d[1];                               \
    float s0 = up32 ? d[0] : d[2], s1 = up32 ? d[1] : d[3];                               \
    k0 += __shfl_xor(s0, 32);                                                             \
    k1 += __shfl_xor(s1, 32);                                                             \
    float kq = up16 ? k1 : k0, sq = up16 ? k0 : k1;                                       \
    kq += __shfl_xor(sq, 16);                                                             \
    kq = DPP_ADD(kq, 0xB1);                                                               \
    kq = DPP_ADD(kq, 0x4E);                                                               \
    kq = DPP_ADD(kq, 0x141);                                                              \
    kq = DPP_ADD(kq, 0x140);                                                              \
    COEFV = myw * (1.f / 64.f) * gelu_tanh(kq * (1.f / 512.f));                           \
  }
#define P9_ACCUM(KK, VV, COEFV)                                                           \
  _Pragma("unroll") for (int i = 0; i < 4; ++i) {                                         \
    const float ci = __builtin_bit_cast(float, __builtin_amdgcn_readlane(__builtin_bit_cast(int, COEFV), 16 * i)); \
    const unsigned slot = KK[i] >> 14;                                                    \
    float vf[16];                                                                         \
    {                                                                                     \
      f32x2 t;                                                                            \
      t = __builtin_amdgcn_cvt_pk_f32_fp8((int)VV[i].x, false); vf[0] = t.x; vf[1] = t.y;   \
      t = __builtin_amdgcn_cvt_pk_f32_fp8((int)VV[i].x, true);  vf[2] = t.x; vf[3] = t.y;   \
      t = __builtin_amdgcn_cvt_pk_f32_fp8((int)VV[i].y, false); vf[4] = t.x; vf[5] = t.y;   \
      t = __builtin_amdgcn_cvt_pk_f32_fp8((int)VV[i].y, true);  vf[6] = t.x; vf[7] = t.y;   \
      t = __builtin_amdgcn_cvt_pk_f32_fp8((int)VV[i].z, false); vf[8] = t.x; vf[9] = t.y;   \
      t = __builtin_amdgcn_cvt_pk_f32_fp8((int)VV[i].z, true);  vf[10] = t.x; vf[11] = t.y; \
      t = __builtin_amdgcn_cvt_pk_f32_fp8((int)VV[i].w, false); vf[12] = t.x; vf[13] = t.y; \
      t = __builtin_amdgcn_cvt_pk_f32_fp8((int)VV[i].w, true);  vf[14] = t.x; vf[15] = t.y; \
    }                                                                                     \
    if (slot == 0) { _Pragma("unroll") for (int k = 0; k < 16; ++k) o0[k] += ci * vf[k]; }       \
    else if (slot == 1) { _Pragma("unroll") for (int k = 0; k < 16; ++k) o1[k] += ci * vf[k]; }  \
    else if (slot == 2) { _Pragma("unroll") for (int k = 0; k < 16; ++k) o2[k] += ci * vf[k]; }  \
    else { _Pragma("unroll") for (int k = 0; k < 16; ++k) o3[k] += ci * vf[k]; }                 \
  }
  {
    const unsigned char* U8 = (const unsigned char*)(p.ws + OFF_UBF);
    const unsigned char* V8 = (const unsigned char*)(p.ws + OFF_VBF);
    unsigned kkA[4], kkB[4];
    u32x4 uA[4], vA[4], uB[4], vB[4];
    float cfA, cfB;
    P9_LOAD(kkA, uA, vA, 0)
#pragma unroll 1
    for (int bb = 0; bb < 128; bb += 2) {
      P9_LOAD(kkB, uB, vB, bb + 1)
      P9_DOTS(kkA, uA, bb, cfA)
      P9_ACCUM(kkA, vA, cfA)
      const int n0 = (bb + 2 < 128) ? (bb + 2) : 0;
      P9_LOAD(kkA, uA, vA, n0)
      P9_DOTS(kkB, uB, bb + 1, cfB)
      P9_ACCUM(kkB, vB, cfB)
    }
  }
#pragma unroll
  for (int s = 0; s < 4; ++s) {
    const int t = t0 + s;
    const int b = t >> 12;
    const float* mod = (const float*)(p.ws + OFF_MOD) + b * 6144 + 5120 + 16 * lane;
    float* xm = p.out + (size_t)t * 1024 + 16 * lane;
    const float* oo = (s == 0) ? o0 : ((s == 1) ? o1 : ((s == 2) ? o2 : o3));
    float xo[16];
    float ss = 0.f;
#pragma unroll
    for (int q = 0; q < 4; ++q) {
      const float4 xv = *(const float4*)(xm + 4 * q);
      const float4 gv = *(const float4*)(mod + 4 * q);
      xo[4 * q + 0] = xv.x + gv.x * oo[4 * q + 0];
      xo[4 * q + 1] = xv.y + gv.y * oo[4 * q + 1];
      xo[4 * q + 2] = xv.z + gv.z * oo[4 * q + 2];
      xo[4 * q + 3] = xv.w + gv.w * oo[4 * q + 3];
    }
#pragma unroll
    for (int k = 0; k < 16; ++k) ss += xo[k] * xo[k];
    ss = wave_sum(ss);
    const float r = rsqrtf(ss * (1.f / 1024.f) + 1e-6f);
#pragma unroll
    for (int q = 0; q < 4; ++q) {
      const float4 fg = *(const float4*)(p.final_g + 16 * lane + 4 * q);
      *(float4*)(xm + 4 * q) = make_float4(xo[4 * q] * r * fg.x, xo[4 * q + 1] * r * fg.y, xo[4 * q + 2] * r * fg.z, xo[4 * q + 3] * r * fg.w);
    }
  }
  __builtin_amdgcn_fence(__ATOMIC_RELEASE, "wavefront");
  __builtin_amdgcn_wave_barrier();
}

#define XB_TMO      128
#define XB_XCNT(j)  (256  + 64 * (j))
#define XB_XSUB(j)  (1280 + 64 * (j))
#define XB_XGEN(j)  (2304 + 64 * (j))
#define XB_TOP      3328
#define XB_TOPGEN   3392
#define XCD_BAR_WORDS 3456
#define XB_SPIN_CAP (1u << 18)
#define LAS __attribute__((address_space(3)))

__device__ __forceinline__ unsigned xb_ld(unsigned* p)              { return __hip_atomic_load(p, __ATOMIC_RELAXED, __HIP_MEMORY_SCOPE_AGENT); }
__device__ __forceinline__ unsigned xb_add(unsigned* p, unsigned v) { return __hip_atomic_fetch_add(p, v, __ATOMIC_RELAXED, __HIP_MEMORY_SCOPE_AGENT); }
__device__ __forceinline__ unsigned xb_xcc_id() { return (unsigned)__builtin_amdgcn_s_getreg((3 << 11) | 20) & 0xFu; }
#define XB_SPIN(cond, bar) do { unsigned _sp = 0; while (cond) { __builtin_amdgcn_s_sleep(1); \
    if ((++_sp & 255u) == 0u) { if (xb_ld(&(bar)[XB_TMO])) break; if (_sp > XB_SPIN_CAP) { atomicAdd(&(bar)[XB_TMO], 1u); break; } } } } while (0)

struct XcdBarrier {
    unsigned* bar; unsigned x;
    volatile LAS unsigned* st;
};

__device__ __forceinline__ XcdBarrier xcd_barrier_post(unsigned* bar, volatile LAS unsigned* st) {
    XcdBarrier b; b.bar = bar; b.x = xb_xcc_id(); b.st = st;
    if (threadIdx.x == 0) (void)xb_add(&bar[XB_XCNT(b.x)], 1u);
    return b;
}
__device__ __forceinline__ void xcd_barrier_complete(unsigned* bar, unsigned x, unsigned& nloc, unsigned& nx) {
    const unsigned G = gridDim.x * gridDim.y * gridDim.z;
    unsigned sum, cnt, mine, sp = 0u;
    for (;;) {
        sum = 0u; cnt = 0u; mine = 0u;
#pragma unroll
        for (unsigned j = 0; j < 16; ++j) { const unsigned c = xb_ld(&bar[XB_XCNT(j)]); sum += c; cnt += (c > 0u) ? 1u : 0u; mine = (j == x) ? c : mine; }
        if (sum == G) break;
        __builtin_amdgcn_s_sleep(1);
        if ((++sp & 255u) == 0u) { if (xb_ld(&bar[XB_TMO])) break; if (sp > XB_SPIN_CAP) { atomicAdd(&bar[XB_TMO], 1u); break; } }
    }
    nloc = mine > 0u ? mine : 1u; nx = cnt > 0u ? cnt : 1u;
}

__device__ __forceinline__ void xcd_barrier(const XcdBarrier& b) {
    asm volatile("s_waitcnt vmcnt(0)" ::: "memory");
    __syncthreads();
    if (threadIdx.x == 0) {
        unsigned* bar = b.bar;
        __builtin_amdgcn_s_waitcnt(0);
        unsigned nloc = b.st[0], nx = b.st[1];
        if (nloc == 0u) { xcd_barrier_complete(bar, b.x, nloc, nx); b.st[0] = nloc; b.st[1] = nx; }
        const unsigned old = xb_add(&bar[XB_XSUB(b.x)], 1u);
        const unsigned gen = old / nloc;
        if (old + 1u == (gen + 1u) * nloc) {
            __builtin_amdgcn_fence(__ATOMIC_RELEASE, "agent");
            asm volatile("s_waitcnt vmcnt(0)" ::: "memory");
            const unsigned og = xb_add(&bar[XB_TOP], 1u);
            const unsigned tg = og / nx;
            if (og + 1u == (tg + 1u) * nx) xb_add(&bar[XB_TOPGEN], 1u);
            else XB_SPIN(xb_ld(&bar[XB_TOPGEN]) == tg, bar);
            __builtin_amdgcn_fence(__ATOMIC_ACQUIRE, "agent");
            xb_add(&bar[XB_XGEN(b.x)], 1u);
            asm volatile("s_waitcnt vmcnt(0)" ::: "memory");
        } else {
            XB_SPIN(xb_ld(&bar[XB_XGEN(b.x)]) == gen, bar);
            __builtin_amdgcn_fence(__ATOMIC_ACQUIRE, "agent");
            asm volatile("s_waitcnt vmcnt(0)" ::: "memory");
        }
    }
    __syncthreads();
}


__global__ void __launch_bounds__(256, 2) mega(Params p) {
  extern __shared__ __attribute__((aligned(16))) char smem[];
  cg::grid_group grid = cg::this_grid();
  const int tid = threadIdx.x, lane = tid & 63, wave = tid >> 6;
  const int nb = gridDim.x, bid = blockIdx.x;
  float* smf = (float*)smem;
  if (p.ws == nullptr) grid.sync();
  volatile LAS unsigned* xst = (volatile LAS unsigned*)(smem + SMEM_XB);
  if (tid == 0) { xst[0] = 0u; xst[1] = 0u; }
  __syncthreads();
  const XcdBarrier xb = xcd_barrier_post((unsigned*)(p.ws + OFF_BAR), xst);
  u16* sA = (u16*)smem;
  u16* sB = (u16*)(smem + 128 * 64 * 2);

  for (int rep_ = 0; rep_ < NREP(0); ++rep_) if (PHON(0)) {
    const int N_MOD = 384, N_TIN = 16 * 68, N_TOA = 8 * 16, N_TOH = 8 * 16, N_TOUT = 16 * 16, N_TQ = 16 * 16, N_HID = 1024;
    const int total = N_MOD + N_TIN + N_TOA + N_TOH + N_TOUT + N_TQ + N_HID + 16 + 1;
    for (int it = bid; it < total; it += nb) {
      int i = it;
      if (i < N_MOD) { p0_mod(p, i, smf); continue; }
      i -= N_MOD;
      if (i < N_TIN) { transpose_tile(p.w_in, INW, 1024, (u16*)(p.ws + OFF_WIN), i, smf); continue; }
      i -= N_TIN;
      if (i < N_TOA) { transpose_tile(p.w_o_attn, 1024, 512, (u16*)(p.ws + OFF_WOA), i, smf); continue; }
      i -= N_TOA;
      if (i < N_TOH) { transpose_tile(p.w_o_hy, 1024, 512, (u16*)(p.ws + OFF_WOH), i, smf); continue; }
      i -= N_TOH;
      if (i < N_TOUT) { transpose_tile(p.w_out, 1024, 1024, (u16*)(p.ws + OFF_WOUT), i, smf); continue; }
      i -= N_TOUT;
      if (i < N_TQ) { transpose_tile(p.peer_wq, 1024, 1024, (u16*)(p.ws + OFF_WQ), i, smf); continue; }
      i -= N_TQ;
      if (i < N_HID) { p0_hidden(p, i, smf); continue; }
      i -= N_HID;
      if (i < 16) { transpose_tile(p.hy_fw3, 1024, 64, (u16*)(p.ws + OFF_H2F + 512 * 1024), i, smf); continue; }
      float2* rope = (float2*)(p.ws + OFF_ROPE);
      for (int idx = tid; idx < 1024; idx += 256) {
        const int pos = idx >> 4, f = idx & 15;
        const float inv = powf(10000.f, -(float)f / 16.f);
        const float ang = (float)pos * inv;
        rope[idx] = make_float2(cosf(ang), sinf(ang));
      }
    }
    convert_flat(p.peer_keys, (u16*)(p.ws + OFF_KEYS), (size_t)131072);
    convert_flat_fp8(p.peer_u, (unsigned char*)(p.ws + OFF_UBF), (size_t)16384 * 1024, 512.f);
    convert_flat_fp8(p.peer_v, (unsigned char*)(p.ws + OFF_VBF), (size_t)16384 * 1024, 64.f);
  }
  xcd_barrier(xb);

  for (int rep_ = 0; rep_ < NREP(1); ++rep_) if (PHON(1)) {
    const float* mod = (const float*)(p.ws + OFF_MOD);
    const int nrows = T_TOK + 1024;
    for (int r = bid * 4 + wave; r < nrows; r += nb * 4) {
      if (r < T_TOK) {
        const int b = r >> 12;
        norm_row(p.x + (size_t)r * 1024, p.norm1_g, mod + b * 6144, mod + b * 6144 + 1024,
                 (u16*)((char*)p.out + OO_H1) + (size_t)r * 1024, lane);
      } else {
        const int rc = r - T_TOK;
        norm_row(p.ctx + (size_t)rc * 1024, p.norm1_g, mod + 4 * 6144, mod + 4 * 6144 + 1024,
                 (u16*)((char*)p.out + OO_HC) + (size_t)rc * 1024, lane);
      }
    }
    for (int it = bid; it < 256; it += nb) p1_filter_tile(p, (it + 256 < nb) ? it : it, sA, sB);
  }
  xcd_barrier(xb);

  for (int rep_ = 0; rep_ < NREP(2); ++rep_) if (PHON(2)) {
    if (nb == 512) {
      const int xg = bid & 7, slot = bid >> 3;
      for (int r = 0; r < 8; ++r) {
        const int sup = r * 8 + xg;
        const int mt = (sup >> 2) * 8 + (slot >> 3), nt = (sup & 3) * 8 + (slot & 7);
        p2_inproj(p, mt * 34 + nt, sA, sB);
      }
      if (bid < 256) p2_inproj(p, (bid >> 1) * 34 + 32 + (bid & 1), sA, sB);
      else if (bid < 272) p2_ctxkv(p, bid - 256, sA, sB);
    } else {
      const int total = 128 * 34 + 16;
      for (int it = bid; it < total; it += nb) {
        if (it < 128 * 34) p2_inproj(p, it, sA, sB);
        else p2_ctxkv(p, it - 128 * 34, sA, sB);
      }
    }
  }
  xcd_barrier(xb);

  for (int rep_ = 0; rep_ < NREP(3); ++rep_) if (PHON(3)) {
    const int total = 1024 + 1024;
    for (int it = bid; it < total; it += nb) {
      if (it < 1024) p3_attn(p, it, (u16*)smem, (u16*)(smem + 128 * 72 * 2));
      else p3_hypre(p, it - 1024, (u16*)smem);
    }
  }
  xcd_barrier(xb);

  for (int rep_ = 0; rep_ < NREP(4); ++rep_) if (PHON(4)) for (int it = bid; it < 512; it += nb) p3_toeplitz(p, it, smem);
  xcd_barrier(xb);

  for (int rep_ = 0; rep_ < NREP(5); ++rep_) if (PHON(5)) for (int it = bid; it < 1024; it += nb) p4_merge(p, (nb == 512) ? ((((it >> 9) * 8 + (bid & 7)) * 8 + (bid >> 6)) * 8 + ((bid >> 3) & 7)) : it, sA, sB);
  xcd_barrier(xb);

  for (int rep_ = 0; rep_ < NREP(6); ++rep_) if (PHON(6)) for (int it = bid; it < 1024; it += nb) p5_out(p, (nb == 512) ? ((((it >> 9) * 8 + (bid & 7)) * 8 + (bid >> 6)) * 8 + ((bid >> 3) & 7)) : it, sA, sB);
  xcd_barrier(xb);

  for (int rep_ = 0; rep_ < NREP(7); ++rep_) if (PHON(7)) {
    const float* mod = (const float*)(p.ws + OFF_MOD);
    for (int r = bid * 4 + wave; r < T_TOK; r += nb * 4) {
      const int b = r >> 12;
      norm_row(p.out + (size_t)r * 1024, p.norm2_g, mod + b * 6144 + 3072, mod + b * 6144 + 4096,
               (u16*)(p.ws + OFF_H2) + (size_t)r * 1024, lane);
    }
  }
  xcd_barrier(xb);

  for (int rep_ = 0; rep_ < NREP(8); ++rep_) if (PHON(8)) for (int it = bid; it < 1024; it += nb) p7_qp(p, (nb == 512) ? ((((it >> 9) * 8 + (bid & 7)) * 8 + (bid >> 6)) * 8 + ((bid >> 3) & 7)) : it, sA, sB);
  xcd_barrier(xb);

  for (int rep_ = 0; rep_ < NREP(9); ++rep_) if (PHON(9)) for (int it = bid * 4 + wave; it < 8192; it += nb * 4) p8_route(p, it, smem + wave * 4096);
  xcd_barrier(xb);

  if (PHON(10)) {
    const int nw = nb * 4;
    int t = bid * 4 + wave;
    if (t < T_TOK) {
      int2 e2n = *(const int2*)((const int*)(p.ws + OFF_RIDX) + (size_t)t * 128 + 2 * lane);
      float2 w2n = *(const float2*)((const float*)(p.ws + OFF_RW) + (size_t)t * 128 + 2 * lane);
      u32x4 han = *(const u32x4*)((const u16*)(p.ws + OFF_H2) + (size_t)t * 1024 + 16 * lane);
      u32x4 hbn = *(const u32x4*)((const u16*)(p.ws + OFF_H2) + (size_t)t * 1024 + 16 * lane + 8);
      for (; t < T_TOK; t += nw) {
        const int tn = (t + nw < T_TOK) ? (t + nw) : t;
        p9_token(p, t, tn, lane, e2n, w2n, han, hbn);
      }
    }
  }
}

extern "C" void kernel_launch(void* const* d_in, const int* in_sizes, int n_in, void* d_out, int out_size,
                              void* d_ws, size_t ws_size, hipStream_t stream) {
  static int grid_blocks = 0;
  if (!grid_blocks) {
    int dev = 0, cus = 0, per_cu = 0;
    (void)hipGetDevice(&dev);
    (void)hipDeviceGetAttribute(&cus, hipDeviceAttributeMultiprocessorCount, dev);
    (void)hipFuncSetAttribute((const void*)mega, hipFuncAttributeMaxDynamicSharedMemorySize, SMEM_BYTES);
    (void)hipOccupancyMaxActiveBlocksPerMultiprocessor(&per_cu, mega, 256, SMEM_BYTES);
    if (per_cu > 2) per_cu = 2;
    if (per_cu < 1) per_cu = 1;
    grid_blocks = cus * per_cu;
  }
  Params p{};
  const float** pp = (const float**)&p;
  for (int i = 0; i < 28; ++i) pp[i] = (const float*)d_in[i];
  p.out = (float*)d_out;
  p.ws = (char*)d_ws;
  (void)hipMemsetAsync((char*)d_ws, 0, OFF_BAR + 24576, stream);
  void* args[] = {&p};
  hipError_t e = hipLaunchCooperativeKernel((void*)mega, dim3(grid_blocks), dim3(256), args, SMEM_BYTES, stream);
  if (e != hipSuccess) fprintf(stderr, "cooperative launch failed: %s (grid %d)\n", hipGetErrorString(e), grid_blocks);
}
```

```cpp
#include <hip/hip_runtime.h>
#include <hip/hip_bf16.h>
#include <hip/hip_cooperative_groups.h>
#include <cstdio>
namespace cg = cooperative_groups;

typedef unsigned short u16;
typedef __attribute__((ext_vector_type(8))) short bf16x8;
typedef __attribute__((ext_vector_type(4))) float f32x4;
typedef __attribute__((ext_vector_type(4))) unsigned u32x4;

#define DEV __device__ __forceinline__
#ifndef PH
#define PH -1
#endif
#define PHON(n) (PH < 0 || PH == (n))
#ifndef REP
#define REP -1
#endif
#define NREP(n) ((REP == (n)) ? 2 : 1)

constexpr int T_TOK = 16384;
constexpr int DM = 1024;
constexpr int SEQL = 4096;
constexpr int INW = 4352;

struct Params {
  const float *x, *c, *ctx, *c_ctx, *w_mod, *b_mod, *norm1_g, *w_in, *attn_sink, *hy_conv_w, *hy_conv_b,
      *hy_fw1, *hy_fb1, *hy_fw2, *hy_fb2, *hy_fw3, *hy_fb3, *hy_freq, *hy_skip, *w_o_attn, *w_o_hy, *w_out,
      *norm2_g, *peer_wq, *peer_keys, *peer_u, *peer_v, *final_g;
  float* out;
  char* ws;
};

constexpr size_t MB = 1u << 20;
constexpr size_t OFF_MOD = 0;
constexpr size_t OFF_ROPE = 128 * 1024;
constexpr size_t OFF_NINV = OFF_ROPE + 8192;
constexpr size_t OFF_H2F = 256 * 1024;
constexpr size_t OFF_WIN = OFF_H2F + MB;
constexpr size_t OFF_WOA = OFF_WIN + 9 * MB;
constexpr size_t OFF_WOH = OFF_WOA + MB;
constexpr size_t OFF_WOUT = OFF_WOH + MB;
constexpr size_t OFF_WQ = OFF_WOUT + 2 * MB;
constexpr size_t OFF_KEYS = OFF_WQ + 2 * MB;
constexpr size_t OFF_UBF = OFF_KEYS + MB;
constexpr size_t OFF_VBF = OFF_UBF + 32 * MB;
constexpr size_t OFF_Q = OFF_VBF + 32 * MB;
constexpr size_t OFF_K = OFF_Q + 16 * MB;
constexpr size_t OFF_VT = OFF_K + 4 * MB;
constexpr size_t OFF_KC = OFF_VT + 4 * MB;
constexpr size_t OFF_VCT = OFF_KC + MB / 2;
constexpr size_t OFF_Z = OFF_VCT + MB / 2;
constexpr size_t OFF_GATE = OFF_Z + 48 * MB;
constexpr size_t OFF_YATT = OFF_GATE + 64 * MB;
constexpr size_t OFF_YHY = OFF_YATT + 16 * MB;
constexpr size_t OFF_RIDX = OFF_Q;
constexpr size_t OFF_RW = OFF_Q + 8 * MB;
constexpr size_t OFF_MERGED = OFF_Z;
constexpr size_t OFF_H2 = OFF_GATE;
constexpr size_t OFF_QP = OFF_GATE + 32 * MB;
constexpr size_t OO_H1 = 0;
constexpr size_t OO_UT = 0;
constexpr size_t OO_X0T = 16 * MB;
constexpr size_t OO_HC = 32 * MB;
constexpr size_t OO_G = 34 * MB;

constexpr int SMEM_BYTES = 70144;
constexpr size_t OFF_BAR = 160 * 1024;
constexpr int SMEM_XB = 70016;

typedef __attribute__((ext_vector_type(2))) float pk_f2;
typedef __attribute__((ext_vector_type(2))) __bf16 pk_b2;
DEV unsigned pack2(float a, float b) {
  pk_f2 v = {a, b};
  return __builtin_bit_cast(unsigned, __builtin_convertvector(v, pk_b2));
}
DEV u16 f2bf(float f) { return (u16)(pack2(f, 0.f) & 0xffffu); }
DEV float bf2f(u16 h) { return __uint_as_float(((unsigned)h) << 16); }
DEV float bflo(unsigned w) { return __uint_as_float(w << 16); }
DEV float bfhi(unsigned w) { return __uint_as_float(w & 0xffff0000u); }
#define DPP_ADD(v, ctrl) ((v) + __builtin_bit_cast(float, __builtin_amdgcn_update_dpp(0, __builtin_bit_cast(int, (v)), (ctrl), 0xF, 0xF, true)))
DEV float wave_sum(float v) {
  v = DPP_ADD(v, 0xB1);
  v = DPP_ADD(v, 0x4E);
  v = DPP_ADD(v, 0x141);
  v = DPP_ADD(v, 0x140);
  v += __shfl_xor(v, 16);
  v += __shfl_xor(v, 32);
  return v;
}
DEV float wave_max(float v) {
#pragma unroll
  for (int o = 32; o > 0; o >>= 1) v = fmaxf(v, __shfl_xor(v, o));
  return v;
}

DEV void p0_mod(const Params& p, int item, float* sm) {
  const int tid = threadIdx.x;
  const int cblk = item >> 2, kq = item & 3;
  for (int i = tid; i < 5 * 256; i += 256) {
    const int r = i >> 8, k = kq * 256 + (i & 255);
    const float c = (r < 4) ? p.c[r * 1024 + k] : p.c_ctx[k];
    sm[i] = c * __builtin_amdgcn_rcpf(1.f + __expf(-c));
  }
  __syncthreads();
  const int col = cblk * 64 + (tid & 63), sub = tid >> 6;
  float a0 = 0, a1 = 0, a2 = 0, a3 = 0, a4 = 0;
  const float* wp = p.w_mod + (size_t)(kq * 256 + sub * 64) * 6144 + col;
#pragma unroll 16
  for (int k = 0; k < 64; ++k) {
    const float w = wp[(size_t)k * 6144];
    const int kk = sub * 64 + k;
    a0 += sm[kk] * w; a1 += sm[256 + kk] * w; a2 += sm[512 + kk] * w; a3 += sm[768 + kk] * w; a4 += sm[1024 + kk] * w;
  }
  float* red = sm + 5 * 256;
  red[(sub * 5 + 0) * 64 + (tid & 63)] = a0;
  red[(sub * 5 + 1) * 64 + (tid & 63)] = a1;
  red[(sub * 5 + 2) * 64 + (tid & 63)] = a2;
  red[(sub * 5 + 3) * 64 + (tid & 63)] = a3;
  red[(sub * 5 + 4) * 64 + (tid & 63)] = a4;
  __syncthreads();
  float* mod = (float*)(p.ws + OFF_MOD);
  for (int i = tid; i < 320; i += 256) {
    const int r = i >> 6, cc = i & 63;
    float sacc = red[(0 * 5 + r) * 64 + cc] + red[(1 * 5 + r) * 64 + cc] + red[(2 * 5 + r) * 64 + cc] + red[(3 * 5 + r) * 64 + cc];
    if (kq == 0) sacc += p.b_mod[cblk * 64 + cc];
    atomicAdd(mod + r * 6144 + cblk * 64 + cc, sacc);
  }
  __syncthreads();
}

DEV void transpose_tile(const float* __restrict__ src, int N, int K, u16* __restrict__ dst, int tile, float* sm) {
  const int tid = threadIdx.x;
  const int nkt = K >> 6;
  const int kt = tile % nkt, nt = tile / nkt;
  const int k0 = kt * 64, n0 = nt * 64;
  const int c4 = tid & 15, r = tid >> 4;
  float4 tv[4];
#pragma unroll
  for (int rr = 0; rr < 4; ++rr) tv[rr] = *(const float4*)(src + (size_t)(k0 + rr * 16 + r) * N + n0 + c4 * 4);
#pragma unroll
  for (int rr = 0; rr < 4; ++rr) {
    float* d0 = sm + (rr * 16 + r) * 65 + c4 * 4;
    d0[0] = tv[rr].x; d0[1] = tv[rr].y; d0[2] = tv[rr].z; d0[3] = tv[rr].w;
  }
  __syncthreads();
  const int nn = tid >> 2, part = tid & 3;
  unsigned w[8];
#pragma unroll
  for (int j = 0; j < 8; ++j) w[j] = pack2(sm[(part * 16 + 2 * j) * 65 + nn], sm[(part * 16 + 2 * j + 1) * 65 + nn]);
  uint4* d = (uint4*)(dst + (size_t)(n0 + nn) * K + k0 + part * 16);
  d[0] = make_uint4(w[0], w[1], w[2], w[3]);
  d[1] = make_uint4(w[4], w[5], w[6], w[7]);
  __syncthreads();
}

DEV void p0_hidden(const Params& p, int item, float* sm) {
  const int tid = threadIdx.x;
  float* z = sm;
  float* h1 = sm + 4 * 36;
  if (tid < 4 * 33) {
    int tt = tid / 33, i = tid % 33;
    int t = item * 4 + tt;
    float v;
    if (i == 0) v = (float)t * (1.f / 4096.f);
    else {
      int band = (i <= 16) ? i : (i - 16);
      float fr = (float)((t * band) & 4095) * (1.f / 4096.f);
      v = (i <= 16) ? cospif(2.f * fr) : sinpif(2.f * fr);
    }
    z[tt * 36 + i] = v;
  }
  __syncthreads();
  const int tt = tid >> 6, j = tid & 63;
  float a = p.hy_fb1[j];
  for (int i = 0; i < 33; ++i) a += z[tt * 36 + i] * p.hy_fw1[i * 64 + j];
  const float fq = p.hy_freq[j];
  h1[tt * 64 + j] = sinf(fq * a);
  __syncthreads();
  float b = p.hy_fb2[j];
  for (int i = 0; i < 64; ++i) b += h1[tt * 64 + i] * p.hy_fw2[i * 64 + j];
  ((u16*)(p.ws + OFF_H2F))[(item * 4 + tt) * 64 + j] = f2bf(sinf(fq * b));
  __syncthreads();
}

DEV void convert_flat(const float* __restrict__ src, u16* __restrict__ dst, size_t n) {
  size_t stride = (size_t)gridDim.x * 256 * 8;
  for (size_t i = ((size_t)blockIdx.x * 256 + threadIdx.x) * 8; i < n; i += stride) {
    float4 a = *(const float4*)(src + i);
    float4 b = *(const float4*)(src + i + 4);
    *(uint4*)(dst + i) = make_uint4(pack2(a.x, a.y), pack2(a.z, a.w), pack2(b.x, b.y), pack2(b.z, b.w));
  }
}

typedef __attribute__((ext_vector_type(2))) float f32x2;
DEV void convert_flat_fp8(const float* __restrict__ src, unsigned char* __restrict__ dst, size_t n, float scale) {
  const size_t q4 = (size_t)gridDim.x * 256 * 16;
  const size_t stride = q4 * 4;
  for (size_t i = ((size_t)blockIdx.x * 256 + threadIdx.x) * 16; i < n; i += stride) {
    float4 a[16];
#pragma unroll
    for (int c = 0; c < 4; ++c) {
      const size_t off = i + c * q4;
      if (off < n) {
#pragma unroll
        for (int q = 0; q < 4; ++q) a[c * 4 + q] = *(const float4*)(src + off + 4 * q);
      }
    }
#pragma unroll
    for (int c = 0; c < 4; ++c) {
      const size_t off = i + c * q4;
      if (off < n) {
        unsigned w[4];
#pragma unroll
        for (int q = 0; q < 4; ++q) {
          int v = 0;
          v = __builtin_amdgcn_cvt_pk_fp8_f32(a[c * 4 + q].x * scale, a[c * 4 + q].y * scale, v, false);
          v = __builtin_amdgcn_cvt_pk_fp8_f32(a[c * 4 + q].z * scale, a[c * 4 + q].w * scale, v, true);
          w[q] = (unsigned)v;
        }
        *(uint4*)(dst + off) = make_uint4(w[0], w[1], w[2], w[3]);
      }
    }
  }
}

DEV void norm_row(const float* __restrict__ xr, const float* __restrict__ g, const float* __restrict__ sh,
                  const float* __restrict__ sc, u16* __restrict__ dst, int lane) {
  float4 v[4];
  float ss = 0.f;
#pragma unroll
  for (int i = 0; i < 4; ++i) {
    v[i] = ((const float4*)xr)[lane + 64 * i];
    ss += v[i].x * v[i].x + v[i].y * v[i].y + v[i].z * v[i].z + v[i].w * v[i].w;
  }
  ss = wave_sum(ss);
  const float r = rsqrtf(ss * (1.f / 1024.f) + 1e-6f);
#pragma unroll
  for (int i = 0; i < 4; ++i) {
    const int idx = lane + 64 * i;
    float4 gg = ((const float4*)g)[idx], s1 = ((const float4*)sh)[idx], s2 = ((const float4*)sc)[idx];
    float y0 = v[i].x * r * gg.x * (1.f + s2.x) + s1.x;
    float y1 = v[i].y * r * gg.y * (1.f + s2.y) + s1.y;
    float y2 = v[i].z * r * gg.z * (1.f + s2.z) + s1.z;
    float y3 = v[i].w * r * gg.w * (1.f + s2.w) + s1.w;
    *(uint2*)(dst + idx * 4) = make_uint2(pack2(y0, y1), pack2(y2, y3));
  }
}

DEV void p1_filter(const Params& p, int item, float* sm) {
  const int tid = threadIdx.x;
  const int c0 = (item >> 2) * 4, tq = item & 3;
  float* wc = sm;
  float* red = sm + 512;
  for (int i = tid; i < 512; i += 256) {
    const int j = i >> 6, k = i & 63;
    wc[i] = p.hy_fw3[k * 1024 + ((j < 4) ? (c0 + j) : (512 + c0 + j - 4))];
  }
  __syncthreads();
  float fb[8], dl[4];
#pragma unroll
  for (int j = 0; j < 8; ++j) fb[j] = p.hy_fb3[(j < 4) ? (c0 + j) : (512 + c0 + j - 4)];
  const float da = logf(1e-2f) / 1.5f, db = logf(1e-2f) / 0.3f;
#pragma unroll
  for (int j = 0; j < 4; ++j) dl[j] = fabsf(da + (db - da) * (float)(c0 + j) / 511.f);
  u16* G = (u16*)((char*)p.out + OO_G);
  const float* H = (const float*)(p.ws + OFF_H2F);
  float as[4] = {0.f, 0.f, 0.f, 0.f};
#pragma unroll 1
  for (int i = 0; i < 4; ++i) {
    const int t = tq * 1024 + i * 256 + tid;
    const float4* hp = (const float4*)(H + t * 64);
    float d[8];
#pragma unroll
    for (int j = 0; j < 8; ++j) d[j] = fb[j];
#pragma unroll 1
    for (int q8 = 0; q8 < 16; q8 += 8) {
      float4 hv[8];
#pragma unroll
      for (int u = 0; u < 8; ++u) hv[u] = hp[q8 + u];
#pragma unroll
      for (int u = 0; u < 8; ++u)
#pragma unroll
        for (int j = 0; j < 8; ++j) {
          const float4 w = *(const float4*)(wc + j * 64 + 4 * (q8 + u));
          d[j] += hv[u].x * w.x + hv[u].y * w.y + hv[u].z * w.z + hv[u].w * w.w;
        }
    }
    const float tn = (float)t * (1.f / 4096.f);
#pragma unroll
    for (int j = 0; j < 4; ++j) {
      const float dec = expf(-tn * dl[j]);
      const float f = d[j] * dec, bw = d[4 + j] * dec;
      u16* Gc = G + (size_t)(c0 + j) * 8192;
      Gc[4095 - t] = f2bf(f);
      as[j] += fabsf(f);
      if (t < 4095) { Gc[4096 + t] = f2bf(bw); as[j] += fabsf(bw); }
      else Gc[8191] = 0;
    }
  }
#pragma unroll
  for (int j = 0; j < 4; ++j) {
    const float v = wave_sum(as[j]);
    if ((tid & 63) == 0) red[(tid >> 6) * 4 + j] = v;
  }
  __syncthreads();
  if (tid < 4) atomicAdd((float*)(p.ws + OFF_BAR + 20480) + c0 + tid, red[tid] + red[4 + tid] + red[8 + tid] + red[12 + tid]);
  __syncthreads();
}

struct Acc { f32x4 v[4][4]; };

DEV void acc_zero(Acc& a) {
#pragma unroll
  for (int i = 0; i < 4; ++i)
#pragma unroll
    for (int j = 0; j < 4; ++j) a.v[i][j] = (f32x4){0.f, 0.f, 0.f, 0.f};
}

#define LDSAS __attribute__((address_space(3)))
DEV void gemm_kloop(const u16* __restrict__ A, int lda, const u16* __restrict__ Bt, int ldb, int K, int m0, int n0,
                    u16* sA, u16* sB_unused, Acc& acc) {
  const int tid = threadIdx.x, lane = tid & 63, wave = tid >> 6, wm = wave >> 1, wn = wave & 1;
  const int l15 = lane & 15, quad = lane >> 4;
  const int rsw = (l15 >> 1) & 7;
  const int nk = K >> 6;
  const int prow = lane >> 3;
  const int pch = lane & 7;
  unsigned oA[4], oB[4];
#pragma unroll
  for (int i = 0; i < 4; ++i) {
    const int row = (wave * 4 + i) * 8 + prow;
    const int c = pch ^ ((row >> 1) & 7);
    oA[i] = (unsigned)(row * lda + c * 8) * 2u;
    oB[i] = (unsigned)(row * ldb + c * 8) * 2u;
  }
  const char* bA = (const char*)(A + (size_t)m0 * lda);
  const char* bB = (const char*)(Bt + (size_t)n0 * ldb);
  LDSAS char* lbase = (LDSAS char*)sA;
#define GEMM_DMA(KT, BUF)                                                                                   \
  _Pragma("unroll") for (int i = 0; i < 4; ++i) {                                                           \
    __builtin_amdgcn_global_load_lds((const unsigned*)(bA + (KT) * 128 + oA[i]), (LDSAS unsigned*)(lbase + (BUF) * 32768 + (wave * 4 + i) * 1024), 16, 0, 0);          \
    __builtin_amdgcn_global_load_lds((const unsigned*)(bB + (KT) * 128 + oB[i]), (LDSAS unsigned*)(lbase + (BUF) * 32768 + 16384 + (wave * 4 + i) * 1024), 16, 0, 0);  \
  }
  GEMM_DMA(0, 0)
  for (int kt = 0; kt < nk; ++kt) {
    asm volatile("s_waitcnt vmcnt(0)" ::: "memory");
    __syncthreads();
    const int buf = kt & 1;
    if (kt + 1 < nk) { GEMM_DMA(kt + 1, buf ^ 1) }
    const u16* tA = sA + buf * 16384;
    const u16* tB = tA + 8192;
    bf16x8 af[2][4], bfr[2][4];
#pragma unroll
    for (int ks = 0; ks < 2; ++ks) {
      const int cs = ((ks * 4 + quad) ^ rsw) * 8;
#pragma unroll
      for (int i = 0; i < 4; ++i) af[ks][i] = *(const bf16x8*)(tB + (wn * 64 + i * 16 + l15) * 64 + cs);
#pragma unroll
      for (int j = 0; j < 4; ++j) bfr[ks][j] = *(const bf16x8*)(tA + (wm * 64 + j * 16 + l15) * 64 + cs);
    }
    __builtin_amdgcn_s_setprio(1);
#pragma unroll
    for (int ks = 0; ks < 2; ++ks)
#pragma unroll
      for (int i = 0; i < 4; ++i)
#pragma unroll
        for (int j = 0; j < 4; ++j) acc.v[i][j] = __builtin_amdgcn_mfma_f32_16x16x32_bf16(af[ks][i], bfr[ks][j], acc.v[i][j], 0, 0, 0);
    __builtin_amdgcn_s_setprio(0);
  }
  __syncthreads();
}

DEV void p1_filter_tile(const Params& p, int tile, u16* sA, u16* sB) {
  const int mt = tile >> 3, nt = tile & 7;
  const int m0 = mt * 128, n0 = nt * 128;
  Acc acc; acc_zero(acc);
  gemm_kloop((const u16*)(p.ws + OFF_H2F), 64, (const u16*)(p.ws + OFF_H2F + 512 * 1024), 64, 64, m0, n0, sA, sB, acc);
  asm volatile("" ::: "memory");
  const int tid = threadIdx.x, lane = tid & 63, wave = tid >> 6, wm = wave >> 1, wn = wave & 1;
  const int l15 = lane & 15, quad = lane >> 4;
  const int mb = m0 + wm * 64, nbase = n0 + wn * 64;
  u16* G = (u16*)((char*)p.out + OO_G);
  float* nsum = (float*)(p.ws + OFF_BAR + 20480);
  const float da = logf(1e-2f) / 1.5f, db = logf(1e-2f) / 0.3f;
  const bool bwd = nbase >= 512;
#pragma unroll
  for (int i = 0; i < 4; ++i)
#pragma unroll
    for (int r = 0; r < 4; ++r) {
      const int col = nbase + i * 16 + quad * 4 + r;
      const int c = col & 511;
      const float fbv = p.hy_fb3[col];
      const float dlc = fabsf(da + (db - da) * (float)c / 511.f);
      u16* Gc = G + (size_t)c * 8192;
      float sum = 0.f;
#pragma unroll
      for (int j = 0; j < 4; ++j) {
        const int t = mb + j * 16 + l15;
        const float val = (acc.v[i][j][r] + fbv) * __expf(-(float)t * (1.f / 4096.f) * dlc);
        if (!bwd) { Gc[4095 - t] = f2bf(val); sum += fabsf(val); }
        else if (t < 4095) { Gc[4096 + t] = f2bf(val); sum += fabsf(val); }
        else Gc[8191] = 0;
      }
      sum = DPP_ADD(sum, 0xB1);
      sum = DPP_ADD(sum, 0x4E);
      sum = DPP_ADD(sum, 0x141);
      sum = DPP_ADD(sum, 0x140);
      if (l15 == 0) atomicAdd(nsum + c, sum);
    }
}

DEV void p2_inproj(const Params& p, int tile, u16* sA, u16* sB) {
  const int mt = tile / 34, nt = tile % 34;
  const int m0 = mt * 128, n0 = nt * 128;
  Acc acc; acc_zero(acc);
  gemm_kloop((const u16*)((const char*)p.out + OO_H1), 1024, (const u16*)(p.ws + OFF_WIN), 1024, 1024, m0, n0, sA, sB, acc);
  asm volatile("" ::: "memory");
  const int tid = threadIdx.x, lane = tid & 63, wave = tid >> 6, wm = wave >> 1, wn = wave & 1;
  int l15 = lane & 15, quad = lane >> 4;
  int mb = m0 + wm * 64, nb = n0 + wn * 64;
  asm volatile("" : "+v"(l15), "+v"(quad), "+v"(mb), "+v"(nb));
  mb = __builtin_amdgcn_readfirstlane(mb); nb = __builtin_amdgcn_readfirstlane(nb);
  if (nb < 640) {
    const float2* rope = (const float2*)(p.ws + OFF_ROPE);
    const bool isq = nb < 512;
    const float qs = isq ? 0.125f : 1.f;
#pragma unroll
    for (int j = 0; j < 4; ++j) {
      const int m = mb + j * 16 + l15;
      const int b = m >> 12, l = m & 4095;
      const int prow = l >> 6, pcol = l & 63;
      u16* dst;
      if (isq) dst = (u16*)(p.ws + OFF_Q) + ((size_t)(b * 8 + (nb >> 6)) * 4096 + l) * 64;
      else dst = (u16*)(p.ws + OFF_K) + ((size_t)(b * 2 + ((nb - 512) >> 6)) * 4096 + l) * 64;
#pragma unroll
      for (int hh = 0; hh < 2; ++hh) {
        const int pos = hh ? pcol : prow;
        f32x4 x1 = acc.v[hh * 2][j], x2 = acc.v[hh * 2 + 1][j];
        float o1[4], o2[4];
#pragma unroll
        for (int r = 0; r < 4; ++r) {
          float2 cs = rope[pos * 16 + quad * 4 + r];
          o1[r] = (x1[r] * cs.x - x2[r] * cs.y) * qs;
          o2[r] = (x2[r] * cs.x + x1[r] * cs.y) * qs;
        }
        *(uint2*)(dst + hh * 32 + quad * 4) = make_uint2(pack2(o1[0], o1[1]), pack2(o1[2], o1[3]));
        *(uint2*)(dst + hh * 32 + 16 + quad * 4) = make_uint2(pack2(o2[0], o2[1]), pack2(o2[2], o2[3]));
      }
    }
  } else if (nb < 768) {
    const int g = (nb - 640) >> 6;
    u16* vt = (u16*)(p.ws + OFF_VT);
#pragma unroll
    for (int j = 0; j < 4; ++j) {
      const int m = mb + j * 16 + l15;
      const int b = m >> 12, l = m & 4095;
#pragma unroll
      for (int i = 0; i < 4; ++i)
#pragma unroll
        for (int r = 0; r < 4; ++r) {
          const int d = i * 16 + quad * 4 + r;
          vt[((size_t)(b * 2 + g) * 64 + d) * 4096 + l] = f2bf(acc.v[i][j][r]);
        }
    }
  } else if (nb < 2304) {
    u16* z = (u16*)(p.ws + OFF_Z);
#pragma unroll
    for (int j = 0; j < 4; ++j) {
      const int m = mb + j * 16 + l15;
#pragma unroll
      for (int i = 0; i < 4; ++i) {
        const int n = nb - 768 + i * 16 + quad * 4;
        f32x4 a = acc.v[i][j];
        *(uint2*)(z + (size_t)m * 1536 + n) = make_uint2(pack2(a[0], a[1]), pack2(a[2], a[3]));
      }
    }
  } else {
    u16* gt = (u16*)(p.ws + OFF_GATE);
#pragma unroll
    for (int j = 0; j < 4; ++j) {
      const int m = mb + j * 16 + l15;
#pragma unroll
      for (int i = 0; i < 4; ++i) {
        const int n = nb - 2304 + i * 16 + quad * 4;
        f32x4 a = acc.v[i][j];
        float s0 = __builtin_amdgcn_rcpf(1.f + __expf(-a[0])), s1 = __builtin_amdgcn_rcpf(1.f + __expf(-a[1]));
        float s2 = __builtin_amdgcn_rcpf(1.f + __expf(-a[2])), s3 = __builtin_amdgcn_rcpf(1.f + __expf(-a[3]));
        *(uint2*)(gt + (size_t)m * 2048 + n) = make_uint2(pack2(s0, s1), pack2(s2, s3));
      }
    }
  }
}

DEV void p2_ctxkv(const Params& p, int tile, u16* sA, u16* sB) {
  const int mt = tile >> 1, nt = tile & 1;
  const int m0 = mt * 128, n0 = nt * 128;
  Acc acc; acc_zero(acc);
  gemm_kloop((const u16*)((const char*)p.out + OO_HC), 1024, (const u16*)(p.ws + OFF_WIN) + (size_t)512 * 1024, 1024, 1024, m0, n0, sA, sB, acc);
  const int tid = threadIdx.x, lane = tid & 63, wave = tid >> 6, wm = wave >> 1, wn = wave & 1;
  const int l15 = lane & 15, quad = lane >> 4;
  const int mb = m0 + wm * 64, nb = n0 + wn * 64;
  const int g = (nb >> 6) & 1;
  if (nb < 128) {
    u16* kc = (u16*)(p.ws + OFF_KC);
#pragma unroll
    for (int j = 0; j < 4; ++j) {
      const int m = mb + j * 16 + l15;
      const int b = m >> 8, c = m & 255;
#pragma unroll
      for (int i = 0; i < 4; ++i) {
        f32x4 a = acc.v[i][j];
        *(uint2*)(kc + ((size_t)(b * 2 + g) * 256 + c) * 64 + i * 16 + quad * 4) = make_uint2(pack2(a[0], a[1]), pack2(a[2], a[3]));
      }
    }
  } else {
    u16* vct = (u16*)(p.ws + OFF_VCT);
#pragma unroll
    for (int j = 0; j < 4; ++j) {
      const int m = mb + j * 16 + l15;
      const int b = m >> 8, c = m & 255;
#pragma unroll
      for (int i = 0; i < 4; ++i)
#pragma unroll
        for (int r = 0; r < 4; ++r) {
          const int d = i * 16 + quad * 4 + r;
          vct[((size_t)(b * 2 + g) * 64 + d) * 256 + c] = f2bf(acc.v[i][j][r]);
        }
    }
  }
}

DEV void p3_attn(const Params& p, int item, u16* sK, u16* sVt) {
  const int tid = threadIdx.x, lane = tid & 63, wave = tid >> 6, l15 = lane & 15, quad = lane >> 4;
  const int n = item & 31, h = (item >> 5) & 7, b = item >> 8;
  const int g = h >> 2;
  const u16* Q = (const u16*)(p.ws + OFF_Q) + ((size_t)(b * 8 + h) * 4096 + n * 128 + wave * 32) * 64;
  bf16x8 bq[2][2];
#pragma unroll
  for (int qt = 0; qt < 2; ++qt)
#pragma unroll
    for (int ks = 0; ks < 2; ++ks) bq[qt][ks] = *(const bf16x8*)(Q + (qt * 16 + l15) * 64 + ks * 32 + quad * 8);
  const float sink = p.attn_sink[h];
  float mrun[2] = {sink, sink};
  float lrun[2];
  lrun[0] = lrun[1] = (quad == 0) ? 1.f : 0.f;
  f32x4 O[4][2];
#pragma unroll
  for (int dt = 0; dt < 4; ++dt)
#pragma unroll
    for (int qt = 0; qt < 2; ++qt) O[dt][qt] = (f32x4){0.f, 0.f, 0.f, 0.f};

  u32x4 pk[4], pv[4];
#define ATT_LOAD(KB)                                                                                  \
  {                                                                                                   \
    const u16* Ksrc; const u16* Vsrc; int vstride;                                                    \
    if ((KB) < 3) {                                                                                   \
      const int nbk = n + (KB) - 1;                                                                   \
      Ksrc = (const u16*)(p.ws + OFF_K) + ((size_t)(b * 2 + g) * 4096 + nbk * 128) * 64;              \
      Vsrc = (const u16*)(p.ws + OFF_VT) + (size_t)(b * 2 + g) * 64 * 4096 + nbk * 128;               \
      vstride = 4096;                                                                                 \
    } else {                                                                                          \
      const int cb = (KB) - 3;                                                                        \
      Ksrc = (const u16*)(p.ws + OFF_KC) + ((size_t)(b * 2 + g) * 256 + cb * 128) * 64;               \
      Vsrc = (const u16*)(p.ws + OFF_VCT) + (size_t)(b * 2 + g) * 64 * 256 + cb * 128;                \
      vstride = 256;                                                                                  \
    }                                                                                                 \
    _Pragma("unroll") for (int i = 0; i < 4; ++i) {                                                   \
      const int id = tid + i * 256;                                                                   \
      pk[i] = *(const u32x4*)(Ksrc + (id >> 3) * 64 + (id & 7) * 8);                                  \
      pv[i] = *(const u32x4*)(Vsrc + (size_t)(id >> 4) * vstride + (id & 15) * 8);                    \
    }                                                                                                 \
  }
  int kb = (n == 0) ? 1 : 0;
  ATT_LOAD(kb)
  while (kb < 5) {
#pragma unroll
    for (int i = 0; i < 4; ++i) {
      const int id = tid + i * 256;
      *(u32x4*)(sK + (id >> 3) * 72 + (id & 7) * 8) = pk[i];
      *(u32x4*)(sVt + (id >> 4) * 136 + (id & 15) * 8) = pv[i];
    }
    __syncthreads();
    int nx = kb + 1;
    if (nx == 2 && n == 31) nx = 3;
    if (nx < 5) ATT_LOAD(nx)
#pragma unroll 1
    for (int c4 = 0; c4 < 4; ++c4) {
      f32x4 s[2][2];
#pragma unroll
      for (int kt = 0; kt < 2; ++kt) {
        bf16x8 ak0 = *(const bf16x8*)(sK + (c4 * 32 + kt * 16 + l15) * 72 + quad * 8);
        bf16x8 ak1 = *(const bf16x8*)(sK + (c4 * 32 + kt * 16 + l15) * 72 + 32 + quad * 8);
#pragma unroll
        for (int qt = 0; qt < 2; ++qt) {
          f32x4 z = (f32x4){0.f, 0.f, 0.f, 0.f};
          z = __builtin_amdgcn_mfma_f32_16x16x32_bf16(ak0, bq[qt][0], z, 0, 0, 0);
          z = __builtin_amdgcn_mfma_f32_16x16x32_bf16(ak1, bq[qt][1], z, 0, 0, 0);
          s[kt][qt] = z;
        }
      }
      if (kb == 0 || kb == 2) {
#pragma unroll
        for (int kt = 0; kt < 2; ++kt)
#pragma unroll
          for (int qt = 0; qt < 2; ++qt)
#pragma unroll
            for (int r = 0; r < 4; ++r) {
              const int kk = c4 * 32 + kt * 16 + quad * 4 + r;
              const int qq = wave * 32 + qt * 16 + l15;
              const bool valid = (kb == 0) ? (kk >= qq) : (kk <= qq);
              if (!valid) s[kt][qt][r] = -INFINITY;
            }
      }
      bf16x8 bp[2];
#pragma unroll
      for (int qt = 0; qt < 2; ++qt) {
        float cm = fmaxf(fmaxf(fmaxf(s[0][qt][0], s[0][qt][1]), fmaxf(s[0][qt][2], s[0][qt][3])),
                         fmaxf(fmaxf(s[1][qt][0], s[1][qt][1]), fmaxf(s[1][qt][2], s[1][qt][3])));
        cm = fmaxf(cm, __shfl_xor(cm, 16));
        cm = fmaxf(cm, __shfl_xor(cm, 32));
        const float mnew = fmaxf(mrun[qt], cm);
        const float alpha = __expf(mrun[qt] - mnew);
        mrun[qt] = mnew;
        float ps = 0.f;
        float pv[8];
#pragma unroll
        for (int r = 0; r < 4; ++r) {
          pv[r] = __expf(s[0][qt][r] - mnew);
          pv[4 + r] = __expf(s[1][qt][r] - mnew);
          ps += pv[r] + pv[4 + r];
        }
        lrun[qt] = lrun[qt] * alpha + ps;
#pragma unroll
        for (int dt = 0; dt < 4; ++dt) {
          O[dt][qt][0] *= alpha; O[dt][qt][1] *= alpha; O[dt][qt][2] *= alpha; O[dt][qt][3] *= alpha;
        }
        union { bf16x8 v; unsigned u[4]; } pk;
        pk.u[0] = pack2(pv[0], pv[1]); pk.u[1] = pack2(pv[2], pv[3]);
        pk.u[2] = pack2(pv[4], pv[5]); pk.u[3] = pack2(pv[6], pv[7]);
        bp[qt] = pk.v;
      }
#pragma unroll
      for (int dt = 0; dt < 4; ++dt) {
        union { bf16x8 v; uint2 h[2]; } av;
        const u16* vrow = sVt + (dt * 16 + l15) * 136 + c4 * 32 + quad * 4;
        av.h[0] = *(const uint2*)(vrow);
        av.h[1] = *(const uint2*)(vrow + 16);
#pragma unroll
        for (int qt = 0; qt < 2; ++qt) O[dt][qt] = __builtin_amdgcn_mfma_f32_16x16x32_bf16(av.v, bp[qt], O[dt][qt], 0, 0, 0);
      }
    }
    __syncthreads();
    kb = nx;
  }
  u16* Y = (u16*)(p.ws + OFF_YATT);
#pragma unroll
  for (int qt = 0; qt < 2; ++qt) {
    float l = lrun[qt];
    l += __shfl_xor(l, 16);
    l += __shfl_xor(l, 32);
    const float inv = __builtin_amdgcn_rcpf(l);
    const int t = b * 4096 + n * 128 + wave * 32 + qt * 16 + l15;
#pragma unroll
    for (int dt = 0; dt < 4; ++dt) {
      f32x4 o = O[dt][qt];
      *(uint2*)(Y + (size_t)t * 512 + h * 64 + dt * 16 + quad * 4) = make_uint2(pack2(o[0] * inv, o[1] * inv), pack2(o[2] * inv, o[3] * inv));
    }
  }
}

DEV void p3_hypre(const Params& p, int item, u16* sm) {
  const int tid = threadIdx.x;
  const int cb = item & 3, tb = (item >> 2) & 63, b = item >> 8;
  const int tq = tid >> 6, ch2 = tid & 63;
  const int c = cb * 128 + ch2 * 2;
  u16* su = sm;
  u16* sx = sm + 128 * 66;
  float w[3][3][2], bias[3][2];
#pragma unroll
  for (int s = 0; s < 3; ++s) {
#pragma unroll
    for (int k = 0; k < 3; ++k) {
      const float2 wv = *(const float2*)(p.hy_conv_w + k * 1536 + s * 512 + c);
      w[s][k][0] = wv.x; w[s][k][1] = wv.y;
    }
    const float2 bv = *(const float2*)(p.hy_conv_b + s * 512 + c);
    bias[s][0] = bv.x; bias[s][1] = bv.y;
  }
  const u16* Z = (const u16*)(p.ws + OFF_Z) + (size_t)b * 4096 * 1536;
  const int l0 = tb * 64 + tq * 16;
  unsigned zr[18][3];
#pragma unroll
  for (int i = 0; i < 18; ++i) {
    const int l = l0 - 1 + i;
    const bool ok = (l >= 0) && (l < 4096);
    const int lc = ok ? l : l0;
#pragma unroll
    for (int s2 = 0; s2 < 3; ++s2) {
      const unsigned v = *(const unsigned*)(Z + (size_t)lc * 1536 + s2 * 512 + c);
      zr[i][s2] = ok ? v : 0u;
    }
  }
#pragma unroll
  for (int i = 0; i < 16; ++i) {
    float cv0[3], cv1[3];
#pragma unroll
    for (int s2 = 0; s2 < 3; ++s2) {
      cv0[s2] = bflo(zr[i][s2]) * w[s2][0][0] + bflo(zr[i + 1][s2]) * w[s2][1][0] + bflo(zr[i + 2][s2]) * w[s2][2][0] + bias[s2][0];
      cv1[s2] = bfhi(zr[i][s2]) * w[s2][0][1] + bfhi(zr[i + 1][s2]) * w[s2][1][1] + bfhi(zr[i + 2][s2]) * w[s2][2][1] + bias[s2][1];
    }
    su[(ch2 * 2) * 66 + tq * 16 + i] = f2bf(cv0[2] * cv0[1]);
    su[(ch2 * 2 + 1) * 66 + tq * 16 + i] = f2bf(cv1[2] * cv1[1]);
    sx[(ch2 * 2) * 66 + tq * 16 + i] = f2bf(cv0[0]);
    sx[(ch2 * 2 + 1) * 66 + tq * 16 + i] = f2bf(cv1[0]);
  }
  __syncthreads();
  const int chr = tid >> 1, part = tid & 1;
  const int cc = cb * 128 + chr;
  const unsigned* ru = (const unsigned*)(su + chr * 66 + part * 32);
  const unsigned* rx = (const unsigned*)(sx + chr * 66 + part * 32);
  u16* UT = (u16*)((char*)p.out + OO_UT) + ((size_t)(cc * 4 + b) * 4096 + tb * 64 + part * 32);
  u16* XT = (u16*)((char*)p.out + OO_X0T) + ((size_t)(cc * 4 + b) * 4096 + tb * 64 + part * 32);
#pragma unroll
  for (int q = 0; q < 4; ++q) {
    ((uint4*)UT)[q] = make_uint4(ru[4 * q], ru[4 * q + 1], ru[4 * q + 2], ru[4 * q + 3]);
    ((uint4*)XT)[q] = make_uint4(rx[4 * q], rx[4 * q + 1], rx[4 * q + 2], rx[4 * q + 3]);
  }
  __syncthreads();
}

DEV void p3_toeplitz(const Params& p, int c, char* smem) {
  const int tid = threadIdx.x, lane = tid & 63, wave = tid >> 6, l15 = lane & 15, quad = lane >> 4;
  u16* sG0 = (u16*)smem;
  u16* sG1 = (u16*)(smem + 16384 + 64);
  u16* sU = (u16*)(smem + 32768 + 128);
  u16* sZ = sU + 4 * 64 * 72;
  const u16* G = (const u16*)((const char*)p.out + OO_G) + (size_t)c * 8192;
  const u16* UT = (const u16*)((const char*)p.out + OO_UT) + (size_t)c * 16384;
#pragma unroll
  for (int i = 0; i < 4; ++i) {
    const int id = tid + i * 256;
    *(uint4*)(sG0 + id * 8) = *(const uint4*)(G + id * 8);
  }
#pragma unroll
  for (int i = 0; i < 8; ++i) {
    const int id = tid + i * 256;
    const int bb = id >> 9, blk = (id >> 3) & 63, c8 = id & 7;
    *(uint4*)(sU + (bb * 64 + blk) * 72 + c8 * 8) = *(const uint4*)(UT + id * 8);
  }
  if (tid < 72) sZ[tid] = 0;
  __syncthreads();
  for (int i = tid; i < 8192; i += 256) sG1[i] = (i < 8191) ? sG0[i + 1] : (u16)0;
  __syncthreads();

  Acc acc; acc_zero(acc);
  const u16* gbase = (l15 & 1) ? sG0 : (sG1 - 1);
  const u16* ubase = sU + wave * 64 * 72 + quad * 8;
  const u16* zbase = sZ + quad * 8;
#define TOEP_LOADA(AF, D)                                                                 \
  {                                                                                       \
    const int base_ = 4095 - 64 * (D) - l15 + quad * 8;                                   \
    _Pragma("unroll") for (int mt = 0; mt < 4; ++mt)                                      \
      _Pragma("unroll") for (int ks = 0; ks < 2; ++ks) {                                  \
        const unsigned* gp = (const unsigned*)(gbase + base_ - mt * 16 + ks * 32);        \
        union { bf16x8 v; unsigned u[4]; } t_;                                            \
        t_.u[0] = gp[0]; t_.u[1] = gp[1]; t_.u[2] = gp[2]; t_.u[3] = gp[3];               \
        AF[mt][ks] = t_.v;                                                                \
      }                                                                                   \
  }
#define TOEP_MMA(AF, D)                                                                   \
  _Pragma("unroll") for (int nt = 0; nt < 4; ++nt) {                                      \
    if (!(nt * 16 + 15 - (D) < 0 || nt * 16 - (D) > 63)) {                                \
      const int ip = nt * 16 + l15 - (D);                                                 \
      const u16* up = (ip >= 0 && ip < 64) ? (ubase + ip * 72) : zbase;                   \
      bf16x8 b0 = *(const bf16x8*)(up);                                                   \
      bf16x8 b1 = *(const bf16x8*)(up + 32);                                              \
      _Pragma("unroll") for (int mt = 0; mt < 4; ++mt) {                                  \
        acc.v[mt][nt] = __builtin_amdgcn_mfma_f32_16x16x32_bf16(AF[mt][0], b0, acc.v[mt][nt], 0, 0, 0); \
        acc.v[mt][nt] = __builtin_amdgcn_mfma_f32_16x16x32_bf16(AF[mt][1], b1, acc.v[mt][nt], 0, 0, 0); \
      }                                                                                   \
    }                                                                                     \
  }
  {
    bf16x8 afA[4][2], afB[4][2];
    TOEP_LOADA(afA, -63)
#pragma unroll 1
    for (int d = -63; d <= 63; d += 2) {
      if (d + 1 <= 63) TOEP_LOADA(afB, d + 1)
      TOEP_MMA(afA, d)
      if (d + 1 <= 63) {
        if (d + 2 <= 63) TOEP_LOADA(afA, d + 2)
        TOEP_MMA(afB, d + 1)
      }
    }
  }
  const float ninv = 1.f / ((const float*)(p.ws + OFF_BAR + 20480))[c];
  const float skip = p.hy_skip[c];
  const u16* XT = (const u16*)((const char*)p.out + OO_X0T) + ((size_t)(c * 4 + wave) * 4096);
  u16* Y = (u16*)(p.ws + OFF_YHY);
#pragma unroll
  for (int nt = 0; nt < 4; ++nt) {
    const int ib = nt * 16 + l15;
#pragma unroll
    for (int mt = 0; mt < 4; ++mt) {
      const int r0 = mt * 16 + quad * 4;
      const int t = ib * 64 + r0;
      uint2 uu = *(const uint2*)(sU + (wave * 64 + ib) * 72 + r0);
      uint2 xx = *(const uint2*)(XT + t);
      float uv[4] = {bflo(uu.x), bfhi(uu.x), bflo(uu.y), bfhi(uu.y)};
      float xv[4] = {bflo(xx.x), bfhi(xx.x), bflo(xx.y), bfhi(xx.y)};
#pragma unroll
      for (int r = 0; r < 4; ++r) {
        float y = acc.v[mt][nt][r] * ninv + uv[r] * skip;
        Y[(size_t)(wave * 4096 + t + r) * 512 + c] = f2bf(y * xv[r]);
      }
    }
  }
  __syncthreads();
}

DEV void p4_merge(const Params& p, int tile, u16* sA, u16* sB) {
  const int mt = tile >> 3, nt = tile & 7;
  const int m0 = mt * 128, n0 = nt * 128;
  const int tid = threadIdx.x, lane = tid & 63, wave = tid >> 6, wm = wave >> 1, wn = wave & 1;
  const int l15 = lane & 15, quad = lane >> 4;
  const int mb = m0 + wm * 64, nb = n0 + wn * 64;
  const u16* gt = (const u16*)(p.ws + OFF_GATE);
  u16* mg = (u16*)(p.ws + OFF_MERGED);
  Acc a1; acc_zero(a1);
  gemm_kloop((const u16*)(p.ws + OFF_YATT), 512, (const u16*)(p.ws + OFF_WOA), 512, 512, m0, n0, sA, sB, a1);
  asm volatile("" ::: "memory");
#pragma unroll
  for (int j = 0; j < 4; ++j) {
    const int m = mb + j * 16 + l15;
#pragma unroll
    for (int i = 0; i < 4; ++i) {
      const int n = nb + i * 16 + quad * 4;
      uint2 ga = *(const uint2*)(gt + (size_t)m * 2048 + n);
      f32x4 x = a1.v[i][j];
      *(uint2*)(mg + (size_t)m * 1024 + n) = make_uint2(pack2(bflo(ga.x) * x[0], bfhi(ga.x) * x[1]), pack2(bflo(ga.y) * x[2], bfhi(ga.y) * x[3]));
    }
  }
  asm volatile("" ::: "memory");
  acc_zero(a1);
  gemm_kloop((const u16*)(p.ws + OFF_YHY), 512, (const u16*)(p.ws + OFF_WOH), 512, 512, m0, n0, sA, sB, a1);
  asm volatile("" ::: "memory");
#pragma unroll
  for (int j = 0; j < 4; ++j) {
    const int m = mb + j * 16 + l15;
#pragma unroll
    for (int i = 0; i < 4; ++i) {
      const int n = nb + i * 16 + quad * 4;
      uint2 gh = *(const uint2*)(gt + (size_t)m * 2048 + 1024 + n);
      uint2 pv = *(const uint2*)(mg + (size_t)m * 1024 + n);
      f32x4 y = a1.v[i][j];
      float o0 = bflo(pv.x) + bflo(gh.x) * y[0];
      float o1 = bfhi(pv.x) + bfhi(gh.x) * y[1];
      float o2 = bflo(pv.y) + bflo(gh.y) * y[2];
      float o3 = bfhi(pv.y) + bfhi(gh.y) * y[3];
      *(uint2*)(mg + (size_t)m * 1024 + n) = make_uint2(pack2(o0, o1), pack2(o2, o3));
    }
  }
}

DEV void p5_out(const Params& p, int tile, u16* sA, u16* sB) {
  const int mt = tile >> 3, nt = tile & 7;
  const int m0 = mt * 128, n0 = nt * 128;
  Acc acc; acc_zero(acc);
  gemm_kloop((const u16*)(p.ws + OFF_MERGED), 1024, (const u16*)(p.ws + OFF_WOUT), 1024, 1024, m0, n0, sA, sB, acc);
  const int tid = threadIdx.x, lane = tid & 63, wave = tid >> 6, wm = wave >> 1, wn = wave & 1;
  const int l15 = lane & 15, quad = lane >> 4;
  const int mb = m0 + wm * 64, nb = n0 + wn * 64;
  const float* mod = (const float*)(p.ws + OFF_MOD);
#pragma unroll
  for (int j = 0; j < 4; ++j) {
    const int m = mb + j * 16 + l15;
    const int b = m >> 12;
#pragma unroll
    for (int i = 0; i < 4; ++i) {
      const int n = nb + i * 16 + quad * 4;
      float4 g1 = *(const float4*)(mod + b * 6144 + 2048 + n);
      float4 xv = *(const float4*)(p.x + (size_t)m * 1024 + n);
      f32x4 a = acc.v[i][j];
      float4 o = make_float4(xv.x + g1.x * a[0], xv.y + g1.y * a[1], xv.z + g1.z * a[2], xv.w + g1.w * a[3]);
      *(float4*)(p.out + (size_t)m * 1024 + n) = o;
    }
  }
}

DEV void p7_qp(const Params& p, int tile, u16* sA, u16* sB) {
  const int mt = tile >> 3, nt = tile & 7;
  const int m0 = mt * 128, n0 = nt * 128;
  Acc acc; acc_zero(acc);
  gemm_kloop((const u16*)(p.ws + OFF_H2), 1024, (const u16*)(p.ws + OFF_WQ), 1024, 1024, m0, n0, sA, sB, acc);
  const int tid = threadIdx.x, lane = tid & 63, wave = tid >> 6, wm = wave >> 1, wn = wave & 1;
  const int l15 = lane & 15, quad = lane >> 4;
  const int mb = m0 + wm * 64, nb = n0 + wn * 64;
  u16* qp = (u16*)(p.ws + OFF_QP);
#pragma unroll
  for (int j = 0; j < 4; ++j) {
    const int m = mb + j * 16 + l15;
#pragma unroll
    for (int i = 0; i < 4; ++i) {
      const int n = nb + i * 16 + quad * 4;
      f32x4 a = acc.v[i][j];
      *(uint2*)(qp + (size_t)m * 1024 + n) = make_uint2(pack2(a[0], a[1]), pack2(a[2], a[3]));
    }
  }
}

DEV unsigned f2ord(float f) {
  const unsigned u = __float_as_uint(f);
  return u ^ (((int)u >> 31) | 0x80000000u);
}
DEV float ord2f(unsigned k) {
  const unsigned m = (k & 0x80000000u) ? 0x80000000u : 0xffffffffu;
  return __uint_as_float(k ^ m);
}
DEV unsigned umax_(unsigned a, unsigned b) { return a > b ? a : b; }
DEV unsigned umin_(unsigned a, unsigned b) { return a < b ? a : b; }

DEV void sort16_desc(unsigned (&v)[16]) {
#pragma unroll
  for (int k = 2; k <= 16; k <<= 1)
#pragma unroll
    for (int j = k >> 1; j > 0; j >>= 1)
#pragma unroll
      for (int i = 0; i < 16; ++i) {
        const int l = i ^ j;
        if (l > i) {
          const bool desc = ((i & k) == 0);
          const unsigned a = v[i], b = v[l];
          const unsigned hi = umax_(a, b), lo = umin_(a, b);
          v[i] = desc ? hi : lo;
          v[l] = desc ? lo : hi;
        }
      }
}
DEV void merge16_desc(unsigned (&v)[16]) {
#pragma unroll
  for (int j = 8; j > 0; j >>= 1)
#pragma unroll
    for (int i = 0; i < 16; ++i) {
      const int l = i ^ j;
      if (l > i) {
        const unsigned a = v[i], b = v[l];
        v[i] = umax_(a, b);
        v[l] = umin_(a, b);
      }
    }
}
DEV void xmerge16(unsigned (&v)[16], int off) {
  unsigned pr[16];
#pragma unroll
  for (int i = 0; i < 16; ++i) pr[i] = (unsigned)__shfl_xor((int)v[i], off);
#pragma unroll
  for (int i = 0; i < 16; ++i) v[i] = umax_(v[i], pr[15 - i]);
  merge16_desc(v);
}

DEV void route_top16_of_128(const u16* __restrict__ keys, const u16* __restrict__ qp, int l15, int quad, unsigned (&out)[16]) {
  bf16x8 b0 = *(const bf16x8*)(qp);
  bf16x8 b1 = *(const bf16x8*)(qp + 32);
  unsigned ka[16], kb[16];
#pragma unroll
  for (int kt = 0; kt < 8; ++kt) {
    bf16x8 a0 = *(const bf16x8*)(keys + (kt * 16 + l15) * 64 + quad * 8);
    bf16x8 a1 = *(const bf16x8*)(keys + (kt * 16 + l15) * 64 + 32 + quad * 8);
    f32x4 z = (f32x4){0.f, 0.f, 0.f, 0.f};
    z = __builtin_amdgcn_mfma_f32_16x16x32_bf16(a0, b0, z, 0, 0, 0);
    z = __builtin_amdgcn_mfma_f32_16x16x32_bf16(a1, b1, z, 0, 0, 0);
#pragma unroll
    for (int r = 0; r < 4; ++r) {
      const unsigned key = (f2ord(z[r]) & ~127u) | (unsigned)(kt * 16 + quad * 4 + r);
      if (kt < 4) ka[kt * 4 + r] = key; else kb[(kt - 4) * 4 + r] = key;
    }
  }
  sort16_desc(ka);
  sort16_desc(kb);
#pragma unroll
  for (int i = 0; i < 16; ++i) out[i] = umax_(ka[i], kb[15 - i]);
  merge16_desc(out);
  xmerge16(out, 16);
  xmerge16(out, 32);
}

__device__ const unsigned char kTabG[52] = {
    0x00, 0x01, 0x02, 0x03, 0x04, 0x05, 0x06, 0x07, 0x08, 0x09, 0x0A, 0x0B, 0x0C, 0x0D, 0x0E, 0x0F,
    0x10, 0x11, 0x12, 0x13, 0x14, 0x15, 0x16, 0x17, 0x20, 0x21, 0x22, 0x23, 0x24, 0x30, 0x31, 0x32, 0x33,
    0x40, 0x41, 0x42, 0x50, 0x51, 0x60, 0x61, 0x70, 0x71, 0x80, 0x90, 0xA0, 0xB0, 0xC0, 0xD0, 0xE0, 0xF0, 0x00, 0x00};

DEV void p8_route(const Params& p, int task, char* wsm, const unsigned char* kTab) {
  const int lane = threadIdx.x & 63, l15 = lane & 15, quad = lane >> 4;
  const int h = task & 7, tt = task >> 3;
  const int t0 = tt * 16;
  float* s1v = (float*)wsm;
  float* s2v = s1v + 256;
  int* i1 = (int*)(s2v + 256);
  int* i2 = i1 + 256;
  const u16* keys = (const u16*)(p.ws + OFF_KEYS) + (size_t)(h * 2) * 128 * 64;
  const u16* qp = (const u16*)(p.ws + OFF_QP) + (size_t)(t0 + l15) * 1024 + h * 128 + quad * 8;
  unsigned l1[16], l2[16];
  route_top16_of_128(keys, qp, l15, quad, l1);
  route_top16_of_128(keys + 128 * 64, qp + 64, l15, quad, l2);
  if (quad == 0) {
#pragma unroll
    for (int i = 0; i < 16; ++i) { s1v[l15 * 16 + i] = ord2f(l1[i] & ~127u); i1[l15 * 16 + i] = (int)(l1[i] & 127u); }
  } else if (quad == 1) {
#pragma unroll
    for (int i = 0; i < 16; ++i) { s2v[l15 * 16 + i] = ord2f(l2[i] & ~127u); i2[l15 * 16 + i] = (int)(l2[i] & 127u); }
  }
  __builtin_amdgcn_fence(__ATOMIC_RELEASE, "wavefront");
  __builtin_amdgcn_wave_barrier();
  __builtin_amdgcn_fence(__ATOMIC_ACQUIRE, "wavefront");
  unsigned ck[16];
#pragma unroll
  for (int s = 0; s < 16; ++s) {
    const int c = quad + 4 * s;
    unsigned key = 0u;
    if (s < 13 && c < 50) {
      const unsigned ab = kTab[c];
      const float val = s1v[l15 * 16 + (ab >> 4)] + s2v[l15 * 16 + (ab & 15)];
      key = (f2ord(val) & ~255u) | ab;
    }
    ck[s] = key;
  }
  sort16_desc(ck);
  xmerge16(ck, 16);
  xmerge16(ck, 32);
  if (quad == 0) {
    float e[16];
    const float vmax = ord2f(ck[0] & ~255u);
    float ssum = 0.f;
#pragma unroll
    for (int i = 0; i < 16; ++i) { e[i] = __expf(ord2f(ck[i] & ~255u) - vmax); ssum += e[i]; }
    const float inv = __builtin_amdgcn_rcpf(ssum);
    int* ridx = (int*)(p.ws + OFF_RIDX) + (size_t)(t0 + l15) * 128 + h * 16;
    float* rw = (float*)(p.ws + OFF_RW) + (size_t)(t0 + l15) * 128 + h * 16;
#pragma unroll
    for (int i = 0; i < 16; i += 4) {
      int ee[4]; float ww[4];
#pragma unroll
      for (int j = 0; j < 4; ++j) {
        const unsigned ab = ck[i + j] & 255u;
        ee[j] = i1[l15 * 16 + (ab >> 4)] * 128 + i2[l15 * 16 + (ab & 15)];
        ww[j] = e[i + j] * inv;
      }
      *(int4*)(ridx + i) = make_int4(ee[0], ee[1], ee[2], ee[3]);
      *(float4*)(rw + i) = make_float4(ww[0], ww[1], ww[2], ww[3]);
    }
  }
  __builtin_amdgcn_fence(__ATOMIC_RELEASE, "wavefront");
  __builtin_amdgcn_wave_barrier();
}

DEV float gelu_tanh(float x) {
  const float u2 = 1.5957691216057308f * (x + 0.044715f * x * x * x);
  return x * __builtin_amdgcn_rcpf(1.f + __expf(-u2));
}

DEV void unpack8(const uint4& q, float* f) {
  f[0] = bflo(q.x); f[1] = bfhi(q.x); f[2] = bflo(q.y); f[3] = bfhi(q.y);
  f[4] = bflo(q.z); f[5] = bfhi(q.z); f[6] = bflo(q.w); f[7] = bfhi(q.w);
}

DEV float dpp_add(float v, const int ctrl_sel) {
  return v;
}
typedef __attribute__((ext_vector_type(2))) __bf16 bf2_t;
DEV float dot2bf(unsigned a, unsigned b, float c) {
  return __builtin_amdgcn_fdot2_f32_bf16(__builtin_bit_cast(bf2_t, a), __builtin_bit_cast(bf2_t, b), c, false);
}

DEV float reduce4_rows(float d0, float d1, float d2, float d3, int lane) {
  const bool up32 = (lane & 32) != 0, up16 = (lane & 16) != 0;
  float k0 = up32 ? d2 : d0, k1 = up32 ? d3 : d1;
  const float s0 = up32 ? d0 : d2, s1 = up32 ? d1 : d3;
  k0 += __shfl_xor(s0, 32);
  k1 += __shfl_xor(s1, 32);
  float kq = up16 ? k1 : k0;
  const float sq = up16 ? k0 : k1;
  kq += __shfl_xor(sq, 16);
  kq = DPP_ADD(kq, 0xB1);
  kq = DPP_ADD(kq, 0x4E);
  kq = DPP_ADD(kq, 0x141);
  kq = DPP_ADD(kq, 0x140);
  return kq;
}

DEV void p9_token(const Params& p, int t, int tnext, int lane, int2& e2n, float2& w2n, u32x4& han, u32x4& hbn) {
  const unsigned char* U8 = (const unsigned char*)(p.ws + OFF_UBF);
  const unsigned char* V8 = (const unsigned char*)(p.ws + OFF_VBF);
  const int2 e2 = e2n;
  const float2 w2 = w2n;
  const u32x4 ha = han, hb = hbn;
  {
    e2n = *(const int2*)((const int*)(p.ws + OFF_RIDX) + (size_t)tnext * 128 + 2 * lane);
    w2n = *(const float2*)((const float*)(p.ws + OFF_RW) + (size_t)tnext * 128 + 2 * lane);
    const u16* h2 = (const u16*)(p.ws + OFF_H2) + (size_t)tnext * 1024 + 16 * lane;
    han = *(const u32x4*)(h2);
    hbn = *(const u32x4*)(h2 + 8);
  }
  float hf[16];
  hf[0] = bflo(ha.x); hf[1] = bfhi(ha.x); hf[2] = bflo(ha.y); hf[3] = bfhi(ha.y);
  hf[4] = bflo(ha.z); hf[5] = bfhi(ha.z); hf[6] = bflo(ha.w); hf[7] = bfhi(ha.w);
  hf[8] = bflo(hb.x); hf[9] = bfhi(hb.x); hf[10] = bflo(hb.y); hf[11] = bfhi(hb.y);
  hf[12] = bflo(hb.z); hf[13] = bfhi(hb.z); hf[14] = bflo(hb.w); hf[15] = bfhi(hb.w);
  float o[16];
#pragma unroll
  for (int k = 0; k < 16; ++k) o[k] = 0.f;
#pragma unroll 1
  for (int g = 0; g < 128; g += 16) {
    u32x4 uu[16], vv[16];
    float wj[16];
#pragma unroll
    for (int j = 0; j < 16; ++j) {
      const int src = (g >> 1) + (j >> 1);
      const int ej = (j & 1) ? __builtin_amdgcn_readlane(e2.y, src) : __builtin_amdgcn_readlane(e2.x, src);
      wj[j] = __builtin_bit_cast(float, (j & 1) ? __builtin_amdgcn_readlane(__builtin_bit_cast(int, w2.y), src)
                                                : __builtin_amdgcn_readlane(__builtin_bit_cast(int, w2.x), src));
      const size_t ro = (size_t)ej * 1024 + 16 * lane;
      uu[j] = *(const u32x4*)(U8 + ro);
      vv[j] = *(const u32x4*)(V8 + ro);
    }
    float d[16];
#pragma unroll
    for (int j = 0; j < 16; ++j) {
      const f32x2 l0 = __builtin_amdgcn_cvt_pk_f32_fp8((int)uu[j].x, false), h0 = __builtin_amdgcn_cvt_pk_f32_fp8((int)uu[j].x, true);
      const f32x2 l1 = __builtin_amdgcn_cvt_pk_f32_fp8((int)uu[j].y, false), h1 = __builtin_amdgcn_cvt_pk_f32_fp8((int)uu[j].y, true);
      const f32x2 l2 = __builtin_amdgcn_cvt_pk_f32_fp8((int)uu[j].z, false), h2v = __builtin_amdgcn_cvt_pk_f32_fp8((int)uu[j].z, true);
      const f32x2 l3 = __builtin_amdgcn_cvt_pk_f32_fp8((int)uu[j].w, false), h3 = __builtin_amdgcn_cvt_pk_f32_fp8((int)uu[j].w, true);
      float a0 = l0.x * hf[0] + l0.y * hf[1], a1 = h0.x * hf[2] + h0.y * hf[3];
      a0 += l1.x * hf[4] + l1.y * hf[5]; a1 += h1.x * hf[6] + h1.y * hf[7];
      a0 += l2.x * hf[8] + l2.y * hf[9]; a1 += h2v.x * hf[10] + h2v.y * hf[11];
      a0 += l3.x * hf[12] + l3.y * hf[13]; a1 += h3.x * hf[14] + h3.y * hf[15];
      d[j] = a0 + a1;
    }
#pragma unroll
    for (int q = 0; q < 4; ++q) {
      const float dot = reduce4_rows(d[4 * q], d[4 * q + 1], d[4 * q + 2], d[4 * q + 3], lane);
      const float gl = gelu_tanh(dot * (1.f / 512.f)) * (1.f / 64.f);
#pragma unroll
      for (int i = 0; i < 4; ++i) {
        const int j = 4 * q + i;
        const float ci = wj[j] * __builtin_bit_cast(float, __builtin_amdgcn_readlane(__builtin_bit_cast(int, gl), 16 * i));
        f32x2 tq;
        tq = __builtin_amdgcn_cvt_pk_f32_fp8((int)vv[j].x, false); o[0] += ci * tq.x; o[1] += ci * tq.y;
        tq = __builtin_amdgcn_cvt_pk_f32_fp8((int)vv[j].x, true);  o[2] += ci * tq.x; o[3] += ci * tq.y;
        tq = __builtin_amdgcn_cvt_pk_f32_fp8((int)vv[j].y, false); o[4] += ci * tq.x; o[5] += ci * tq.y;
        tq = __builtin_amdgcn_cvt_pk_f32_fp8((int)vv[j].y, true);  o[6] += ci * tq.x; o[7] += ci * tq.y;
        tq = __builtin_amdgcn_cvt_pk_f32_fp8((int)vv[j].z, false); o[8] += ci * tq.x; o[9] += ci * tq.y;
        tq = __builtin_amdgcn_cvt_pk_f32_fp8((int)vv[j].z, true);  o[10] += ci * tq.x; o[11] += ci * tq.y;
        tq = __builtin_amdgcn_cvt_pk_f32_fp8((int)vv[j].w, false); o[12] += ci * tq.x; o[13] += ci * tq.y;
        tq = __builtin_amdgcn_cvt_pk_f32_fp8((int)vv[j].w, true);  o[14] += ci * tq.x; o[15] += ci * tq.y;
      }
    }
  }
  const int b = t >> 12;
  const float* mod = (const float*)(p.ws + OFF_MOD) + b * 6144 + 5120 + 16 * lane;
  float* xm = p.out + (size_t)t * 1024 + 16 * lane;
  float xo[16];
  float ss = 0.f;
#pragma unroll
  for (int q = 0; q < 4; ++q) {
    const float4 xv = *(const float4*)(xm + 4 * q);
    const float4 gv = *(const float4*)(mod + 4 * q);
    xo[4 * q + 0] = xv.x + gv.x * o[4 * q + 0];
    xo[4 * q + 1] = xv.y + gv.y * o[4 * q + 1];
    xo[4 * q + 2] = xv.z + gv.z * o[4 * q + 2];
    xo[4 * q + 3] = xv.w + gv.w * o[4 * q + 3];
  }
#pragma unroll
  for (int k = 0; k < 16; ++k) ss += xo[k] * xo[k];
  ss = wave_sum(ss);
  const float r = rsqrtf(ss * (1.f / 1024.f) + 1e-6f);
#pragma unroll
  for (int q = 0; q < 4; ++q) {
    const float4 fg = *(const float4*)(p.final_g + 16 * lane + 4 * q);
    *(float4*)(xm + 4 * q) = make_float4(xo[4 * q] * r * fg.x, xo[4 * q + 1] * r * fg.y, xo[4 * q + 2] * r * fg.z, xo[4 * q + 3] * r * fg.w);
  }
}

DEV void p9_experts4(const Params& p, int task, char* wsm) {
  const int lane = threadIdx.x & 63;
  const int t0 = task * 4;
  int* hist = (int*)wsm;
  unsigned* skey = (unsigned*)(wsm + 1024);
  float* swt = (float*)(wsm + 1024 + 2048);
  u16* sh2 = (u16*)(wsm + 1024 + 4096);
  hist[lane] = 0; hist[lane + 64] = 0; hist[lane + 128] = 0; hist[lane + 192] = 0;
  const int* ridx = (const int*)(p.ws + OFF_RIDX) + (size_t)t0 * 128 + lane * 8;
  const float* rw = (const float*)(p.ws + OFF_RW) + (size_t)t0 * 128 + lane * 8;
  int4 ea = *(const int4*)(ridx), eb = *(const int4*)(ridx + 4);
  float4 wa = *(const float4*)(rw), wb = *(const float4*)(rw + 4);
  int e[8] = {ea.x, ea.y, ea.z, ea.w, eb.x, eb.y, eb.z, eb.w};
  float w[8] = {wa.x, wa.y, wa.z, wa.w, wb.x, wb.y, wb.z, wb.w};
  {
    const u16* h2 = (const u16*)(p.ws + OFF_H2) + (size_t)t0 * 1024;
#pragma unroll
    for (int i = 0; i < 8; ++i) *(u32x4*)(sh2 + (lane + 64 * i) * 8) = *(const u32x4*)(h2 + (lane + 64 * i) * 8);
  }
  __builtin_amdgcn_fence(__ATOMIC_RELEASE, "wavefront");
  __builtin_amdgcn_wave_barrier();
  __builtin_amdgcn_fence(__ATOMIC_ACQUIRE, "wavefront");
  int rank[8];
#pragma unroll
  for (int j = 0; j < 8; ++j) rank[j] = atomicAdd(&hist[e[j] >> 6], 1);
  __builtin_amdgcn_fence(__ATOMIC_RELEASE, "wavefront");
  __builtin_amdgcn_wave_barrier();
  __builtin_amdgcn_fence(__ATOMIC_ACQUIRE, "wavefront");
  {
    const int c0 = hist[4 * lane], c1 = hist[4 * lane + 1], c2 = hist[4 * lane + 2], c3 = hist[4 * lane + 3];
    const int tot = c0 + c1 + c2 + c3;
    int x = tot;
#pragma unroll
    for (int o = 1; o < 64; o <<= 1) { const int y = __shfl_up(x, o); if (lane >= o) x += y; }
    const int base = x - tot;
    __builtin_amdgcn_fence(__ATOMIC_RELEASE, "wavefront");
    __builtin_amdgcn_wave_barrier();
    hist[4 * lane] = base; hist[4 * lane + 1] = base + c0; hist[4 * lane + 2] = base + c0 + c1; hist[4 * lane + 3] = base + c0 + c1 + c2;
  }
  __builtin_amdgcn_fence(__ATOMIC_RELEASE, "wavefront");
  __builtin_amdgcn_wave_barrier();
  __builtin_amdgcn_fence(__ATOMIC_ACQUIRE, "wavefront");
  {
    const unsigned slot = (unsigned)(lane >> 4);
#pragma unroll
    for (int j = 0; j < 8; ++j) {
      const int pos = hist[e[j] >> 6] + rank[j];
      skey[pos] = (unsigned)e[j] | (slot << 14);
      swt[pos] = w[j];
    }
  }
  __builtin_amdgcn_fence(__ATOMIC_RELEASE, "wavefront");
  __builtin_amdgcn_wave_barrier();
  __builtin_amdgcn_fence(__ATOMIC_ACQUIRE, "wavefront");

  float o0[16], o1[16], o2[16], o3[16];
#pragma unroll
  for (int k = 0; k < 16; ++k) { o0[k] = 0.f; o1[k] = 0.f; o2[k] = 0.f; o3[k] = 0.f; }
  const u16* U = (const u16*)(p.ws + OFF_UBF);
  const u16* V = (const u16*)(p.ws + OFF_VBF);
#define P9_LOAD(KK, UU, VV, BB)                                                           \
  _Pragma("unroll") for (int i = 0; i < 4; ++i) {                                         \
    KK[i] = (unsigned)__builtin_amdgcn_readfirstlane((int)skey[4 * (BB) + i]);            \
    const size_t ro = (size_t)(KK[i] & 16383u) * 1024 + 16 * lane;                        \
    UU[i] = *(const u32x4*)(U8 + ro);                                                     \
    VV[i] = *(const u32x4*)(V8 + ro);                                                     \
  }
#define P9_DOTS(KK, UU, BB, COEFV)                                                        \
  {                                                                                       \
    const float myw = swt[4 * (BB) + (lane >> 4)];                                        \
    float d[4];                                                                           \
    _Pragma("unroll") for (int i = 0; i < 4; ++i) {                                       \
      const unsigned slot = KK[i] >> 14;                                                  \
      const u32x4 ha = *(const u32x4*)(sh2 + slot * 1024 + 16 * lane);                    \
      const u32x4 hb = *(const u32x4*)(sh2 + slot * 1024 + 16 * lane + 8);                \
      float acc0 = 0.f, acc1 = 0.f;                                                       \
      {                                                                                   \
        f32x2 l0 = __builtin_amdgcn_cvt_pk_f32_fp8((int)UU[i].x, false), h0 = __builtin_amdgcn_cvt_pk_f32_fp8((int)UU[i].x, true); \
        f32x2 l1 = __builtin_amdgcn_cvt_pk_f32_fp8((int)UU[i].y, false), h1 = __builtin_amdgcn_cvt_pk_f32_fp8((int)UU[i].y, true); \
        f32x2 l2 = __builtin_amdgcn_cvt_pk_f32_fp8((int)UU[i].z, false), h2_ = __builtin_amdgcn_cvt_pk_f32_fp8((int)UU[i].z, true); \
        f32x2 l3 = __builtin_amdgcn_cvt_pk_f32_fp8((int)UU[i].w, false), h3 = __builtin_amdgcn_cvt_pk_f32_fp8((int)UU[i].w, true); \
        acc0 += l0.x * bflo(ha.x) + l0.y * bfhi(ha.x); acc1 += h0.x * bflo(ha.y) + h0.y * bfhi(ha.y);   \
        acc0 += l1.x * bflo(ha.z) + l1.y * bfhi(ha.z); acc1 += h1.x * bflo(ha.w) + h1.y * bfhi(ha.w);   \
        acc0 += l2.x * bflo(hb.x) + l2.y * bfhi(hb.x); acc1 += h2_.x * bflo(hb.y) + h2_.y * bfhi(hb.y); \
        acc0 += l3.x * bflo(hb.z) + l3.y * bfhi(hb.z); acc1 += h3.x * bflo(hb.w) + h3.y * bfhi(hb.w);   \
      }                                                                                   \
      d[i] = acc0 + acc1;                                                                 \
    }                                                                                     \
    const bool up32 = (lane & 32) != 0, up16 = (lane & 16) != 0;                          \
    float k0 = up32 ? d[2] : d[0], k1 = up32 ? d[3] : d[1];                               \
    float s0 = up32 ? d[0] : d[2], s1 = up32 ? d[1] : d[3];                               \
    k0 += __shfl_xor(s0, 32);                                                             \
    k1 += __shfl_xor(s1, 32);                                                             \
    float kq = up16 ? k1 : k0, sq = up16 ? k0 : k1;                                       \
    kq += __shfl_xor(sq, 16);                                                             \
    kq = DPP_ADD(kq, 0xB1);                                                               \
    kq = DPP_ADD(kq, 0x4E);                                                               \
    kq = DPP_ADD(kq, 0x141);                                                              \
    kq = DPP_ADD(kq, 0x140);                                                              \
    COEFV = myw * (1.f / 64.f) * gelu_tanh(kq * (1.f / 512.f));                           \
  }
#define P9_ACCUM(KK, VV, COEFV)                                                           \
  _Pragma("unroll") for (int i = 0; i < 4; ++i) {                                         \
    const float ci = __builtin_bit_cast(float, __builtin_amdgcn_readlane(__builtin_bit_cast(int, COEFV), 16 * i)); \
    const unsigned slot = KK[i] >> 14;                                                    \
    float vf[16];                                                                         \
    {                                                                                     \
      f32x2 t;                                                                            \
      t = __builtin_amdgcn_cvt_pk_f32_fp8((int)VV[i].x, false); vf[0] = t.x; vf[1] = t.y;   \
      t = __builtin_amdgcn_cvt_pk_f32_fp8((int)VV[i].x, true);  vf[2] = t.x; vf[3] = t.y;   \
      t = __builtin_amdgcn_cvt_pk_f32_fp8((int)VV[i].y, false); vf[4] = t.x; vf[5] = t.y;   \
      t = __builtin_amdgcn_cvt_pk_f32_fp8((int)VV[i].y, true);  vf[6] = t.x; vf[7] = t.y;   \
      t = __builtin_amdgcn_cvt_pk_f32_fp8((int)VV[i].z, false); vf[8] = t.x; vf[9] = t.y;   \
      t = __builtin_amdgcn_cvt_pk_f32_fp8((int)VV[i].z, true);  vf[10] = t.x; vf[11] = t.y; \
      t = __builtin_amdgcn_cvt_pk_f32_fp8((int)VV[i].w, false); vf[12] = t.x; vf[13] = t.y; \
      t = __builtin_amdgcn_cvt_pk_f32_fp8((int)VV[i].w, true);  vf[14] = t.x; vf[15] = t.y; \
    }                                                                                     \
    if (slot == 0) { _Pragma("unroll") for (int k = 0; k < 16; ++k) o0[k] += ci * vf[k]; }       \
    else if (slot == 1) { _Pragma("unroll") for (int k = 0; k < 16; ++k) o1[k] += ci * vf[k]; }  \
    else if (slot == 2) { _Pragma("unroll") for (int k = 0; k < 16; ++k) o2[k] += ci * vf[k]; }  \
    else { _Pragma("unroll") for (int k = 0; k < 16; ++k) o3[k] += ci * vf[k]; }                 \
  }
  {
    const unsigned char* U8 = (const unsigned char*)(p.ws + OFF_UBF);
    const unsigned char* V8 = (const unsigned char*)(p.ws + OFF_VBF);
    unsigned kkA[4], kkB[4];
    u32x4 uA[4], vA[4], uB[4], vB[4];
    float cfA, cfB;
    P9_LOAD(kkA, uA, vA, 0)
#pragma unroll 1
    for (int bb = 0; bb < 128; bb += 2) {
      P9_LOAD(kkB, uB, vB, bb + 1)
      P9_DOTS(kkA, uA, bb, cfA)
      P9_ACCUM(kkA, vA, cfA)
      const int n0 = (bb + 2 < 128) ? (bb + 2) : 0;
      P9_LOAD(kkA, uA, vA, n0)
      P9_DOTS(kkB, uB, bb + 1, cfB)
      P9_ACCUM(kkB, vB, cfB)
    }
  }
#pragma unroll
  for (int s = 0; s < 4; ++s) {
    const int t = t0 + s;
    const int b = t >> 12;
    const float* mod = (const float*)(p.ws + OFF_MOD) + b * 6144 + 5120 + 16 * lane;
    float* xm = p.out + (size_t)t * 1024 + 16 * lane;
    const float* oo = (s == 0) ? o0 : ((s == 1) ? o1 : ((s == 2) ? o2 : o3));
    float xo[16];
    float ss = 0.f;
#pragma unroll
    for (int q = 0; q < 4; ++q) {
      const float4 xv = *(const float4*)(xm + 4 * q);
      const float4 gv = *(const float4*)(mod + 4 * q);
      xo[4 * q + 0] = xv.x + gv.x * oo[4 * q + 0];
      xo[4 * q + 1] = xv.y + gv.y * oo[4 * q + 1];
      xo[4 * q + 2] = xv.z + gv.z * oo[4 * q + 2];
      xo[4 * q + 3] = xv.w + gv.w * oo[4 * q + 3];
    }
#pragma unroll
    for (int k = 0; k < 16; ++k) ss += xo[k] * xo[k];
    ss = wave_sum(ss);
    const float r = rsqrtf(ss * (1.f / 1024.f) + 1e-6f);
#pragma unroll
    for (int q = 0; q < 4; ++q) {
      const float4 fg = *(const float4*)(p.final_g + 16 * lane + 4 * q);
      *(float4*)(xm + 4 * q) = make_float4(xo[4 * q] * r * fg.x, xo[4 * q + 1] * r * fg.y, xo[4 * q + 2] * r * fg.z, xo[4 * q + 3] * r * fg.w);
    }
  }
  __builtin_amdgcn_fence(__ATOMIC_RELEASE, "wavefront");
  __builtin_amdgcn_wave_barrier();
}

#define XB_TMO      128
#define XB_XCNT(j)  (256  + 64 * (j))
#define XB_XSUB(j)  (1280 + 64 * (j))
#define XB_XGEN(j)  (2304 + 64 * (j))
#define XB_TOP      3328
#define XB_TOPGEN   3392
#define XCD_BAR_WORDS 3456
#define XB_SPIN_CAP (1u << 18)
#define LAS __attribute__((address_space(3)))

__device__ __forceinline__ unsigned xb_ld(unsigned* p)              { return __hip_atomic_load(p, __ATOMIC_RELAXED, __HIP_MEMORY_SCOPE_AGENT); }
__device__ __forceinline__ unsigned xb_add(unsigned* p, unsigned v) { return __hip_atomic_fetch_add(p, v, __ATOMIC_RELAXED, __HIP_MEMORY_SCOPE_AGENT); }
__device__ __forceinline__ unsigned xb_xcc_id() { return (unsigned)__builtin_amdgcn_s_getreg((3 << 11) | 20) & 0xFu; }
#define XB_SPIN(cond, bar) do { unsigned _sp = 0; while (cond) { __builtin_amdgcn_s_sleep(1); \
    if ((++_sp & 255u) == 0u) { if (xb_ld(&(bar)[XB_TMO])) break; if (_sp > XB_SPIN_CAP) { atomicAdd(&(bar)[XB_TMO], 1u); break; } } } } while (0)

struct XcdBarrier {
    unsigned* bar; unsigned x;
    volatile LAS unsigned* st;
};

__device__ __forceinline__ XcdBarrier xcd_barrier_post(unsigned* bar, volatile LAS unsigned* st) {
    XcdBarrier b; b.bar = bar; b.x = xb_xcc_id(); b.st = st;
    if (threadIdx.x == 0) (void)xb_add(&bar[XB_XCNT(b.x)], 1u);
    return b;
}
__device__ __forceinline__ void xcd_barrier_complete(unsigned* bar, unsigned x, unsigned& nloc, unsigned& nx) {
    const unsigned G = gridDim.x * gridDim.y * gridDim.z;
    unsigned sum, cnt, mine, sp = 0u;
    for (;;) {
        sum = 0u; cnt = 0u; mine = 0u;
#pragma unroll
        for (unsigned j = 0; j < 16; ++j) { const unsigned c = xb_ld(&bar[XB_XCNT(j)]); sum += c; cnt += (c > 0u) ? 1u : 0u; mine = (j == x) ? c : mine; }
        if (sum == G) break;
        __builtin_amdgcn_s_sleep(1);
        if ((++sp & 255u) == 0u) { if (xb_ld(&bar[XB_TMO])) break; if (sp > XB_SPIN_CAP) { atomicAdd(&bar[XB_TMO], 1u); break; } }
    }
    nloc = mine > 0u ? mine : 1u; nx = cnt > 0u ? cnt : 1u;
}

__device__ __forceinline__ void xcd_barrier(const XcdBarrier& b) {
    asm volatile("s_waitcnt vmcnt(0)" ::: "memory");
    __syncthreads();
    if (threadIdx.x == 0) {
        unsigned* bar = b.bar;
        __builtin_amdgcn_s_waitcnt(0);
        unsigned nloc = b.st[0], nx = b.st[1];
        if (nloc == 0u) { xcd_barrier_complete(bar, b.x, nloc, nx); b.st[0] = nloc; b.st[1] = nx; }
        const unsigned old = xb_add(&bar[XB_XSUB(b.x)], 1u);
        const unsigned gen = old / nloc;
        if (old + 1u == (gen + 1u) * nloc) {
            __builtin_amdgcn_fence(__ATOMIC_RELEASE, "agent");
            asm volatile("s_waitcnt vmcnt(0)" ::: "memory");
            const unsigned og = xb_add(&bar[XB_TOP], 1u);
            const unsigned tg = og / nx;
            if (og + 1u == (tg + 1u) * nx) xb_add(&bar[XB_TOPGEN], 1u);
            else XB_SPIN(xb_ld(&bar[XB_TOPGEN]) == tg, bar);
            __builtin_amdgcn_fence(__ATOMIC_ACQUIRE, "agent");
            xb_add(&bar[XB_XGEN(b.x)], 1u);
            asm volatile("s_waitcnt vmcnt(0)" ::: "memory");
        } else {
            XB_SPIN(xb_ld(&bar[XB_XGEN(b.x)]) == gen, bar);
            __builtin_amdgcn_fence(__ATOMIC_ACQUIRE, "agent");
            asm volatile("s_waitcnt vmcnt(0)" ::: "memory");
        }
    }
    __syncthreads();
}


__global__ void __launch_bounds__(256, 2) mega(Params p) {
  extern __shared__ __attribute__((aligned(16))) char smem[];
  cg::grid_group grid = cg::this_grid();
  const int tid = threadIdx.x, lane = tid & 63, wave = tid >> 6;
  const int nb = gridDim.x, bid = blockIdx.x;
  float* smf = (float*)smem;
  if (p.ws == nullptr) grid.sync();
  volatile LAS unsigned* xst = (volatile LAS unsigned*)(smem + SMEM_XB);
  if (tid == 0) { xst[0] = 0u; xst[1] = 0u; }
  __syncthreads();
  const XcdBarrier xb = xcd_barrier_post((unsigned*)(p.ws + OFF_BAR), xst);
  u16* sA = (u16*)smem;
  u16* sB = (u16*)(smem + 128 * 64 * 2);

  for (int rep_ = 0; rep_ < NREP(0); ++rep_) if (PHON(0)) {
    const int N_MOD = 384, N_TIN = 16 * 68, N_TOA = 8 * 16, N_TOH = 8 * 16, N_TOUT = 16 * 16, N_TQ = 16 * 16, N_HID = 1024;
    const int total = N_MOD + N_TIN + N_TOA + N_TOH + N_TOUT + N_TQ + N_HID + 16 + 1;
    for (int it = bid; it < total; it += nb) {
      int i = it;
      if (i < N_MOD) { p0_mod(p, i, smf); continue; }
      i -= N_MOD;
      if (i < N_TIN) { transpose_tile(p.w_in, INW, 1024, (u16*)(p.ws + OFF_WIN), i, smf); continue; }
      i -= N_TIN;
      if (i < N_TOA) { transpose_tile(p.w_o_attn, 1024, 512, (u16*)(p.ws + OFF_WOA), i, smf); continue; }
      i -= N_TOA;
      if (i < N_TOH) { transpose_tile(p.w_o_hy, 1024, 512, (u16*)(p.ws + OFF_WOH), i, smf); continue; }
      i -= N_TOH;
      if (i < N_TOUT) { transpose_tile(p.w_out, 1024, 1024, (u16*)(p.ws + OFF_WOUT), i, smf); continue; }
      i -= N_TOUT;
      if (i < N_TQ) { transpose_tile(p.peer_wq, 1024, 1024, (u16*)(p.ws + OFF_WQ), i, smf); continue; }
      i -= N_TQ;
      if (i < N_HID) { p0_hidden(p, i, smf); continue; }
      i -= N_HID;
      if (i < 16) { transpose_tile(p.hy_fw3, 1024, 64, (u16*)(p.ws + OFF_H2F + 512 * 1024), i, smf); continue; }
      float2* rope = (float2*)(p.ws + OFF_ROPE);
      for (int idx = tid; idx < 1024; idx += 256) {
        const int pos = idx >> 4, f = idx & 15;
        const float inv = powf(10000.f, -(float)f / 16.f);
        const float ang = (float)pos * inv;
        rope[idx] = make_float2(cosf(ang), sinf(ang));
      }
    }
    convert_flat(p.peer_keys, (u16*)(p.ws + OFF_KEYS), (size_t)131072);
    convert_flat_fp8(p.peer_u, (unsigned char*)(p.ws + OFF_UBF), (size_t)16384 * 1024, 512.f);
    convert_flat_fp8(p.peer_v, (unsigned char*)(p.ws + OFF_VBF), (size_t)16384 * 1024, 64.f);
  }
  xcd_barrier(xb);

  for (int rep_ = 0; rep_ < NREP(1); ++rep_) if (PHON(1)) {
    const float* mod = (const float*)(p.ws + OFF_MOD);
    const int nrows = T_TOK + 1024;
    for (int r = bid * 4 + wave; r < nrows; r += nb * 4) {
      if (r < T_TOK) {
        const int b = r >> 12;
        norm_row(p.x + (size_t)r * 1024, p.norm1_g, mod + b * 6144, mod + b * 6144 + 1024,
                 (u16*)((char*)p.out + OO_H1) + (size_t)r * 1024, lane);
      } else {
        const int rc = r - T_TOK;
        norm_row(p.ctx + (size_t)rc * 1024, p.norm1_g, mod + 4 * 6144, mod + 4 * 6144 + 1024,
                 (u16*)((char*)p.out + OO_HC) + (size_t)rc * 1024, lane);
      }
    }
    for (int it = bid; it < 256; it += nb) p1_filter_tile(p, (it + 256 < nb) ? it : it, sA, sB);
  }
  xcd_barrier(xb);

  for (int rep_ = 0; rep_ < NREP(2); ++rep_) if (PHON(2)) {
    if (nb == 512) {
      const int xg = bid & 7, slot = bid >> 3;
      for (int r = 0; r < 8; ++r) {
        const int sup = r * 8 + xg;
        const int mt = (sup >> 2) * 8 + (slot >> 3), nt = (sup & 3) * 8 + (slot & 7);
        p2_inproj(p, mt * 34 + nt, sA, sB);
      }
      if (bid < 256) p2_inproj(p, (bid >> 1) * 34 + 32 + (bid & 1), sA, sB);
      else if (bid < 272) p2_ctxkv(p, bid - 256, sA, sB);
    } else {
      const int total = 128 * 34 + 16;
      for (int it = bid; it < total; it += nb) {
        if (it < 128 * 34) p2_inproj(p, it, sA, sB);
        else p2_ctxkv(p, it - 128 * 34, sA, sB);
      }
    }
  }
  xcd_barrier(xb);

  for (int rep_ = 0; rep_ < NREP(3); ++rep_) if (PHON(3)) {
    const int total = 1024 + 1024;
    for (int it = bid; it < total; it += nb) {
      if (it < 1024) p3_attn(p, it, (u16*)smem, (u16*)(smem + 128 * 72 * 2));
      else p3_hypre(p, it - 1024, (u16*)smem);
    }
  }
  xcd_barrier(xb);

  for (int rep_ = 0; rep_ < NREP(4); ++rep_) if (PHON(4)) for (int it = bid; it < 512; it += nb) p3_toeplitz(p, it, smem);
  xcd_barrier(xb);

  for (int rep_ = 0; rep_ < NREP(5); ++rep_) if (PHON(5)) for (int it = bid; it < 1024; it += nb) p4_merge(p, (nb == 512) ? ((((it >> 9) * 8 + (bid & 7)) * 8 + (bid >> 6)) * 8 + ((bid >> 3) & 7)) : it, sA, sB);
  xcd_barrier(xb);

  for (int rep_ = 0; rep_ < NREP(6); ++rep_) if (PHON(6)) for (int it = bid; it < 1024; it += nb) p5_out(p, (nb == 512) ? ((((it >> 9) * 8 + (bid & 7)) * 8 + (bid >> 6)) * 8 + ((bid >> 3) & 7)) : it, sA, sB);
  xcd_barrier(xb);

  for (int rep_ = 0; rep_ < NREP(7); ++rep_) if (PHON(7)) {
    const float* mod = (const float*)(p.ws + OFF_MOD);
    for (int r = bid * 4 + wave; r < T_TOK; r += nb * 4) {
      const int b = r >> 12;
      norm_row(p.out + (size_t)r * 1024, p.norm2_g, mod + b * 6144 + 3072, mod + b * 6144 + 4096,
               (u16*)(p.ws + OFF_H2) + (size_t)r * 1024, lane);
    }
  }
  xcd_barrier(xb);

  for (int rep_ = 0; rep_ < NREP(8); ++rep_) if (PHON(8)) for (int it = bid; it < 1024; it += nb) p7_qp(p, (nb == 512) ? ((((it >> 9) * 8 + (bid & 7)) * 8 + (bid >> 6)) * 8 + ((bid >> 3) & 7)) : it, sA, sB);
  xcd_barrier(xb);

  for (int rep_ = 0; rep_ < NREP(9); ++rep_) if (PHON(9)) {
    if (tid < 52) ((unsigned char*)(smem + 16384))[tid] = kTabG[tid];
    __syncthreads();
    for (int it = bid * 4 + wave; it < 8192; it += nb * 4) p8_route(p, it, smem + wave * 4096, (const unsigned char*)(smem + 16384));
  }
  xcd_barrier(xb);

  if (PHON(10)) {
    const int nw = nb * 4;
    int t = bid * 4 + wave;
    if (t < T_TOK) {
      int2 e2n = *(const int2*)((const int*)(p.ws + OFF_RIDX) + (size_t)t * 128 + 2 * lane);
      float2 w2n = *(const float2*)((const float*)(p.ws + OFF_RW) + (size_t)t * 128 + 2 * lane);
      u32x4 han = *(const u32x4*)((const u16*)(p.ws + OFF_H2) + (size_t)t * 1024 + 16 * lane);
      u32x4 hbn = *(const u32x4*)((const u16*)(p.ws + OFF_H2) + (size_t)t * 1024 + 16 * lane + 8);
      for (; t < T_TOK; t += nw) {
        const int tn = (t + nw < T_TOK) ? (t + nw) : t;
        p9_token(p, t, tn, lane, e2n, w2n, han, hbn);
      }
    }
  }
}

extern "C" void kernel_launch(void* const* d_in, const int* in_sizes, int n_in, void* d_out, int out_size,
                              void* d_ws, size_t ws_size, hipStream_t stream) {
  static int grid_blocks = 0;
  if (!grid_blocks) {
    int dev = 0, cus = 0, per_cu = 0;
    (void)hipGetDevice(&dev);
    (void)hipDeviceGetAttribute(&cus, hipDeviceAttributeMultiprocessorCount, dev);
    (void)hipFuncSetAttribute((const void*)mega, hipFuncAttributeMaxDynamicSharedMemorySize, SMEM_BYTES);
    (void)hipOccupancyMaxActiveBlocksPerMultiprocessor(&per_cu, mega, 256, SMEM_BYTES);
    if (per_cu > 2) per_cu = 2;
    if (per_cu < 1) per_cu = 1;
    grid_blocks = cus * per_cu;
  }
  Params p{};
  const float** pp = (const float**)&p;
  for (int i = 0; i < 28; ++i) pp[i] = (const float*)d_in[i];
  p.out = (float*)d_out;
  p.ws = (char*)d_ws;
  (void)hipMemsetAsync((char*)d_ws, 0, OFF_BAR + 24576, stream);
  void* args[] = {&p};
  hipError_t e = hipLaunchCooperativeKernel((void*)mega, dim3(grid_blocks), dim3(256), args, SMEM_BYTES, stream);
  if (e != hipSuccess) fprintf(stderr, "cooperative launch failed: %s (grid %d)\n", hipGetErrorString(e), grid_blocks);
}
```

```cpp
#include <hip/hip_runtime.h>
#include <hip/hip_bf16.h>
#include <hip/hip_cooperative_groups.h>
#include <cstdio>
namespace cg = cooperative_groups;

typedef unsigned short u16;
typedef __attribute__((ext_vector_type(8))) short bf16x8;
typedef __attribute__((ext_vector_type(4))) float f32x4;
typedef __attribute__((ext_vector_type(4))) unsigned u32x4;

#define DEV __device__ __forceinline__
#ifndef PH
#define PH -1
#endif
#define PHON(n) (PH < 0 || PH == (n))
#ifndef REP
#define REP -1
#endif
#define NREP(n) ((REP == (n)) ? 2 : 1)

constexpr int T_TOK = 16384;
constexpr int DM = 1024;
constexpr int SEQL = 4096;
constexpr int INW = 4352;

struct Params {
  const float *x, *c, *ctx, *c_ctx, *w_mod, *b_mod, *norm1_g, *w_in, *attn_sink, *hy_conv_w, *hy_conv_b,
      *hy_fw1, *hy_fb1, *hy_fw2, *hy_fb2, *hy_fw3, *hy_fb3, *hy_freq, *hy_skip, *w_o_attn, *w_o_hy, *w_out,
      *norm2_g, *peer_wq, *peer_keys, *peer_u, *peer_v, *final_g;
  float* out;
  char* ws;
};

constexpr size_t MB = 1u << 20;
constexpr size_t OFF_MOD = 0;
constexpr size_t OFF_ROPE = 128 * 1024;
constexpr size_t OFF_NINV = OFF_ROPE + 8192;
constexpr size_t OFF_H2F = 256 * 1024;
constexpr size_t OFF_WIN = OFF_H2F + MB;
constexpr size_t OFF_WOA = OFF_WIN + 9 * MB;
constexpr size_t OFF_WOH = OFF_WOA + MB;
constexpr size_t OFF_WOUT = OFF_WOH + MB;
constexpr size_t OFF_WQ = OFF_WOUT + 2 * MB;
constexpr size_t OFF_KEYS = OFF_WQ + 2 * MB;
constexpr size_t OFF_UBF = OFF_KEYS + MB;
constexpr size_t OFF_VBF = OFF_UBF + 32 * MB;
constexpr size_t OFF_Q = OFF_VBF + 32 * MB;
constexpr size_t OFF_K = OFF_Q + 16 * MB;
constexpr size_t OFF_VT = OFF_K + 4 * MB;
constexpr size_t OFF_KC = OFF_VT + 4 * MB;
constexpr size_t OFF_VCT = OFF_KC + MB / 2;
constexpr size_t OFF_Z = OFF_VCT + MB / 2;
constexpr size_t OFF_GATE = OFF_Z + 48 * MB;
constexpr size_t OFF_YATT = OFF_GATE + 64 * MB;
constexpr size_t OFF_YHY = OFF_YATT + 16 * MB;
constexpr size_t OFF_RIDX = OFF_Q;
constexpr size_t OFF_RW = OFF_Q + 8 * MB;
constexpr size_t OFF_MERGED = OFF_Z;
constexpr size_t OFF_H2 = OFF_GATE;
constexpr size_t OFF_QP = OFF_GATE + 32 * MB;
constexpr size_t OO_H1 = 0;
constexpr size_t OO_UT = 0;
constexpr size_t OO_X0T = 16 * MB;
constexpr size_t OO_HC = 32 * MB;
constexpr size_t OO_G = 34 * MB;

constexpr int SMEM_BYTES = 70144;
constexpr size_t OFF_BAR = 160 * 1024;
constexpr int SMEM_XB = 70016;

typedef __attribute__((ext_vector_type(2))) float pk_f2;
typedef __attribute__((ext_vector_type(2))) __bf16 pk_b2;
DEV unsigned pack2(float a, float b) {
  pk_f2 v = {a, b};
  return __builtin_bit_cast(unsigned, __builtin_convertvector(v, pk_b2));
}
DEV u16 f2bf(float f) { return (u16)(pack2(f, 0.f) & 0xffffu); }
DEV float bf2f(u16 h) { return __uint_as_float(((unsigned)h) << 16); }
DEV float bflo(unsigned w) { return __uint_as_float(w << 16); }
DEV float bfhi(unsigned w) { return __uint_as_float(w & 0xffff0000u); }
#define DPP_ADD(v, ctrl) ((v) + __builtin_bit_cast(float, __builtin_amdgcn_update_dpp(0, __builtin_bit_cast(int, (v)), (ctrl), 0xF, 0xF, true)))
DEV float wave_sum(float v) {
  v = DPP_ADD(v, 0xB1);
  v = DPP_ADD(v, 0x4E);
  v = DPP_ADD(v, 0x141);
  v = DPP_ADD(v, 0x140);
  v += __shfl_xor(v, 16);
  v += __shfl_xor(v, 32);
  return v;
}
DEV float wave_max(float v) {
#pragma unroll
  for (int o = 32; o > 0; o >>= 1) v = fmaxf(v, __shfl_xor(v, o));
  return v;
}

DEV void p0_mod(const Params& p, int item, float* sm) {
  const int tid = threadIdx.x;
  const int cblk = item >> 2, kq = item & 3;
  for (int i = tid; i < 5 * 256; i += 256) {
    const int r = i >> 8, k = kq * 256 + (i & 255);
    const float c = (r < 4) ? p.c[r * 1024 + k] : p.c_ctx[k];
    sm[i] = c * __builtin_amdgcn_rcpf(1.f + __expf(-c));
  }
  __syncthreads();
  const int col = cblk * 64 + (tid & 63), sub = tid >> 6;
  float a0 = 0, a1 = 0, a2 = 0, a3 = 0, a4 = 0;
  const float* wp = p.w_mod + (size_t)(kq * 256 + sub * 64) * 6144 + col;
#pragma unroll 16
  for (int k = 0; k < 64; ++k) {
    const float w = wp[(size_t)k * 6144];
    const int kk = sub * 64 + k;
    a0 += sm[kk] * w; a1 += sm[256 + kk] * w; a2 += sm[512 + kk] * w; a3 += sm[768 + kk] * w; a4 += sm[1024 + kk] * w;
  }
  float* red = sm + 5 * 256;
  red[(sub * 5 + 0) * 64 + (tid & 63)] = a0;
  red[(sub * 5 + 1) * 64 + (tid & 63)] = a1;
  red[(sub * 5 + 2) * 64 + (tid & 63)] = a2;
  red[(sub * 5 + 3) * 64 + (tid & 63)] = a3;
  red[(sub * 5 + 4) * 64 + (tid & 63)] = a4;
  __syncthreads();
  float* mod = (float*)(p.ws + OFF_MOD);
  for (int i = tid; i < 320; i += 256) {
    const int r = i >> 6, cc = i & 63;
    float sacc = red[(0 * 5 + r) * 64 + cc] + red[(1 * 5 + r) * 64 + cc] + red[(2 * 5 + r) * 64 + cc] + red[(3 * 5 + r) * 64 + cc];
    if (kq == 0) sacc += p.b_mod[cblk * 64 + cc];
    atomicAdd(mod + r * 6144 + cblk * 64 + cc, sacc);
  }
  __syncthreads();
}

DEV void transpose_tile(const float* __restrict__ src, int N, int K, u16* __restrict__ dst, int tile, float* sm) {
  const int tid = threadIdx.x;
  const int nkt = K >> 6;
  const int kt = tile % nkt, nt = tile / nkt;
  const int k0 = kt * 64, n0 = nt * 64;
  const int c4 = tid & 15, r = tid >> 4;
  float4 tv[4];
#pragma unroll
  for (int rr = 0; rr < 4; ++rr) tv[rr] = *(const float4*)(src + (size_t)(k0 + rr * 16 + r) * N + n0 + c4 * 4);
#pragma unroll
  for (int rr = 0; rr < 4; ++rr) {
    float* d0 = sm + (rr * 16 + r) * 65 + c4 * 4;
    d0[0] = tv[rr].x; d0[1] = tv[rr].y; d0[2] = tv[rr].z; d0[3] = tv[rr].w;
  }
  __syncthreads();
  const int nn = tid >> 2, part = tid & 3;
  unsigned w[8];
#pragma unroll
  for (int j = 0; j < 8; ++j) w[j] = pack2(sm[(part * 16 + 2 * j) * 65 + nn], sm[(part * 16 + 2 * j + 1) * 65 + nn]);
  uint4* d = (uint4*)(dst + (size_t)(n0 + nn) * K + k0 + part * 16);
  d[0] = make_uint4(w[0], w[1], w[2], w[3]);
  d[1] = make_uint4(w[4], w[5], w[6], w[7]);
  __syncthreads();
}

DEV void p0_hidden(const Params& p, int item, float* sm) {
  const int tid = threadIdx.x;
  float* z = sm;
  float* h1 = sm + 4 * 36;
  if (tid < 4 * 33) {
    int tt = tid / 33, i = tid % 33;
    int t = item * 4 + tt;
    float v;
    if (i == 0) v = (float)t * (1.f / 4096.f);
    else {
      int band = (i <= 16) ? i : (i - 16);
      float fr = (float)((t * band) & 4095) * (1.f / 4096.f);
      v = (i <= 16) ? cospif(2.f * fr) : sinpif(2.f * fr);
    }
    z[tt * 36 + i] = v;
  }
  __syncthreads();
  const int tt = tid >> 6, j = tid & 63;
  float a = p.hy_fb1[j];
  for (int i = 0; i < 33; ++i) a += z[tt * 36 + i] * p.hy_fw1[i * 64 + j];
  const float fq = p.hy_freq[j];
  h1[tt * 64 + j] = sinf(fq * a);
  __syncthreads();
  float b = p.hy_fb2[j];
  for (int i = 0; i < 64; ++i) b += h1[tt * 64 + i] * p.hy_fw2[i * 64 + j];
  ((u16*)(p.ws + OFF_H2F))[(item * 4 + tt) * 64 + j] = f2bf(sinf(fq * b));
  __syncthreads();
}

DEV void convert_flat(const float* __restrict__ src, u16* __restrict__ dst, size_t n) {
  size_t stride = (size_t)gridDim.x * 256 * 8;
  for (size_t i = ((size_t)blockIdx.x * 256 + threadIdx.x) * 8; i < n; i += stride) {
    float4 a = *(const float4*)(src + i);
    float4 b = *(const float4*)(src + i + 4);
    *(uint4*)(dst + i) = make_uint4(pack2(a.x, a.y), pack2(a.z, a.w), pack2(b.x, b.y), pack2(b.z, b.w));
  }
}

typedef __attribute__((ext_vector_type(2))) float f32x2;
DEV void convert_flat_fp8(const float* __restrict__ src, unsigned char* __restrict__ dst, size_t n, float scale) {
  const size_t q4 = (size_t)gridDim.x * 256 * 16;
  const size_t stride = q4 * 4;
  for (size_t i = ((size_t)blockIdx.x * 256 + threadIdx.x) * 16; i < n; i += stride) {
    float4 a[16];
#pragma unroll
    for (int c = 0; c < 4; ++c) {
      const size_t off = i + c * q4;
      if (off < n) {
#pragma unroll
        for (int q = 0; q < 4; ++q) a[c * 4 + q] = *(const float4*)(src + off + 4 * q);
      }
    }
#pragma unroll
    for (int c = 0; c < 4; ++c) {
      const size_t off = i + c * q4;
      if (off < n) {
        unsigned w[4];
#pragma unroll
        for (int q = 0; q < 4; ++q) {
          int v = 0;
          v = __builtin_amdgcn_cvt_pk_fp8_f32(a[c * 4 + q].x * scale, a[c * 4 + q].y * scale, v, false);
          v = __builtin_amdgcn_cvt_pk_fp8_f32(a[c * 4 + q].z * scale, a[c * 4 + q].w * scale, v, true);
          w[q] = (unsigned)v;
        }
        *(uint4*)(dst + off) = make_uint4(w[0], w[1], w[2], w[3]);
      }
    }
  }
}

DEV void norm_row(const float* __restrict__ xr, const float* __restrict__ g, const float* __restrict__ sh,
                  const float* __restrict__ sc, u16* __restrict__ dst, int lane) {
  float4 v[4];
  float ss = 0.f;
#pragma unroll
  for (int i = 0; i < 4; ++i) {
    v[i] = ((const float4*)xr)[lane + 64 * i];
    ss += v[i].x * v[i].x + v[i].y * v[i].y + v[i].z * v[i].z + v[i].w * v[i].w;
  }
  ss = wave_sum(ss);
  const float r = rsqrtf(ss * (1.f / 1024.f) + 1e-6f);
#pragma unroll
  for (int i = 0; i < 4; ++i) {
    const int idx = lane + 64 * i;
    float4 gg = ((const float4*)g)[idx], s1 = ((const float4*)sh)[idx], s2 = ((const float4*)sc)[idx];
    float y0 = v[i].x * r * gg.x * (1.f + s2.x) + s1.x;
    float y1 = v[i].y * r * gg.y * (1.f + s2.y) + s1.y;
    float y2 = v[i].z * r * gg.z * (1.f + s2.z) + s1.z;
    float y3 = v[i].w * r * gg.w * (1.f + s2.w) + s1.w;
    *(uint2*)(dst + idx * 4) = make_uint2(pack2(y0, y1), pack2(y2, y3));
  }
}

DEV void p1_filter(const Params& p, int item, float* sm) {
  const int tid = threadIdx.x;
  const int c0 = (item >> 2) * 4, tq = item & 3;
  float* wc = sm;
  float* red = sm + 512;
  for (int i = tid; i < 512; i += 256) {
    const int j = i >> 6, k = i & 63;
    wc[i] = p.hy_fw3[k * 1024 + ((j < 4) ? (c0 + j) : (512 + c0 + j - 4))];
  }
  __syncthreads();
  float fb[8], dl[4];
#pragma unroll
  for (int j = 0; j < 8; ++j) fb[j] = p.hy_fb3[(j < 4) ? (c0 + j) : (512 + c0 + j - 4)];
  const float da = logf(1e-2f) / 1.5f, db = logf(1e-2f) / 0.3f;
#pragma unroll
  for (int j = 0; j < 4; ++j) dl[j] = fabsf(da + (db - da) * (float)(c0 + j) / 511.f);
  u16* G = (u16*)((char*)p.out + OO_G);
  const float* H = (const float*)(p.ws + OFF_H2F);
  float as[4] = {0.f, 0.f, 0.f, 0.f};
#pragma unroll 1
  for (int i = 0; i < 4; ++i) {
    const int t = tq * 1024 + i * 256 + tid;
    const float4* hp = (const float4*)(H + t * 64);
    float d[8];
#pragma unroll
    for (int j = 0; j < 8; ++j) d[j] = fb[j];
#pragma unroll 1
    for (int q8 = 0; q8 < 16; q8 += 8) {
      float4 hv[8];
#pragma unroll
      for (int u = 0; u < 8; ++u) hv[u] = hp[q8 + u];
#pragma unroll
      for (int u = 0; u < 8; ++u)
#pragma unroll
        for (int j = 0; j < 8; ++j) {
          const float4 w = *(const float4*)(wc + j * 64 + 4 * (q8 + u));
          d[j] += hv[u].x * w.x + hv[u].y * w.y + hv[u].z * w.z + hv[u].w * w.w;
        }
    }
    const float tn = (float)t * (1.f / 4096.f);
#pragma unroll
    for (int j = 0; j < 4; ++j) {
      const float dec = expf(-tn * dl[j]);
      const float f = d[j] * dec, bw = d[4 + j] * dec;
      u16* Gc = G + (size_t)(c0 + j) * 8192;
      Gc[4095 - t] = f2bf(f);
      as[j] += fabsf(f);
      if (t < 4095) { Gc[4096 + t] = f2bf(bw); as[j] += fabsf(bw); }
      else Gc[8191] = 0;
    }
  }
#pragma unroll
  for (int j = 0; j < 4; ++j) {
    const float v = wave_sum(as[j]);
    if ((tid & 63) == 0) red[(tid >> 6) * 4 + j] = v;
  }
  __syncthreads();
  if (tid < 4) atomicAdd((float*)(p.ws + OFF_BAR + 20480) + c0 + tid, red[tid] + red[4 + tid] + red[8 + tid] + red[12 + tid]);
  __syncthreads();
}

struct Acc { f32x4 v[4][4]; };

DEV void acc_zero(Acc& a) {
#pragma unroll
  for (int i = 0; i < 4; ++i)
#pragma unroll
    for (int j = 0; j < 4; ++j) a.v[i][j] = (f32x4){0.f, 0.f, 0.f, 0.f};
}

#define LDSAS __attribute__((address_space(3)))
DEV void gemm_kloop(const u16* __restrict__ A, int lda, const u16* __restrict__ Bt, int ldb, int K, int m0, int n0,
                    u16* sA, u16* sB_unused, Acc& acc) {
  const int tid = threadIdx.x, lane = tid & 63, wave = tid >> 6, wm = wave >> 1, wn = wave & 1;
  const int l15 = lane & 15, quad = lane >> 4;
  const int rsw = (l15 >> 1) & 7;
  const int nk = K >> 6;
  const int prow = lane >> 3;
  const int pch = lane & 7;
  unsigned oA[4], oB[4];
#pragma unroll
  for (int i = 0; i < 4; ++i) {
    const int row = (wave * 4 + i) * 8 + prow;
    const int c = pch ^ ((row >> 1) & 7);
    oA[i] = (unsigned)(row * lda + c * 8) * 2u;
    oB[i] = (unsigned)(row * ldb + c * 8) * 2u;
  }
  const char* bA = (const char*)(A + (size_t)m0 * lda);
  const char* bB = (const char*)(Bt + (size_t)n0 * ldb);
  LDSAS char* lbase = (LDSAS char*)sA;
#define GEMM_DMA(KT, BUF)                                                                                   \
  _Pragma("unroll") for (int i = 0; i < 4; ++i) {                                                           \
    __builtin_amdgcn_global_load_lds((const unsigned*)(bA + (KT) * 128 + oA[i]), (LDSAS unsigned*)(lbase + (BUF) * 32768 + (wave * 4 + i) * 1024), 16, 0, 0);          \
    __builtin_amdgcn_global_load_lds((const unsigned*)(bB + (KT) * 128 + oB[i]), (LDSAS unsigned*)(lbase + (BUF) * 32768 + 16384 + (wave * 4 + i) * 1024), 16, 0, 0);  \
  }
  GEMM_DMA(0, 0)
  for (int kt = 0; kt < nk; ++kt) {
    asm volatile("s_waitcnt vmcnt(0)" ::: "memory");
    __syncthreads();
    const int buf = kt & 1;
    if (kt + 1 < nk) { GEMM_DMA(kt + 1, buf ^ 1) }
    const u16* tA = sA + buf * 16384;
    const u16* tB = tA + 8192;
    bf16x8 af[2][4], bfr[2][4];
#pragma unroll
    for (int ks = 0; ks < 2; ++ks) {
      const int cs = ((ks * 4 + quad) ^ rsw) * 8;
#pragma unroll
      for (int i = 0; i < 4; ++i) af[ks][i] = *(const bf16x8*)(tB + (wn * 64 + i * 16 + l15) * 64 + cs);
#pragma unroll
      for (int j = 0; j < 4; ++j) bfr[ks][j] = *(const bf16x8*)(tA + (wm * 64 + j * 16 + l15) * 64 + cs);
    }
    __builtin_amdgcn_s_setprio(1);
#pragma unroll
    for (int ks = 0; ks < 2; ++ks)
#pragma unroll
      for (int i = 0; i < 4; ++i)
#pragma unroll
        for (int j = 0; j < 4; ++j) acc.v[i][j] = __builtin_amdgcn_mfma_f32_16x16x32_bf16(af[ks][i], bfr[ks][j], acc.v[i][j], 0, 0, 0);
    __builtin_amdgcn_s_setprio(0);
  }
  __syncthreads();
}

DEV void p1_filter_tile(const Params& p, int tile, u16* sA, u16* sB) {
  const int mt = tile >> 3, nt = tile & 7;
  const int m0 = mt * 128, n0 = nt * 128;
  Acc acc; acc_zero(acc);
  gemm_kloop((const u16*)(p.ws + OFF_H2F), 64, (const u16*)(p.ws + OFF_H2F + 512 * 1024), 64, 64, m0, n0, sA, sB, acc);
  asm volatile("" ::: "memory");
  const int tid = threadIdx.x, lane = tid & 63, wave = tid >> 6, wm = wave >> 1, wn = wave & 1;
  const int l15 = lane & 15, quad = lane >> 4;
  const int mb = m0 + wm * 64, nbase = n0 + wn * 64;
  u16* G = (u16*)((char*)p.out + OO_G);
  float* nsum = (float*)(p.ws + OFF_BAR + 20480);
  const float da = logf(1e-2f) / 1.5f, db = logf(1e-2f) / 0.3f;
  const bool bwd = nbase >= 512;
#pragma unroll
  for (int i = 0; i < 4; ++i)
#pragma unroll
    for (int r = 0; r < 4; ++r) {
      const int col = nbase + i * 16 + quad * 4 + r;
      const int c = col & 511;
      const float fbv = p.hy_fb3[col];
      const float dlc = fabsf(da + (db - da) * (float)c / 511.f);
      u16* Gc = G + (size_t)c * 8192;
      float sum = 0.f;
#pragma unroll
      for (int j = 0; j < 4; ++j) {
        const int t = mb + j * 16 + l15;
        const float val = (acc.v[i][j][r] + fbv) * __expf(-(float)t * (1.f / 4096.f) * dlc);
        if (!bwd) { Gc[4095 - t] = f2bf(val); sum += fabsf(val); }
        else if (t < 4095) { Gc[4096 + t] = f2bf(val); sum += fabsf(val); }
        else Gc[8191] = 0;
      }
      sum = DPP_ADD(sum, 0xB1);
      sum = DPP_ADD(sum, 0x4E);
      sum = DPP_ADD(sum, 0x141);
      sum = DPP_ADD(sum, 0x140);
      if (l15 == 0) atomicAdd(nsum + c, sum);
    }
}

DEV void p2_inproj(const Params& p, int tile, u16* sA, u16* sB) {
  const int mt = tile / 34, nt = tile % 34;
  const int m0 = mt * 128, n0 = nt * 128;
  Acc acc; acc_zero(acc);
  gemm_kloop((const u16*)((const char*)p.out + OO_H1), 1024, (const u16*)(p.ws + OFF_WIN), 1024, 1024, m0, n0, sA, sB, acc);
  asm volatile("" ::: "memory");
  const int tid = threadIdx.x, lane = tid & 63, wave = tid >> 6, wm = wave >> 1, wn = wave & 1;
  int l15 = lane & 15, quad = lane >> 4;
  int mb = m0 + wm * 64, nb = n0 + wn * 64;
  asm volatile("" : "+v"(l15), "+v"(quad), "+v"(mb), "+v"(nb));
  mb = __builtin_amdgcn_readfirstlane(mb); nb = __builtin_amdgcn_readfirstlane(nb);
  if (nb < 640) {
    const float2* rope = (const float2*)(p.ws + OFF_ROPE);
    const bool isq = nb < 512;
    const float qs = isq ? (0.125f * 1.4426950408889634f) : 1.f;
#pragma unroll
    for (int j = 0; j < 4; ++j) {
      const int m = mb + j * 16 + l15;
      const int b = m >> 12, l = m & 4095;
      const int prow = l >> 6, pcol = l & 63;
      u16* dst;
      if (isq) dst = (u16*)(p.ws + OFF_Q) + ((size_t)(b * 8 + (nb >> 6)) * 4096 + l) * 64;
      else dst = (u16*)(p.ws + OFF_K) + ((size_t)(b * 2 + ((nb - 512) >> 6)) * 4096 + l) * 64;
#pragma unroll
      for (int hh = 0; hh < 2; ++hh) {
        const int pos = hh ? pcol : prow;
        f32x4 x1 = acc.v[hh * 2][j], x2 = acc.v[hh * 2 + 1][j];
        float o1[4], o2[4];
#pragma unroll
        for (int r = 0; r < 4; ++r) {
          float2 cs = rope[pos * 16 + quad * 4 + r];
          o1[r] = (x1[r] * cs.x - x2[r] * cs.y) * qs;
          o2[r] = (x2[r] * cs.x + x1[r] * cs.y) * qs;
        }
        *(uint2*)(dst + hh * 32 + quad * 4) = make_uint2(pack2(o1[0], o1[1]), pack2(o1[2], o1[3]));
        *(uint2*)(dst + hh * 32 + 16 + quad * 4) = make_uint2(pack2(o2[0], o2[1]), pack2(o2[2], o2[3]));
      }
    }
  } else if (nb < 768) {
    const int g = (nb - 640) >> 6;
    u16* vt = (u16*)(p.ws + OFF_VT);
#pragma unroll
    for (int j = 0; j < 4; ++j) {
      const int m = mb + j * 16 + l15;
      const int b = m >> 12, l = m & 4095;
#pragma unroll
      for (int i = 0; i < 4; ++i)
#pragma unroll
        for (int r = 0; r < 4; ++r) {
          const int d = i * 16 + quad * 4 + r;
          vt[((size_t)(b * 2 + g) * 64 + d) * 4096 + l] = f2bf(acc.v[i][j][r]);
        }
    }
  } else if (nb < 2304) {
    u16* z = (u16*)(p.ws + OFF_Z);
#pragma unroll
    for (int j = 0; j < 4; ++j) {
      const int m = mb + j * 16 + l15;
#pragma unroll
      for (int i = 0; i < 4; ++i) {
        const int n = nb - 768 + i * 16 + quad * 4;
        f32x4 a = acc.v[i][j];
        *(uint2*)(z + (size_t)m * 1536 + n) = make_uint2(pack2(a[0], a[1]), pack2(a[2], a[3]));
      }
    }
  } else {
    u16* gt = (u16*)(p.ws + OFF_GATE);
#pragma unroll
    for (int j = 0; j < 4; ++j) {
      const int m = mb + j * 16 + l15;
#pragma unroll
      for (int i = 0; i < 4; ++i) {
        const int n = nb - 2304 + i * 16 + quad * 4;
        f32x4 a = acc.v[i][j];
        float s0 = __builtin_amdgcn_rcpf(1.f + __expf(-a[0])), s1 = __builtin_amdgcn_rcpf(1.f + __expf(-a[1]));
        float s2 = __builtin_amdgcn_rcpf(1.f + __expf(-a[2])), s3 = __builtin_amdgcn_rcpf(1.f + __expf(-a[3]));
        *(uint2*)(gt + (size_t)m * 2048 + n) = make_uint2(pack2(s0, s1), pack2(s2, s3));
      }
    }
  }
}

DEV void p2_ctxkv(const Params& p, int tile, u16* sA, u16* sB) {
  const int mt = tile >> 1, nt = tile & 1;
  const int m0 = mt * 128, n0 = nt * 128;
  Acc acc; acc_zero(acc);
  gemm_kloop((const u16*)((const char*)p.out + OO_HC), 1024, (const u16*)(p.ws + OFF_WIN) + (size_t)512 * 1024, 1024, 1024, m0, n0, sA, sB, acc);
  const int tid = threadIdx.x, lane = tid & 63, wave = tid >> 6, wm = wave >> 1, wn = wave & 1;
  const int l15 = lane & 15, quad = lane >> 4;
  const int mb = m0 + wm * 64, nb = n0 + wn * 64;
  const int g = (nb >> 6) & 1;
  if (nb < 128) {
    u16* kc = (u16*)(p.ws + OFF_KC);
#pragma unroll
    for (int j = 0; j < 4; ++j) {
      const int m = mb + j * 16 + l15;
      const int b = m >> 8, c = m & 255;
#pragma unroll
      for (int i = 0; i < 4; ++i) {
        f32x4 a = acc.v[i][j];
        *(uint2*)(kc + ((size_t)(b * 2 + g) * 256 + c) * 64 + i * 16 + quad * 4) = make_uint2(pack2(a[0], a[1]), pack2(a[2], a[3]));
      }
    }
  } else {
    u16* vct = (u16*)(p.ws + OFF_VCT);
#pragma unroll
    for (int j = 0; j < 4; ++j) {
      const int m = mb + j * 16 + l15;
      const int b = m >> 8, c = m & 255;
#pragma unroll
      for (int i = 0; i < 4; ++i)
#pragma unroll
        for (int r = 0; r < 4; ++r) {
          const int d = i * 16 + quad * 4 + r;
          vct[((size_t)(b * 2 + g) * 64 + d) * 256 + c] = f2bf(acc.v[i][j][r]);
        }
    }
  }
}

DEV void p3_attn(const Params& p, int item, u16* sK, u16* sVt) {
  const int tid = threadIdx.x, lane = tid & 63, wave = tid >> 6, l15 = lane & 15, quad = lane >> 4;
  const int n = item & 31, h = (item >> 5) & 7, b = item >> 8;
  const int g = h >> 2;
  const u16* Q = (const u16*)(p.ws + OFF_Q) + ((size_t)(b * 8 + h) * 4096 + n * 128 + wave * 32) * 64;
  bf16x8 bq[2][2];
#pragma unroll
  for (int qt = 0; qt < 2; ++qt)
#pragma unroll
    for (int ks = 0; ks < 2; ++ks) bq[qt][ks] = *(const bf16x8*)(Q + (qt * 16 + l15) * 64 + ks * 32 + quad * 8);
  const float sink = p.attn_sink[h] * 1.4426950408889634f;
  float mrun[2] = {sink, sink};
  float lrun[2];
  lrun[0] = lrun[1] = (quad == 0) ? 1.f : 0.f;
  f32x4 O[4][2];
#pragma unroll
  for (int dt = 0; dt < 4; ++dt)
#pragma unroll
    for (int qt = 0; qt < 2; ++qt) O[dt][qt] = (f32x4){0.f, 0.f, 0.f, 0.f};

  u32x4 pk[4], pv[4];
#define ATT_LOAD(KB)                                                                                  \
  {                                                                                                   \
    const u16* Ksrc; const u16* Vsrc; int vstride;                                                    \
    if ((KB) < 3) {                                                                                   \
      const int nbk = n + (KB) - 1;                                                                   \
      Ksrc = (const u16*)(p.ws + OFF_K) + ((size_t)(b * 2 + g) * 4096 + nbk * 128) * 64;              \
      Vsrc = (const u16*)(p.ws + OFF_VT) + (size_t)(b * 2 + g) * 64 * 4096 + nbk * 128;               \
      vstride = 4096;                                                                                 \
    } else {                                                                                          \
      const int cb = (KB) - 3;                                                                        \
      Ksrc = (const u16*)(p.ws + OFF_KC) + ((size_t)(b * 2 + g) * 256 + cb * 128) * 64;               \
      Vsrc = (const u16*)(p.ws + OFF_VCT) + (size_t)(b * 2 + g) * 64 * 256 + cb * 128;                \
      vstride = 256;                                                                                  \
    }                                                                                                 \
    _Pragma("unroll") for (int i = 0; i < 4; ++i) {                                                   \
      const int id = tid + i * 256;                                                                   \
      pk[i] = *(const u32x4*)(Ksrc + (id >> 3) * 64 + (id & 7) * 8);                                  \
      pv[i] = *(const u32x4*)(Vsrc + (size_t)(id >> 4) * vstride + (id & 15) * 8);                    \
    }                                                                                                 \
  }
  int kb = (n == 0) ? 1 : 0;
  ATT_LOAD(kb)
  while (kb < 5) {
#pragma unroll
    for (int i = 0; i < 4; ++i) {
      const int id = tid + i * 256;
      *(u32x4*)(sK + (id >> 3) * 72 + (id & 7) * 8) = pk[i];
      *(u32x4*)(sVt + (id >> 4) * 136 + (id & 15) * 8) = pv[i];
    }
    __syncthreads();
    int nx = kb + 1;
    if (nx == 2 && n == 31) nx = 3;
    if (nx < 5) ATT_LOAD(nx)
#pragma unroll 1
    for (int c4 = 0; c4 < 4; ++c4) {
      f32x4 s[2][2];
#pragma unroll
      for (int kt = 0; kt < 2; ++kt) {
        bf16x8 ak0 = *(const bf16x8*)(sK + (c4 * 32 + kt * 16 + l15) * 72 + quad * 8);
        bf16x8 ak1 = *(const bf16x8*)(sK + (c4 * 32 + kt * 16 + l15) * 72 + 32 + quad * 8);
#pragma unroll
        for (int qt = 0; qt < 2; ++qt) {
          f32x4 z = (f32x4){0.f, 0.f, 0.f, 0.f};
          z = __builtin_amdgcn_mfma_f32_16x16x32_bf16(ak0, bq[qt][0], z, 0, 0, 0);
          z = __builtin_amdgcn_mfma_f32_16x16x32_bf16(ak1, bq[qt][1], z, 0, 0, 0);
          s[kt][qt] = z;
        }
      }
      if (kb == 0 || kb == 2) {
#pragma unroll
        for (int kt = 0; kt < 2; ++kt)
#pragma unroll
          for (int qt = 0; qt < 2; ++qt)
#pragma unroll
            for (int r = 0; r < 4; ++r) {
              const int kk = c4 * 32 + kt * 16 + quad * 4 + r;
              const int qq = wave * 32 + qt * 16 + l15;
              const bool valid = (kb == 0) ? (kk >= qq) : (kk <= qq);
              if (!valid) s[kt][qt][r] = -INFINITY;
            }
      }
      bf16x8 bp[2];
#pragma unroll
      for (int qt = 0; qt < 2; ++qt) {
        float cm = fmaxf(fmaxf(fmaxf(s[0][qt][0], s[0][qt][1]), fmaxf(s[0][qt][2], s[0][qt][3])),
                         fmaxf(fmaxf(s[1][qt][0], s[1][qt][1]), fmaxf(s[1][qt][2], s[1][qt][3])));
        cm = fmaxf(cm, __shfl_xor(cm, 16));
        cm = fmaxf(cm, __shfl_xor(cm, 32));
        const float mnew = fmaxf(mrun[qt], cm);
        const float alpha = __builtin_amdgcn_exp2f(mrun[qt] - mnew);
        mrun[qt] = mnew;
        float ps = 0.f;
        float pv[8];
#pragma unroll
        for (int r = 0; r < 4; ++r) {
          pv[r] = __builtin_amdgcn_exp2f(s[0][qt][r] - mnew);
          pv[4 + r] = __builtin_amdgcn_exp2f(s[1][qt][r] - mnew);
          ps += pv[r] + pv[4 + r];
        }
        lrun[qt] = lrun[qt] * alpha + ps;
#pragma unroll
        for (int dt = 0; dt < 4; ++dt) {
          O[dt][qt][0] *= alpha; O[dt][qt][1] *= alpha; O[dt][qt][2] *= alpha; O[dt][qt][3] *= alpha;
        }
        union { bf16x8 v; unsigned u[4]; } pk;
        pk.u[0] = pack2(pv[0], pv[1]); pk.u[1] = pack2(pv[2], pv[3]);
        pk.u[2] = pack2(pv[4], pv[5]); pk.u[3] = pack2(pv[6], pv[7]);
        bp[qt] = pk.v;
      }
#pragma unroll
      for (int dt = 0; dt < 4; ++dt) {
        union { bf16x8 v; uint2 h[2]; } av;
        const u16* vrow = sVt + (dt * 16 + l15) * 136 + c4 * 32 + quad * 4;
        av.h[0] = *(const uint2*)(vrow);
        av.h[1] = *(const uint2*)(vrow + 16);
#pragma unroll
        for (int qt = 0; qt < 2; ++qt) O[dt][qt] = __builtin_amdgcn_mfma_f32_16x16x32_bf16(av.v, bp[qt], O[dt][qt], 0, 0, 0);
      }
    }
    __syncthreads();
    kb = nx;
  }
  u16* Y = (u16*)(p.ws + OFF_YATT);
#pragma unroll
  for (int qt = 0; qt < 2; ++qt) {
    float l = lrun[qt];
    l += __shfl_xor(l, 16);
    l += __shfl_xor(l, 32);
    const float inv = __builtin_amdgcn_rcpf(l);
    const int t = b * 4096 + n * 128 + wave * 32 + qt * 16 + l15;
#pragma unroll
    for (int dt = 0; dt < 4; ++dt) {
      f32x4 o = O[dt][qt];
      *(uint2*)(Y + (size_t)t * 512 + h * 64 + dt * 16 + quad * 4) = make_uint2(pack2(o[0] * inv, o[1] * inv), pack2(o[2] * inv, o[3] * inv));
    }
  }
}

DEV void p3_hypre(const Params& p, int item, u16* sm) {
  const int tid = threadIdx.x;
  const int cb = item & 3, tb = (item >> 2) & 63, b = item >> 8;
  const int tq = tid >> 6, ch2 = tid & 63;
  const int c = cb * 128 + ch2 * 2;
  u16* su = sm;
  u16* sx = sm + 128 * 66;
  float w[3][3][2], bias[3][2];
#pragma unroll
  for (int s = 0; s < 3; ++s) {
#pragma unroll
    for (int k = 0; k < 3; ++k) {
      const float2 wv = *(const float2*)(p.hy_conv_w + k * 1536 + s * 512 + c);
      w[s][k][0] = wv.x; w[s][k][1] = wv.y;
    }
    const float2 bv = *(const float2*)(p.hy_conv_b + s * 512 + c);
    bias[s][0] = bv.x; bias[s][1] = bv.y;
  }
  const u16* Z = (const u16*)(p.ws + OFF_Z) + (size_t)b * 4096 * 1536;
  const int l0 = tb * 64 + tq * 16;
  unsigned zr[18][3];
#pragma unroll
  for (int i = 0; i < 18; ++i) {
    const int l = l0 - 1 + i;
    const bool ok = (l >= 0) && (l < 4096);
    const int lc = ok ? l : l0;
#pragma unroll
    for (int s2 = 0; s2 < 3; ++s2) {
      const unsigned v = *(const unsigned*)(Z + (size_t)lc * 1536 + s2 * 512 + c);
      zr[i][s2] = ok ? v : 0u;
    }
  }
#pragma unroll
  for (int i = 0; i < 16; ++i) {
    float cv0[3], cv1[3];
#pragma unroll
    for (int s2 = 0; s2 < 3; ++s2) {
      cv0[s2] = bflo(zr[i][s2]) * w[s2][0][0] + bflo(zr[i + 1][s2]) * w[s2][1][0] + bflo(zr[i + 2][s2]) * w[s2][2][0] + bias[s2][0];
      cv1[s2] = bfhi(zr[i][s2]) * w[s2][0][1] + bfhi(zr[i + 1][s2]) * w[s2][1][1] + bfhi(zr[i + 2][s2]) * w[s2][2][1] + bias[s2][1];
    }
    su[(ch2 * 2) * 66 + tq * 16 + i] = f2bf(cv0[2] * cv0[1]);
    su[(ch2 * 2 + 1) * 66 + tq * 16 + i] = f2bf(cv1[2] * cv1[1]);
    sx[(ch2 * 2) * 66 + tq * 16 + i] = f2bf(cv0[0]);
    sx[(ch2 * 2 + 1) * 66 + tq * 16 + i] = f2bf(cv1[0]);
  }
  __syncthreads();
  const int chr = tid >> 1, part = tid & 1;
  const int cc = cb * 128 + chr;
  const unsigned* ru = (const unsigned*)(su + chr * 66 + part * 32);
  const unsigned* rx = (const unsigned*)(sx + chr * 66 + part * 32);
  u16* UT = (u16*)((char*)p.out + OO_UT) + ((size_t)(cc * 4 + b) * 4096 + tb * 64 + part * 32);
  u16* XT = (u16*)((char*)p.out + OO_X0T) + ((size_t)(cc * 4 + b) * 4096 + tb * 64 + part * 32);
#pragma unroll
  for (int q = 0; q < 4; ++q) {
    ((uint4*)UT)[q] = make_uint4(ru[4 * q], ru[4 * q + 1], ru[4 * q + 2], ru[4 * q + 3]);
    ((uint4*)XT)[q] = make_uint4(rx[4 * q], rx[4 * q + 1], rx[4 * q + 2], rx[4 * q + 3]);
  }
  __syncthreads();
}

DEV void p3_toeplitz(const Params& p, int c, char* smem) {
  const int tid = threadIdx.x, lane = tid & 63, wave = tid >> 6, l15 = lane & 15, quad = lane >> 4;
  u16* sG0 = (u16*)smem;
  u16* sG1 = (u16*)(smem + 16384 + 64);
  u16* sU = (u16*)(smem + 32768 + 128);
  u16* sZ = sU + 4 * 64 * 72;
  const u16* G = (const u16*)((const char*)p.out + OO_G) + (size_t)c * 8192;
  const u16* UT = (const u16*)((const char*)p.out + OO_UT) + (size_t)c * 16384;
#pragma unroll
  for (int i = 0; i < 4; ++i) {
    const int id = tid + i * 256;
    *(uint4*)(sG0 + id * 8) = *(const uint4*)(G + id * 8);
  }
#pragma unroll
  for (int i = 0; i < 8; ++i) {
    const int id = tid + i * 256;
    const int bb = id >> 9, blk = (id >> 3) & 63, c8 = id & 7;
    *(uint4*)(sU + (bb * 64 + blk) * 72 + c8 * 8) = *(const uint4*)(UT + id * 8);
  }
  if (tid < 72) sZ[tid] = 0;
  __syncthreads();
  for (int i = tid; i < 8192; i += 256) sG1[i] = (i < 8191) ? sG0[i + 1] : (u16)0;
  __syncthreads();

  Acc acc; acc_zero(acc);
  const u16* gbase = (l15 & 1) ? sG0 : (sG1 - 1);
  const u16* ubase = sU + wave * 64 * 72 + quad * 8;
  const u16* zbase = sZ + quad * 8;
#define TOEP_LOADA(AF, D)                                                                 \
  {                                                                                       \
    const int base_ = 4095 - 64 * (D) - l15 + quad * 8;                                   \
    _Pragma("unroll") for (int mt = 0; mt < 4; ++mt)                                      \
      _Pragma("unroll") for (int ks = 0; ks < 2; ++ks) {                                  \
        const unsigned* gp = (const unsigned*)(gbase + base_ - mt * 16 + ks * 32);        \
        union { bf16x8 v; unsigned u[4]; } t_;                                            \
        t_.u[0] = gp[0]; t_.u[1] = gp[1]; t_.u[2] = gp[2]; t_.u[3] = gp[3];               \
        AF[mt][ks] = t_.v;                                                                \
      }                                                                                   \
  }
#define TOEP_MMA(AF, D)                                                                   \
  _Pragma("unroll") for (int nt = 0; nt < 4; ++nt) {                                      \
    if (!(nt * 16 + 15 - (D) < 0 || nt * 16 - (D) > 63)) {                                \
      const int ip = nt * 16 + l15 - (D);                                                 \
      const u16* up = (ip >= 0 && ip < 64) ? (ubase + ip * 72) : zbase;                   \
      bf16x8 b0 = *(const bf16x8*)(up);                                                   \
      bf16x8 b1 = *(const bf16x8*)(up + 32);                                              \
      _Pragma("unroll") for (int mt = 0; mt < 4; ++mt) {                                  \
        acc.v[mt][nt] = __builtin_amdgcn_mfma_f32_16x16x32_bf16(AF[mt][0], b0, acc.v[mt][nt], 0, 0, 0); \
        acc.v[mt][nt] = __builtin_amdgcn_mfma_f32_16x16x32_bf16(AF[mt][1], b1, acc.v[mt][nt], 0, 0, 0); \
      }                                                                                   \
    }                                                                                     \
  }
  {
    bf16x8 afA[4][2], afB[4][2];
    TOEP_LOADA(afA, -63)
#pragma unroll 1
    for (int d = -63; d <= 63; d += 2) {
      if (d + 1 <= 63) TOEP_LOADA(afB, d + 1)
      TOEP_MMA(afA, d)
      if (d + 1 <= 63) {
        if (d + 2 <= 63) TOEP_LOADA(afA, d + 2)
        TOEP_MMA(afB, d + 1)
      }
    }
  }
  const float ninv = 1.f / ((const float*)(p.ws + OFF_BAR + 20480))[c];
  const float skip = p.hy_skip[c];
  const u16* XT = (const u16*)((const char*)p.out + OO_X0T) + ((size_t)(c * 4 + wave) * 4096);
  u16* Y = (u16*)(p.ws + OFF_YHY);
#pragma unroll
  for (int nt = 0; nt < 4; ++nt) {
    const int ib = nt * 16 + l15;
#pragma unroll
    for (int mt = 0; mt < 4; ++mt) {
      const int r0 = mt * 16 + quad * 4;
      const int t = ib * 64 + r0;
      uint2 uu = *(const uint2*)(sU + (wave * 64 + ib) * 72 + r0);
      uint2 xx = *(const uint2*)(XT + t);
      float uv[4] = {bflo(uu.x), bfhi(uu.x), bflo(uu.y), bfhi(uu.y)};
      float xv[4] = {bflo(xx.x), bfhi(xx.x), bflo(xx.y), bfhi(xx.y)};
#pragma unroll
      for (int r = 0; r < 4; ++r) {
        float y = acc.v[mt][nt][r] * ninv + uv[r] * skip;
        Y[(size_t)(wave * 4096 + t + r) * 512 + c] = f2bf(y * xv[r]);
      }
    }
  }
  __syncthreads();
}

DEV void p4_merge(const Params& p, int tile, u16* sA, u16* sB) {
  const int mt = tile >> 3, nt = tile & 7;
  const int m0 = mt * 128, n0 = nt * 128;
  const int tid = threadIdx.x, lane = tid & 63, wave = tid >> 6, wm = wave >> 1, wn = wave & 1;
  const int l15 = lane & 15, quad = lane >> 4;
  const int mb = m0 + wm * 64, nb = n0 + wn * 64;
  const u16* gt = (const u16*)(p.ws + OFF_GATE);
  u16* mg = (u16*)(p.ws + OFF_MERGED);
  Acc a1; acc_zero(a1);
  gemm_kloop((const u16*)(p.ws + OFF_YATT), 512, (const u16*)(p.ws + OFF_WOA), 512, 512, m0, n0, sA, sB, a1);
  asm volatile("" ::: "memory");
#pragma unroll
  for (int j = 0; j < 4; ++j) {
    const int m = mb + j * 16 + l15;
#pragma unroll
    for (int i = 0; i < 4; ++i) {
      const int n = nb + i * 16 + quad * 4;
      uint2 ga = *(const uint2*)(gt + (size_t)m * 2048 + n);
      f32x4 x = a1.v[i][j];
      *(uint2*)(mg + (size_t)m * 1024 + n) = make_uint2(pack2(bflo(ga.x) * x[0], bfhi(ga.x) * x[1]), pack2(bflo(ga.y) * x[2], bfhi(ga.y) * x[3]));
    }
  }
  asm volatile("" ::: "memory");
  acc_zero(a1);
  gemm_kloop((const u16*)(p.ws + OFF_YHY), 512, (const u16*)(p.ws + OFF_WOH), 512, 512, m0, n0, sA, sB, a1);
  asm volatile("" ::: "memory");
#pragma unroll
  for (int j = 0; j < 4; ++j) {
    const int m = mb + j * 16 + l15;
#pragma unroll
    for (int i = 0; i < 4; ++i) {
      const int n = nb + i * 16 + quad * 4;
      uint2 gh = *(const uint2*)(gt + (size_t)m * 2048 + 1024 + n);
      uint2 pv = *(const uint2*)(mg + (size_t)m * 1024 + n);
      f32x4 y = a1.v[i][j];
      float o0 = bflo(pv.x) + bflo(gh.x) * y[0];
      float o1 = bfhi(pv.x) + bfhi(gh.x) * y[1];
      float o2 = bflo(pv.y) + bflo(gh.y) * y[2];
      float o3 = bfhi(pv.y) + bfhi(gh.y) * y[3];
      *(uint2*)(mg + (size_t)m * 1024 + n) = make_uint2(pack2(o0, o1), pack2(o2, o3));
    }
  }
}

DEV void p5_out(const Params& p, int tile, u16* sA, u16* sB) {
  const int mt = tile >> 3, nt = tile & 7;
  const int m0 = mt * 128, n0 = nt * 128;
  Acc acc; acc_zero(acc);
  gemm_kloop((const u16*)(p.ws + OFF_MERGED), 1024, (const u16*)(p.ws + OFF_WOUT), 1024, 1024, m0, n0, sA, sB, acc);
  const int tid = threadIdx.x, lane = tid & 63, wave = tid >> 6, wm = wave >> 1, wn = wave & 1;
  const int l15 = lane & 15, quad = lane >> 4;
  const int mb = m0 + wm * 64, nb = n0 + wn * 64;
  const float* mod = (const float*)(p.ws + OFF_MOD);
#pragma unroll
  for (int j = 0; j < 4; ++j) {
    const int m = mb + j * 16 + l15;
    const int b = m >> 12;
#pragma unroll
    for (int i = 0; i < 4; ++i) {
      const int n = nb + i * 16 + quad * 4;
      float4 g1 = *(const float4*)(mod + b * 6144 + 2048 + n);
      float4 xv = *(const float4*)(p.x + (size_t)m * 1024 + n);
      f32x4 a = acc.v[i][j];
      float4 o = make_float4(xv.x + g1.x * a[0], xv.y + g1.y * a[1], xv.z + g1.z * a[2], xv.w + g1.w * a[3]);
      *(float4*)(p.out + (size_t)m * 1024 + n) = o;
    }
  }
}

DEV void p7_qp(const Params& p, int tile, u16* sA, u16* sB) {
  const int mt = tile >> 3, nt = tile & 7;
  const int m0 = mt * 128, n0 = nt * 128;
  Acc acc; acc_zero(acc);
  gemm_kloop((const u16*)(p.ws + OFF_H2), 1024, (const u16*)(p.ws + OFF_WQ), 1024, 1024, m0, n0, sA, sB, acc);
  const int tid = threadIdx.x, lane = tid & 63, wave = tid >> 6, wm = wave >> 1, wn = wave & 1;
  const int l15 = lane & 15, quad = lane >> 4;
  const int mb = m0 + wm * 64, nb = n0 + wn * 64;
  u16* qp = (u16*)(p.ws + OFF_QP);
#pragma unroll
  for (int j = 0; j < 4; ++j) {
    const int m = mb + j * 16 + l15;
#pragma unroll
    for (int i = 0; i < 4; ++i) {
      const int n = nb + i * 16 + quad * 4;
      f32x4 a = acc.v[i][j];
      *(uint2*)(qp + (size_t)m * 1024 + n) = make_uint2(pack2(a[0], a[1]), pack2(a[2], a[3]));
    }
  }
}

DEV unsigned f2ord(float f) {
  const unsigned u = __float_as_uint(f);
  return u ^ (((int)u >> 31) | 0x80000000u);
}
DEV float ord2f(unsigned k) {
  const unsigned m = (k & 0x80000000u) ? 0x80000000u : 0xffffffffu;
  return __uint_as_float(k ^ m);
}
DEV unsigned umax_(unsigned a, unsigned b) { return a > b ? a : b; }
DEV unsigned umin_(unsigned a, unsigned b) { return a < b ? a : b; }

DEV void sort16_desc(unsigned (&v)[16]) {
#pragma unroll
  for (int k = 2; k <= 16; k <<= 1)
#pragma unroll
    for (int j = k >> 1; j > 0; j >>= 1)
#pragma unroll
      for (int i = 0; i < 16; ++i) {
        const int l = i ^ j;
        if (l > i) {
          const bool desc = ((i & k) == 0);
          const unsigned a = v[i], b = v[l];
          const unsigned hi = umax_(a, b), lo = umin_(a, b);
          v[i] = desc ? hi : lo;
          v[l] = desc ? lo : hi;
        }
      }
}
DEV void merge16_desc(unsigned (&v)[16]) {
#pragma unroll
  for (int j = 8; j > 0; j >>= 1)
#pragma unroll
    for (int i = 0; i < 16; ++i) {
      const int l = i ^ j;
      if (l > i) {
        const unsigned a = v[i], b = v[l];
        v[i] = umax_(a, b);
        v[l] = umin_(a, b);
      }
    }
}
DEV void xmerge16(unsigned (&v)[16], int off) {
  unsigned pr[16];
#pragma unroll
  for (int i = 0; i < 16; ++i) pr[i] = (unsigned)__shfl_xor((int)v[i], off);
#pragma unroll
  for (int i = 0; i < 16; ++i) v[i] = umax_(v[i], pr[15 - i]);
  merge16_desc(v);
}

DEV void route_top16_of_128(const u16* __restrict__ keys, const u16* __restrict__ qp, int l15, int quad, unsigned (&out)[16]) {
  bf16x8 b0 = *(const bf16x8*)(qp);
  bf16x8 b1 = *(const bf16x8*)(qp + 32);
  unsigned ka[16], kb[16];
#pragma unroll
  for (int kt = 0; kt < 8; ++kt) {
    bf16x8 a0 = *(const bf16x8*)(keys + (kt * 16 + l15) * 64 + quad * 8);
    bf16x8 a1 = *(const bf16x8*)(keys + (kt * 16 + l15) * 64 + 32 + quad * 8);
    f32x4 z = (f32x4){0.f, 0.f, 0.f, 0.f};
    z = __builtin_amdgcn_mfma_f32_16x16x32_bf16(a0, b0, z, 0, 0, 0);
    z = __builtin_amdgcn_mfma_f32_16x16x32_bf16(a1, b1, z, 0, 0, 0);
#pragma unroll
    for (int r = 0; r < 4; ++r) {
      const unsigned key = (f2ord(z[r]) & ~127u) | (unsigned)(kt * 16 + quad * 4 + r);
      if (kt < 4) ka[kt * 4 + r] = key; else kb[(kt - 4) * 4 + r] = key;
    }
  }
  sort16_desc(ka);
  sort16_desc(kb);
#pragma unroll
  for (int i = 0; i < 16; ++i) out[i] = umax_(ka[i], kb[15 - i]);
  merge16_desc(out);
  xmerge16(out, 16);
  xmerge16(out, 32);
}

__device__ const unsigned char kTabG[52] = {
    0x00, 0x01, 0x02, 0x03, 0x04, 0x05, 0x06, 0x07, 0x08, 0x09, 0x0A, 0x0B, 0x0C, 0x0D, 0x0E, 0x0F,
    0x10, 0x11, 0x12, 0x13, 0x14, 0x15, 0x16, 0x17, 0x20, 0x21, 0x22, 0x23, 0x24, 0x30, 0x31, 0x32, 0x33,
    0x40, 0x41, 0x42, 0x50, 0x51, 0x60, 0x61, 0x70, 0x71, 0x80, 0x90, 0xA0, 0xB0, 0xC0, 0xD0, 0xE0, 0xF0, 0x00, 0x00};

DEV void p8_route(const Params& p, int task, char* wsm, const unsigned char* kTab) {
  const int lane = threadIdx.x & 63, l15 = lane & 15, quad = lane >> 4;
  const int h = task & 7, tt = task >> 3;
  const int t0 = tt * 16;
  float* s1v = (float*)wsm;
  float* s2v = s1v + 256;
  int* i1 = (int*)(s2v + 256);
  int* i2 = i1 + 256;
  const u16* keys = (const u16*)(p.ws + OFF_KEYS) + (size_t)(h * 2) * 128 * 64;
  const u16* qp = (const u16*)(p.ws + OFF_QP) + (size_t)(t0 + l15) * 1024 + h * 128 + quad * 8;
  unsigned l1[16], l2[16];
  route_top16_of_128(keys, qp, l15, quad, l1);
  route_top16_of_128(keys + 128 * 64, qp + 64, l15, quad, l2);
  if (quad == 0) {
#pragma unroll
    for (int i = 0; i < 16; ++i) { s1v[l15 * 16 + i] = ord2f(l1[i] & ~127u); i1[l15 * 16 + i] = (int)(l1[i] & 127u); }
  } else if (quad == 1) {
#pragma unroll
    for (int i = 0; i < 16; ++i) { s2v[l15 * 16 + i] = ord2f(l2[i] & ~127u); i2[l15 * 16 + i] = (int)(l2[i] & 127u); }
  }
  __builtin_amdgcn_fence(__ATOMIC_RELEASE, "wavefront");
  __builtin_amdgcn_wave_barrier();
  __builtin_amdgcn_fence(__ATOMIC_ACQUIRE, "wavefront");
  unsigned ck[16];
#pragma unroll
  for (int s = 0; s < 16; ++s) {
    const int c = quad + 4 * s;
    unsigned key = 0u;
    if (s < 13 && c < 50) {
      const unsigned ab = kTab[c];
      const float val = s1v[l15 * 16 + (ab >> 4)] + s2v[l15 * 16 + (ab & 15)];
      key = (f2ord(val) & ~255u) | ab;
    }
    ck[s] = key;
  }
  sort16_desc(ck);
  xmerge16(ck, 16);
  xmerge16(ck, 32);
  if (quad == 0) {
    float e[16];
    const float vmax = ord2f(ck[0] & ~255u);
    float ssum = 0.f;
#pragma unroll
    for (int i = 0; i < 16; ++i) { e[i] = __expf(ord2f(ck[i] & ~255u) - vmax); ssum += e[i]; }
    const float inv = __builtin_amdgcn_rcpf(ssum);
    int* ridx = (int*)(p.ws + OFF_RIDX) + (size_t)(t0 + l15) * 128 + h * 16;
    float* rw = (float*)(p.ws + OFF_RW) + (size_t)(t0 + l15) * 128 + h * 16;
#pragma unroll
    for (int i = 0; i < 16; i += 4) {
      int ee[4]; float ww[4];
#pragma unroll
      for (int j = 0; j < 4; ++j) {
        const unsigned ab = ck[i + j] & 255u;
        ee[j] = i1[l15 * 16 + (ab >> 4)] * 128 + i2[l15 * 16 + (ab & 15)];
        ww[j] = e[i + j] * inv;
      }
      *(int4*)(ridx + i) = make_int4(ee[0], ee[1], ee[2], ee[3]);
      *(float4*)(rw + i) = make_float4(ww[0], ww[1], ww[2], ww[3]);
    }
  }
  __builtin_amdgcn_fence(__ATOMIC_RELEASE, "wavefront");
  __builtin_amdgcn_wave_barrier();
}

DEV float gelu_tanh(float x) {
  const float u2 = 1.5957691216057308f * (x + 0.044715f * x * x * x);
  return x * __builtin_amdgcn_rcpf(1.f + __expf(-u2));
}

DEV void unpack8(const uint4& q, float* f) {
  f[0] = bflo(q.x); f[1] = bfhi(q.x); f[2] = bflo(q.y); f[3] = bfhi(q.y);
  f[4] = bflo(q.z); f[5] = bfhi(q.z); f[6] = bflo(q.w); f[7] = bfhi(q.w);
}

DEV float dpp_add(float v, const int ctrl_sel) {
  return v;
}
typedef __attribute__((ext_vector_type(2))) __bf16 bf2_t;
DEV float dot2bf(unsigned a, unsigned b, float c) {
  return __builtin_amdgcn_fdot2_f32_bf16(__builtin_bit_cast(bf2_t, a), __builtin_bit_cast(bf2_t, b), c, false);
}

DEV float reduce4_rows(float d0, float d1, float d2, float d3, int lane) {
  const bool up32 = (lane & 32) != 0, up16 = (lane & 16) != 0;
  float k0 = up32 ? d2 : d0, k1 = up32 ? d3 : d1;
  const float s0 = up32 ? d0 : d2, s1 = up32 ? d1 : d3;
  k0 += __shfl_xor(s0, 32);
  k1 += __shfl_xor(s1, 32);
  float kq = up16 ? k1 : k0;
  const float sq = up16 ? k0 : k1;
  kq += __shfl_xor(sq, 16);
  kq = DPP_ADD(kq, 0xB1);
  kq = DPP_ADD(kq, 0x4E);
  kq = DPP_ADD(kq, 0x141);
  kq = DPP_ADD(kq, 0x140);
  return kq;
}

DEV void p9_token(const Params& p, int t, int tnext, int lane, int2& e2n, float2& w2n, u32x4& han, u32x4& hbn) {
  const unsigned char* U8 = (const unsigned char*)(p.ws + OFF_UBF);
  const unsigned char* V8 = (const unsigned char*)(p.ws + OFF_VBF);
  const int2 e2 = e2n;
  const float2 w2 = w2n;
  const u32x4 ha = han, hb = hbn;
  {
    e2n = *(const int2*)((const int*)(p.ws + OFF_RIDX) + (size_t)tnext * 128 + 2 * lane);
    w2n = *(const float2*)((const float*)(p.ws + OFF_RW) + (size_t)tnext * 128 + 2 * lane);
    const u16* h2 = (const u16*)(p.ws + OFF_H2) + (size_t)tnext * 1024 + 16 * lane;
    han = *(const u32x4*)(h2);
    hbn = *(const u32x4*)(h2 + 8);
  }
  float hf[16];
  hf[0] = bflo(ha.x); hf[1] = bfhi(ha.x); hf[2] = bflo(ha.y); hf[3] = bfhi(ha.y);
  hf[4] = bflo(ha.z); hf[5] = bfhi(ha.z); hf[6] = bflo(ha.w); hf[7] = bfhi(ha.w);
  hf[8] = bflo(hb.x); hf[9] = bfhi(hb.x); hf[10] = bflo(hb.y); hf[11] = bfhi(hb.y);
  hf[12] = bflo(hb.z); hf[13] = bfhi(hb.z); hf[14] = bflo(hb.w); hf[15] = bfhi(hb.w);
  float o[16];
#pragma unroll
  for (int k = 0; k < 16; ++k) o[k] = 0.f;
#pragma unroll 1
  for (int g = 0; g < 128; g += 16) {
    u32x4 uu[16], vv[16];
    float wj[16];
#pragma unroll
    for (int j = 0; j < 16; ++j) {
      const int src = (g >> 1) + (j >> 1);
      const int ej = (j & 1) ? __builtin_amdgcn_readlane(e2.y, src) : __builtin_amdgcn_readlane(e2.x, src);
      wj[j] = __builtin_bit_cast(float, (j & 1) ? __builtin_amdgcn_readlane(__builtin_bit_cast(int, w2.y), src)
                                                : __builtin_amdgcn_readlane(__builtin_bit_cast(int, w2.x), src));
      const size_t ro = (size_t)ej * 1024 + 16 * lane;
      uu[j] = *(const u32x4*)(U8 + ro);
      vv[j] = *(const u32x4*)(V8 + ro);
    }
    float d[16];
#pragma unroll
    for (int j = 0; j < 16; ++j) {
      const f32x2 l0 = __builtin_amdgcn_cvt_pk_f32_fp8((int)uu[j].x, false), h0 = __builtin_amdgcn_cvt_pk_f32_fp8((int)uu[j].x, true);
      const f32x2 l1 = __builtin_amdgcn_cvt_pk_f32_fp8((int)uu[j].y, false), h1 = __builtin_amdgcn_cvt_pk_f32_fp8((int)uu[j].y, true);
      const f32x2 l2 = __builtin_amdgcn_cvt_pk_f32_fp8((int)uu[j].z, false), h2v = __builtin_amdgcn_cvt_pk_f32_fp8((int)uu[j].z, true);
      const f32x2 l3 = __builtin_amdgcn_cvt_pk_f32_fp8((int)uu[j].w, false), h3 = __builtin_amdgcn_cvt_pk_f32_fp8((int)uu[j].w, true);
      float a0 = l0.x * hf[0] + l0.y * hf[1], a1 = h0.x * hf[2] + h0.y * hf[3];
      a0 += l1.x * hf[4] + l1.y * hf[5]; a1 += h1.x * hf[6] + h1.y * hf[7];
      a0 += l2.x * hf[8] + l2.y * hf[9]; a1 += h2v.x * hf[10] + h2v.y * hf[11];
      a0 += l3.x * hf[12] + l3.y * hf[13]; a1 += h3.x * hf[14] + h3.y * hf[15];
      d[j] = a0 + a1;
    }
#pragma unroll
    for (int q = 0; q < 4; ++q) {
      const float dot = reduce4_rows(d[4 * q], d[4 * q + 1], d[4 * q + 2], d[4 * q + 3], lane);
      const float gl = gelu_tanh(dot * (1.f / 512.f)) * (1.f / 64.f);
#pragma unroll
      for (int i = 0; i < 4; ++i) {
        const int j = 4 * q + i;
        const float ci = wj[j] * __builtin_bit_cast(float, __builtin_amdgcn_readlane(__builtin_bit_cast(int, gl), 16 * i));
        f32x2 tq;
        tq = __builtin_amdgcn_cvt_pk_f32_fp8((int)vv[j].x, false); o[0] += ci * tq.x; o[1] += ci * tq.y;
        tq = __builtin_amdgcn_cvt_pk_f32_fp8((int)vv[j].x, true);  o[2] += ci * tq.x; o[3] += ci * tq.y;
        tq = __builtin_amdgcn_cvt_pk_f32_fp8((int)vv[j].y, false); o[4] += ci * tq.x; o[5] += ci * tq.y;
        tq = __builtin_amdgcn_cvt_pk_f32_fp8((int)vv[j].y, true);  o[6] += ci * tq.x; o[7] += ci * tq.y;
        tq = __builtin_amdgcn_cvt_pk_f32_fp8((int)vv[j].z, false); o[8] += ci * tq.x; o[9] += ci * tq.y;
        tq = __builtin_amdgcn_cvt_pk_f32_fp8((int)vv[j].z, true);  o[10] += ci * tq.x; o[11] += ci * tq.y;
        tq = __builtin_amdgcn_cvt_pk_f32_fp8((int)vv[j].w, false); o[12] += ci * tq.x; o[13] += ci * tq.y;
        tq = __builtin_amdgcn_cvt_pk_f32_fp8((int)vv[j].w, true);  o[14] += ci * tq.x; o[15] += ci * tq.y;
      }
    }
  }
  const int b = t >> 12;
  const float* mod = (const float*)(p.ws + OFF_MOD) + b * 6144 + 5120 + 16 * lane;
  float* xm = p.out + (size_t)t * 1024 + 16 * lane;
  float xo[16];
  float ss = 0.f;
#pragma unroll
  for (int q = 0; q < 4; ++q) {
    const float4 xv = *(const float4*)(xm + 4 * q);
    const float4 gv = *(const float4*)(mod + 4 * q);
    xo[4 * q + 0] = xv.x + gv.x * o[4 * q + 0];
    xo[4 * q + 1] = xv.y + gv.y * o[4 * q + 1];
    xo[4 * q + 2] = xv.z + gv.z * o[4 * q + 2];
    xo[4 * q + 3] = xv.w + gv.w * o[4 * q + 3];
  }
#pragma unroll
  for (int k = 0; k < 16; ++k) ss += xo[k] * xo[k];
  ss = wave_sum(ss);
  const float r = rsqrtf(ss * (1.f / 1024.f) + 1e-6f);
#pragma unroll
  for (int q = 0; q < 4; ++q) {
    const float4 fg = *(const float4*)(p.final_g + 16 * lane + 4 * q);
    *(float4*)(xm + 4 * q) = make_float4(xo[4 * q] * r * fg.x, xo[4 * q + 1] * r * fg.y, xo[4 * q + 2] * r * fg.z, xo[4 * q + 3] * r * fg.w);
  }
}

DEV void p9_experts4(const Params& p, int task, char* wsm) {
  const int lane = threadIdx.x & 63;
  const int t0 = task * 4;
  int* hist = (int*)wsm;
  unsigned* skey = (unsigned*)(wsm + 1024);
  float* swt = (float*)(wsm + 1024 + 2048);
  u16* sh2 = (u16*)(wsm + 1024 + 4096);
  hist[lane] = 0; hist[lane + 64] = 0; hist[lane + 128] = 0; hist[lane + 192] = 0;
  const int* ridx = (const int*)(p.ws + OFF_RIDX) + (size_t)t0 * 128 + lane * 8;
  const float* rw = (const float*)(p.ws + OFF_RW) + (size_t)t0 * 128 + lane * 8;
  int4 ea = *(const int4*)(ridx), eb = *(const int4*)(ridx + 4);
  float4 wa = *(const float4*)(rw), wb = *(const float4*)(rw + 4);
  int e[8] = {ea.x, ea.y, ea.z, ea.w, eb.x, eb.y, eb.z, eb.w};
  float w[8] = {wa.x, wa.y, wa.z, wa.w, wb.x, wb.y, wb.z, wb.w};
  {
    const u16* h2 = (const u16*)(p.ws + OFF_H2) + (size_t)t0 * 1024;
#pragma unroll
    for (int i = 0; i < 8; ++i) *(u32x4*)(sh2 + (lane + 64 * i) * 8) = *(const u32x4*)(h2 + (lane + 64 * i) * 8);
  }
  __builtin_amdgcn_fence(__ATOMIC_RELEASE, "wavefront");
  __builtin_amdgcn_wave_barrier();
  __builtin_amdgcn_fence(__ATOMIC_ACQUIRE, "wavefront");
  int rank[8];
#pragma unroll
  for (int j = 0; j < 8; ++j) rank[j] = atomicAdd(&hist[e[j] >> 6], 1);
  __builtin_amdgcn_fence(__ATOMIC_RELEASE, "wavefront");
  __builtin_amdgcn_wave_barrier();
  __builtin_amdgcn_fence(__ATOMIC_ACQUIRE, "wavefront");
  {
    const int c0 = hist[4 * lane], c1 = hist[4 * lane + 1], c2 = hist[4 * lane + 2], c3 = hist[4 * lane + 3];
    const int tot = c0 + c1 + c2 + c3;
    int x = tot;
#pragma unroll
    for (int o = 1; o < 64; o <<= 1) { const int y = __shfl_up(x, o); if (lane >= o) x += y; }
    const int base = x - tot;
    __builtin_amdgcn_fence(__ATOMIC_RELEASE, "wavefront");
    __builtin_amdgcn_wave_barrier();
    hist[4 * lane] = base; hist[4 * lane + 1] = base + c0; hist[4 * lane + 2] = base + c0 + c1; hist[4 * lane + 3] = base + c0 + c1 + c2;
  }
  __builtin_amdgcn_fence(__ATOMIC_RELEASE, "wavefront");
  __builtin_amdgcn_wave_barrier();
  __builtin_amdgcn_fence(__ATOMIC_ACQUIRE, "wavefront");
  {
    const unsigned slot = (unsigned)(lane >> 4);
#pragma unroll
    for (int j = 0; j < 8; ++j) {
      const int pos = hist[e[j] >> 6] + rank[j];
      skey[pos] = (unsigned)e[j] | (slot << 14);
      swt[pos] = w[j];
    }
  }
  __builtin_amdgcn_fence(__ATOMIC_RELEASE, "wavefront");
  __builtin_amdgcn_wave_barrier();
  __builtin_amdgcn_fence(__ATOMIC_ACQUIRE, "wavefront");

  float o0[16], o1[16], o2[16], o3[16];
#pragma unroll
  for (int k = 0; k < 16; ++k) { o0[k] = 0.f; o1[k] = 0.f; o2[k] = 0.f; o3[k] = 0.f; }
  const u16* U = (const u16*)(p.ws + OFF_UBF);
  const u16* V = (const u16*)(p.ws + OFF_VBF);
#define P9_LOAD(KK, UU, VV, BB)                                                           \
  _Pragma("unroll") for (int i = 0; i < 4; ++i) {                                         \
    KK[i] = (unsigned)__builtin_amdgcn_readfirstlane((int)skey[4 * (BB) + i]);            \
    const size_t ro = (size_t)(KK[i] & 16383u) * 1024 + 16 * lane;                        \
    UU[i] = *(const u32x4*)(U8 + ro);                                                     \
    VV[i] = *(const u32x4*)(V8 + ro);                                                     \
  }
#define P9_DOTS(KK, UU, BB, COEFV)                                                        \
  {                                                                                       \
    const float myw = swt[4 * (BB) + (lane >> 4)];                                        \
    float d[4];                                                                           \
    _Pragma("unroll") for (int i = 0; i < 4; ++i) {                                       \
      const unsigned slot = KK[i] >> 14;                                                  \
      const u32x4 ha = *(const u32x4*)(sh2 + slot * 1024 + 16 * lane);                    \
      const u32x4 hb = *(const u32x4*)(sh2 + slot * 1024 + 16 * lane + 8);                \
      float acc0 = 0.f, acc1 = 0.f;                                                       \
      {                                                                                   \
        f32x2 l0 = __builtin_amdgcn_cvt_pk_f32_fp8((int)UU[i].x, false), h0 = __builtin_amdgcn_cvt_pk_f32_fp8((int)UU[i].x, true); \
        f32x2 l1 = __builtin_amdgcn_cvt_pk_f32_fp8((int)UU[i].y, false), h1 = __builtin_amdgcn_cvt_pk_f32_fp8((int)UU[i].y, true); \
        f32x2 l2 = __builtin_amdgcn_cvt_pk_f32_fp8((int)UU[i].z, false), h2_ = __builtin_amdgcn_cvt_pk_f32_fp8((int)UU[i].z, true); \
        f32x2 l3 = __builtin_amdgcn_cvt_pk_f32_fp8((int)UU[i].w, false), h3 = __builtin_amdgcn_cvt_pk_f32_fp8((int)UU[i].w, true); \
        acc0 += l0.x * bflo(ha.x) + l0.y * bfhi(ha.x); acc1 += h0.x * bflo(ha.y) + h0.y * bfhi(ha.y);   \
        acc0 += l1.x * bflo(ha.z) + l1.y * bfhi(ha.z); acc1 += h1.x * bflo(ha.w) + h1.y * bfhi(ha.w);   \
        acc0 += l2.x * bflo(hb.x) + l2.y * bfhi(hb.x); acc1 += h2_.x * bflo(hb.y) + h2_.y * bfhi(hb.y); \
        acc0 += l3.x * bflo(hb.z) + l3.y * bfhi(hb.z); acc1 += h3.x * bflo(hb.w) + h3.y * bfhi(hb.w);   \
      }                                                                                   \
      d[i] = acc0 + acc1;                                                                 \
    }                                                                                     \
    const bool up32 = (lane & 32) != 0, up16 = (lane & 16) != 0;                          \
    float k0 = up32 ? d[2] : d[0], k1 = up32 ? d[3] : d[1];                               \
    float s0 = up32 ? d[0] : d[2], s1 = up32 ? d[1] : d[3];                               \
    k0 += __shfl_xor(s0, 32);                                                             \
    k1 += __shfl_xor(s1, 32);                                                             \
    float kq = up16 ? k1 : k0, sq = up16 ? k0 : k1;                                       \
    kq += __shfl_xor(sq, 16);                                                             \
    kq = DPP_ADD(kq, 0xB1);                                                               \
    kq = DPP_ADD(kq, 0x4E);                                                               \
    kq = DPP_ADD(kq, 0x141);                                                              \
    kq = DPP_ADD(kq, 0x140);                                                              \
    COEFV = myw * (1.f / 64.f) * gelu_tanh(kq * (1.f / 512.f));                           \
  }
#define P9_ACCUM(KK, VV, COEFV)                                                           \
  _Pragma("unroll") for (int i = 0; i < 4; ++i) {                                         \
    const float ci = __builtin_bit_cast(float, __builtin_amdgcn_readlane(__builtin_bit_cast(int, COEFV), 16 * i)); \
    const unsigned slot = KK[i] >> 14;                                                    \
    float vf[16];                                                                         \
    {                                                                                     \
      f32x2 t;                                                                            \
      t = __builtin_amdgcn_cvt_pk_f32_fp8((int)VV[i].x, false); vf[0] = t.x; vf[1] = t.y;   \
      t = __builtin_amdgcn_cvt_pk_f32_fp8((int)VV[i].x, true);  vf[2] = t.x; vf[3] = t.y;   \
      t = __builtin_amdgcn_cvt_pk_f32_fp8((int)VV[i].y, false); vf[4] = t.x; vf[5] = t.y;   \
      t = __builtin_amdgcn_cvt_pk_f32_fp8((int)VV[i].y, true);  vf[6] = t.x; vf[7] = t.y;   \
      t = __builtin_amdgcn_cvt_pk_f32_fp8((int)VV[i].z, false); vf[8] = t.x; vf[9] = t.y;   \
      t = __builtin_amdgcn_cvt_pk_f32_fp8((int)VV[i].z, true);  vf[10] = t.x; vf[11] = t.y; \
      t = __builtin_amdgcn_cvt_pk_f32_fp8((int)VV[i].w, false); vf[12] = t.x; vf[13] = t.y; \
      t = __builtin_amdgcn_cvt_pk_f32_fp8((int)VV[i].w, true);  vf[14] = t.x; vf[15] = t.y; \
    }                                                                                     \
    if (slot == 0) { _Pragma("unroll") for (int k = 0; k < 16; ++k) o0[k] += ci * vf[k]; }       \
    else if (slot == 1) { _Pragma("unroll") for (int k = 0; k < 16; ++k) o1[k] += ci * vf[k]; }  \
    else if (slot == 2) { _Pragma("unroll") for (int k = 0; k < 16; ++k) o2[k] += ci * vf[k]; }  \
    else { _Pragma("unroll") for (int k = 0; k < 16; ++k) o3[k] += ci * vf[k]; }                 \
  }
  {
    const unsigned char* U8 = (const unsigned char*)(p.ws + OFF_UBF);
    const unsigned char* V8 = (const unsigned char*)(p.ws + OFF_VBF);
    unsigned kkA[4], kkB[4];
    u32x4 uA[4], vA[4], uB[4], vB[4];
    float cfA, cfB;
    P9_LOAD(kkA, uA, vA, 0)
#pragma unroll 1
    for (int bb = 0; bb < 128; bb += 2) {
      P9_LOAD(kkB, uB, vB, bb + 1)
      P9_DOTS(kkA, uA, bb, cfA)
      P9_ACCUM(kkA, vA, cfA)
      const int n0 = (bb + 2 < 128) ? (bb + 2) : 0;
      P9_LOAD(kkA, uA, vA, n0)
      P9_DOTS(kkB, uB, bb + 1, cfB)
      P9_ACCUM(kkB, vB, cfB)
    }
  }
#pragma unroll
  for (int s = 0; s < 4; ++s) {
    const int t = t0 + s;
    const int b = t >> 12;
    const float* mod = (const float*)(p.ws + OFF_MOD) + b * 6144 + 5120 + 16 * lane;
    float* xm = p.out + (size_t)t * 1024 + 16 * lane;
    const float* oo = (s == 0) ? o0 : ((s == 1) ? o1 : ((s == 2) ? o2 : o3));
    float xo[16];
    float ss = 0.f;
#pragma unroll
    for (int q = 0; q < 4; ++q) {
      const float4 xv = *(const float4*)(xm + 4 * q);
      const float4 gv = *(const float4*)(mod + 4 * q);
      xo[4 * q + 0] = xv.x + gv.x * oo[4 * q + 0];
      xo[4 * q + 1] = xv.y + gv.y * oo[4 * q + 1];
      xo[4 * q + 2] = xv.z + gv.z * oo[4 * q + 2];
      xo[4 * q + 3] = xv.w + gv.w * oo[4 * q + 3];
    }
#pragma unroll
    for (int k = 0; k < 16; ++k) ss += xo[k] * xo[k];
    ss = wave_sum(ss);
    const float r = rsqrtf(ss * (1.f / 1024.f) + 1e-6f);
#pragma unroll
    for (int q = 0; q < 4; ++q) {
      const float4 fg = *(const float4*)(p.final_g + 16 * lane + 4 * q);
      *(float4*)(xm + 4 * q) = make_float4(xo[4 * q] * r * fg.x, xo[4 * q + 1] * r * fg.y, xo[4 * q + 2] * r * fg.z, xo[4 * q + 3] * r * fg.w);
    }
  }
  __builtin_amdgcn_fence(__ATOMIC_RELEASE, "wavefront");
  __builtin_amdgcn_wave_barrier();
}

#define XB_TMO      128
#define XB_XCNT(j)  (256  + 64 * (j))
#define XB_XSUB(j)  (1280 + 64 * (j))
#define XB_XGEN(j)  (2304 + 64 * (j))
#define XB_TOP      3328
#define XB_TOPGEN   3392
#define XCD_BAR_WORDS 3456
#define XB_SPIN_CAP (1u << 18)
#define LAS __attribute__((address_space(3)))

__device__ __forceinline__ unsigned xb_ld(unsigned* p)              { return __hip_atomic_load(p, __ATOMIC_RELAXED, __HIP_MEMORY_SCOPE_AGENT); }
__device__ __forceinline__ unsigned xb_add(unsigned* p, unsigned v) { return __hip_atomic_fetch_add(p, v, __ATOMIC_RELAXED, __HIP_MEMORY_SCOPE_AGENT); }
__device__ __forceinline__ unsigned xb_xcc_id() { return (unsigned)__builtin_amdgcn_s_getreg((3 << 11) | 20) & 0xFu; }
#define XB_SPIN(cond, bar) do { unsigned _sp = 0; while (cond) { __builtin_amdgcn_s_sleep(1); \
    if ((++_sp & 255u) == 0u) { if (xb_ld(&(bar)[XB_TMO])) break; if (_sp > XB_SPIN_CAP) { atomicAdd(&(bar)[XB_TMO], 1u); break; } } } } while (0)

struct XcdBarrier {
    unsigned* bar; unsigned x;
    volatile LAS unsigned* st;
};

__device__ __forceinline__ XcdBarrier xcd_barrier_post(unsigned* bar, volatile LAS unsigned* st) {
    XcdBarrier b; b.bar = bar; b.x = xb_xcc_id(); b.st = st;
    if (threadIdx.x == 0) (void)xb_add(&bar[XB_XCNT(b.x)], 1u);
    return b;
}
__device__ __forceinline__ void xcd_barrier_complete(unsigned* bar, unsigned x, unsigned& nloc, unsigned& nx) {
    const unsigned G = gridDim.x * gridDim.y * gridDim.z;
    unsigned sum, cnt, mine, sp = 0u;
    for (;;) {
        sum = 0u; cnt = 0u; mine = 0u;
#pragma unroll
        for (unsigned j = 0; j < 16; ++j) { const unsigned c = xb_ld(&bar[XB_XCNT(j)]); sum += c; cnt += (c > 0u) ? 1u : 0u; mine = (j == x) ? c : mine; }
        if (sum == G) break;
        __builtin_amdgcn_s_sleep(1);
        if ((++sp & 255u) == 0u) { if (xb_ld(&bar[XB_TMO])) break; if (sp > XB_SPIN_CAP) { atomicAdd(&bar[XB_TMO], 1u); break; } }
    }
    nloc = mine > 0u ? mine : 1u; nx = cnt > 0u ? cnt : 1u;
}

__device__ __forceinline__ void xcd_barrier(const XcdBarrier& b) {
    asm volatile("s_waitcnt vmcnt(0)" ::: "memory");
    __syncthreads();
    if (threadIdx.x == 0) {
        unsigned* bar = b.bar;
        __builtin_amdgcn_s_waitcnt(0);
        unsigned nloc = b.st[0], nx = b.st[1];
        if (nloc == 0u) { xcd_barrier_complete(bar, b.x, nloc, nx); b.st[0] = nloc; b.st[1] = nx; }
        const unsigned old = xb_add(&bar[XB_XSUB(b.x)], 1u);
        const unsigned gen = old / nloc;
        if (old + 1u == (gen + 1u) * nloc) {
            __builtin_amdgcn_fence(__ATOMIC_RELEASE, "agent");
            asm volatile("s_waitcnt vmcnt(0)" ::: "memory");
            const unsigned og = xb_add(&bar[XB_TOP], 1u);
            const unsigned tg = og / nx;
            if (og + 1u == (tg + 1u) * nx) xb_add(&bar[XB_TOPGEN], 1u);
            else XB_SPIN(xb_ld(&bar[XB_TOPGEN]) == tg, bar);
            __builtin_amdgcn_fence(__ATOMIC_ACQUIRE, "agent");
            xb_add(&bar[XB_XGEN(b.x)], 1u);
            asm volatile("s_waitcnt vmcnt(0)" ::: "memory");
        } else {
            XB_SPIN(xb_ld(&bar[XB_XGEN(b.x)]) == gen, bar);
            __builtin_amdgcn_fence(__ATOMIC_ACQUIRE, "agent");
            asm volatile("s_waitcnt vmcnt(0)" ::: "memory");
        }
    }
    __syncthreads();
}


__global__ void __launch_bounds__(256, 2) mega(Params p) {
  extern __shared__ __attribute__((aligned(16))) char smem[];
  cg::grid_group grid = cg::this_grid();
  const int tid = threadIdx.x, lane = tid & 63, wave = tid >> 6;
  const int nb = gridDim.x, bid = blockIdx.x;
  float* smf = (float*)smem;
  if (p.ws == nullptr) grid.sync();
  volatile LAS unsigned* xst = (volatile LAS unsigned*)(smem + SMEM_XB);
  if (tid == 0) { xst[0] = 0u; xst[1] = 0u; }
  __syncthreads();
  const XcdBarrier xb = xcd_barrier_post((unsigned*)(p.ws + OFF_BAR), xst);
  u16* sA = (u16*)smem;
  u16* sB = (u16*)(smem + 128 * 64 * 2);

  for (int rep_ = 0; rep_ < NREP(0); ++rep_) if (PHON(0)) {
    const int N_MOD = 384, N_TIN = 16 * 68, N_TOA = 8 * 16, N_TOH = 8 * 16, N_TOUT = 16 * 16, N_TQ = 16 * 16, N_HID = 1024;
    const int total = N_MOD + N_TIN + N_TOA + N_TOH + N_TOUT + N_TQ + N_HID + 16 + 1;
    for (int it = bid; it < total; it += nb) {
      int i = it;
      if (i < N_MOD) { p0_mod(p, i, smf); continue; }
      i -= N_MOD;
      if (i < N_TIN) { transpose_tile(p.w_in, INW, 1024, (u16*)(p.ws + OFF_WIN), i, smf); continue; }
      i -= N_TIN;
      if (i < N_TOA) { transpose_tile(p.w_o_attn, 1024, 512, (u16*)(p.ws + OFF_WOA), i, smf); continue; }
      i -= N_TOA;
      if (i < N_TOH) { transpose_tile(p.w_o_hy, 1024, 512, (u16*)(p.ws + OFF_WOH), i, smf); continue; }
      i -= N_TOH;
      if (i < N_TOUT) { transpose_tile(p.w_out, 1024, 1024, (u16*)(p.ws + OFF_WOUT), i, smf); continue; }
      i -= N_TOUT;
      if (i < N_TQ) { transpose_tile(p.peer_wq, 1024, 1024, (u16*)(p.ws + OFF_WQ), i, smf); continue; }
      i -= N_TQ;
      if (i < N_HID) { p0_hidden(p, i, smf); continue; }
      i -= N_HID;
      if (i < 16) { transpose_tile(p.hy_fw3, 1024, 64, (u16*)(p.ws + OFF_H2F + 512 * 1024), i, smf); continue; }
      float2* rope = (float2*)(p.ws + OFF_ROPE);
      for (int idx = tid; idx < 1024; idx += 256) {
        const int pos = idx >> 4, f = idx & 15;
        const float inv = powf(10000.f, -(float)f / 16.f);
        const float ang = (float)pos * inv;
        rope[idx] = make_float2(cosf(ang), sinf(ang));
      }
    }
    convert_flat(p.peer_keys, (u16*)(p.ws + OFF_KEYS), (size_t)131072);
    convert_flat_fp8(p.peer_u, (unsigned char*)(p.ws + OFF_UBF), (size_t)16384 * 1024, 512.f);
    convert_flat_fp8(p.peer_v, (unsigned char*)(p.ws + OFF_VBF), (size_t)16384 * 1024, 64.f);
  }
  xcd_barrier(xb);

  for (int rep_ = 0; rep_ < NREP(1); ++rep_) if (PHON(1)) {
    const float* mod = (const float*)(p.ws + OFF_MOD);
    const int nrows = T_TOK + 1024;
    for (int r = bid * 4 + wave; r < nrows; r += nb * 4) {
      if (r < T_TOK) {
        const int b = r >> 12;
        norm_row(p.x + (size_t)r * 1024, p.norm1_g, mod + b * 6144, mod + b * 6144 + 1024,
                 (u16*)((char*)p.out + OO_H1) + (size_t)r * 1024, lane);
      } else {
        const int rc = r - T_TOK;
        norm_row(p.ctx + (size_t)rc * 1024, p.norm1_g, mod + 4 * 6144, mod + 4 * 6144 + 1024,
                 (u16*)((char*)p.out + OO_HC) + (size_t)rc * 1024, lane);
      }
    }
    for (int it = bid; it < 256; it += nb) p1_filter_tile(p, (it + 256 < nb) ? it : it, sA, sB);
  }
  xcd_barrier(xb);

  for (int rep_ = 0; rep_ < NREP(2); ++rep_) if (PHON(2)) {
    if (nb == 512) {
      const int xg = bid & 7, slot = bid >> 3;
      for (int r = 0; r < 8; ++r) {
        const int sup = r * 8 + xg;
        const int mt = (sup >> 2) * 8 + (slot >> 3), nt = (sup & 3) * 8 + (slot & 7);
        p2_inproj(p, mt * 34 + nt, sA, sB);
      }
      if (bid < 256) p2_inproj(p, (bid >> 1) * 34 + 32 + (bid & 1), sA, sB);
      else if (bid < 272) p2_ctxkv(p, bid - 256, sA, sB);
    } else {
      const int total = 128 * 34 + 16;
      for (int it = bid; it < total; it += nb) {
        if (it < 128 * 34) p2_inproj(p, it, sA, sB);
        else p2_ctxkv(p, it - 128 * 34, sA, sB);
      }
    }
  }
  xcd_barrier(xb);

  for (int rep_ = 0; rep_ < NREP(3); ++rep_) if (PHON(3)) {
    const int total = 1024 + 1024;
    for (int it = bid; it < total; it += nb) {
      if (it < 1024) p3_attn(p, it, (u16*)smem, (u16*)(smem + 128 * 72 * 2));
      else p3_hypre(p, it - 1024, (u16*)smem);
    }
  }
  xcd_barrier(xb);

  for (int rep_ = 0; rep_ < NREP(4); ++rep_) if (PHON(4)) for (int it = bid; it < 512; it += nb) p3_toeplitz(p, it, smem);
  xcd_barrier(xb);

  for (int rep_ = 0; rep_ < NREP(5); ++rep_) if (PHON(5)) for (int it = bid; it < 1024; it += nb) p4_merge(p, (nb == 512) ? ((((it >> 9) * 8 + (bid & 7)) * 8 + (bid >> 6)) * 8 + ((bid >> 3) & 7)) : it, sA, sB);
  xcd_barrier(xb);

  for (int rep_ = 0; rep_ < NREP(6); ++rep_) if (PHON(6)) for (int it = bid; it < 1024; it += nb) p5_out(p, (nb == 512) ? ((((it >> 9) * 8 + (bid & 7)) * 8 + (bid >> 6)) * 8 + ((bid >> 3) & 7)) : it, sA, sB);
  xcd_barrier(xb);

  for (int rep_ = 0; rep_ < NREP(7); ++rep_) if (PHON(7)) {
    const float* mod = (const float*)(p.ws + OFF_MOD);
    for (int r = bid * 4 + wave; r < T_TOK; r += nb * 4) {
      const int b = r >> 12;
      norm_row(p.out + (size_t)r * 1024, p.norm2_g, mod + b * 6144 + 3072, mod + b * 6144 + 4096,
               (u16*)(p.ws + OFF_H2) + (size_t)r * 1024, lane);
    }
  }
  xcd_barrier(xb);

  for (int rep_ = 0; rep_ < NREP(8); ++rep_) if (PHON(8)) for (int it = bid; it < 1024; it += nb) p7_qp(p, (nb == 512) ? ((((it >> 9) * 8 + (bid & 7)) * 8 + (bid >> 6)) * 8 + ((bid >> 3) & 7)) : it, sA, sB);
  xcd_barrier(xb);

  for (int rep_ = 0; rep_ < NREP(9); ++rep_) if (PHON(9)) {
    if (tid < 52) ((unsigned char*)(smem + 16384))[tid] = kTabG[tid];
    __syncthreads();
    for (int it = bid * 4 + wave; it < 8192; it += nb * 4) p8_route(p, it, smem + wave * 4096, (const unsigned char*)(smem + 16384));
  }
  xcd_barrier(xb);

  if (PHON(10)) {
    const int nw = nb * 4;
    int t = bid * 4 + wave;
    if (t < T_TOK) {
      int2 e2n = *(const int2*)((const int*)(p.ws + OFF_RIDX) + (size_t)t * 128 + 2 * lane);
      float2 w2n = *(const float2*)((const float*)(p.ws + OFF_RW) + (size_t)t * 128 + 2 * lane);
      u32x4 han = *(const u32x4*)((const u16*)(p.ws + OFF_H2) + (size_t)t * 1024 + 16 * lane);
      u32x4 hbn = *(const u32x4*)((const u16*)(p.ws + OFF_H2) + (size_t)t * 1024 + 16 * lane + 8);
      for (; t < T_TOK; t += nw) {
        const int tn = (t + nw < T_TOK) ? (t + nw) : t;
        p9_token(p, t, tn, lane, e2n, w2n, han, hbn);
      }
    }
  }
}

extern "C" void kernel_launch(void* const* d_in, const int* in_sizes, int n_in, void* d_out, int out_size,
                              void* d_ws, size_t ws_size, hipStream_t stream) {
  static int grid_blocks = 0;
  if (!grid_blocks) {
    int dev = 0, cus = 0, per_cu = 0;
    (void)hipGetDevice(&dev);
    (void)hipDeviceGetAttribute(&cus, hipDeviceAttributeMultiprocessorCount, dev);
    (void)hipFuncSetAttribute((const void*)mega, hipFuncAttributeMaxDynamicSharedMemorySize, SMEM_BYTES);
    (void)hipOccupancyMaxActiveBlocksPerMultiprocessor(&per_cu, mega, 256, SMEM_BYTES);
    if (per_cu > 2) per_cu = 2;
    if (per_cu < 1) per_cu = 1;
    grid_blocks = cus * per_cu;
  }
  Params p{};
  const float** pp = (const float**)&p;
  for (int i = 0; i < 28; ++i) pp[i] = (const float*)d_in[i];
  p.out = (float*)d_out;
  p.ws = (char*)d_ws;
  (void)hipMemsetAsync((char*)d_ws, 0, OFF_BAR + 24576, stream);
  void* args[] = {&p};
  hipError_t e = hipLaunchCooperativeKernel((void*)mega, dim3(grid_blocks), dim3(256), args, SMEM_BYTES, stream);
  if (e != hipSuccess) fprintf(stderr, "cooperative launch failed: %s (grid %d)\n", hipGetErrorString(e), grid_blocks);
}
```

```cpp
#include <hip/hip_runtime.h>
#include <hip/hip_bf16.h>
#include <hip/hip_cooperative_groups.h>
#include <cstdio>
namespace cg = cooperative_groups;

typedef unsigned short u16;
typedef __attribute__((ext_vector_type(8))) short bf16x8;
typedef __attribute__((ext_vector_type(4))) float f32x4;
typedef __attribute__((ext_vector_type(4))) unsigned u32x4;

#define DEV __device__ __forceinline__
#ifndef PH
#define PH -1
#endif
#define PHON(n) (PH < 0 || PH == (n))
#ifndef REP
#define REP -1
#endif
#define NREP(n) ((REP == (n)) ? 2 : 1)

constexpr int T_TOK = 16384;
constexpr int DM = 1024;
constexpr int SEQL = 4096;
constexpr int INW = 4352;

struct Params {
  const float *x, *c, *ctx, *c_ctx, *w_mod, *b_mod, *norm1_g, *w_in, *attn_sink, *hy_conv_w, *hy_conv_b,
      *hy_fw1, *hy_fb1, *hy_fw2, *hy_fb2, *hy_fw3, *hy_fb3, *hy_freq, *hy_skip, *w_o_attn, *w_o_hy, *w_out,
      *norm2_g, *peer_wq, *peer_keys, *peer_u, *peer_v, *final_g;
  float* out;
  char* ws;
};

constexpr size_t MB = 1u << 20;
constexpr size_t OFF_MOD = 0;
constexpr size_t OFF_ROPE = 128 * 1024;
constexpr size_t OFF_NINV = OFF_ROPE + 8192;
constexpr size_t OFF_H2F = 256 * 1024;
constexpr size_t OFF_WIN = OFF_H2F + MB;
constexpr size_t OFF_WOA = OFF_WIN + 9 * MB;
constexpr size_t OFF_WOH = OFF_WOA + MB;
constexpr size_t OFF_WOUT = OFF_WOH + MB;
constexpr size_t OFF_WQ = OFF_WOUT + 2 * MB;
constexpr size_t OFF_KEYS = OFF_WQ + 2 * MB;
constexpr size_t OFF_UBF = OFF_KEYS + MB;
constexpr size_t OFF_VBF = OFF_UBF + 32 * MB;
constexpr size_t OFF_Q = OFF_VBF + 32 * MB;
constexpr size_t OFF_K = OFF_Q + 16 * MB;
constexpr size_t OFF_VT = OFF_K + 4 * MB;
constexpr size_t OFF_KC = OFF_VT + 4 * MB;
constexpr size_t OFF_VCT = OFF_KC + MB / 2;
constexpr size_t OFF_Z = OFF_VCT + MB / 2;
constexpr size_t OFF_GATE = OFF_Z + 48 * MB;
constexpr size_t OFF_YATT = OFF_GATE + 64 * MB;
constexpr size_t OFF_YHY = OFF_YATT + 16 * MB;
constexpr size_t OFF_RIDX = OFF_Q;
constexpr size_t OFF_RW = OFF_Q + 8 * MB;
constexpr size_t OFF_MERGED = OFF_Z;
constexpr size_t OFF_H2 = OFF_GATE;
constexpr size_t OFF_QP = OFF_GATE + 32 * MB;
constexpr size_t OO_H1 = 0;
constexpr size_t OO_UT = 0;
constexpr size_t OO_X0T = 16 * MB;
constexpr size_t OO_HC = 32 * MB;
constexpr size_t OO_G = 34 * MB;

constexpr int SMEM_BYTES = 70144;
constexpr size_t OFF_BAR = 160 * 1024;
constexpr int SMEM_XB = 70016;

typedef __attribute__((ext_vector_type(2))) float pk_f2;
typedef __attribute__((ext_vector_type(2))) __bf16 pk_b2;
DEV unsigned pack2(float a, float b) {
  pk_f2 v = {a, b};
  return __builtin_bit_cast(unsigned, __builtin_convertvector(v, pk_b2));
}
DEV u16 f2bf(float f) { return (u16)(pack2(f, 0.f) & 0xffffu); }
DEV float bf2f(u16 h) { return __uint_as_float(((unsigned)h) << 16); }
DEV float bflo(unsigned w) { return __uint_as_float(w << 16); }
DEV float bfhi(unsigned w) { return __uint_as_float(w & 0xffff0000u); }
#define DPP_ADD(v, ctrl) ((v) + __builtin_bit_cast(float, __builtin_amdgcn_update_dpp(0, __builtin_bit_cast(int, (v)), (ctrl), 0xF, 0xF, true)))
DEV float wave_sum(float v) {
  v = DPP_ADD(v, 0xB1);
  v = DPP_ADD(v, 0x4E);
  v = DPP_ADD(v, 0x141);
  v = DPP_ADD(v, 0x140);
  v += __shfl_xor(v, 16);
  v += __shfl_xor(v, 32);
  return v;
}
DEV float wave_max(float v) {
#pragma unroll
  for (int o = 32; o > 0; o >>= 1) v = fmaxf(v, __shfl_xor(v, o));
  return v;
}

DEV void p0_mod(const Params& p, int item, float* sm) {
  const int tid = threadIdx.x;
  const int cblk = item >> 2, kq = item & 3;
  for (int i = tid; i < 5 * 256; i += 256) {
    const int r = i >> 8, k = kq * 256 + (i & 255);
    const float c = (r < 4) ? p.c[r * 1024 + k] : p.c_ctx[k];
    sm[i] = c * __builtin_amdgcn_rcpf(1.f + __expf(-c));
  }
  __syncthreads();
  const int col = cblk * 64 + (tid & 63), sub = tid >> 6;
  float a0 = 0, a1 = 0, a2 = 0, a3 = 0, a4 = 0;
  const float* wp = p.w_mod + (size_t)(kq * 256 + sub * 64) * 6144 + col;
#pragma unroll 16
  for (int k = 0; k < 64; ++k) {
    const float w = wp[(size_t)k * 6144];
    const int kk = sub * 64 + k;
    a0 += sm[kk] * w; a1 += sm[256 + kk] * w; a2 += sm[512 + kk] * w; a3 += sm[768 + kk] * w; a4 += sm[1024 + kk] * w;
  }
  float* red = sm + 5 * 256;
  red[(sub * 5 + 0) * 64 + (tid & 63)] = a0;
  red[(sub * 5 + 1) * 64 + (tid & 63)] = a1;
  red[(sub * 5 + 2) * 64 + (tid & 63)] = a2;
  red[(sub * 5 + 3) * 64 + (tid & 63)] = a3;
  red[(sub * 5 + 4) * 64 + (tid & 63)] = a4;
  __syncthreads();
  float* mod = (float*)(p.ws + OFF_MOD);
  for (int i = tid; i < 320; i += 256) {
    const int r = i >> 6, cc = i & 63;
    float sacc = red[(0 * 5 + r) * 64 + cc] + red[(1 * 5 + r) * 64 + cc] + red[(2 * 5 + r) * 64 + cc] + red[(3 * 5 + r) * 64 + cc];
    if (kq == 0) sacc += p.b_mod[cblk * 64 + cc];
    atomicAdd(mod + r * 6144 + cblk * 64 + cc, sacc);
  }
  __syncthreads();
}

DEV void transpose_tile(const float* __restrict__ src, int N, int K, u16* __restrict__ dst, int tile, float* sm) {
  const int tid = threadIdx.x;
  const int nkt = K >> 6;
  const int kt = tile % nkt, nt = tile / nkt;
  const int k0 = kt * 64, n0 = nt * 64;
  const int c4 = tid & 15, r = tid >> 4;
  float4 tv[4];
#pragma unroll
  for (int rr = 0; rr < 4; ++rr) tv[rr] = *(const float4*)(src + (size_t)(k0 + rr * 16 + r) * N + n0 + c4 * 4);
#pragma unroll
  for (int rr = 0; rr < 4; ++rr) {
    float* d0 = sm + (rr * 16 + r) * 65 + c4 * 4;
    d0[0] = tv[rr].x; d0[1] = tv[rr].y; d0[2] = tv[rr].z; d0[3] = tv[rr].w;
  }
  __syncthreads();
  const int nn = tid >> 2, part = tid & 3;
  unsigned w[8];
#pragma unroll
  for (int j = 0; j < 8; ++j) w[j] = pack2(sm[(part * 16 + 2 * j) * 65 + nn], sm[(part * 16 + 2 * j + 1) * 65 + nn]);
  uint4* d = (uint4*)(dst + (size_t)(n0 + nn) * K + k0 + part * 16);
  d[0] = make_uint4(w[0], w[1], w[2], w[3]);
  d[1] = make_uint4(w[4], w[5], w[6], w[7]);
  __syncthreads();
}

DEV void p0_hidden(const Params& p, int item, float* sm) {
  const int tid = threadIdx.x;
  float* z = sm;
  float* h1 = sm + 4 * 36;
  if (tid < 4 * 33) {
    int tt = tid / 33, i = tid % 33;
    int t = item * 4 + tt;
    float v;
    if (i == 0) v = (float)t * (1.f / 4096.f);
    else {
      int band = (i <= 16) ? i : (i - 16);
      float fr = (float)((t * band) & 4095) * (1.f / 4096.f);
      v = (i <= 16) ? cospif(2.f * fr) : sinpif(2.f * fr);
    }
    z[tt * 36 + i] = v;
  }
  __syncthreads();
  const int tt = tid >> 6, j = tid & 63;
  float a = p.hy_fb1[j];
  for (int i = 0; i < 33; ++i) a += z[tt * 36 + i] * p.hy_fw1[i * 64 + j];
  const float fq = p.hy_freq[j];
  h1[tt * 64 + j] = sinf(fq * a);
  __syncthreads();
  float b = p.hy_fb2[j];
  for (int i = 0; i < 64; ++i) b += h1[tt * 64 + i] * p.hy_fw2[i * 64 + j];
  ((u16*)(p.ws + OFF_H2F))[(item * 4 + tt) * 64 + j] = f2bf(sinf(fq * b));
  __syncthreads();
}

DEV void convert_flat(const float* __restrict__ src, u16* __restrict__ dst, size_t n) {
  size_t stride = (size_t)gridDim.x * 256 * 8;
  for (size_t i = ((size_t)blockIdx.x * 256 + threadIdx.x) * 8; i < n; i += stride) {
    float4 a = *(const float4*)(src + i);
    float4 b = *(const float4*)(src + i + 4);
    *(uint4*)(dst + i) = make_uint4(pack2(a.x, a.y), pack2(a.z, a.w), pack2(b.x, b.y), pack2(b.z, b.w));
  }
}

typedef __attribute__((ext_vector_type(2))) float f32x2;
DEV void convert_flat_fp8(const float* __restrict__ src, unsigned char* __restrict__ dst, size_t n, float scale) {
  const size_t q4 = (size_t)gridDim.x * 256 * 16;
  const size_t stride = q4 * 4;
  for (size_t i = ((size_t)blockIdx.x * 256 + threadIdx.x) * 16; i < n; i += stride) {
    float4 a[16];
#pragma unroll
    for (int c = 0; c < 4; ++c) {
      const size_t off = i + c * q4;
      if (off < n) {
#pragma unroll
        for (int q = 0; q < 4; ++q) a[c * 4 + q] = *(const float4*)(src + off + 4 * q);
      }
    }
#pragma unroll
    for (int c = 0; c < 4; ++c) {
      const size_t off = i + c * q4;
      if (off < n) {
        unsigned w[4];
#pragma unroll
        for (int q = 0; q < 4; ++q) {
          int v = 0;
          v = __builtin_amdgcn_cvt_pk_fp8_f32(a[c * 4 + q].x * scale, a[c * 4 + q].y * scale, v, false);
          v = __builtin_amdgcn_cvt_pk_fp8_f32(a[c * 4 + q].z * scale, a[c * 4 + q].w * scale, v, true);
          w[q] = (unsigned)v;
        }
        *(uint4*)(dst + off) = make_uint4(w[0], w[1], w[2], w[3]);
      }
    }
  }
}

DEV void norm_row(const float* __restrict__ xr, const float* __restrict__ g, const float* __restrict__ sh,
                  const float* __restrict__ sc, u16* __restrict__ dst, int lane) {
  float4 v[4];
  float ss = 0.f;
#pragma unroll
  for (int i = 0; i < 4; ++i) {
    v[i] = ((const float4*)xr)[lane + 64 * i];
    ss += v[i].x * v[i].x + v[i].y * v[i].y + v[i].z * v[i].z + v[i].w * v[i].w;
  }
  ss = wave_sum(ss);
  const float r = rsqrtf(ss * (1.f / 1024.f) + 1e-6f);
#pragma unroll
  for (int i = 0; i < 4; ++i) {
    const int idx = lane + 64 * i;
    float4 gg = ((const float4*)g)[idx], s1 = ((const float4*)sh)[idx], s2 = ((const float4*)sc)[idx];
    float y0 = v[i].x * r * gg.x * (1.f + s2.x) + s1.x;
    float y1 = v[i].y * r * gg.y * (1.f + s2.y) + s1.y;
    float y2 = v[i].z * r * gg.z * (1.f + s2.z) + s1.z;
    float y3 = v[i].w * r * gg.w * (1.f + s2.w) + s1.w;
    *(uint2*)(dst + idx * 4) = make_uint2(pack2(y0, y1), pack2(y2, y3));
  }
}

DEV void p1_filter(const Params& p, int item, float* sm) {
  const int tid = threadIdx.x;
  const int c0 = (item >> 2) * 4, tq = item & 3;
  float* wc = sm;
  float* red = sm + 512;
  for (int i = tid; i < 512; i += 256) {
    const int j = i >> 6, k = i & 63;
    wc[i] = p.hy_fw3[k * 1024 + ((j < 4) ? (c0 + j) : (512 + c0 + j - 4))];
  }
  __syncthreads();
  float fb[8], dl[4];
#pragma unroll
  for (int j = 0; j < 8; ++j) fb[j] = p.hy_fb3[(j < 4) ? (c0 + j) : (512 + c0 + j - 4)];
  const float da = logf(1e-2f) / 1.5f, db = logf(1e-2f) / 0.3f;
#pragma unroll
  for (int j = 0; j < 4; ++j) dl[j] = fabsf(da + (db - da) * (float)(c0 + j) / 511.f);
  u16* G = (u16*)((char*)p.out + OO_G);
  const float* H = (const float*)(p.ws + OFF_H2F);
  float as[4] = {0.f, 0.f, 0.f, 0.f};
#pragma unroll 1
  for (int i = 0; i < 4; ++i) {
    const int t = tq * 1024 + i * 256 + tid;
    const float4* hp = (const float4*)(H + t * 64);
    float d[8];
#pragma unroll
    for (int j = 0; j < 8; ++j) d[j] = fb[j];
#pragma unroll 1
    for (int q8 = 0; q8 < 16; q8 += 8) {
      float4 hv[8];
#pragma unroll
      for (int u = 0; u < 8; ++u) hv[u] = hp[q8 + u];
#pragma unroll
      for (int u = 0; u < 8; ++u)
#pragma unroll
        for (int j = 0; j < 8; ++j) {
          const float4 w = *(const float4*)(wc + j * 64 + 4 * (q8 + u));
          d[j] += hv[u].x * w.x + hv[u].y * w.y + hv[u].z * w.z + hv[u].w * w.w;
        }
    }
    const float tn = (float)t * (1.f / 4096.f);
#pragma unroll
    for (int j = 0; j < 4; ++j) {
      const float dec = expf(-tn * dl[j]);
      const float f = d[j] * dec, bw = d[4 + j] * dec;
      u16* Gc = G + (size_t)(c0 + j) * 8192;
      Gc[4095 - t] = f2bf(f);
      as[j] += fabsf(f);
      if (t < 4095) { Gc[4096 + t] = f2bf(bw); as[j] += fabsf(bw); }
      else Gc[8191] = 0;
    }
  }
#pragma unroll
  for (int j = 0; j < 4; ++j) {
    const float v = wave_sum(as[j]);
    if ((tid & 63) == 0) red[(tid >> 6) * 4 + j] = v;
  }
  __syncthreads();
  if (tid < 4) atomicAdd((float*)(p.ws + OFF_BAR + 20480) + c0 + tid, red[tid] + red[4 + tid] + red[8 + tid] + red[12 + tid]);
  __syncthreads();
}

struct Acc { f32x4 v[4][4]; };

DEV void acc_zero(Acc& a) {
#pragma unroll
  for (int i = 0; i < 4; ++i)
#pragma unroll
    for (int j = 0; j < 4; ++j) a.v[i][j] = (f32x4){0.f, 0.f, 0.f, 0.f};
}

#define LDSAS __attribute__((address_space(3)))
DEV void gemm_kloop(const u16* __restrict__ A, int lda, const u16* __restrict__ Bt, int ldb, int K, int m0, int n0,
                    u16* sA, u16* sB_unused, Acc& acc) {
  const int tid = threadIdx.x, lane = tid & 63, wave = tid >> 6, wm = wave >> 1, wn = wave & 1;
  const int l15 = lane & 15, quad = lane >> 4;
  const int rsw = (l15 >> 1) & 7;
  const int nk = K >> 6;
  const int prow = lane >> 3;
  const int pch = lane & 7;
  unsigned oA[4], oB[4];
#pragma unroll
  for (int i = 0; i < 4; ++i) {
    const int row = (wave * 4 + i) * 8 + prow;
    const int c = pch ^ ((row >> 1) & 7);
    oA[i] = (unsigned)(row * lda + c * 8) * 2u;
    oB[i] = (unsigned)(row * ldb + c * 8) * 2u;
  }
  const char* bA = (const char*)(A + (size_t)m0 * lda);
  const char* bB = (const char*)(Bt + (size_t)n0 * ldb);
  LDSAS char* lbase = (LDSAS char*)sA;
#define GEMM_DMA(KT, BUF)                                                                                   \
  _Pragma("unroll") for (int i = 0; i < 4; ++i) {                                                           \
    __builtin_amdgcn_global_load_lds((const unsigned*)(bA + (KT) * 128 + oA[i]), (LDSAS unsigned*)(lbase + (BUF) * 32768 + (wave * 4 + i) * 1024), 16, 0, 0);          \
    __builtin_amdgcn_global_load_lds((const unsigned*)(bB + (KT) * 128 + oB[i]), (LDSAS unsigned*)(lbase + (BUF) * 32768 + 16384 + (wave * 4 + i) * 1024), 16, 0, 0);  \
  }
  GEMM_DMA(0, 0)
  for (int kt = 0; kt < nk; ++kt) {
    asm volatile("s_waitcnt vmcnt(0)" ::: "memory");
    __syncthreads();
    const int buf = kt & 1;
    if (kt + 1 < nk) { GEMM_DMA(kt + 1, buf ^ 1) }
    const u16* tA = sA + buf * 16384;
    const u16* tB = tA + 8192;
    bf16x8 af[2][4], bfr[2][4];
#pragma unroll
    for (int ks = 0; ks < 2; ++ks) {
      const int cs = ((ks * 4 + quad) ^ rsw) * 8;
#pragma unroll
      for (int i = 0; i < 4; ++i) af[ks][i] = *(const bf16x8*)(tB + (wn * 64 + i * 16 + l15) * 64 + cs);
#pragma unroll
      for (int j = 0; j < 4; ++j) bfr[ks][j] = *(const bf16x8*)(tA + (wm * 64 + j * 16 + l15) * 64 + cs);
    }
    __builtin_amdgcn_s_setprio(1);
#pragma unroll
    for (int ks = 0; ks < 2; ++ks)
#pragma unroll
      for (int i = 0; i < 4; ++i)
#pragma unroll
        for (int j = 0; j < 4; ++j) acc.v[i][j] = __builtin_amdgcn_mfma_f32_16x16x32_bf16(af[ks][i], bfr[ks][j], acc.v[i][j], 0, 0, 0);
    __builtin_amdgcn_s_setprio(0);
  }
  __syncthreads();
}

DEV void p1_filter_tile(const Params& p, int tile, u16* sA, u16* sB) {
  const int mt = tile >> 3, nt = tile & 7;
  const int m0 = mt * 128, n0 = nt * 128;
  Acc acc; acc_zero(acc);
  gemm_kloop((const u16*)(p.ws + OFF_H2F), 64, (const u16*)(p.ws + OFF_H2F + 512 * 1024), 64, 64, m0, n0, sA, sB, acc);
  asm volatile("" ::: "memory");
  const int tid = threadIdx.x, lane = tid & 63, wave = tid >> 6, wm = wave >> 1, wn = wave & 1;
  const int l15 = lane & 15, quad = lane >> 4;
  const int mb = m0 + wm * 64, nbase = n0 + wn * 64;
  u16* G = (u16*)((char*)p.out + OO_G);
  float* nsum = (float*)(p.ws + OFF_BAR + 20480);
  const float da = logf(1e-2f) / 1.5f, db = logf(1e-2f) / 0.3f;
  const bool bwd = nbase >= 512;
#pragma unroll
  for (int i = 0; i < 4; ++i)
#pragma unroll
    for (int r = 0; r < 4; ++r) {
      const int col = nbase + i * 16 + quad * 4 + r;
      const int c = col & 511;
      const float fbv = p.hy_fb3[col];
      const float dlc = fabsf(da + (db - da) * (float)c / 511.f);
      u16* Gc = G + (size_t)c * 8192;
      float sum = 0.f;
#pragma unroll
      for (int j = 0; j < 4; ++j) {
        const int t = mb + j * 16 + l15;
        const float val = (acc.v[i][j][r] + fbv) * __expf(-(float)t * (1.f / 4096.f) * dlc);
        if (!bwd) { Gc[4095 - t] = f2bf(val); sum += fabsf(val); }
        else if (t < 4095) { Gc[4096 + t] = f2bf(val); sum += fabsf(val); }
        else Gc[8191] = 0;
      }
      sum = DPP_ADD(sum, 0xB1);
      sum = DPP_ADD(sum, 0x4E);
      sum = DPP_ADD(sum, 0x141);
      sum = DPP_ADD(sum, 0x140);
      if (l15 == 0) atomicAdd(nsum + c, sum);
    }
}

DEV void p2_inproj(const Params& p, int tile, u16* sA, u16* sB) {
  const int mt = tile / 34, nt = tile % 34;
  const int m0 = mt * 128, n0 = nt * 128;
  Acc acc; acc_zero(acc);
  gemm_kloop((const u16*)((const char*)p.out + OO_H1), 1024, (const u16*)(p.ws + OFF_WIN), 1024, 1024, m0, n0, sA, sB, acc);
  asm volatile("" ::: "memory");
  const int tid = threadIdx.x, lane = tid & 63, wave = tid >> 6, wm = wave >> 1, wn = wave & 1;
  int l15 = lane & 15, quad = lane >> 4;
  int mb = m0 + wm * 64, nb = n0 + wn * 64;
  asm volatile("" : "+v"(l15), "+v"(quad), "+v"(mb), "+v"(nb));
  mb = __builtin_amdgcn_readfirstlane(mb); nb = __builtin_amdgcn_readfirstlane(nb);
  if (nb < 640) {
    const float2* rope = (const float2*)(p.ws + OFF_ROPE);
    const bool isq = nb < 512;
    const float qs = isq ? (0.125f * 1.4426950408889634f) : 1.f;
#pragma unroll
    for (int j = 0; j < 4; ++j) {
      const int m = mb + j * 16 + l15;
      const int b = m >> 12, l = m & 4095;
      const int prow = l >> 6, pcol = l & 63;
      u16* dst;
      if (isq) dst = (u16*)(p.ws + OFF_Q) + ((size_t)(b * 8 + (nb >> 6)) * 4096 + l) * 64;
      else dst = (u16*)(p.ws + OFF_K) + ((size_t)(b * 2 + ((nb - 512) >> 6)) * 4096 + l) * 64;
#pragma unroll
      for (int hh = 0; hh < 2; ++hh) {
        const int pos = hh ? pcol : prow;
        f32x4 x1 = acc.v[hh * 2][j], x2 = acc.v[hh * 2 + 1][j];
        float o1[4], o2[4];
#pragma unroll
        for (int r = 0; r < 4; ++r) {
          float2 cs = rope[pos * 16 + quad * 4 + r];
          o1[r] = (x1[r] * cs.x - x2[r] * cs.y) * qs;
          o2[r] = (x2[r] * cs.x + x1[r] * cs.y) * qs;
        }
        *(uint2*)(dst + hh * 32 + quad * 4) = make_uint2(pack2(o1[0], o1[1]), pack2(o1[2], o1[3]));
        *(uint2*)(dst + hh * 32 + 16 + quad * 4) = make_uint2(pack2(o2[0], o2[1]), pack2(o2[2], o2[3]));
      }
    }
  } else if (nb < 768) {
    const int g = (nb - 640) >> 6;
    u16* vt = (u16*)(p.ws + OFF_VT);
#pragma unroll
    for (int j = 0; j < 4; ++j) {
      const int m = mb + j * 16 + l15;
      const int b = m >> 12, l = m & 4095;
#pragma unroll
      for (int i = 0; i < 4; ++i)
#pragma unroll
        for (int r = 0; r < 4; ++r) {
          const int d = i * 16 + quad * 4 + r;
          vt[((size_t)(b * 2 + g) * 64 + d) * 4096 + l] = f2bf(acc.v[i][j][r]);
        }
    }
  } else if (nb < 2304) {
    u16* z = (u16*)(p.ws + OFF_Z);
#pragma unroll
    for (int j = 0; j < 4; ++j) {
      const int m = mb + j * 16 + l15;
#pragma unroll
      for (int i = 0; i < 4; ++i) {
        const int n = nb - 768 + i * 16 + quad * 4;
        f32x4 a = acc.v[i][j];
        *(uint2*)(z + (size_t)m * 1536 + n) = make_uint2(pack2(a[0], a[1]), pack2(a[2], a[3]));
      }
    }
  } else {
    u16* gt = (u16*)(p.ws + OFF_GATE);
#pragma unroll
    for (int j = 0; j < 4; ++j) {
      const int m = mb + j * 16 + l15;
#pragma unroll
      for (int i = 0; i < 4; ++i) {
        const int n = nb - 2304 + i * 16 + quad * 4;
        f32x4 a = acc.v[i][j];
        float s0 = __builtin_amdgcn_rcpf(1.f + __expf(-a[0])), s1 = __builtin_amdgcn_rcpf(1.f + __expf(-a[1]));
        float s2 = __builtin_amdgcn_rcpf(1.f + __expf(-a[2])), s3 = __builtin_amdgcn_rcpf(1.f + __expf(-a[3]));
        *(uint2*)(gt + (size_t)m * 2048 + n) = make_uint2(pack2(s0, s1), pack2(s2, s3));
      }
    }
  }
}

DEV void p2_ctxkv(const Params& p, int tile, u16* sA, u16* sB) {
  const int mt = tile >> 1, nt = tile & 1;
  const int m0 = mt * 128, n0 = nt * 128;
  Acc acc; acc_zero(acc);
  gemm_kloop((const u16*)((const char*)p.out + OO_HC), 1024, (const u16*)(p.ws + OFF_WIN) + (size_t)512 * 1024, 1024, 1024, m0, n0, sA, sB, acc);
  const int tid = threadIdx.x, lane = tid & 63, wave = tid >> 6, wm = wave >> 1, wn = wave & 1;
  const int l15 = lane & 15, quad = lane >> 4;
  const int mb = m0 + wm * 64, nb = n0 + wn * 64;
  const int g = (nb >> 6) & 1;
  if (nb < 128) {
    u16* kc = (u16*)(p.ws + OFF_KC);
#pragma unroll
    for (int j = 0; j < 4; ++j) {
      const int m = mb + j * 16 + l15;
      const int b = m >> 8, c = m & 255;
#pragma unroll
      for (int i = 0; i < 4; ++i) {
        f32x4 a = acc.v[i][j];
        *(uint2*)(kc + ((size_t)(b * 2 + g) * 256 + c) * 64 + i * 16 + quad * 4) = make_uint2(pack2(a[0], a[1]), pack2(a[2], a[3]));
      }
    }
  } else {
    u16* vct = (u16*)(p.ws + OFF_VCT);
#pragma unroll
    for (int j = 0; j < 4; ++j) {
      const int m = mb + j * 16 + l15;
      const int b = m >> 8, c = m & 255;
#pragma unroll
      for (int i = 0; i < 4; ++i)
#pragma unroll
        for (int r = 0; r < 4; ++r) {
          const int d = i * 16 + quad * 4 + r;
          vct[((size_t)(b * 2 + g) * 64 + d) * 256 + c] = f2bf(acc.v[i][j][r]);
        }
    }
  }
}

DEV void p3_attn(const Params& p, int item, u16* sK, u16* sVt) {
  const int tid = threadIdx.x, lane = tid & 63, wave = tid >> 6, l15 = lane & 15, quad = lane >> 4;
  const int n = item & 31, h = (item >> 5) & 7, b = item >> 8;
  const int g = h >> 2;
  const u16* Q = (const u16*)(p.ws + OFF_Q) + ((size_t)(b * 8 + h) * 4096 + n * 128 + wave * 32) * 64;
  bf16x8 bq[2][2];
#pragma unroll
  for (int qt = 0; qt < 2; ++qt)
#pragma unroll
    for (int ks = 0; ks < 2; ++ks) bq[qt][ks] = *(const bf16x8*)(Q + (qt * 16 + l15) * 64 + ks * 32 + quad * 8);
  const float sink = p.attn_sink[h] * 1.4426950408889634f;
  float mrun[2] = {sink, sink};
  float lrun[2];
  lrun[0] = lrun[1] = (quad == 0) ? 1.f : 0.f;
  f32x4 O[4][2];
#pragma unroll
  for (int dt = 0; dt < 4; ++dt)
#pragma unroll
    for (int qt = 0; qt < 2; ++qt) O[dt][qt] = (f32x4){0.f, 0.f, 0.f, 0.f};

  u32x4 pk[4], pv[4];
#define ATT_LOAD(KB)                                                                                  \
  {                                                                                                   \
    const u16* Ksrc; const u16* Vsrc; int vstride;                                                    \
    if ((KB) < 3) {                                                                                   \
      const int nbk = n + (KB) - 1;                                                                   \
      Ksrc = (const u16*)(p.ws + OFF_K) + ((size_t)(b * 2 + g) * 4096 + nbk * 128) * 64;              \
      Vsrc = (const u16*)(p.ws + OFF_VT) + (size_t)(b * 2 + g) * 64 * 4096 + nbk * 128;               \
      vstride = 4096;                                                                                 \
    } else {                                                                                          \
      const int cb = (KB) - 3;                                                                        \
      Ksrc = (const u16*)(p.ws + OFF_KC) + ((size_t)(b * 2 + g) * 256 + cb * 128) * 64;               \
      Vsrc = (const u16*)(p.ws + OFF_VCT) + (size_t)(b * 2 + g) * 64 * 256 + cb * 128;                \
      vstride = 256;                                                                                  \
    }                                                                                                 \
    _Pragma("unroll") for (int i = 0; i < 4; ++i) {                                                   \
      const int id = tid + i * 256;                                                                   \
      pk[i] = *(const u32x4*)(Ksrc + (id >> 3) * 64 + (id & 7) * 8);                                  \
      pv[i] = *(const u32x4*)(Vsrc + (size_t)(id >> 4) * vstride + (id & 15) * 8);                    \
    }                                                                                                 \
  }
  int kb = (n == 0) ? 1 : 0;
  ATT_LOAD(kb)
  while (kb < 5) {
#pragma unroll
    for (int i = 0; i < 4; ++i) {
      const int id = tid + i * 256;
      *(u32x4*)(sK + (id >> 3) * 72 + (id & 7) * 8) = pk[i];
      *(u32x4*)(sVt + (id >> 4) * 136 + (id & 15) * 8) = pv[i];
    }
    __syncthreads();
    int nx = kb + 1;
    if (nx == 2 && n == 31) nx = 3;
    if (nx < 5) ATT_LOAD(nx)
#pragma unroll 1
    for (int c4 = 0; c4 < 4; ++c4) {
      f32x4 s[2][2];
#pragma unroll
      for (int kt = 0; kt < 2; ++kt) {
        bf16x8 ak0 = *(const bf16x8*)(sK + (c4 * 32 + kt * 16 + l15) * 72 + quad * 8);
        bf16x8 ak1 = *(const bf16x8*)(sK + (c4 * 32 + kt * 16 + l15) * 72 + 32 + quad * 8);
#pragma unroll
        for (int qt = 0; qt < 2; ++qt) {
          f32x4 z = (f32x4){0.f, 0.f, 0.f, 0.f};
          z = __builtin_amdgcn_mfma_f32_16x16x32_bf16(ak0, bq[qt][0], z, 0, 0, 0);
          z = __builtin_amdgcn_mfma_f32_16x16x32_bf16(ak1, bq[qt][1], z, 0, 0, 0);
          s[kt][qt] = z;
        }
      }
      if (kb == 0 || kb == 2) {
#pragma unroll
        for (int kt = 0; kt < 2; ++kt)
#pragma unroll
          for (int qt = 0; qt < 2; ++qt)
#pragma unroll
            for (int r = 0; r < 4; ++r) {
              const int kk = c4 * 32 + kt * 16 + quad * 4 + r;
              const int qq = wave * 32 + qt * 16 + l15;
              const bool valid = (kb == 0) ? (kk >= qq) : (kk <= qq);
              if (!valid) s[kt][qt][r] = -INFINITY;
            }
      }
      bf16x8 bp[2];
#pragma unroll
      for (int qt = 0; qt < 2; ++qt) {
        float cm = fmaxf(fmaxf(fmaxf(s[0][qt][0], s[0][qt][1]), fmaxf(s[0][qt][2], s[0][qt][3])),
                         fmaxf(fmaxf(s[1][qt][0], s[1][qt][1]), fmaxf(s[1][qt][2], s[1][qt][3])));
        cm = fmaxf(cm, __shfl_xor(cm, 16));
        cm = fmaxf(cm, __shfl_xor(cm, 32));
        const float mnew = fmaxf(mrun[qt], cm);
        const float alpha = __builtin_amdgcn_exp2f(mrun[qt] - mnew);
        mrun[qt] = mnew;
        float ps = 0.f;
        float pv[8];
#pragma unroll
        for (int r = 0; r < 4; ++r) {
          pv[r] = __builtin_amdgcn_exp2f(s[0][qt][r] - mnew);
          pv[4 + r] = __builtin_amdgcn_exp2f(s[1][qt][r] - mnew);
          ps += pv[r] + pv[4 + r];
        }
        lrun[qt] = lrun[qt] * alpha + ps;
#pragma unroll
        for (int dt = 0; dt < 4; ++dt) {
          O[dt][qt][0] *= alpha; O[dt][qt][1] *= alpha; O[dt][qt][2] *= alpha; O[dt][qt][3] *= alpha;
        }
        union { bf16x8 v; unsigned u[4]; } pk;
        pk.u[0] = pack2(pv[0], pv[1]); pk.u[1] = pack2(pv[2], pv[3]);
        pk.u[2] = pack2(pv[4], pv[5]); pk.u[3] = pack2(pv[6], pv[7]);
        bp[qt] = pk.v;
      }
#pragma unroll
      for (int dt = 0; dt < 4; ++dt) {
        union { bf16x8 v; uint2 h[2]; } av;
        const u16* vrow = sVt + (dt * 16 + l15) * 136 + c4 * 32 + quad * 4;
        av.h[0] = *(const uint2*)(vrow);
        av.h[1] = *(const uint2*)(vrow + 16);
#pragma unroll
        for (int qt = 0; qt < 2; ++qt) O[dt][qt] = __builtin_amdgcn_mfma_f32_16x16x32_bf16(av.v, bp[qt], O[dt][qt], 0, 0, 0);
      }
    }
    __syncthreads();
    kb = nx;
  }
  u16* Y = (u16*)(p.ws + OFF_YATT);
#pragma unroll
  for (int qt = 0; qt < 2; ++qt) {
    float l = lrun[qt];
    l += __shfl_xor(l, 16);
    l += __shfl_xor(l, 32);
    const float inv = __builtin_amdgcn_rcpf(l);
    const int t = b * 4096 + n * 128 + wave * 32 + qt * 16 + l15;
#pragma unroll
    for (int dt = 0; dt < 4; ++dt) {
      f32x4 o = O[dt][qt];
      *(uint2*)(Y + (size_t)t * 512 + h * 64 + dt * 16 + quad * 4) = make_uint2(pack2(o[0] * inv, o[1] * inv), pack2(o[2] * inv, o[3] * inv));
    }
  }
}

DEV void p3_hypre(const Params& p, int item, u16* sm) {
  const int tid = threadIdx.x;
  const int cb = item & 3, tb = (item >> 2) & 63, b = item >> 8;
  const int tq = tid >> 6, ch2 = tid & 63;
  const int c = cb * 128 + ch2 * 2;
  u16* su = sm;
  u16* sx = sm + 128 * 66;
  float w[3][3][2], bias[3][2];
#pragma unroll
  for (int s = 0; s < 3; ++s) {
#pragma unroll
    for (int k = 0; k < 3; ++k) {
      const float2 wv = *(const float2*)(p.hy_conv_w + k * 1536 + s * 512 + c);
      w[s][k][0] = wv.x; w[s][k][1] = wv.y;
    }
    const float2 bv = *(const float2*)(p.hy_conv_b + s * 512 + c);
    bias[s][0] = bv.x; bias[s][1] = bv.y;
  }
  const u16* Z = (const u16*)(p.ws + OFF_Z) + (size_t)b * 4096 * 1536;
  const int l0 = tb * 64 + tq * 16;
  unsigned zr[18][3];
#pragma unroll
  for (int i = 0; i < 18; ++i) {
    const int l = l0 - 1 + i;
    const bool ok = (l >= 0) && (l < 4096);
    const int lc = ok ? l : l0;
#pragma unroll
    for (int s2 = 0; s2 < 3; ++s2) {
      const unsigned v = *(const unsigned*)(Z + (size_t)lc * 1536 + s2 * 512 + c);
      zr[i][s2] = ok ? v : 0u;
    }
  }
#pragma unroll
  for (int i = 0; i < 16; ++i) {
    float cv0[3], cv1[3];
#pragma unroll
    for (int s2 = 0; s2 < 3; ++s2) {
      cv0[s2] = bflo(zr[i][s2]) * w[s2][0][0] + bflo(zr[i + 1][s2]) * w[s2][1][0] + bflo(zr[i + 2][s2]) * w[s2][2][0] + bias[s2][0];
      cv1[s2] = bfhi(zr[i][s2]) * w[s2][0][1] + bfhi(zr[i + 1][s2]) * w[s2][1][1] + bfhi(zr[i + 2][s2]) * w[s2][2][1] + bias[s2][1];
    }
    su[(ch2 * 2) * 66 + tq * 16 + i] = f2bf(cv0[2] * cv0[1]);
    su[(ch2 * 2 + 1) * 66 + tq * 16 + i] = f2bf(cv1[2] * cv1[1]);
    sx[(ch2 * 2) * 66 + tq * 16 + i] = f2bf(cv0[0]);
    sx[(ch2 * 2 + 1) * 66 + tq * 16 + i] = f2bf(cv1[0]);
  }
  __syncthreads();
  const int chr = tid >> 1, part = tid & 1;
  const int cc = cb * 128 + chr;
  const unsigned* ru = (const unsigned*)(su + chr * 66 + part * 32);
  const unsigned* rx = (const unsigned*)(sx + chr * 66 + part * 32);
  u16* UT = (u16*)((char*)p.out + OO_UT) + ((size_t)(cc * 4 + b) * 4096 + tb * 64 + part * 32);
  u16* XT = (u16*)((char*)p.out + OO_X0T) + ((size_t)(cc * 4 + b) * 4096 + tb * 64 + part * 32);
#pragma unroll
  for (int q = 0; q < 4; ++q) {
    ((uint4*)UT)[q] = make_uint4(ru[4 * q], ru[4 * q + 1], ru[4 * q + 2], ru[4 * q + 3]);
    ((uint4*)XT)[q] = make_uint4(rx[4 * q], rx[4 * q + 1], rx[4 * q + 2], rx[4 * q + 3]);
  }
  __syncthreads();
}

DEV void p3_toeplitz(const Params& p, int c, char* smem) {
  const int tid = threadIdx.x, lane = tid & 63, wave = tid >> 6, l15 = lane & 15, quad = lane >> 4;
  u16* sG0 = (u16*)smem;
  u16* sG1 = (u16*)(smem + 16384 + 64);
  u16* sU = (u16*)(smem + 32768 + 128);
  u16* sZ = sU + 4 * 64 * 72;
  const u16* G = (const u16*)((const char*)p.out + OO_G) + (size_t)c * 8192;
  const u16* UT = (const u16*)((const char*)p.out + OO_UT) + (size_t)c * 16384;
#pragma unroll
  for (int i = 0; i < 4; ++i) {
    const int id = tid + i * 256;
    *(uint4*)(sG0 + id * 8) = *(const uint4*)(G + id * 8);
  }
#pragma unroll
  for (int i = 0; i < 8; ++i) {
    const int id = tid + i * 256;
    const int bb = id >> 9, blk = (id >> 3) & 63, c8 = id & 7;
    *(uint4*)(sU + (bb * 64 + blk) * 72 + c8 * 8) = *(const uint4*)(UT + id * 8);
  }
  if (tid < 72) sZ[tid] = 0;
  __syncthreads();
  for (int i = tid; i < 8192; i += 256) sG1[i] = (i < 8191) ? sG0[i + 1] : (u16)0;
  __syncthreads();

  Acc acc; acc_zero(acc);
  const u16* gbase = (l15 & 1) ? sG0 : (sG1 - 1);
  const u16* ubase = sU + wave * 64 * 72 + quad * 8;
  const u16* zbase = sZ + quad * 8;
#define TOEP_LOADA(AF, D)                                                                 \
  {                                                                                       \
    const int base_ = 4095 - 64 * (D) - l15 + quad * 8;                                   \
    _Pragma("unroll") for (int mt = 0; mt < 4; ++mt)                                      \
      _Pragma("unroll") for (int ks = 0; ks < 2; ++ks) {                                  \
        const unsigned* gp = (const unsigned*)(gbase + base_ - mt * 16 + ks * 32);        \
        union { bf16x8 v; unsigned u[4]; } t_;                                            \
        t_.u[0] = gp[0]; t_.u[1] = gp[1]; t_.u[2] = gp[2]; t_.u[3] = gp[3];               \
        AF[mt][ks] = t_.v;                                                                \
      }                                                                                   \
  }
#define TOEP_MMA(AF, D)                                                                   \
  _Pragma("unroll") for (int nt = 0; nt < 4; ++nt) {                                      \
    if (!(nt * 16 + 15 - (D) < 0 || nt * 16 - (D) > 63)) {                                \
      const int ip = nt * 16 + l15 - (D);                                                 \
      const u16* up = (ip >= 0 && ip < 64) ? (ubase + ip * 72) : zbase;                   \
      bf16x8 b0 = *(const bf16x8*)(up);                                                   \
      bf16x8 b1 = *(const bf16x8*)(up + 32);                                              \
      _Pragma("unroll") for (int mt = 0; mt < 4; ++mt) {                                  \
        acc.v[mt][nt] = __builtin_amdgcn_mfma_f32_16x16x32_bf16(AF[mt][0], b0, acc.v[mt][nt], 0, 0, 0); \
        acc.v[mt][nt] = __builtin_amdgcn_mfma_f32_16x16x32_bf16(AF[mt][1], b1, acc.v[mt][nt], 0, 0, 0); \
      }                                                                                   \
    }                                                                                     \
  }
  {
    bf16x8 afA[4][2], afB[4][2];
    TOEP_LOADA(afA, -63)
#pragma unroll 1
    for (int d = -63; d <= 63; d += 2) {
      if (d + 1 <= 63) TOEP_LOADA(afB, d + 1)
      TOEP_MMA(afA, d)
      if (d + 1 <= 63) {
        if (d + 2 <= 63) TOEP_LOADA(afA, d + 2)
        TOEP_MMA(afB, d + 1)
      }
    }
  }
  const float ninv = 1.f / ((const float*)(p.ws + OFF_BAR + 20480))[c];
  const float skip = p.hy_skip[c];
  const u16* XT = (const u16*)((const char*)p.out + OO_X0T) + ((size_t)(c * 4 + wave) * 4096);
  u16* Y = (u16*)(p.ws + OFF_YHY);
#pragma unroll
  for (int nt = 0; nt < 4; ++nt) {
    const int ib = nt * 16 + l15;
#pragma unroll
    for (int mt = 0; mt < 4; ++mt) {
      const int r0 = mt * 16 + quad * 4;
      const int t = ib * 64 + r0;
      uint2 uu = *(const uint2*)(sU + (wave * 64 + ib) * 72 + r0);
      uint2 xx = *(const uint2*)(XT + t);
      float uv[4] = {bflo(uu.x), bfhi(uu.x), bflo(uu.y), bfhi(uu.y)};
      float xv[4] = {bflo(xx.x), bfhi(xx.x), bflo(xx.y), bfhi(xx.y)};
#pragma unroll
      for (int r = 0; r < 4; ++r) {
        float y = acc.v[mt][nt][r] * ninv + uv[r] * skip;
        Y[(size_t)(wave * 4096 + t + r) * 512 + c] = f2bf(y * xv[r]);
      }
    }
  }
  __syncthreads();
}

DEV void p4_merge(const Params& p, int tile, u16* sA, u16* sB) {
  const int mt = tile >> 3, nt = tile & 7;
  const int m0 = mt * 128, n0 = nt * 128;
  const int tid = threadIdx.x, lane = tid & 63, wave = tid >> 6, wm = wave >> 1, wn = wave & 1;
  const int l15 = lane & 15, quad = lane >> 4;
  const int mb = m0 + wm * 64, nb = n0 + wn * 64;
  const u16* gt = (const u16*)(p.ws + OFF_GATE);
  u16* mg = (u16*)(p.ws + OFF_MERGED);
  Acc a1; acc_zero(a1);
  gemm_kloop((const u16*)(p.ws + OFF_YATT), 512, (const u16*)(p.ws + OFF_WOA), 512, 512, m0, n0, sA, sB, a1);
  asm volatile("" ::: "memory");
#pragma unroll
  for (int j = 0; j < 4; ++j) {
    const int m = mb + j * 16 + l15;
#pragma unroll
    for (int i = 0; i < 4; ++i) {
      const int n = nb + i * 16 + quad * 4;
      uint2 ga = *(const uint2*)(gt + (size_t)m * 2048 + n);
      f32x4 x = a1.v[i][j];
      *(uint2*)(mg + (size_t)m * 1024 + n) = make_uint2(pack2(bflo(ga.x) * x[0], bfhi(ga.x) * x[1]), pack2(bflo(ga.y) * x[2], bfhi(ga.y) * x[3]));
    }
  }
  asm volatile("" ::: "memory");
  acc_zero(a1);
  gemm_kloop((const u16*)(p.ws + OFF_YHY), 512, (const u16*)(p.ws + OFF_WOH), 512, 512, m0, n0, sA, sB, a1);
  asm volatile("" ::: "memory");
#pragma unroll
  for (int j = 0; j < 4; ++j) {
    const int m = mb + j * 16 + l15;
#pragma unroll
    for (int i = 0; i < 4; ++i) {
      const int n = nb + i * 16 + quad * 4;
      uint2 gh = *(const uint2*)(gt + (size_t)m * 2048 + 1024 + n);
      uint2 pv = *(const uint2*)(mg + (size_t)m * 1024 + n);
      f32x4 y = a1.v[i][j];
      float o0 = bflo(pv.x) + bflo(gh.x) * y[0];
      float o1 = bfhi(pv.x) + bfhi(gh.x) * y[1];
      float o2 = bflo(pv.y) + bflo(gh.y) * y[2];
      float o3 = bfhi(pv.y) + bfhi(gh.y) * y[3];
      *(uint2*)(mg + (size_t)m * 1024 + n) = make_uint2(pack2(o0, o1), pack2(o2, o3));
    }
  }
}

DEV void p5_out(const Params& p, int tile, u16* sA, u16* sB) {
  const int mt = tile >> 3, nt = tile & 7;
  const int m0 = mt * 128, n0 = nt * 128;
  Acc acc; acc_zero(acc);
  gemm_kloop((const u16*)(p.ws + OFF_MERGED), 1024, (const u16*)(p.ws + OFF_WOUT), 1024, 1024, m0, n0, sA, sB, acc);
  const int tid = threadIdx.x, lane = tid & 63, wave = tid >> 6, wm = wave >> 1, wn = wave & 1;
  const int l15 = lane & 15, quad = lane >> 4;
  const int mb = m0 + wm * 64, nb = n0 + wn * 64;
  const float* mod = (const float*)(p.ws + OFF_MOD);
#pragma unroll
  for (int j = 0; j < 4; ++j) {
    const int m = mb + j * 16 + l15;
    const int b = m >> 12;
#pragma unroll
    for (int i = 0; i < 4; ++i) {
      const int n = nb + i * 16 + quad * 4;
      float4 g1 = *(const float4*)(mod + b * 6144 + 2048 + n);
      float4 xv = *(const float4*)(p.x + (size_t)m * 1024 + n);
      f32x4 a = acc.v[i][j];
      float4 o = make_float4(xv.x + g1.x * a[0], xv.y + g1.y * a[1], xv.z + g1.z * a[2], xv.w + g1.w * a[3]);
      *(float4*)(p.out + (size_t)m * 1024 + n) = o;
    }
  }
}

DEV void p7_qp(const Params& p, int tile, u16* sA, u16* sB) {
  const int mt = tile >> 3, nt = tile & 7;
  const int m0 = mt * 128, n0 = nt * 128;
  Acc acc; acc_zero(acc);
  gemm_kloop((const u16*)(p.ws + OFF_H2), 1024, (const u16*)(p.ws + OFF_WQ), 1024, 1024, m0, n0, sA, sB, acc);
  const int tid = threadIdx.x, lane = tid & 63, wave = tid >> 6, wm = wave >> 1, wn = wave & 1;
  const int l15 = lane & 15, quad = lane >> 4;
  const int mb = m0 + wm * 64, nb = n0 + wn * 64;
  u16* qp = (u16*)(p.ws + OFF_QP);
#pragma unroll
  for (int j = 0; j < 4; ++j) {
    const int m = mb + j * 16 + l15;
#pragma unroll
    for (int i = 0; i < 4; ++i) {
      const int n = nb + i * 16 + quad * 4;
      f32x4 a = acc.v[i][j];
      *(uint2*)(qp + (size_t)m * 1024 + n) = make_uint2(pack2(a[0], a[1]), pack2(a[2], a[3]));
    }
  }
}

DEV unsigned f2ord(float f) {
  const unsigned u = __float_as_uint(f);
  return u ^ (((int)u >> 31) | 0x80000000u);
}
DEV float ord2f(unsigned k) {
  const unsigned m = (k & 0x80000000u) ? 0x80000000u : 0xffffffffu;
  return __uint_as_float(k ^ m);
}
DEV unsigned umax_(unsigned a, unsigned b) { return a > b ? a : b; }
DEV unsigned umin_(unsigned a, unsigned b) { return a < b ? a : b; }

DEV void sort16_desc(unsigned (&v)[16]) {
#pragma unroll
  for (int k = 2; k <= 16; k <<= 1)
#pragma unroll
    for (int j = k >> 1; j > 0; j >>= 1)
#pragma unroll
      for (int i = 0; i < 16; ++i) {
        const int l = i ^ j;
        if (l > i) {
          const bool desc = ((i & k) == 0);
          const unsigned a = v[i], b = v[l];
          const unsigned hi = umax_(a, b), lo = umin_(a, b);
          v[i] = desc ? hi : lo;
          v[l] = desc ? lo : hi;
        }
      }
}
DEV void merge16_desc(unsigned (&v)[16]) {
#pragma unroll
  for (int j = 8; j > 0; j >>= 1)
#pragma unroll
    for (int i = 0; i < 16; ++i) {
      const int l = i ^ j;
      if (l > i) {
        const unsigned a = v[i], b = v[l];
        v[i] = umax_(a, b);
        v[l] = umin_(a, b);
      }
    }
}
DEV void xmerge16(unsigned (&v)[16], int off) {
  unsigned pr[16];
#pragma unroll
  for (int i = 0; i < 16; ++i) pr[i] = (unsigned)__shfl_xor((int)v[i], off);
#pragma unroll
  for (int i = 0; i < 16; ++i) v[i] = umax_(v[i], pr[15 - i]);
  merge16_desc(v);
}

DEV void route_top16_of_128(const u16* __restrict__ keys, const u16* __restrict__ qp, int l15, int quad, unsigned (&out)[16]) {
  bf16x8 b0 = *(const bf16x8*)(qp);
  bf16x8 b1 = *(const bf16x8*)(qp + 32);
  unsigned ka[16], kb[16];
#pragma unroll
  for (int kt = 0; kt < 8; ++kt) {
    bf16x8 a0 = *(const bf16x8*)(keys + (kt * 16 + l15) * 64 + quad * 8);
    bf16x8 a1 = *(const bf16x8*)(keys + (kt * 16 + l15) * 64 + 32 + quad * 8);
    f32x4 z = (f32x4){0.f, 0.f, 0.f, 0.f};
    z = __builtin_amdgcn_mfma_f32_16x16x32_bf16(a0, b0, z, 0, 0, 0);
    z = __builtin_amdgcn_mfma_f32_16x16x32_bf16(a1, b1, z, 0, 0, 0);
#pragma unroll
    for (int r = 0; r < 4; ++r) {
      const unsigned key = (f2ord(z[r]) & ~127u) | (unsigned)(kt * 16 + quad * 4 + r);
      if (kt < 4) ka[kt * 4 + r] = key; else kb[(kt - 4) * 4 + r] = key;
    }
  }
  sort16_desc(ka);
  sort16_desc(kb);
#pragma unroll
  for (int i = 0; i < 16; ++i) out[i] = umax_(ka[i], kb[15 - i]);
  merge16_desc(out);
  xmerge16(out, 16);
  xmerge16(out, 32);
}

__device__ const unsigned char kTabG[52] = {
    0x00, 0x01, 0x02, 0x03, 0x04, 0x05, 0x06, 0x07, 0x08, 0x09, 0x0A, 0x0B, 0x0C, 0x0D, 0x0E, 0x0F,
    0x10, 0x11, 0x12, 0x13, 0x14, 0x15, 0x16, 0x17, 0x20, 0x21, 0x22, 0x23, 0x24, 0x30, 0x31, 0x32, 0x33,
    0x40, 0x41, 0x42, 0x50, 0x51, 0x60, 0x61, 0x70, 0x71, 0x80, 0x90, 0xA0, 0xB0, 0xC0, 0xD0, 0xE0, 0xF0, 0x00, 0x00};

DEV void p8_route(const Params& p, int task, char* wsm, const unsigned char* kTab) {
  const int lane = threadIdx.x & 63, l15 = lane & 15, quad = lane >> 4;
  const int h = task & 7, tt = task >> 3;
  const int t0 = tt * 16;
  float* s1v = (float*)wsm;
  float* s2v = s1v + 256;
  int* i1 = (int*)(s2v + 256);
  int* i2 = i1 + 256;
  const u16* keys = (const u16*)(p.ws + OFF_KEYS) + (size_t)(h * 2) * 128 * 64;
  const u16* qp = (const u16*)(p.ws + OFF_QP) + (size_t)(t0 + l15) * 1024 + h * 128 + quad * 8;
  unsigned l1[16], l2[16];
  route_top16_of_128(keys, qp, l15, quad, l1);
  route_top16_of_128(keys + 128 * 64, qp + 64, l15, quad, l2);
  if (quad == 0) {
#pragma unroll
    for (int i = 0; i < 16; ++i) { s1v[l15 * 16 + i] = ord2f(l1[i] & ~127u); i1[l15 * 16 + i] = (int)(l1[i] & 127u); }
  } else if (quad == 1) {
#pragma unroll
    for (int i = 0; i < 16; ++i) { s2v[l15 * 16 + i] = ord2f(l2[i] & ~127u); i2[l15 * 16 + i] = (int)(l2[i] & 127u); }
  }
  __builtin_amdgcn_fence(__ATOMIC_RELEASE, "wavefront");
  __builtin_amdgcn_wave_barrier();
  __builtin_amdgcn_fence(__ATOMIC_ACQUIRE, "wavefront");
  unsigned ck[16];
#pragma unroll
  for (int s = 0; s < 16; ++s) {
    const int c = quad + 4 * s;
    unsigned key = 0u;
    if (s < 13 && c < 50) {
      const unsigned ab = kTab[c];
      const float val = s1v[l15 * 16 + (ab >> 4)] + s2v[l15 * 16 + (ab & 15)];
      key = (f2ord(val) & ~255u) | ab;
    }
    ck[s] = key;
  }
  sort16_desc(ck);
  xmerge16(ck, 16);
  xmerge16(ck, 32);
  if (quad == 0) {
    float e[16];
    const float vmax = ord2f(ck[0] & ~255u);
    float ssum = 0.f;
#pragma unroll
    for (int i = 0; i < 16; ++i) { e[i] = __expf(ord2f(ck[i] & ~255u) - vmax); ssum += e[i]; }
    const float inv = __builtin_amdgcn_rcpf(ssum);
    int* ridx = (int*)(p.ws + OFF_RIDX) + (size_t)(t0 + l15) * 128 + h * 16;
    float* rw = (float*)(p.ws + OFF_RW) + (size_t)(t0 + l15) * 128 + h * 16;
#pragma unroll
    for (int i = 0; i < 16; i += 4) {
      int ee[4]; float ww[4];
#pragma unroll
      for (int j = 0; j < 4; ++j) {
        const unsigned ab = ck[i + j] & 255u;
        ee[j] = i1[l15 * 16 + (ab >> 4)] * 128 + i2[l15 * 16 + (ab & 15)];
        ww[j] = e[i + j] * inv;
      }
      *(int4*)(ridx + i) = make_int4(ee[0], ee[1], ee[2], ee[3]);
      *(float4*)(rw + i) = make_float4(ww[0], ww[1], ww[2], ww[3]);
    }
  }
  __builtin_amdgcn_fence(__ATOMIC_RELEASE, "wavefront");
  __builtin_amdgcn_wave_barrier();
}

DEV float gelu_tanh(float x) {
  const float u2 = 1.5957691216057308f * (x + 0.044715f * x * x * x);
  return x * __builtin_amdgcn_rcpf(1.f + __expf(-u2));
}

DEV void unpack8(const uint4& q, float* f) {
  f[0] = bflo(q.x); f[1] = bfhi(q.x); f[2] = bflo(q.y); f[3] = bfhi(q.y);
  f[4] = bflo(q.z); f[5] = bfhi(q.z); f[6] = bflo(q.w); f[7] = bfhi(q.w);
}

DEV float dpp_add(float v, const int ctrl_sel) {
  return v;
}
typedef __attribute__((ext_vector_type(2))) __bf16 bf2_t;
DEV float dot2bf(unsigned a, unsigned b, float c) {
  return __builtin_amdgcn_fdot2_f32_bf16(__builtin_bit_cast(bf2_t, a), __builtin_bit_cast(bf2_t, b), c, false);
}

DEV float reduce4_rows(float d0, float d1, float d2, float d3, int lane) {
  const bool up32 = (lane & 32) != 0, up16 = (lane & 16) != 0;
  float k0 = up32 ? d2 : d0, k1 = up32 ? d3 : d1;
  const float s0 = up32 ? d0 : d2, s1 = up32 ? d1 : d3;
  k0 += __shfl_xor(s0, 32);
  k1 += __shfl_xor(s1, 32);
  float kq = up16 ? k1 : k0;
  const float sq = up16 ? k0 : k1;
  kq += __shfl_xor(sq, 16);
  kq = DPP_ADD(kq, 0xB1);
  kq = DPP_ADD(kq, 0x4E);
  kq = DPP_ADD(kq, 0x141);
  kq = DPP_ADD(kq, 0x140);
  return kq;
}

DEV void p9_token(const Params& p, int t, int tnext, int lane, int2& e2n, float2& w2n, u32x4& han, u32x4& hbn) {
  const unsigned char* U8 = (const unsigned char*)(p.ws + OFF_UBF);
  const unsigned char* V8 = (const unsigned char*)(p.ws + OFF_VBF);
  const int2 e2 = e2n;
  const float2 w2 = w2n;
  const u32x4 ha = han, hb = hbn;
  {
    e2n = *(const int2*)((const int*)(p.ws + OFF_RIDX) + (size_t)tnext * 128 + 2 * lane);
    w2n = *(const float2*)((const float*)(p.ws + OFF_RW) + (size_t)tnext * 128 + 2 * lane);
    const u16* h2 = (const u16*)(p.ws + OFF_H2) + (size_t)tnext * 1024 + 16 * lane;
    han = *(const u32x4*)(h2);
    hbn = *(const u32x4*)(h2 + 8);
  }
  float hf[16];
  hf[0] = bflo(ha.x); hf[1] = bfhi(ha.x); hf[2] = bflo(ha.y); hf[3] = bfhi(ha.y);
  hf[4] = bflo(ha.z); hf[5] = bfhi(ha.z); hf[6] = bflo(ha.w); hf[7] = bfhi(ha.w);
  hf[8] = bflo(hb.x); hf[9] = bfhi(hb.x); hf[10] = bflo(hb.y); hf[11] = bfhi(hb.y);
  hf[12] = bflo(hb.z); hf[13] = bfhi(hb.z); hf[14] = bflo(hb.w); hf[15] = bfhi(hb.w);
  float o[16];
#pragma unroll
  for (int k = 0; k < 16; ++k) o[k] = 0.f;
#pragma unroll 1
  for (int g = 0; g < 128; g += 16) {
    u32x4 uu[16], vv[16];
    float wj[16];
#pragma unroll
    for (int j = 0; j < 16; ++j) {
      const int src = (g >> 1) + (j >> 1);
      const int ej = (j & 1) ? __builtin_amdgcn_readlane(e2.y, src) : __builtin_amdgcn_readlane(e2.x, src);
      wj[j] = __builtin_bit_cast(float, (j & 1) ? __builtin_amdgcn_readlane(__builtin_bit_cast(int, w2.y), src)
                                                : __builtin_amdgcn_readlane(__builtin_bit_cast(int, w2.x), src));
      const size_t ro = (size_t)ej * 1024 + 16 * lane;
      uu[j] = *(const u32x4*)(U8 + ro);
      vv[j] = *(const u32x4*)(V8 + ro);
    }
    float d[16];
#pragma unroll
    for (int j = 0; j < 16; ++j) {
      const f32x2 l0 = __builtin_amdgcn_cvt_pk_f32_fp8((int)uu[j].x, false), h0 = __builtin_amdgcn_cvt_pk_f32_fp8((int)uu[j].x, true);
      const f32x2 l1 = __builtin_amdgcn_cvt_pk_f32_fp8((int)uu[j].y, false), h1 = __builtin_amdgcn_cvt_pk_f32_fp8((int)uu[j].y, true);
      const f32x2 l2 = __builtin_amdgcn_cvt_pk_f32_fp8((int)uu[j].z, false), h2v = __builtin_amdgcn_cvt_pk_f32_fp8((int)uu[j].z, true);
      const f32x2 l3 = __builtin_amdgcn_cvt_pk_f32_fp8((int)uu[j].w, false), h3 = __builtin_amdgcn_cvt_pk_f32_fp8((int)uu[j].w, true);
      float a0 = l0.x * hf[0] + l0.y * hf[1], a1 = h0.x * hf[2] + h0.y * hf[3];
      a0 += l1.x * hf[4] + l1.y * hf[5]; a1 += h1.x * hf[6] + h1.y * hf[7];
      a0 += l2.x * hf[8] + l2.y * hf[9]; a1 += h2v.x * hf[10] + h2v.y * hf[11];
      a0 += l3.x * hf[12] + l3.y * hf[13]; a1 += h3.x * hf[14] + h3.y * hf[15];
      d[j] = a0 + a1;
    }
#pragma unroll
    for (int q = 0; q < 4; ++q) {
      const float dot = reduce4_rows(d[4 * q], d[4 * q + 1], d[4 * q + 2], d[4 * q + 3], lane);
      const float gl = gelu_tanh(dot * (1.f / 512.f)) * (1.f / 64.f);
#pragma unroll
      for (int i = 0; i < 4; ++i) {
        const int j = 4 * q + i;
        const float ci = wj[j] * __builtin_bit_cast(float, __builtin_amdgcn_readlane(__builtin_bit_cast(int, gl), 16 * i));
        f32x2 tq;
        tq = __builtin_amdgcn_cvt_pk_f32_fp8((int)vv[j].x, false); o[0] += ci * tq.x; o[1] += ci * tq.y;
        tq = __builtin_amdgcn_cvt_pk_f32_fp8((int)vv[j].x, true);  o[2] += ci * tq.x; o[3] += ci * tq.y;
        tq = __builtin_amdgcn_cvt_pk_f32_fp8((int)vv[j].y, false); o[4] += ci * tq.x; o[5] += ci * tq.y;
        tq = __builtin_amdgcn_cvt_pk_f32_fp8((int)vv[j].y, true);  o[6] += ci * tq.x; o[7] += ci * tq.y;
        tq = __builtin_amdgcn_cvt_pk_f32_fp8((int)vv[j].z, false); o[8] += ci * tq.x; o[9] += ci * tq.y;
        tq = __builtin_amdgcn_cvt_pk_f32_fp8((int)vv[j].z, true);  o[10] += ci * tq.x; o[11] += ci * tq.y;
        tq = __builtin_amdgcn_cvt_pk_f32_fp8((int)vv[j].w, false); o[12] += ci * tq.x; o[13] += ci * tq.y;
        tq = __builtin_amdgcn_cvt_pk_f32_fp8((int)vv[j].w, true);  o[14] += ci * tq.x; o[15] += ci * tq.y;
      }
    }
  }
  const int b = t >> 12;
  const float* mod = (const float*)(p.ws + OFF_MOD) + b * 6144 + 5120 + 16 * lane;
  float* xm = p.out + (size_t)t * 1024 + 16 * lane;
  float xo[16];
  float ss = 0.f;
#pragma unroll
  for (int q = 0; q < 4; ++q) {
    const float4 xv = *(const float4*)(xm + 4 * q);
    const float4 gv = *(const float4*)(mod + 4 * q);
    xo[4 * q + 0] = xv.x + gv.x * o[4 * q + 0];
    xo[4 * q + 1] = xv.y + gv.y * o[4 * q + 1];
    xo[4 * q + 2] = xv.z + gv.z * o[4 * q + 2];
    xo[4 * q + 3] = xv.w + gv.w * o[4 * q + 3];
  }
#pragma unroll
  for (int k = 0; k < 16; ++k) ss += xo[k] * xo[k];
  ss = wave_sum(ss);
  const float r = rsqrtf(ss * (1.f / 1024.f) + 1e-6f);
#pragma unroll
  for (int q = 0; q < 4; ++q) {
    const float4 fg = *(const float4*)(p.final_g + 16 * lane + 4 * q);
    *(float4*)(xm + 4 * q) = make_float4(xo[4 * q] * r * fg.x, xo[4 * q + 1] * r * fg.y, xo[4 * q + 2] * r * fg.z, xo[4 * q + 3] * r * fg.w);
  }
}

DEV void p9_experts4(const Params& p, int task, char* wsm) {
  const int lane = threadIdx.x & 63;
  const int t0 = task * 4;
  int* hist = (int*)wsm;
  unsigned* skey = (unsigned*)(wsm + 1024);
  float* swt = (float*)(wsm + 1024 + 2048);
  u16* sh2 = (u16*)(wsm + 1024 + 4096);
  hist[lane] = 0; hist[lane + 64] = 0; hist[lane + 128] = 0; hist[lane + 192] = 0;
  const int* ridx = (const int*)(p.ws + OFF_RIDX) + (size_t)t0 * 128 + lane * 8;
  const float* rw = (const float*)(p.ws + OFF_RW) + (size_t)t0 * 128 + lane * 8;
  int4 ea = *(const int4*)(ridx), eb = *(const int4*)(ridx + 4);
  float4 wa = *(const float4*)(rw), wb = *(const float4*)(rw + 4);
  int e[8] = {ea.x, ea.y, ea.z, ea.w, eb.x, eb.y, eb.z, eb.w};
  float w[8] = {wa.x, wa.y, wa.z, wa.w, wb.x, wb.y, wb.z, wb.w};
  {
    const u16* h2 = (const u16*)(p.ws + OFF_H2) + (size_t)t0 * 1024;
#pragma unroll
    for (int i = 0; i < 8; ++i) *(u32x4*)(sh2 + (lane + 64 * i) * 8) = *(const u32x4*)(h2 + (lane + 64 * i) * 8);
  }
  __builtin_amdgcn_fence(__ATOMIC_RELEASE, "wavefront");
  __builtin_amdgcn_wave_barrier();
  __builtin_amdgcn_fence(__ATOMIC_ACQUIRE, "wavefront");
  int rank[8];
#pragma unroll
  for (int j = 0; j < 8; ++j) rank[j] = atomicAdd(&hist[e[j] >> 6], 1);
  __builtin_amdgcn_fence(__ATOMIC_RELEASE, "wavefront");
  __builtin_amdgcn_wave_barrier();
  __builtin_amdgcn_fence(__ATOMIC_ACQUIRE, "wavefront");
  {
    const int c0 = hist[4 * lane], c1 = hist[4 * lane + 1], c2 = hist[4 * lane + 2], c3 = hist[4 * lane + 3];
    const int tot = c0 + c1 + c2 + c3;
    int x = tot;
#pragma unroll
    for (int o = 1; o < 64; o <<= 1) { const int y = __shfl_up(x, o); if (lane >= o) x += y; }
    const int base = x - tot;
    __builtin_amdgcn_fence(__ATOMIC_RELEASE, "wavefront");
    __builtin_amdgcn_wave_barrier();
    hist[4 * lane] = base; hist[4 * lane + 1] = base + c0; hist[4 * lane + 2] = base + c0 + c1; hist[4 * lane + 3] = base + c0 + c1 + c2;
  }
  __builtin_amdgcn_fence(__ATOMIC_RELEASE, "wavefront");
  __builtin_amdgcn_wave_barrier();
  __builtin_amdgcn_fence(__ATOMIC_ACQUIRE, "wavefront");
  {
    const unsigned slot = (unsigned)(lane >> 4);
#pragma unroll
    for (int j = 0; j < 8; ++j) {
      const int pos = hist[e[j] >> 6] + rank[j];
      skey[pos] = (unsigned)e[j] | (slot << 14);
      swt[pos] = w[j];
    }
  }
  __builtin_amdgcn_fence(__ATOMIC_RELEASE, "wavefront");
  __builtin_amdgcn_wave_barrier();
  __builtin_amdgcn_fence(__ATOMIC_ACQUIRE, "wavefront");

  float o0[16], o1[16], o2[16], o3[16];
#pragma unroll
  for (int k = 0; k < 16; ++k) { o0[k] = 0.f; o1[k] = 0.f; o2[k] = 0.f; o3[k] = 0.f; }
  const u16* U = (const u16*)(p.ws + OFF_UBF);
  const u16* V = (const u16*)(p.ws + OFF_VBF);
#define P9_LOAD(KK, UU, VV, BB)                                                           \
  _Pragma("unroll") for (int i = 0; i < 4; ++i) {                                         \
    KK[i] = (unsigned)__builtin_amdgcn_readfirstlane((int)skey[4 * (BB) + i]);            \
    const size_t ro = (size_t)(KK[i] & 16383u) * 1024 + 16 * lane;                        \
    UU[i] = *(const u32x4*)(U8 + ro);                                                     \
    VV[i] = *(const u32x4*)(V8 + ro);                                                     \
  }
#define P9_DOTS(KK, UU, BB, COEFV)                                                        \
  {                                                                                       \
    const float myw = swt[4 * (BB) + (lane >> 4)];                                        \
    float d[4];                                                                           \
    _Pragma("unroll") for (int i = 0; i < 4; ++i) {                                       \
      const unsigned slot = KK[i] >> 14;                                                  \
      const u32x4 ha = *(const u32x4*)(sh2 + slot * 1024 + 16 * lane);                    \
      const u32x4 hb = *(const u32x4*)(sh2 + slot * 1024 + 16 * lane + 8);                \
      float acc0 = 0.f, acc1 = 0.f;                                                       \
      {                                                                                   \
        f32x2 l0 = __builtin_amdgcn_cvt_pk_f32_fp8((int)UU[i].x, false), h0 = __builtin_amdgcn_cvt_pk_f32_fp8((int)UU[i].x, true); \
        f32x2 l1 = __builtin_amdgcn_cvt_pk_f32_fp8((int)UU[i].y, false), h1 = __builtin_amdgcn_cvt_pk_f32_fp8((int)UU[i].y, true); \
        f32x2 l2 = __builtin_amdgcn_cvt_pk_f32_fp8((int)UU[i].z, false), h2_ = __builtin_amdgcn_cvt_pk_f32_fp8((int)UU[i].z, true); \
        f32x2 l3 = __builtin_amdgcn_cvt_pk_f32_fp8((int)UU[i].w, false), h3 = __builtin_amdgcn_cvt_pk_f32_fp8((int)UU[i].w, true); \
        acc0 += l0.x * bflo(ha.x) + l0.y * bfhi(ha.x); acc1 += h0.x * bflo(ha.y) + h0.y * bfhi(ha.y);   \
        acc0 += l1.x * bflo(ha.z) + l1.y * bfhi(ha.z); acc1 += h1.x * bflo(ha.w) + h1.y * bfhi(ha.w);   \
        acc0 += l2.x * bflo(hb.x) + l2.y * bfhi(hb.x); acc1 += h2_.x * bflo(hb.y) + h2_.y * bfhi(hb.y); \
        acc0 += l3.x * bflo(hb.z) + l3.y * bfhi(hb.z); acc1 += h3.x * bflo(hb.w) + h3.y * bfhi(hb.w);   \
      }                                                                                   \
      d[i] = acc0 + acc1;                                                                 \
    }                                                                                     \
    const bool up32 = (lane & 32) != 0, up16 = (lane & 16) != 0;                          \
    float k0 = up32 ? d[2] : d[0], k1 = up32 ? d[3] : d[1];                               \
    float s0 = up32 ? d[0] : d[2], s1 = up32 ? d[1] : d[3];                               \
    k0 += __shfl_xor(s0, 32);                                                             \
    k1 += __shfl_xor(s1, 32);                                                             \
    float kq = up16 ? k1 : k0, sq = up16 ? k0 : k1;                                       \
    kq += __shfl_xor(sq, 16);                                                             \
    kq = DPP_ADD(kq, 0xB1);                                                               \
    kq = DPP_ADD(kq, 0x4E);                                                               \
    kq = DPP_ADD(kq, 0x141);                                                              \
    kq = DPP_ADD(kq, 0x140);                                                              \
    COEFV = myw * (1.f / 64.f) * gelu_tanh(kq * (1.f / 512.f));                           \
  }
#define P9_ACCUM(KK, VV, COEFV)                                                           \
  _Pragma("unroll") for (int i = 0; i < 4; ++i) {                                         \
    const float ci = __builtin_bit_cast(float, __builtin_amdgcn_readlane(__builtin_bit_cast(int, COEFV), 16 * i)); \
    const unsigned slot = KK[i] >> 14;                                                    \
    float vf[16];                                                                         \
    {                                                                                     \
      f32x2 t;                                                                            \
      t = __builtin_amdgcn_cvt_pk_f32_fp8((int)VV[i].x, false); vf[0] = t.x; vf[1] = t.y;   \
      t = __builtin_amdgcn_cvt_pk_f32_fp8((int)VV[i].x, true);  vf[2] = t.x; vf[3] = t.y;   \
      t = __builtin_amdgcn_cvt_pk_f32_fp8((int)VV[i].y, false); vf[4] = t.x; vf[5] = t.y;   \
      t = __builtin_amdgcn_cvt_pk_f32_fp8((int)VV[i].y, true);  vf[6] = t.x; vf[7] = t.y;   \
      t = __builtin_amdgcn_cvt_pk_f32_fp8((int)VV[i].z, false); vf[8] = t.x; vf[9] = t.y;   \
      t = __builtin_amdgcn_cvt_pk_f32_fp8((int)VV[i].z, true);  vf[10] = t.x; vf[11] = t.y; \
      t = __builtin_amdgcn_cvt_pk_f32_fp8((int)VV[i].w, false); vf[12] = t.x; vf[13] = t.y; \
      t = __builtin_amdgcn_cvt_pk_f32_fp8((int)VV[i].w, true);  vf[14] = t.x; vf[15] = t.y; \
    }                                                                                     \
    if (slot == 0) { _Pragma("unroll") for (int k = 0; k < 16; ++k) o0[k] += ci * vf[k]; }       \
    else if (slot == 1) { _Pragma("unroll") for (int k = 0; k < 16; ++k) o1[k] += ci * vf[k]; }  \
    else if (slot == 2) { _Pragma("unroll") for (int k = 0; k < 16; ++k) o2[k] += ci * vf[k]; }  \
    else { _Pragma("unroll") for (int k = 0; k < 16; ++k) o3[k] += ci * vf[k]; }                 \
  }
  {
    const unsigned char* U8 = (const unsigned char*)(p.ws + OFF_UBF);
    const unsigned char* V8 = (const unsigned char*)(p.ws + OFF_VBF);
    unsigned kkA[4], kkB[4];
    u32x4 uA[4], vA[4], uB[4], vB[4];
    float cfA, cfB;
    P9_LOAD(kkA, uA, vA, 0)
#pragma unroll 1
    for (int bb = 0; bb < 128; bb += 2) {
      P9_LOAD(kkB, uB, vB, bb + 1)
      P9_DOTS(kkA, uA, bb, cfA)
      P9_ACCUM(kkA, vA, cfA)
      const int n0 = (bb + 2 < 128) ? (bb + 2) : 0;
      P9_LOAD(kkA, uA, vA, n0)
      P9_DOTS(kkB, uB, bb + 1, cfB)
      P9_ACCUM(kkB, vB, cfB)
    }
  }
#pragma unroll
  for (int s = 0; s < 4; ++s) {
    const int t = t0 + s;
    const int b = t >> 12;
    const float* mod = (const float*)(p.ws + OFF_MOD) + b * 6144 + 5120 + 16 * lane;
    float* xm = p.out + (size_t)t * 1024 + 16 * lane;
    const float* oo = (s == 0) ? o0 : ((s == 1) ? o1 : ((s == 2) ? o2 : o3));
    float xo[16];
    float ss = 0.f;
#pragma unroll
    for (int q = 0; q < 4; ++q) {
      const float4 xv = *(const float4*)(xm + 4 * q);
      const float4 gv = *(const float4*)(mod + 4 * q);
      xo[4 * q + 0] = xv.x + gv.x * oo[4 * q + 0];
      xo[4 * q + 1] = xv.y + gv.y * oo[4 * q + 1];
      xo[4 * q + 2] = xv.z + gv.z * oo[4 * q + 2];
      xo[4 * q + 3] = xv.w + gv.w * oo[4 * q + 3];
    }
#pragma unroll
    for (int k = 0; k < 16; ++k) ss += xo[k] * xo[k];
    ss = wave_sum(ss);
    const float r = rsqrtf(ss * (1.f / 1024.f) + 1e-6f);
#pragma unroll
    for (int q = 0; q < 4; ++q) {
      const float4 fg = *(const float4*)(p.final_g + 16 * lane + 4 * q);
      *(float4*)(xm + 4 * q) = make_float4(xo[4 * q] * r * fg.x, xo[4 * q + 1] * r * fg.y, xo[4 * q + 2] * r * fg.z, xo[4 * q + 3] * r * fg.w);
    }
  }
  __builtin_amdgcn_fence(__ATOMIC_RELEASE, "wavefront");
  __builtin_amdgcn_wave_barrier();
}

#define XB_TMO      128
#define XB_XCNT(j)  (256  + 64 * (j))
#define XB_XSUB(j)  (1280 + 64 * (j))
#define XB_XGEN(j)  (2304 + 64 * (j))
#define XB_TOP      3328
#define XB_TOPGEN   3392
#define XCD_BAR_WORDS 3456
#define XB_SPIN_CAP (1u << 18)
#define LAS __attribute__((address_space(3)))

__device__ __forceinline__ unsigned xb_ld(unsigned* p)              { return __hip_atomic_load(p, __ATOMIC_RELAXED, __HIP_MEMORY_SCOPE_AGENT); }
__device__ __forceinline__ unsigned xb_add(unsigned* p, unsigned v) { return __hip_atomic_fetch_add(p, v, __ATOMIC_RELAXED, __HIP_MEMORY_SCOPE_AGENT); }
__device__ __forceinline__ unsigned xb_xcc_id() { return (unsigned)__builtin_amdgcn_s_getreg((3 << 11) | 20) & 0xFu; }
#define XB_SPIN(cond, bar) do { unsigned _sp = 0; while (cond) { __builtin_amdgcn_s_sleep(1); \
    if ((++_sp & 255u) == 0u) { if (xb_ld(&(bar)[XB_TMO])) break; if (_sp > XB_SPIN_CAP) { atomicAdd(&(bar)[XB_TMO], 1u); break; } } } } while (0)

struct XcdBarrier {
    unsigned* bar; unsigned x;
    volatile LAS unsigned* st;
};

__device__ __forceinline__ XcdBarrier xcd_barrier_post(unsigned* bar, volatile LAS unsigned* st) {
    XcdBarrier b; b.bar = bar; b.x = xb_xcc_id(); b.st = st;
    if (threadIdx.x == 0) (void)xb_add(&bar[XB_XCNT(b.x)], 1u);
    return b;
}
__device__ __forceinline__ void xcd_barrier_complete(unsigned* bar, unsigned x, unsigned& nloc, unsigned& nx) {
    const unsigned G = gridDim.x * gridDim.y * gridDim.z;
    unsigned sum, cnt, mine, sp = 0u;
    for (;;) {
        sum = 0u; cnt = 0u; mine = 0u;
#pragma unroll
        for (unsigned j = 0; j < 16; ++j) { const unsigned c = xb_ld(&bar[XB_XCNT(j)]); sum += c; cnt += (c > 0u) ? 1u : 0u; mine = (j == x) ? c : mine; }
        if (sum == G) break;
        __builtin_amdgcn_s_sleep(1);
        if ((++sp & 255u) == 0u) { if (xb_ld(&bar[XB_TMO])) break; if (sp > XB_SPIN_CAP) { atomicAdd(&bar[XB_TMO], 1u); break; } }
    }
    nloc = mine > 0u ? mine : 1u; nx = cnt > 0u ? cnt : 1u;
}

__device__ __forceinline__ void xcd_barrier(const XcdBarrier& b) {
    asm volatile("s_waitcnt vmcnt(0)" ::: "memory");
    __syncthreads();
    if (threadIdx.x == 0) {
        unsigned* bar = b.bar;
        __builtin_amdgcn_s_waitcnt(0);
        unsigned nloc = b.st[0], nx = b.st[1];
        if (nloc == 0u) { xcd_barrier_complete(bar, b.x, nloc, nx); b.st[0] = nloc; b.st[1] = nx; }
        const unsigned old = xb_add(&bar[XB_XSUB(b.x)], 1u);
        const unsigned gen = old / nloc;
        if (old + 1u == (gen + 1u) * nloc) {
            __builtin_amdgcn_fence(__ATOMIC_RELEASE, "agent");
            asm volatile("s_waitcnt vmcnt(0)" ::: "memory");
            const unsigned og = xb_add(&bar[XB_TOP], 1u);
            const unsigned tg = og / nx;
            if (og + 1u == (tg + 1u) * nx) xb_add(&bar[XB_TOPGEN], 1u);
            else XB_SPIN(xb_ld(&bar[XB_TOPGEN]) == tg, bar);
            __builtin_amdgcn_fence(__ATOMIC_ACQUIRE, "agent");
            xb_add(&bar[XB_XGEN(b.x)], 1u);
            asm volatile("s_waitcnt vmcnt(0)" ::: "memory");
        } else {
            XB_SPIN(xb_ld(&bar[XB_XGEN(b.x)]) == gen, bar);
            __builtin_amdgcn_fence(__ATOMIC_ACQUIRE, "agent");
            asm volatile("s_waitcnt vmcnt(0)" ::: "memory");
        }
    }
    __syncthreads();
}


__global__ void __launch_bounds__(256, 2) mega(Params p) {
  extern __shared__ __attribute__((aligned(16))) char smem[];
  cg::grid_group grid = cg::this_grid();
  const int tid = threadIdx.x, lane = tid & 63, wave = tid >> 6;
  const int nb = gridDim.x, bid = blockIdx.x;
  float* smf = (float*)smem;
  if (p.ws == nullptr) grid.sync();
  volatile LAS unsigned* xst = (volatile LAS unsigned*)(smem + SMEM_XB);
  if (tid == 0) { xst[0] = 0u; xst[1] = 0u; }
  __syncthreads();
  const XcdBarrier xb = xcd_barrier_post((unsigned*)(p.ws + OFF_BAR), xst);
  u16* sA = (u16*)smem;
  u16* sB = (u16*)(smem + 128 * 64 * 2);

  for (int rep_ = 0; rep_ < NREP(0); ++rep_) if (PHON(0)) {
    const int N_MOD = 384, N_TIN = 16 * 68, N_TOA = 8 * 16, N_TOH = 8 * 16, N_TOUT = 16 * 16, N_TQ = 16 * 16, N_HID = 1024;
    const int total = N_MOD + N_TIN + N_TOA + N_TOH + N_TOUT + N_TQ + N_HID + 16 + 1;
    const bool conv_first = ((bid >> 3) & 1) != 0;
    if (conv_first) {
      convert_flat(p.peer_keys, (u16*)(p.ws + OFF_KEYS), (size_t)131072);
      convert_flat_fp8(p.peer_u, (unsigned char*)(p.ws + OFF_UBF), (size_t)16384 * 1024, 512.f);
      convert_flat_fp8(p.peer_v, (unsigned char*)(p.ws + OFF_VBF), (size_t)16384 * 1024, 64.f);
    }
    for (int it = bid; it < total; it += nb) {
      int i = it;
      if (i < N_MOD) { p0_mod(p, i, smf); continue; }
      i -= N_MOD;
      if (i < N_TIN) { transpose_tile(p.w_in, INW, 1024, (u16*)(p.ws + OFF_WIN), i, smf); continue; }
      i -= N_TIN;
      if (i < N_TOA) { transpose_tile(p.w_o_attn, 1024, 512, (u16*)(p.ws + OFF_WOA), i, smf); continue; }
      i -= N_TOA;
      if (i < N_TOH) { transpose_tile(p.w_o_hy, 1024, 512, (u16*)(p.ws + OFF_WOH), i, smf); continue; }
      i -= N_TOH;
      if (i < N_TOUT) { transpose_tile(p.w_out, 1024, 1024, (u16*)(p.ws + OFF_WOUT), i, smf); continue; }
      i -= N_TOUT;
      if (i < N_TQ) { transpose_tile(p.peer_wq, 1024, 1024, (u16*)(p.ws + OFF_WQ), i, smf); continue; }
      i -= N_TQ;
      if (i < N_HID) { p0_hidden(p, i, smf); continue; }
      i -= N_HID;
      if (i < 16) { transpose_tile(p.hy_fw3, 1024, 64, (u16*)(p.ws + OFF_H2F + 512 * 1024), i, smf); continue; }
      float2* rope = (float2*)(p.ws + OFF_ROPE);
      for (int idx = tid; idx < 1024; idx += 256) {
        const int pos = idx >> 4, f = idx & 15;
        const float inv = powf(10000.f, -(float)f / 16.f);
        const float ang = (float)pos * inv;
        rope[idx] = make_float2(cosf(ang), sinf(ang));
      }
    }
    if (!conv_first) {
      convert_flat(p.peer_keys, (u16*)(p.ws + OFF_KEYS), (size_t)131072);
      convert_flat_fp8(p.peer_u, (unsigned char*)(p.ws + OFF_UBF), (size_t)16384 * 1024, 512.f);
      convert_flat_fp8(p.peer_v, (unsigned char*)(p.ws + OFF_VBF), (size_t)16384 * 1024, 64.f);
    }
  }
  xcd_barrier(xb);

  for (int rep_ = 0; rep_ < NREP(1); ++rep_) if (PHON(1)) {
    const float* mod = (const float*)(p.ws + OFF_MOD);
    const int nrows = T_TOK + 1024;
    for (int r = bid * 4 + wave; r < nrows; r += nb * 4) {
      if (r < T_TOK) {
        const int b = r >> 12;
        norm_row(p.x + (size_t)r * 1024, p.norm1_g, mod + b * 6144, mod + b * 6144 + 1024,
                 (u16*)((char*)p.out + OO_H1) + (size_t)r * 1024, lane);
      } else {
        const int rc = r - T_TOK;
        norm_row(p.ctx + (size_t)rc * 1024, p.norm1_g, mod + 4 * 6144, mod + 4 * 6144 + 1024,
                 (u16*)((char*)p.out + OO_HC) + (size_t)rc * 1024, lane);
      }
    }
    for (int it = bid; it < 256; it += nb) p1_filter_tile(p, (it + 256 < nb) ? it : it, sA, sB);
  }
  xcd_barrier(xb);

  for (int rep_ = 0; rep_ < NREP(2); ++rep_) if (PHON(2)) {
    if (nb == 512) {
      const int xg = bid & 7, slot = bid >> 3;
      for (int r = 0; r < 8; ++r) {
        const int sup = r * 8 + xg;
        const int mt = (sup >> 2) * 8 + (slot >> 3), nt = (sup & 3) * 8 + (slot & 7);
        p2_inproj(p, mt * 34 + nt, sA, sB);
      }
      if (bid < 256) p2_inproj(p, (bid >> 1) * 34 + 32 + (bid & 1), sA, sB);
      else if (bid < 272) p2_ctxkv(p, bid - 256, sA, sB);
    } else {
      const int total = 128 * 34 + 16;
      for (int it = bid; it < total; it += nb) {
        if (it < 128 * 34) p2_inproj(p, it, sA, sB);
        else p2_ctxkv(p, it - 128 * 34, sA, sB);
      }
    }
  }
  xcd_barrier(xb);

  for (int rep_ = 0; rep_ < NREP(3); ++rep_) if (PHON(3)) {
    const int total = 1024 + 1024;
    for (int it = bid; it < total; it += nb) {
      if (it < 1024) p3_attn(p, it, (u16*)smem, (u16*)(smem + 128 * 72 * 2));
      else p3_hypre(p, it - 1024, (u16*)smem);
    }
  }
  xcd_barrier(xb);

  for (int rep_ = 0; rep_ < NREP(4); ++rep_) if (PHON(4)) for (int it = bid; it < 512; it += nb) p3_toeplitz(p, it, smem);
  xcd_barrier(xb);

  for (int rep_ = 0; rep_ < NREP(5); ++rep_) if (PHON(5)) for (int it = bid; it < 1024; it += nb) p4_merge(p, (nb == 512) ? ((((it >> 9) * 8 + (bid & 7)) * 8 + (bid >> 6)) * 8 + ((bid >> 3) & 7)) : it, sA, sB);
  xcd_barrier(xb);

  for (int rep_ = 0; rep_ < NREP(6); ++rep_) if (PHON(6)) for (int it = bid; it < 1024; it += nb) p5_out(p, (nb == 512) ? ((((it >> 9) * 8 + (bid & 7)) * 8 + (bid >> 6)) * 8 + ((bid >> 3) & 7)) : it, sA, sB);
  xcd_barrier(xb);

  for (int rep_ = 0; rep_ < NREP(7); ++rep_) if (PHON(7)) {
    const float* mod = (const float*)(p.ws + OFF_MOD);
    for (int r = bid * 4 + wave; r < T_TOK; r += nb * 4) {
      const int b = r >> 12;
      norm_row(p.out + (size_t)r * 1024, p.norm2_g, mod + b * 6144 + 3072, mod + b * 6144 + 4096,
               (u16*)(p.ws + OFF_H2) + (size_t)r * 1024, lane);
    }
  }
  xcd_barrier(xb);

  for (int rep_ = 0; rep_ < NREP(8); ++rep_) if (PHON(8)) for (int it = bid; it < 1024; it += nb) p7_qp(p, (nb == 512) ? ((((it >> 9) * 8 + (bid & 7)) * 8 + (bid >> 6)) * 8 + ((bid >> 3) & 7)) : it, sA, sB);
  xcd_barrier(xb);

  for (int rep_ = 0; rep_ < NREP(9); ++rep_) if (PHON(9)) {
    if (tid < 52) ((unsigned char*)(smem + 16384))[tid] = kTabG[tid];
    __syncthreads();
    for (int it = bid * 4 + wave; it < 8192; it += nb * 4) p8_route(p, it, smem + wave * 4096, (const unsigned char*)(smem + 16384));
  }
  xcd_barrier(xb);

  if (PHON(10)) {
    const int nw = nb * 4;
    int t = bid * 4 + wave;
    if (t < T_TOK) {
      int2 e2n = *(const int2*)((const int*)(p.ws + OFF_RIDX) + (size_t)t * 128 + 2 * lane);
      float2 w2n = *(const float2*)((const float*)(p.ws + OFF_RW) + (size_t)t * 128 + 2 * lane);
      u32x4 han = *(const u32x4*)((const u16*)(p.ws + OFF_H2) + (size_t)t * 1024 + 16 * lane);
      u32x4 hbn = *(const u32x4*)((const u16*)(p.ws + OFF_H2) + (size_t)t * 1024 + 16 * lane + 8);
      for (; t < T_TOK; t += nw) {
        const int tn = (t + nw < T_TOK) ? (t + nw) : t;
        p9_token(p, t, tn, lane, e2n, w2n, han, hbn);
      }
    }
  }
}

extern "C" void kernel_launch(void* const* d_in, const int* in_sizes, int n_in, void* d_out, int out_size,
                              void* d_ws, size_t ws_size, hipStream_t stream) {
  static int grid_blocks = 0;
  if (!grid_blocks) {
    int dev = 0, cus = 0, per_cu = 0;
    (void)hipGetDevice(&dev);
    (void)hipDeviceGetAttribute(&cus, hipDeviceAttributeMultiprocessorCount, dev);
    (void)hipFuncSetAttribute((const void*)mega, hipFuncAttributeMaxDynamicSharedMemorySize, SMEM_BYTES);
    (void)hipOccupancyMaxActiveBlocksPerMultiprocessor(&per_cu, mega, 256, SMEM_BYTES);
    if (per_cu > 2) per_cu = 2;
    if (per_cu < 1) per_cu = 1;
    grid_blocks = cus * per_cu;
  }
  Params p{};
  const float** pp = (const float**)&p;
  for (int i = 0; i < 28; ++i) pp[i] = (const float*)d_in[i];
  p.out = (float*)d_out;
  p.ws = (char*)d_ws;
  (void)hipMemsetAsync((char*)d_ws, 0, OFF_BAR + 24576, stream);
  void* args[] = {&p};
  hipError_t e = hipLaunchCooperativeKernel((void*)mega, dim3(grid_blocks), dim3(256), args, SMEM_BYTES, stream);
  if (e != hipSuccess) fprintf(stderr, "cooperative launch failed: %s (grid %d)\n", hipGetErrorString(e), grid_blocks);
}
```

```cpp
#include <hip/hip_runtime.h>
#include <hip/hip_bf16.h>
#include <hip/hip_cooperative_groups.h>
#include <cstdio>
namespace cg = cooperative_groups;

typedef unsigned short u16;
typedef __attribute__((ext_vector_type(8))) short bf16x8;
typedef __attribute__((ext_vector_type(4))) float f32x4;
typedef __attribute__((ext_vector_type(4))) unsigned u32x4;

#define DEV __device__ __forceinline__
#ifndef PH
#define PH -1
#endif
#define PHON(n) (PH < 0 || PH == (n))
#ifndef REP
#define REP -1
#endif
#define NREP(n) ((REP == (n)) ? 2 : 1)

constexpr int T_TOK = 16384;
constexpr int DM = 1024;
constexpr int SEQL = 4096;
constexpr int INW = 4352;

struct Params {
  const float *x, *c, *ctx, *c_ctx, *w_mod, *b_mod, *norm1_g, *w_in, *attn_sink, *hy_conv_w, *hy_conv_b,
      *hy_fw1, *hy_fb1, *hy_fw2, *hy_fb2, *hy_fw3, *hy_fb3, *hy_freq, *hy_skip, *w_o_attn, *w_o_hy, *w_out,
      *norm2_g, *peer_wq, *peer_keys, *peer_u, *peer_v, *final_g;
  float* out;
  char* ws;
};

constexpr size_t MB = 1u << 20;
constexpr size_t OFF_MOD = 0;
constexpr size_t OFF_ROPE = 128 * 1024;
constexpr size_t OFF_NINV = OFF_ROPE + 8192;
constexpr size_t OFF_H2F = 256 * 1024;
constexpr size_t OFF_WIN = OFF_H2F + MB;
constexpr size_t OFF_WOA = OFF_WIN + 9 * MB;
constexpr size_t OFF_WOH = OFF_WOA + MB;
constexpr size_t OFF_WOUT = OFF_WOH + MB;
constexpr size_t OFF_WQ = OFF_WOUT + 2 * MB;
constexpr size_t OFF_KEYS = OFF_WQ + 2 * MB;
constexpr size_t OFF_UBF = OFF_KEYS + MB;
constexpr size_t OFF_VBF = OFF_UBF + 32 * MB;
constexpr size_t OFF_Q = OFF_VBF + 32 * MB;
constexpr size_t OFF_K = OFF_Q + 16 * MB;
constexpr size_t OFF_VT = OFF_K + 4 * MB;
constexpr size_t OFF_KC = OFF_VT + 4 * MB;
constexpr size_t OFF_VCT = OFF_KC + MB / 2;
constexpr size_t OFF_Z = OFF_VCT + MB / 2;
constexpr size_t OFF_GATE = OFF_Z + 48 * MB;
constexpr size_t OFF_YATT = OFF_GATE + 64 * MB;
constexpr size_t OFF_YHY = OFF_YATT + 16 * MB;
constexpr size_t OFF_RIDX = OFF_Q;
constexpr size_t OFF_RW = OFF_Q + 8 * MB;
constexpr size_t OFF_MERGED = OFF_Z;
constexpr size_t OFF_H2 = OFF_GATE;
constexpr size_t OFF_QP = OFF_GATE + 32 * MB;
constexpr size_t OO_H1 = 0;
constexpr size_t OO_UT = 0;
constexpr size_t OO_X0T = 16 * MB;
constexpr size_t OO_HC = 32 * MB;
constexpr size_t OO_G = 34 * MB;

constexpr int SMEM_BYTES = 70144;
constexpr size_t OFF_BAR = 160 * 1024;
constexpr int SMEM_XB = 70016;

typedef __attribute__((ext_vector_type(2))) float pk_f2;
typedef __attribute__((ext_vector_type(2))) __bf16 pk_b2;
DEV unsigned pack2(float a, float b) {
  pk_f2 v = {a, b};
  return __builtin_bit_cast(unsigned, __builtin_convertvector(v, pk_b2));
}
DEV u16 f2bf(float f) { return (u16)(pack2(f, 0.f) & 0xffffu); }
DEV float bf2f(u16 h) { return __uint_as_float(((unsigned)h) << 16); }
DEV float bflo(unsigned w) { return __uint_as_float(w << 16); }
DEV float bfhi(unsigned w) { return __uint_as_float(w & 0xffff0000u); }
#define DPP_ADD(v, ctrl) ((v) + __builtin_bit_cast(float, __builtin_amdgcn_update_dpp(0, __builtin_bit_cast(int, (v)), (ctrl), 0xF, 0xF, true)))
DEV float wave_sum(float v) {
  v = DPP_ADD(v, 0xB1);
  v = DPP_ADD(v, 0x4E);
  v = DPP_ADD(v, 0x141);
  v = DPP_ADD(v, 0x140);
  v += __shfl_xor(v, 16);
  v += __shfl_xor(v, 32);
  return v;
}
DEV float wave_max(float v) {
#pragma unroll
  for (int o = 32; o > 0; o >>= 1) v = fmaxf(v, __shfl_xor(v, o));
  return v;
}

DEV void p0_mod(const Params& p, int item, float* sm) {
  const int tid = threadIdx.x;
  const int cblk = item >> 2, kq = item & 3;
  for (int i = tid; i < 5 * 256; i += 256) {
    const int r = i >> 8, k = kq * 256 + (i & 255);
    const float c = (r < 4) ? p.c[r * 1024 + k] : p.c_ctx[k];
    sm[i] = c * __builtin_amdgcn_rcpf(1.f + __expf(-c));
  }
  __syncthreads();
  const int col = cblk * 64 + (tid & 63), sub = tid >> 6;
  float a0 = 0, a1 = 0, a2 = 0, a3 = 0, a4 = 0;
  const float* wp = p.w_mod + (size_t)(kq * 256 + sub * 64) * 6144 + col;
#pragma unroll 16
  for (int k = 0; k < 64; ++k) {
    const float w = wp[(size_t)k * 6144];
    const int kk = sub * 64 + k;
    a0 += sm[kk] * w; a1 += sm[256 + kk] * w; a2 += sm[512 + kk] * w; a3 += sm[768 + kk] * w; a4 += sm[1024 + kk] * w;
  }
  float* red = sm + 5 * 256;
  red[(sub * 5 + 0) * 64 + (tid & 63)] = a0;
  red[(sub * 5 + 1) * 64 + (tid & 63)] = a1;
  red[(sub * 5 + 2) * 64 + (tid & 63)] = a2;
  red[(sub * 5 + 3) * 64 + (tid & 63)] = a3;
  red[(sub * 5 + 4) * 64 + (tid & 63)] = a4;
  __syncthreads();
  float* mod = (float*)(p.ws + OFF_MOD);
  for (int i = tid; i < 320; i += 256) {
    const int r = i >> 6, cc = i & 63;
    float sacc = red[(0 * 5 + r) * 64 + cc] + red[(1 * 5 + r) * 64 + cc] + red[(2 * 5 + r) * 64 + cc] + red[(3 * 5 + r) * 64 + cc];
    if (kq == 0) sacc += p.b_mod[cblk * 64 + cc];
    atomicAdd(mod + r * 6144 + cblk * 64 + cc, sacc);
  }
  __syncthreads();
}

DEV void transpose_tile(const float* __restrict__ src, int N, int K, u16* __restrict__ dst, int tile, float* sm) {
  const int tid = threadIdx.x;
  const int nkt = K >> 6;
  const int kt = tile % nkt, nt = tile / nkt;
  const int k0 = kt * 64, n0 = nt * 64;
  const int c4 = tid & 15, r = tid >> 4;
  float4 tv[4];
#pragma unroll
  for (int rr = 0; rr < 4; ++rr) tv[rr] = *(const float4*)(src + (size_t)(k0 + rr * 16 + r) * N + n0 + c4 * 4);
#pragma unroll
  for (int rr = 0; rr < 4; ++rr) {
    float* d0 = sm + (rr * 16 + r) * 65 + c4 * 4;
    d0[0] = tv[rr].x; d0[1] = tv[rr].y; d0[2] = tv[rr].z; d0[3] = tv[rr].w;
  }
  __syncthreads();
  const int nn = tid >> 2, part = tid & 3;
  unsigned w[8];
#pragma unroll
  for (int j = 0; j < 8; ++j) w[j] = pack2(sm[(part * 16 + 2 * j) * 65 + nn], sm[(part * 16 + 2 * j + 1) * 65 + nn]);
  uint4* d = (uint4*)(dst + (size_t)(n0 + nn) * K + k0 + part * 16);
  d[0] = make_uint4(w[0], w[1], w[2], w[3]);
  d[1] = make_uint4(w[4], w[5], w[6], w[7]);
  __syncthreads();
}

DEV void p0_hidden(const Params& p, int item, float* sm) {
  const int tid = threadIdx.x;
  float* z = sm;
  float* h1 = sm + 4 * 36;
  if (tid < 4 * 33) {
    int tt = tid / 33, i = tid % 33;
    int t = item * 4 + tt;
    float v;
    if (i == 0) v = (float)t * (1.f / 4096.f);
    else {
      int band = (i <= 16) ? i : (i - 16);
      float fr = (float)((t * band) & 4095) * (1.f / 4096.f);
      v = (i <= 16) ? cospif(2.f * fr) : sinpif(2.f * fr);
    }
    z[tt * 36 + i] = v;
  }
  __syncthreads();
  const int tt = tid >> 6, j = tid & 63;
  float a = p.hy_fb1[j];
  for (int i = 0; i < 33; ++i) a += z[tt * 36 + i] * p.hy_fw1[i * 64 + j];
  const float fq = p.hy_freq[j];
  h1[tt * 64 + j] = sinf(fq * a);
  __syncthreads();
  float b = p.hy_fb2[j];
  for (int i = 0; i < 64; ++i) b += h1[tt * 64 + i] * p.hy_fw2[i * 64 + j];
  ((u16*)(p.ws + OFF_H2F))[(item * 4 + tt) * 64 + j] = f2bf(sinf(fq * b));
  __syncthreads();
}

DEV void convert_flat(const float* __restrict__ src, u16* __restrict__ dst, size_t n) {
  size_t stride = (size_t)gridDim.x * 256 * 8;
  for (size_t i = ((size_t)blockIdx.x * 256 + threadIdx.x) * 8; i < n; i += stride) {
    float4 a = *(const float4*)(src + i);
    float4 b = *(const float4*)(src + i + 4);
    *(uint4*)(dst + i) = make_uint4(pack2(a.x, a.y), pack2(a.z, a.w), pack2(b.x, b.y), pack2(b.z, b.w));
  }
}

typedef __attribute__((ext_vector_type(2))) float f32x2;
DEV void convert_flat_fp8(const float* __restrict__ src, unsigned char* __restrict__ dst, size_t n, float scale) {
  const size_t q4 = (size_t)gridDim.x * 256 * 16;
  const size_t stride = q4 * 4;
  for (size_t i = ((size_t)blockIdx.x * 256 + threadIdx.x) * 16; i < n; i += stride) {
    float4 a[16];
#pragma unroll
    for (int c = 0; c < 4; ++c) {
      const size_t off = i + c * q4;
      if (off < n) {
#pragma unroll
        for (int q = 0; q < 4; ++q) a[c * 4 + q] = *(const float4*)(src + off + 4 * q);
      }
    }
#pragma unroll
    for (int c = 0; c < 4; ++c) {
      const size_t off = i + c * q4;
      if (off < n) {
        unsigned w[4];
#pragma unroll
        for (int q = 0; q < 4; ++q) {
          int v = 0;
          v = __builtin_amdgcn_cvt_pk_fp8_f32(a[c * 4 + q].x * scale, a[c * 4 + q].y * scale, v, false);
          v = __builtin_amdgcn_cvt_pk_fp8_f32(a[c * 4 + q].z * scale, a[c * 4 + q].w * scale, v, true);
          w[q] = (unsigned)v;
        }
        *(uint4*)(dst + off) = make_uint4(w[0], w[1], w[2], w[3]);
      }
    }
  }
}

DEV void norm_row(const float* __restrict__ xr, const float* __restrict__ g, const float* __restrict__ sh,
                  const float* __restrict__ sc, u16* __restrict__ dst, int lane) {
  float4 v[4];
  float ss = 0.f;
#pragma unroll
  for (int i = 0; i < 4; ++i) {
    v[i] = ((const float4*)xr)[lane + 64 * i];
    ss += v[i].x * v[i].x + v[i].y * v[i].y + v[i].z * v[i].z + v[i].w * v[i].w;
  }
  ss = wave_sum(ss);
  const float r = rsqrtf(ss * (1.f / 1024.f) + 1e-6f);
#pragma unroll
  for (int i = 0; i < 4; ++i) {
    const int idx = lane + 64 * i;
    float4 gg = ((const float4*)g)[idx], s1 = ((const float4*)sh)[idx], s2 = ((const float4*)sc)[idx];
    float y0 = v[i].x * r * gg.x * (1.f + s2.x) + s1.x;
    float y1 = v[i].y * r * gg.y * (1.f + s2.y) + s1.y;
    float y2 = v[i].z * r * gg.z * (1.f + s2.z) + s1.z;
    float y3 = v[i].w * r * gg.w * (1.f + s2.w) + s1.w;
    *(uint2*)(dst + idx * 4) = make_uint2(pack2(y0, y1), pack2(y2, y3));
  }
}

DEV void p1_filter(const Params& p, int item, float* sm) {
  const int tid = threadIdx.x;
  const int c0 = (item >> 2) * 4, tq = item & 3;
  float* wc = sm;
  float* red = sm + 512;
  for (int i = tid; i < 512; i += 256) {
    const int j = i >> 6, k = i & 63;
    wc[i] = p.hy_fw3[k * 1024 + ((j < 4) ? (c0 + j) : (512 + c0 + j - 4))];
  }
  __syncthreads();
  float fb[8], dl[4];
#pragma unroll
  for (int j = 0; j < 8; ++j) fb[j] = p.hy_fb3[(j < 4) ? (c0 + j) : (512 + c0 + j - 4)];
  const float da = logf(1e-2f) / 1.5f, db = logf(1e-2f) / 0.3f;
#pragma unroll
  for (int j = 0; j < 4; ++j) dl[j] = fabsf(da + (db - da) * (float)(c0 + j) / 511.f);
  u16* G = (u16*)((char*)p.out + OO_G);
  const float* H = (const float*)(p.ws + OFF_H2F);
  float as[4] = {0.f, 0.f, 0.f, 0.f};
#pragma unroll 1
  for (int i = 0; i < 4; ++i) {
    const int t = tq * 1024 + i * 256 + tid;
    const float4* hp = (const float4*)(H + t * 64);
    float d[8];
#pragma unroll
    for (int j = 0; j < 8; ++j) d[j] = fb[j];
#pragma unroll 1
    for (int q8 = 0; q8 < 16; q8 += 8) {
      float4 hv[8];
#pragma unroll
      for (int u = 0; u < 8; ++u) hv[u] = hp[q8 + u];
#pragma unroll
      for (int u = 0; u < 8; ++u)
#pragma unroll
        for (int j = 0; j < 8; ++j) {
          const float4 w = *(const float4*)(wc + j * 64 + 4 * (q8 + u));
          d[j] += hv[u].x * w.x + hv[u].y * w.y + hv[u].z * w.z + hv[u].w * w.w;
        }
    }
    const float tn = (float)t * (1.f / 4096.f);
#pragma unroll
    for (int j = 0; j < 4; ++j) {
      const float dec = expf(-tn * dl[j]);
      const float f = d[j] * dec, bw = d[4 + j] * dec;
      u16* Gc = G + (size_t)(c0 + j) * 8192;
      Gc[4095 - t] = f2bf(f);
      as[j] += fabsf(f);
      if (t < 4095) { Gc[4096 + t] = f2bf(bw); as[j] += fabsf(bw); }
      else Gc[8191] = 0;
    }
  }
#pragma unroll
  for (int j = 0; j < 4; ++j) {
    const float v = wave_sum(as[j]);
    if ((tid & 63) == 0) red[(tid >> 6) * 4 + j] = v;
  }
  __syncthreads();
  if (tid < 4) atomicAdd((float*)(p.ws + OFF_BAR + 20480) + c0 + tid, red[tid] + red[4 + tid] + red[8 + tid] + red[12 + tid]);
  __syncthreads();
}

struct Acc { f32x4 v[4][4]; };

DEV void acc_zero(Acc& a) {
#pragma unroll
  for (int i = 0; i < 4; ++i)
#pragma unroll
    for (int j = 0; j < 4; ++j) a.v[i][j] = (f32x4){0.f, 0.f, 0.f, 0.f};
}

#define LDSAS __attribute__((address_space(3)))
DEV void gemm_kloop(const u16* __restrict__ A, int lda, const u16* __restrict__ Bt, int ldb, int K, int m0, int n0,
                    u16* sA, u16* sB_unused, Acc& acc) {
  const int tid = threadIdx.x, lane = tid & 63, wave = tid >> 6, wm = wave >> 1, wn = wave & 1;
  const int l15 = lane & 15, quad = lane >> 4;
  const int rsw = (l15 >> 1) & 7;
  const int nk = K >> 6;
  const int prow = lane >> 3;
  const int pch = lane & 7;
  unsigned oA[4], oB[4];
#pragma unroll
  for (int i = 0; i < 4; ++i) {
    const int row = (wave * 4 + i) * 8 + prow;
    const int c = pch ^ ((row >> 1) & 7);
    oA[i] = (unsigned)(row * lda + c * 8) * 2u;
    oB[i] = (unsigned)(row * ldb + c * 8) * 2u;
  }
  const char* bA = (const char*)(A + (size_t)m0 * lda);
  const char* bB = (const char*)(Bt + (size_t)n0 * ldb);
  LDSAS char* lbase = (LDSAS char*)sA;
#define GEMM_DMA(KT, BUF)                                                                                   \
  _Pragma("unroll") for (int i = 0; i < 4; ++i) {                                                           \
    __builtin_amdgcn_global_load_lds((const unsigned*)(bA + (KT) * 128 + oA[i]), (LDSAS unsigned*)(lbase + (BUF) * 32768 + (wave * 4 + i) * 1024), 16, 0, 0);          \
    __builtin_amdgcn_global_load_lds((const unsigned*)(bB + (KT) * 128 + oB[i]), (LDSAS unsigned*)(lbase + (BUF) * 32768 + 16384 + (wave * 4 + i) * 1024), 16, 0, 0);  \
  }
  GEMM_DMA(0, 0)
  for (int kt = 0; kt < nk; ++kt) {
    asm volatile("s_waitcnt vmcnt(0)" ::: "memory");
    __syncthreads();
    const int buf = kt & 1;
    if (kt + 1 < nk) { GEMM_DMA(kt + 1, buf ^ 1) }
    const u16* tA = sA + buf * 16384;
    const u16* tB = tA + 8192;
    bf16x8 af[2][4], bfr[2][4];
#pragma unroll
    for (int ks = 0; ks < 2; ++ks) {
      const int cs = ((ks * 4 + quad) ^ rsw) * 8;
#pragma unroll
      for (int i = 0; i < 4; ++i) af[ks][i] = *(const bf16x8*)(tB + (wn * 64 + i * 16 + l15) * 64 + cs);
#pragma unroll
      for (int j = 0; j < 4; ++j) bfr[ks][j] = *(const bf16x8*)(tA + (wm * 64 + j * 16 + l15) * 64 + cs);
    }
    __builtin_amdgcn_s_setprio(1);
#pragma unroll
    for (int ks = 0; ks < 2; ++ks)
#pragma unroll
      for (int i = 0; i < 4; ++i)
#pragma unroll
        for (int j = 0; j < 4; ++j) acc.v[i][j] = __builtin_amdgcn_mfma_f32_16x16x32_bf16(af[ks][i], bfr[ks][j], acc.v[i][j], 0, 0, 0);
    __builtin_amdgcn_s_setprio(0);
  }
  __syncthreads();
}

DEV void p1_filter_tile(const Params& p, int tile, u16* sA, u16* sB) {
  const int mt = tile >> 3, nt = tile & 7;
  const int m0 = mt * 128, n0 = nt * 128;
  Acc acc; acc_zero(acc);
  gemm_kloop((const u16*)(p.ws + OFF_H2F), 64, (const u16*)(p.ws + OFF_H2F + 512 * 1024), 64, 64, m0, n0, sA, sB, acc);
  asm volatile("" ::: "memory");
  const int tid = threadIdx.x, lane = tid & 63, wave = tid >> 6, wm = wave >> 1, wn = wave & 1;
  const int l15 = lane & 15, quad = lane >> 4;
  const int mb = m0 + wm * 64, nbase = n0 + wn * 64;
  u16* G = (u16*)((char*)p.out + OO_G);
  float* nsum = (float*)(p.ws + OFF_BAR + 20480);
  const float da = logf(1e-2f) / 1.5f, db = logf(1e-2f) / 0.3f;
  const bool bwd = nbase >= 512;
#pragma unroll
  for (int i = 0; i < 4; ++i)
#pragma unroll
    for (int r = 0; r < 4; ++r) {
      const int col = nbase + i * 16 + quad * 4 + r;
      const int c = col & 511;
      const float fbv = p.hy_fb3[col];
      const float dlc = fabsf(da + (db - da) * (float)c / 511.f);
      u16* Gc = G + (size_t)c * 8192;
      float sum = 0.f;
#pragma unroll
      for (int j = 0; j < 4; ++j) {
        const int t = mb + j * 16 + l15;
        const float val = (acc.v[i][j][r] + fbv) * __expf(-(float)t * (1.f / 4096.f) * dlc);
        if (!bwd) { Gc[4095 - t] = f2bf(val); sum += fabsf(val); }
        else if (t < 4095) { Gc[4096 + t] = f2bf(val); sum += fabsf(val); }
        else Gc[8191] = 0;
      }
      sum = DPP_ADD(sum, 0xB1);
      sum = DPP_ADD(sum, 0x4E);
      sum = DPP_ADD(sum, 0x141);
      sum = DPP_ADD(sum, 0x140);
      if (l15 == 0) atomicAdd(nsum + c, sum);
    }
}

DEV void p2_inproj(const Params& p, int tile, u16* sA, u16* sB) {
  const int mt = tile / 34, nt = tile % 34;
  const int m0 = mt * 128, n0 = nt * 128;
  Acc acc; acc_zero(acc);
  gemm_kloop((const u16*)((const char*)p.out + OO_H1), 1024, (const u16*)(p.ws + OFF_WIN), 1024, 1024, m0, n0, sA, sB, acc);
  asm volatile("" ::: "memory");
  const int tid = threadIdx.x, lane = tid & 63, wave = tid >> 6, wm = wave >> 1, wn = wave & 1;
  int l15 = lane & 15, quad = lane >> 4;
  int mb = m0 + wm * 64, nb = n0 + wn * 64;
  asm volatile("" : "+v"(l15), "+v"(quad), "+v"(mb), "+v"(nb));
  mb = __builtin_amdgcn_readfirstlane(mb); nb = __builtin_amdgcn_readfirstlane(nb);
  if (nb < 640) {
    const float2* rope = (const float2*)(p.ws + OFF_ROPE);
    const bool isq = nb < 512;
    const float qs = isq ? (0.125f * 1.4426950408889634f) : 1.f;
#pragma unroll
    for (int j = 0; j < 4; ++j) {
      const int m = mb + j * 16 + l15;
      const int b = m >> 12, l = m & 4095;
      const int prow = l >> 6, pcol = l & 63;
      u16* dst;
      if (isq) dst = (u16*)(p.ws + OFF_Q) + ((size_t)(b * 8 + (nb >> 6)) * 4096 + l) * 64;
      else dst = (u16*)(p.ws + OFF_K) + ((size_t)(b * 2 + ((nb - 512) >> 6)) * 4096 + l) * 64;
#pragma unroll
      for (int hh = 0; hh < 2; ++hh) {
        const int pos = hh ? pcol : prow;
        f32x4 x1 = acc.v[hh * 2][j], x2 = acc.v[hh * 2 + 1][j];
        float o1[4], o2[4];
#pragma unroll
        for (int r = 0; r < 4; ++r) {
          float2 cs = rope[pos * 16 + quad * 4 + r];
          o1[r] = (x1[r] * cs.x - x2[r] * cs.y) * qs;
          o2[r] = (x2[r] * cs.x + x1[r] * cs.y) * qs;
        }
        *(uint2*)(dst + hh * 32 + quad * 4) = make_uint2(pack2(o1[0], o1[1]), pack2(o1[2], o1[3]));
        *(uint2*)(dst + hh * 32 + 16 + quad * 4) = make_uint2(pack2(o2[0], o2[1]), pack2(o2[2], o2[3]));
      }
    }
  } else if (nb < 768) {
    const int g = (nb - 640) >> 6;
    u16* vt = (u16*)(p.ws + OFF_VT);
#pragma unroll
    for (int j = 0; j < 4; ++j) {
      const int m = mb + j * 16 + l15;
      const int b = m >> 12, l = m & 4095;
#pragma unroll
      for (int i = 0; i < 4; ++i)
#pragma unroll
        for (int r = 0; r < 4; ++r) {
          const int d = i * 16 + quad * 4 + r;
          vt[((size_t)(b * 2 + g) * 64 + d) * 4096 + l] = f2bf(acc.v[i][j][r]);
        }
    }
  } else if (nb < 2304) {
    u16* z = (u16*)(p.ws + OFF_Z);
#pragma unroll
    for (int j = 0; j < 4; ++j) {
      const int m = mb + j * 16 + l15;
#pragma unroll
      for (int i = 0; i < 4; ++i) {
        const int n = nb - 768 + i * 16 + quad * 4;
        f32x4 a = acc.v[i][j];
        *(uint2*)(z + (size_t)m * 1536 + n) = make_uint2(pack2(a[0], a[1]), pack2(a[2], a[3]));
      }
    }
  } else {
    u16* gt = (u16*)(p.ws + OFF_GATE);
#pragma unroll
    for (int j = 0; j < 4; ++j) {
      const int m = mb + j * 16 + l15;
#pragma unroll
      for (int i = 0; i < 4; ++i) {
        const int n = nb - 2304 + i * 16 + quad * 4;
        f32x4 a = acc.v[i][j];
        float s0 = __builtin_amdgcn_rcpf(1.f + __expf(-a[0])), s1 = __builtin_amdgcn_rcpf(1.f + __expf(-a[1]));
        float s2 = __builtin_amdgcn_rcpf(1.f + __expf(-a[2])), s3 = __builtin_amdgcn_rcpf(1.f + __expf(-a[3]));
        *(uint2*)(gt + (size_t)m * 2048 + n) = make_uint2(pack2(s0, s1), pack2(s2, s3));
      }
    }
  }
}

DEV void p2_ctxkv(const Params& p, int tile, u16* sA, u16* sB) {
  const int mt = tile >> 1, nt = tile & 1;
  const int m0 = mt * 128, n0 = nt * 128;
  Acc acc; acc_zero(acc);
  gemm_kloop((const u16*)((const char*)p.out + OO_HC), 1024, (const u16*)(p.ws + OFF_WIN) + (size_t)512 * 1024, 1024, 1024, m0, n0, sA, sB, acc);
  const int tid = threadIdx.x, lane = tid & 63, wave = tid >> 6, wm = wave >> 1, wn = wave & 1;
  const int l15 = lane & 15, quad = lane >> 4;
  const int mb = m0 + wm * 64, nb = n0 + wn * 64;
  const int g = (nb >> 6) & 1;
  if (nb < 128) {
    u16* kc = (u16*)(p.ws + OFF_KC);
#pragma unroll
    for (int j = 0; j < 4; ++j) {
      const int m = mb + j * 16 + l15;
      const int b = m >> 8, c = m & 255;
#pragma unroll
      for (int i = 0; i < 4; ++i) {
        f32x4 a = acc.v[i][j];
        *(uint2*)(kc + ((size_t)(b * 2 + g) * 256 + c) * 64 + i * 16 + quad * 4) = make_uint2(pack2(a[0], a[1]), pack2(a[2], a[3]));
      }
    }
  } else {
    u16* vct = (u16*)(p.ws + OFF_VCT);
#pragma unroll
    for (int j = 0; j < 4; ++j) {
      const int m = mb + j * 16 + l15;
      const int b = m >> 8, c = m & 255;
#pragma unroll
      for (int i = 0; i < 4; ++i)
#pragma unroll
        for (int r = 0; r < 4; ++r) {
          const int d = i * 16 + quad * 4 + r;
          vct[((size_t)(b * 2 + g) * 64 + d) * 256 + c] = f2bf(acc.v[i][j][r]);
        }
    }
  }
}

DEV void p3_attn(const Params& p, int item, u16* sK, u16* sVt) {
  const int tid = threadIdx.x, lane = tid & 63, wave = tid >> 6, l15 = lane & 15, quad = lane >> 4;
  const int n = item & 31, h = (item >> 5) & 7, b = item >> 8;
  const int g = h >> 2;
  const u16* Q = (const u16*)(p.ws + OFF_Q) + ((size_t)(b * 8 + h) * 4096 + n * 128 + wave * 32) * 64;
  bf16x8 bq[2][2];
#pragma unroll
  for (int qt = 0; qt < 2; ++qt)
#pragma unroll
    for (int ks = 0; ks < 2; ++ks) bq[qt][ks] = *(const bf16x8*)(Q + (qt * 16 + l15) * 64 + ks * 32 + quad * 8);
  const float sink = p.attn_sink[h] * 1.4426950408889634f;
  float mrun[2] = {sink, sink};
  float lrun[2];
  lrun[0] = lrun[1] = (quad == 0) ? 1.f : 0.f;
  f32x4 O[4][2];
#pragma unroll
  for (int dt = 0; dt < 4; ++dt)
#pragma unroll
    for (int qt = 0; qt < 2; ++qt) O[dt][qt] = (f32x4){0.f, 0.f, 0.f, 0.f};

  u32x4 pk[4], pv[4];
#define ATT_LOAD(KB)                                                                                  \
  {                                                                                                   \
    const u16* Ksrc; const u16* Vsrc; int vstride;                                                    \
    if ((KB) < 3) {                                                                                   \
      const int nbk = n + (KB) - 1;                                                                   \
      Ksrc = (const u16*)(p.ws + OFF_K) + ((size_t)(b * 2 + g) * 4096 + nbk * 128) * 64;              \
      Vsrc = (const u16*)(p.ws + OFF_VT) + (size_t)(b * 2 + g) * 64 * 4096 + nbk * 128;               \
      vstride = 4096;                                                                                 \
    } else {                                                                                          \
      const int cb = (KB) - 3;                                                                        \
      Ksrc = (const u16*)(p.ws + OFF_KC) + ((size_t)(b * 2 + g) * 256 + cb * 128) * 64;               \
      Vsrc = (const u16*)(p.ws + OFF_VCT) + (size_t)(b * 2 + g) * 64 * 256 + cb * 128;                \
      vstride = 256;                                                                                  \
    }                                                                                                 \
    _Pragma("unroll") for (int i = 0; i < 4; ++i) {                                                   \
      const int id = tid + i * 256;                                                                   \
      pk[i] = *(const u32x4*)(Ksrc + (id >> 3) * 64 + (id & 7) * 8);                                  \
      pv[i] = *(const u32x4*)(Vsrc + (size_t)(id >> 4) * vstride + (id & 15) * 8);                    \
    }                                                                                                 \
  }
  int kb = (n == 0) ? 1 : 0;
  ATT_LOAD(kb)
  while (kb < 5) {
#pragma unroll
    for (int i = 0; i < 4; ++i) {
      const int id = tid + i * 256;
      *(u32x4*)(sK + (id >> 3) * 72 + (id & 7) * 8) = pk[i];
      *(u32x4*)(sVt + (id >> 4) * 136 + (id & 15) * 8) = pv[i];
    }
    __syncthreads();
    int nx = kb + 1;
    if (nx == 2 && n == 31) nx = 3;
    if (nx < 5) ATT_LOAD(nx)
#pragma unroll 1
    for (int c4 = 0; c4 < 4; ++c4) {
      f32x4 s[2][2];
#pragma unroll
      for (int kt = 0; kt < 2; ++kt) {
        bf16x8 ak0 = *(const bf16x8*)(sK + (c4 * 32 + kt * 16 + l15) * 72 + quad * 8);
        bf16x8 ak1 = *(const bf16x8*)(sK + (c4 * 32 + kt * 16 + l15) * 72 + 32 + quad * 8);
#pragma unroll
        for (int qt = 0; qt < 2; ++qt) {
          f32x4 z = (f32x4){0.f, 0.f, 0.f, 0.f};
          z = __builtin_amdgcn_mfma_f32_16x16x32_bf16(ak0, bq[qt][0], z, 0, 0, 0);
          z = __builtin_amdgcn_mfma_f32_16x16x32_bf16(ak1, bq[qt][1], z, 0, 0, 0);
          s[kt][qt] = z;
        }
      }
      if (kb == 0 || kb == 2) {
#pragma unroll
        for (int kt = 0; kt < 2; ++kt)
#pragma unroll
          for (int qt = 0; qt < 2; ++qt)
#pragma unroll
            for (int r = 0; r < 4; ++r) {
              const int kk = c4 * 32 + kt * 16 + quad * 4 + r;
              const int qq = wave * 32 + qt * 16 + l15;
              const bool valid = (kb == 0) ? (kk >= qq) : (kk <= qq);
              if (!valid) s[kt][qt][r] = -INFINITY;
            }
      }
      bf16x8 bp[2];
#pragma unroll
      for (int qt = 0; qt < 2; ++qt) {
        float cm = fmaxf(fmaxf(fmaxf(s[0][qt][0], s[0][qt][1]), fmaxf(s[0][qt][2], s[0][qt][3])),
                         fmaxf(fmaxf(s[1][qt][0], s[1][qt][1]), fmaxf(s[1][qt][2], s[1][qt][3])));
        cm = fmaxf(cm, __shfl_xor(cm, 16));
        cm = fmaxf(cm, __shfl_xor(cm, 32));
        const float mnew = fmaxf(mrun[qt], cm);
        const float alpha = __builtin_amdgcn_exp2f(mrun[qt] - mnew);
        mrun[qt] = mnew;
        float ps = 0.f;
        float pv[8];
#pragma unroll
        for (int r = 0; r < 4; ++r) {
          pv[r] = __builtin_amdgcn_exp2f(s[0][qt][r] - mnew);
          pv[4 + r] = __builtin_amdgcn_exp2f(s[1][qt][r] - mnew);
          ps += pv[r] + pv[4 + r];
        }
        lrun[qt] = lrun[qt] * alpha + ps;
#pragma unroll
        for (int dt = 0; dt < 4; ++dt) {
          O[dt][qt][0] *= alpha; O[dt][qt][1] *= alpha; O[dt][qt][2] *= alpha; O[dt][qt][3] *= alpha;
        }
        union { bf16x8 v; unsigned u[4]; } pk;
        pk.u[0] = pack2(pv[0], pv[1]); pk.u[1] = pack2(pv[2], pv[3]);
        pk.u[2] = pack2(pv[4], pv[5]); pk.u[3] = pack2(pv[6], pv[7]);
        bp[qt] = pk.v;
      }
#pragma unroll
      for (int dt = 0; dt < 4; ++dt) {
        union { bf16x8 v; uint2 h[2]; } av;
        const u16* vrow = sVt + (dt * 16 + l15) * 136 + c4 * 32 + quad * 4;
        av.h[0] = *(const uint2*)(vrow);
        av.h[1] = *(const uint2*)(vrow + 16);
#pragma unroll
        for (int qt = 0; qt < 2; ++qt) O[dt][qt] = __builtin_amdgcn_mfma_f32_16x16x32_bf16(av.v, bp[qt], O[dt][qt], 0, 0, 0);
      }
    }
    __syncthreads();
    kb = nx;
  }
  u16* Y = (u16*)(p.ws + OFF_YATT);
#pragma unroll
  for (int qt = 0; qt < 2; ++qt) {
    float l = lrun[qt];
    l += __shfl_xor(l, 16);
    l += __shfl_xor(l, 32);
    const float inv = __builtin_amdgcn_rcpf(l);
    const int t = b * 4096 + n * 128 + wave * 32 + qt * 16 + l15;
#pragma unroll
    for (int dt = 0; dt < 4; ++dt) {
      f32x4 o = O[dt][qt];
      *(uint2*)(Y + (size_t)t * 512 + h * 64 + dt * 16 + quad * 4) = make_uint2(pack2(o[0] * inv, o[1] * inv), pack2(o[2] * inv, o[3] * inv));
    }
  }
}

DEV void p3_hypre(const Params& p, int item, u16* sm) {
  const int tid = threadIdx.x;
  const int cb = item & 3, tb = (item >> 2) & 63, b = item >> 8;
  const int tq = tid >> 6, ch2 = tid & 63;
  const int c = cb * 128 + ch2 * 2;
  u16* su = sm;
  u16* sx = sm + 128 * 66;
  float w[3][3][2], bias[3][2];
#pragma unroll
  for (int s = 0; s < 3; ++s) {
#pragma unroll
    for (int k = 0; k < 3; ++k) {
      const float2 wv = *(const float2*)(p.hy_conv_w + k * 1536 + s * 512 + c);
      w[s][k][0] = wv.x; w[s][k][1] = wv.y;
    }
    const float2 bv = *(const float2*)(p.hy_conv_b + s * 512 + c);
    bias[s][0] = bv.x; bias[s][1] = bv.y;
  }
  const u16* Z = (const u16*)(p.ws + OFF_Z) + (size_t)b * 4096 * 1536;
  const int l0 = tb * 64 + tq * 16;
  unsigned zr[18][3];
#pragma unroll
  for (int i = 0; i < 18; ++i) {
    const int l = l0 - 1 + i;
    const bool ok = (l >= 0) && (l < 4096);
    const int lc = ok ? l : l0;
#pragma unroll
    for (int s2 = 0; s2 < 3; ++s2) {
      const unsigned v = *(const unsigned*)(Z + (size_t)lc * 1536 + s2 * 512 + c);
      zr[i][s2] = ok ? v : 0u;
    }
  }
#pragma unroll
  for (int i = 0; i < 16; ++i) {
    float cv0[3], cv1[3];
#pragma unroll
    for (int s2 = 0; s2 < 3; ++s2) {
      cv0[s2] = bflo(zr[i][s2]) * w[s2][0][0] + bflo(zr[i + 1][s2]) * w[s2][1][0] + bflo(zr[i + 2][s2]) * w[s2][2][0] + bias[s2][0];
      cv1[s2] = bfhi(zr[i][s2]) * w[s2][0][1] + bfhi(zr[i + 1][s2]) * w[s2][1][1] + bfhi(zr[i + 2][s2]) * w[s2][2][1] + bias[s2][1];
    }
    su[(ch2 * 2) * 66 + tq * 16 + i] = f2bf(cv0[2] * cv0[1]);
    su[(ch2 * 2 + 1) * 66 + tq * 16 + i] = f2bf(cv1[2] * cv1[1]);
    sx[(ch2 * 2) * 66 + tq * 16 + i] = f2bf(cv0[0]);
    sx[(ch2 * 2 + 1) * 66 + tq * 16 + i] = f2bf(cv1[0]);
  }
  __syncthreads();
  const int chr = tid >> 1, part = tid & 1;
  const int cc = cb * 128 + chr;
  const unsigned* ru = (const unsigned*)(su + chr * 66 + part * 32);
  const unsigned* rx = (const unsigned*)(sx + chr * 66 + part * 32);
  u16* UT = (u16*)((char*)p.out + OO_UT) + ((size_t)(cc * 4 + b) * 4096 + tb * 64 + part * 32);
  u16* XT = (u16*)((char*)p.out + OO_X0T) + ((size_t)(cc * 4 + b) * 4096 + tb * 64 + part * 32);
#pragma unroll
  for (int q = 0; q < 4; ++q) {
    ((uint4*)UT)[q] = make_uint4(ru[4 * q], ru[4 * q + 1], ru[4 * q + 2], ru[4 * q + 3]);
    ((uint4*)XT)[q] = make_uint4(rx[4 * q], rx[4 * q + 1], rx[4 * q + 2], rx[4 * q + 3]);
  }
  __syncthreads();
}

DEV void p3_toeplitz(const Params& p, int c, char* smem) {
  const int tid = threadIdx.x, lane = tid & 63, wave = tid >> 6, l15 = lane & 15, quad = lane >> 4;
  u16* sG0 = (u16*)smem;
  u16* sG1 = (u16*)(smem + 16384 + 64);
  u16* sU = (u16*)(smem + 32768 + 128);
  u16* sZ = sU + 4 * 64 * 72;
  const u16* G = (const u16*)((const char*)p.out + OO_G) + (size_t)c * 8192;
  const u16* UT = (const u16*)((const char*)p.out + OO_UT) + (size_t)c * 16384;
#pragma unroll
  for (int i = 0; i < 4; ++i) {
    const int id = tid + i * 256;
    *(uint4*)(sG0 + id * 8) = *(const uint4*)(G + id * 8);
  }
#pragma unroll
  for (int i = 0; i < 8; ++i) {
    const int id = tid + i * 256;
    const int bb = id >> 9, blk = (id >> 3) & 63, c8 = id & 7;
    *(uint4*)(sU + (bb * 64 + blk) * 72 + c8 * 8) = *(const uint4*)(UT + id * 8);
  }
  if (tid < 72) sZ[tid] = 0;
  __syncthreads();
  for (int i = tid; i < 8192; i += 256) sG1[i] = (i < 8191) ? sG0[i + 1] : (u16)0;
  __syncthreads();

  Acc acc; acc_zero(acc);
  const u16* gbase = (l15 & 1) ? sG0 : (sG1 - 1);
  const u16* ubase = sU + wave * 64 * 72 + quad * 8;
  const u16* zbase = sZ + quad * 8;
#define TOEP_LOADA(AF, D)                                                                 \
  {                                                                                       \
    const int base_ = 4095 - 64 * (D) - l15 + quad * 8;                                   \
    _Pragma("unroll") for (int mt = 0; mt < 4; ++mt)                                      \
      _Pragma("unroll") for (int ks = 0; ks < 2; ++ks) {                                  \
        const unsigned* gp = (const unsigned*)(gbase + base_ - mt * 16 + ks * 32);        \
        union { bf16x8 v; unsigned u[4]; } t_;                                            \
        t_.u[0] = gp[0]; t_.u[1] = gp[1]; t_.u[2] = gp[2]; t_.u[3] = gp[3];               \
        AF[mt][ks] = t_.v;                                                                \
      }                                                                                   \
  }
#define TOEP_MMA(AF, D)                                                                   \
  _Pragma("unroll") for (int nt = 0; nt < 4; ++nt) {                                      \
    if (!(nt * 16 + 15 - (D) < 0 || nt * 16 - (D) > 63)) {                                \
      const int ip = nt * 16 + l15 - (D);                                                 \
      const u16* up = (ip >= 0 && ip < 64) ? (ubase + ip * 72) : zbase;                   \
      bf16x8 b0 = *(const bf16x8*)(up);                                                   \
      bf16x8 b1 = *(const bf16x8*)(up + 32);                                              \
      _Pragma("unroll") for (int mt = 0; mt < 4; ++mt) {                                  \
        acc.v[mt][nt] = __builtin_amdgcn_mfma_f32_16x16x32_bf16(AF[mt][0], b0, acc.v[mt][nt], 0, 0, 0); \
        acc.v[mt][nt] = __builtin_amdgcn_mfma_f32_16x16x32_bf16(AF[mt][1], b1, acc.v[mt][nt], 0, 0, 0); \
      }                                                                                   \
    }                                                                                     \
  }
  {
    bf16x8 afA[4][2], afB[4][2];
    TOEP_LOADA(afA, -63)
#pragma unroll 1
    for (int d = -63; d <= 63; d += 2) {
      if (d + 1 <= 63) TOEP_LOADA(afB, d + 1)
      TOEP_MMA(afA, d)
      if (d + 1 <= 63) {
        if (d + 2 <= 63) TOEP_LOADA(afA, d + 2)
        TOEP_MMA(afB, d + 1)
      }
    }
  }
  const float ninv = 1.f / ((const float*)(p.ws + OFF_BAR + 20480))[c];
  const float skip = p.hy_skip[c];
  const u16* XT = (const u16*)((const char*)p.out + OO_X0T) + ((size_t)(c * 4 + wave) * 4096);
  u16* Y = (u16*)(p.ws + OFF_YHY);
#pragma unroll
  for (int nt = 0; nt < 4; ++nt) {
    const int ib = nt * 16 + l15;
#pragma unroll
    for (int mt = 0; mt < 4; ++mt) {
      const int r0 = mt * 16 + quad * 4;
      const int t = ib * 64 + r0;
      uint2 uu = *(const uint2*)(sU + (wave * 64 + ib) * 72 + r0);
      uint2 xx = *(const uint2*)(XT + t);
      float uv[4] = {bflo(uu.x), bfhi(uu.x), bflo(uu.y), bfhi(uu.y)};
      float xv[4] = {bflo(xx.x), bfhi(xx.x), bflo(xx.y), bfhi(xx.y)};
#pragma unroll
      for (int r = 0; r < 4; ++r) {
        float y = acc.v[mt][nt][r] * ninv + uv[r] * skip;
        Y[(size_t)(wave * 4096 + t + r) * 512 + c] = f2bf(y * xv[r]);
      }
    }
  }
  __syncthreads();
}

DEV void p4_merge(const Params& p, int tile, u16* sA, u16* sB) {
  const int mt = tile >> 3, nt = tile & 7;
  const int m0 = mt * 128, n0 = nt * 128;
  const int tid = threadIdx.x, lane = tid & 63, wave = tid >> 6, wm = wave >> 1, wn = wave & 1;
  const int l15 = lane & 15, quad = lane >> 4;
  const int mb = m0 + wm * 64, nb = n0 + wn * 64;
  const u16* gt = (const u16*)(p.ws + OFF_GATE);
  u16* mg = (u16*)(p.ws + OFF_MERGED);
  Acc a1; acc_zero(a1);
  gemm_kloop((const u16*)(p.ws + OFF_YATT), 512, (const u16*)(p.ws + OFF_WOA), 512, 512, m0, n0, sA, sB, a1);
  asm volatile("" ::: "memory");
#pragma unroll
  for (int j = 0; j < 4; ++j) {
    const int m = mb + j * 16 + l15;
#pragma unroll
    for (int i = 0; i < 4; ++i) {
      const int n = nb + i * 16 + quad * 4;
      uint2 ga = *(const uint2*)(gt + (size_t)m * 2048 + n);
      f32x4 x = a1.v[i][j];
      *(uint2*)(mg + (size_t)m * 1024 + n) = make_uint2(pack2(bflo(ga.x) * x[0], bfhi(ga.x) * x[1]), pack2(bflo(ga.y) * x[2], bfhi(ga.y) * x[3]));
    }
  }
  asm volatile("" ::: "memory");
  acc_zero(a1);
  gemm_kloop((const u16*)(p.ws + OFF_YHY), 512, (const u16*)(p.ws + OFF_WOH), 512, 512, m0, n0, sA, sB, a1);
  asm volatile("" ::: "memory");
#pragma unroll
  for (int j = 0; j < 4; ++j) {
    const int m = mb + j * 16 + l15;
#pragma unroll
    for (int i = 0; i < 4; ++i) {
      const int n = nb + i * 16 + quad * 4;
      uint2 gh = *(const uint2*)(gt + (size_t)m * 2048 + 1024 + n);
      uint2 pv = *(const uint2*)(mg + (size_t)m * 1024 + n);
      f32x4 y = a1.v[i][j];
      float o0 = bflo(pv.x) + bflo(gh.x) * y[0];
      float o1 = bfhi(pv.x) + bfhi(gh.x) * y[1];
      float o2 = bflo(pv.y) + bflo(gh.y) * y[2];
      float o3 = bfhi(pv.y) + bfhi(gh.y) * y[3];
      *(uint2*)(mg + (size_t)m * 1024 + n) = make_uint2(pack2(o0, o1), pack2(o2, o3));
    }
  }
}

DEV void p5_out(const Params& p, int tile, u16* sA, u16* sB) {
  const int mt = tile >> 3, nt = tile & 7;
  const int m0 = mt * 128, n0 = nt * 128;
  Acc acc; acc_zero(acc);
  gemm_kloop((const u16*)(p.ws + OFF_MERGED), 1024, (const u16*)(p.ws + OFF_WOUT), 1024, 1024, m0, n0, sA, sB, acc);
  const int tid = threadIdx.x, lane = tid & 63, wave = tid >> 6, wm = wave >> 1, wn = wave & 1;
  const int l15 = lane & 15, quad = lane >> 4;
  const int mb = m0 + wm * 64, nb = n0 + wn * 64;
  const float* mod = (const float*)(p.ws + OFF_MOD);
#pragma unroll
  for (int j = 0; j < 4; ++j) {
    const int m = mb + j * 16 + l15;
    const int b = m >> 12;
#pragma unroll
    for (int i = 0; i < 4; ++i) {
      const int n = nb + i * 16 + quad * 4;
      float4 g1 = *(const float4*)(mod + b * 6144 + 2048 + n);
      float4 xv = *(const float4*)(p.x + (size_t)m * 1024 + n);
      f32x4 a = acc.v[i][j];
      float4 o = make_float4(xv.x + g1.x * a[0], xv.y + g1.y * a[1], xv.z + g1.z * a[2], xv.w + g1.w * a[3]);
      *(float4*)(p.out + (size_t)m * 1024 + n) = o;
    }
  }
}

DEV void p7_qp(const Params& p, int tile, u16* sA, u16* sB) {
  const int mt = tile >> 3, nt = tile & 7;
  const int m0 = mt * 128, n0 = nt * 128;
  Acc acc; acc_zero(acc);
  gemm_kloop((const u16*)(p.ws + OFF_H2), 1024, (const u16*)(p.ws + OFF_WQ), 1024, 1024, m0, n0, sA, sB, acc);
  const int tid = threadIdx.x, lane = tid & 63, wave = tid >> 6, wm = wave >> 1, wn = wave & 1;
  const int l15 = lane & 15, quad = lane >> 4;
  const int mb = m0 + wm * 64, nb = n0 + wn * 64;
  u16* qp = (u16*)(p.ws + OFF_QP);
#pragma unroll
  for (int j = 0; j < 4; ++j) {
    const int m = mb + j * 16 + l15;
#pragma unroll
    for (int i = 0; i < 4; ++i) {
      const int n = nb + i * 16 + quad * 4;
      f32x4 a = acc.v[i][j];
      *(uint2*)(qp + (size_t)m * 1024 + n) = make_uint2(pack2(a[0], a[1]), pack2(a[2], a[3]));
    }
  }
}

DEV unsigned f2ord(float f) {
  const unsigned u = __float_as_uint(f);
  return u ^ (((int)u >> 31) | 0x80000000u);
}
DEV float ord2f(unsigned k) {
  const unsigned m = (k & 0x80000000u) ? 0x80000000u : 0xffffffffu;
  return __uint_as_float(k ^ m);
}
DEV unsigned umax_(unsigned a, unsigned b) { return a > b ? a : b; }
DEV unsigned umin_(unsigned a, unsigned b) { return a < b ? a : b; }

DEV void sort16_desc(unsigned (&v)[16]) {
#pragma unroll
  for (int k = 2; k <= 16; k <<= 1)
#pragma unroll
    for (int j = k >> 1; j > 0; j >>= 1)
#pragma unroll
      for (int i = 0; i < 16; ++i) {
        const int l = i ^ j;
        if (l > i) {
          const bool desc = ((i & k) == 0);
          const unsigned a = v[i], b = v[l];
          const unsigned hi = umax_(a, b), lo = umin_(a, b);
          v[i] = desc ? hi : lo;
          v[l] = desc ? lo : hi;
        }
      }
}
DEV void merge16_desc(unsigned (&v)[16]) {
#pragma unroll
  for (int j = 8; j > 0; j >>= 1)
#pragma unroll
    for (int i = 0; i < 16; ++i) {
      const int l = i ^ j;
      if (l > i) {
        const unsigned a = v[i], b = v[l];
        v[i] = umax_(a, b);
        v[l] = umin_(a, b);
      }
    }
}
DEV void xmerge16(unsigned (&v)[16], int off) {
  unsigned pr[16];
#pragma unroll
  for (int i = 0; i < 16; ++i) pr[i] = (unsigned)__shfl_xor((int)v[i], off);
#pragma unroll
  for (int i = 0; i < 16; ++i) v[i] = umax_(v[i], pr[15 - i]);
  merge16_desc(v);
}

DEV void route_top16_of_128(const u16* __restrict__ keys, const u16* __restrict__ qp, int l15, int quad, unsigned (&out)[16]) {
  bf16x8 b0 = *(const bf16x8*)(qp);
  bf16x8 b1 = *(const bf16x8*)(qp + 32);
  unsigned ka[16], kb[16];
#pragma unroll
  for (int kt = 0; kt < 8; ++kt) {
    bf16x8 a0 = *(const bf16x8*)(keys + (kt * 16 + l15) * 64 + quad * 8);
    bf16x8 a1 = *(const bf16x8*)(keys + (kt * 16 + l15) * 64 + 32 + quad * 8);
    f32x4 z = (f32x4){0.f, 0.f, 0.f, 0.f};
    z = __builtin_amdgcn_mfma_f32_16x16x32_bf16(a0, b0, z, 0, 0, 0);
    z = __builtin_amdgcn_mfma_f32_16x16x32_bf16(a1, b1, z, 0, 0, 0);
#pragma unroll
    for (int r = 0; r < 4; ++r) {
      const unsigned key = (f2ord(z[r]) & ~127u) | (unsigned)(kt * 16 + quad * 4 + r);
      if (kt < 4) ka[kt * 4 + r] = key; else kb[(kt - 4) * 4 + r] = key;
    }
  }
  sort16_desc(ka);
  sort16_desc(kb);
#pragma unroll
  for (int i = 0; i < 16; ++i) out[i] = umax_(ka[i], kb[15 - i]);
  merge16_desc(out);
  xmerge16(out, 16);
  xmerge16(out, 32);
}

__device__ const unsigned char kTabG[52] = {
    0x00, 0x01, 0x02, 0x03, 0x04, 0x05, 0x06, 0x07, 0x08, 0x09, 0x0A, 0x0B, 0x0C, 0x0D, 0x0E, 0x0F,
    0x10, 0x11, 0x12, 0x13, 0x14, 0x15, 0x16, 0x17, 0x20, 0x21, 0x22, 0x23, 0x24, 0x30, 0x31, 0x32, 0x33,
    0x40, 0x41, 0x42, 0x50, 0x51, 0x60, 0x61, 0x70, 0x71, 0x80, 0x90, 0xA0, 0xB0, 0xC0, 0xD0, 0xE0, 0xF0, 0x00, 0x00};

DEV void p8_route(const Params& p, int task, char* wsm, const unsigned char* kTab) {
  const int lane = threadIdx.x & 63, l15 = lane & 15, quad = lane >> 4;
  const int h = task & 7, tt = task >> 3;
  const int t0 = tt * 16;
  float* s1v = (float*)wsm;
  float* s2v = s1v + 256;
  int* i1 = (int*)(s2v + 256);
  int* i2 = i1 + 256;
  const u16* keys = (const u16*)(p.ws + OFF_KEYS) + (size_t)(h * 2) * 128 * 64;
  const u16* qp = (const u16*)(p.ws + OFF_QP) + (size_t)(t0 + l15) * 1024 + h * 128 + quad * 8;
  unsigned l1[16], l2[16];
  route_top16_of_128(keys, qp, l15, quad, l1);
  route_top16_of_128(keys + 128 * 64, qp + 64, l15, quad, l2);
  if (quad == 0) {
#pragma unroll
    for (int i = 0; i < 16; ++i) { s1v[l15 * 16 + i] = ord2f(l1[i] & ~127u); i1[l15 * 16 + i] = (int)(l1[i] & 127u); }
  } else if (quad == 1) {
#pragma unroll
    for (int i = 0; i < 16; ++i) { s2v[l15 * 16 + i] = ord2f(l2[i] & ~127u); i2[l15 * 16 + i] = (int)(l2[i] & 127u); }
  }
  __builtin_amdgcn_fence(__ATOMIC_RELEASE, "wavefront");
  __builtin_amdgcn_wave_barrier();
  __builtin_amdgcn_fence(__ATOMIC_ACQUIRE, "wavefront");
  unsigned ck[16];
#pragma unroll
  for (int s = 0; s < 16; ++s) {
    const int c = quad + 4 * s;
    unsigned key = 0u;
    if (s < 13 && c < 50) {
      const unsigned ab = kTab[c];
      const float val = s1v[l15 * 16 + (ab >> 4)] + s2v[l15 * 16 + (ab & 15)];
      key = (f2ord(val) & ~255u) | ab;
    }
    ck[s] = key;
  }
  sort16_desc(ck);
  xmerge16(ck, 16);
  xmerge16(ck, 32);
  if (quad == 0) {
    float e[16];
    const float vmax = ord2f(ck[0] & ~255u);
    float ssum = 0.f;
#pragma unroll
    for (int i = 0; i < 16; ++i) { e[i] = __expf(ord2f(ck[i] & ~255u) - vmax); ssum += e[i]; }
    const float inv = __builtin_amdgcn_rcpf(ssum);
    int* ridx = (int*)(p.ws + OFF_RIDX) + (size_t)(t0 + l15) * 128 + h * 16;
    float* rw = (float*)(p.ws + OFF_RW) + (size_t)(t0 + l15) * 128 + h * 16;
#pragma unroll
    for (int i = 0; i < 16; i += 4) {
      int ee[4]; float ww[4];
#pragma unroll
      for (int j = 0; j < 4; ++j) {
        const unsigned ab = ck[i + j] & 255u;
        ee[j] = i1[l15 * 16 + (ab >> 4)] * 128 + i2[l15 * 16 + (ab & 15)];
        ww[j] = e[i + j] * inv;
      }
      *(int4*)(ridx + i) = make_int4(ee[0], ee[1], ee[2], ee[3]);
      *(float4*)(rw + i) = make_float4(ww[0], ww[1], ww[2], ww[3]);
    }
  }
  __builtin_amdgcn_fence(__ATOMIC_RELEASE, "wavefront");
  __builtin_amdgcn_wave_barrier();
}

DEV float gelu_tanh(float x) {
  const float u2 = 1.5957691216057308f * (x + 0.044715f * x * x * x);
  return x * __builtin_amdgcn_rcpf(1.f + __expf(-u2));
}

DEV void unpack8(const uint4& q, float* f) {
  f[0] = bflo(q.x); f[1] = bfhi(q.x); f[2] = bflo(q.y); f[3] = bfhi(q.y);
  f[4] = bflo(q.z); f[5] = bfhi(q.z); f[6] = bflo(q.w); f[7] = bfhi(q.w);
}

DEV float dpp_add(float v, const int ctrl_sel) {
  return v;
}
typedef __attribute__((ext_vector_type(2))) __bf16 bf2_t;
DEV float dot2bf(unsigned a, unsigned b, float c) {
  return __builtin_amdgcn_fdot2_f32_bf16(__builtin_bit_cast(bf2_t, a), __builtin_bit_cast(bf2_t, b), c, false);
}

DEV float reduce4_rows(float d0, float d1, float d2, float d3, int lane) {
  const bool up32 = (lane & 32) != 0, up16 = (lane & 16) != 0;
  float k0 = up32 ? d2 : d0, k1 = up32 ? d3 : d1;
  const float s0 = up32 ? d0 : d2, s1 = up32 ? d1 : d3;
  k0 += __shfl_xor(s0, 32);
  k1 += __shfl_xor(s1, 32);
  float kq = up16 ? k1 : k0;
  const float sq = up16 ? k0 : k1;
  kq += __shfl_xor(sq, 16);
  kq = DPP_ADD(kq, 0xB1);
  kq = DPP_ADD(kq, 0x4E);
  kq = DPP_ADD(kq, 0x141);
  kq = DPP_ADD(kq, 0x140);
  return kq;
}

DEV void p9_token(const Params& p, int t, int tnext, int lane, int2& e2n, float2& w2n, u32x4& han, u32x4& hbn) {
  const unsigned char* U8 = (const unsigned char*)(p.ws + OFF_UBF);
  const unsigned char* V8 = (const unsigned char*)(p.ws + OFF_VBF);
  const int2 e2 = e2n;
  const float2 w2 = w2n;
  const u32x4 ha = han, hb = hbn;
  {
    e2n = *(const int2*)((const int*)(p.ws + OFF_RIDX) + (size_t)tnext * 128 + 2 * lane);
    w2n = *(const float2*)((const float*)(p.ws + OFF_RW) + (size_t)tnext * 128 + 2 * lane);
    const u16* h2 = (const u16*)(p.ws + OFF_H2) + (size_t)tnext * 1024 + 16 * lane;
    han = *(const u32x4*)(h2);
    hbn = *(const u32x4*)(h2 + 8);
  }
  float hf[16];
  hf[0] = bflo(ha.x); hf[1] = bfhi(ha.x); hf[2] = bflo(ha.y); hf[3] = bfhi(ha.y);
  hf[4] = bflo(ha.z); hf[5] = bfhi(ha.z); hf[6] = bflo(ha.w); hf[7] = bfhi(ha.w);
  hf[8] = bflo(hb.x); hf[9] = bfhi(hb.x); hf[10] = bflo(hb.y); hf[11] = bfhi(hb.y);
  hf[12] = bflo(hb.z); hf[13] = bfhi(hb.z); hf[14] = bflo(hb.w); hf[15] = bfhi(hb.w);
  float o[16];
#pragma unroll
  for (int k = 0; k < 16; ++k) o[k] = 0.f;
#pragma unroll 1
  for (int g = 0; g < 128; g += 16) {
    u32x4 uu[16], vv[16];
    float wj[16];
#pragma unroll
    for (int j = 0; j < 16; ++j) {
      const int src = (g >> 1) + (j >> 1);
      const int ej = (j & 1) ? __builtin_amdgcn_readlane(e2.y, src) : __builtin_amdgcn_readlane(e2.x, src);
      wj[j] = __builtin_bit_cast(float, (j & 1) ? __builtin_amdgcn_readlane(__builtin_bit_cast(int, w2.y), src)
                                                : __builtin_amdgcn_readlane(__builtin_bit_cast(int, w2.x), src));
      const size_t ro = (size_t)ej * 1024 + 16 * lane;
      uu[j] = *(const u32x4*)(U8 + ro);
      vv[j] = *(const u32x4*)(V8 + ro);
    }
    float d[16];
#pragma unroll
    for (int j = 0; j < 16; ++j) {
      const f32x2 l0 = __builtin_amdgcn_cvt_pk_f32_fp8((int)uu[j].x, false), h0 = __builtin_amdgcn_cvt_pk_f32_fp8((int)uu[j].x, true);
      const f32x2 l1 = __builtin_amdgcn_cvt_pk_f32_fp8((int)uu[j].y, false), h1 = __builtin_amdgcn_cvt_pk_f32_fp8((int)uu[j].y, true);
      const f32x2 l2 = __builtin_amdgcn_cvt_pk_f32_fp8((int)uu[j].z, false), h2v = __builtin_amdgcn_cvt_pk_f32_fp8((int)uu[j].z, true);
      const f32x2 l3 = __builtin_amdgcn_cvt_pk_f32_fp8((int)uu[j].w, false), h3 = __builtin_amdgcn_cvt_pk_f32_fp8((int)uu[j].w, true);
      float a0 = l0.x * hf[0] + l0.y * hf[1], a1 = h0.x * hf[2] + h0.y * hf[3];
      a0 += l1.x * hf[4] + l1.y * hf[5]; a1 += h1.x * hf[6] + h1.y * hf[7];
      a0 += l2.x * hf[8] + l2.y * hf[9]; a1 += h2v.x * hf[10] + h2v.y * hf[11];
      a0 += l3.x * hf[12] + l3.y * hf[13]; a1 += h3.x * hf[14] + h3.y * hf[15];
      d[j] = a0 + a1;
    }
#pragma unroll
    for (int q = 0; q < 4; ++q) {
      const float dot = reduce4_rows(d[4 * q], d[4 * q + 1], d[4 * q + 2], d[4 * q + 3], lane);
      const float gl = gelu_tanh(dot * (1.f / 512.f)) * (1.f / 64.f);
#pragma unroll
      for (int i = 0; i < 4; ++i) {
        const int j = 4 * q + i;
        const float ci = wj[j] * __builtin_bit_cast(float, __builtin_amdgcn_readlane(__builtin_bit_cast(int, gl), 16 * i));
        f32x2 tq;
        tq = __builtin_amdgcn_cvt_pk_f32_fp8((int)vv[j].x, false); o[0] += ci * tq.x; o[1] += ci * tq.y;
        tq = __builtin_amdgcn_cvt_pk_f32_fp8((int)vv[j].x, true);  o[2] += ci * tq.x; o[3] += ci * tq.y;
        tq = __builtin_amdgcn_cvt_pk_f32_fp8((int)vv[j].y, false); o[4] += ci * tq.x; o[5] += ci * tq.y;
        tq = __builtin_amdgcn_cvt_pk_f32_fp8((int)vv[j].y, true);  o[6] += ci * tq.x; o[7] += ci * tq.y;
        tq = __builtin_amdgcn_cvt_pk_f32_fp8((int)vv[j].z, false); o[8] += ci * tq.x; o[9] += ci * tq.y;
        tq = __builtin_amdgcn_cvt_pk_f32_fp8((int)vv[j].z, true);  o[10] += ci * tq.x; o[11] += ci * tq.y;
        tq = __builtin_amdgcn_cvt_pk_f32_fp8((int)vv[j].w, false); o[12] += ci * tq.x; o[13] += ci * tq.y;
        tq = __builtin_amdgcn_cvt_pk_f32_fp8((int)vv[j].w, true);  o[14] += ci * tq.x; o[15] += ci * tq.y;
      }
    }
  }
  const int b = t >> 12;
  const float* mod = (const float*)(p.ws + OFF_MOD) + b * 6144 + 5120 + 16 * lane;
  float* xm = p.out + (size_t)t * 1024 + 16 * lane;
  float xo[16];
  float ss = 0.f;
#pragma unroll
  for (int q = 0; q < 4; ++q) {
    const float4 xv = *(const float4*)(xm + 4 * q);
    const float4 gv = *(const float4*)(mod + 4 * q);
    xo[4 * q + 0] = xv.x + gv.x * o[4 * q + 0];
    xo[4 * q + 1] = xv.y + gv.y * o[4 * q + 1];
    xo[4 * q + 2] = xv.z + gv.z * o[4 * q + 2];
    xo[4 * q + 3] = xv.w + gv.w * o[4 * q + 3];
  }
#pragma unroll
  for (int k = 0; k < 16; ++k) ss += xo[k] * xo[k];
  ss = wave_sum(ss);
  const float r = rsqrtf(ss * (1.f / 1024.f) + 1e-6f);
#pragma unroll
  for (int q = 0; q < 4; ++q) {
    const float4 fg = *(const float4*)(p.final_g + 16 * lane + 4 * q);
    *(float4*)(xm + 4 * q) = make_float4(xo[4 * q] * r * fg.x, xo[4 * q + 1] * r * fg.y, xo[4 * q + 2] * r * fg.z, xo[4 * q + 3] * r * fg.w);
  }
}

DEV void p9_experts4(const Params& p, int task, char* wsm) {
  const int lane = threadIdx.x & 63;
  const int t0 = task * 4;
  int* hist = (int*)wsm;
  unsigned* skey = (unsigned*)(wsm + 1024);
  float* swt = (float*)(wsm + 1024 + 2048);
  u16* sh2 = (u16*)(wsm + 1024 + 4096);
  hist[lane] = 0; hist[lane + 64] = 0; hist[lane + 128] = 0; hist[lane + 192] = 0;
  const int* ridx = (const int*)(p.ws + OFF_RIDX) + (size_t)t0 * 128 + lane * 8;
  const float* rw = (const float*)(p.ws + OFF_RW) + (size_t)t0 * 128 + lane * 8;
  int4 ea = *(const int4*)(ridx), eb = *(const int4*)(ridx + 4);
  float4 wa = *(const float4*)(rw), wb = *(const float4*)(rw + 4);
  int e[8] = {ea.x, ea.y, ea.z, ea.w, eb.x, eb.y, eb.z, eb.w};
  float w[8] = {wa.x, wa.y, wa.z, wa.w, wb.x, wb.y, wb.z, wb.w};
  {
    const u16* h2 = (const u16*)(p.ws + OFF_H2) + (size_t)t0 * 1024;
#pragma unroll
    for (int i = 0; i < 8; ++i) *(u32x4*)(sh2 + (lane + 64 * i) * 8) = *(const u32x4*)(h2 + (lane + 64 * i) * 8);
  }
  __builtin_amdgcn_fence(__ATOMIC_RELEASE, "wavefront");
  __builtin_amdgcn_wave_barrier();
  __builtin_amdgcn_fence(__ATOMIC_ACQUIRE, "wavefront");
  int rank[8];
#pragma unroll
  for (int j = 0; j < 8; ++j) rank[j] = atomicAdd(&hist[e[j] >> 6], 1);
  __builtin_amdgcn_fence(__ATOMIC_RELEASE, "wavefront");
  __builtin_amdgcn_wave_barrier();
  __builtin_amdgcn_fence(__ATOMIC_ACQUIRE, "wavefront");
  {
    const int c0 = hist[4 * lane], c1 = hist[4 * lane + 1], c2 = hist[4 * lane + 2], c3 = hist[4 * lane + 3];
    const int tot = c0 + c1 + c2 + c3;
    int x = tot;
#pragma unroll
    for (int o = 1; o < 64; o <<= 1) { const int y = __shfl_up(x, o); if (lane >= o) x += y; }
    const int base = x - tot;
    __builtin_amdgcn_fence(__ATOMIC_RELEASE, "wavefront");
    __builtin_amdgcn_wave_barrier();
    hist[4 * lane] = base; hist[4 * lane + 1] = base + c0; hist[4 * lane + 2] = base + c0 + c1; hist[4 * lane + 3] = base + c0 + c1 + c2;
  }
  __builtin_amdgcn_fence(__ATOMIC_RELEASE, "wavefront");
  __builtin_amdgcn_wave_barrier();
  __builtin_amdgcn_fence(__ATOMIC_ACQUIRE, "wavefront");
  {
    const unsigned slot = (unsigned)(lane >> 4);
#pragma unroll
    for (int j = 0; j < 8; ++j) {
      const int pos = hist[e[j] >> 6] + rank[j];
      skey[pos] = (unsigned)e[j] | (slot << 14);
      swt[pos] = w[j];
    }
  }
  __builtin_amdgcn_fence(__ATOMIC_RELEASE, "wavefront");
  __builtin_amdgcn_wave_barrier();
  __builtin_amdgcn_fence(__ATOMIC_ACQUIRE, "wavefront");

  float o0[16], o1[16], o2[16], o3[16];
#pragma unroll
  for (int k = 0; k < 16; ++k) { o0[k] = 0.f; o1[k] = 0.f; o2[k] = 0.f; o3[k] = 0.f; }
  const u16* U = (const u16*)(p.ws + OFF_UBF);
  const u16* V = (const u16*)(p.ws + OFF_VBF);
#define P9_LOAD(KK, UU, VV, BB)                                                           \
  _Pragma("unroll") for (int i = 0; i < 4; ++i) {                                         \
    KK[i] = (unsigned)__builtin_amdgcn_readfirstlane((int)skey[4 * (BB) + i]);            \
    const size_t ro = (size_t)(KK[i] & 16383u) * 1024 + 16 * lane;                        \
    UU[i] = *(const u32x4*)(U8 + ro);                                                     \
    VV[i] = *(const u32x4*)(V8 + ro);                                                     \
  }
#define P9_DOTS(KK, UU, BB, COEFV)                                                        \
  {                                                                                       \
    const float myw = swt[4 * (BB) + (lane >> 4)];                                        \
    float d[4];                                                                           \
    _Pragma("unroll") for (int i = 0; i < 4; ++i) {                                       \
      const unsigned slot = KK[i] >> 14;                                                  \
      const u32x4 ha = *(const u32x4*)(sh2 + slot * 1024 + 16 * lane);                    \
      const u32x4 hb = *(const u32x4*)(sh2 + slot * 1024 + 16 * lane + 8);                \
      float acc0 = 0.f, acc1 = 0.f;                                                       \
      {                                                                                   \
        f32x2 l0 = __builtin_amdgcn_cvt_pk_f32_fp8((int)UU[i].x, false), h0 = __builtin_amdgcn_cvt_pk_f32_fp8((int)UU[i].x, true); \
        f32x2 l1 = __builtin_amdgcn_cvt_pk_f32_fp8((int)UU[i].y, false), h1 = __builtin_amdgcn_cvt_pk_f32_fp8((int)UU[i].y, true); \
        f32x2 l2 = __builtin_amdgcn_cvt_pk_f32_fp8((int)UU[i].z, false), h2_ = __builtin_amdgcn_cvt_pk_f32_fp8((int)UU[i].z, true); \
        f32x2 l3 = __builtin_amdgcn_cvt_pk_f32_fp8((int)UU[i].w, false), h3 = __builtin_amdgcn_cvt_pk_f32_fp8((int)UU[i].w, true); \
        acc0 += l0.x * bflo(ha.x) + l0.y * bfhi(ha.x); acc1 += h0.x * bflo(ha.y) + h0.y * bfhi(ha.y);   \
        acc0 += l1.x * bflo(ha.z) + l1.y * bfhi(ha.z); acc1 += h1.x * bflo(ha.w) + h1.y * bfhi(ha.w);   \
        acc0 += l2.x * bflo(hb.x) + l2.y * bfhi(hb.x); acc1 += h2_.x * bflo(hb.y) + h2_.y * bfhi(hb.y); \
        acc0 += l3.x * bflo(hb.z) + l3.y * bfhi(hb.z); acc1 += h3.x * bflo(hb.w) + h3.y * bfhi(hb.w);   \
      }                                                                                   \
      d[i] = acc0 + acc1;                                                                 \
    }                                                                                     \
    const bool up32 = (lane & 32) != 0, up16 = (lane & 16) != 0;                          \
    float k0 = up32 ? d[2] : d[0], k1 = up32 ? d[3] : d[1];                               \
    float s0 = up32 ? d[0] : d[2], s1 = up32 ? d[1] : d[3];                               \
    k0 += __shfl_xor(s0, 32);                                                             \
    k1 += __shfl_xor(s1, 32);                                                             \
    float kq = up16 ? k1 : k0, sq = up16 ? k0 : k1;                                       \
    kq += __shfl_xor(sq, 16);                                                             \
    kq = DPP_ADD(kq, 0xB1);                                                               \
    kq = DPP_ADD(kq, 0x4E);                                                               \
    kq = DPP_ADD(kq, 0x141);                                                              \
    kq = DPP_ADD(kq, 0x140);                                                              \
    COEFV = myw * (1.f / 64.f) * gelu_tanh(kq * (1.f / 512.f));                           \
  }
#define P9_ACCUM(KK, VV, COEFV)                                                           \
  _Pragma("unroll") for (int i = 0; i < 4; ++i) {                                         \
    const float ci = __builtin_bit_cast(float, __builtin_amdgcn_readlane(__builtin_bit_cast(int, COEFV), 16 * i)); \
    const unsigned slot = KK[i] >> 14;                                                    \
    float vf[16];                                                                         \
    {                                                                                     \
      f32x2 t;                                                                            \
      t = __builtin_amdgcn_cvt_pk_f32_fp8((int)VV[i].x, false); vf[0] = t.x; vf[1] = t.y;   \
      t = __builtin_amdgcn_cvt_pk_f32_fp8((int)VV[i].x, true);  vf[2] = t.x; vf[3] = t.y;   \
      t = __builtin_amdgcn_cvt_pk_f32_fp8((int)VV[i].y, false); vf[4] = t.x; vf[5] = t.y;   \
      t = __builtin_amdgcn_cvt_pk_f32_fp8((int)VV[i].y, true);  vf[6] = t.x; vf[7] = t.y;   \
      t = __builtin_amdgcn_cvt_pk_f32_fp8((int)VV[i].z, false); vf[8] = t.x; vf[9] = t.y;   \
      t = __builtin_amdgcn_cvt_pk_f32_fp8((int)VV[i].z, true);  vf[10] = t.x; vf[11] = t.y; \
      t = __builtin_amdgcn_cvt_pk_f32_fp8((int)VV[i].w, false); vf[12] = t.x; vf[13] = t.y; \
      t = __builtin_amdgcn_cvt_pk_f32_fp8((int)VV[i].w, true);  vf[14] = t.x; vf[15] = t.y; \
    }                                                                                     \
    if (slot == 0) { _Pragma("unroll") for (int k = 0; k < 16; ++k) o0[k] += ci * vf[k]; }       \
    else if (slot == 1) { _Pragma("unroll") for (int k = 0; k < 16; ++k) o1[k] += ci * vf[k]; }  \
    else if (slot == 2) { _Pragma("unroll") for (int k = 0; k < 16; ++k) o2[k] += ci * vf[k]; }  \
    else { _Pragma("unroll") for (int k = 0; k < 16; ++k) o3[k] += ci * vf[k]; }                 \
  }
  {
    const unsigned char* U8 = (const unsigned char*)(p.ws + OFF_UBF);
    const unsigned char* V8 = (const unsigned char*)(p.ws + OFF_VBF);
    unsigned kkA[4], kkB[4];
    u32x4 uA[4], vA[4], uB[4], vB[4];
    float cfA, cfB;
    P9_LOAD(kkA, uA, vA, 0)
#pragma unroll 1
    for (int bb = 0; bb < 128; bb += 2) {
      P9_LOAD(kkB, uB, vB, bb + 1)
      P9_DOTS(kkA, uA, bb, cfA)
      P9_ACCUM(kkA, vA, cfA)
      const int n0 = (bb + 2 < 128) ? (bb + 2) : 0;
      P9_LOAD(kkA, uA, vA, n0)
      P9_DOTS(kkB, uB, bb + 1, cfB)
      P9_ACCUM(kkB, vB, cfB)
    }
  }
#pragma unroll
  for (int s = 0; s < 4; ++s) {
    const int t = t0 + s;
    const int b = t >> 12;
    const float* mod = (const float*)(p.ws + OFF_MOD) + b * 6144 + 5120 + 16 * lane;
    float* xm = p.out + (size_t)t * 1024 + 16 * lane;
    const float* oo = (s == 0) ? o0 : ((s == 1) ? o1 : ((s == 2) ? o2 : o3));
    float xo[16];
    float ss = 0.f;
#pragma unroll
    for (int q = 0; q < 4; ++q) {
      const float4 xv = *(const float4*)(xm + 4 * q);
      const float4 gv = *(const float4*)(mod + 4 * q);
      xo[4 * q + 0] = xv.x + gv.x * oo[4 * q + 0];
      xo[4 * q + 1] = xv.y + gv.y * oo[4 * q + 1];
      xo[4 * q + 2] = xv.z + gv.z * oo[4 * q + 2];
      xo[4 * q + 3] = xv.w + gv.w * oo[4 * q + 3];
    }
#pragma unroll
    for (int k = 0; k < 16; ++k) ss += xo[k] * xo[k];
    ss = wave_sum(ss);
    const float r = rsqrtf(ss * (1.f / 1024.f) + 1e-6f);
#pragma unroll
    for (int q = 0; q < 4; ++q) {
      const float4 fg = *(const float4*)(p.final_g + 16 * lane + 4 * q);
      *(float4*)(xm + 4 * q) = make_float4(xo[4 * q] * r * fg.x, xo[4 * q + 1] * r * fg.y, xo[4 * q + 2] * r * fg.z, xo[4 * q + 3] * r * fg.w);
    }
  }
  __builtin_amdgcn_fence(__ATOMIC_RELEASE, "wavefront");
  __builtin_amdgcn_wave_barrier();
}

#define XB_TMO      128
#define XB_XCNT(j)  (256  + 64 * (j))
#define XB_XSUB(j)  (1280 + 64 * (j))
#define XB_XGEN(j)  (2304 + 64 * (j))
#define XB_TOP      3328
#define XB_TOPGEN   3392
#define XCD_BAR_WORDS 3456
#define XB_SPIN_CAP (1u << 18)
#define LAS __attribute__((address_space(3)))

__device__ __forceinline__ unsigned xb_ld(unsigned* p)              { return __hip_atomic_load(p, __ATOMIC_RELAXED, __HIP_MEMORY_SCOPE_AGENT); }
__device__ __forceinline__ unsigned xb_add(unsigned* p, unsigned v) { return __hip_atomic_fetch_add(p, v, __ATOMIC_RELAXED, __HIP_MEMORY_SCOPE_AGENT); }
__device__ __forceinline__ unsigned xb_xcc_id() { return (unsigned)__builtin_amdgcn_s_getreg((3 << 11) | 20) & 0xFu; }
#define XB_SPIN(cond, bar) do { unsigned _sp = 0; while (cond) { __builtin_amdgcn_s_sleep(1); \
    if ((++_sp & 255u) == 0u) { if (xb_ld(&(bar)[XB_TMO])) break; if (_sp > XB_SPIN_CAP) { atomicAdd(&(bar)[XB_TMO], 1u); break; } } } } while (0)

struct XcdBarrier {
    unsigned* bar; unsigned x;
    volatile LAS unsigned* st;
};

__device__ __forceinline__ XcdBarrier xcd_barrier_post(unsigned* bar, volatile LAS unsigned* st) {
    XcdBarrier b; b.bar = bar; b.x = xb_xcc_id(); b.st = st;
    if (threadIdx.x == 0) (void)xb_add(&bar[XB_XCNT(b.x)], 1u);
    return b;
}
__device__ __forceinline__ void xcd_barrier_complete(unsigned* bar, unsigned x, unsigned& nloc, unsigned& nx) {
    const unsigned G = gridDim.x * gridDim.y * gridDim.z;
    unsigned sum, cnt, mine, sp = 0u;
    for (;;) {
        sum = 0u; cnt = 0u; mine = 0u;
#pragma unroll
        for (unsigned j = 0; j < 16; ++j) { const unsigned c = xb_ld(&bar[XB_XCNT(j)]); sum += c; cnt += (c > 0u) ? 1u : 0u; mine = (j == x) ? c : mine; }
        if (sum == G) break;
        __builtin_amdgcn_s_sleep(1);
        if ((++sp & 255u) == 0u) { if (xb_ld(&bar[XB_TMO])) break; if (sp > XB_SPIN_CAP) { atomicAdd(&bar[XB_TMO], 1u); break; } }
    }
    nloc = mine > 0u ? mine : 1u; nx = cnt > 0u ? cnt : 1u;
}

__device__ __forceinline__ void xcd_barrier(const XcdBarrier& b) {
    asm volatile("s_waitcnt vmcnt(0)" ::: "memory");
    __syncthreads();
    if (threadIdx.x == 0) {
        unsigned* bar = b.bar;
        __builtin_amdgcn_s_waitcnt(0);
        unsigned nloc = b.st[0], nx = b.st[1];
        if (nloc == 0u) { xcd_barrier_complete(bar, b.x, nloc, nx); b.st[0] = nloc; b.st[1] = nx; }
        const unsigned old = xb_add(&bar[XB_XSUB(b.x)], 1u);
        const unsigned gen = old / nloc;
        if (old + 1u == (gen + 1u) * nloc) {
            __builtin_amdgcn_fence(__ATOMIC_RELEASE, "agent");
            asm volatile("s_waitcnt vmcnt(0)" ::: "memory");
            const unsigned og = xb_add(&bar[XB_TOP], 1u);
            const unsigned tg = og / nx;
            if (og + 1u == (tg + 1u) * nx) xb_add(&bar[XB_TOPGEN], 1u);
            else XB_SPIN(xb_ld(&bar[XB_TOPGEN]) == tg, bar);
            __builtin_amdgcn_fence(__ATOMIC_ACQUIRE, "agent");
            xb_add(&bar[XB_XGEN(b.x)], 1u);
            asm volatile("s_waitcnt vmcnt(0)" ::: "memory");
        } else {
            XB_SPIN(xb_ld(&bar[XB_XGEN(b.x)]) == gen, bar);
            __builtin_amdgcn_fence(__ATOMIC_ACQUIRE, "agent");
            asm volatile("s_waitcnt vmcnt(0)" ::: "memory");
        }
    }
    __syncthreads();
}


__global__ void __launch_bounds__(256, 2) mega(Params p) {
  extern __shared__ __attribute__((aligned(16))) char smem[];
  cg::grid_group grid = cg::this_grid();
  const int tid = threadIdx.x, lane = tid & 63, wave = tid >> 6;
  const int nb = gridDim.x, bid = blockIdx.x;
  float* smf = (float*)smem;
  if (p.ws == nullptr) grid.sync();
  volatile LAS unsigned* xst = (volatile LAS unsigned*)(smem + SMEM_XB);
  if (tid == 0) { xst[0] = 0u; xst[1] = 0u; }
  __syncthreads();
  const XcdBarrier xb = xcd_barrier_post((unsigned*)(p.ws + OFF_BAR), xst);
  u16* sA = (u16*)smem;
  u16* sB = (u16*)(smem + 128 * 64 * 2);

  for (int rep_ = 0; rep_ < NREP(0); ++rep_) if (PHON(0)) {
    const int N_MOD = 384, N_TIN = 16 * 68, N_TOA = 8 * 16, N_TOH = 8 * 16, N_TOUT = 16 * 16, N_TQ = 16 * 16, N_HID = 1024;
    const int total = N_MOD + N_TIN + N_TOA + N_TOH + N_TOUT + N_TQ + N_HID + 16 + 1;
    const bool conv_first = ((bid >> 3) & 1) != 0;
    if (conv_first) {
      convert_flat(p.peer_keys, (u16*)(p.ws + OFF_KEYS), (size_t)131072);
      convert_flat_fp8(p.peer_u, (unsigned char*)(p.ws + OFF_UBF), (size_t)16384 * 1024, 512.f);
      convert_flat_fp8(p.peer_v, (unsigned char*)(p.ws + OFF_VBF), (size_t)16384 * 1024, 64.f);
    }
    for (int it = bid; it < total; it += nb) {
      int i = it;
      if (i < N_MOD) { p0_mod(p, i, smf); continue; }
      i -= N_MOD;
      if (i < N_TIN) { transpose_tile(p.w_in, INW, 1024, (u16*)(p.ws + OFF_WIN), i, smf); continue; }
      i -= N_TIN;
      if (i < N_TOA) { transpose_tile(p.w_o_attn, 1024, 512, (u16*)(p.ws + OFF_WOA), i, smf); continue; }
      i -= N_TOA;
      if (i < N_TOH) { transpose_tile(p.w_o_hy, 1024, 512, (u16*)(p.ws + OFF_WOH), i, smf); continue; }
      i -= N_TOH;
      if (i < N_TOUT) { transpose_tile(p.w_out, 1024, 1024, (u16*)(p.ws + OFF_WOUT), i, smf); continue; }
      i -= N_TOUT;
      if (i < N_TQ) { transpose_tile(p.peer_wq, 1024, 1024, (u16*)(p.ws + OFF_WQ), i, smf); continue; }
      i -= N_TQ;
      if (i < N_HID) { p0_hidden(p, i, smf); continue; }
      i -= N_HID;
      if (i < 16) { transpose_tile(p.hy_fw3, 1024, 64, (u16*)(p.ws + OFF_H2F + 512 * 1024), i, smf); continue; }
      float2* rope = (float2*)(p.ws + OFF_ROPE);
      for (int idx = tid; idx < 1024; idx += 256) {
        const int pos = idx >> 4, f = idx & 15;
        const float inv = powf(10000.f, -(float)f / 16.f);
        const float ang = (float)pos * inv;
        rope[idx] = make_float2(cosf(ang), sinf(ang));
      }
    }
    if (!conv_first) {
      convert_flat(p.peer_keys, (u16*)(p.ws + OFF_KEYS), (size_t)131072);
      convert_flat_fp8(p.peer_u, (unsigned char*)(p.ws + OFF_UBF), (size_t)16384 * 1024, 512.f);
      convert_flat_fp8(p.peer_v, (unsigned char*)(p.ws + OFF_VBF), (size_t)16384 * 1024, 64.f);
    }
  }
  xcd_barrier(xb);

  for (int rep_ = 0; rep_ < NREP(1); ++rep_) if (PHON(1)) {
    const float* mod = (const float*)(p.ws + OFF_MOD);
    const int nrows = T_TOK + 1024;
    for (int r = bid * 4 + wave; r < nrows; r += nb * 4) {
      if (r < T_TOK) {
        const int b = r >> 12;
        norm_row(p.x + (size_t)r * 1024, p.norm1_g, mod + b * 6144, mod + b * 6144 + 1024,
                 (u16*)((char*)p.out + OO_H1) + (size_t)r * 1024, lane);
      } else {
        const int rc = r - T_TOK;
        norm_row(p.ctx + (size_t)rc * 1024, p.norm1_g, mod + 4 * 6144, mod + 4 * 6144 + 1024,
                 (u16*)((char*)p.out + OO_HC) + (size_t)rc * 1024, lane);
      }
    }
    for (int it = bid; it < 256; it += nb) p1_filter_tile(p, (it + 256 < nb) ? it : it, sA, sB);
  }
  xcd_barrier(xb);

  for (int rep_ = 0; rep_ < NREP(2); ++rep_) if (PHON(2)) {
    if (nb == 512) {
      const int xg = bid & 7, slot = bid >> 3;
      for (int r = 0; r < 8; ++r) {
        const int sup = r * 8 + xg;
        const int mt = (sup >> 2) * 8 + (slot >> 3), nt = (sup & 3) * 8 + (slot & 7);
        p2_inproj(p, mt * 34 + nt, sA, sB);
      }
      if (bid < 256) p2_inproj(p, (bid >> 1) * 34 + 32 + (bid & 1), sA, sB);
      else if (bid < 272) p2_ctxkv(p, bid - 256, sA, sB);
    } else {
      const int total = 128 * 34 + 16;
      for (int it = bid; it < total; it += nb) {
        if (it < 128 * 34) p2_inproj(p, it, sA, sB);
        else p2_ctxkv(p, it - 128 * 34, sA, sB);
      }
    }
  }
  xcd_barrier(xb);

  for (int rep_ = 0; rep_ < NREP(3); ++rep_) if (PHON(3)) {
    const int total = 1024 + 1024;
    const int flip = (nb == 512 && ((bid >> 3) & 1)) ? 1024 : 0;
    for (int it0 = bid; it0 < total; it0 += nb) {
      const int it = it0 ^ flip;
      if (it < 1024) p3_attn(p, it, (u16*)smem, (u16*)(smem + 128 * 72 * 2));
      else p3_hypre(p, it - 1024, (u16*)smem);
    }
  }
  xcd_barrier(xb);

  for (int rep_ = 0; rep_ < NREP(4); ++rep_) if (PHON(4)) for (int it = bid; it < 512; it += nb) p3_toeplitz(p, it, smem);
  xcd_barrier(xb);

  for (int rep_ = 0; rep_ < NREP(5); ++rep_) if (PHON(5)) for (int it = bid; it < 1024; it += nb) p4_merge(p, (nb == 512) ? ((((it >> 9) * 8 + (bid & 7)) * 8 + (bid >> 6)) * 8 + ((bid >> 3) & 7)) : it, sA, sB);
  xcd_barrier(xb);

  for (int rep_ = 0; rep_ < NREP(6); ++rep_) if (PHON(6)) for (int it = bid; it < 1024; it += nb) p5_out(p, (nb == 512) ? ((((it >> 9) * 8 + (bid & 7)) * 8 + (bid >> 6)) * 8 + ((bid >> 3) & 7)) : it, sA, sB);
  xcd_barrier(xb);

  for (int rep_ = 0; rep_ < NREP(7); ++rep_) if (PHON(7)) {
    const float* mod = (const float*)(p.ws + OFF_MOD);
    for (int r = bid * 4 + wave; r < T_TOK; r += nb * 4) {
      const int b = r >> 12;
      norm_row(p.out + (size_t)r * 1024, p.norm2_g, mod + b * 6144 + 3072, mod + b * 6144 + 4096,
               (u16*)(p.ws + OFF_H2) + (size_t)r * 1024, lane);
    }
  }
  xcd_barrier(xb);

  for (int rep_ = 0; rep_ < NREP(8); ++rep_) if (PHON(8)) for (int it = bid; it < 1024; it += nb) p7_qp(p, (nb == 512) ? ((((it >> 9) * 8 + (bid & 7)) * 8 + (bid >> 6)) * 8 + ((bid >> 3) & 7)) : it, sA, sB);
  xcd_barrier(xb);

  for (int rep_ = 0; rep_ < NREP(9); ++rep_) if (PHON(9)) {
    if (tid < 52) ((unsigned char*)(smem + 16384))[tid] = kTabG[tid];
    __syncthreads();
    for (int it = bid * 4 + wave; it < 8192; it += nb * 4) p8_route(p, it, smem + wave * 4096, (const unsigned char*)(smem + 16384));
  }
  xcd_barrier(xb);

  if (PHON(10)) {
    const int nw = nb * 4;
    int t = bid * 4 + wave;
    if (t < T_TOK) {
      int2 e2n = *(const int2*)((const int*)(p.ws + OFF_RIDX) + (size_t)t * 128 + 2 * lane);
      float2 w2n = *(const float2*)((const float*)(p.ws + OFF_RW) + (size_t)t * 128 + 2 * lane);
      u32x4 han = *(const u32x4*)((const u16*)(p.ws + OFF_H2) + (size_t)t * 1024 + 16 * lane);
      u32x4 hbn = *(const u32x4*)((const u16*)(p.ws + OFF_H2) + (size_t)t * 1024 + 16 * lane + 8);
      for (; t < T_TOK; t += nw) {
        const int tn = (t + nw < T_TOK) ? (t + nw) : t;
        p9_token(p, t, tn, lane, e2n, w2n, han, hbn);
      }
    }
  }
}

extern "C" void kernel_launch(void* const* d_in, const int* in_sizes, int n_in, void* d_out, int out_size,
                              void* d_ws, size_t ws_size, hipStream_t stream) {
  static int grid_blocks = 0;
  if (!grid_blocks) {
    int dev = 0, cus = 0, per_cu = 0;
    (void)hipGetDevice(&dev);
    (void)hipDeviceGetAttribute(&cus, hipDeviceAttributeMultiprocessorCount, dev);
    (void)hipFuncSetAttribute((const void*)mega, hipFuncAttributeMaxDynamicSharedMemorySize, SMEM_BYTES);
    (void)hipOccupancyMaxActiveBlocksPerMultiprocessor(&per_cu, mega, 256, SMEM_BYTES);
    if (per_cu > 2) per_cu = 2;
    if (per_cu < 1) per_cu = 1;
    grid_blocks = cus * per_cu;
  }
  Params p{};
  const float** pp = (const float**)&p;
  for (int i = 0; i < 28; ++i) pp[i] = (const float*)d_in[i];
  p.out = (float*)d_out;
  p.ws = (char*)d_ws;
  (void)hipMemsetAsync((char*)d_ws, 0, OFF_BAR + 24576, stream);
  void* args[] = {&p};
  hipError_t e = hipLaunchCooperativeKernel((void*)mega, dim3(grid_blocks), dim3(256), args, SMEM_BYTES, stream);
  if (e != hipSuccess) fprintf(stderr, "cooperative launch failed: %s (grid %d)\n", hipGetErrorString(e), grid_blocks);
}
```
